# Optimizing an MI355X kernel written in HIP

```python
import math
import jax
import jax.numpy as jnp
from jax import lax
import numpy as np


D_MODEL = 2048
BATCH = 4
SEQ = 2048
DEPTH = 4
DEC_BATCH = 4
DEC_SEQ = 4096
PAST_LEN = 128

GRID_W = 64
CHUNK = 128
Q_BLOCK = 128
N_GROUPS = 4
D_MIX = D_MODEL
W_GROUP = D_MIX // N_GROUPS
A_HEADS = 4
A_HEAD_W = W_GROUP // A_HEADS
B_W = W_GROUP
HYENA_ORDER = 2
POS_BANDS = 16
POS_EMB = 2 * POS_BANDS + 1
FILT_H = 64
HYENA_TARGET = 1e-2
HYENA_DECAY_SHORT = 0.3
HYENA_DECAY_LONG = 1.5
C_HEADS = 4
C_KV_HEADS = 2
C_HD = W_GROUP // C_HEADS
D_HEADS = 4
Q_LORA = D_MODEL // 4
KV_LORA = D_MODEL // 8
NOPE = 128
ROPE_D = 64
V_HD = W_GROUP // D_HEADS
ROPE_THETA = 10000.0
D_FF = 11 * D_MODEL // 4
EPS = 1e-6
IN_A = 2 * W_GROUP
IN_B = 3 * B_W
IN_C = (C_HEADS + 2 * C_KV_HEADS) * C_HD
IN_D = Q_LORA + KV_LORA + ROPE_D
IN_COLS = IN_A + IN_B + IN_C + IN_D

kernel_name = 'hybrid_bidir_encoder_two_groups'


def rms_norm(x, g):
    xf = x.astype(jnp.float32)
    y = xf * lax.rsqrt(jnp.mean(xf * xf, axis=-1, keepdims=True) + EPS)
    return y.astype(x.dtype) * g


def layer_norm(x, g):
    xf = x.astype(jnp.float32)
    xc = xf - jnp.mean(xf, axis=-1, keepdims=True)
    y = xc * lax.rsqrt(jnp.mean(xc * xc, axis=-1, keepdims=True) + EPS)
    return y.astype(x.dtype) * g


def dwconv3(x, w, b):
    xp = jnp.pad(x, ((0, 0), (1, 1), (0, 0)))
    return xp[:, :-2] * w[0] + xp[:, 1:-1] * w[1] + xp[:, 2:] * w[2] + b


def rope_half_split(x, ang):
    cos = jnp.cos(ang)[:, None, :].astype(x.dtype)
    sin = jnp.sin(ang)[:, None, :].astype(x.dtype)
    x1, x2 = jnp.split(x, 2, axis=-1)
    return jnp.concatenate([x1 * cos - x2 * sin, x2 * cos + x1 * sin], axis=-1)


def axial_rope(x, row, col):
    sec = x.shape[-1] // 2
    inv = ROPE_THETA ** (-jnp.arange(0, sec, 2, dtype=jnp.float32) / sec)
    return jnp.concatenate([rope_half_split(x[..., :sec], row[:, None] * inv),
                            rope_half_split(x[..., sec:], col[:, None] * inv)], axis=-1)


def block_attention(q, k, v):
    b, s, hkv, g, dk = q.shape
    nb = s // Q_BLOCK
    scale = 1.0 / math.sqrt(dk)
    qb = jnp.moveaxis(q.reshape(b, nb, Q_BLOCK, hkv, g, dk), 1, 0)

    def one_block(qi):
        sc = jnp.einsum('bqhgd,bkhd->bhgqk', qi, k, preferred_element_type=jnp.float32) * scale
        p = jax.nn.softmax(sc, axis=-1).astype(v.dtype)
        return jnp.einsum('bhgqk,bkhe->bqhge', p, v)

    o = lax.map(one_block, qb)
    return jnp.moveaxis(o, 0, 1).reshape(b, s, hkv * g * v.shape[-1])


def gmlp_mixer(proj, vnorm_g, ws, bs):
    z = jax.nn.gelu(proj, approximate=False)
    u, v = jnp.split(z, 2, axis=-1)
    v = layer_norm(v, vnorm_g)
    b, s, _ = v.shape
    vc = v.reshape(b, s // CHUNK, CHUNK, A_HEADS, A_HEAD_W)
    mixed = jnp.einsum('hpq,bnqhc->bnphc', ws, vc) + bs.T[None, None, :, :, None]
    return u * mixed.reshape(b, s, W_GROUP)


def hyena_filters(L, w1, b1, f1, w2, b2, f2, w3, decay):
    pos = jnp.arange(L, dtype=jnp.float32)
    t = jnp.linspace(0.0, 1.0, L, dtype=jnp.float32)
    bands = jnp.linspace(1e-4, POS_BANDS - 1, POS_BANDS, dtype=jnp.float32)
    ang = (2.0 * math.pi / L) * pos[:, None] * bands[None, :]
    feats = jnp.concatenate([t[:, None], jnp.cos(ang), -jnp.sin(ang)], axis=-1)
    h = jnp.sin(f1 * (feats @ w1 + b1))
    h = jnp.sin(f2 * (h @ w2 + b2))
    h = h @ w3
    window = jnp.exp(-t[:, None] * jnp.abs(decay).astype(jnp.float32))
    return (h * window).astype(jnp.float32).reshape(L, HYENA_ORDER, 2, B_W)


def bidir_long_conv(u, h_fwd, h_bwd, skip):
    L, ch = h_fwd.shape
    k_circ = jnp.concatenate([h_fwd, jnp.zeros((1, ch), jnp.float32), h_bwd[:0:-1]], axis=0)
    kf = jnp.fft.rfft(k_circ, n=2 * L, axis=0)
    uf32 = u.astype(jnp.float32)
    uf = jnp.fft.rfft(uf32, n=2 * L, axis=1)
    y = jnp.fft.irfft(uf * kf[None], n=2 * L, axis=1)[:, :L]
    return (y + uf32 * skip.astype(jnp.float32)).astype(u.dtype)


def hyena_mixer(proj, conv_w, conv_b, w1, b1, f1, w2, b2, f2, w3, decay, skip):
    L = proj.shape[1]
    z = dwconv3(proj, conv_w, conv_b)
    x1, x2, v = jnp.split(z, 3, axis=-1)
    h = hyena_filters(L, w1, b1, f1, w2, b2, f2, w3, decay)
    y = x1 * bidir_long_conv(v, h[:, 0, 0], h[:, 0, 1], skip[0])
    y = x2 * bidir_long_conv(y, h[:, 1, 0], h[:, 1, 1], skip[1])
    return y


def gqa_mixer(proj, qn_g, kn_g, row, col):
    b, s, _ = proj.shape
    q, k, v = jnp.split(proj, [C_HEADS * C_HD, (C_HEADS + C_KV_HEADS) * C_HD], axis=-1)
    q = q.reshape(b, s, C_HEADS, C_HD)
    k = k.reshape(b, s, C_KV_HEADS, C_HD)
    v = v.reshape(b, s, C_KV_HEADS, C_HD)
    q = axial_rope(rms_norm(q, qn_g), row, col)
    k = axial_rope(rms_norm(k, kn_g), row, col)
    q = q.reshape(b, s, C_KV_HEADS, C_HEADS // C_KV_HEADS, C_HD)
    return block_attention(q, k, v)


def mla_mixer(proj, q_a_g, w_q_b, kv_a_g, w_kv_b, qn_g, kn_g, row, col):
    b, s, _ = proj.shape
    q_a, c_kv, k_rope = jnp.split(proj, [Q_LORA, Q_LORA + KV_LORA], axis=-1)
    q = (rms_norm(q_a, q_a_g) @ w_q_b).reshape(b, s, D_HEADS, NOPE + ROPE_D)
    kv = (rms_norm(c_kv, kv_a_g) @ w_kv_b).reshape(b, s, D_HEADS, NOPE + V_HD)
    k_nope, v = jnp.split(kv, [NOPE], axis=-1)
    k = jnp.concatenate([k_nope, jnp.broadcast_to(k_rope[:, :, None, :], (b, s, D_HEADS, ROPE_D))], axis=-1)
    q = rms_norm(q, qn_g)
    k = rms_norm(k, kn_g)
    q = jnp.concatenate([q[..., :NOPE], axial_rope(q[..., NOPE:], row, col)], axis=-1)
    k = jnp.concatenate([k[..., :NOPE], axial_rope(k[..., NOPE:], row, col)], axis=-1)
    return block_attention(q[:, :, :, None, :], k, v)


def run_trunk(x, c, p):
    b, s, _ = x.shape
    rows = s // GRID_W
    row = jnp.repeat(jnp.arange(rows, dtype=jnp.float32), GRID_W)
    col = jnp.tile(jnp.arange(GRID_W, dtype=jnp.float32), rows)
    for l in range(DEPTH):
        mod = jax.nn.silu(c) @ p['ada_w'][l] + p['ada_b'][l]
        sh1, sc1, g1, sh2, sc2, g2 = [m[:, None, :] for m in jnp.split(mod, 6, axis=-1)]
        h = rms_norm(x, p['norm1_g'][l]) * (1 + sc1) + sh1
        proj = h @ p['w_in'][l]
        pa, pb, pc, pd = jnp.split(proj, [IN_A, IN_A + IN_B, IN_A + IN_B + IN_C], axis=-1)
        ya = gmlp_mixer(pa, p['gm_vnorm_g'][l], p['gm_spatial_w'][l], p['gm_spatial_b'][l])
        yb = hyena_mixer(pb, p['hy_conv_w'][l], p['hy_conv_b'][l], p['hy_w1'][l], p['hy_b1'][l], p['hy_f1'][l],
                         p['hy_w2'][l], p['hy_b2'][l], p['hy_f2'][l], p['hy_w3'][l], p['hy_decay'][l], p['hy_skip'][l])
        yc = gqa_mixer(pc, p['gqa_qn_g'][l], p['gqa_kn_g'][l], row, col)
        yd = mla_mixer(pd, p['mla_q_a_g'][l], p['mla_w_q_b'][l], p['mla_kv_a_g'][l], p['mla_w_kv_b'][l],
                       p['mla_qn_g'][l], p['mla_kn_g'][l], row, col)
        ycat = jnp.stack([ya, yb, yc, yd], axis=2)
        ycat = rms_norm(ycat, p['group_norm_g'][l].reshape(N_GROUPS, W_GROUP)).reshape(b, s, D_MIX)
        x = x + g1 * (ycat @ p['w_out'][l])
        h = rms_norm(x, p['norm2_g'][l]) * (1 + sc2) + sh2
        u = dwconv3(h @ p['ffn_w_up'][l], p['ffn_conv_w'][l], p['ffn_conv_b'][l])
        gate, up = jnp.split(u, 2, axis=-1)
        x = x + g2 * ((jax.nn.silu(gate) * up) @ p['ffn_w_down'][l])
    return x


def setup_inputs(seed: int = 0) -> dict:
    key = jax.random.key(seed)
    ks = iter(jax.random.split(key, 48))

    def nrm(shape, scale):
        return jax.random.normal(next(ks), shape, jnp.float32) * scale

    def gain(shape):
        return 1.0 + nrm(shape, 0.02)

    L = DEPTH
    decay_base = jnp.abs(jnp.linspace(math.log(HYENA_TARGET) / HYENA_DECAY_LONG,
                                      math.log(HYENA_TARGET) / HYENA_DECAY_SHORT, B_W, dtype=jnp.float32))
    decay_base = jnp.tile(decay_base, HYENA_ORDER * 2)
    return {
        'x_prompt': nrm((BATCH, SEQ, D_MODEL), 1.0),
        'x_sample': nrm((DEC_BATCH, DEC_SEQ, D_MODEL), 1.0),
        'c_prompt': nrm((BATCH, D_MODEL), 1.0),
        'c_sample': nrm((DEC_BATCH, D_MODEL), 1.0),
        'ada_w': nrm((L, D_MODEL, 6 * D_MODEL), 0.5 * D_MODEL ** -0.5),
        'ada_b': nrm((L, 6 * D_MODEL), 0.02),
        'norm1_g': gain((L, D_MODEL)),
        'w_in': nrm((L, D_MODEL, IN_COLS), D_MODEL ** -0.5),
        'gm_vnorm_g': gain((L, W_GROUP)),
        'gm_spatial_w': nrm((L, A_HEADS, CHUNK, CHUNK), CHUNK ** -0.5),
        'gm_spatial_b': gain((L, A_HEADS, CHUNK)),
        'hy_conv_w': nrm((L, 3, IN_B), 3 ** -0.5),
        'hy_conv_b': nrm((L, IN_B), 0.02),
        'hy_w1': nrm((L, POS_EMB, FILT_H), POS_EMB ** -0.5),
        'hy_b1': nrm((L, FILT_H), 0.1),
        'hy_f1': gain((L, FILT_H)),
        'hy_w2': nrm((L, FILT_H, FILT_H), FILT_H ** -0.5),
        'hy_b2': nrm((L, FILT_H), 0.1),
        'hy_f2': gain((L, FILT_H)),
        'hy_w3': nrm((L, FILT_H, HYENA_ORDER * 2 * B_W), 0.1 * FILT_H ** -0.5),
        'hy_decay': decay_base * (1.0 + nrm((L, HYENA_ORDER * 2 * B_W), 0.05)),
        'hy_skip': nrm((L, HYENA_ORDER, B_W), 0.5),
        'gqa_qn_g': gain((L, C_HD)),
        'gqa_kn_g': gain((L, C_HD)),
        'mla_q_a_g': gain((L, Q_LORA)),
        'mla_w_q_b': nrm((L, Q_LORA, D_HEADS * (NOPE + ROPE_D)), Q_LORA ** -0.5),
        'mla_kv_a_g': gain((L, KV_LORA)),
        'mla_w_kv_b': nrm((L, KV_LORA, D_HEADS * (NOPE + V_HD)), KV_LORA ** -0.5),
        'mla_qn_g': gain((L, NOPE + ROPE_D)),
        'mla_kn_g': gain((L, NOPE + ROPE_D)),
        'group_norm_g': gain((L, D_MIX)),
        'w_out': nrm((L, D_MIX, D_MODEL), D_MIX ** -0.5),
        'norm2_g': gain((L, D_MODEL)),
        'ffn_w_up': nrm((L, D_MODEL, 2 * D_FF), D_MODEL ** -0.5),
        'ffn_conv_w': nrm((L, 3, 2 * D_FF), 3 ** -0.5),
        'ffn_conv_b': nrm((L, 2 * D_FF), 0.02),
        'ffn_w_down': nrm((L, D_FF, D_MODEL), D_FF ** -0.5),
    }


def reference(x_prompt, x_sample, c_prompt, c_sample, ada_w, ada_b, norm1_g, w_in, gm_vnorm_g, gm_spatial_w,
              gm_spatial_b, hy_conv_w, hy_conv_b, hy_w1, hy_b1, hy_f1, hy_w2, hy_b2, hy_f2, hy_w3, hy_decay, hy_skip,
              gqa_qn_g, gqa_kn_g, mla_q_a_g, mla_w_q_b, mla_kv_a_g, mla_w_kv_b, mla_qn_g, mla_kn_g, group_norm_g,
              w_out, norm2_g, ffn_w_up, ffn_conv_w, ffn_conv_b, ffn_w_down):
    params = {
        'ada_w': ada_w, 'ada_b': ada_b, 'norm1_g': norm1_g, 'w_in': w_in,
        'gm_vnorm_g': gm_vnorm_g, 'gm_spatial_w': gm_spatial_w, 'gm_spatial_b': gm_spatial_b,
        'hy_conv_w': hy_conv_w, 'hy_conv_b': hy_conv_b, 'hy_w1': hy_w1, 'hy_b1': hy_b1, 'hy_f1': hy_f1,
        'hy_w2': hy_w2, 'hy_b2': hy_b2, 'hy_f2': hy_f2, 'hy_w3': hy_w3, 'hy_decay': hy_decay, 'hy_skip': hy_skip,
        'gqa_qn_g': gqa_qn_g, 'gqa_kn_g': gqa_kn_g,
        'mla_q_a_g': mla_q_a_g, 'mla_w_q_b': mla_w_q_b, 'mla_kv_a_g': mla_kv_a_g, 'mla_w_kv_b': mla_w_kv_b,
        'mla_qn_g': mla_qn_g, 'mla_kn_g': mla_kn_g,
        'group_norm_g': group_norm_g, 'w_out': w_out, 'norm2_g': norm2_g,
        'ffn_w_up': ffn_w_up, 'ffn_conv_w': ffn_conv_w, 'ffn_conv_b': ffn_conv_b, 'ffn_w_down': ffn_w_down,
    }
    y_prompt = run_trunk(x_prompt, c_prompt, params)
    y_sample = run_trunk(x_sample, c_sample, params)
    return (y_prompt, y_sample)
```

```cpp
#include <hip/hip_runtime.h>
#include <hip/hip_bf16.h>
#include <cstdio>
#include <cstdint>
#include <cmath>

#ifndef MK_MULTI
#define MK_MULTI 1
#endif

constexpr int DM = 2048, NTOK = 24576, NPR = 8192  , LP = 2048, LS = 4096, DEPTH = 4, NB = 8  ;
constexpr int INC = 4416, INCP = 4608;
constexpr int C_A = 0, C_B = 1024, C_C = 2560, C_D = 3584;
constexpr int DFF = 5632, DFF2 = 11264;
constexpr int MODW = 6 * DM;
constexpr float EPS = 1e-6f;
constexpr int NWAVES = 8, NTHR = 512;

constexpr size_t MiB = 1u << 20;
constexpr size_t WS_CTL = 0, CTL_ZERO_BYTES = 1 * MiB;
constexpr size_t WS_MOD = 1 * MiB;
constexpr size_t WS_ROPE = WS_MOD + (size_t)DEPTH * NB * MODW * 4;
constexpr size_t WS_WIN = 3 * MiB;
constexpr size_t SZ_WIN = (size_t)INCP * DM * 2;
constexpr size_t WS_WQB = WS_WIN + DEPTH * SZ_WIN;
constexpr size_t SZ_WQB = (size_t)768 * 512 * 2;
constexpr size_t WS_WKVB = WS_WQB + DEPTH * SZ_WQB;
constexpr size_t SZ_WKVB = (size_t)1024 * 256 * 2;
constexpr size_t WS_WOUT = WS_WKVB + DEPTH * SZ_WKVB;
constexpr size_t SZ_WOUT = (size_t)DM * DM * 2;
constexpr size_t WS_WUP = WS_WOUT + DEPTH * SZ_WOUT;
constexpr size_t SZ_WUP = (size_t)DFF2 * DM * 2;
constexpr size_t WS_WDN = WS_WUP + DEPTH * SZ_WUP;
constexpr size_t SZ_WDN = (size_t)DM * DFF * 2;
constexpr size_t WS_GF = WS_WDN + DEPTH * SZ_WDN;
constexpr size_t SZ_GF_P = (size_t)2 * 512 * 4608 * 2, SZ_GF_S = (size_t)2 * 512 * 9216 * 2, SZ_GF = SZ_GF_P + SZ_GF_S;
constexpr size_t WS_HB = WS_GF + DEPTH * SZ_GF;
constexpr size_t WS_AFFN = WS_HB + (size_t)NTOK * DM * 2;
constexpr size_t WS_R1 = WS_AFFN + (size_t)NTOK * DFF * 2;
constexpr size_t WS_Z = WS_R1;
constexpr size_t WS_PROJ = WS_R1;
constexpr size_t WS_XT = WS_PROJ + (size_t)NTOK * INCP * 2;
constexpr size_t SZ_XT1 = (size_t)NTOK * 512 * 2;
constexpr size_t WS_Y2T = WS_XT + 3 * SZ_XT1;
constexpr size_t WS_QD = WS_Y2T + SZ_XT1;
constexpr size_t WS_KVD = WS_QD + (size_t)NTOK * 768 * 2;
constexpr size_t WS_KMLA = WS_KVD + (size_t)NTOK * 1024 * 2;
constexpr size_t WS_YCAT = WS_KMLA + (size_t)NTOK * 768 * 2;
constexpr size_t WS_END = WS_R1 + (size_t)NTOK * DFF2 * 2;
static_assert(WS_YCAT + (size_t)NTOK * DM * 2 <= WS_END, "mixer buffers fit under Z");
static_assert(WS_ROPE <= WS_WIN, "ws map");
constexpr int CW_BAR = 4096;

__host__ __device__ __forceinline__ size_t xt_off(int b, int c) { return b < 4 ? ((size_t)(b * 512 + c) * LP) : ((size_t)4 * 512 * LP + (size_t)((b - 4) * 512 + c) * LS); }
__host__ __device__ __forceinline__ int row_batch(int row) { return row < NPR ? (row >> 11) : 4 + ((row - NPR) >> 12); }
__host__ __device__ __forceinline__ int row_pos(int row) { return row < NPR ? (row & (LP - 1)) : ((row - NPR) & (LS - 1)); }
__host__ __device__ __forceinline__ int batch_row0(int b) { return b < 4 ? b * LP : NPR + (b - 4) * LS; }
__host__ __device__ __forceinline__ int batch_len(int b) { return b < 4 ? LP : LS; }

constexpr int RING_BYTES = 131072;
constexpr int LDSCTL_OFF = RING_BYTES, MISC_OFF = LDSCTL_OFF + 320;
constexpr int LDS_BYTES = 147456;
#define GAS __attribute__((address_space(1)))
#define LAS __attribute__((address_space(3)))
typedef unsigned short bf16;
typedef unsigned v4u __attribute__((ext_vector_type(4)));
typedef float f32x4 __attribute__((ext_vector_type(4)));
typedef short bf16x8 __attribute__((ext_vector_type(8)));
typedef GAS unsigned gu32;
typedef GAS unsigned long long gu64;
#define RLX_AGENT __ATOMIC_RELAXED, __HIP_MEMORY_SCOPE_AGENT
#define LDS_WAIT() asm volatile("s_waitcnt lgkmcnt(0)" ::: "memory")
#define VM_WAIT() asm volatile("s_waitcnt vmcnt(0)" ::: "memory")
__device__ __forceinline__ int tid_fresh() { int t = threadIdx.x; asm volatile("" : "+v"(t)); return t; }
__device__ __forceinline__ unsigned long long rt() { return __builtin_amdgcn_s_memrealtime(); }
__device__ __forceinline__ unsigned f2bf(float f) { unsigned u = __builtin_bit_cast(unsigned, f); return (u + 0x7fffu + ((u >> 16) & 1u)) >> 16; }
__device__ __forceinline__ unsigned pk2(float lo, float hi) { return f2bf(lo) | (f2bf(hi) << 16); }
#define XB_TMO      128
#define XB_XCNT(j)  (256  + 64 * (j))
#define XB_XSUB(j)  (1280 + 64 * (j))
#define XB_XGEN(j)  (2304 + 64 * (j))
#define XB_TOP      3328
#define XB_TOPGEN   3392
#define XCD_BAR_WORDS 3456
#define XB_SPIN_CAP (1u << 18)

__device__ __forceinline__ unsigned xb_ld(unsigned* p)              { return __hip_atomic_load(p, __ATOMIC_RELAXED, __HIP_MEMORY_SCOPE_AGENT); }
__device__ __forceinline__ unsigned xb_add(unsigned* p, unsigned v) { return __hip_atomic_fetch_add(p, v, __ATOMIC_RELAXED, __HIP_MEMORY_SCOPE_AGENT); }
__device__ __forceinline__ unsigned xb_xcc_id() { return (unsigned)__builtin_amdgcn_s_getreg((3 << 11) | 20) & 0xFu; }
#define XB_SPIN(cond, bar) do { unsigned _sp = 0; while (cond) { __builtin_amdgcn_s_sleep(1); \
    if ((++_sp & 255u) == 0u) { if (xb_ld(&(bar)[XB_TMO])) break; if (_sp > XB_SPIN_CAP) { atomicAdd(&(bar)[XB_TMO], 1u); break; } } } } while (0)

struct XcdBarrier {
    unsigned* bar; unsigned x;
    volatile LAS unsigned* st;
};

__device__ __forceinline__ XcdBarrier xcd_barrier_post(unsigned* bar, volatile LAS unsigned* st) {
    XcdBarrier b; b.bar = bar; b.x = xb_xcc_id(); b.st = st;
    if (threadIdx.x == 0) (void)xb_add(&bar[XB_XCNT(b.x)], 1u);
    return b;
}
__device__ __forceinline__ void xcd_barrier_complete(unsigned* bar, unsigned x, unsigned& nloc, unsigned& nx) {
    const unsigned G = gridDim.x * gridDim.y * gridDim.z;
    unsigned sum, cnt, mine, sp = 0u;
    for (;;) {
        sum = 0u; cnt = 0u; mine = 0u;
#pragma unroll
        for (unsigned j = 0; j < 16; ++j) { const unsigned c = xb_ld(&bar[XB_XCNT(j)]); sum += c; cnt += (c > 0u) ? 1u : 0u; mine = (j == x) ? c : mine; }
        if (sum == G) break;
        __builtin_amdgcn_s_sleep(1);
        if ((++sp & 255u) == 0u) { if (xb_ld(&bar[XB_TMO])) break; if (sp > XB_SPIN_CAP) { atomicAdd(&bar[XB_TMO], 1u); break; } }
    }
    nloc = mine > 0u ? mine : 1u; nx = cnt > 0u ? cnt : 1u;
}

__device__ __forceinline__ void xcd_barrier(const XcdBarrier& b) {
    asm volatile("s_waitcnt vmcnt(0)" ::: "memory");
    __syncthreads();
    if (threadIdx.x == 0) {
        unsigned* bar = b.bar;
        __builtin_amdgcn_s_waitcnt(0);
        unsigned nloc = b.st[0], nx = b.st[1];
        if (nloc == 0u) { xcd_barrier_complete(bar, b.x, nloc, nx); b.st[0] = nloc; b.st[1] = nx; }
        const unsigned old = xb_add(&bar[XB_XSUB(b.x)], 1u);
        const unsigned gen = old / nloc;
        if (old + 1u == (gen + 1u) * nloc) {
            __builtin_amdgcn_fence(__ATOMIC_RELEASE, "agent");
            asm volatile("s_waitcnt vmcnt(0)" ::: "memory");
            const unsigned og = xb_add(&bar[XB_TOP], 1u);
            const unsigned tg = og / nx;
            if (og + 1u == (tg + 1u) * nx) xb_add(&bar[XB_TOPGEN], 1u);
            else XB_SPIN(xb_ld(&bar[XB_TOPGEN]) == tg, bar);
            __builtin_amdgcn_fence(__ATOMIC_ACQUIRE, "agent");
            xb_add(&bar[XB_XGEN(b.x)], 1u);
            asm volatile("s_waitcnt vmcnt(0)" ::: "memory");
        } else {
            XB_SPIN(xb_ld(&bar[XB_XGEN(b.x)]) == gen, bar);
            __builtin_amdgcn_fence(__ATOMIC_ACQUIRE, "agent");
            asm volatile("s_waitcnt vmcnt(0)" ::: "memory");
        }
    }
    __syncthreads();
}
namespace pg8 {
#define PG8_LAS __attribute__((address_space(3)))
typedef unsigned short bf16_t;
typedef short bf16x8 __attribute__((ext_vector_type(8)));
typedef float f32x4 __attribute__((ext_vector_type(4)));
typedef unsigned u32x4 __attribute__((ext_vector_type(4)));
constexpr int BM = 256, BK = 64, HALF = 128, HTB = HALF * BK * 2  , STAGE_BYTES = 8 * HTB, NXCD = 8, WGM = 8;

__host__ __device__ __forceinline__ int lds_byte(int r, int c) { const int st = (r >> 4) * 2 + (c >> 5), rr = r & 15, cc = c & 31, ob = rr * 64 + cc * 2; return st * 1024 + (ob ^ (((ob >> 9) & 1) << 5)); }
__host__ __device__ __forceinline__ void stage_rc(int b, int& R, int& C) { const int st = b / 1024, sb = b % 1024, swz = sb ^ (((sb >> 9) & 1) << 5); R = (st >> 1) * 16 + swz / 64; C = (st & 1) * 32 + (swz % 64) / 2; }
__host__ __device__ __forceinline__ int perm32(int rho) { const int n = rho >> 4, i = rho & 15; return 8 * (i >> 2) + 4 * n + (i & 3); }

struct Unit { int pm, pn; };
struct Gemm { const bf16_t* A; const bf16_t* Bt; int M, N, K, lda, ldb; };

struct StaticOrder {
    int nM, nN, nwg, G, c;
    __host__ __device__ void init(int M, int N, int G_, int c_) { nM = M / BM; nN = N / BM; nwg = nM * nN; G = G_; c = c_; }
    __host__ __device__ bool next(int i, Unit& u) const {
        const long L = (long)i * G + c; if (L >= nwg) return false;
        int wgid = (int)L; { const int q = nwg / NXCD, r = nwg % NXCD, xcd = wgid % NXCD, off = wgid / NXCD; wgid = (xcd < r ? xcd * (q + 1) : r * (q + 1) + (xcd - r) * q) + off; }
        const int nig = WGM * nN, gid = wgid / nig, fm = gid * WGM, gsz = (nM - fm) < WGM ? (nM - fm) : WGM;
        u.pm = fm + ((wgid % nig) % gsz); u.pn = (wgid % nig) / gsz; return true;
    }
    __device__ __forceinline__ void a_ready(const Unit&) const {}
    __device__ __forceinline__ void done(const Unit&) const {}
};

__device__ __forceinline__ unsigned cvt_pk_bf16(float lo, float hi) { unsigned r; asm volatile("v_cvt_pk_bf16_f32 %0, %1, %2" : "=v"(r) : "v"(lo), "v"(hi)); return r; }
typedef float f32x2 __attribute__((ext_vector_type(2)));
__device__ __forceinline__ f32x2 gelu_pk(f32x2 v) {
    const f32x2 av = __builtin_elementwise_abs(v), d = av * 0.2316418882f + 1.0f;
    f32x2 t; t.x = __builtin_amdgcn_rcpf(d.x); t.y = __builtin_amdgcn_rcpf(d.y);
    f32x2 q = t * 0.5307027145f + (-0.7265760135f); q = q * t + 0.7107068705f; q = q * t + (-0.142248368f); q = q * t + 0.127414796f; q = q * t;
    const f32x2 s = (v * v) * (-0.72134752044f);
    f32x2 e; e.x = __builtin_amdgcn_exp2f(s.x); e.y = __builtin_amdgcn_exp2f(s.y);
    const f32x2 m = v * (q * e), r = v - m;
    f32x2 o; o.x = v.x < 0.f ? m.x : r.x; o.y = v.y < 0.f ? m.y : r.y; return o;
}

template <class Epi, class Sched, bool ALIGN_EPI = false, bool SP2 = false>
__device__ __forceinline__ void gemm_phase(PG8_LAS unsigned char* lds, const Gemm g, const Sched& S, const Epi& E) {
    const int tid = tid_fresh(), wid = __builtin_amdgcn_readfirstlane(tid >> 6), lane = tid & 63, wr = wid >> 2, wc = wid & 3, fr = lane & 15, fq = lane >> 4;
    const int K = g.K, nt = K / BK;
    unsigned voffA[2], voffB[2];
#pragma unroll
    for (int i = 0; i < 2; ++i) { int R, C; stage_rc(tid * 16 + i * 8192, R, C); const int Rb = Epi::PERM ? ((R & ~31) + perm32(R & 31)) : R;
        voffA[i] = (unsigned)(R * g.lda + C) * 2u; voffB[i] = (unsigned)(Rb * g.ldb + C) * 2u; }
    const size_t kstep = (size_t)(BK * 2);
    const size_t hstepA = (size_t)HALF * g.lda * 2, hstepB = (size_t)HALF * g.ldb * 2;
    const size_t tstepA = 2 * hstepA, tstepB = 2 * hstepB;
    const unsigned ldsw = (unsigned)wid * 1024u;
    const int aoff = lds_byte(wr * 64 + fr, fq * 8), boff = lds_byte(wc * 32 + fr, fq * 8);
#define PG8_SA(b, h) (((b) * 2 + (h)) * HTB)
#define PG8_SB(b, h) ((4 + (b) * 2 + (h)) * HTB)
#define PG8_STAGE(bufoff, gbase, voff) do { _Pragma("unroll") for (int _i = 0; _i < 2; ++_i) \
        __builtin_amdgcn_global_load_lds((const unsigned*)((const char*)(gbase) + (voff)[_i]), (PG8_LAS unsigned*)(lds + (bufoff) + ldsw + _i * 8192), 16, 0, 0); } while (0)
#define PG8_LDA(dst, b, h) do { _Pragma("unroll") for (int m = 0; m < 4; ++m) _Pragma("unroll") for (int k = 0; k < 2; ++k) dst[m][k] = *(const PG8_LAS bf16x8*)(lds + PG8_SA(b, h) + aoff + m * 2048 + k * 1024); } while (0)
#define PG8_LDB(dst, b, h) do { _Pragma("unroll") for (int n = 0; n < 2; ++n) _Pragma("unroll") for (int k = 0; k < 2; ++k) dst[n][k] = *(const PG8_LAS bf16x8*)(lds + PG8_SB(b, h) + boff + n * 2048 + k * 1024); } while (0)
#define PG8_MMA(ai, bj, At, Bt) do { __builtin_amdgcn_s_setprio(1); _Pragma("unroll") for (int m = 0; m < 4; ++m) _Pragma("unroll") for (int n = 0; n < 2; ++n) _Pragma("unroll") for (int k = 0; k < 2; ++k) \
        acc[ai][bj][m][n] = __builtin_amdgcn_mfma_f32_16x16x32_bf16(Bt[n][k], At[m][k], acc[ai][bj][m][n], 0, 0, 0); __builtin_amdgcn_s_setprio(0); } while (0)
#define PG8_WAIT_V(n) asm volatile("s_waitcnt vmcnt(" #n ")" ::: "memory")
#define PG8_WAIT_L(n) asm volatile("s_waitcnt lgkmcnt(" #n ")" ::: "memory")
#define PG8_BAR __builtin_amdgcn_s_barrier()
#define PG8_SCHED __builtin_amdgcn_sched_barrier(0)
    Unit cur, nxt; int ui = 0;
    if (!S.next(0, cur)) return;
    f32x4 acc[2][2][4][2];
#pragma unroll
    for (int a = 0; a < 2; ++a)
#pragma unroll
        for (int b = 0; b < 2; ++b)
#pragma unroll
            for (int m = 0; m < 4; ++m)
#pragma unroll
                for (int n = 0; n < 2; ++n) acc[a][b][m][n] = (f32x4){0.f, 0.f, 0.f, 0.f};
    bf16x8 At[4][2], B0[2][2], B1[2][2];
    const char* cA = (const char*)g.A + (size_t)cur.pm * tstepA; const char* cB = (const char*)g.Bt + (size_t)cur.pn * tstepB;
    S.a_ready(cur);
    if constexpr (SP2) {
        PG8_STAGE(PG8_SB(0, 0), cB, voffB); PG8_STAGE(PG8_SB(0, 1), cB + hstepB, voffB); PG8_STAGE(PG8_SA(0, 0), cA, voffA); PG8_STAGE(PG8_SA(0, 1), cA + hstepA, voffA);
        if (wr == 1) PG8_BAR;
        PG8_WAIT_V(2); PG8_BAR;
        PG8_STAGE(PG8_SB(1, 0), cB + kstep, voffB); PG8_STAGE(PG8_SA(1, 0), cA + kstep, voffA); PG8_STAGE(PG8_SB(1, 1), cB + hstepB + kstep, voffB);
        PG8_WAIT_V(6); PG8_BAR;
    } else {
        PG8_STAGE(PG8_SB(0, 0), cB, voffB); PG8_STAGE(PG8_SA(0, 0), cA, voffA); PG8_STAGE(PG8_SB(0, 1), cB + hstepB, voffB); PG8_STAGE(PG8_SA(0, 1), cA + hstepA, voffA);
        if (wr == 1) PG8_BAR;
        PG8_WAIT_V(4); PG8_BAR;
        PG8_STAGE(PG8_SB(1, 0), cB + kstep, voffB); PG8_STAGE(PG8_SA(1, 0), cA + kstep, voffA); PG8_STAGE(PG8_SB(1, 1), cB + hstepB + kstep, voffB);
        PG8_WAIT_V(6); PG8_BAR;
    }
    for (;;) {
        const bool has_next = S.next(ui + 1, nxt);
        const char* nA = has_next ? (const char*)g.A + (size_t)nxt.pm * tstepA : cA; const char* nB = has_next ? (const char*)g.Bt + (size_t)nxt.pn * tstepB : cB;
        for (int t = 0; t < nt; t += 2) {
            const bool last = (t == nt - 2);
            const char* a1 = cA + (size_t)(t + 1) * kstep;
            const char* a2 = last ? nA : cA + (size_t)(t + 2) * kstep; const char* b2 = last ? nB : cB + (size_t)(t + 2) * kstep;
            const char* a3 = a2 + kstep; const char* b3 = b2 + kstep;
            if (last && has_next) S.a_ready(nxt);
            if constexpr (SP2) {
            PG8_LDB(B0, 0, 0); PG8_LDB(B1, 0, 1); PG8_SCHED; PG8_LDA(At, 0, 0); PG8_STAGE(PG8_SA(1, 1), a1 + hstepA, voffA);
            PG8_WAIT_V(8); PG8_WAIT_L(0); PG8_BAR; PG8_MMA(0, 0, At, B0); PG8_MMA(0, 1, At, B1); PG8_BAR; PG8_SCHED;
            PG8_LDA(At, 0, 1); PG8_STAGE(PG8_SB(0, 0), b2, voffB); PG8_STAGE(PG8_SB(0, 1), b2 + hstepB, voffB); PG8_STAGE(PG8_SA(0, 0), a2, voffA);
            PG8_WAIT_V(8); PG8_WAIT_L(0); PG8_BAR; PG8_MMA(1, 0, At, B0); PG8_MMA(1, 1, At, B1); PG8_BAR; PG8_SCHED;
            PG8_LDB(B0, 1, 0); PG8_LDB(B1, 1, 1); PG8_SCHED; PG8_LDA(At, 1, 0); PG8_STAGE(PG8_SA(0, 1), a2 + hstepA, voffA);
            PG8_WAIT_V(8); PG8_WAIT_L(0); PG8_BAR; PG8_MMA(0, 0, At, B0); PG8_MMA(0, 1, At, B1); PG8_BAR; PG8_SCHED;
            PG8_LDA(At, 1, 1); PG8_STAGE(PG8_SB(1, 0), b3, voffB); PG8_STAGE(PG8_SB(1, 1), b3 + hstepB, voffB); PG8_STAGE(PG8_SA(1, 0), a3, voffA);
            PG8_WAIT_V(8); PG8_WAIT_L(0); PG8_BAR; PG8_MMA(1, 0, At, B0); PG8_MMA(1, 1, At, B1); PG8_BAR; PG8_SCHED;
            } else {
            PG8_LDB(B0, 0, 0); PG8_SCHED; PG8_LDA(At, 0, 0); PG8_STAGE(PG8_SA(1, 1), a1 + hstepA, voffA);
            PG8_WAIT_L(8); PG8_BAR; PG8_WAIT_L(0); PG8_MMA(0, 0, At, B0); PG8_BAR; PG8_SCHED;
            PG8_LDB(B1, 0, 1); PG8_STAGE(PG8_SB(0, 0), b2, voffB);
            PG8_BAR; PG8_WAIT_L(0); PG8_MMA(0, 1, At, B1); PG8_BAR;
            PG8_LDA(At, 0, 1); PG8_STAGE(PG8_SA(0, 0), a2, voffA);
            PG8_BAR; PG8_WAIT_L(0); PG8_MMA(1, 0, At, B0); PG8_BAR; PG8_SCHED;
            PG8_STAGE(PG8_SB(0, 1), b2 + hstepB, voffB);
            PG8_WAIT_V(6); PG8_BAR; PG8_MMA(1, 1, At, B1); PG8_BAR;
            PG8_LDB(B0, 1, 0); PG8_SCHED; PG8_LDA(At, 1, 0); PG8_STAGE(PG8_SA(0, 1), a2 + hstepA, voffA);
            PG8_WAIT_L(8); PG8_BAR; PG8_WAIT_L(0); PG8_MMA(0, 0, At, B0); PG8_BAR; PG8_SCHED;
            PG8_LDB(B1, 1, 1); PG8_STAGE(PG8_SB(1, 0), b3, voffB);
            PG8_BAR; PG8_WAIT_L(0); PG8_MMA(0, 1, At, B1); PG8_BAR;
            PG8_LDA(At, 1, 1); PG8_STAGE(PG8_SA(1, 0), a3, voffA);
            PG8_BAR; PG8_WAIT_L(0); PG8_MMA(1, 0, At, B0); PG8_BAR; PG8_SCHED;
            PG8_STAGE(PG8_SB(1, 1), b3 + hstepB, voffB);
            PG8_WAIT_V(6); PG8_BAR; PG8_MMA(1, 1, At, B1); PG8_BAR;
            }
        }
        if constexpr (ALIGN_EPI) { if (wr == 0) PG8_BAR; }
        if constexpr (!Epi::AFTER_DRAIN) { E(acc, cur, wr, wc, fr, fq); S.done(cur); }
        if (!has_next) break;
#pragma unroll
        for (int a = 0; a < 2; ++a)
#pragma unroll
            for (int b = 0; b < 2; ++b)
#pragma unroll
                for (int m = 0; m < 4; ++m)
#pragma unroll
                    for (int n = 0; n < 2; ++n) acc[a][b][m][n] = (f32x4){0.f, 0.f, 0.f, 0.f};
        cur = nxt; cA = nA; cB = nB; ++ui;
        if constexpr (ALIGN_EPI) { if (wr == 1) PG8_BAR; }
    }
    PG8_WAIT_V(0);
    if constexpr (!ALIGN_EPI) { if (wr == 0) PG8_BAR; }
    PG8_BAR;
    if constexpr (Epi::AFTER_DRAIN) { E.fused(acc, cur, wr, wc, fr, fq, lds, wid, lane); S.done(cur); }
#undef PG8_SA
#undef PG8_SB
#undef PG8_STAGE
#undef PG8_LDA
#undef PG8_LDB
#undef PG8_MMA
#undef PG8_WAIT_V
#undef PG8_WAIT_L
#undef PG8_BAR
#undef PG8_SCHED
}
}
namespace pg8 {
struct EpiBf {
    static constexpr bool PERM = true, AFTER_DRAIN = false;
    bf16_t* O; int ldc; int gelu_tiles;
    __device__ __forceinline__ void operator()(const f32x4 (&acc)[2][2][4][2], const Unit& u, int wr, int wc, int fr, int fq) const {
        const int row0 = u.pm * BM + wr * 64 + fr; const int col0 = u.pn * BM + wc * 32 + 8 * fq;
        const bool act = u.pn < gelu_tiles;
#pragma unroll
        for (int ai = 0; ai < 2; ++ai)
#pragma unroll
            for (int m = 0; m < 4; ++m) { bf16_t* rowp = O + (size_t)(row0 + ai * HALF + m * 16) * ldc + col0;
#pragma unroll
                for (int bj = 0; bj < 2; ++bj) { f32x4 v0 = acc[ai][bj][m][0], v1 = acc[ai][bj][m][1];
                    if (act) { f32x2 a = gelu_pk((f32x2){v0[0], v0[1]}), b = gelu_pk((f32x2){v0[2], v0[3]}), c = gelu_pk((f32x2){v1[0], v1[1]}), d = gelu_pk((f32x2){v1[2], v1[3]});
                        v0 = (f32x4){a.x, a.y, b.x, b.y}; v1 = (f32x4){c.x, c.y, d.x, d.y}; }
                    u32x4 w; w.x = cvt_pk_bf16(v0[0], v0[1]); w.y = cvt_pk_bf16(v0[2], v0[3]); w.z = cvt_pk_bf16(v1[0], v1[1]); w.w = cvt_pk_bf16(v1[2], v1[3]);
                    *(u32x4*)(rowp + bj * HALF) = w; } }
    }
};
struct EpiResid {
    static constexpr bool PERM = true, AFTER_DRAIN = false;
    const float* xa; const float* xb; float* out; const float* gate;
    __device__ __forceinline__ void operator()(const f32x4 (&acc)[2][2][4][2], const Unit& u, int wr, int wc, int fr, int fq) const {
        const int row0 = u.pm * BM + wr * 64 + fr; const int col0 = u.pn * BM + wc * 32 + 8 * fq;
        const int b = row_batch(u.pm * BM); const float* xin = (u.pm * BM < NPR) ? xa : xb;
        f32x4 gv[2][2];
#pragma unroll
        for (int bj = 0; bj < 2; ++bj)
#pragma unroll
            for (int n = 0; n < 2; ++n) gv[bj][n] = *(const f32x4*)(gate + (size_t)b * MODW + col0 + bj * HALF + 4 * n);
#pragma unroll
        for (int ai = 0; ai < 2; ++ai)
#pragma unroll
            for (int m = 0; m < 4; ++m) { const size_t off = (size_t)(row0 + ai * HALF + m * 16) * DM + col0;
#pragma unroll
                for (int bj = 0; bj < 2; ++bj)
#pragma unroll
                    for (int n = 0; n < 2; ++n) { const f32x4 xv = *(const f32x4*)(xin + off + bj * HALF + 4 * n);
                        *(f32x4*)(out + off + bj * HALF + 4 * n) = xv + gv[bj][n] * acc[ai][bj][m][n]; } }
    }
};
}
namespace att {
using bf16x8 = __attribute__((ext_vector_type(8))) short;
using s16x4  = __attribute__((ext_vector_type(4))) short;
using f32x16 = __attribute__((ext_vector_type(16))) float;
using u32x4  = __attribute__((ext_vector_type(4))) unsigned;
constexpr int NW = 8, QBLK = 32, KVBLK = 64, DV = 128;
constexpr float THR = 8.f;
#define ATT_SBAR() __builtin_amdgcn_sched_barrier(0)
__device__ __forceinline__ int crow(int r, int hi) { return (r & 3) + 8 * (r >> 2) + 4 * hi; }
__device__ __forceinline__ unsigned cvtpk(float lo, float hi) { unsigned r; asm volatile("v_cvt_pk_bf16_f32 %0, %1, %2" : "=v"(r) : "v"(lo), "v"(hi)); return r; }
template <int DK> __device__ __forceinline__ int kswz(int row, int colB) { return row * (2 * DK + 16) + colB; }

template <int DK> __device__ __forceinline__ void partialSM(f32x16& p0, f32x16& p1, float& m_reg, float& mn, float& alpha) {
  constexpr float SCALE = (DK == 128) ? 0.08838834764831845f : 0.07216878364870323f;
  constexpr float C = SCALE * 1.4426950408889634f;
  float pmax = p0[0];
#pragma unroll
  for (int r = 1; r < 16; ++r) pmax = fmaxf(pmax, p0[r]);
#pragma unroll
  for (int r = 0; r < 16; ++r) pmax = fmaxf(pmax, p1[r]);
  { auto rr = __builtin_amdgcn_permlane32_swap(__float_as_uint(pmax), __float_as_uint(pmax), false, false);
    pmax = fmaxf(__uint_as_float(rr[0]), __uint_as_float(rr[1])); }
  if (__builtin_expect(__all(pmax - m_reg <= THR / SCALE), 1)) { mn = m_reg; alpha = 1.f; }
  else { mn = fmaxf(m_reg, pmax); alpha = __builtin_amdgcn_exp2f((m_reg - mn) * C); m_reg = mn; }
  float mnC = -mn * C;
#pragma unroll
  for (int r = 0; r < 16; ++r) p0[r] = fmaf(p0[r], C, mnC);
#pragma unroll
  for (int r = 0; r < 16; ++r) p1[r] = fmaf(p1[r], C, mnC);
#pragma unroll
  for (int r = 0; r < 16; ++r) p0[r] = __builtin_amdgcn_exp2f(p0[r]);
}
__device__ __forceinline__ void finishSM(f32x16& p0, f32x16& p1, float alpha, float& l_reg, bf16x8& pa0, bf16x8& pa1, bf16x8& pa2, bf16x8& pa3) {
#pragma unroll
  for (int r = 0; r < 16; ++r) p1[r] = __builtin_amdgcn_exp2f(p1[r]);
  float ps = 0;
#pragma unroll
  for (int r = 0; r < 16; ++r) ps += p0[r];
#pragma unroll
  for (int r = 0; r < 16; ++r) ps += p1[r];
  { auto rr = __builtin_amdgcn_permlane32_swap(__float_as_uint(ps), __float_as_uint(ps), false, false);
    ps = __uint_as_float(rr[0]) + __uint_as_float(rr[1]); }
  l_reg = l_reg * alpha + ps;
#define ATT_PK4(P, BASE, OUT) do { unsigned a0 = cvtpk(P[BASE + 0], P[BASE + 1]), a1 = cvtpk(P[BASE + 2], P[BASE + 3]);   \
    unsigned b0 = cvtpk(P[BASE + 4], P[BASE + 5]), b1 = cvtpk(P[BASE + 6], P[BASE + 7]);                              \
    auto r0 = __builtin_amdgcn_permlane32_swap(a0, b0, false, false); auto r1 = __builtin_amdgcn_permlane32_swap(a1, b1, false, false); \
    u32x4 w = {r0[0], r1[0], r0[1], r1[1]}; OUT = *reinterpret_cast<bf16x8*>(&w); } while (0)
  ATT_PK4(p0, 0, pa0); ATT_PK4(p0, 8, pa1); ATT_PK4(p1, 0, pa2); ATT_PK4(p1, 8, pa3);
#undef ATT_PK4
}
template <int DK> __device__ __forceinline__ void qkt(f32x16& p0, f32x16& p1, const char* Ks, const bf16x8* qr, const char* ldsb, int qxo, int r32, int hi) {
  p0 = f32x16{}; p1 = f32x16{};
  if constexpr (DK > 128) asm volatile("" : "+v"(qxo));
  const char* qx = ldsb + qxo;
#pragma unroll
  for (int d0 = 0; d0 < DK / 16; ++d0) { int cb = (d0 * 16 + hi * 8) * 2;
    bf16x8 b0 = *reinterpret_cast<const bf16x8*>(Ks + kswz<DK>(r32, cb));
    bf16x8 b1 = *reinterpret_cast<const bf16x8*>(Ks + kswz<DK>(32 + r32, cb));
    bf16x8 qf; if (d0 < 8) qf = qr[d0]; else qf = *reinterpret_cast<const bf16x8*>(qx + (d0 - 8) * 1024);
    p0 = __builtin_amdgcn_mfma_f32_32x32x16_bf16(b0, qf, p0, 0, 0, 0);
    p1 = __builtin_amdgcn_mfma_f32_32x32x16_bf16(b1, qf, p1, 0, 0, 0);
    if ((d0 & 3) == 3) ATT_SBAR(); }
}
__device__ __forceinline__ int v_st(int k, int c) { const int kk = (k & ~0xC) | ((k & 4) << 1) | ((k & 8) >> 1); return ((kk >> 3) * 4 + (c >> 5)) * 512 + ((kk & 7) * 32 + (c & 31)) * 2; }
__device__ __forceinline__ int v_rd_base(int lane) { return ((lane & 3) << 3) | (((lane >> 2) & 3) << 6) | (((lane >> 4) & 1) << 5) | (((lane >> 5) & 1) << 8); }
constexpr int v_rd_off(int d0, int ks, int half) { return d0 * 512 + ks * 4096 + half * 2048; }
template <int OFF> __device__ __forceinline__ s16x4 tr_read(int vb) {
  s16x4 r; asm volatile("ds_read_b64_tr_b16 %0, %1 offset:%2" : "=&v"(r) : "v"(vb), "i"(OFF) : "memory"); return r;
}
template <int D0> __device__ __forceinline__ void pv_one(f32x16& od, int vb, bf16x8 pa0, bf16x8 pa1, bf16x8 pa2, bf16x8 pa3) {
  const s16x4 l0 = tr_read<v_rd_off(D0, 0, 0)>(vb), h0 = tr_read<v_rd_off(D0, 0, 1)>(vb), l1 = tr_read<v_rd_off(D0, 1, 0)>(vb), h1 = tr_read<v_rd_off(D0, 1, 1)>(vb);
  const s16x4 l2 = tr_read<v_rd_off(D0, 2, 0)>(vb), h2 = tr_read<v_rd_off(D0, 2, 1)>(vb), l3 = tr_read<v_rd_off(D0, 3, 0)>(vb), h3 = tr_read<v_rd_off(D0, 3, 1)>(vb);
  asm volatile("s_waitcnt lgkmcnt(0)" ::: "memory"); ATT_SBAR();
#define ATT_PK(L, H) (bf16x8){L[0], L[1], L[2], L[3], H[0], H[1], H[2], H[3]}
  od = __builtin_amdgcn_mfma_f32_32x32x16_bf16(pa0, ATT_PK(l0, h0), od, 0, 0, 0);
  od = __builtin_amdgcn_mfma_f32_32x32x16_bf16(pa1, ATT_PK(l1, h1), od, 0, 0, 0);
  od = __builtin_amdgcn_mfma_f32_32x32x16_bf16(pa2, ATT_PK(l2, h2), od, 0, 0, 0);
  od = __builtin_amdgcn_mfma_f32_32x32x16_bf16(pa3, ATT_PK(l3, h3), od, 0, 0, 0);
#undef ATT_PK
}
__device__ __forceinline__ void pv_d0(f32x16* o, int vb, bf16x8 pa0, bf16x8 pa1, bf16x8 pa2, bf16x8 pa3) {
  pv_one<0>(o[0], vb, pa0, pa1, pa2, pa3); pv_one<1>(o[1], vb, pa0, pa1, pa2, pa3); pv_one<2>(o[2], vb, pa0, pa1, pa2, pa3); pv_one<3>(o[3], vb, pa0, pa1, pa2, pa3);
}
template <int DK> struct Cfg { static constexpr int SHM_V = KVBLK * DV * 2, SHM_K = KVBLK * (DK * 2 + 16), SHM_Q = (DK > 128) ? NW * 4096 : 0, SHM = 2 * SHM_V + 2 * SHM_K + NW * 64 * 4 + SHM_Q; };

template <int DK, int SDEPTH, int ldq, int ldk, int ldv, int ldo>
__device__ __forceinline__ void attn_body(const unsigned short* __restrict__ Qb, const unsigned short* __restrict__ Kh,
                                          const unsigned short* __restrict__ Vh, unsigned short* __restrict__ Ob, int seq, char* lds) {
  constexpr int SHM_V = Cfg<DK>::SHM_V, SHM_K = Cfg<DK>::SHM_K, NQ = (DK > 128 ? 8 : DK / 16), NKI = DK / 64;
  const int tid = tid_fresh(), wid = tid >> 6, lane = tid & 63, r32 = lane & 31, hi = lane >> 5;
  char* V_lds = lds; char* K_lds = lds + 2 * SHM_V;
  float* ws = (float*)(lds + 2 * SHM_V + 2 * SHM_K) + wid * 64; float* li_l = ws; float* al_l = ws + 32;
  float m_reg = -1e30f, l_reg = 0; f32x16 o[4] = {}; bf16x8 qr[NQ];
  const unsigned short* Qw = Qb + (wid * QBLK + r32) * ldq + hi * 8;
#pragma unroll
  for (int d0 = 0; d0 < NQ; ++d0) qr[d0] = *reinterpret_cast<const bf16x8*>(Qw + d0 * 16);
  const int qxo = 2 * SHM_V + 2 * SHM_K + NW * 64 * 4 + wid * 4096 + lane * 16; char* qx = lds + qxo;
  if constexpr (DK > 128) {
#pragma unroll
    for (int d0 = 8; d0 < DK / 16; ++d0) *reinterpret_cast<bf16x8*>(qx + (d0 - 8) * 1024) = *reinterpret_cast<const bf16x8*>(Qw + d0 * 16);
  }
  const int sr = tid >> 4, sc = (tid & 15) * 8, vst0 = v_st(sr, sc);
  const int vgo = sr * ldv + sc;
  const int kr = tid >> 3, kc8 = tid & 7, kgo = kr * ldk + kc8 * 8, kdst = kswz<DK>(kr, kc8 * 16);
  const int vb0 = (int)(uintptr_t)V_lds + v_rd_base(lane);
  struct { bf16x8 vs0, vs1, ks[NKI]; } sr_[SDEPTH];
#define ATT_SLOAD(i, k0) do { const unsigned short* vt_ = Vh + (size_t)(k0) * ldv; const unsigned short* kt_ = Kh + (size_t)(k0) * ldk; \
    sr_[i].vs0 = *reinterpret_cast<const bf16x8*>(vt_ + vgo); sr_[i].vs1 = *reinterpret_cast<const bf16x8*>(vt_ + vgo + 32 * ldv); \
    _Pragma("unroll") for (int q_ = 0; q_ < NKI; ++q_) sr_[i].ks[q_] = *reinterpret_cast<const bf16x8*>(kt_ + kgo + 64 * q_); } while (0)
#define ATT_SWRITE(b, i) do { *(bf16x8*)(V_lds + (b) * SHM_V + vst0) = sr_[i].vs0; *(bf16x8*)(V_lds + (b) * SHM_V + vst0 + 8192) = sr_[i].vs1; \
    _Pragma("unroll") for (int q_ = 0; q_ < NKI; ++q_) *(bf16x8*)(K_lds + (b) * SHM_K + kdst + 128 * q_) = sr_[i].ks[q_]; } while (0)
#define ATT_SWAIT() do { if constexpr (SDEPTH == 2) { if constexpr (NKI == 2) asm volatile("s_waitcnt vmcnt(4)" ::: "memory"); else asm volatile("s_waitcnt vmcnt(5)" ::: "memory"); } else asm volatile("s_waitcnt vmcnt(0)" ::: "memory"); } while (0)
#define ATT_RESC(a) do { if (__any((a) < 1.f)) { if (hi == 0) al_l[r32] = (a); asm volatile("s_waitcnt lgkmcnt(0)" ::: "memory"); \
    _Pragma("unroll") for (int d = 0; d < 4; ++d) _Pragma("unroll") for (int r = 0; r < 16; ++r) o[d][r] *= al_l[crow(r, hi)]; } } while (0)
  f32x16 pA0, pA1, pB0, pB1; float mnA, mnB, alA, alB; bf16x8 pa0, pa1, pa2, pa3; const int NT = seq / KVBLK;
  constexpr int SE = 0, SO = SDEPTH - 1;
  ATT_SLOAD(SE, 0); asm volatile("s_waitcnt vmcnt(0)" ::: "memory"); ATT_SWRITE(0, SE); __syncthreads();
  qkt<DK>(pA0, pA1, K_lds, qr, lds, qxo, r32, hi); partialSM<DK>(pA0, pA1, m_reg, mnA, alA);
  ATT_SLOAD(SO, KVBLK); if constexpr (SDEPTH == 2) { if (2 < NT) ATT_SLOAD(SE, 2 * KVBLK); }
  ATT_SWAIT(); ATT_SWRITE(1, SO); __syncthreads();
  for (int j = 1; j + 1 < NT; j += 2) {
    ATT_SBAR(); qkt<DK>(pB0, pB1, K_lds + SHM_K, qr, lds, qxo, r32, hi);
    finishSM(pA0, pA1, alA, l_reg, pa0, pa1, pa2, pa3); ATT_SBAR();
    ATT_SLOAD(SO, (j + SDEPTH) * KVBLK); ATT_SBAR();
    pv_d0(o, vb0, pa0, pa1, pa2, pa3); partialSM<DK>(pB0, pB1, m_reg, mnB, alB);
    __syncthreads(); ATT_SWAIT(); ATT_SWRITE(0, SE);
    ATT_RESC(alB); __syncthreads();
    ATT_SBAR(); qkt<DK>(pA0, pA1, K_lds, qr, lds, qxo, r32, hi);
    finishSM(pB0, pB1, alB, l_reg, pa0, pa1, pa2, pa3); ATT_SBAR();
    if (SDEPTH == 1 || j + 3 < NT) ATT_SLOAD(SE, (j + 1 + SDEPTH) * KVBLK); ATT_SBAR();
    pv_d0(o, vb0 + SHM_V, pa0, pa1, pa2, pa3); partialSM<DK>(pA0, pA1, m_reg, mnA, alA);
    __syncthreads(); ATT_SWAIT(); ATT_SWRITE(1, SO);
    ATT_RESC(alA); __syncthreads();
  }
  ATT_SBAR(); qkt<DK>(pB0, pB1, K_lds + SHM_K, qr, lds, qxo, r32, hi);
  finishSM(pA0, pA1, alA, l_reg, pa0, pa1, pa2, pa3); ATT_SBAR();
  pv_d0(o, vb0, pa0, pa1, pa2, pa3); partialSM<DK>(pB0, pB1, m_reg, mnB, alB);
  __syncthreads(); ATT_RESC(alB);
  finishSM(pB0, pB1, alB, l_reg, pa0, pa1, pa2, pa3); ATT_SBAR();
  pv_d0(o, vb0 + SHM_V, pa0, pa1, pa2, pa3);
  if (hi == 0) li_l[r32] = l_reg; asm volatile("s_waitcnt lgkmcnt(0)" ::: "memory");
  float rli[16];
#pragma unroll
  for (int r = 0; r < 16; ++r) rli[r] = __builtin_amdgcn_rcpf(li_l[crow(r, hi)]);
  unsigned short* Ow = Ob + (wid * QBLK) * ldo;
#pragma unroll
  for (int r = 0; r < 16; ++r) { int orow = crow(r, hi);
#pragma unroll
    for (int d0 = 0; d0 < 4; ++d0) Ow[orow * ldo + d0 * 32 + r32] = (unsigned short)f2bf(o[d0][r] * rli[r]); }
  __syncthreads();
#undef ATT_SLOAD
#undef ATT_SWRITE
#undef ATT_SWAIT
#undef ATT_RESC
}

template <int DK, int ldq, int ldk, int ldv, int ldo>
__device__ __forceinline__ void attn_body_seq(const unsigned short* __restrict__ Qb, const unsigned short* __restrict__ Kh,
                                              const unsigned short* __restrict__ Vh, unsigned short* __restrict__ Ob, int seq, char* lds) {
  constexpr int SHM_V = Cfg<DK>::SHM_V, SHM_K = Cfg<DK>::SHM_K, NQ = (DK > 128 ? 8 : DK / 16), NKI = DK / 64;
  const int tid = tid_fresh(), wid = tid >> 6, lane = tid & 63, r32 = lane & 31, hi = lane >> 5;
  char* V_lds = lds; char* K_lds = lds + 2 * SHM_V;
  float* ws = (float*)(lds + 2 * SHM_V + 2 * SHM_K) + wid * 64; float* li_l = ws; float* al_l = ws + 32;
  float m_reg = -1e30f, l_reg = 0; f32x16 o[4] = {}; bf16x8 qr[NQ];
  const unsigned short* Qw = Qb + (wid * QBLK + r32) * ldq + hi * 8;
#pragma unroll
  for (int d0 = 0; d0 < NQ; ++d0) qr[d0] = *reinterpret_cast<const bf16x8*>(Qw + d0 * 16);
  const int qxo = 2 * SHM_V + 2 * SHM_K + NW * 64 * 4 + wid * 4096 + lane * 16; char* qx = lds + qxo;
  if constexpr (DK > 128) {
#pragma unroll
    for (int d0 = 8; d0 < DK / 16; ++d0) *reinterpret_cast<bf16x8*>(qx + (d0 - 8) * 1024) = *reinterpret_cast<const bf16x8*>(Qw + d0 * 16);
  }
  const int sr = tid >> 4, sc = (tid & 15) * 8, vst0 = v_st(sr, sc);
  const int vgo = sr * ldv + sc;
  const int kr = tid >> 3, kc8 = tid & 7, kgo = kr * ldk + kc8 * 8, kdst = kswz<DK>(kr, kc8 * 16);
  const int vb0 = (int)(uintptr_t)V_lds + v_rd_base(lane);
  bf16x8 vs0, vs1, ks[NKI];
#define ATT_SLOAD1(k0) do { const unsigned short* vt_ = Vh + (size_t)(k0) * ldv; const unsigned short* kt_ = Kh + (size_t)(k0) * ldk; \
    vs0 = *reinterpret_cast<const bf16x8*>(vt_ + vgo); vs1 = *reinterpret_cast<const bf16x8*>(vt_ + vgo + 32 * ldv); \
    _Pragma("unroll") for (int q_ = 0; q_ < NKI; ++q_) ks[q_] = *reinterpret_cast<const bf16x8*>(kt_ + kgo + 64 * q_); } while (0)
#define ATT_SWRITE1(b) do { *(bf16x8*)(V_lds + (b) * SHM_V + vst0) = vs0; *(bf16x8*)(V_lds + (b) * SHM_V + vst0 + 8192) = vs1; \
    _Pragma("unroll") for (int q_ = 0; q_ < NKI; ++q_) *(bf16x8*)(K_lds + (b) * SHM_K + kdst + 128 * q_) = ks[q_]; } while (0)
  const int NT = seq / KVBLK;
  ATT_SLOAD1(0); ATT_SWRITE1(0); __syncthreads();
#pragma unroll 1
  for (int j = 0; j < NT; ++j) {
    const int b = j & 1;
    f32x16 p0, p1; float mn, al; bf16x8 pa0, pa1, pa2, pa3;
    if (j + 1 < NT) ATT_SLOAD1((j + 1) * KVBLK);
    ATT_SBAR();
    qkt<DK>(p0, p1, K_lds + b * SHM_K, qr, lds, qxo, r32, hi);
    partialSM<DK>(p0, p1, m_reg, mn, al);
    if (__any(al < 1.f)) { if (hi == 0) al_l[r32] = al; asm volatile("s_waitcnt lgkmcnt(0)" ::: "memory");
#pragma unroll
      for (int d = 0; d < 4; ++d)
#pragma unroll
        for (int r = 0; r < 16; ++r) o[d][r] *= al_l[crow(r, hi)]; }
    finishSM(p0, p1, al, l_reg, pa0, pa1, pa2, pa3); ATT_SBAR();
    pv_d0(o, vb0 + b * SHM_V, pa0, pa1, pa2, pa3);
    if (j + 1 < NT) ATT_SWRITE1(b ^ 1);
    __syncthreads();
  }
  if (hi == 0) li_l[r32] = l_reg; asm volatile("s_waitcnt lgkmcnt(0)" ::: "memory");
  float rli[16];
#pragma unroll
  for (int r = 0; r < 16; ++r) rli[r] = __builtin_amdgcn_rcpf(li_l[crow(r, hi)]);
  unsigned short* Ow = Ob + (wid * QBLK) * ldo;
#pragma unroll
  for (int r = 0; r < 16; ++r) { int orow = crow(r, hi);
#pragma unroll
    for (int d0 = 0; d0 < 4; ++d0) Ow[orow * ldo + d0 * 32 + r32] = (unsigned short)f2bf(o[d0][r] * rli[r]); }
  __syncthreads();
#undef ATT_SLOAD1
#undef ATT_SWRITE1
}
#undef ATT_SBAR
}
namespace hy {
using bf16x8 = __attribute__((ext_vector_type(8))) short;
using f32x16 = __attribute__((ext_vector_type(16))) float;
using u32x4  = __attribute__((ext_vector_type(4))) unsigned;
using u32x2  = __attribute__((ext_vector_type(2))) unsigned;
template <int L> struct HC {
    static constexpr int NMB = L / 2048, NCH = (L == 4096) ? 2 : 4, UST = L + 160, GRN = 2 * L / 64 * 72;
    static constexpr int UB = 4 * UST * 2, GB = GRN * 2, CHB = UB + GB, NK4 = L / 64 + 1;
    static_assert(NCH * CHB <= RING_BYTES, "hyena LDS");
};
__device__ __forceinline__ int crow(int r, int hi) { return (r & 3) + 8 * (r >> 2) + 4 * hi; }
__device__ __forceinline__ float bf2f(unsigned short v) { return __uint_as_float((unsigned)v << 16); }

template <int L, int RH>
__device__ __forceinline__ void conv_kloop(f32x16 (&acc)[4], const LAS char* gA, const LAS char* uB) {
    constexpr int NK4 = HC<L>::NK4;
#pragma unroll
    for (int i = 0; i < 4; ++i) acc[i] = f32x16{};
    for (int kk4 = 0; kk4 < NK4; ++kk4) {
#pragma unroll
        for (int ks = 0; ks < 4; ++ks) {
            const bf16x8 A = *(const LAS bf16x8*)(gA + kk4 * 144 + ks * 32);
            const u32x4 w0 = *(const LAS u32x4*)(uB + kk4 * 128 + ks * 32);
            const u32x4 w1 = *(const LAS u32x4*)(uB + kk4 * 128 + ks * 32 + 16);
            const unsigned w[8] = {w0.x, w0.y, w0.z, w0.w, w1.x, w1.y, w1.z, w1.w};
#pragma unroll
            for (int ri = 0; ri < 4; ++ri) {
                constexpr int dummy = 0; (void)dummy;
                const int r = 4 * RH + ri; u32x4 bf;
                if ((r & 1) == 0) { const int q = r >> 1; bf = (u32x4){w[q], w[q + 1], w[q + 2], w[q + 3]}; }
                else { const int q = (r - 1) >> 1;
                    bf = (u32x4){__builtin_amdgcn_alignbit(w[q + 1], w[q], 16), __builtin_amdgcn_alignbit(w[q + 2], w[q + 1], 16),
                                 __builtin_amdgcn_alignbit(w[q + 3], w[q + 2], 16), __builtin_amdgcn_alignbit(w[q + 4], w[q + 3], 16)}; }
                acc[ri] = __builtin_amdgcn_mfma_f32_32x32x16_bf16(A, __builtin_bit_cast(bf16x8, bf), acc[ri], 0, 0, 0);
            }
        }
    }
}

template <int L>
__device__ __forceinline__ void hyena_unit(LAS char* lds, const unsigned short* GFl, const unsigned short* X1T, const unsigned short* X2T, const unsigned short* VT,
                                           unsigned short* Y2T, const float* skip  , int b0, int c0) {
    using C = HC<L>;
    constexpr int NCH = C::NCH, UST = C::UST, GRN = C::GRN, UB = C::UB, GB = C::GB, CHB = C::CHB;
    const int tid = tid_fresh(), wid = __builtin_amdgcn_readfirstlane(tid >> 6), lane = tid & 63;
    const int ch = (L == 4096) ? (wid >> 2) : (wid >> 1);
    const int mb = (L == 4096) ? ((wid >> 1) & 1) : 0;
    const int rh = wid & 1;
    const int n = lane & 31, hi = lane >> 5, np = n >> 2, bb = n & 3;
    LAS char* Uch = lds + ch * CHB; LAS char* Gch = Uch + UB;
    const LAS char* gA = Gch + 2 * ((L / 64 - 32 * mb - n - 1) * 72 + 8 * hi);
    const LAS char* uB = Uch + 2 * (bb * UST + 8 * hi + 8 * np);
    const int c = c0 + ch;
    unsigned y1p[16][2];
#pragma unroll 1
    for (int o = 0; o < 2; ++o) {
        for (int id = tid; id < NCH * (GB / 16); id += NTHR) { const int cc = id / (GB / 16), off = id % (GB / 16);
            const u32x4 v = *(const u32x4*)((const char*)(GFl + ((size_t)(o * 512 + c0 + cc)) * GRN) + off * 16);
            *(LAS u32x4*)(lds + cc * CHB + UB + off * 16) = v; }
        if (o == 0) {
            for (int id = tid; id < NCH * 4 * (L / 8); id += NTHR) { const int cb = id / (L / 8), off = id % (L / 8), cc = cb >> 2, b = cb & 3;
                const u32x4 v = *(const u32x4*)(VT + xt_off(b0 + b, c0 + cc) + off * 8);
                *(LAS u32x4*)(lds + cc * CHB + (b * UST + 64) * 2 + off * 16) = v; }
            for (int id = tid; id < NCH * 4 * 20; id += NTHR) { const int cb = id / 20, k = id % 20, cc = cb >> 2, b = cb & 3;
                const int el = k < 8 ? k * 8 : (L + 64) + (k - 8) * 8;
                *(LAS u32x4*)(lds + cc * CHB + (b * UST + el) * 2) = (u32x4){0u, 0u, 0u, 0u}; }
        } else {
#pragma unroll
            for (int q = 0; q < 16; ++q) { const int t0 = 2048 * mb + 64 * crow(q, hi) + 8 * np + 4 * rh;
                *(LAS u32x2*)(Uch + (bb * UST + 64 + t0) * 2) = (u32x2){y1p[q][0], y1p[q][1]}; }
        }
        __syncthreads();
        f32x16 acc[4];
        if (rh == 0) conv_kloop<L, 0>(acc, gA, uB); else conv_kloop<L, 1>(acc, gA, uB);
        const float sk = skip[o * 512 + c];
        const unsigned short* XT = (o == 0) ? X1T : X2T;
        const size_t gbase = xt_off(b0 + bb, c);
#pragma unroll
        for (int q = 0; q < 16; ++q) { const int t0 = 2048 * mb + 64 * crow(q, hi) + 8 * np + 4 * rh;
            const u32x2 xv = *(const u32x2*)(XT + gbase + t0);
            const u32x2 uv = *(const LAS u32x2*)(Uch + (bb * UST + 64 + t0) * 2);
            float y[4];
            y[0] = bf2f((unsigned short)(xv.x & 0xffff)) * (acc[0][q] + sk * bf2f((unsigned short)(uv.x & 0xffff)));
            y[1] = bf2f((unsigned short)(xv.x >> 16))    * (acc[1][q] + sk * bf2f((unsigned short)(uv.x >> 16)));
            y[2] = bf2f((unsigned short)(xv.y & 0xffff)) * (acc[2][q] + sk * bf2f((unsigned short)(uv.y & 0xffff)));
            y[3] = bf2f((unsigned short)(xv.y >> 16))    * (acc[3][q] + sk * bf2f((unsigned short)(uv.y >> 16)));
            const unsigned p0 = pk2(y[0], y[1]), p1 = pk2(y[2], y[3]);
            if (o == 0) { y1p[q][0] = p0; y1p[q][1] = p1; }
            else *(u32x2*)(Y2T + gbase + t0) = (u32x2){p0, p1}; }
        __syncthreads();
    }
}
}
typedef unsigned u32x2v __attribute__((ext_vector_type(2)));
__device__ __forceinline__ float bf2f(unsigned short v) { return __uint_as_float((unsigned)v << 16); }
__device__ __forceinline__ float bflo(unsigned w) { return __uint_as_float(w << 16); }
__device__ __forceinline__ float bfhi(unsigned w) { return __uint_as_float(w & 0xffff0000u); }
__device__ __forceinline__ float wave_sum(float v) {
#pragma unroll
    for (int o = 1; o < 64; o <<= 1) v += __shfl_xor(v, o);
    return v;
}
__device__ __forceinline__ void unpack8(const v4u& w, float (&f)[8]) {
    f[0] = bflo(w.x); f[1] = bfhi(w.x); f[2] = bflo(w.y); f[3] = bfhi(w.y); f[4] = bflo(w.z); f[5] = bfhi(w.z); f[6] = bflo(w.w); f[7] = bfhi(w.w);
}
__device__ __forceinline__ v4u pack8(const float (&f)[8]) { v4u w; w.x = pk2(f[0], f[1]); w.y = pk2(f[2], f[3]); w.z = pk2(f[4], f[5]); w.w = pk2(f[6], f[7]); return w; }

__device__ __forceinline__ void norm_rows(const float* xa, const float* xb, const float* g, const float* mod  , int sh_off, int sc_off, bf16* H, int gw, int ngw, int lane) {
    for (int ck = gw; ck < NTOK / 4; ck += ngw) {
        const int row0 = ck * 4, b = row_batch(row0);
        const float* xin = row0 < NPR ? xa : xb;
        const float* sc = mod + (size_t)b * MODW + sc_off; const float* sh = mod + (size_t)b * MODW + sh_off;
        f32x4 ga[8], sb[8];
#pragma unroll
        for (int j = 0; j < 8; ++j) { const int col = 4 * lane + 256 * j; const f32x4 gg = *(const f32x4*)(g + col), s1 = *(const f32x4*)(sc + col);
            ga[j] = gg * (s1 + 1.0f); sb[j] = *(const f32x4*)(sh + col); }
#pragma unroll 1
        for (int r = 0; r < 4; ++r) {
            const float* xr = xin + (size_t)(row0 + r) * DM;
            f32x4 v[8]; float ss = 0.f;
#pragma unroll
            for (int j = 0; j < 8; ++j) { v[j] = *(const f32x4*)(xr + 4 * lane + 256 * j); ss += (v[j].x * v[j].x + v[j].y * v[j].y) + (v[j].z * v[j].z + v[j].w * v[j].w); }
            const float rs = rsqrtf(wave_sum(ss) * (1.0f / DM) + EPS);
            bf16* hr = H + (size_t)(row0 + r) * DM;
#pragma unroll
            for (int j = 0; j < 8; ++j) { const f32x4 o = v[j] * rs * ga[j] + sb[j]; u32x2v w; w.x = pk2(o.x, o.y); w.y = pk2(o.z, o.w);
                *(u32x2v*)(hr + 4 * lane + 256 * j) = w; }
        }
    }
}

__device__ __forceinline__ void post_row(bf16* P, int pos, const float* vng, const float* qng, const float* kng, const float* qag, const float* kvag, int lane) {
    { v4u w = *(const v4u*)(P + 512 + 8 * lane); float f[8]; unpack8(w, f);
      float s = 0.f;
#pragma unroll
      for (int i = 0; i < 8; ++i) s += f[i];
      const float mean = wave_sum(s) * (1.0f / 512.0f); float q = 0.f;
#pragma unroll
      for (int i = 0; i < 8; ++i) { f[i] -= mean; q += f[i] * f[i]; }
      const float rs = rsqrtf(wave_sum(q) * (1.0f / 512.0f) + EPS);
      const f32x4 g0 = *(const f32x4*)(vng + 8 * lane), g1 = *(const f32x4*)(vng + 8 * lane + 4);
      f[0] *= rs * g0.x; f[1] *= rs * g0.y; f[2] *= rs * g0.z; f[3] *= rs * g0.w; f[4] *= rs * g1.x; f[5] *= rs * g1.y; f[6] *= rs * g1.z; f[7] *= rs * g1.w;
      *(v4u*)(P + 512 + 8 * lane) = pack8(f); }
    { v4u w = *(const v4u*)(P + C_D + 8 * lane); float f[8]; unpack8(w, f); float q = 0.f;
#pragma unroll
      for (int i = 0; i < 8; ++i) q += f[i] * f[i];
      const float rs = rsqrtf(wave_sum(q) * (1.0f / 512.0f) + EPS);
#pragma unroll
      for (int i = 0; i < 8; ++i) f[i] *= rs * qag[8 * lane + i];
      *(v4u*)(P + C_D + 8 * lane) = pack8(f); }
    { const int l32 = lane & 31; v4u w = *(const v4u*)(P + C_D + 512 + 8 * l32); float f[8]; unpack8(w, f); float q = 0.f;
#pragma unroll
      for (int i = 0; i < 8; ++i) q += f[i] * f[i];
      const float rs = rsqrtf(wave_sum(q) * (0.5f / 256.0f) + EPS);
#pragma unroll
      for (int i = 0; i < 8; ++i) f[i] *= rs * kvag[8 * l32 + i];
      if (lane < 32) *(v4u*)(P + C_D + 512 + 8 * l32) = pack8(f); }
    { const int head = lane >> 3, sub = lane & 7, sec = sub >> 2, chk = sub & 3; const bool on = head < 6;
      const int hh = on ? head : 0;
      bf16* hp = P + C_C + hh * 128 + 64 * sec + 8 * chk;
      v4u w1 = *(const v4u*)hp, w2 = *(const v4u*)(hp + 32); float a[8], c[8]; unpack8(w1, a); unpack8(w2, c);
      float q = 0.f;
#pragma unroll
      for (int i = 0; i < 8; ++i) q += a[i] * a[i] + c[i] * c[i];
      q += __shfl_xor(q, 1); q += __shfl_xor(q, 2); q += __shfl_xor(q, 4);
      const float rs = rsqrtf(q * (1.0f / 128.0f) + EPS);
      const float* gg = (hh < 4 ? qng : kng) + 64 * sec + 8 * chk;
      const float p = (float)(sec ? (pos & 63) : (pos >> 6));
#pragma unroll
      for (int i = 0; i < 8; ++i) {
          const float x1 = a[i] * rs * gg[i], x2 = c[i] * rs * gg[32 + i];
          const float inv = __expf(-(float)(2 * (8 * chk + i)) * (9.210340371976184f / 64.0f));
          float sn, cs; __sincosf(p * inv, &sn, &cs);
          a[i] = x1 * cs - x2 * sn; c[i] = x2 * cs + x1 * sn; }
      if (on) { *(v4u*)hp = pack8(a); *(v4u*)(hp + 32) = pack8(c); } }
}

__device__ __forceinline__ void mlapost_row(bf16* Qr, const bf16* KVr, const bf16* krope, bf16* Kr, int pos, const float* qng, const float* kng, int lane) {
    const int head = lane >> 4, sub = lane & 15;
    const bool rp = sub < 4; const int sec = (sub >> 1) & 1, chk = sub & 1;
    const int x1o = 128 + 32 * sec + 8 * chk;
    const float p = (float)(sec ? (pos & 63) : (pos >> 6));
#pragma unroll
    for (int which = 0; which < 2; ++which) {
        const bf16* np_src = which == 0 ? (Qr + head * 192 + 8 * sub) : (KVr + head * 256 + 8 * sub);
        const bf16* r_src = which == 0 ? (Qr + head * 192 + x1o) : (krope + 32 * sec + 8 * chk);
        const float* g = which == 0 ? qng : kng;
        bf16* dst = (which == 0 ? Qr : Kr) + head * 192;
        float n[8], a[8], c[8]; { v4u w = *(const v4u*)np_src; unpack8(w, n); }
        float q = 0.f;
#pragma unroll
        for (int i = 0; i < 8; ++i) q += n[i] * n[i];
        if (rp) { v4u w1 = *(const v4u*)r_src, w2 = *(const v4u*)(r_src + 16); unpack8(w1, a); unpack8(w2, c);
#pragma unroll
            for (int i = 0; i < 8; ++i) q += a[i] * a[i] + c[i] * c[i]; }
        else {
#pragma unroll
            for (int i = 0; i < 8; ++i) { a[i] = 0.f; c[i] = 0.f; } }
        q += __shfl_xor(q, 1); q += __shfl_xor(q, 2); q += __shfl_xor(q, 4); q += __shfl_xor(q, 8);
        const float rs = rsqrtf(q * (1.0f / 192.0f) + EPS);
#pragma unroll
        for (int i = 0; i < 8; ++i) n[i] *= rs * g[8 * sub + i];
        *(v4u*)(dst + 8 * sub) = pack8(n);
        if (rp) {
#pragma unroll
            for (int i = 0; i < 8; ++i) {
                const float x1 = a[i] * rs * g[x1o + i], x2 = c[i] * rs * g[x1o + 16 + i];
                const float inv = __expf(-(float)(2 * (8 * chk + i)) * (9.210340371976184f / 32.0f));
                float sn, cs; __sincosf(p * inv, &sn, &cs);
                a[i] = x1 * cs - x2 * sn; c[i] = x2 * cs + x1 * sn; }
            *(v4u*)(dst + x1o) = pack8(a); *(v4u*)(dst + x1o + 16) = pack8(c); }
    }
}

__device__ __forceinline__ void hyconv_tile(LAS unsigned char* lds, const bf16* PROJ, bf16* XT, const float* cw  , const float* cb  , int tile, int tid) {
    const int which = tile % 3, tb = tile / 3, row0 = tb * 64, b = row_batch(row0), pos0 = row_pos(row0), Lb = batch_len(b);
    constexpr int PITCH = 257;
    LAS unsigned* raw = (LAS unsigned*)lds;
    for (int id = tid; id < 66 * 64; id += NTHR) { const int r = id >> 6, k = id & 63; const int p = pos0 - 1 + r;
        v4u w = (v4u){0u, 0u, 0u, 0u};
        if (p >= 0 && p < Lb) w = *(const v4u*)(PROJ + (size_t)(row0 - 1 + r) * INCP + C_B + which * 512 + 8 * k);
        LAS unsigned* d = raw + r * PITCH + 4 * k; d[0] = w.x; d[1] = w.y; d[2] = w.z; d[3] = w.w; }
    __syncthreads();
    { const int c = tid, col = which * 512 + c; const float w0 = cw[col], w1 = cw[1536 + col], w2 = cw[3072 + col], bb = cb[col];
      const LAS unsigned short* rc = (const LAS unsigned short*)raw + c;
      bf16* dst = XT + (size_t)which * ((size_t)NTOK * 512) + xt_off(b, c) + pos0;
      float xm = bf2f(rc[0]), x0 = bf2f(rc[2 * PITCH]);
#pragma unroll 1
      for (int k = 0; k < 8; ++k) { float z[8];
#pragma unroll
          for (int i = 0; i < 8; ++i) { const float xp = bf2f(rc[(8 * k + i + 2) * 2 * PITCH]); z[i] = w0 * xm + w1 * x0 + w2 * xp + bb; xm = x0; x0 = xp; }
          *(v4u*)(dst + 8 * k) = pack8(z); } }
    __syncthreads();
}

__device__ __forceinline__ void gnorm_tile(LAS unsigned char* lds, const bf16* YCAT, const bf16* Y2T, const float* gg  , bf16* YN, int tile, int tid) {
    const int row0 = tile * 32, b = row_batch(row0), pos0 = row_pos(row0), lane = tid & 63, wid = tid >> 6;
    constexpr int PITCH = 17;
    LAS unsigned* yb = (LAS unsigned*)lds;
    for (int id = tid; id < 512 * 4; id += NTHR) { const int c = id >> 2, k = id & 3;
        const v4u w = *(const v4u*)(Y2T + xt_off(b, c) + pos0 + 8 * k);
        LAS unsigned* d = yb + c * PITCH + 4 * k; d[0] = w.x; d[1] = w.y; d[2] = w.z; d[3] = w.w; }
    __syncthreads();
#pragma unroll 1
    for (int r = 0; r < 4; ++r) { const int t = wid * 4 + r, row = row0 + t;
        const bf16* yr = YCAT + (size_t)row * DM; bf16* on = YN + (size_t)row * DM;
#pragma unroll
        for (int grp = 0; grp < 4; ++grp) {
            if (grp == 1) {
                float f[8]; float q = 0.f;
#pragma unroll
                for (int i = 0; i < 8; ++i) { f[i] = bf2f(((const LAS unsigned short*)yb)[(lane + 64 * i) * 2 * PITCH + t]); q += f[i] * f[i]; }
                const float rs = rsqrtf(wave_sum(q) * (1.0f / 512.0f) + EPS);
#pragma unroll
                for (int i = 0; i < 8; ++i) on[512 + lane + 64 * i] = (bf16)f2bf(f[i] * rs * gg[512 + lane + 64 * i]);
            } else {
                v4u w = *(const v4u*)(yr + grp * 512 + 8 * lane); float f[8]; unpack8(w, f); float q = 0.f;
#pragma unroll
                for (int i = 0; i < 8; ++i) q += f[i] * f[i];
                const float rs = rsqrtf(wave_sum(q) * (1.0f / 512.0f) + EPS);
                const f32x4 g0 = *(const f32x4*)(gg + grp * 512 + 8 * lane), g1 = *(const f32x4*)(gg + grp * 512 + 8 * lane + 4);
                f[0] *= rs * g0.x; f[1] *= rs * g0.y; f[2] *= rs * g0.z; f[3] *= rs * g0.w; f[4] *= rs * g1.x; f[5] *= rs * g1.y; f[6] *= rs * g1.z; f[7] *= rs * g1.w;
                *(v4u*)(on + grp * 512 + 8 * lane) = pack8(f);
            }
        }
    }
    __syncthreads();
}

__device__ __forceinline__ void ffn_gate(const bf16* Z, bf16* A, const float* cw  , const float* cb  , int gt, int ngt) {
    constexpr int NCK = DFF / 8;
    for (int it = gt; it < (NTOK / 16) * NCK; it += ngt) {
        const int rb = it / NCK, ck = it % NCK, row0 = rb * 16, j0 = ck * 8;
        const int pos0 = row_pos(row0), Lb = batch_len(row_batch(row0));
        float wg[3][8], wu[3][8], bg[8], bu[8];
#pragma unroll
        for (int k = 0; k < 3; ++k)
#pragma unroll
            for (int i = 0; i < 8; ++i) { wg[k][i] = cw[k * DFF2 + j0 + i]; wu[k][i] = cw[k * DFF2 + DFF + j0 + i]; }
#pragma unroll
        for (int i = 0; i < 8; ++i) { bg[i] = cb[j0 + i]; bu[i] = cb[DFF + j0 + i]; }
        float gm[8], g0[8], um[8], u0[8];
        const bf16* zr = Z + (size_t)row0 * DFF2 + j0;
        if (pos0 > 0) { v4u a = *(const v4u*)(zr - DFF2), c = *(const v4u*)(zr - DFF2 + DFF); unpack8(a, gm); unpack8(c, um); }
        else {
#pragma unroll
            for (int i = 0; i < 8; ++i) { gm[i] = 0.f; um[i] = 0.f; } }
        { v4u a = *(const v4u*)zr, c = *(const v4u*)(zr + DFF); unpack8(a, g0); unpack8(c, u0); }
#pragma unroll 1
        for (int r = 0; r < 16; ++r) {
            float gp[8], up[8];
            if (pos0 + r + 1 < Lb) { v4u a = *(const v4u*)(zr + (size_t)(r + 1) * DFF2), c = *(const v4u*)(zr + (size_t)(r + 1) * DFF2 + DFF); unpack8(a, gp); unpack8(c, up); }
            else {
#pragma unroll
                for (int i = 0; i < 8; ++i) { gp[i] = 0.f; up[i] = 0.f; } }
            float o[8];
#pragma unroll
            for (int i = 0; i < 8; ++i) {
                const float gc = wg[0][i] * gm[i] + wg[1][i] * g0[i] + wg[2][i] * gp[i] + bg[i];
                const float uc = wu[0][i] * um[i] + wu[1][i] * u0[i] + wu[2][i] * up[i] + bu[i];
                o[i] = gc * __builtin_amdgcn_rcpf(1.0f + __expf(-gc)) * uc;
                gm[i] = g0[i]; g0[i] = gp[i]; um[i] = u0[i]; u0[i] = up[i]; }
            *(v4u*)(A + (size_t)(row0 + r) * DFF + j0) = pack8(o);
        }
    }
}
__device__ __forceinline__ void p0_transpose_item(const float* W, int K, int N, bf16* WT, int row_off, LAS float* scr, int item, int lane) {
    const int nblk = N / 32, kb = item / nblk, nb = item % nblk, k0 = 64 * kb, n0 = 32 * nb;
#pragma unroll 8
    for (int i = 0; i < 32; ++i) { const int kk = 2 * i + (lane >> 5); scr[kk * 33 + (lane & 31)] = W[(size_t)(k0 + kk) * N + n0 + (lane & 31)]; }
    LDS_WAIT(); asm volatile("" ::: "memory");
    const int c = lane & 7;
#pragma unroll
    for (int j = 0; j < 4; ++j) { const int n = (lane >> 3) + 8 * j; const LAS float* s = scr + (8 * c) * 33 + n;
        v4u o; o.x = pk2(s[0 * 33], s[1 * 33]); o.y = pk2(s[2 * 33], s[3 * 33]); o.z = pk2(s[4 * 33], s[5 * 33]); o.w = pk2(s[6 * 33], s[7 * 33]);
        *(GAS v4u*)(WT + (size_t)(row_off + n0 + n) * K + k0 + 8 * c) = o; }
    LDS_WAIT(); asm volatile("" ::: "memory");
}
typedef float f32x16_t __attribute__((ext_vector_type(16)));
__device__ __forceinline__ int crow16(int r, int hi) { return (r & 3) + 8 * (r >> 2) + 4 * hi; }
__device__ __forceinline__ void gmlp_unit(LAS unsigned char* lds, const bf16* PROJ, bf16* YCAT, const float* sw  , const float* sb  , int unit, int tid) {
    const int chunk = unit >> 2, h = unit & 3, row0 = chunk * 128, lane = tid & 63, wid = __builtin_amdgcn_readfirstlane(tid >> 6), hi = lane >> 5, l32 = lane & 31;
    constexpr int PIT = 136;
    LAS unsigned short* WS = (LAS unsigned short*)lds; LAS unsigned short* VT = WS + 128 * PIT;
    for (int id = tid; id < 128 * 32; id += NTHR) { const int p = id >> 5, q4 = (id & 31) * 4;
        const f32x4 w = *(const f32x4*)(sw + (size_t)h * 16384 + p * 128 + q4);
        u32x2v o; o.x = pk2(w.x, w.y); o.y = pk2(w.z, w.w); *(LAS u32x2v*)(WS + p * PIT + q4) = o; }
    for (int id = tid; id < 128 * 16; id += NTHR) { const int q = id >> 4, cc = (id & 15) * 8;
        const v4u w = *(const v4u*)(PROJ + (size_t)(row0 + q) * INCP + 512 + h * 128 + cc);
        const unsigned ww[4] = {w.x, w.y, w.z, w.w};
#pragma unroll
        for (int i = 0; i < 4; ++i) { VT[(cc + 2 * i) * PIT + q] = (unsigned short)(ww[i] & 0xffff); VT[(cc + 2 * i + 1) * PIT + q] = (unsigned short)(ww[i] >> 16); } }
    __syncthreads();
    const int pblk = wid >> 1, cb2 = (wid & 1) * 2;
    f32x16_t acc0 = {}, acc1 = {};
#pragma unroll
    for (int k = 0; k < 8; ++k) {
        const bf16x8 A = *(const LAS bf16x8*)(WS + (32 * pblk + l32) * PIT + 16 * k + 8 * hi);
        const bf16x8 B0 = *(const LAS bf16x8*)(VT + (32 * cb2 + l32) * PIT + 16 * k + 8 * hi);
        const bf16x8 B1 = *(const LAS bf16x8*)(VT + (32 * (cb2 + 1) + l32) * PIT + 16 * k + 8 * hi);
        acc0 = __builtin_amdgcn_mfma_f32_32x32x16_bf16(A, B0, acc0, 0, 0, 0);
        acc1 = __builtin_amdgcn_mfma_f32_32x32x16_bf16(A, B1, acc1, 0, 0, 0);
    }
#pragma unroll
    for (int q = 0; q < 16; ++q) { const int p = 32 * pblk + crow16(q, hi), row = row0 + p; const float bs = sb[h * 128 + p];
        const int c0 = h * 128 + 32 * cb2 + l32;
        const float u0 = bf2f(PROJ[(size_t)row * INCP + c0]), u1 = bf2f(PROJ[(size_t)row * INCP + c0 + 32]);
        YCAT[(size_t)row * DM + c0] = (bf16)f2bf(u0 * (acc0[q] + bs)); YCAT[(size_t)row * DM + c0 + 32] = (bf16)f2bf(u1 * (acc1[q] + bs)); }
    __syncthreads();
}

__device__ __forceinline__ void mod_phase(LAS unsigned char* lds, const float* cp, const float* cs, const float* ada_w, const float* ada_b, float* MOD, int vcu, int G, int tid) {
    LAS float* sc = (LAS float*)lds;
    LAS float* red = (LAS float*)(lds + 65536);
    const int lane = tid & 63, wid = tid >> 6;
    for (int i = tid; i < NB * DM; i += NTHR) { const int b = i >> 11, k = i & 2047; const float c = b < 4 ? cp[b * DM + k] : cs[(b - 4) * DM + k]; sc[i] = c / (1.0f + __expf(-c)); }
    __syncthreads();
    for (int item = vcu; item < DEPTH * 96; item += G) {
        const int l = item / 96, cbk = item % 96, col0 = cbk * 128 + 2 * lane;
        const float* W = ada_w + (size_t)l * DM * MODW + col0;
        float acc[8][2];
#pragma unroll
        for (int b = 0; b < 8; ++b) { acc[b][0] = 0.f; acc[b][1] = 0.f; }
        const int kbeg = wid * 256;
#pragma unroll 2
        for (int k = kbeg; k < kbeg + 256; k += 4) {
            typedef float f32x2w __attribute__((ext_vector_type(2)));
            f32x2w w[4];
#pragma unroll
            for (int i = 0; i < 4; ++i) w[i] = *(const f32x2w*)(W + (size_t)(k + i) * MODW);
#pragma unroll
            for (int b = 0; b < 8; ++b) { const f32x4 s = *(const LAS f32x4*)(sc + b * DM + k);
                acc[b][0] += s.x * w[0].x + s.y * w[1].x + s.z * w[2].x + s.w * w[3].x;
                acc[b][1] += s.x * w[0].y + s.y * w[1].y + s.z * w[2].y + s.w * w[3].y; }
        }
#pragma unroll
        for (int b = 0; b < 8; ++b) { red[(wid * 8 + b) * 128 + 2 * lane] = acc[b][0]; red[(wid * 8 + b) * 128 + 2 * lane + 1] = acc[b][1]; }
        __syncthreads();
        { const int b = tid >> 6, pr = tid & 63; float s0 = 0.f, s1 = 0.f;
#pragma unroll
          for (int w = 0; w < 8; ++w) { s0 += red[(w * 8 + b) * 128 + 2 * pr]; s1 += red[(w * 8 + b) * 128 + 2 * pr + 1]; }
          const int col = cbk * 128 + 2 * pr;
          float* o = MOD + ((size_t)l * NB + b) * MODW + col; o[0] = s0 + ada_b[l * MODW + col]; o[1] = s1 + ada_b[l * MODW + col + 1]; }
        __syncthreads();
    }
}

__device__ __forceinline__ void filt_item(LAS unsigned char* lds, int L, int tb, const float* w1, const float* b1, const float* f1, const float* w2, const float* b2, const float* f2,
                                          const float* w3, const float* decay, bf16* GFl, int tid) {
    LAS float* feats = (LAS float*)lds;
    LAS float* h1 = feats + 2176;
    LAS float* h2 = h1 + 65 * 64;
    const int t0 = 64 * tb; const float invL1 = 1.0f / (float)(L - 1);
    const int GRN = 2 * L / 64 * 72;
    for (int id = tid; id < 65 * 33; id += NTHR) { const int i = id / 33, f = id % 33; const float t = (float)(t0 + i); float v;
        if (f == 0) v = t * invL1;
        else { const int kb = (f - 1) & 15; const float band = 1e-4f + (float)kb * ((15.0f - 1e-4f) / 15.0f);
            float x = t * band / (float)L; x -= floorf(x); const float a = 6.283185307179586f * x;
            v = (f <= 16) ? __cosf(a) : -__sinf(a); }
        feats[i * 33 + f] = v; }
    __syncthreads();
    for (int id = tid; id < 65 * 64; id += NTHR) { const int i = id >> 6, j = id & 63; float s = b1[j];
#pragma unroll 11
        for (int f = 0; f < 33; ++f) s += feats[i * 33 + f] * w1[f * 64 + j];
        h1[i * 64 + j] = __sinf(f1[j] * s); }
    __syncthreads();
    for (int id = tid; id < 65 * 64; id += NTHR) { const int i = id >> 6, j = id & 63; float s = b2[j];
#pragma unroll 16
        for (int f = 0; f < 64; ++f) s += h1[i * 64 + f] * w2[f * 64 + j];
        h2[i * 68 + j] = __sinf(f2[j] * s); }
    __syncthreads();
#pragma unroll 1
    for (int ci = 0; ci < 4; ++ci) {
        const int col = tid + 512 * ci, o = col >> 10, dir = (col >> 9) & 1, c = col & 511;
        float wc[64];
#pragma unroll
        for (int j = 0; j < 64; ++j) wc[j] = w3[j * 2048 + col];
        const float dec = fabsf(decay[col]);
        bf16* dst = GFl + (size_t)(o * 512 + c) * GRN;
        float hf0 = 0.f;
        if (dir == 1 && t0 == 0) {
#pragma unroll 16
            for (int j = 0; j < 64; ++j) hf0 += h2[j] * w3[j * 2048 + col - 512]; }
#pragma unroll 1
        for (int grp = 0; grp < 8; ++grp) {
            unsigned p0 = 0u, p1 = 0u, p2 = 0u, p3 = 0u;
#pragma unroll 1
            for (int e = 0; e < 8; ++e) { const int i = 8 * grp + e + (dir == 0 ? 1 : 0); const int t = t0 + i;
                float s = 0.f;
#pragma unroll
                for (int j4 = 0; j4 < 16; ++j4) { const f32x4 hv = *(const LAS f32x4*)(h2 + i * 68 + 4 * j4);
                    s += hv.x * wc[4 * j4] + hv.y * wc[4 * j4 + 1] + hv.z * wc[4 * j4 + 2] + hv.w * wc[4 * j4 + 3]; }
                s *= __expf(-(float)t * invL1 * dec);
                if (dir == 0 && t == L) s = 0.f;
                if (dir == 1 && t == 0) s = hf0;
                const unsigned hb = f2bf(s);
                if (dir == 1) { p0 = (p0 >> 16) | (p1 << 16); p1 = (p1 >> 16) | (p2 << 16); p2 = (p2 >> 16) | (p3 << 16); p3 = (p3 >> 16) | (hb << 16); }
                else { p3 = (p3 << 16) | (p2 >> 16); p2 = (p2 << 16) | (p1 >> 16); p1 = (p1 << 16) | (p0 >> 16); p0 = (p0 << 16) | hb; }
            }
            const int ib = (dir == 1) ? (L + t0 + 8 * grp) : (L - t0 - 8 * grp - 8), ph = (ib >> 6) * 72 + (ib & 63);
            *(v4u*)(dst + ph) = (v4u){p0, p1, p2, p3};
        }
    }
    __syncthreads();
}
#ifndef MK_PHMASK
#define MK_PHMASK 0xFFFFFFFFu
#endif
#define EN(p) (((MK_PHMASK) >> (p)) & 1u)
constexpr int NPH_LAYER = 12, NPHASE = 1 + DEPTH * NPH_LAYER;
struct Args { const float* in[37]; float* out; unsigned char* ws; int ph_lo, ph_hi; };
static_assert(sizeof(Args) == 39 * 8 + 8, "Args has no padding");

typedef const __attribute__((address_space(4))) Args* KArgs;
__device__ __forceinline__ KArgs kargs() { KArgs p = (KArgs)__builtin_amdgcn_kernarg_segment_ptr(); asm volatile("" : "+s"(p)); return p; }
#define AIN(i) (kargs()->in[i])
__global__ void __launch_bounds__(NTHR, 2) mk_fwd(Args args_unused) {
    extern __shared__ __attribute__((aligned(16))) unsigned char lds_raw[];
    LAS unsigned char* lds = (LAS unsigned char*)lds_raw;
    volatile LAS unsigned* MISC = (volatile LAS unsigned*)(lds + MISC_OFF);
    const int tid0 = threadIdx.x;
#define tid tid_fresh()
#define lane (tid_fresh() & 63)
#define wave (__builtin_amdgcn_readfirstlane(tid_fresh() >> 6))
    const int G = gridDim.x; const int bx = blockIdx.x; const int vcu = (G % 8 == 0) ? (bx % 8) * (G / 8) + bx / 8 : bx;
#define gw (vcu * NWAVES + wave)
    const int ngw = G * NWAVES;
    gu32* ctl = (gu32*)(kargs()->ws + WS_CTL);
    for (int u = tid0; u < (LDS_BYTES - LDSCTL_OFF) / 4; u += NTHR) ((LAS unsigned*)(lds + LDSCTL_OFF))[u] = 0u;
    __syncthreads();
#if MK_MULTI
    XcdBarrier bar; bar.bar = (unsigned*)(ctl + CW_BAR); bar.x = 0; bar.st = nullptr;
#define SEAM(k) do { } while (0)
#else
    XcdBarrier bar = xcd_barrier_post((unsigned*)(ctl + CW_BAR), MISC + 8);
#define SEAM(k) do { if (IN(k) && IN((k) + 1)) xcd_barrier(bar); } while (0)
#endif
    const int lo = kargs()->ph_lo, hi = kargs()->ph_hi;
#define IN(k) (lo <= (k) && (k) < hi)
#define ws (kargs()->ws)
#define MOD ((float*)(ws + WS_MOD))
#define HB ((bf16*)(ws + WS_HB))
#define AFFN ((bf16*)(ws + WS_AFFN))
#define Z ((bf16*)(ws + WS_Z))
#define PROJ ((bf16*)(ws + WS_PROJ))
#define XT ((bf16*)(ws + WS_XT))
#define Y2T ((bf16*)(ws + WS_Y2T))
#define QD ((bf16*)(ws + WS_QD))
#define KVD ((bf16*)(ws + WS_KVD))
#define KMLA ((bf16*)(ws + WS_KMLA))
#define YCAT ((bf16*)(ws + WS_YCAT))
#define OUT (kargs()->out)

    if (EN(0) && IN(0)) {
        mod_phase(lds, AIN(2), AIN(3), AIN(4), AIN(5), MOD, vcu, G, tid);
        for (int item = vcu; item < DEPTH * 96; item += G) { const int l = item / 96, r = item % 96; const int L = r < 32 ? LP : LS, tb = r < 32 ? r : r - 32;
            bf16* GFl = (bf16*)(ws + WS_GF + (size_t)l * SZ_GF + (r < 32 ? 0 : SZ_GF_P));
            filt_item(lds, L, tb, AIN(13) + (size_t)l * 33 * 64, AIN(14) + l * 64, AIN(15) + l * 64, AIN(16) + (size_t)l * 4096, AIN(17) + l * 64, AIN(18) + l * 64,
                      AIN(19) + (size_t)l * 64 * 2048, AIN(20) + (size_t)l * 2048, GFl, tid); }
        { LAS float* scr = (LAS float*)(lds + wave * 16384);
          constexpr int I_IN = 32 * 138, I_QB = 8 * 24, I_KVB = 4 * 32, I_OUT = 32 * 64, I_UP = 32 * 352, I_DN = 88 * 64, I_L = I_IN + I_QB + I_KVB + I_OUT + I_UP + I_DN;
          for (int it = gw; it < DEPTH * I_L; it += ngw) { const int l = it / I_L; int r = it % I_L;
              if (r < I_IN) { p0_transpose_item(AIN(7) + (size_t)l * DM * INC, DM, INC, (bf16*)(ws + WS_WIN + l * SZ_WIN), 0, scr, r, lane); continue; } r -= I_IN;
              if (r < I_QB) { p0_transpose_item(AIN(25) + (size_t)l * 512 * 768, 512, 768, (bf16*)(ws + WS_WQB + l * SZ_WQB), 0, scr, r, lane); continue; } r -= I_QB;
              if (r < I_KVB) { p0_transpose_item(AIN(27) + (size_t)l * 256 * 1024, 256, 1024, (bf16*)(ws + WS_WKVB + l * SZ_WKVB), 0, scr, r, lane); continue; } r -= I_KVB;
              if (r < I_OUT) { p0_transpose_item(AIN(31) + (size_t)l * DM * DM, DM, DM, (bf16*)(ws + WS_WOUT + l * SZ_WOUT), 0, scr, r, lane); continue; } r -= I_OUT;
              if (r < I_UP) { p0_transpose_item(AIN(33) + (size_t)l * DM * DFF2, DM, DFF2, (bf16*)(ws + WS_WUP + l * SZ_WUP), 0, scr, r, lane); continue; } r -= I_UP;
              p0_transpose_item(AIN(36) + (size_t)l * DFF * DM, DFF, DM, (bf16*)(ws + WS_WDN + l * SZ_WDN), 0, scr, r, lane); } }
        VM_WAIT(); __syncthreads();
    }
    SEAM(0);

#pragma unroll 1
    for (int l = 0; l < DEPTH; ++l) {
        const int pb = 1 + l * NPH_LAYER;
        const float* xa = (l == 0) ? AIN(0) : OUT; const float* xb = (l == 0) ? (AIN(1) - (size_t)NPR * DM) : OUT;
        const float* modl = MOD + (size_t)l * NB * MODW;
        if (EN(1) && IN(pb + 0)) norm_rows(xa, xb, AIN(6) + l * DM, modl, 0, DM, HB, gw, ngw, lane);
        SEAM(pb + 0);
        if (EN(2) && IN(pb + 1)) {
            pg8::Gemm g{HB, (const bf16*)(ws + WS_WIN + l * SZ_WIN), NTOK, INCP, DM, DM, DM}; pg8::StaticOrder S; S.init(NTOK, INCP, G, bx);
            pg8::EpiBf E{PROJ, INCP, 4};
            pg8::gemm_phase<pg8::EpiBf, pg8::StaticOrder, true, true>(lds, g, S, E);
        }
        SEAM(pb + 1);
        if (EN(3) && IN(pb + 2)) {
            for (int row = gw; row < NTOK; row += ngw)
                post_row(PROJ + (size_t)row * INCP, row_pos(row), AIN(8) + l * 512, AIN(22) + l * 128, AIN(23) + l * 128, AIN(24) + l * 512, AIN(26) + l * 256, lane);
            for (int t = vcu; t < (NTOK / 64) * 3; t += G) hyconv_tile(lds, PROJ, XT, AIN(11) + (size_t)l * 3 * 1536, AIN(12) + l * 1536, t, tid);
        }
        SEAM(pb + 2);
        if (EN(4) && IN(pb + 3)) {
            { pg8::Gemm g{PROJ + C_D, (const bf16*)(ws + WS_WQB + l * SZ_WQB), NTOK, 768, 512, INCP, 512}; pg8::StaticOrder S; S.init(NTOK, 768, G, bx);
              pg8::EpiBf E{QD, 768, 0};
              pg8::gemm_phase<pg8::EpiBf, pg8::StaticOrder, true, true>(lds, g, S, E); }
            { pg8::Gemm g{PROJ + C_D + 512, (const bf16*)(ws + WS_WKVB + l * SZ_WKVB), NTOK, 1024, 256, INCP, 256}; pg8::StaticOrder S; S.init(NTOK, 1024, G, bx);
              pg8::EpiBf E{KVD, 1024, 0};
              pg8::gemm_phase<pg8::EpiBf, pg8::StaticOrder, true, true>(lds, g, S, E); }
        }
        SEAM(pb + 3);
        if (EN(5) && IN(pb + 4)) {
            for (int row = gw; row < NTOK; row += ngw)
                mlapost_row(QD + (size_t)row * 768, KVD + (size_t)row * 1024, PROJ + (size_t)row * INCP + C_D + 768, KMLA + (size_t)row * 768, row_pos(row), AIN(28) + l * 192, AIN(29) + l * 192, lane);
        }
        SEAM(pb + 4);
        if (EN(6) && IN(pb + 5)) {
            if (EN(13)) for (int u = vcu; u < 256; u += G) { const int bh = u >> 4, qb = u & 15, b = 4 + (bh >> 2), h = bh & 3; const size_t r0 = batch_row0(b);
                att::attn_body_seq<192, 768, 768, 1024, DM>(QD + (r0 + qb * 256) * 768 + h * 192, KMLA + r0 * 768 + h * 192, KVD + r0 * 1024 + h * 256 + 128,
                                      YCAT + (r0 + qb * 256) * DM + 1536 + h * 128, LS, (char*)lds_raw); }
            if (EN(14)) for (int u = vcu; u < 256; u += G) { const int bh = u >> 4, qb = u & 15, b = 4 + (bh >> 2), h = bh & 3; const size_t r0 = batch_row0(b);
                att::attn_body<128, 2, INCP, INCP, INCP, DM>(PROJ + (r0 + qb * 256) * INCP + C_C + h * 128, PROJ + r0 * INCP + C_C + 512 + (h >> 1) * 128, PROJ + r0 * INCP + C_C + 768 + (h >> 1) * 128,
                                      YCAT + (r0 + qb * 256) * DM + 1024 + h * 128, LS, (char*)lds_raw); }
            if (EN(15)) for (int u = vcu; u < 256; u += G)
                hy::hyena_unit<LS>((LAS char*)lds, (const bf16*)(ws + WS_GF + (size_t)l * SZ_GF + SZ_GF_P), XT, XT + (size_t)NTOK * 512, XT + (size_t)2 * NTOK * 512, Y2T, AIN(21) + l * 1024, 4, 2 * u);
            for (int i = vcu; i < 256; i += G) { const int u = i & 127, bh = u >> 3, qb = u & 7, b = bh >> 2, h = bh & 3; const size_t r0 = batch_row0(b);
                if (i < 128) { if (EN(13))
                    att::attn_body_seq<192, 768, 768, 1024, DM>(QD + (r0 + qb * 256) * 768 + h * 192, KMLA + r0 * 768 + h * 192, KVD + r0 * 1024 + h * 256 + 128,
                                          YCAT + (r0 + qb * 256) * DM + 1536 + h * 128, LP, (char*)lds_raw); }
                else if (EN(14))
                    att::attn_body<128, 2, INCP, INCP, INCP, DM>(PROJ + (r0 + qb * 256) * INCP + C_C + h * 128, PROJ + r0 * INCP + C_C + 512 + (h >> 1) * 128, PROJ + r0 * INCP + C_C + 768 + (h >> 1) * 128,
                                          YCAT + (r0 + qb * 256) * DM + 1024 + h * 128, LP, (char*)lds_raw); }
            if (EN(15)) for (int i = (G == 256) ? (vcu + 128) % 256 : vcu; i < 128; i += G)
                hy::hyena_unit<LP>((LAS char*)lds, (const bf16*)(ws + WS_GF + (size_t)l * SZ_GF), XT, XT + (size_t)NTOK * 512, XT + (size_t)2 * NTOK * 512, Y2T, AIN(21) + l * 1024, 0, 4 * i);
            if (EN(16)) for (int u = vcu; u < 768; u += G) gmlp_unit(lds, PROJ, YCAT, AIN(9) + (size_t)l * 4 * 16384, AIN(10) + l * 512, u, tid);
            VM_WAIT(); __syncthreads();
        }
        SEAM(pb + 5);
        if (EN(7) && IN(pb + 6)) { for (int t = vcu; t < NTOK / 32; t += G) gnorm_tile(lds, YCAT, Y2T, AIN(30) + l * DM, HB, t, tid); }
        SEAM(pb + 6);
        if (EN(8) && IN(pb + 7)) {
            pg8::Gemm g{HB, (const bf16*)(ws + WS_WOUT + l * SZ_WOUT), NTOK, DM, DM, DM, DM}; pg8::StaticOrder S; S.init(NTOK, DM, G, bx);
            pg8::EpiResid E{xa, xb, OUT, modl + 2 * DM};
            pg8::gemm_phase<pg8::EpiResid, pg8::StaticOrder, true, true>(lds, g, S, E);
        }
        SEAM(pb + 7);
        if (EN(9) && IN(pb + 8)) norm_rows(OUT, OUT, AIN(32) + l * DM, modl, 3 * DM, 4 * DM, HB, gw, ngw, lane);
        SEAM(pb + 8);
        if (EN(10) && IN(pb + 9)) {
            pg8::Gemm g{HB, (const bf16*)(ws + WS_WUP + l * SZ_WUP), NTOK, DFF2, DM, DM, DM}; pg8::StaticOrder S; S.init(NTOK, DFF2, G, bx);
            pg8::EpiBf E{Z, DFF2, 0};
            pg8::gemm_phase<pg8::EpiBf, pg8::StaticOrder, true, true>(lds, g, S, E);
        }
        SEAM(pb + 9);
        if (EN(11) && IN(pb + 10)) ffn_gate(Z, AFFN, AIN(34) + (size_t)l * 3 * DFF2, AIN(35) + l * DFF2, vcu * NTHR + tid, G * NTHR);
        SEAM(pb + 10);
        if (EN(12) && IN(pb + 11)) {
            pg8::Gemm g{AFFN, (const bf16*)(ws + WS_WDN + l * SZ_WDN), NTOK, DM, DFF, DFF, DFF}; pg8::StaticOrder S; S.init(NTOK, DM, G, bx);
            pg8::EpiResid E{OUT, OUT, OUT, modl + 5 * DM};
            pg8::gemm_phase<pg8::EpiResid, pg8::StaticOrder, true, true>(lds, g, S, E);
        }
        if (l + 1 < DEPTH) SEAM(pb + 11);
    }
#undef IN
#undef SEAM
#undef tid
#undef lane
#undef wave
#undef gw
#undef ws
#undef MOD
#undef HB
#undef AFFN
#undef Z
#undef PROJ
#undef XT
#undef Y2T
#undef QD
#undef KVD
#undef KMLA
#undef YCAT
#undef OUT
}

extern "C" void kernel_launch(void* const* d_in, const int* in_sizes, int n_in, void* d_out, int out_size, void* d_ws, size_t ws_size, hipStream_t stream) {
    static int grid = 0;
    if (grid == 0) {
        if (n_in != 37 || out_size != NTOK * DM || ws_size < WS_END) { fprintf(stderr, "kernel_launch: shape mismatch (n_in %d out %d ws %zu need %zu)\n", n_in, out_size, ws_size, (size_t)WS_END); grid = -1; return; }
        int dev = 0, cus = 0, per_cu = 0;
        if (hipGetDevice(&dev) != hipSuccess || hipDeviceGetAttribute(&cus, hipDeviceAttributeMultiprocessorCount, dev) != hipSuccess) { grid = -1; return; }
        if (hipFuncSetAttribute((const void*)mk_fwd, hipFuncAttributeMaxDynamicSharedMemorySize, LDS_BYTES) != hipSuccess) { fprintf(stderr, "kernel_launch: hipFuncSetAttribute failed\n"); grid = -1; return; }
        if (hipOccupancyMaxActiveBlocksPerMultiprocessor(&per_cu, (const void*)mk_fwd, NTHR, LDS_BYTES) != hipSuccess || per_cu < 1)
            fprintf(stderr, "kernel_launch: occupancy query reports %d workgroups per CU\n", per_cu);
        (void)hipGetLastError();
        grid = cus;
        if (grid > 256) grid = 256;
    }
    if (grid < 0) return;
    if (hipMemsetAsync((char*)d_ws + WS_CTL, 0, CTL_ZERO_BYTES, stream) != hipSuccess) { fprintf(stderr, "kernel_launch: memset failed\n"); return; }
    Args a{};
    for (int i = 0; i < 37; ++i) a.in[i] = (const float*)d_in[i];
    a.out = (float*)d_out; a.ws = (unsigned char*)d_ws;
#if MK_MULTI
    for (int p = 0; p < NPHASE; ++p) { a.ph_lo = p; a.ph_hi = p + 1; hipLaunchKernelGGL(mk_fwd, dim3(grid), dim3(NTHR), LDS_BYTES, stream, a); }
#else
    a.ph_lo = 0; a.ph_hi = NPHASE;
    hipLaunchKernelGGL(mk_fwd, dim3(grid), dim3(NTHR), LDS_BYTES, stream, a);
#endif
    const hipError_t le = hipPeekAtLastError();
    if (le != hipSuccess) fprintf(stderr, "kernel_launch: launch failed: %s\n", hipGetErrorName(le));
}
```

```cpp
#include <hip/hip_runtime.h>
#include <hip/hip_bf16.h>
#include <cstdio>
#include <cstdint>
#include <cmath>

#ifndef MK_MULTI
#define MK_MULTI 0
#endif

constexpr int DM = 2048, NTOK = 24576, NPR = 8192  , LP = 2048, LS = 4096, DEPTH = 4, NB = 8  ;
constexpr int INC = 4416, INCP = 4608;
constexpr int C_A = 0, C_B = 1024, C_C = 2560, C_D = 3584;
constexpr int DFF = 5632, DFF2 = 11264;
constexpr int MODW = 6 * DM;
constexpr float EPS = 1e-6f;
constexpr int NWAVES = 8, NTHR = 512;

constexpr size_t MiB = 1u << 20;
constexpr size_t WS_CTL = 0, CTL_ZERO_BYTES = 1 * MiB;
constexpr size_t WS_MOD = 1 * MiB;
constexpr size_t WS_GA1 = 2 * MiB + 512 * 1024;
constexpr size_t WS_GA2 = WS_GA1 + 256 * 1024;
constexpr size_t WS_BV1 = 3 * MiB;
constexpr size_t WS_BV2 = 4 * MiB;
constexpr size_t WS_SS = 65536;
constexpr size_t WS_WIN = 6 * MiB;
constexpr size_t SZ_WIN = (size_t)INCP * DM * 2;
constexpr size_t WS_WQB = WS_WIN + DEPTH * SZ_WIN;
constexpr size_t SZ_WQB = (size_t)768 * 512 * 2;
constexpr size_t WS_WKVB = WS_WQB + DEPTH * SZ_WQB;
constexpr size_t SZ_WKVB = (size_t)1024 * 256 * 2;
constexpr size_t WS_WOUT = WS_WKVB + DEPTH * SZ_WKVB;
constexpr size_t SZ_WOUT = (size_t)DM * DM * 2;
constexpr size_t WS_WUP = WS_WOUT + DEPTH * SZ_WOUT;
constexpr size_t SZ_WUP = (size_t)DFF2 * DM * 2;
constexpr size_t WS_WDN = WS_WUP + DEPTH * SZ_WUP;
constexpr size_t SZ_WDN = (size_t)DM * DFF * 2;
constexpr size_t WS_GF = WS_WDN + DEPTH * SZ_WDN;
constexpr size_t SZ_GF_P = (size_t)2 * 512 * 4608 * 2, SZ_GF_S = (size_t)2 * 512 * 9216 * 2, SZ_GF = SZ_GF_P + SZ_GF_S;
constexpr size_t WS_HB = WS_GF + DEPTH * SZ_GF;
constexpr size_t WS_HB2 = WS_HB + (size_t)NTOK * DM * 2;
constexpr size_t WS_AFFN = WS_HB2 + (size_t)NTOK * DM * 2;
constexpr size_t WS_R1 = WS_AFFN + (size_t)NTOK * DFF * 2;
constexpr size_t WS_Z = WS_R1;
constexpr size_t WS_PROJ = WS_R1;
constexpr size_t WS_XT = WS_PROJ + (size_t)NTOK * INCP * 2;
constexpr size_t SZ_XT1 = (size_t)NTOK * 512 * 2;
constexpr size_t WS_Y2T = WS_XT + 3 * SZ_XT1;
constexpr size_t WS_QD = WS_Y2T + SZ_XT1;
constexpr size_t WS_KVD = WS_QD + (size_t)NTOK * 768 * 2;
constexpr size_t WS_KMLA = WS_KVD + (size_t)NTOK * 1024 * 2;
constexpr size_t WS_YCAT = WS_KMLA + (size_t)NTOK * 768 * 2;
constexpr size_t WS_END = WS_R1 + (size_t)NTOK * DFF2 * 2;
static_assert(WS_YCAT + (size_t)NTOK * DM * 2 <= WS_END, "mixer buffers fit under Z");
static_assert(WS_SS + 8 * (size_t)NTOK * 4 <= CTL_ZERO_BYTES && WS_BV2 + (size_t)DEPTH * NB * DFF2 * 4 <= WS_WIN, "ws map");
constexpr int CW_BAR = 4096;

__host__ __device__ __forceinline__ size_t xt_off(int b, int c) { return b < 4 ? ((size_t)(b * 512 + c) * LP) : ((size_t)4 * 512 * LP + (size_t)((b - 4) * 512 + c) * LS); }
__host__ __device__ __forceinline__ int row_batch(int row) { return row < NPR ? (row >> 11) : 4 + ((row - NPR) >> 12); }
__host__ __device__ __forceinline__ int row_pos(int row) { return row < NPR ? (row & (LP - 1)) : ((row - NPR) & (LS - 1)); }
__host__ __device__ __forceinline__ int batch_row0(int b) { return b < 4 ? b * LP : NPR + (b - 4) * LS; }
__host__ __device__ __forceinline__ int batch_len(int b) { return b < 4 ? LP : LS; }

__host__ __device__ __forceinline__ size_t affn_off(int row, int j) { return ((((size_t)(row >> 8) * (DFF / 64) + (j >> 6)) * 256 + (row & 255)) << 6) + (j & 63); }

constexpr int RING_BYTES = 131072;
constexpr int LDSCTL_OFF = RING_BYTES, MISC_OFF = LDSCTL_OFF + 320, HALO_OFF = RING_BYTES + 1024;
constexpr int TAB_OFF = HALO_OFF + 8192 + 1024, TAB_BYTES = 17408;
constexpr int LDS_BYTES = 161792;
#define GAS __attribute__((address_space(1)))
#define LAS __attribute__((address_space(3)))
typedef unsigned short bf16;
typedef unsigned v4u __attribute__((ext_vector_type(4)));
typedef float f32x4 __attribute__((ext_vector_type(4)));
typedef short bf16x8 __attribute__((ext_vector_type(8)));
typedef GAS unsigned gu32;
typedef GAS unsigned long long gu64;
#define RLX_AGENT __ATOMIC_RELAXED, __HIP_MEMORY_SCOPE_AGENT
#define LDS_WAIT() asm volatile("s_waitcnt lgkmcnt(0)" ::: "memory")
#define VM_WAIT() asm volatile("s_waitcnt vmcnt(0)" ::: "memory")
__device__ __forceinline__ int tid_fresh() { int t = threadIdx.x; asm volatile("" : "+v"(t)); return t; }
__device__ __forceinline__ int sfresh(int v) { asm volatile("" : "+s"(v)); return v; }
__device__ __forceinline__ unsigned long long rt() { return __builtin_amdgcn_s_memrealtime(); }
__device__ __forceinline__ unsigned f2bf(float f) { unsigned u = __builtin_bit_cast(unsigned, f); return (u + 0x7fffu + ((u >> 16) & 1u)) >> 16; }
__device__ __forceinline__ unsigned pk2(float lo, float hi) { return f2bf(lo) | (f2bf(hi) << 16); }
#define XB_TMO      128
#define XB_XCNT(j)  (256  + 64 * (j))
#define XB_XSUB(j)  (1280 + 64 * (j))
#define XB_XGEN(j)  (2304 + 64 * (j))
#define XB_TOP      3328
#define XB_TOPGEN   3392
#define XCD_BAR_WORDS 3456
#define XB_SPIN_CAP (1u << 18)

__device__ __forceinline__ unsigned xb_ld(unsigned* p)              { return __hip_atomic_load(p, __ATOMIC_RELAXED, __HIP_MEMORY_SCOPE_AGENT); }
__device__ __forceinline__ unsigned xb_add(unsigned* p, unsigned v) { return __hip_atomic_fetch_add(p, v, __ATOMIC_RELAXED, __HIP_MEMORY_SCOPE_AGENT); }
__device__ __forceinline__ unsigned xb_xcc_id() { return (unsigned)__builtin_amdgcn_s_getreg((3 << 11) | 20) & 0xFu; }
#define XB_SPIN(cond, bar) do { unsigned _sp = 0; while (cond) { __builtin_amdgcn_s_sleep(1); \
    if ((++_sp & 255u) == 0u) { if (xb_ld(&(bar)[XB_TMO])) break; if (_sp > XB_SPIN_CAP) { atomicAdd(&(bar)[XB_TMO], 1u); break; } } } } while (0)

struct XcdBarrier {
    unsigned* bar; unsigned x;
    volatile LAS unsigned* st;
};

__device__ __forceinline__ XcdBarrier xcd_barrier_post(unsigned* bar, volatile LAS unsigned* st) {
    XcdBarrier b; b.bar = bar; b.x = xb_xcc_id(); b.st = st;
    if (threadIdx.x == 0) (void)xb_add(&bar[XB_XCNT(b.x)], 1u);
    return b;
}
__device__ __forceinline__ void xcd_barrier_complete(unsigned* bar, unsigned x, unsigned& nloc, unsigned& nx) {
    const unsigned G = gridDim.x * gridDim.y * gridDim.z;
    unsigned sum, cnt, mine, sp = 0u;
    for (;;) {
        sum = 0u; cnt = 0u; mine = 0u;
#pragma unroll
        for (unsigned j = 0; j < 16; ++j) { const unsigned c = xb_ld(&bar[XB_XCNT(j)]); sum += c; cnt += (c > 0u) ? 1u : 0u; mine = (j == x) ? c : mine; }
        if (sum == G) break;
        __builtin_amdgcn_s_sleep(1);
        if ((++sp & 255u) == 0u) { if (xb_ld(&bar[XB_TMO])) break; if (sp > XB_SPIN_CAP) { atomicAdd(&bar[XB_TMO], 1u); break; } }
    }
    nloc = mine > 0u ? mine : 1u; nx = cnt > 0u ? cnt : 1u;
}

__device__ __forceinline__ void xcd_barrier(const XcdBarrier& b) {
    asm volatile("s_waitcnt vmcnt(0)" ::: "memory");
    __syncthreads();
    if (threadIdx.x == 0) {
        unsigned* bar = b.bar;
        __builtin_amdgcn_s_waitcnt(0);
        unsigned nloc = b.st[0], nx = b.st[1];
        if (nloc == 0u) { xcd_barrier_complete(bar, b.x, nloc, nx); b.st[0] = nloc; b.st[1] = nx; }
        const unsigned old = xb_add(&bar[XB_XSUB(b.x)], 1u);
        const unsigned gen = old / nloc;
        if (old + 1u == (gen + 1u) * nloc) {
            __builtin_amdgcn_fence(__ATOMIC_RELEASE, "agent");
            asm volatile("s_waitcnt vmcnt(0)" ::: "memory");
            const unsigned og = xb_add(&bar[XB_TOP], 1u);
            const unsigned tg = og / nx;
            if (og + 1u == (tg + 1u) * nx) xb_add(&bar[XB_TOPGEN], 1u);
            else XB_SPIN(xb_ld(&bar[XB_TOPGEN]) == tg, bar);
            __builtin_amdgcn_fence(__ATOMIC_ACQUIRE, "agent");
            xb_add(&bar[XB_XGEN(b.x)], 1u);
            asm volatile("s_waitcnt vmcnt(0)" ::: "memory");
        } else {
            XB_SPIN(xb_ld(&bar[XB_XGEN(b.x)]) == gen, bar);
            __builtin_amdgcn_fence(__ATOMIC_ACQUIRE, "agent");
            asm volatile("s_waitcnt vmcnt(0)" ::: "memory");
        }
    }
    __syncthreads();
}
namespace pg8 {
#define PG8_LAS __attribute__((address_space(3)))
typedef unsigned short bf16_t;
typedef short bf16x8 __attribute__((ext_vector_type(8)));
typedef float f32x4 __attribute__((ext_vector_type(4)));
typedef unsigned u32x4 __attribute__((ext_vector_type(4)));
constexpr int BM = 256, BK = 64, HALF = 128, HTB = HALF * BK * 2  , STAGE_BYTES = 8 * HTB, NXCD = 8, WGM = 4;

__host__ __device__ __forceinline__ int lds_byte(int r, int c) { const int st = (r >> 4) * 2 + (c >> 5), rr = r & 15, cc = c & 31, ob = rr * 64 + cc * 2; return st * 1024 + (ob ^ (((ob >> 9) & 1) << 5)); }
__host__ __device__ __forceinline__ void stage_rc(int b, int& R, int& C) { const int st = b / 1024, sb = b % 1024, swz = sb ^ (((sb >> 9) & 1) << 5); R = (st >> 1) * 16 + swz / 64; C = (st & 1) * 32 + (swz % 64) / 2; }
__host__ __device__ __forceinline__ int perm32(int rho) { const int n = rho >> 4, i = rho & 15; return 8 * (i >> 2) + 4 * n + (i & 3); }

struct Unit { int pm, pn; };
struct Gemm { const bf16_t* A; const bf16_t* Bt; int M, N, K, lda, ldb; };

struct StaticOrder {
    int nM, nN, nwg, G, c;
    __host__ __device__ void init(int M, int N, int G_, int c_) { nM = M / BM; nN = N / BM; nwg = nM * nN; G = G_; c = c_; }
    __host__ __device__ bool next(int i, Unit& u) const {
        const long L = (long)i * G + c; if (L >= nwg) return false;
        int wgid = (int)L; { const int q = nwg / NXCD, r = nwg % NXCD, xcd = wgid % NXCD, off = wgid / NXCD; wgid = (xcd < r ? xcd * (q + 1) : r * (q + 1) + (xcd - r) * q) + off; }
        const int nig = WGM * nN, gid = wgid / nig, fm = gid * WGM, gsz = (nM - fm) < WGM ? (nM - fm) : WGM;
        u.pm = fm + ((wgid % nig) % gsz); u.pn = (wgid % nig) / gsz; return true;
    }
    __device__ __forceinline__ void a_ready(const Unit&) const {}
    __device__ __forceinline__ void done(const Unit&) const {}
};

__device__ __forceinline__ unsigned cvt_pk_bf16(float lo, float hi) { unsigned r; asm volatile("v_cvt_pk_bf16_f32 %0, %1, %2" : "=v"(r) : "v"(lo), "v"(hi)); return r; }
typedef float f32x2 __attribute__((ext_vector_type(2)));
__device__ __forceinline__ f32x2 gelu_pk(f32x2 v) {
    const f32x2 av = __builtin_elementwise_abs(v), d = av * 0.2316418882f + 1.0f;
    f32x2 t; t.x = __builtin_amdgcn_rcpf(d.x); t.y = __builtin_amdgcn_rcpf(d.y);
    f32x2 q = t * 0.5307027145f + (-0.7265760135f); q = q * t + 0.7107068705f; q = q * t + (-0.142248368f); q = q * t + 0.127414796f; q = q * t;
    const f32x2 s = (v * v) * (-0.72134752044f);
    f32x2 e; e.x = __builtin_amdgcn_exp2f(s.x); e.y = __builtin_amdgcn_exp2f(s.y);
    const f32x2 m = v * (q * e), r = v - m;
    f32x2 o; o.x = v.x < 0.f ? m.x : r.x; o.y = v.y < 0.f ? m.y : r.y; return o;
}

template <class Epi, class Sched, bool ALIGN_EPI = false, bool SP2 = false, bool BLKA = false, bool BLKB = false>
__device__ __forceinline__ void gemm_phase(PG8_LAS unsigned char* lds, const Gemm g, const Sched& S, const Epi& E) {
    const int tid = tid_fresh(), wid = __builtin_amdgcn_readfirstlane(tid >> 6), lane = tid & 63, wr = wid >> 2, wc = wid & 3, fr = lane & 15, fq = lane >> 4;
    const int K = g.K, nt = K / BK;
    unsigned voffA[2], voffB[2];
#pragma unroll
    for (int i = 0; i < 2; ++i) { int R, C; stage_rc(tid * 16 + i * 8192, R, C); const int Rb = Epi::PERM ? ((R & ~31) + perm32(R & 31)) : R;
        const int Ra = Epi::AROWPERM ? ((R & ~63) | (4 * (R & 15) + ((R >> 4) & 3))) : R;
        voffA[i] = (unsigned)(Ra * (BLKA ? BK : g.lda) + C) * 2u; voffB[i] = (unsigned)(Rb * (BLKB ? BK : g.ldb) + C) * 2u; }
    const size_t kstepA = BLKA ? (size_t)BM * BK * 2 : (size_t)(BK * 2), kstepB = BLKB ? (size_t)BM * BK * 2 : (size_t)(BK * 2);
    const size_t hstepA = BLKA ? (size_t)HALF * BK * 2 : (size_t)HALF * g.lda * 2, hstepB = BLKB ? (size_t)HALF * BK * 2 : (size_t)HALF * g.ldb * 2;
    const size_t tstepA = BLKA ? (size_t)nt * BM * BK * 2 : 2 * hstepA, tstepB = BLKB ? (size_t)nt * BM * BK * 2 : 2 * hstepB;
    const unsigned ldsw = (unsigned)wid * 1024u;
    const int aoff = lds_byte(wr * 64 + fr, fq * 8), boff = lds_byte(wc * 32 + fr, fq * 8);
#define PG8_SA(b, h) (((b) * 2 + (h)) * HTB)
#define PG8_SB(b, h) ((4 + (b) * 2 + (h)) * HTB)
#define PG8_STAGE(bufoff, gbase, voff) do { _Pragma("unroll") for (int _i = 0; _i < 2; ++_i) \
        __builtin_amdgcn_global_load_lds((const unsigned*)((const char*)(gbase) + (voff)[_i]), (PG8_LAS unsigned*)(lds + (bufoff) + ldsw + _i * 8192), 16, 0, 0); } while (0)
#define PG8_LDA(dst, b, h) do { _Pragma("unroll") for (int m = 0; m < 4; ++m) _Pragma("unroll") for (int k = 0; k < 2; ++k) dst[m][k] = *(const PG8_LAS bf16x8*)(lds + PG8_SA(b, h) + aoff + m * 2048 + k * 1024); } while (0)
#define PG8_LDB(dst, b, h) do { _Pragma("unroll") for (int n = 0; n < 2; ++n) _Pragma("unroll") for (int k = 0; k < 2; ++k) dst[n][k] = *(const PG8_LAS bf16x8*)(lds + PG8_SB(b, h) + boff + n * 2048 + k * 1024); } while (0)
#define PG8_MMA(ai, bj, At, Bt) do { __builtin_amdgcn_s_setprio(1); _Pragma("unroll") for (int m = 0; m < 4; ++m) _Pragma("unroll") for (int n = 0; n < 2; ++n) _Pragma("unroll") for (int k = 0; k < 2; ++k) \
        acc[ai][bj][m][n] = __builtin_amdgcn_mfma_f32_16x16x32_bf16(Bt[n][k], At[m][k], acc[ai][bj][m][n], 0, 0, 0); __builtin_amdgcn_s_setprio(0); } while (0)
#define PG8_WAIT_V(n) asm volatile("s_waitcnt vmcnt(" #n ")" ::: "memory")
#define PG8_WAIT_L(n) asm volatile("s_waitcnt lgkmcnt(" #n ")" ::: "memory")
#define PG8_BAR __builtin_amdgcn_s_barrier()
#define PG8_SCHED __builtin_amdgcn_sched_barrier(0)
    Unit cur, nxt; int ui = 0;
    if (!S.next(0, cur)) return;
    f32x4 acc[2][2][4][2];
#pragma unroll
    for (int a = 0; a < 2; ++a)
#pragma unroll
        for (int b = 0; b < 2; ++b)
#pragma unroll
            for (int m = 0; m < 4; ++m)
#pragma unroll
                for (int n = 0; n < 2; ++n) acc[a][b][m][n] = (f32x4){0.f, 0.f, 0.f, 0.f};
    bf16x8 At[4][2], B0[2][2], B1[2][2];
    const char* cA = (const char*)g.A + (size_t)cur.pm * tstepA; const char* cB = (const char*)g.Bt + (size_t)cur.pn * tstepB;
    S.a_ready(cur);
    if constexpr (SP2) {
        PG8_STAGE(PG8_SB(0, 0), cB, voffB); PG8_STAGE(PG8_SB(0, 1), cB + hstepB, voffB); PG8_STAGE(PG8_SA(0, 0), cA, voffA); PG8_STAGE(PG8_SA(0, 1), cA + hstepA, voffA);
        if (wr == 1) PG8_BAR;
        PG8_WAIT_V(2); PG8_BAR;
        PG8_STAGE(PG8_SB(1, 0), cB + kstepB, voffB); PG8_STAGE(PG8_SA(1, 0), cA + kstepA, voffA); PG8_STAGE(PG8_SB(1, 1), cB + hstepB + kstepB, voffB);
        PG8_WAIT_V(6); PG8_BAR;
    } else {
        PG8_STAGE(PG8_SB(0, 0), cB, voffB); PG8_STAGE(PG8_SA(0, 0), cA, voffA); PG8_STAGE(PG8_SB(0, 1), cB + hstepB, voffB); PG8_STAGE(PG8_SA(0, 1), cA + hstepA, voffA);
        if (wr == 1) PG8_BAR;
        PG8_WAIT_V(4); PG8_BAR;
        PG8_STAGE(PG8_SB(1, 0), cB + kstepB, voffB); PG8_STAGE(PG8_SA(1, 0), cA + kstepA, voffA); PG8_STAGE(PG8_SB(1, 1), cB + hstepB + kstepB, voffB);
        PG8_WAIT_V(6); PG8_BAR;
    }
    for (;;) {
        const bool has_next = S.next(ui + 1, nxt);
        const char* nA = has_next ? (const char*)g.A + (size_t)nxt.pm * tstepA : cA; const char* nB = has_next ? (const char*)g.Bt + (size_t)nxt.pn * tstepB : cB;
        for (int t = 0; t < nt; t += 2) {
            const bool last = (t == nt - 2);
            const char* a1 = cA + (size_t)(t + 1) * kstepA;
            const char* a2 = last ? nA : cA + (size_t)(t + 2) * kstepA; const char* b2 = last ? nB : cB + (size_t)(t + 2) * kstepB;
            const char* a3 = a2 + kstepA; const char* b3 = b2 + kstepB;
            if (last && has_next) S.a_ready(nxt);
            if constexpr (SP2) {
            PG8_LDB(B0, 0, 0); PG8_LDB(B1, 0, 1); PG8_SCHED; PG8_LDA(At, 0, 0); PG8_STAGE(PG8_SA(1, 1), a1 + hstepA, voffA);
            PG8_WAIT_V(8); PG8_WAIT_L(0); PG8_BAR; PG8_MMA(0, 0, At, B0); PG8_MMA(0, 1, At, B1); PG8_BAR; PG8_SCHED;
            PG8_LDA(At, 0, 1); PG8_STAGE(PG8_SB(0, 0), b2, voffB); PG8_STAGE(PG8_SB(0, 1), b2 + hstepB, voffB); PG8_STAGE(PG8_SA(0, 0), a2, voffA);
            PG8_WAIT_V(8); PG8_WAIT_L(0); PG8_BAR; PG8_MMA(1, 0, At, B0); PG8_MMA(1, 1, At, B1); PG8_BAR; PG8_SCHED;
            PG8_LDB(B0, 1, 0); PG8_LDB(B1, 1, 1); PG8_SCHED; PG8_LDA(At, 1, 0); PG8_STAGE(PG8_SA(0, 1), a2 + hstepA, voffA);
            PG8_WAIT_V(8); PG8_WAIT_L(0); PG8_BAR; PG8_MMA(0, 0, At, B0); PG8_MMA(0, 1, At, B1); PG8_BAR; PG8_SCHED;
            PG8_LDA(At, 1, 1); PG8_STAGE(PG8_SB(1, 0), b3, voffB); PG8_STAGE(PG8_SB(1, 1), b3 + hstepB, voffB); PG8_STAGE(PG8_SA(1, 0), a3, voffA);
            PG8_WAIT_V(8); PG8_WAIT_L(0); PG8_BAR; PG8_MMA(1, 0, At, B0); PG8_MMA(1, 1, At, B1); PG8_BAR; PG8_SCHED;
            } else {
            PG8_LDB(B0, 0, 0); PG8_SCHED; PG8_LDA(At, 0, 0); PG8_STAGE(PG8_SA(1, 1), a1 + hstepA, voffA);
            PG8_WAIT_L(8); PG8_BAR; PG8_WAIT_L(0); PG8_MMA(0, 0, At, B0); PG8_BAR; PG8_SCHED;
            PG8_LDB(B1, 0, 1); PG8_STAGE(PG8_SB(0, 0), b2, voffB);
            PG8_BAR; PG8_WAIT_L(0); PG8_MMA(0, 1, At, B1); PG8_BAR;
            PG8_LDA(At, 0, 1); PG8_STAGE(PG8_SA(0, 0), a2, voffA);
            PG8_BAR; PG8_WAIT_L(0); PG8_MMA(1, 0, At, B0); PG8_BAR; PG8_SCHED;
            PG8_STAGE(PG8_SB(0, 1), b2 + hstepB, voffB);
            PG8_WAIT_V(6); PG8_BAR; PG8_MMA(1, 1, At, B1); PG8_BAR;
            PG8_LDB(B0, 1, 0); PG8_SCHED; PG8_LDA(At, 1, 0); PG8_STAGE(PG8_SA(0, 1), a2 + hstepA, voffA);
            PG8_WAIT_L(8); PG8_BAR; PG8_WAIT_L(0); PG8_MMA(0, 0, At, B0); PG8_BAR; PG8_SCHED;
            PG8_LDB(B1, 1, 1); PG8_STAGE(PG8_SB(1, 0), b3, voffB);
            PG8_BAR; PG8_WAIT_L(0); PG8_MMA(0, 1, At, B1); PG8_BAR;
            PG8_LDA(At, 1, 1); PG8_STAGE(PG8_SA(1, 0), a3, voffA);
            PG8_BAR; PG8_WAIT_L(0); PG8_MMA(1, 0, At, B0); PG8_BAR; PG8_SCHED;
            PG8_STAGE(PG8_SB(1, 1), b3 + hstepB, voffB);
            PG8_WAIT_V(6); PG8_BAR; PG8_MMA(1, 1, At, B1); PG8_BAR;
            }
        }
        if constexpr (ALIGN_EPI) { if (wr == 0) PG8_BAR; }
        if constexpr (!Epi::AFTER_DRAIN) { E(acc, cur, wr, wc, fr, fq); S.done(cur); }
        if (!has_next) break;
#pragma unroll
        for (int a = 0; a < 2; ++a)
#pragma unroll
            for (int b = 0; b < 2; ++b)
#pragma unroll
                for (int m = 0; m < 4; ++m)
#pragma unroll
                    for (int n = 0; n < 2; ++n) acc[a][b][m][n] = (f32x4){0.f, 0.f, 0.f, 0.f};
        cur = nxt; cA = nA; cB = nB; ++ui;
        if constexpr (ALIGN_EPI) { if (wr == 1) PG8_BAR; }
    }
    PG8_WAIT_V(0);
    if constexpr (!ALIGN_EPI) { if (wr == 0) PG8_BAR; }
    PG8_BAR;
    if constexpr (Epi::AFTER_DRAIN) { E.fused(acc, cur, wr, wc, fr, fq, lds, wid, lane); S.done(cur); }
#undef PG8_SA
#undef PG8_SB
#undef PG8_STAGE
#undef PG8_LDA
#undef PG8_LDB
#undef PG8_MMA
#undef PG8_WAIT_V
#undef PG8_WAIT_L
#undef PG8_BAR
#undef PG8_SCHED
}
}
namespace pg8 {
struct EpiBf {
    static constexpr bool PERM = true, AFTER_DRAIN = false, AROWPERM = false;
    bf16_t* O; int ldc; int gelu_tiles;
    const PG8_LAS float* ss; const PG8_LAS float* bvec; mutable int ui;
    __device__ __forceinline__ void operator()(const f32x4 (&acc)[2][2][4][2], const Unit& u, int wr, int wc, int fr, int fq) const {
        const int row0 = u.pm * BM + wr * 64 + fr; const int col0 = u.pn * BM + wc * 32 + 8 * fq;
        const bool act = u.pn < gelu_tiles;
        f32x4 bv[2][2];
        if (ss) { const PG8_LAS float* bp = bvec + ui * BM + wc * 32 + 8 * fq;
#pragma unroll
            for (int bj = 0; bj < 2; ++bj)
#pragma unroll
                for (int n = 0; n < 2; ++n) bv[bj][n] = *(const PG8_LAS f32x4*)(bp + bj * HALF + 4 * n); }
#pragma unroll
        for (int ai = 0; ai < 2; ++ai)
#pragma unroll
            for (int m = 0; m < 4; ++m) { bf16_t* rowp = O + (size_t)(row0 + ai * HALF + m * 16) * ldc + col0;
                float rs = 1.f; if (ss) rs = ss[ui * BM + wr * 64 + fr + ai * HALF + m * 16];
#pragma unroll
                for (int bj = 0; bj < 2; ++bj) { f32x4 v0 = acc[ai][bj][m][0], v1 = acc[ai][bj][m][1];
                    if (ss) { v0 = v0 * rs + bv[bj][0]; v1 = v1 * rs + bv[bj][1]; }
                    if (act) { f32x2 a = gelu_pk((f32x2){v0[0], v0[1]}), b = gelu_pk((f32x2){v0[2], v0[3]}), c = gelu_pk((f32x2){v1[0], v1[1]}), d = gelu_pk((f32x2){v1[2], v1[3]});
                        v0 = (f32x4){a.x, a.y, b.x, b.y}; v1 = (f32x4){c.x, c.y, d.x, d.y}; }
                    u32x4 w; w.x = cvt_pk_bf16(v0[0], v0[1]); w.y = cvt_pk_bf16(v0[2], v0[3]); w.z = cvt_pk_bf16(v1[0], v1[1]); w.w = cvt_pk_bf16(v1[2], v1[3]);
                    *(u32x4*)(rowp + bj * HALF) = w; } }
        ++ui;
    }
};
struct EpiResid {
    static constexpr bool PERM = true, AFTER_DRAIN = false, AROWPERM = false;
    const float* xa; const float* xb; float* out; const float* gate;
    bf16_t* xg; const float* ga; float* ssq;
    __device__ __forceinline__ void operator()(const f32x4 (&acc)[2][2][4][2], const Unit& u, int wr, int wc, int fr, int fq) const {
        const int row0 = u.pm * BM + wr * 64 + fr; const int col0 = u.pn * BM + wc * 32 + 8 * fq;
        const int b = row_batch(u.pm * BM); const float* xin = (u.pm * BM < NPR) ? xa : xb;
        f32x4 gv[2][2], gn[2][2];
#pragma unroll
        for (int bj = 0; bj < 2; ++bj)
#pragma unroll
            for (int n = 0; n < 2; ++n) { gv[bj][n] = *(const f32x4*)(gate + (size_t)b * MODW + col0 + bj * HALF + 4 * n);
                if (xg) gn[bj][n] = *(const f32x4*)(ga + (size_t)b * DM + col0 + bj * HALF + 4 * n); }
#pragma unroll
        for (int aim = 0; aim < 4; ++aim) { const int ai = aim >> 1, mh = (aim & 1) * 2;
            f32x4 xv[2][2][2];
#pragma unroll
            for (int mm = 0; mm < 2; ++mm) { const size_t off = (size_t)(row0 + ai * HALF + (mh + mm) * 16) * DM + col0;
#pragma unroll
                for (int bj = 0; bj < 2; ++bj)
#pragma unroll
                    for (int n = 0; n < 2; ++n) xv[mm][bj][n] = *(const f32x4*)(xin + off + bj * HALF + 4 * n); }
#pragma unroll
            for (int mm = 0; mm < 2; ++mm) { const int m = mh + mm; const size_t off = (size_t)(row0 + ai * HALF + m * 16) * DM + col0; float sq = 0.f;
#pragma unroll
                for (int bj = 0; bj < 2; ++bj) { f32x4 xn[2];
#pragma unroll
                    for (int n = 0; n < 2; ++n) {
                        xn[n] = xv[mm][bj][n] + gv[bj][n] * acc[ai][bj][m][n];
                        *(f32x4*)(out + off + bj * HALF + 4 * n) = xn[n]; }
                    if (xg) { const f32x4 a = xn[0] * gn[bj][0], c = xn[1] * gn[bj][1];
                        sq += (xn[0][0] * xn[0][0] + xn[0][1] * xn[0][1]) + (xn[0][2] * xn[0][2] + xn[0][3] * xn[0][3]) + (xn[1][0] * xn[1][0] + xn[1][1] * xn[1][1]) + (xn[1][2] * xn[1][2] + xn[1][3] * xn[1][3]);
                        u32x4 w; w.x = cvt_pk_bf16(a[0], a[1]); w.y = cvt_pk_bf16(a[2], a[3]); w.z = cvt_pk_bf16(c[0], c[1]); w.w = cvt_pk_bf16(c[2], c[3]);
                        *(u32x4*)(xg + off + bj * HALF) = w; } }
                if (xg) { sq += __shfl_xor(sq, 16); sq += __shfl_xor(sq, 32);
                    if (fq == 0) __hip_atomic_fetch_add(ssq + row0 + ai * HALF + m * 16, sq, __ATOMIC_RELAXED, __HIP_MEMORY_SCOPE_AGENT); } }
        }
    }
};
}
namespace pg8 {
__device__ __forceinline__ float dpp_prev(float x) { return __int_as_float(__builtin_amdgcn_update_dpp(0, __float_as_int(x), 0x121, 0xF, 0xF, true)); }
__device__ __forceinline__ float dpp_next(float x) { return __int_as_float(__builtin_amdgcn_update_dpp(0, __float_as_int(x), 0x12F, 0xF, 0xF, true)); }
__device__ __forceinline__ float dpp_shr1_old(float oldv, float x) { return __int_as_float(__builtin_amdgcn_update_dpp(__float_as_int(oldv), __float_as_int(x), 0x111, 0xF, 0xF, false)); }
__device__ __forceinline__ float dpp_shl1_old(float oldv, float x) { return __int_as_float(__builtin_amdgcn_update_dpp(__float_as_int(oldv), __float_as_int(x), 0x101, 0xF, 0xF, false)); }
__device__ __forceinline__ f32x4 dpp_shr1_old4(f32x4 o, f32x4 v) { return (f32x4){dpp_shr1_old(o[0], v[0]), dpp_shr1_old(o[1], v[1]), dpp_shr1_old(o[2], v[2]), dpp_shr1_old(o[3], v[3])}; }
__device__ __forceinline__ f32x4 dpp_shl1_old4(f32x4 o, f32x4 v) { return (f32x4){dpp_shl1_old(o[0], v[0]), dpp_shl1_old(o[1], v[1]), dpp_shl1_old(o[2], v[2]), dpp_shl1_old(o[3], v[3])}; }
__device__ __forceinline__ f32x4 dpp_prev4(f32x4 v) { return (f32x4){dpp_prev(v[0]), dpp_prev(v[1]), dpp_prev(v[2]), dpp_prev(v[3])}; }
__device__ __forceinline__ f32x4 dpp_next4(f32x4 v) { return (f32x4){dpp_next(v[0]), dpp_next(v[1]), dpp_next(v[2]), dpp_next(v[3])}; }
struct EpiGate {
    static constexpr bool PERM = true, AFTER_DRAIN = false, AROWPERM = true;
    bf16_t* A; float* ZH; const float* cw; const float* cb; PG8_LAS float* halo;
    const PG8_LAS float* rstab; const float* bvec; mutable int ui;
    __device__ __forceinline__ void operator()(f32x4 (&acc)[2][2][4][2], const Unit& u, int wr, int wc, int fr, int fq) const {
        const int cl = wc * 32 + 8 * fq;
        f32x4 w[2][3], bs[2], bv[2];
#define EG_LOADC(n_) do { const float* bp_ = bvec + (size_t)row_batch(u.pm * BM) * DFF2 + u.pn * BM + cl + 4 * (n_); const int j0_ = u.pn * HALF + cl + 4 * (n_); \
        _Pragma("unroll") for (int bj = 0; bj < 2; ++bj) { bv[bj] = *(const f32x4*)(bp_ + bj * HALF); bs[bj] = *(const f32x4*)(cb + bj * DFF + j0_); } } while (0)
#define EG_LOADW(n_) do { const int j0_ = u.pn * HALF + cl + 4 * (n_); \
        _Pragma("unroll") for (int bj = 0; bj < 2; ++bj) _Pragma("unroll") for (int k = 0; k < 3; ++k) w[bj][k] = *(const f32x4*)(cw + (size_t)k * DFF2 + bj * DFF + j0_); } while (0)
#pragma unroll
        for (int ai = 0; ai < 2; ++ai)
#pragma unroll
            for (int m = 0; m < 4; ++m) { const float rs = rstab[ui * BM + ai * HALF + wr * 64 + 4 * fr + m];
#pragma unroll
                for (int bj = 0; bj < 2; ++bj)
#pragma unroll
                    for (int n = 0; n < 2; ++n) acc[ai][bj][m][n] = acc[ai][bj][m][n] * rs; }
#pragma unroll
        for (int ai = 0; ai < 2; ++ai)
#pragma unroll
            for (int bj = 0; bj < 2; ++bj)
#pragma unroll
                for (int n = 0; n < 2; ++n) { const int blk = ai * 2 + wr, c = bj * HALF + cl + 4 * n;
                    const f32x4 hv = (fr == 0) ? acc[ai][bj][0][n] : acc[ai][bj][3][n];
                    *(PG8_LAS f32x4*)(halo + ((fr == 0) ? (blk * 2) * 256 : (fr == 15) ? (blk * 2 + 1) * 256 : 2048) + c) = hv; }
        asm volatile("s_waitcnt lgkmcnt(0)" ::: "memory"); __builtin_amdgcn_s_barrier(); asm volatile("" ::: "memory");
        const int trow0 = u.pm * BM, pos0 = row_pos(trow0), Lb = batch_len(row_batch(trow0));
        const bool top_ok = (pos0 == 0), bot_ok = (pos0 + BM == Lb);
        const unsigned aoff = ((((unsigned)u.pm * (DFF / 64) + 2 * u.pn + (wc >> 1)) << 14) + 32 * (wc & 1) + 8 * fq) * 2u;
#pragma unroll
        for (int n = 0; n < 2; ++n) {
            EG_LOADW(n); EG_LOADC(n);
            f32x4 cfull[2];
#pragma unroll
            for (int bj = 0; bj < 2; ++bj) cfull[bj] = bs[bj] + bv[bj] * (w[bj][0] + w[bj][1] + w[bj][2]);
            { const unsigned zo = (((unsigned)u.pm * 4) * DFF2 + u.pn * BM + cl + 4 * n) * 4u;
              if (wr == 0 && fr == 0) {
#pragma unroll
                  for (int bj = 0; bj < 2; ++bj) { *(f32x4*)((char*)ZH + (zo + (unsigned)(bj * HALF) * 4u)) = acc[0][bj][0][n] + bv[bj];
                      *(f32x4*)((char*)ZH + (zo + (unsigned)(DFF2 + bj * HALF) * 4u)) = acc[0][bj][1][n] + bv[bj]; } }
              if (wr == 1 && fr == 15) {
#pragma unroll
                  for (int bj = 0; bj < 2; ++bj) { *(f32x4*)((char*)ZH + (zo + (unsigned)(2 * DFF2 + bj * HALF) * 4u)) = acc[1][bj][2][n] + bv[bj];
                      *(f32x4*)((char*)ZH + (zo + (unsigned)(3 * DFF2 + bj * HALF) * 4u)) = acc[1][bj][3][n] + bv[bj]; } } }
#pragma unroll
            for (int ai = 0; ai < 2; ++ai) {
                const int blk = ai * 2 + wr;
                f32x4 hp[2], hn[2];
#pragma unroll
                for (int bj = 0; bj < 2; ++bj) {
                    hp[bj] = (blk > 0) ? *(const PG8_LAS f32x4*)(halo + ((blk - 1) * 2 + 1) * 256 + bj * HALF + cl + 4 * n) : (f32x4){0.f, 0.f, 0.f, 0.f};
                    hn[bj] = (blk < 3) ? *(const PG8_LAS f32x4*)(halo + ((blk + 1) * 2 + 0) * 256 + bj * HALF + cl + 4 * n) : (f32x4){0.f, 0.f, 0.f, 0.f}; }
#pragma unroll
                for (int m = 0; m < 4; ++m) {
                    const int rt = ai * HALF + wr * 64 + 4 * fr + m;
                    f32x4 cv[2];
#pragma unroll
                    for (int bj = 0; bj < 2; ++bj) {
                        const f32x4 cur = acc[ai][bj][m][n];
                        const f32x4 prev = (m > 0) ? acc[ai][bj][m > 0 ? m - 1 : 0][n] : dpp_shr1_old4(hp[bj], acc[ai][bj][3][n]);
                        const f32x4 next = (m < 3) ? acc[ai][bj][m < 3 ? m + 1 : 3][n] : dpp_shl1_old4(hn[bj], acc[ai][bj][0][n]);
                        cv[bj] = w[bj][0] * prev + w[bj][1] * cur + w[bj][2] * next + cfull[bj];
                        if (ai == 0 && m == 0) { if (wr == 0 && fr == 0 && top_ok) cv[bj] = cv[bj] - bv[bj] * w[bj][0]; }
                        if (ai == 1 && m == 3) { if (wr == 1 && fr == 15 && bot_ok) cv[bj] = cv[bj] - bv[bj] * w[bj][2]; } }
                    float o[4];
#pragma unroll
                    for (int e = 0; e < 4; ++e) { const float g = cv[0][e]; o[e] = g * __builtin_amdgcn_rcpf(1.0f + __expf(-g)) * cv[1][e]; }
                    const unsigned p0 = cvt_pk_bf16(o[0], o[1]), p1 = cvt_pk_bf16(o[2], o[3]);
                    {
                      typedef unsigned u32x2e __attribute__((ext_vector_type(2)));
                      *(u32x2e*)((char*)A + (aoff + (unsigned)(rt * 128 + 8 * n))) = (u32x2e){p0, p1}; }
                }
            }
        }
        asm volatile("s_waitcnt lgkmcnt(0)" ::: "memory"); __builtin_amdgcn_s_barrier(); asm volatile("" ::: "memory");
        ++ui;
#undef EG_LOADC
#undef EG_LOADW
    }
};
template <class Sched> __device__ __forceinline__ void fill_tabs(const Sched& S, const float* ss, const float* bvec, int ldb, PG8_LAS float* rstab, PG8_LAS float* bvtab, int tid) {
    Unit u;
    for (int i = 0; S.next(i, u); ++i) {
        if (tid < 256) rstab[i * BM + tid] = rsqrtf(ss[u.pm * BM + tid] * (1.0f / DM) + EPS);
        else if (bvec) bvtab[i * BM + tid - 256] = bvec[(size_t)row_batch(u.pm * BM) * ldb + u.pn * BM + tid - 256]; }
    __syncthreads();
}
}
namespace att {
using bf16x8 = __attribute__((ext_vector_type(8))) short;
using s16x4  = __attribute__((ext_vector_type(4))) short;
using f32x16 = __attribute__((ext_vector_type(16))) float;
using u32x4  = __attribute__((ext_vector_type(4))) unsigned;
constexpr int NW = 8, QBLK = 32, KVBLK = 64, DV = 128;
constexpr float THR = 8.f;
#define ATT_SBAR() __builtin_amdgcn_sched_barrier(0)
__device__ __forceinline__ int crow(int r, int hi) { return (r & 3) + 8 * (r >> 2) + 4 * hi; }
__device__ __forceinline__ unsigned cvtpk(float lo, float hi) { unsigned r; asm volatile("v_cvt_pk_bf16_f32 %0, %1, %2" : "=v"(r) : "v"(lo), "v"(hi)); return r; }
template <int DK> __device__ __forceinline__ int kswz(int row, int colB) { return row * (2 * DK + 16) + colB; }

template <int DK> __device__ __forceinline__ void partialSM(f32x16& p0, f32x16& p1, float& m_reg, float& mn, float& alpha) {
  constexpr float SCALE = (DK == 128) ? 0.08838834764831845f : 0.07216878364870323f;
  constexpr float C = SCALE * 1.4426950408889634f;
  float pmax = p0[0];
#pragma unroll
  for (int r = 1; r < 16; ++r) pmax = fmaxf(pmax, p0[r]);
#pragma unroll
  for (int r = 0; r < 16; ++r) pmax = fmaxf(pmax, p1[r]);
  { auto rr = __builtin_amdgcn_permlane32_swap(__float_as_uint(pmax), __float_as_uint(pmax), false, false);
    pmax = fmaxf(__uint_as_float(rr[0]), __uint_as_float(rr[1])); }
  if (__builtin_expect(__all(pmax - m_reg <= THR / SCALE), 1)) { mn = m_reg; alpha = 1.f; }
  else { mn = fmaxf(m_reg, pmax); alpha = __builtin_amdgcn_exp2f((m_reg - mn) * C); m_reg = mn; }
  float mnC = -mn * C;
#pragma unroll
  for (int r = 0; r < 16; ++r) p0[r] = fmaf(p0[r], C, mnC);
#pragma unroll
  for (int r = 0; r < 16; ++r) p1[r] = fmaf(p1[r], C, mnC);
#pragma unroll
  for (int r = 0; r < 16; ++r) p0[r] = __builtin_amdgcn_exp2f(p0[r]);
}
__device__ __forceinline__ void finishSM(f32x16& p0, f32x16& p1, float alpha, float& l_reg, bf16x8& pa0, bf16x8& pa1, bf16x8& pa2, bf16x8& pa3) {
#pragma unroll
  for (int r = 0; r < 16; ++r) p1[r] = __builtin_amdgcn_exp2f(p1[r]);
  float ps = 0;
#pragma unroll
  for (int r = 0; r < 16; ++r) ps += p0[r];
#pragma unroll
  for (int r = 0; r < 16; ++r) ps += p1[r];
  { auto rr = __builtin_amdgcn_permlane32_swap(__float_as_uint(ps), __float_as_uint(ps), false, false);
    ps = __uint_as_float(rr[0]) + __uint_as_float(rr[1]); }
  l_reg = l_reg * alpha + ps;
#define ATT_PK4(P, BASE, OUT) do { unsigned a0 = cvtpk(P[BASE + 0], P[BASE + 1]), a1 = cvtpk(P[BASE + 2], P[BASE + 3]);   \
    unsigned b0 = cvtpk(P[BASE + 4], P[BASE + 5]), b1 = cvtpk(P[BASE + 6], P[BASE + 7]);                              \
    auto r0 = __builtin_amdgcn_permlane32_swap(a0, b0, false, false); auto r1 = __builtin_amdgcn_permlane32_swap(a1, b1, false, false); \
    u32x4 w = {r0[0], r1[0], r0[1], r1[1]}; OUT = *reinterpret_cast<bf16x8*>(&w); } while (0)
  ATT_PK4(p0, 0, pa0); ATT_PK4(p0, 8, pa1); ATT_PK4(p1, 0, pa2); ATT_PK4(p1, 8, pa3);
#undef ATT_PK4
}
template <int DK> __device__ __forceinline__ void qkt(f32x16& p0, f32x16& p1, const char* Ks, const bf16x8* qr, const char* ldsb, int qxo, int r32, int hi) {
  p0 = f32x16{}; p1 = f32x16{};
  if constexpr (DK > 128) asm volatile("" : "+v"(qxo));
  const char* qx = ldsb + qxo;
#pragma unroll
  for (int d0 = 0; d0 < DK / 16; ++d0) { int cb = (d0 * 16 + hi * 8) * 2;
    bf16x8 b0 = *reinterpret_cast<const bf16x8*>(Ks + kswz<DK>(r32, cb));
    bf16x8 b1 = *reinterpret_cast<const bf16x8*>(Ks + kswz<DK>(32 + r32, cb));
    bf16x8 qf; if (d0 < 8) qf = qr[d0]; else qf = *reinterpret_cast<const bf16x8*>(qx + (d0 - 8) * 1024);
    p0 = __builtin_amdgcn_mfma_f32_32x32x16_bf16(b0, qf, p0, 0, 0, 0);
    p1 = __builtin_amdgcn_mfma_f32_32x32x16_bf16(b1, qf, p1, 0, 0, 0);
    if ((d0 & 3) == 3) ATT_SBAR(); }
}
__device__ __forceinline__ int v_st(int k, int c) { const int kk = (k & ~0xC) | ((k & 4) << 1) | ((k & 8) >> 1); return ((kk >> 3) * 4 + (c >> 5)) * 512 + ((kk & 7) * 32 + (c & 31)) * 2; }
__device__ __forceinline__ int v_rd_base(int lane) { return ((lane & 3) << 3) | (((lane >> 2) & 3) << 6) | (((lane >> 4) & 1) << 5) | (((lane >> 5) & 1) << 8); }
constexpr int v_rd_off(int d0, int ks, int half) { return d0 * 512 + ks * 4096 + half * 2048; }
template <int OFF> __device__ __forceinline__ s16x4 tr_read(int vb) {
  s16x4 r; asm volatile("ds_read_b64_tr_b16 %0, %1 offset:%2" : "=&v"(r) : "v"(vb), "i"(OFF) : "memory"); return r;
}
template <int D0> __device__ __forceinline__ void pv_one(f32x16& od, int vb, bf16x8 pa0, bf16x8 pa1, bf16x8 pa2, bf16x8 pa3) {
  const s16x4 l0 = tr_read<v_rd_off(D0, 0, 0)>(vb), h0 = tr_read<v_rd_off(D0, 0, 1)>(vb), l1 = tr_read<v_rd_off(D0, 1, 0)>(vb), h1 = tr_read<v_rd_off(D0, 1, 1)>(vb);
  const s16x4 l2 = tr_read<v_rd_off(D0, 2, 0)>(vb), h2 = tr_read<v_rd_off(D0, 2, 1)>(vb), l3 = tr_read<v_rd_off(D0, 3, 0)>(vb), h3 = tr_read<v_rd_off(D0, 3, 1)>(vb);
  asm volatile("s_waitcnt lgkmcnt(0)" ::: "memory"); ATT_SBAR();
#define ATT_PK(L, H) (bf16x8){L[0], L[1], L[2], L[3], H[0], H[1], H[2], H[3]}
  od = __builtin_amdgcn_mfma_f32_32x32x16_bf16(pa0, ATT_PK(l0, h0), od, 0, 0, 0);
  od = __builtin_amdgcn_mfma_f32_32x32x16_bf16(pa1, ATT_PK(l1, h1), od, 0, 0, 0);
  od = __builtin_amdgcn_mfma_f32_32x32x16_bf16(pa2, ATT_PK(l2, h2), od, 0, 0, 0);
  od = __builtin_amdgcn_mfma_f32_32x32x16_bf16(pa3, ATT_PK(l3, h3), od, 0, 0, 0);
#undef ATT_PK
}
__device__ __forceinline__ void pv_d0(f32x16* o, int vb, bf16x8 pa0, bf16x8 pa1, bf16x8 pa2, bf16x8 pa3) {
  pv_one<0>(o[0], vb, pa0, pa1, pa2, pa3); pv_one<1>(o[1], vb, pa0, pa1, pa2, pa3); pv_one<2>(o[2], vb, pa0, pa1, pa2, pa3); pv_one<3>(o[3], vb, pa0, pa1, pa2, pa3);
}
template <int DK> struct Cfg { static constexpr int SHM_V = KVBLK * DV * 2, SHM_K = KVBLK * (DK * 2 + 16), SHM_Q = (DK > 128) ? NW * 4096 : 0, SHM = 2 * SHM_V + 2 * SHM_K + NW * 64 * 4 + SHM_Q; };

template <int DK, int SDEPTH, int ldq, int ldk, int ldv, int ldo>
__device__ __forceinline__ void attn_body(const unsigned short* __restrict__ Qb, const unsigned short* __restrict__ Kh,
                                          const unsigned short* __restrict__ Vh, unsigned short* __restrict__ Ob, int seq, char* lds) {
  constexpr int SHM_V = Cfg<DK>::SHM_V, SHM_K = Cfg<DK>::SHM_K, NQ = (DK > 128 ? 8 : DK / 16), NKI = DK / 64;
  const int tid = tid_fresh(), wid = tid >> 6, lane = tid & 63, r32 = lane & 31, hi = lane >> 5;
  char* V_lds = lds; char* K_lds = lds + 2 * SHM_V;
  float* ws = (float*)(lds + 2 * SHM_V + 2 * SHM_K) + wid * 64; float* li_l = ws; float* al_l = ws + 32;
  float m_reg = -1e30f, l_reg = 0; f32x16 o[4] = {}; bf16x8 qr[NQ];
  const unsigned short* Qw = Qb + (wid * QBLK + r32) * ldq + hi * 8;
#pragma unroll
  for (int d0 = 0; d0 < NQ; ++d0) qr[d0] = *reinterpret_cast<const bf16x8*>(Qw + d0 * 16);
  const int qxo = 2 * SHM_V + 2 * SHM_K + NW * 64 * 4 + wid * 4096 + lane * 16; char* qx = lds + qxo;
  if constexpr (DK > 128) {
#pragma unroll
    for (int d0 = 8; d0 < DK / 16; ++d0) *reinterpret_cast<bf16x8*>(qx + (d0 - 8) * 1024) = *reinterpret_cast<const bf16x8*>(Qw + d0 * 16);
  }
  const int sr = tid >> 4, sc = (tid & 15) * 8, vst0 = v_st(sr, sc);
  const int vgo = sr * ldv + sc;
  const int kr = tid >> 3, kc8 = tid & 7, kgo = kr * ldk + kc8 * 8, kdst = kswz<DK>(kr, kc8 * 16);
  const int vb0 = (int)(uintptr_t)V_lds + v_rd_base(lane);
  struct { bf16x8 vs0, vs1, ks[NKI]; } sr_[SDEPTH];
#define ATT_SLOAD(i, k0) do { const unsigned short* vt_ = Vh + (size_t)(k0) * ldv; const unsigned short* kt_ = Kh + (size_t)(k0) * ldk; \
    sr_[i].vs0 = *reinterpret_cast<const bf16x8*>(vt_ + vgo); sr_[i].vs1 = *reinterpret_cast<const bf16x8*>(vt_ + vgo + 32 * ldv); \
    _Pragma("unroll") for (int q_ = 0; q_ < NKI; ++q_) sr_[i].ks[q_] = *reinterpret_cast<const bf16x8*>(kt_ + kgo + 64 * q_); } while (0)
#define ATT_SWRITE(b, i) do { *(bf16x8*)(V_lds + (b) * SHM_V + vst0) = sr_[i].vs0; *(bf16x8*)(V_lds + (b) * SHM_V + vst0 + 8192) = sr_[i].vs1; \
    _Pragma("unroll") for (int q_ = 0; q_ < NKI; ++q_) *(bf16x8*)(K_lds + (b) * SHM_K + kdst + 128 * q_) = sr_[i].ks[q_]; } while (0)
#define ATT_SWAIT() do { if constexpr (SDEPTH == 2) { if constexpr (NKI == 2) asm volatile("s_waitcnt vmcnt(4)" ::: "memory"); else asm volatile("s_waitcnt vmcnt(5)" ::: "memory"); } else asm volatile("s_waitcnt vmcnt(0)" ::: "memory"); } while (0)
#define ATT_RESC(a) do { if (__any((a) < 1.f)) { if (hi == 0) al_l[r32] = (a); asm volatile("s_waitcnt lgkmcnt(0)" ::: "memory"); \
    _Pragma("unroll") for (int d = 0; d < 4; ++d) _Pragma("unroll") for (int r = 0; r < 16; ++r) o[d][r] *= al_l[crow(r, hi)]; } } while (0)
  f32x16 pA0, pA1, pB0, pB1; float mnA, mnB, alA, alB; bf16x8 pa0, pa1, pa2, pa3; const int NT = seq / KVBLK;
  constexpr int SE = 0, SO = SDEPTH - 1;
  ATT_SLOAD(SE, 0); asm volatile("s_waitcnt vmcnt(0)" ::: "memory"); ATT_SWRITE(0, SE); __syncthreads();
  qkt<DK>(pA0, pA1, K_lds, qr, lds, qxo, r32, hi); partialSM<DK>(pA0, pA1, m_reg, mnA, alA);
  ATT_SLOAD(SO, KVBLK); if constexpr (SDEPTH == 2) { if (2 < NT) ATT_SLOAD(SE, 2 * KVBLK); }
  ATT_SWAIT(); ATT_SWRITE(1, SO); __syncthreads();
  for (int j = 1; j + 1 < NT; j += 2) {
    ATT_SBAR(); qkt<DK>(pB0, pB1, K_lds + SHM_K, qr, lds, qxo, r32, hi);
    finishSM(pA0, pA1, alA, l_reg, pa0, pa1, pa2, pa3); ATT_SBAR();
    ATT_SLOAD(SO, (j + SDEPTH) * KVBLK); ATT_SBAR();
    pv_d0(o, vb0, pa0, pa1, pa2, pa3); partialSM<DK>(pB0, pB1, m_reg, mnB, alB);
    __syncthreads(); ATT_SWAIT(); ATT_SWRITE(0, SE);
    ATT_RESC(alB); __syncthreads();
    ATT_SBAR(); qkt<DK>(pA0, pA1, K_lds, qr, lds, qxo, r32, hi);
    finishSM(pB0, pB1, alB, l_reg, pa0, pa1, pa2, pa3); ATT_SBAR();
    if (SDEPTH == 1 || j + 3 < NT) ATT_SLOAD(SE, (j + 1 + SDEPTH) * KVBLK); ATT_SBAR();
    pv_d0(o, vb0 + SHM_V, pa0, pa1, pa2, pa3); partialSM<DK>(pA0, pA1, m_reg, mnA, alA);
    __syncthreads(); ATT_SWAIT(); ATT_SWRITE(1, SO);
    ATT_RESC(alA); __syncthreads();
  }
  ATT_SBAR(); qkt<DK>(pB0, pB1, K_lds + SHM_K, qr, lds, qxo, r32, hi);
  finishSM(pA0, pA1, alA, l_reg, pa0, pa1, pa2, pa3); ATT_SBAR();
  pv_d0(o, vb0, pa0, pa1, pa2, pa3); partialSM<DK>(pB0, pB1, m_reg, mnB, alB);
  __syncthreads(); ATT_RESC(alB);
  finishSM(pB0, pB1, alB, l_reg, pa0, pa1, pa2, pa3); ATT_SBAR();
  pv_d0(o, vb0 + SHM_V, pa0, pa1, pa2, pa3);
  if (hi == 0) li_l[r32] = l_reg; asm volatile("s_waitcnt lgkmcnt(0)" ::: "memory");
  float rli[16];
#pragma unroll
  for (int r = 0; r < 16; ++r) rli[r] = __builtin_amdgcn_rcpf(li_l[crow(r, hi)]);
  unsigned short* Ow = Ob + (wid * QBLK) * ldo;
#pragma unroll
  for (int r = 0; r < 16; ++r) { int orow = crow(r, hi);
#pragma unroll
    for (int d0 = 0; d0 < 4; ++d0) Ow[orow * ldo + d0 * 32 + r32] = (unsigned short)f2bf(o[d0][r] * rli[r]); }
  __syncthreads();
#undef ATT_SLOAD
#undef ATT_SWRITE
#undef ATT_SWAIT
#undef ATT_RESC
}

template <int DK, int ldq, int ldk, int ldv, int ldo>
__device__ __forceinline__ void attn_body_seq(const unsigned short* __restrict__ Qb, const unsigned short* __restrict__ Kh,
                                              const unsigned short* __restrict__ Vh, unsigned short* __restrict__ Ob, int seq, char* lds) {
  constexpr int SHM_V = Cfg<DK>::SHM_V, SHM_K = Cfg<DK>::SHM_K, NQ = (DK > 128 ? 8 : DK / 16), NKI = DK / 64;
  const int tid = tid_fresh(), wid = tid >> 6, lane = tid & 63, r32 = lane & 31, hi = lane >> 5;
  char* V_lds = lds; char* K_lds = lds + 2 * SHM_V;
  float* ws = (float*)(lds + 2 * SHM_V + 2 * SHM_K) + wid * 64; float* li_l = ws; float* al_l = ws + 32;
  float m_reg = -1e30f, l_reg = 0; f32x16 o[4] = {}; bf16x8 qr[NQ];
  const unsigned short* Qw = Qb + (wid * QBLK + r32) * ldq + hi * 8;
#pragma unroll
  for (int d0 = 0; d0 < NQ; ++d0) qr[d0] = *reinterpret_cast<const bf16x8*>(Qw + d0 * 16);
  const int qxo = 2 * SHM_V + 2 * SHM_K + NW * 64 * 4 + wid * 4096 + lane * 16; char* qx = lds + qxo;
  if constexpr (DK > 128) {
#pragma unroll
    for (int d0 = 8; d0 < DK / 16; ++d0) *reinterpret_cast<bf16x8*>(qx + (d0 - 8) * 1024) = *reinterpret_cast<const bf16x8*>(Qw + d0 * 16);
  }
  const int sr = tid >> 4, sc = (tid & 15) * 8, vst0 = v_st(sr, sc);
  const int vgo = sr * ldv + sc;
  const int kr = tid >> 3, kc8 = tid & 7, kgo = kr * ldk + kc8 * 8, kdst = kswz<DK>(kr, kc8 * 16);
  const int vb0 = (int)(uintptr_t)V_lds + v_rd_base(lane);
  bf16x8 vs0, vs1, ks[NKI];
#define ATT_SLOAD1(k0) do { const unsigned short* vt_ = Vh + (size_t)(k0) * ldv; const unsigned short* kt_ = Kh + (size_t)(k0) * ldk; \
    vs0 = *reinterpret_cast<const bf16x8*>(vt_ + vgo); vs1 = *reinterpret_cast<const bf16x8*>(vt_ + vgo + 32 * ldv); \
    _Pragma("unroll") for (int q_ = 0; q_ < NKI; ++q_) ks[q_] = *reinterpret_cast<const bf16x8*>(kt_ + kgo + 64 * q_); } while (0)
#define ATT_SWRITE1(b) do { *(bf16x8*)(V_lds + (b) * SHM_V + vst0) = vs0; *(bf16x8*)(V_lds + (b) * SHM_V + vst0 + 8192) = vs1; \
    _Pragma("unroll") for (int q_ = 0; q_ < NKI; ++q_) *(bf16x8*)(K_lds + (b) * SHM_K + kdst + 128 * q_) = ks[q_]; } while (0)
  const int NT = seq / KVBLK;
  ATT_SLOAD1(0); ATT_SWRITE1(0); __syncthreads();
#pragma unroll 1
  for (int j = 0; j < NT; ++j) {
    const int b = j & 1;
    f32x16 p0, p1; float mn, al; bf16x8 pa0, pa1, pa2, pa3;
    if (j + 1 < NT) ATT_SLOAD1((j + 1) * KVBLK);
    ATT_SBAR();
    qkt<DK>(p0, p1, K_lds + b * SHM_K, qr, lds, qxo, r32, hi);
    partialSM<DK>(p0, p1, m_reg, mn, al);
    if (__any(al < 1.f)) { if (hi == 0) al_l[r32] = al; asm volatile("s_waitcnt lgkmcnt(0)" ::: "memory");
#pragma unroll
      for (int d = 0; d < 4; ++d)
#pragma unroll
        for (int r = 0; r < 16; ++r) o[d][r] *= al_l[crow(r, hi)]; }
    finishSM(p0, p1, al, l_reg, pa0, pa1, pa2, pa3); ATT_SBAR();
    pv_d0(o, vb0 + b * SHM_V, pa0, pa1, pa2, pa3);
    if (j + 1 < NT) ATT_SWRITE1(b ^ 1);
    __syncthreads();
  }
  if (hi == 0) li_l[r32] = l_reg; asm volatile("s_waitcnt lgkmcnt(0)" ::: "memory");
  float rli[16];
#pragma unroll
  for (int r = 0; r < 16; ++r) rli[r] = __builtin_amdgcn_rcpf(li_l[crow(r, hi)]);
  unsigned short* Ow = Ob + (wid * QBLK) * ldo;
#pragma unroll
  for (int r = 0; r < 16; ++r) { int orow = crow(r, hi);
#pragma unroll
    for (int d0 = 0; d0 < 4; ++d0) Ow[orow * ldo + d0 * 32 + r32] = (unsigned short)f2bf(o[d0][r] * rli[r]); }
  __syncthreads();
#undef ATT_SLOAD1
#undef ATT_SWRITE1
}

template <int DK> __device__ __forceinline__ void qk_half(f32x16& p, const char* Ks, int rowoff, const bf16x8* qr, const char* ldsb, int qxo, int r32, int hi) {
  p = f32x16{};
  const char* qx = ldsb + qxo;
#pragma unroll
  for (int d0 = 0; d0 < DK / 16; ++d0) { int cb = (d0 * 16 + hi * 8) * 2;
    bf16x8 b0 = *reinterpret_cast<const bf16x8*>(Ks + kswz<DK>(rowoff + r32, cb));
    bf16x8 qf; if (d0 < 8) qf = qr[d0]; else qf = *reinterpret_cast<const bf16x8*>(qx + (d0 - 8) * 1024);
    p = __builtin_amdgcn_mfma_f32_32x32x16_bf16(b0, qf, p, 0, 0, 0); }
}
template <int KH> __device__ __forceinline__ void pv_half(f32x16* o, int vb, bf16x8 pa, bf16x8 pb) {
#define ATT_PK(L, H) (bf16x8){L[0], L[1], L[2], L[3], H[0], H[1], H[2], H[3]}
#define ATT_PVD(D0) do { const s16x4 l0 = tr_read<v_rd_off(D0, 2 * KH, 0)>(vb), h0 = tr_read<v_rd_off(D0, 2 * KH, 1)>(vb), l1 = tr_read<v_rd_off(D0, 2 * KH + 1, 0)>(vb), h1 = tr_read<v_rd_off(D0, 2 * KH + 1, 1)>(vb); \
    asm volatile("s_waitcnt lgkmcnt(0)" ::: "memory"); ATT_SBAR();   \
    o[D0] = __builtin_amdgcn_mfma_f32_32x32x16_bf16(pa, ATT_PK(l0, h0), o[D0], 0, 0, 0); o[D0] = __builtin_amdgcn_mfma_f32_32x32x16_bf16(pb, ATT_PK(l1, h1), o[D0], 0, 0, 0); } while (0)
  ATT_PVD(0); ATT_PVD(1); ATT_PVD(2); ATT_PVD(3);
#undef ATT_PVD
#undef ATT_PK
}
__device__ __forceinline__ float exp_pack(f32x16& p, bf16x8& pa, bf16x8& pb) {
#pragma unroll
  for (int r = 0; r < 16; ++r) p[r] = __builtin_amdgcn_exp2f(p[r]);
  float ps = 0.f;
#pragma unroll
  for (int r = 0; r < 16; ++r) ps += p[r];
#define ATT_PK4(P, BASE, OUT) do { unsigned a0 = cvtpk(P[BASE + 0], P[BASE + 1]), a1 = cvtpk(P[BASE + 2], P[BASE + 3]);   \
    unsigned b0 = cvtpk(P[BASE + 4], P[BASE + 5]), b1 = cvtpk(P[BASE + 6], P[BASE + 7]);                              \
    auto r0 = __builtin_amdgcn_permlane32_swap(a0, b0, false, false); auto r1 = __builtin_amdgcn_permlane32_swap(a1, b1, false, false); \
    u32x4 w = {r0[0], r1[0], r0[1], r1[1]}; OUT = *reinterpret_cast<bf16x8*>(&w); } while (0)
  ATT_PK4(p, 0, pa); ATT_PK4(p, 8, pb);
#undef ATT_PK4
  return ps;
}
template <int DK, int ldq, int ldk, int ldv, int ldo>
__device__ __forceinline__ void attn_body_nomax(const unsigned short* __restrict__ Qb, const unsigned short* __restrict__ Kh,
                                                const unsigned short* __restrict__ Vh, unsigned short* __restrict__ Ob, int seq, char* lds) {
  constexpr int SHM_V = Cfg<DK>::SHM_V, SHM_K = Cfg<DK>::SHM_K, NQ = (DK > 128 ? 8 : DK / 16), NKI = DK / 64;
  const int tid = tid_fresh(), wid = tid >> 6, lane = tid & 63, r32 = lane & 31, hi = lane >> 5;
  char* V_lds = lds; char* K_lds = lds + 2 * SHM_V;
  float* ws = (float*)(lds + 2 * SHM_V + 2 * SHM_K) + wid * 64; float* li_l = ws;
  float l_reg = 0; f32x16 o[4] = {}; bf16x8 qr[NQ];
  const unsigned short* Qw = Qb + (wid * QBLK + r32) * ldq + hi * 8;
#pragma unroll
  for (int d0 = 0; d0 < NQ; ++d0) qr[d0] = *reinterpret_cast<const bf16x8*>(Qw + d0 * 16);
  int qxo = 2 * SHM_V + 2 * SHM_K + NW * 64 * 4 + wid * 4096 + lane * 16; char* qx = lds + qxo;
  if constexpr (DK > 128) {
#pragma unroll
    for (int d0 = 8; d0 < DK / 16; ++d0) *reinterpret_cast<bf16x8*>(qx + (d0 - 8) * 1024) = *reinterpret_cast<const bf16x8*>(Qw + d0 * 16);
  }
  const int sr = tid >> 4, sc = (tid & 15) * 8, vst0 = v_st(sr, sc);
  const int vgo = sr * ldv + sc;
  const int kr = tid >> 3, kc8 = tid & 7, kgo = kr * ldk + kc8 * 8, kdst = kswz<DK>(kr, kc8 * 16);
  const int vb0 = (int)(uintptr_t)V_lds + v_rd_base(lane);
  bf16x8 vs0, vs1, ks[NKI];
#define ATT_SLOAD1(k0) do { const unsigned short* vt_ = Vh + (size_t)(k0) * ldv; const unsigned short* kt_ = Kh + (size_t)(k0) * ldk; \
    vs0 = *reinterpret_cast<const bf16x8*>(vt_ + vgo); vs1 = *reinterpret_cast<const bf16x8*>(vt_ + vgo + 32 * ldv); \
    _Pragma("unroll") for (int q_ = 0; q_ < NKI; ++q_) ks[q_] = *reinterpret_cast<const bf16x8*>(kt_ + kgo + 64 * q_); } while (0)
#define ATT_SWRITE1(b) do { *(bf16x8*)(V_lds + (b) * SHM_V + vst0) = vs0; *(bf16x8*)(V_lds + (b) * SHM_V + vst0 + 8192) = vs1; \
    _Pragma("unroll") for (int q_ = 0; q_ < NKI; ++q_) *(bf16x8*)(K_lds + (b) * SHM_K + kdst + 128 * q_) = ks[q_]; } while (0)
  const int NT = seq / KVBLK;
  ATT_SLOAD1(0); ATT_SWRITE1(0); __syncthreads();
#pragma unroll 1
  for (int j = 0; j < NT; ++j) {
    const int b = j & 1;
    f32x16 p0, p1; bf16x8 pa0, pa1, pa2, pa3;
    if (j + 1 < NT) ATT_SLOAD1((j + 1) * KVBLK);
    if constexpr (DK > 128) asm volatile("" : "+v"(qxo));
    ATT_SBAR();
    qk_half<DK>(p0, K_lds + b * SHM_K, 0, qr, lds, qxo, r32, hi);
    ATT_SBAR();
    qk_half<DK>(p1, K_lds + b * SHM_K, 32, qr, lds, qxo, r32, hi);
    float ps = exp_pack(p0, pa0, pa1);
    ATT_SBAR();
    pv_half<0>(o, vb0 + b * SHM_V, pa0, pa1);
    ps += exp_pack(p1, pa2, pa3);
    ATT_SBAR();
    pv_half<1>(o, vb0 + b * SHM_V, pa2, pa3);
    l_reg += ps;
    if (j + 1 < NT) ATT_SWRITE1(b ^ 1);
    __syncthreads();
  }
  { auto rr = __builtin_amdgcn_permlane32_swap(__float_as_uint(l_reg), __float_as_uint(l_reg), false, false); l_reg = __uint_as_float(rr[0]) + __uint_as_float(rr[1]); }
  if (hi == 0) li_l[r32] = l_reg; asm volatile("s_waitcnt lgkmcnt(0)" ::: "memory");
  float rli[16];
#pragma unroll
  for (int r = 0; r < 16; ++r) rli[r] = __builtin_amdgcn_rcpf(li_l[crow(r, hi)]);
  unsigned short* Ow = Ob + (wid * QBLK) * ldo;
#pragma unroll
  for (int r = 0; r < 16; ++r) { int orow = crow(r, hi);
#pragma unroll
    for (int d0 = 0; d0 < 4; ++d0) Ow[orow * ldo + d0 * 32 + r32] = (unsigned short)f2bf(o[d0][r] * rli[r]); }
  __syncthreads();
#undef ATT_SLOAD1
#undef ATT_SWRITE1
}

typedef float f32x4a __attribute__((ext_vector_type(4)));
__device__ __forceinline__ int v16_st(int key, int d) { return (((key >> 4) * 8 + (d >> 4)) * 4 + ((key >> 2) & 3)) * 128 + ((key & 3) * 16 + (d & 15)) * 2; }
template <int OFF> __device__ __forceinline__ s16x4 tr_read16(int vb) { s16x4 r; asm volatile("ds_read_b64_tr_b16 %0, %1 offset:%2" : "=&v"(r) : "v"(vb), "i"(OFF) : "memory"); return r; }
template <int DK, int ldq, int ldk, int ldv, int ldo>
__device__ __forceinline__ void attn_body16(const unsigned short* __restrict__ Qb, const unsigned short* __restrict__ Kh,
                                            const unsigned short* __restrict__ Vh, unsigned short* __restrict__ Ob, int seq, char* lds) {
  constexpr int SHM_V = KVBLK * DV * 2, KP = 2 * DK + 16, SHM_K = KVBLK * KP, NDS = DK / 32, NKI = DK / 64;
  const int tid = tid_fresh(), wid = tid >> 6, lane = tid & 63, c16 = lane & 15, g = lane >> 4;
  char* V_lds = lds; char* K_lds = lds + 2 * SHM_V;
  f32x4a ot[8][2]; float lsum[2] = {0.f, 0.f}; bf16x8 qf[2][NDS];
#pragma unroll
  for (int db = 0; db < 8; ++db) { ot[db][0] = (f32x4a){0.f, 0.f, 0.f, 0.f}; ot[db][1] = (f32x4a){0.f, 0.f, 0.f, 0.f}; }
#pragma unroll
  for (int qb = 0; qb < 2; ++qb)
#pragma unroll
    for (int ds = 0; ds < NDS; ++ds) qf[qb][ds] = *reinterpret_cast<const bf16x8*>(Qb + (wid * QBLK + 16 * qb + c16) * ldq + 32 * ds + 8 * g);
  const int sr = tid >> 4, sc = (tid & 15) * 8, vst0 = v16_st(sr, sc), vst1 = v16_st(32 + sr, sc);
  const int vgo = sr * ldv + sc;
  const int kr = tid >> 3, kc8 = tid & 7, kgo = kr * ldk + kc8 * 8, kdst = kr * KP + kc8 * 16;
  const int kfo = c16 * KP + 16 * g;
  const int vb0 = (int)(uintptr_t)V_lds + g * 128 + 8 * c16;
  bf16x8 vs0, vs1, ks[NKI];
#define A16_SLOAD(k0) do { const unsigned short* vt_ = Vh + (size_t)(k0) * ldv; const unsigned short* kt_ = Kh + (size_t)(k0) * ldk; \
    vs0 = *reinterpret_cast<const bf16x8*>(vt_ + vgo); vs1 = *reinterpret_cast<const bf16x8*>(vt_ + vgo + 32 * ldv); \
    _Pragma("unroll") for (int q_ = 0; q_ < NKI; ++q_) ks[q_] = *reinterpret_cast<const bf16x8*>(kt_ + kgo + 64 * q_); } while (0)
#define A16_SWRITE(b) do { *(bf16x8*)(V_lds + (b) * SHM_V + vst0) = vs0; *(bf16x8*)(V_lds + (b) * SHM_V + vst1) = vs1; \
    _Pragma("unroll") for (int q_ = 0; q_ < NKI; ++q_) *(bf16x8*)(K_lds + (b) * SHM_K + kdst + 128 * q_) = ks[q_]; } while (0)
  const int NT = seq / KVBLK;
  A16_SLOAD(0); A16_SWRITE(0); __syncthreads();
#pragma unroll 1
  for (int j = 0; j < NT; ++j) {
    const int b = j & 1;
    if (j + 1 < NT) A16_SLOAD((j + 1) * KVBLK);
    ATT_SBAR();
    f32x4a sct[4][2];
#pragma unroll
    for (int kb = 0; kb < 4; ++kb) { sct[kb][0] = (f32x4a){0.f, 0.f, 0.f, 0.f}; sct[kb][1] = (f32x4a){0.f, 0.f, 0.f, 0.f}; }
    const char* Kt = K_lds + b * SHM_K + kfo;
#pragma unroll
    for (int ds = 0; ds < NDS; ++ds)
#pragma unroll
      for (int kb = 0; kb < 4; ++kb) { const bf16x8 kf = *reinterpret_cast<const bf16x8*>(Kt + kb * 16 * KP + ds * 64);
        sct[kb][0] = __builtin_amdgcn_mfma_f32_16x16x32_bf16(kf, qf[0][ds], sct[kb][0], 0, 0, 0);
        sct[kb][1] = __builtin_amdgcn_mfma_f32_16x16x32_bf16(kf, qf[1][ds], sct[kb][1], 0, 0, 0); }
    ATT_SBAR();
    bf16x8 pf[2][2];
#pragma unroll
    for (int qb = 0; qb < 2; ++qb) {
#pragma unroll
      for (int kb = 0; kb < 4; ++kb) {
#pragma unroll
        for (int i = 0; i < 4; ++i) sct[kb][qb][i] = __builtin_amdgcn_exp2f(sct[kb][qb][i]);
        lsum[qb] += (sct[kb][qb][0] + sct[kb][qb][1]) + (sct[kb][qb][2] + sct[kb][qb][3]); }
#pragma unroll
      for (int ksp = 0; ksp < 2; ++ksp) { u32x4 w; w.x = cvtpk(sct[2 * ksp][qb][0], sct[2 * ksp][qb][1]); w.y = cvtpk(sct[2 * ksp][qb][2], sct[2 * ksp][qb][3]);
        w.z = cvtpk(sct[2 * ksp + 1][qb][0], sct[2 * ksp + 1][qb][1]); w.w = cvtpk(sct[2 * ksp + 1][qb][2], sct[2 * ksp + 1][qb][3]); pf[qb][ksp] = __builtin_bit_cast(bf16x8, w); } }
    ATT_SBAR();
    const int vb = vb0 + b * SHM_V;
#define A16_PV(KSP, DB0) do { s16x4 t_[4][2]; \
      t_[0][0] = tr_read16<(2 * KSP) * 4096 + (DB0 + 0) * 512>(vb); t_[0][1] = tr_read16<(2 * KSP + 1) * 4096 + (DB0 + 0) * 512>(vb); \
      t_[1][0] = tr_read16<(2 * KSP) * 4096 + (DB0 + 1) * 512>(vb); t_[1][1] = tr_read16<(2 * KSP + 1) * 4096 + (DB0 + 1) * 512>(vb); \
      t_[2][0] = tr_read16<(2 * KSP) * 4096 + (DB0 + 2) * 512>(vb); t_[2][1] = tr_read16<(2 * KSP + 1) * 4096 + (DB0 + 2) * 512>(vb); \
      t_[3][0] = tr_read16<(2 * KSP) * 4096 + (DB0 + 3) * 512>(vb); t_[3][1] = tr_read16<(2 * KSP + 1) * 4096 + (DB0 + 3) * 512>(vb); \
      asm volatile("s_waitcnt lgkmcnt(0)" ::: "memory"); ATT_SBAR(); \
      _Pragma("unroll") for (int d_ = 0; d_ < 4; ++d_) { const bf16x8 vf = (bf16x8){t_[d_][0][0], t_[d_][0][1], t_[d_][0][2], t_[d_][0][3], t_[d_][1][0], t_[d_][1][1], t_[d_][1][2], t_[d_][1][3]}; \
        ot[DB0 + d_][0] = __builtin_amdgcn_mfma_f32_16x16x32_bf16(vf, pf[0][KSP], ot[DB0 + d_][0], 0, 0, 0); \
        ot[DB0 + d_][1] = __builtin_amdgcn_mfma_f32_16x16x32_bf16(vf, pf[1][KSP], ot[DB0 + d_][1], 0, 0, 0); } ATT_SBAR(); } while (0)
    A16_PV(0, 0); A16_PV(0, 4); A16_PV(1, 0); A16_PV(1, 4);
#undef A16_PV
    if (j + 1 < NT) A16_SWRITE(b ^ 1);
    __syncthreads();
  }
#pragma unroll
  for (int qb = 0; qb < 2; ++qb) { float l = lsum[qb]; l += __shfl_xor(l, 16); l += __shfl_xor(l, 32); const float rl = __builtin_amdgcn_rcpf(l);
    unsigned short* Or = Ob + (wid * QBLK + 16 * qb + c16) * ldo + 4 * g;
#pragma unroll
    for (int db = 0; db < 8; ++db) { typedef unsigned u32x2a __attribute__((ext_vector_type(2)));
      u32x2a w; w.x = pk2(ot[db][qb][0] * rl, ot[db][qb][1] * rl); w.y = pk2(ot[db][qb][2] * rl, ot[db][qb][3] * rl);
      *(u32x2a*)(Or + 16 * db) = w; } }
  __syncthreads();
#undef A16_SLOAD
#undef A16_SWRITE
}
#undef ATT_SBAR
}
namespace hy {
using bf16x8 = __attribute__((ext_vector_type(8))) short;
using f32x16 = __attribute__((ext_vector_type(16))) float;
using u32x4  = __attribute__((ext_vector_type(4))) unsigned;
using u32x2  = __attribute__((ext_vector_type(2))) unsigned;
template <int L> struct HC {
    static constexpr int NMB = L / 2048, NCH = (L == 4096) ? 2 : 4, UST = L + 160, GRN = 2 * L / 64 * 72;
    static constexpr int UB = 4 * UST * 2, GB = GRN * 2, CHB = UB + GB, NK4 = L / 64 + 1;
    static_assert(NCH * CHB <= RING_BYTES, "hyena LDS");
};
__device__ __forceinline__ int crow(int r, int hi) { return (r & 3) + 8 * (r >> 2) + 4 * hi; }
__device__ __forceinline__ float bf2f(unsigned short v) { return __uint_as_float((unsigned)v << 16); }

typedef float f32x4h __attribute__((ext_vector_type(4)));
template <int L>
__device__ __forceinline__ void conv_kloop16(f32x4h (&acc)[2][8], const LAS char* gA, const LAS char* uB) {
    constexpr int NK2 = L / 64 + 1;
#pragma unroll
    for (int a = 0; a < 2; ++a)
#pragma unroll
        for (int r = 0; r < 8; ++r) acc[a][r] = (f32x4h){0.f, 0.f, 0.f, 0.f};
    for (int kk2 = 0; kk2 < NK2; ++kk2) {
#pragma unroll
        for (int h = 0; h < 2; ++h) {
            const bf16x8 A = *(const LAS bf16x8*)(gA + kk2 * 144 + h * 64);
#pragma unroll
            for (int nh = 0; nh < 2; ++nh) {
                const u32x4 w0 = *(const LAS u32x4*)(uB + kk2 * 128 + h * 64 + nh * 64);
                const u32x4 w1 = *(const LAS u32x4*)(uB + kk2 * 128 + h * 64 + nh * 64 + 16);
                const unsigned w[8] = {w0.x, w0.y, w0.z, w0.w, w1.x, w1.y, w1.z, w1.w};
#pragma unroll
                for (int r = 0; r < 8; ++r) { u32x4 bf;
                    if ((r & 1) == 0) { const int q = r >> 1; bf = (u32x4){w[q], w[q + 1], w[q + 2], w[q + 3]}; }
                    else { const int q = (r - 1) >> 1;
                        bf = (u32x4){__builtin_amdgcn_alignbit(w[q + 1], w[q], 16), __builtin_amdgcn_alignbit(w[q + 2], w[q + 1], 16),
                                     __builtin_amdgcn_alignbit(w[q + 3], w[q + 2], 16), __builtin_amdgcn_alignbit(w[q + 4], w[q + 3], 16)}; }
                    acc[nh][r] = __builtin_amdgcn_mfma_f32_16x16x32_bf16(A, __builtin_bit_cast(bf16x8, bf), acc[nh][r], 0, 0, 0); }
            }
        }
    }
}

template <int L>
__device__ __forceinline__ void hyena_unit(LAS char* lds, const unsigned short* GFl, const unsigned short* X1T, const unsigned short* X2T, const unsigned short* VT,
                                           unsigned short* Y2T, const float* skip  , int b0, int c0) {
    using C = HC<L>;
    constexpr int NCH = C::NCH, UST = C::UST, GRN = C::GRN, UB = C::UB, GB = C::GB, CHB = C::CHB, WPC = 8 / NCH;
    static_assert(L / 1024 == WPC, "one wave per (channel, 1024-output block)");
    const int tid = tid_fresh(), wid = __builtin_amdgcn_readfirstlane(tid >> 6), lane = tid & 63;
    const int ch = wid / WPC, Mb = wid % WPC;
    const int c16 = lane & 15, g = lane >> 4, np = c16 >> 2, bb = c16 & 3;
    LAS char* Uch = lds + ch * CHB; LAS char* Gch = Uch + UB;
    const LAS char* gA = Gch + 2 * ((L / 64 - 16 * Mb - c16 - 1) * 72 + 8 * g);
    const LAS char* uB = Uch + 2 * (bb * UST + 8 * g + 8 * np);
    const int c = c0 + ch;
    u32x4 y1p[2][4];
#pragma unroll 1
    for (int o = 0; o < 2; ++o) {
        { constexpr int NG = NCH * (GB / 16), NGI = (NG + NTHR - 1) / NTHR; u32x4 gv[NGI];
#pragma unroll
          for (int i = 0; i < NGI; ++i) { const int id = tid + i * NTHR, cc = id / (GB / 16), off = id % (GB / 16);
              gv[i] = (id < NG) ? *(const u32x4*)((const char*)(GFl + ((size_t)(o * 512 + c0 + cc)) * GRN) + off * 16) : (u32x4){0u, 0u, 0u, 0u}; }
          if (o == 0) {
              constexpr int NU = NCH * 4 * (L / 8), NUI = NU / NTHR; static_assert(NU % NTHR == 0, "u staging"); u32x4 uv_[NUI];
#pragma unroll
              for (int i = 0; i < NUI; ++i) { const int id = tid + i * NTHR, cb = id / (L / 8), off = id % (L / 8), cc = cb >> 2, b = cb & 3;
                  uv_[i] = *(const u32x4*)(VT + xt_off(b0 + b, c0 + cc) + off * 8); }
#pragma unroll
              for (int i = 0; i < NUI; ++i) { const int id = tid + i * NTHR, cb = id / (L / 8), off = id % (L / 8), cc = cb >> 2, b = cb & 3;
                  *(LAS u32x4*)(lds + cc * CHB + (b * UST + 64) * 2 + off * 16) = uv_[i]; }
              for (int id = tid; id < NCH * 4 * 20; id += NTHR) { const int cb = id / 20, k = id % 20, cc = cb >> 2, b = cb & 3;
                  const int el = k < 8 ? k * 8 : (L + 64) + (k - 8) * 8;
                  *(LAS u32x4*)(lds + cc * CHB + (b * UST + el) * 2) = (u32x4){0u, 0u, 0u, 0u}; }
          }
#pragma unroll
          for (int i = 0; i < NGI; ++i) { const int id = tid + i * NTHR, cc = id / (GB / 16), off = id % (GB / 16);
              if (id < NG) *(LAS u32x4*)(lds + cc * CHB + UB + off * 16) = gv[i]; } }
        if (o == 1) {
#pragma unroll
            for (int nh = 0; nh < 2; ++nh)
#pragma unroll
                for (int i = 0; i < 4; ++i) { const int t0 = 1024 * Mb + 64 * (4 * g + i) + 32 * nh + 8 * np;
                    *(LAS u32x4*)(Uch + (bb * UST + 64 + t0) * 2) = y1p[nh][i]; }
        }
        __syncthreads();
        f32x4h acc[2][8];
        conv_kloop16<L>(acc, gA, uB);
        const float sk = skip[o * 512 + c];
        const unsigned short* XT = (o == 0) ? X1T : X2T;
        const size_t gbase = xt_off(b0 + bb, c);
        u32x4 xvs[2][4];
#pragma unroll
        for (int nh = 0; nh < 2; ++nh)
#pragma unroll
            for (int i = 0; i < 4; ++i) { const int t0 = 1024 * Mb + 64 * (4 * g + i) + 32 * nh + 8 * np; xvs[nh][i] = *(const u32x4*)(XT + gbase + t0); }
#pragma unroll
        for (int nh = 0; nh < 2; ++nh)
#pragma unroll
            for (int i = 0; i < 4; ++i) { const int t0 = 1024 * Mb + 64 * (4 * g + i) + 32 * nh + 8 * np;
                const u32x4 xv = xvs[nh][i];
                const u32x4 uv = *(const LAS u32x4*)(Uch + (bb * UST + 64 + t0) * 2);
                const unsigned xw[4] = {xv.x, xv.y, xv.z, xv.w}, uw[4] = {uv.x, uv.y, uv.z, uv.w}; unsigned pw[4];
#pragma unroll
                for (int q = 0; q < 4; ++q) {
                    const float ylo = bf2f((unsigned short)(xw[q] & 0xffff)) * (acc[nh][2 * q][i] + sk * bf2f((unsigned short)(uw[q] & 0xffff)));
                    const float yhi = bf2f((unsigned short)(xw[q] >> 16)) * (acc[nh][2 * q + 1][i] + sk * bf2f((unsigned short)(uw[q] >> 16)));
                    pw[q] = pk2(ylo, yhi); }
                const u32x4 p = (u32x4){pw[0], pw[1], pw[2], pw[3]};
                if (o == 0) y1p[nh][i] = p;
                else *(u32x4*)(Y2T + gbase + t0) = p; }
        __syncthreads();
    }
}
}
typedef unsigned u32x2v __attribute__((ext_vector_type(2)));
__device__ __forceinline__ float bf2f(unsigned short v) { return __uint_as_float((unsigned)v << 16); }
__device__ __forceinline__ float bflo(unsigned w) { return __uint_as_float(w << 16); }
__device__ __forceinline__ float bfhi(unsigned w) { return __uint_as_float(w & 0xffff0000u); }
__device__ __forceinline__ float wave_sum(float v) {
#pragma unroll
    for (int o = 1; o < 64; o <<= 1) v += __shfl_xor(v, o);
    return v;
}
__device__ __forceinline__ void unpack8(const v4u& w, float (&f)[8]) {
    f[0] = bflo(w.x); f[1] = bfhi(w.x); f[2] = bflo(w.y); f[3] = bfhi(w.y); f[4] = bflo(w.z); f[5] = bfhi(w.z); f[6] = bflo(w.w); f[7] = bfhi(w.w);
}
__device__ __forceinline__ v4u pack8(const float (&f)[8]) { v4u w; w.x = pk2(f[0], f[1]); w.y = pk2(f[2], f[3]); w.z = pk2(f[4], f[5]); w.w = pk2(f[6], f[7]); return w; }

__device__ __forceinline__ void norm_rows(const float* xa, const float* xb, const float* g, const float* mod  , int sh_off, int sc_off, bf16* H, int gw, int ngw, int lane) {
    for (int ck = gw; ck < NTOK / 4; ck += ngw) {
        const int row0 = ck * 4, b = row_batch(row0);
        const float* xin = row0 < NPR ? xa : xb;
        const float* sc = mod + (size_t)b * MODW + sc_off; const float* sh = mod + (size_t)b * MODW + sh_off;
        f32x4 ga[8], sb[8];
#pragma unroll
        for (int j = 0; j < 8; ++j) { const int col = 4 * lane + 256 * j; const f32x4 gg = *(const f32x4*)(g + col), s1 = *(const f32x4*)(sc + col);
            ga[j] = gg * (s1 + 1.0f); sb[j] = *(const f32x4*)(sh + col); }
#pragma unroll 1
        for (int r = 0; r < 4; ++r) {
            const float* xr = xin + (size_t)(row0 + r) * DM;
            f32x4 v[8]; float ss = 0.f;
#pragma unroll
            for (int j = 0; j < 8; ++j) { v[j] = *(const f32x4*)(xr + 4 * lane + 256 * j); ss += (v[j].x * v[j].x + v[j].y * v[j].y) + (v[j].z * v[j].z + v[j].w * v[j].w); }
            const float rs = rsqrtf(wave_sum(ss) * (1.0f / DM) + EPS);
            bf16* hr = H + (size_t)(row0 + r) * DM;
#pragma unroll
            for (int j = 0; j < 8; ++j) { const f32x4 o = v[j] * rs * ga[j] + sb[j]; u32x2v w; w.x = pk2(o.x, o.y); w.y = pk2(o.z, o.w);
                *(u32x2v*)(hr + 4 * lane + 256 * j) = w; }
        }
    }
}

struct PostIn { v4u v, qa, ckv, h1, h2; };
__device__ __forceinline__ PostIn post_load(const bf16* P, int lane) {
    PostIn in; const int head = lane >> 3, sub = lane & 7, sec = sub >> 2, chk = sub & 3, hh = head < 6 ? head : 0;
    in.v = *(const v4u*)(P + 512 + 8 * lane); in.qa = *(const v4u*)(P + C_D + 8 * lane); in.ckv = *(const v4u*)(P + C_D + 512 + 8 * (lane & 31));
    const bf16* hp = P + C_C + hh * 128 + 64 * sec + 8 * chk; in.h1 = *(const v4u*)hp; in.h2 = *(const v4u*)(hp + 32); return in;
}
__device__ __forceinline__ void post_finish(const PostIn& in, bf16* P, int pos, const float* vng, const float* qng, const float* kng, const float* qag, const float* kvag, int lane, bool st = true) {
    { float f[8]; unpack8(in.v, f);
      float s = 0.f;
#pragma unroll
      for (int i = 0; i < 8; ++i) s += f[i];
      const float mean = wave_sum(s) * (1.0f / 512.0f); float q = 0.f;
#pragma unroll
      for (int i = 0; i < 8; ++i) { f[i] -= mean; q += f[i] * f[i]; }
      const float rs = rsqrtf(wave_sum(q) * (1.0f / 512.0f) + EPS);
      const f32x4 g0 = *(const f32x4*)(vng + 8 * lane), g1 = *(const f32x4*)(vng + 8 * lane + 4);
      f[0] *= rs * g0.x; f[1] *= rs * g0.y; f[2] *= rs * g0.z; f[3] *= rs * g0.w; f[4] *= rs * g1.x; f[5] *= rs * g1.y; f[6] *= rs * g1.z; f[7] *= rs * g1.w;
      if (st) *(v4u*)(P + 512 + 8 * lane) = pack8(f); }
    { float f[8]; unpack8(in.qa, f); float q = 0.f;
#pragma unroll
      for (int i = 0; i < 8; ++i) q += f[i] * f[i];
      const float rs = rsqrtf(wave_sum(q) * (1.0f / 512.0f) + EPS);
#pragma unroll
      for (int i = 0; i < 8; ++i) f[i] *= rs * qag[8 * lane + i];
      if (st) *(v4u*)(P + C_D + 8 * lane) = pack8(f); }
    { const int l32 = lane & 31; float f[8]; unpack8(in.ckv, f); float q = 0.f;
#pragma unroll
      for (int i = 0; i < 8; ++i) q += f[i] * f[i];
      const float rs = rsqrtf(wave_sum(q) * (0.5f / 256.0f) + EPS);
#pragma unroll
      for (int i = 0; i < 8; ++i) f[i] *= rs * kvag[8 * l32 + i];
      if (st && lane < 32) *(v4u*)(P + C_D + 512 + 8 * l32) = pack8(f); }
    { const int head = lane >> 3, sub = lane & 7, sec = sub >> 2, chk = sub & 3; const bool on = head < 6;
      const int hh = on ? head : 0;
      bf16* hp = P + C_C + hh * 128 + 64 * sec + 8 * chk;
      float a[8], c[8]; unpack8(in.h1, a); unpack8(in.h2, c);
      float q = 0.f;
#pragma unroll
      for (int i = 0; i < 8; ++i) q += a[i] * a[i] + c[i] * c[i];
      q += __shfl_xor(q, 1); q += __shfl_xor(q, 2); q += __shfl_xor(q, 4);
      const float rs = rsqrtf(q * (1.0f / 128.0f) + EPS);
      const float* gg = (hh < 4 ? qng : kng) + 64 * sec + 8 * chk;
      const float p = (float)(sec ? (pos & 63) : (pos >> 6));
#pragma unroll
      for (int i = 0; i < 8; ++i) {
          const float x1 = a[i] * rs * gg[i], x2 = c[i] * rs * gg[32 + i];
          const float inv = __expf(-(float)(2 * (8 * chk + i)) * (9.210340371976184f / 64.0f));
          float sn, cs; __sincosf(p * inv, &sn, &cs);
          const float qs = (hh < 4) ? 0.12751743082459868f : 1.0f;
          a[i] = (x1 * cs - x2 * sn) * qs; c[i] = (x2 * cs + x1 * sn) * qs; }
      if (st && on) { *(v4u*)hp = pack8(a); *(v4u*)(hp + 32) = pack8(c); } }
}
__device__ __forceinline__ void post_rows(bf16* PROJp, const float* vng, const float* qng, const float* kng, const float* qag, const float* kvag, int gw, int ngw, int lane, bool st) {
    int row = gw; if (row >= NTOK) return;
    PostIn cur = post_load(PROJp + (size_t)row * INCP, lane);
    for (; row < NTOK; row += ngw) { const int nr = row + ngw; PostIn nxt = cur;
        if (nr < NTOK) nxt = post_load(PROJp + (size_t)nr * INCP, lane);
        post_finish(cur, PROJp + (size_t)row * INCP, row_pos(row), vng, qng, kng, qag, kvag, lane, st); cur = nxt; }
}

struct MlaIn { v4u n[2], a[2], c[2]; };
__device__ __forceinline__ MlaIn mla_load(const bf16* Qr, const bf16* KVr, const bf16* krope, int lane) {
    MlaIn in; const int head = lane >> 4, sub = lane & 15; const bool rp = sub < 4; const int sec = (sub >> 1) & 1, chk = sub & 1, x1o = 128 + 32 * sec + 8 * chk;
    in.n[0] = *(const v4u*)(Qr + head * 192 + 8 * sub); in.n[1] = *(const v4u*)(KVr + head * 256 + 8 * sub);
    in.a[0] = in.c[0] = in.a[1] = in.c[1] = (v4u){0u, 0u, 0u, 0u};
    if (rp) { in.a[0] = *(const v4u*)(Qr + head * 192 + x1o); in.c[0] = *(const v4u*)(Qr + head * 192 + x1o + 16);
              in.a[1] = *(const v4u*)(krope + 32 * sec + 8 * chk); in.c[1] = *(const v4u*)(krope + 32 * sec + 8 * chk + 16); }
    return in;
}
__device__ __forceinline__ void mla_finish(const MlaIn& in, bf16* Qr, bf16* Kr, int pos, const float* qng, const float* kng, int lane, bool st = true) {
    const int head = lane >> 4, sub = lane & 15;
    const bool rp = sub < 4; const int sec = (sub >> 1) & 1, chk = sub & 1;
    const int x1o = 128 + 32 * sec + 8 * chk;
    const float p = (float)(sec ? (pos & 63) : (pos >> 6));
#pragma unroll
    for (int which = 0; which < 2; ++which) {
        const float* g = which == 0 ? qng : kng;
        bf16* dst = (which == 0 ? Qr : Kr) + head * 192;
        float n[8], a[8], c[8]; unpack8(in.n[which], n); unpack8(in.a[which], a); unpack8(in.c[which], c);
        float q = 0.f;
#pragma unroll
        for (int i = 0; i < 8; ++i) q += n[i] * n[i] + a[i] * a[i] + c[i] * c[i];
        q += __shfl_xor(q, 1); q += __shfl_xor(q, 2); q += __shfl_xor(q, 4); q += __shfl_xor(q, 8);
        const float rs = rsqrtf(q * (1.0f / 192.0f) + EPS);
        const float qs = (which == 0) ? 0.10411755155693222f : 1.0f;
#pragma unroll
        for (int i = 0; i < 8; ++i) n[i] *= rs * g[8 * sub + i] * qs;
        if (st) *(v4u*)(dst + 8 * sub) = pack8(n);
        if (rp) {
#pragma unroll
            for (int i = 0; i < 8; ++i) {
                const float x1 = a[i] * rs * g[x1o + i], x2 = c[i] * rs * g[x1o + 16 + i];
                const float inv = __expf(-(float)(2 * (8 * chk + i)) * (9.210340371976184f / 32.0f));
                float sn, cs; __sincosf(p * inv, &sn, &cs);
                a[i] = (x1 * cs - x2 * sn) * qs; c[i] = (x2 * cs + x1 * sn) * qs; }
            if (st) { *(v4u*)(dst + x1o) = pack8(a); *(v4u*)(dst + x1o + 16) = pack8(c); } }
    }
}
__device__ __forceinline__ void mla_rows(bf16* QDp, const bf16* KVDp, const bf16* PROJp, bf16* KMp, const float* qng, const float* kng, int gw, int ngw, int lane, bool st) {
    int row = gw; if (row >= NTOK) return;
    MlaIn cur = mla_load(QDp + (size_t)row * 768, KVDp + (size_t)row * 1024, PROJp + (size_t)row * INCP + C_D + 768, lane);
    for (; row < NTOK; row += ngw) { const int nr = row + ngw; MlaIn nxt = cur;
        if (nr < NTOK) nxt = mla_load(QDp + (size_t)nr * 768, KVDp + (size_t)nr * 1024, PROJp + (size_t)nr * INCP + C_D + 768, lane);
        mla_finish(cur, QDp + (size_t)row * 768, KMp + (size_t)row * 768, row_pos(row), qng, kng, lane, st); cur = nxt; }
}

__device__ __forceinline__ void hyconv_tile(LAS unsigned char* lds, const bf16* PROJ, bf16* XT, const float* cw  , const float* cb  , int tile, int tid) {
    const int which = tile % 3, tb = tile / 3, row0 = tb * 64, b = row_batch(row0), pos0 = row_pos(row0), Lb = batch_len(b);
    constexpr int PITCH = 260;
    LAS unsigned* raw = (LAS unsigned*)lds;
    { v4u w[9];
#pragma unroll
      for (int i = 0; i < 9; ++i) { const int id = tid + i * NTHR, r = id >> 6, k = id & 63, p = pos0 - 1 + r;
          w[i] = (v4u){0u, 0u, 0u, 0u};
          if (id < 66 * 64 && p >= 0 && p < Lb) w[i] = *(const v4u*)(PROJ + (size_t)(row0 - 1 + r) * INCP + C_B + which * 512 + 8 * k); }
#pragma unroll
      for (int i = 0; i < 9; ++i) { const int id = tid + i * NTHR, r = id >> 6, k = id & 63;
          if (id < 66 * 64) *(LAS v4u*)(raw + r * PITCH + 4 * k) = w[i]; } }
    __syncthreads();
    { const int c = tid, col = which * 512 + c; const float w0 = cw[col], w1 = cw[1536 + col], w2 = cw[3072 + col], bb = cb[col];
      const LAS unsigned short* rc = (const LAS unsigned short*)raw + c;
      bf16* dst = XT + (size_t)which * ((size_t)NTOK * 512) + xt_off(b, c) + pos0;
      float xm = bf2f(rc[0]), x0 = bf2f(rc[2 * PITCH]);
#pragma unroll 2
      for (int k = 0; k < 8; ++k) { float z[8];
#pragma unroll
          for (int i = 0; i < 8; ++i) { const float xp = bf2f(rc[(8 * k + i + 2) * 2 * PITCH]); z[i] = w0 * xm + w1 * x0 + w2 * xp + bb; xm = x0; x0 = xp; }
          *(v4u*)(dst + 8 * k) = pack8(z); } }
    __syncthreads();
}

__device__ __forceinline__ void gnorm_tile(LAS unsigned char* lds, const bf16* __restrict__ YCAT, const bf16* __restrict__ Y2T, const float* __restrict__ gg  , bf16* __restrict__ YN, int tile, int tid) {
    const int row0 = tile * 32, b = row_batch(row0), pos0 = row_pos(row0), lane = tid & 63, wid = tid >> 6;
    constexpr int PITCH = 17;
    LAS unsigned* yb = (LAS unsigned*)lds;
    { v4u yw[4];
#pragma unroll
      for (int i = 0; i < 4; ++i) { const int id = tid + i * NTHR, c = id >> 2, k = id & 3; yw[i] = *(const v4u*)(Y2T + xt_off(b, c) + pos0 + 8 * k); }
#pragma unroll
      for (int i = 0; i < 4; ++i) { const int id = tid + i * NTHR, c = id >> 2, k = id & 3; LAS unsigned* d = yb + c * PITCH + 4 * k; d[0] = yw[i].x; d[1] = yw[i].y; d[2] = yw[i].z; d[3] = yw[i].w; } }
    __syncthreads();
#pragma unroll 2
    for (int r = 0; r < 4; ++r) { const int t = wid * 4 + r, row = row0 + t;
        const bf16* yr = YCAT + (size_t)row * DM; bf16* on = YN + (size_t)row * DM;
#pragma unroll
        for (int grp = 0; grp < 4; ++grp) {
            if (grp == 1) {
                float f[8]; float q = 0.f;
#pragma unroll
                for (int i = 0; i < 8; ++i) { f[i] = bf2f(((const LAS unsigned short*)yb)[(lane + 64 * i) * 2 * PITCH + t]); q += f[i] * f[i]; }
                const float rs = rsqrtf(wave_sum(q) * (1.0f / 512.0f) + EPS);
#pragma unroll
                for (int i = 0; i < 8; ++i) on[512 + lane + 64 * i] = (bf16)f2bf(f[i] * rs * gg[512 + lane + 64 * i]);
            } else {
                v4u w = *(const v4u*)(yr + grp * 512 + 8 * lane); float f[8]; unpack8(w, f); float q = 0.f;
#pragma unroll
                for (int i = 0; i < 8; ++i) q += f[i] * f[i];
                const float rs = rsqrtf(wave_sum(q) * (1.0f / 512.0f) + EPS);
                const f32x4 g0 = *(const f32x4*)(gg + grp * 512 + 8 * lane), g1 = *(const f32x4*)(gg + grp * 512 + 8 * lane + 4);
                f[0] *= rs * g0.x; f[1] *= rs * g0.y; f[2] *= rs * g0.z; f[3] *= rs * g0.w; f[4] *= rs * g1.x; f[5] *= rs * g1.y; f[6] *= rs * g1.z; f[7] *= rs * g1.w;
                *(v4u*)(on + grp * 512 + 8 * lane) = pack8(f);
            }
        }
    }
    __syncthreads();
}

__device__ __forceinline__ void ffn_gate(const bf16* Z, bf16* A, const float* cw  , const float* cb  , int gt, int ngt) {
    constexpr int NCK = DFF / 8;
    for (int it = gt; it < (NTOK / 16) * NCK; it += ngt) {
        const int rb = it / NCK, ck = it % NCK, row0 = rb * 16, j0 = ck * 8;
        const int pos0 = row_pos(row0), Lb = batch_len(row_batch(row0));
        float wg[3][8], wu[3][8], bg[8], bu[8];
#pragma unroll
        for (int k = 0; k < 3; ++k)
#pragma unroll
            for (int i = 0; i < 8; ++i) { wg[k][i] = cw[k * DFF2 + j0 + i]; wu[k][i] = cw[k * DFF2 + DFF + j0 + i]; }
#pragma unroll
        for (int i = 0; i < 8; ++i) { bg[i] = cb[j0 + i]; bu[i] = cb[DFF + j0 + i]; }
        float gm[8], g0[8], um[8], u0[8];
        const bf16* zr = Z + (size_t)row0 * DFF2 + j0;
        if (pos0 > 0) { v4u a = *(const v4u*)(zr - DFF2), c = *(const v4u*)(zr - DFF2 + DFF); unpack8(a, gm); unpack8(c, um); }
        else {
#pragma unroll
            for (int i = 0; i < 8; ++i) { gm[i] = 0.f; um[i] = 0.f; } }
        { v4u a = *(const v4u*)zr, c = *(const v4u*)(zr + DFF); unpack8(a, g0); unpack8(c, u0); }
#pragma unroll 1
        for (int r = 0; r < 16; ++r) {
            float gp[8], up[8];
            if (pos0 + r + 1 < Lb) { v4u a = *(const v4u*)(zr + (size_t)(r + 1) * DFF2), c = *(const v4u*)(zr + (size_t)(r + 1) * DFF2 + DFF); unpack8(a, gp); unpack8(c, up); }
            else {
#pragma unroll
                for (int i = 0; i < 8; ++i) { gp[i] = 0.f; up[i] = 0.f; } }
            float o[8];
#pragma unroll
            for (int i = 0; i < 8; ++i) {
                const float gc = wg[0][i] * gm[i] + wg[1][i] * g0[i] + wg[2][i] * gp[i] + bg[i];
                const float uc = wu[0][i] * um[i] + wu[1][i] * u0[i] + wu[2][i] * up[i] + bu[i];
                o[i] = gc * __builtin_amdgcn_rcpf(1.0f + __expf(-gc)) * uc;
                gm[i] = g0[i]; g0[i] = gp[i]; um[i] = u0[i]; u0[i] = up[i]; }
            *(v4u*)(A + (size_t)(row0 + r) * DFF + j0) = pack8(o);
        }
    }
}

__device__ __forceinline__ void gate_fix(const float* ZH, bf16* A, const float* cw, const float* cb, int gt, int ngt) {
    constexpr int NQ4 = DFF / 4;
    for (int it = gt; it < 192 * NQ4; it += ngt) {
        const int rs = it / NQ4, q4 = it % NQ4, pm = rs >> 1, s = rs & 1, row = pm * 256 + (s ? 255 : 0), pos = row_pos(row), Lb = batch_len(row_batch(row));
        if (s == 0 ? (pos == 0) : (pos + 1 == Lb)) continue;
        const int j = q4 * 4, zc = 256 * (j >> 7) + (j & 127);
        const float* zp = s == 0 ? ZH + ((size_t)(pm - 1) * 4 + 3) * DFF2 : ZH + ((size_t)pm * 4 + 2) * DFF2;
        const float* z0 = s == 0 ? ZH + ((size_t)pm * 4 + 0) * DFF2 : ZH + ((size_t)pm * 4 + 3) * DFF2;
        const float* zn = s == 0 ? ZH + ((size_t)pm * 4 + 1) * DFF2 : ZH + ((size_t)(pm + 1) * 4 + 0) * DFF2;
        f32x4 cv[2];
#pragma unroll
        for (int h = 0; h < 2; ++h) {
            const f32x4 a = *(const f32x4*)(zp + zc + 128 * h), b = *(const f32x4*)(z0 + zc + 128 * h), c = *(const f32x4*)(zn + zc + 128 * h);
            const f32x4 w0 = *(const f32x4*)(cw + h * DFF + j), w1 = *(const f32x4*)(cw + DFF2 + h * DFF + j), w2 = *(const f32x4*)(cw + 2 * DFF2 + h * DFF + j), bb = *(const f32x4*)(cb + h * DFF + j);
            cv[h] = w0 * a + w1 * b + w2 * c + bb; }
        float o[4];
#pragma unroll
        for (int e = 0; e < 4; ++e) { const float g = cv[0][e]; o[e] = g * __builtin_amdgcn_rcpf(1.0f + __expf(-g)) * cv[1][e]; }
        u32x2v w; w.x = pk2(o[0], o[1]); w.y = pk2(o[2], o[3]);
        *(u32x2v*)(A + affn_off(row, j)) = w;
    }
}

__device__ __forceinline__ void hyconv_regs(const bf16* PROJ, bf16* XT, const float* cw  , const float* cb  , int gt, int ngt) {
    for (int it = gt; it < (NTOK / 8) * 192; it += ngt) {
        const int tb = it / 192, ck = it % 192, row0 = tb * 8, j0 = ck * 8, which = j0 >> 9, c0 = j0 & 511;
        const int b = row_batch(row0), pos0 = row_pos(row0), Lb = batch_len(b);
        float w0[8], w1[8], w2[8], bb[8];
#pragma unroll
        for (int i = 0; i < 8; i += 4) { const f32x4 a = *(const f32x4*)(cw + j0 + i), c = *(const f32x4*)(cw + 1536 + j0 + i), d = *(const f32x4*)(cw + 3072 + j0 + i), e = *(const f32x4*)(cb + j0 + i);
            w0[i] = a.x; w0[i + 1] = a.y; w0[i + 2] = a.z; w0[i + 3] = a.w; w1[i] = c.x; w1[i + 1] = c.y; w1[i + 2] = c.z; w1[i + 3] = c.w;
            w2[i] = d.x; w2[i + 1] = d.y; w2[i + 2] = d.z; w2[i + 3] = d.w; bb[i] = e.x; bb[i + 1] = e.y; bb[i + 2] = e.z; bb[i + 3] = e.w; }
        const bf16* src = PROJ + (size_t)row0 * INCP + C_B + j0;
        v4u raw[10];
        raw[0] = (pos0 > 0) ? *(const v4u*)(src - INCP) : (v4u){0u, 0u, 0u, 0u};
#pragma unroll
        for (int r = 0; r < 8; ++r) raw[r + 1] = *(const v4u*)(src + (size_t)r * INCP);
        raw[9] = (pos0 + 8 < Lb) ? *(const v4u*)(src + (size_t)8 * INCP) : (v4u){0u, 0u, 0u, 0u};
        float z[8][8]; float xm[8], x0[8], xp[8];
        unpack8(raw[0], xm); unpack8(raw[1], x0);
#pragma unroll
        for (int r = 0; r < 8; ++r) { unpack8(raw[r + 2], xp);
#pragma unroll
            for (int i = 0; i < 8; ++i) { z[r][i] = w0[i] * xm[i] + w1[i] * x0[i] + w2[i] * xp[i] + bb[i]; xm[i] = x0[i]; x0[i] = xp[i]; } }
        bf16* dst = XT + (size_t)which * ((size_t)NTOK * 512) + xt_off(b, c0) + pos0;
        const size_t cst = (size_t)Lb;
#pragma unroll
        for (int i = 0; i < 8; ++i) { v4u o; o.x = pk2(z[0][i], z[1][i]); o.y = pk2(z[2][i], z[3][i]); o.z = pk2(z[4][i], z[5][i]); o.w = pk2(z[6][i], z[7][i]);
            *(v4u*)(dst + (size_t)i * cst) = o; }
    }
}
__device__ __forceinline__ void p0_transpose_item(const float* W, int K, int N, bf16* WT, int row_off, LAS float* scr, int item, int lane) {
    const int nblk = N / 32, kb = item / nblk, nb = item % nblk, k0 = 64 * kb, n0 = 32 * nb;
#pragma unroll
    for (int i = 0; i < 32; ++i) { const int kk = 2 * i + (lane >> 5); scr[kk * 33 + (lane & 31)] = __builtin_nontemporal_load(&W[(size_t)(k0 + kk) * N + n0 + (lane & 31)]); }
    LDS_WAIT(); asm volatile("" ::: "memory");
    const int c = lane & 7;
#pragma unroll
    for (int j = 0; j < 4; ++j) { const int n = (lane >> 3) + 8 * j; const LAS float* s = scr + (8 * c) * 33 + n;
        v4u o; o.x = pk2(s[0 * 33], s[1 * 33]); o.y = pk2(s[2 * 33], s[3 * 33]); o.z = pk2(s[4 * 33], s[5 * 33]); o.w = pk2(s[6 * 33], s[7 * 33]);
        *(GAS v4u*)(WT + (size_t)(row_off + n0 + n) * K + k0 + 8 * c) = o; }
    LDS_WAIT(); asm volatile("" ::: "memory");
}
__device__ __forceinline__ void gmlp_unit(char* ldsg, const bf16* PROJ, bf16* YCAT, const float* sw  , const float* sb  , int unit, int tid) {
    using namespace att;
    const int chunk = unit >> 2, h = unit & 3, row0 = chunk * 128, lane = tid & 63, wid = __builtin_amdgcn_readfirstlane(tid >> 6), hi = lane >> 5, r32 = lane & 31;
    { bf16x8 vw[4];
#pragma unroll
      for (int i = 0; i < 4; ++i) { const int id = tid + i * NTHR, q = id >> 4, cc = (id & 15) * 8; vw[i] = *(const bf16x8*)(PROJ + (size_t)(row0 + q) * INCP + 512 + h * 128 + cc); }
#pragma unroll
      for (int i = 0; i < 4; ++i) { const int id = tid + i * NTHR, q = id >> 4, cc = (id & 15) * 8; *(bf16x8*)(ldsg + (q >> 6) * 16384 + v_st(q & 63, cc)) = vw[i]; } }
    const int pblk = wid >> 1, half = wid & 1;
    bf16x8 af[8];
    { const float* wp = sw + (size_t)h * 16384 + (32 * pblk + r32) * 128 + 8 * hi;
#pragma unroll
      for (int k = 0; k < 8; ++k) { const f32x4 a = *(const f32x4*)(wp + 16 * k), c = *(const f32x4*)(wp + 16 * k + 4);
          u32x4 w; w.x = cvtpk(a.x, a.y); w.y = cvtpk(a.z, a.w); w.z = cvtpk(c.x, c.y); w.w = cvtpk(c.z, c.w); af[k] = __builtin_bit_cast(bf16x8, w); } }
    __syncthreads();
    const int vb0 = (int)(uintptr_t)ldsg + v_rd_base(lane);
    f32x16 o0 = {}, o1 = {};
    if (half == 0) { pv_one<0>(o0, vb0, af[0], af[1], af[2], af[3]); pv_one<1>(o1, vb0, af[0], af[1], af[2], af[3]);
                     pv_one<0>(o0, vb0 + 16384, af[4], af[5], af[6], af[7]); pv_one<1>(o1, vb0 + 16384, af[4], af[5], af[6], af[7]); }
    else           { pv_one<2>(o0, vb0, af[0], af[1], af[2], af[3]); pv_one<3>(o1, vb0, af[0], af[1], af[2], af[3]);
                     pv_one<2>(o0, vb0 + 16384, af[4], af[5], af[6], af[7]); pv_one<3>(o1, vb0 + 16384, af[4], af[5], af[6], af[7]); }
    float* st = (float*)(ldsg + 32768) + wid * (32 * 68);
#pragma unroll
    for (int q = 0; q < 16; ++q) { const int pr = crow(q, hi); const float bs = sb[h * 128 + 32 * pblk + pr];
        st[pr * 68 + r32] = o0[q] + bs; st[pr * 68 + 32 + r32] = o1[q] + bs; }
    asm volatile("s_waitcnt lgkmcnt(0)" ::: "memory");
    v4u uws[4];
#pragma unroll
    for (int i = 0; i < 4; ++i) { const int pr = i * 8 + (lane >> 3), cc = (lane & 7) * 8; uws[i] = *(const v4u*)(PROJ + (size_t)(row0 + 32 * pblk + pr) * INCP + h * 128 + 64 * half + cc); }
#pragma unroll
    for (int i = 0; i < 4; ++i) { const int pr = i * 8 + (lane >> 3), cc = (lane & 7) * 8; const int row = row0 + 32 * pblk + pr, col = h * 128 + 64 * half + cc;
        const f32x4 m0 = *(const f32x4*)(st + pr * 68 + cc), m1 = *(const f32x4*)(st + pr * 68 + cc + 4);
        const v4u uw = uws[i]; float uf[8]; unpack8(uw, uf);
        float y[8] = {uf[0] * m0.x, uf[1] * m0.y, uf[2] * m0.z, uf[3] * m0.w, uf[4] * m1.x, uf[5] * m1.y, uf[6] * m1.z, uf[7] * m1.w};
        *(v4u*)(YCAT + (size_t)row * DM + col) = pack8(y); }
    __syncthreads();
}

__device__ __forceinline__ void mod_phase(LAS unsigned char* lds, const float* cp, const float* cs, const float* ada_w, const float* ada_b, float* MOD, int vcu, int G, int tid) {
    LAS float* sc = (LAS float*)lds;
    LAS float* red = (LAS float*)(lds + 65536);
    const int lane = tid & 63, wid = tid >> 6;
#pragma unroll 8
    for (int i = tid; i < NB * DM; i += NTHR) { const int b = i >> 11, k = i & 2047; const float c = b < 4 ? cp[b * DM + k] : cs[(b - 4) * DM + k]; sc[i] = c / (1.0f + __expf(-c)); }
    __syncthreads();
    for (int item = vcu; item < DEPTH * 96; item += G) {
        const int l = item / 96, cbk = item % 96, col0 = cbk * 128 + 2 * lane;
        const float* W = ada_w + (size_t)l * DM * MODW + col0;
        float acc[8][2];
#pragma unroll
        for (int b = 0; b < 8; ++b) { acc[b][0] = 0.f; acc[b][1] = 0.f; }
        const int kbeg = wid * 256;
#pragma unroll 2
        for (int k = kbeg; k < kbeg + 256; k += 4) {
            typedef float f32x2w __attribute__((ext_vector_type(2)));
            f32x2w w[4];
#pragma unroll
            for (int i = 0; i < 4; ++i) w[i] = __builtin_nontemporal_load((const f32x2w*)(W + (size_t)(k + i) * MODW));
#pragma unroll
            for (int b = 0; b < 8; ++b) { const f32x4 s = *(const LAS f32x4*)(sc + b * DM + k);
                acc[b][0] += s.x * w[0].x + s.y * w[1].x + s.z * w[2].x + s.w * w[3].x;
                acc[b][1] += s.x * w[0].y + s.y * w[1].y + s.z * w[2].y + s.w * w[3].y; }
        }
#pragma unroll
        for (int b = 0; b < 8; ++b) { red[(wid * 8 + b) * 128 + 2 * lane] = acc[b][0]; red[(wid * 8 + b) * 128 + 2 * lane + 1] = acc[b][1]; }
        __syncthreads();
        { const int b = tid >> 6, pr = tid & 63; float s0 = 0.f, s1 = 0.f;
#pragma unroll
          for (int w = 0; w < 8; ++w) { s0 += red[(w * 8 + b) * 128 + 2 * pr]; s1 += red[(w * 8 + b) * 128 + 2 * pr + 1]; }
          const int col = cbk * 128 + 2 * pr;
          float* o = MOD + ((size_t)l * NB + b) * MODW + col; o[0] = s0 + ada_b[l * MODW + col]; o[1] = s1 + ada_b[l * MODW + col + 1]; }
        __syncthreads();
    }
}

__device__ __forceinline__ unsigned rot16(unsigned x) { return __builtin_amdgcn_alignbit(x, x, 16); }
__device__ __forceinline__ void filt_item(LAS unsigned char* lds, int L, int tb, const float* w1, const float* b1, const float* f1, const float* w2, const float* b2, const float* f2,
                                          const float* w3, const float* decay, bf16* GFl, int tid) {
    using att::bf16x8; using att::f32x16; using att::u32x4; using att::cvtpk;
    LAS float* feats = (LAS float*)lds;
    LAS float* h1 = feats + 2176;
    LAS float* h2 = h1 + 65 * 64;
    LAS float* hf0 = h2 + 65 * 68;
    const int t0 = 64 * tb; const float invL1 = 1.0f / (float)(L - 1);
    const int GRN = 2 * L / 64 * 72;
    const int lane = tid & 63, wid = __builtin_amdgcn_readfirstlane(tid >> 6), hi = lane >> 5, r32 = lane & 31;
    for (int id = tid; id < 65 * 33; id += NTHR) { const int i = id / 33, f = id % 33; const float t = (float)(t0 + i); float v;
        if (f == 0) v = t * invL1;
        else { const int kb = (f - 1) & 15; const float band = 1e-4f + (float)kb * ((15.0f - 1e-4f) / 15.0f);
            float x = t * band / (float)L; x -= floorf(x); const float a = 6.283185307179586f * x;
            v = (f <= 16) ? __cosf(a) : -__sinf(a); }
        feats[i * 33 + f] = v; }
    __syncthreads();
    for (int id = tid; id < 65 * 64; id += NTHR) { const int i = id >> 6, j = id & 63; float s = b1[j];
#pragma unroll 11
        for (int f = 0; f < 33; ++f) s += feats[i * 33 + f] * w1[f * 64 + j];
        h1[i * 64 + j] = __sinf(f1[j] * s); }
    __syncthreads();
    for (int id = tid; id < 65 * 64; id += NTHR) { const int i = id >> 6, j = id & 63; float s = b2[j];
#pragma unroll 16
        for (int f = 0; f < 64; ++f) s += h1[i * 64 + f] * w2[f * 64 + j];
        h2[i * 68 + j] = __sinf(f2[j] * s); }
    __syncthreads();
    if (tb == 0) {
        for (int cc = tid; cc < 1024; cc += NTHR) { const int col = (cc >> 9) * 1024 + (cc & 511); float s = 0.f;
#pragma unroll 16
            for (int j = 0; j < 64; ++j) s += h2[j] * w3[j * 2048 + col];
            hf0[cc] = s; }
        __syncthreads();
    }
    bf16x8 af[2][2][4];
#pragma unroll
    for (int st = 0; st < 2; ++st)
#pragma unroll
        for (int mb = 0; mb < 2; ++mb)
#pragma unroll
            for (int ks = 0; ks < 4; ++ks) { const LAS float* p = h2 + (st + 32 * mb + r32) * 68 + 16 * ks + 8 * hi;
                const f32x4 x = *(const LAS f32x4*)p, y = *(const LAS f32x4*)(p + 4);
                u32x4 w; w.x = cvtpk(x.x, x.y); w.y = cvtpk(x.z, x.w); w.z = cvtpk(y.x, y.y); w.w = cvtpk(y.z, y.w); af[st][mb][ks] = __builtin_bit_cast(bf16x8, w); }
#pragma unroll 1
    for (int cbi = 0; cbi < 8; ++cbi) {
        const int cb = wid * 8 + cbi, o = cb >> 5, dir = (cb >> 4) & 1, c = (cb & 15) * 32 + r32, col = cb * 32 + r32;
        bf16x8 bfr[4];
#pragma unroll
        for (int ks = 0; ks < 4; ++ks) { float x[8];
#pragma unroll
            for (int j = 0; j < 8; ++j) x[j] = w3[(size_t)(16 * ks + 8 * hi + j) * 2048 + col];
            u32x4 w; w.x = cvtpk(x[0], x[1]); w.y = cvtpk(x[2], x[3]); w.z = cvtpk(x[4], x[5]); w.w = cvtpk(x[6], x[7]); bfr[ks] = __builtin_bit_cast(bf16x8, w); }
        const float dec = fabsf(decay[col]) * invL1;
        bf16* dst = GFl + (size_t)(o * 512 + c) * GRN;
#pragma unroll
        for (int mb = 0; mb < 2; ++mb) {
            f32x16 d = {};
#pragma unroll
            for (int ks = 0; ks < 4; ++ks) d = (dir == 0) ? __builtin_amdgcn_mfma_f32_32x32x16_bf16(af[1][mb][ks], bfr[ks], d, 0, 0, 0)
                                                          : __builtin_amdgcn_mfma_f32_32x32x16_bf16(af[0][mb][ks], bfr[ks], d, 0, 0, 0);
#pragma unroll
            for (int q = 0; q < 16; ++q) { const int mrow = 32 * mb + att::crow(q, hi), t = t0 + mrow + (dir == 0 ? 1 : 0);
                float v = d[q] * __expf(-(float)t * dec);
                if (dir == 0 && t == L) v = 0.f;
                if (dir == 1 && t == 0) v = hf0[o * 512 + c];
                d[q] = v; }
#pragma unroll
            for (int k = 0; k < 2; ++k) {
                const unsigned a0 = cvtpk(d[8 * k + 0], d[8 * k + 1]), a1 = cvtpk(d[8 * k + 2], d[8 * k + 3]), b0 = cvtpk(d[8 * k + 4], d[8 * k + 5]), b1 = cvtpk(d[8 * k + 6], d[8 * k + 7]);
                auto s0 = __builtin_amdgcn_permlane32_swap(a0, b0, false, false); auto s1 = __builtin_amdgcn_permlane32_swap(a1, b1, false, false);
                const unsigned x0 = s0[0], x1 = s1[0], x2 = s0[1], x3 = s1[1];
                const int m0 = 32 * mb + 16 * k + 8 * hi;
                if (dir == 1) { const int ib = L + t0 + m0, ph = (ib >> 6) * 72 + (ib & 63); *(v4u*)(dst + ph) = (v4u){x0, x1, x2, x3}; }
                else { const int ib = L - t0 - m0 - 8, ph = (ib >> 6) * 72 + (ib & 63); *(v4u*)(dst + ph) = (v4u){rot16(x3), rot16(x2), rot16(x1), rot16(x0)}; }
            }
        }
    }
    __syncthreads();
}

__device__ __forceinline__ void ga_tables(const float* n1g, const float* n2g, const float* MODp, float* GA1, float* GA2, int gt, int ngt) {
    for (int i = gt; i < 2 * DEPTH * NB * DM; i += ngt) { const int which = i / (DEPTH * NB * DM), r = i % (DEPTH * NB * DM), l = r / (NB * DM), b = (r / DM) % NB, c = r % DM;
        const float sc = MODp[((size_t)l * NB + b) * MODW + (which ? 4 * DM : DM) + c];
        (which ? GA2 : GA1)[r] = (which ? n2g : n1g)[l * DM + c] * (1.0f + sc); }
}
__device__ __forceinline__ void bvec_item(LAS unsigned char* lds, const float* shp, const bf16* Wt, float* BV, int ldbv, int n0, int tid) {
    LAS float* sb = (LAS float*)lds;
    const int lane = tid & 63, wid = tid >> 6;
#pragma unroll 8
    for (int i = tid; i < NB * DM / 4; i += NTHR) { const int b = i / (DM / 4), k4 = i % (DM / 4); *(LAS f32x4*)(sb + b * DM + 4 * k4) = *(const f32x4*)(shp + (size_t)b * MODW + 4 * k4); }
    __syncthreads();
#pragma unroll 1
    for (int rg = 0; rg < 2; ++rg) { const int nb = n0 + wid * 8 + rg * 4;
        float acc[32];
#pragma unroll
        for (int i = 0; i < 32; ++i) acc[i] = 0.f;
#pragma unroll 1
        for (int j = 0; j < 4; ++j) { float f[4][8];
#pragma unroll
            for (int r = 0; r < 4; ++r) { const v4u w = *(const v4u*)(Wt + (size_t)(nb + r) * DM + 8 * lane + 512 * j); unpack8(w, f[r]); }
#pragma unroll
            for (int b = 0; b < 8; ++b) { const f32x4 s0 = *(const LAS f32x4*)(sb + b * DM + 8 * lane + 512 * j), s1 = *(const LAS f32x4*)(sb + b * DM + 8 * lane + 512 * j + 4);
#pragma unroll
                for (int r = 0; r < 4; ++r)
                    acc[r * 8 + b] += (f[r][0] * s0.x + f[r][1] * s0.y) + (f[r][2] * s0.z + f[r][3] * s0.w) + (f[r][4] * s1.x + f[r][5] * s1.y) + (f[r][6] * s1.z + f[r][7] * s1.w); } }
#pragma unroll
        for (int st = 0; st < 5; ++st) { const int n = 16 >> st, x = 32 >> st; const bool up = (lane & x) != 0;
#pragma unroll
            for (int i = 0; i < n; ++i) { const float keep = up ? acc[i + n] : acc[i], send = up ? acc[i] : acc[i + n]; acc[i] = keep + __shfl_xor(send, x); } }
        const float tot = acc[0] + __shfl_xor(acc[0], 1);
        const int idx = (lane >> 1) & 31;
        const int idxr = ((idx & 16) ? 16 : 0) | ((idx & 8) ? 8 : 0) | ((idx & 4) ? 4 : 0) | ((idx & 2) ? 2 : 0) | (idx & 1);
        if ((lane & 1) == 0) BV[(size_t)(idxr & 7) * ldbv + nb + (idxr >> 3)] = tot;
    }
    __syncthreads();
}
__device__ __forceinline__ void norm0_rows(const float* xa, const float* xb, const float* g, const float* mod, bf16* H, float* SS, int gw, int ngw, int lane) {
    for (int ck = gw; ck < NTOK / 4; ck += ngw) {
        const int row0 = ck * 4, b = row_batch(row0);
        const float* xin = row0 < NPR ? xa : xb;
        const float* sc = mod + (size_t)b * MODW + DM;
        f32x4 ga[8];
#pragma unroll
        for (int j = 0; j < 8; ++j) { const int col = 4 * lane + 256 * j; ga[j] = *(const f32x4*)(g + col) * (*(const f32x4*)(sc + col) + 1.0f); }
#pragma unroll 1
        for (int r = 0; r < 4; ++r) {
            const float* xr = xin + (size_t)(row0 + r) * DM;
            f32x4 v[8]; float ss = 0.f;
#pragma unroll
            for (int j = 0; j < 8; ++j) { v[j] = *(const f32x4*)(xr + 4 * lane + 256 * j); ss += (v[j].x * v[j].x + v[j].y * v[j].y) + (v[j].z * v[j].z + v[j].w * v[j].w); }
            ss = wave_sum(ss); if (lane == 0) SS[row0 + r] = ss;
            bf16* hr = H + (size_t)(row0 + r) * DM;
#pragma unroll
            for (int j = 0; j < 8; ++j) { const f32x4 o = v[j] * ga[j]; u32x2v w; w.x = pk2(o.x, o.y); w.y = pk2(o.z, o.w);
                *(u32x2v*)(hr + 4 * lane + 256 * j) = w; }
        }
    }
}
#ifndef MK_PHMASK
#define MK_PHMASK 0xFFFFFFFFu
#endif
#define EN(p) (((MK_PHMASK) >> (p)) & 1u)
#ifndef MK_REPEAT
#define MK_REPEAT 0u
#endif
#define REP(p) for (int rep_ = 0; rep_ < 1 + (int)(((MK_REPEAT) >> (p)) & 1u); ++rep_)
constexpr int NPH_LAYER = 10, NPHASE = 2 + DEPTH * NPH_LAYER;
struct Args { const float* in[37]; float* out; unsigned char* ws; int ph_lo, ph_hi; };
static_assert(sizeof(Args) == 39 * 8 + 8, "Args has no padding");

typedef const __attribute__((address_space(4))) Args* KArgs;
__device__ __forceinline__ KArgs kargs() { KArgs p = (KArgs)__builtin_amdgcn_kernarg_segment_ptr(); asm volatile("" : "+s"(p)); return p; }
#define AIN(i) (kargs()->in[i])
__global__ void __launch_bounds__(NTHR, 2) mk_fwd(Args args_unused) {
    extern __shared__ __attribute__((aligned(16))) unsigned char lds_raw[];
    LAS unsigned char* lds = (LAS unsigned char*)lds_raw;
    volatile LAS unsigned* MISC = (volatile LAS unsigned*)(lds + MISC_OFF);
    const int tid0 = threadIdx.x;
#define tid tid_fresh()
#define lane (tid_fresh() & 63)
#define wave (__builtin_amdgcn_readfirstlane(tid_fresh() >> 6))
    const int G0 = gridDim.x; const int bx0 = blockIdx.x; const int vcu0 = (G0 % 8 == 0) ? (bx0 % 8) * (G0 / 8) + bx0 / 8 : bx0;
#define G (sfresh(G0))
#define bx (sfresh(bx0))
#define vcu (sfresh(vcu0))
#define gw (vcu * NWAVES + wave)
#define ngw (G * NWAVES)
    gu32* ctl = (gu32*)(kargs()->ws + WS_CTL);
    for (int u = tid0; u < (LDS_BYTES - LDSCTL_OFF) / 4; u += NTHR) ((LAS unsigned*)(lds + LDSCTL_OFF))[u] = 0u;
    __syncthreads();
#if MK_MULTI
    XcdBarrier bar; bar.bar = (unsigned*)(ctl + CW_BAR); bar.x = 0; bar.st = nullptr;
#define SEAM(k) do { } while (0)
#else
    XcdBarrier bar = xcd_barrier_post((unsigned*)(ctl + CW_BAR), MISC + 8);
#define SEAM(k) do { if (IN(k) && IN((k) + 1)) { xcd_barrier(bar); if ((MK_REPEAT >> 19) & 1u) xcd_barrier(bar); } } while (0)
#endif
    const int lo = kargs()->ph_lo, hi = kargs()->ph_hi;
#define IN(k) (lo <= (k) && (k) < hi)
#define ws (kargs()->ws)
#define MOD ((float*)(ws + WS_MOD))
#define HB ((bf16*)(ws + WS_HB))
#define AFFN ((bf16*)(ws + WS_AFFN))
#define Z ((bf16*)(ws + WS_Z))
#define PROJ ((bf16*)(ws + WS_PROJ))
#define XT ((bf16*)(ws + WS_XT))
#define Y2T ((bf16*)(ws + WS_Y2T))
#define QD ((bf16*)(ws + WS_QD))
#define KVD ((bf16*)(ws + WS_KVD))
#define KMLA ((bf16*)(ws + WS_KMLA))
#define YCAT ((bf16*)(ws + WS_YCAT))
#define OUT (kargs()->out)

    if (EN(0) && IN(0)) REP(0) {
        REP(21) mod_phase(lds, AIN(2), AIN(3), AIN(4), AIN(5), MOD, vcu, G, tid);
        REP(22) for (int item = (vcu + G / 2) % G; item < DEPTH * 96; item += G) {     const int l = item / 96, r = item % 96; const int L = r < 32 ? LP : LS, tb = r < 32 ? r : r - 32;
            bf16* GFl = (bf16*)(ws + WS_GF + (size_t)l * SZ_GF + (r < 32 ? 0 : SZ_GF_P));
            filt_item(lds, L, tb, AIN(13) + (size_t)l * 33 * 64, AIN(14) + l * 64, AIN(15) + l * 64, AIN(16) + (size_t)l * 4096, AIN(17) + l * 64, AIN(18) + l * 64,
                      AIN(19) + (size_t)l * 64 * 2048, AIN(20) + (size_t)l * 2048, GFl, tid); }
        { LAS float* scr = (LAS float*)(lds + wave * 16384);
          constexpr int I_IN = 32 * 138, I_QB = 8 * 24, I_KVB = 4 * 32, I_OUT = 32 * 64, I_UP = 32 * 352, I_DN = 88 * 64, I_L = I_IN + I_QB + I_KVB + I_OUT + I_UP + I_DN;
          REP(23) for (int it = gw; it < DEPTH * I_L; it += ngw) { const int l = it / I_L; int r = it % I_L;
              if (r < I_IN) { p0_transpose_item(AIN(7) + (size_t)l * DM * INC, DM, INC, (bf16*)(ws + WS_WIN + l * SZ_WIN), 0, scr, r, lane); continue; } r -= I_IN;
              if (r < I_QB) { p0_transpose_item(AIN(25) + (size_t)l * 512 * 768, 512, 768, (bf16*)(ws + WS_WQB + l * SZ_WQB), 0, scr, r, lane); continue; } r -= I_QB;
              if (r < I_KVB) { p0_transpose_item(AIN(27) + (size_t)l * 256 * 1024, 256, 1024, (bf16*)(ws + WS_WKVB + l * SZ_WKVB), 0, scr, r, lane); continue; } r -= I_KVB;
              if (r < I_OUT) { p0_transpose_item(AIN(31) + (size_t)l * DM * DM, DM, DM, (bf16*)(ws + WS_WOUT + l * SZ_WOUT), 0, scr, r, lane); continue; } r -= I_OUT;
              if (r < I_UP) { const int n0 = 32 * (r % 352), hf = n0 >= DFF ? 1 : 0, j = n0 - DFF * hf, dest = 256 * (j >> 7) + 128 * hf + (j & 127);
                  p0_transpose_item(AIN(33) + (size_t)l * DM * DFF2, DM, DFF2, (bf16*)(ws + WS_WUP + l * SZ_WUP), dest - n0, scr, r, lane); continue; } r -= I_UP;
              p0_transpose_item(AIN(36) + (size_t)l * DFF * DM, DFF, DM, (bf16*)(ws + WS_WDN + l * SZ_WDN), 0, scr, r, lane); } }
        for (int i = vcu * NTHR + tid; i < DEPTH * (INCP - INC) * (DM / 8); i += G * NTHR) { const int l = i / ((INCP - INC) * (DM / 8)), r = i % ((INCP - INC) * (DM / 8));
            *(v4u*)(ws + WS_WIN + l * SZ_WIN + ((size_t)INC * DM + (size_t)r * 8) * 2) = (v4u){0u, 0u, 0u, 0u}; }
        VM_WAIT(); __syncthreads();
    }
    SEAM(0);

    if (EN(1) && IN(1)) REP(1) {
        ga_tables(AIN(6), AIN(32), MOD, (float*)(ws + WS_GA1), (float*)(ws + WS_GA2), vcu * NTHR + tid, G * NTHR);
        for (int it = vcu; it < DEPTH * 248; it += G) { const int l = it / 248, r = it % 248;
            if (r < 72) bvec_item(lds, MOD + (size_t)l * NB * MODW, (const bf16*)(ws + WS_WIN + l * SZ_WIN), (float*)(ws + WS_BV1) + (size_t)l * NB * INCP, INCP, r * 64, tid);
            else bvec_item(lds, MOD + (size_t)l * NB * MODW + 3 * DM, (const bf16*)(ws + WS_WUP + l * SZ_WUP), (float*)(ws + WS_BV2) + (size_t)l * NB * DFF2, DFF2, (r - 72) * 64, tid); }
        norm0_rows(AIN(0), AIN(1) - (size_t)NPR * DM, AIN(6), MOD, HB, (float*)(ws + WS_SS), gw, ngw, lane);
    }
    SEAM(1);

#pragma unroll 1
    for (int l = 0; l < DEPTH; ++l) {
        const int pb = 2 + l * NPH_LAYER;
#define xa ((l == 0) ? AIN(0) : OUT)
#define xb ((l == 0) ? (AIN(1) - (size_t)NPR * DM) : OUT)
#define modl (MOD + (size_t)l * NB * MODW)
        if (EN(2) && IN(pb + 0)) REP(2) {
            pg8::Gemm g{HB, (const bf16*)(ws + WS_WIN + l * SZ_WIN), NTOK, INCP, DM, DM, DM}; pg8::StaticOrder S; S.init(NTOK, INCP, G, bx);
            LAS float* rst = (LAS float*)(lds + TAB_OFF); LAS float* bvt = rst + 8 * 256;
            pg8::fill_tabs(S, (const float*)(ws + WS_SS) + (size_t)l * NTOK, (const float*)(ws + WS_BV1) + (size_t)l * NB * INCP, INCP, rst, bvt, tid);
            pg8::EpiBf E{PROJ, INCP, 4, rst, bvt, 0};
            pg8::gemm_phase<pg8::EpiBf, pg8::StaticOrder, true, true>(lds, g, S, E);
        }
        SEAM(pb + 0);
        if (EN(3) && IN(pb + 1)) {
            REP(20) post_rows(PROJ, AIN(8) + l * 512, AIN(22) + l * 128, AIN(23) + l * 128, AIN(24) + l * 512, AIN(26) + l * 256, gw, ngw, lane, rep_ == (int)((MK_REPEAT >> 20) & 1u));
            REP(3) for (int t = vcu; t < (NTOK / 64) * 3; t += G) hyconv_tile(lds, PROJ, XT, AIN(11) + (size_t)l * 3 * 1536, AIN(12) + l * 1536, t, tid);
        }
        SEAM(pb + 1);
        if (EN(4) && IN(pb + 2)) REP(4) {
            { pg8::Gemm g{PROJ + C_D, (const bf16*)(ws + WS_WQB + l * SZ_WQB), NTOK, 768, 512, INCP, 512}; pg8::StaticOrder S; S.init(NTOK, 768, G, bx);
              pg8::EpiBf E{QD, 768, 0, nullptr, nullptr, 0};
              pg8::gemm_phase<pg8::EpiBf, pg8::StaticOrder, true, true>(lds, g, S, E); }
            { pg8::Gemm g{PROJ + C_D + 512, (const bf16*)(ws + WS_WKVB + l * SZ_WKVB), NTOK, 1024, 256, INCP, 256}; pg8::StaticOrder S; S.init(NTOK, 1024, G, (bx + G / 2) % G);
              pg8::EpiBf E{KVD, 1024, 0, nullptr, nullptr, 0};
              pg8::gemm_phase<pg8::EpiBf, pg8::StaticOrder, true, true>(lds, g, S, E); }
        }
        SEAM(pb + 2);
        if (EN(5) && IN(pb + 3)) {
            REP(5) mla_rows(QD, KVD, PROJ, KMLA, AIN(28) + l * 192, AIN(29) + l * 192, gw, ngw, lane, rep_ == (int)((MK_REPEAT >> 5) & 1u));
        }
        SEAM(pb + 3);
        if (EN(6) && IN(pb + 4)) {
            if (EN(13)) REP(13) for (int u = vcu; u < 256; u += G) { const int bh = u >> 4, qb = u & 15, b = 4 + (bh >> 2), h = bh & 3; const size_t r0 = batch_row0(b);
                att::attn_body16<192, 768, 768, 1024, DM>(QD + (r0 + qb * 256) * 768 + h * 192, KMLA + r0 * 768 + h * 192, KVD + r0 * 1024 + h * 256 + 128,
                                      YCAT + (r0 + qb * 256) * DM + 1536 + h * 128, LS, (char*)lds_raw); }
            if (EN(14)) REP(14) for (int u = vcu; u < 256; u += G) { const int bh = u >> 4, qb = u & 15, b = 4 + (bh >> 2), h = bh & 3; const size_t r0 = batch_row0(b);
                att::attn_body16<128, INCP, INCP, INCP, DM>(PROJ + (r0 + qb * 256) * INCP + C_C + h * 128, PROJ + r0 * INCP + C_C + 512 + (h >> 1) * 128, PROJ + r0 * INCP + C_C + 768 + (h >> 1) * 128,
                                      YCAT + (r0 + qb * 256) * DM + 1024 + h * 128, LS, (char*)lds_raw); }
            if (EN(15)) REP(15) for (int u = vcu; u < 256; u += G)
                hy::hyena_unit<LS>((LAS char*)lds, (const bf16*)(ws + WS_GF + (size_t)l * SZ_GF + SZ_GF_P), XT, XT + (size_t)NTOK * 512, XT + (size_t)2 * NTOK * 512, Y2T, AIN(21) + l * 1024, 4, 2 * u);
            REP(17) for (int i = vcu; i < 256; i += G) { const int u = i & 127, bh = u >> 3, qb = u & 7, b = bh >> 2, h = bh & 3; const size_t r0 = batch_row0(b);
                if (i < 128) { if (EN(13))
                    att::attn_body16<192, 768, 768, 1024, DM>(QD + (r0 + qb * 256) * 768 + h * 192, KMLA + r0 * 768 + h * 192, KVD + r0 * 1024 + h * 256 + 128,
                                          YCAT + (r0 + qb * 256) * DM + 1536 + h * 128, LP, (char*)lds_raw); }
                else if (EN(14))
                    att::attn_body16<128, INCP, INCP, INCP, DM>(PROJ + (r0 + qb * 256) * INCP + C_C + h * 128, PROJ + r0 * INCP + C_C + 512 + (h >> 1) * 128, PROJ + r0 * INCP + C_C + 768 + (h >> 1) * 128,
                                          YCAT + (r0 + qb * 256) * DM + 1024 + h * 128, LP, (char*)lds_raw); }
            if (EN(15)) REP(18) for (int i = (G == 256) ? (vcu + 128) % 256 : vcu; i < 128; i += G)
                hy::hyena_unit<LP>((LAS char*)lds, (const bf16*)(ws + WS_GF + (size_t)l * SZ_GF), XT, XT + (size_t)NTOK * 512, XT + (size_t)2 * NTOK * 512, Y2T, AIN(21) + l * 1024, 0, 4 * i);
            if (EN(16)) REP(16) {
                if (G == 256) { const int v_ = vcu;
                    if (v_ < 128) { for (int u = v_; u < 768; u += 128) gmlp_unit((char*)lds_raw, PROJ, YCAT, AIN(9) + (size_t)l * 4 * 16384, AIN(10) + l * 512, u, tid); } }
                else for (int u = vcu; u < 768; u += G) gmlp_unit((char*)lds_raw, PROJ, YCAT, AIN(9) + (size_t)l * 4 * 16384, AIN(10) + l * 512, u, tid); }
            VM_WAIT(); __syncthreads();
        }
        SEAM(pb + 4);
        if (EN(7) && IN(pb + 5)) REP(7) { for (int t = vcu; t < NTOK / 32; t += G) gnorm_tile(lds, YCAT, Y2T, AIN(30) + l * DM, HB, t, tid); }
        SEAM(pb + 5);
        if (EN(8) && IN(pb + 6)) REP(8) {
            pg8::Gemm g{HB, (const bf16*)(ws + WS_WOUT + l * SZ_WOUT), NTOK, DM, DM, DM, DM}; pg8::StaticOrder S; S.init(NTOK, DM, G, bx);
            const bool dry = (((MK_REPEAT >> 8) & 1u) && rep_ == 0);
            pg8::EpiResid E{xa, xb, dry ? (float*)(ws + WS_R1) : OUT, modl + 2 * DM, dry ? nullptr : (bf16*)(ws + WS_HB2), (const float*)(ws + WS_GA2) + (size_t)l * NB * DM, (float*)(ws + WS_SS) + (size_t)(4 + l) * NTOK};
            pg8::gemm_phase<pg8::EpiResid, pg8::StaticOrder, true, true>(lds, g, S, E);
        }
        SEAM(pb + 6);
        if (EN(10) && IN(pb + 7)) REP(10) {
            pg8::Gemm g{(const bf16*)(ws + WS_HB2), (const bf16*)(ws + WS_WUP + l * SZ_WUP), NTOK, DFF2, DM, DM, DM}; pg8::StaticOrder S; S.init(NTOK, DFF2, G, bx);
            LAS float* rst = (LAS float*)(lds + TAB_OFF);
            pg8::fill_tabs(S, (const float*)(ws + WS_SS) + (size_t)(4 + l) * NTOK, nullptr, 0, rst, rst, tid);
            pg8::EpiGate E{AFFN, (float*)(ws + WS_R1), AIN(34) + (size_t)l * 3 * DFF2, AIN(35) + l * DFF2, (LAS float*)(lds + HALO_OFF), rst, (const float*)(ws + WS_BV2) + (size_t)l * NB * DFF2, 0};
            pg8::gemm_phase<pg8::EpiGate, pg8::StaticOrder, true, true>(lds, g, S, E);
        }
        SEAM(pb + 7);
        if (EN(11) && IN(pb + 8)) REP(11) gate_fix((const float*)(ws + WS_R1), AFFN, AIN(34) + (size_t)l * 3 * DFF2, AIN(35) + l * DFF2, vcu * NTHR + tid, G * NTHR);
        SEAM(pb + 8);
        if (EN(12) && IN(pb + 9)) REP(12) {
            pg8::Gemm g{AFFN, (const bf16*)(ws + WS_WDN + l * SZ_WDN), NTOK, DM, DFF, DFF, DFF}; pg8::StaticOrder S; S.init(NTOK, DM, G, bx);
            const bool dry = (((MK_REPEAT >> 12) & 1u) && rep_ == 0);
            pg8::EpiResid E{OUT, OUT, dry ? (float*)(ws + WS_R1) : OUT, modl + 5 * DM, (dry || l + 1 == DEPTH) ? nullptr : HB, (const float*)(ws + WS_GA1) + (size_t)(l + 1) * NB * DM, (float*)(ws + WS_SS) + (size_t)(l + 1) * NTOK};
            pg8::gemm_phase<pg8::EpiResid, pg8::StaticOrder, true, true, true, false>(lds, g, S, E);
        }
        if (l + 1 < DEPTH) SEAM(pb + 9);
    }
#undef xa
#undef xb
#undef modl
#undef G
#undef bx
#undef vcu
#undef ngw
#undef IN
#undef SEAM
#undef tid
#undef lane
#undef wave
#undef gw
#undef ws
#undef MOD
#undef HB
#undef AFFN
#undef Z
#undef PROJ
#undef XT
#undef Y2T
#undef QD
#undef KVD
#undef KMLA
#undef YCAT
#undef OUT
}

extern "C" void kernel_launch(void* const* d_in, const int* in_sizes, int n_in, void* d_out, int out_size, void* d_ws, size_t ws_size, hipStream_t stream) {
    static int grid = 0;
    if (grid == 0) {
        if (n_in != 37 || out_size != NTOK * DM || ws_size < WS_END) { fprintf(stderr, "kernel_launch: shape mismatch (n_in %d out %d ws %zu need %zu)\n", n_in, out_size, ws_size, (size_t)WS_END); grid = -1; return; }
        int dev = 0, cus = 0, per_cu = 0;
        if (hipGetDevice(&dev) != hipSuccess || hipDeviceGetAttribute(&cus, hipDeviceAttributeMultiprocessorCount, dev) != hipSuccess) { grid = -1; return; }
        if (hipFuncSetAttribute((const void*)mk_fwd, hipFuncAttributeMaxDynamicSharedMemorySize, LDS_BYTES) != hipSuccess) { fprintf(stderr, "kernel_launch: hipFuncSetAttribute failed\n"); grid = -1; return; }
        if (hipOccupancyMaxActiveBlocksPerMultiprocessor(&per_cu, (const void*)mk_fwd, NTHR, LDS_BYTES) != hipSuccess || per_cu < 1)
            fprintf(stderr, "kernel_launch: occupancy query reports %d workgroups per CU\n", per_cu);
        (void)hipGetLastError();
        grid = cus;
        if (grid > 256) grid = 256;
    }
    if (grid < 0) return;
    if (hipMemsetAsync((char*)d_ws + WS_CTL, 0, CTL_ZERO_BYTES, stream) != hipSuccess) { fprintf(stderr, "kernel_launch: memset failed\n"); return; }
    Args a{};
    for (int i = 0; i < 37; ++i) a.in[i] = (const float*)d_in[i];
    a.out = (float*)d_out; a.ws = (unsigned char*)d_ws;
#if MK_MULTI
    for (int p = 0; p < NPHASE; ++p) { a.ph_lo = p; a.ph_hi = p + 1; hipLaunchKernelGGL(mk_fwd, dim3(grid), dim3(NTHR), LDS_BYTES, stream, a); }
#else
    a.ph_lo = 0; a.ph_hi = NPHASE;
    hipLaunchKernelGGL(mk_fwd, dim3(grid), dim3(NTHR), LDS_BYTES, stream, a);
#endif
    const hipError_t le = hipPeekAtLastError();
    if (le != hipSuccess) fprintf(stderr, "kernel_launch: launch failed: %s\n", hipGetErrorName(le));
}
```

```cpp
#include <hip/hip_runtime.h>
#include <hip/hip_bf16.h>
#include <cstdio>
#include <cstdint>
#include <cmath>

#ifndef MK_MULTI
#define MK_MULTI 0
#endif

constexpr int DM = 2048, NTOK = 24576, NPR = 8192  , LP = 2048, LS = 4096, DEPTH = 4, NB = 8  ;
constexpr int INC = 4416, INCP = 4608;
constexpr int C_A = 0, C_B = 1024, C_C = 2560, C_D = 3584;
constexpr int DFF = 5632, DFF2 = 11264;
constexpr int MODW = 6 * DM;
constexpr float EPS = 1e-6f;
constexpr int NWAVES = 8, NTHR = 512;

constexpr size_t MiB = 1u << 20;
constexpr size_t WS_CTL = 0, CTL_ZERO_BYTES = 1 * MiB;
constexpr size_t WS_MOD = 1 * MiB;
constexpr size_t WS_GA1 = 2 * MiB + 512 * 1024;
constexpr size_t WS_GA2 = WS_GA1 + 256 * 1024;
constexpr size_t WS_BV1 = 3 * MiB;
constexpr size_t WS_BV2 = 4 * MiB;
constexpr size_t WS_SS = 65536;
constexpr size_t WS_WIN = 6 * MiB;
constexpr size_t SZ_WIN = (size_t)INCP * DM * 2;
constexpr size_t WS_WQB = WS_WIN + DEPTH * SZ_WIN;
constexpr size_t SZ_WQB = (size_t)768 * 512 * 2;
constexpr size_t WS_WKVB = WS_WQB + DEPTH * SZ_WQB;
constexpr size_t SZ_WKVB = (size_t)1024 * 256 * 2;
constexpr size_t WS_WOUT = WS_WKVB + DEPTH * SZ_WKVB;
constexpr size_t SZ_WOUT = (size_t)DM * DM * 2;
constexpr size_t WS_WUP = WS_WOUT + DEPTH * SZ_WOUT;
constexpr size_t SZ_WUP = (size_t)DFF2 * DM * 2;
constexpr size_t WS_WDN = WS_WUP + DEPTH * SZ_WUP;
constexpr size_t SZ_WDN = (size_t)DM * DFF * 2;
constexpr size_t WS_GF = WS_WDN + DEPTH * SZ_WDN;
constexpr size_t SZ_GF_P = (size_t)2 * 512 * 4608 * 2, SZ_GF_S = (size_t)2 * 512 * 9216 * 2, SZ_GF = SZ_GF_P + SZ_GF_S;
constexpr size_t WS_HB = WS_GF + DEPTH * SZ_GF;
constexpr size_t WS_HB2 = WS_HB + (size_t)NTOK * DM * 2;
constexpr size_t WS_AFFN = WS_HB2 + (size_t)NTOK * DM * 2;
constexpr size_t WS_R1 = WS_AFFN + (size_t)NTOK * DFF * 2;
constexpr size_t WS_Z = WS_R1;
constexpr size_t WS_PROJ = WS_R1;
constexpr size_t WS_XT = WS_PROJ + (size_t)NTOK * INCP * 2;
constexpr size_t SZ_XT1 = (size_t)NTOK * 512 * 2;
constexpr size_t WS_Y2T = WS_XT + 3 * SZ_XT1;
constexpr size_t WS_QD = WS_Y2T + SZ_XT1;
constexpr size_t WS_KVD = WS_QD + (size_t)NTOK * 768 * 2;
constexpr size_t WS_KMLA = WS_KVD + (size_t)NTOK * 1024 * 2;
constexpr size_t WS_YCAT = WS_KMLA + (size_t)NTOK * 768 * 2;
constexpr size_t WS_END = WS_R1 + (size_t)NTOK * DFF2 * 2;
static_assert(WS_YCAT + (size_t)NTOK * DM * 2 <= WS_END, "mixer buffers fit under Z");
static_assert(WS_SS + 8 * (size_t)NTOK * 4 <= CTL_ZERO_BYTES && WS_BV2 + (size_t)DEPTH * NB * DFF2 * 4 <= WS_WIN, "ws map");
constexpr int CW_BAR = 4096;

__host__ __device__ __forceinline__ size_t xt_off(int b, int c) { return b < 4 ? ((size_t)(b * 512 + c) * LP) : ((size_t)4 * 512 * LP + (size_t)((b - 4) * 512 + c) * LS); }
__host__ __device__ __forceinline__ int row_batch(int row) { return row < NPR ? (row >> 11) : 4 + ((row - NPR) >> 12); }
__host__ __device__ __forceinline__ int row_pos(int row) { return row < NPR ? (row & (LP - 1)) : ((row - NPR) & (LS - 1)); }
__host__ __device__ __forceinline__ int batch_row0(int b) { return b < 4 ? b * LP : NPR + (b - 4) * LS; }
__host__ __device__ __forceinline__ int batch_len(int b) { return b < 4 ? LP : LS; }

__host__ __device__ __forceinline__ size_t affn_off(int row, int j) { return ((((size_t)(row >> 8) * (DFF / 64) + (j >> 6)) * 256 + (row & 255)) << 6) + (j & 63); }

constexpr int RING_BYTES = 131072;
constexpr int LDSCTL_OFF = RING_BYTES, MISC_OFF = LDSCTL_OFF + 320, HALO_OFF = RING_BYTES + 1024;
constexpr int TAB_OFF = HALO_OFF + 8192 + 1024, TAB_BYTES = 17408;
constexpr int LDS_BYTES = 161792;
#define GAS __attribute__((address_space(1)))
#define LAS __attribute__((address_space(3)))
typedef unsigned short bf16;
typedef unsigned v4u __attribute__((ext_vector_type(4)));
typedef float f32x4 __attribute__((ext_vector_type(4)));
typedef short bf16x8 __attribute__((ext_vector_type(8)));
typedef GAS unsigned gu32;
typedef GAS unsigned long long gu64;
#define RLX_AGENT __ATOMIC_RELAXED, __HIP_MEMORY_SCOPE_AGENT
#define LDS_WAIT() asm volatile("s_waitcnt lgkmcnt(0)" ::: "memory")
#define VM_WAIT() asm volatile("s_waitcnt vmcnt(0)" ::: "memory")
__device__ __forceinline__ int tid_fresh() { int t = threadIdx.x; asm volatile("" : "+v"(t)); return t; }
__device__ __forceinline__ int sfresh(int v) { asm volatile("" : "+s"(v)); return v; }
__device__ __forceinline__ unsigned long long rt() { return __builtin_amdgcn_s_memrealtime(); }
__device__ __forceinline__ unsigned f2bf(float f) { unsigned u = __builtin_bit_cast(unsigned, f); return (u + 0x7fffu + ((u >> 16) & 1u)) >> 16; }
__device__ __forceinline__ unsigned pk2(float lo, float hi) { return f2bf(lo) | (f2bf(hi) << 16); }
#define XB_TMO      128
#define XB_XCNT(j)  (256  + 64 * (j))
#define XB_XSUB(j)  (1280 + 64 * (j))
#define XB_XGEN(j)  (2304 + 64 * (j))
#define XB_TOP      3328
#define XB_TOPGEN   3392
#define XCD_BAR_WORDS 3456
#define XB_SPIN_CAP (1u << 18)

__device__ __forceinline__ unsigned xb_ld(unsigned* p)              { return __hip_atomic_load(p, __ATOMIC_RELAXED, __HIP_MEMORY_SCOPE_AGENT); }
__device__ __forceinline__ unsigned xb_add(unsigned* p, unsigned v) { return __hip_atomic_fetch_add(p, v, __ATOMIC_RELAXED, __HIP_MEMORY_SCOPE_AGENT); }
__device__ __forceinline__ unsigned xb_xcc_id() { return (unsigned)__builtin_amdgcn_s_getreg((3 << 11) | 20) & 0xFu; }
#define XB_SPIN(cond, bar) do { unsigned _sp = 0; while (cond) { __builtin_amdgcn_s_sleep(1); \
    if ((++_sp & 255u) == 0u) { if (xb_ld(&(bar)[XB_TMO])) break; if (_sp > XB_SPIN_CAP) { atomicAdd(&(bar)[XB_TMO], 1u); break; } } } } while (0)

struct XcdBarrier {
    unsigned* bar; unsigned x;
    volatile LAS unsigned* st;
};

__device__ __forceinline__ XcdBarrier xcd_barrier_post(unsigned* bar, volatile LAS unsigned* st) {
    XcdBarrier b; b.bar = bar; b.x = xb_xcc_id(); b.st = st;
    if (threadIdx.x == 0) (void)xb_add(&bar[XB_XCNT(b.x)], 1u);
    return b;
}
__device__ __forceinline__ void xcd_barrier_complete(unsigned* bar, unsigned x, unsigned& nloc, unsigned& nx) {
    const unsigned G = gridDim.x * gridDim.y * gridDim.z;
    unsigned sum, cnt, mine, sp = 0u;
    for (;;) {
        sum = 0u; cnt = 0u; mine = 0u;
#pragma unroll
        for (unsigned j = 0; j < 16; ++j) { const unsigned c = xb_ld(&bar[XB_XCNT(j)]); sum += c; cnt += (c > 0u) ? 1u : 0u; mine = (j == x) ? c : mine; }
        if (sum == G) break;
        __builtin_amdgcn_s_sleep(1);
        if ((++sp & 255u) == 0u) { if (xb_ld(&bar[XB_TMO])) break; if (sp > XB_SPIN_CAP) { atomicAdd(&bar[XB_TMO], 1u); break; } }
    }
    nloc = mine > 0u ? mine : 1u; nx = cnt > 0u ? cnt : 1u;
}

__device__ __forceinline__ void xcd_barrier(const XcdBarrier& b) {
    asm volatile("s_waitcnt vmcnt(0)" ::: "memory");
    __syncthreads();
    if (threadIdx.x == 0) {
        unsigned* bar = b.bar;
        __builtin_amdgcn_s_waitcnt(0);
        unsigned nloc = b.st[0], nx = b.st[1];
        if (nloc == 0u) { xcd_barrier_complete(bar, b.x, nloc, nx); b.st[0] = nloc; b.st[1] = nx; }
        const unsigned old = xb_add(&bar[XB_XSUB(b.x)], 1u);
        const unsigned gen = old / nloc;
        if (old + 1u == (gen + 1u) * nloc) {
            __builtin_amdgcn_fence(__ATOMIC_RELEASE, "agent");
            asm volatile("s_waitcnt vmcnt(0)" ::: "memory");
            const unsigned og = xb_add(&bar[XB_TOP], 1u);
            const unsigned tg = og / nx;
            if (og + 1u == (tg + 1u) * nx) xb_add(&bar[XB_TOPGEN], 1u);
            else XB_SPIN(xb_ld(&bar[XB_TOPGEN]) == tg, bar);
            __builtin_amdgcn_fence(__ATOMIC_ACQUIRE, "agent");
            xb_add(&bar[XB_XGEN(b.x)], 1u);
            asm volatile("s_waitcnt vmcnt(0)" ::: "memory");
        } else {
            XB_SPIN(xb_ld(&bar[XB_XGEN(b.x)]) == gen, bar);
            __builtin_amdgcn_fence(__ATOMIC_ACQUIRE, "agent");
            asm volatile("s_waitcnt vmcnt(0)" ::: "memory");
        }
    }
    __syncthreads();
}
namespace pg8 {
#define PG8_LAS __attribute__((address_space(3)))
typedef unsigned short bf16_t;
typedef short bf16x8 __attribute__((ext_vector_type(8)));
typedef float f32x4 __attribute__((ext_vector_type(4)));
typedef unsigned u32x4 __attribute__((ext_vector_type(4)));
constexpr int BM = 256, BK = 64, HALF = 128, HTB = HALF * BK * 2  , STAGE_BYTES = 8 * HTB, NXCD = 8, WGM = 4;

__host__ __device__ __forceinline__ int lds_byte(int r, int c) { const int st = (r >> 4) * 2 + (c >> 5), rr = r & 15, cc = c & 31, ob = rr * 64 + cc * 2; return st * 1024 + (ob ^ (((ob >> 9) & 1) << 5)); }
__host__ __device__ __forceinline__ void stage_rc(int b, int& R, int& C) { const int st = b / 1024, sb = b % 1024, swz = sb ^ (((sb >> 9) & 1) << 5); R = (st >> 1) * 16 + swz / 64; C = (st & 1) * 32 + (swz % 64) / 2; }
__host__ __device__ __forceinline__ int perm32(int rho) { const int n = rho >> 4, i = rho & 15; return 8 * (i >> 2) + 4 * n + (i & 3); }

struct Unit { int pm, pn; };
struct Gemm { const bf16_t* A; const bf16_t* Bt; int M, N, K, lda, ldb; };

struct StaticOrder {
    int nM, nN, nwg, G, c;
    __host__ __device__ void init(int M, int N, int G_, int c_) { nM = M / BM; nN = N / BM; nwg = nM * nN; G = G_; c = c_; }
    __host__ __device__ bool next(int i, Unit& u) const {
        const long L = (long)i * G + c; if (L >= nwg) return false;
        int wgid = (int)L; { const int q = nwg / NXCD, r = nwg % NXCD, xcd = wgid % NXCD, off = wgid / NXCD; wgid = (xcd < r ? xcd * (q + 1) : r * (q + 1) + (xcd - r) * q) + off; }
        const int nig = WGM * nN, gid = wgid / nig, fm = gid * WGM, gsz = (nM - fm) < WGM ? (nM - fm) : WGM;
        u.pm = fm + ((wgid % nig) % gsz); u.pn = (wgid % nig) / gsz; return true;
    }
    __device__ __forceinline__ void a_ready(const Unit&) const {}
    __device__ __forceinline__ void done(const Unit&) const {}
};

__device__ __forceinline__ unsigned cvt_pk_bf16(float lo, float hi) { unsigned r; asm volatile("v_cvt_pk_bf16_f32 %0, %1, %2" : "=v"(r) : "v"(lo), "v"(hi)); return r; }
typedef float f32x2 __attribute__((ext_vector_type(2)));
__device__ __forceinline__ f32x2 gelu_pk(f32x2 v) {
    const f32x2 av = __builtin_elementwise_abs(v), d = av * 0.2316418882f + 1.0f;
    f32x2 t; t.x = __builtin_amdgcn_rcpf(d.x); t.y = __builtin_amdgcn_rcpf(d.y);
    f32x2 q = t * 0.5307027145f + (-0.7265760135f); q = q * t + 0.7107068705f; q = q * t + (-0.142248368f); q = q * t + 0.127414796f; q = q * t;
    const f32x2 s = (v * v) * (-0.72134752044f);
    f32x2 e; e.x = __builtin_amdgcn_exp2f(s.x); e.y = __builtin_amdgcn_exp2f(s.y);
    const f32x2 m = v * (q * e), r = v - m;
    f32x2 o; o.x = v.x < 0.f ? m.x : r.x; o.y = v.y < 0.f ? m.y : r.y; return o;
}

template <class Epi, class Sched, bool ALIGN_EPI = false, bool SP2 = false, bool BLKA = false, bool BLKB = false>
__device__ __forceinline__ void gemm_phase(PG8_LAS unsigned char* lds, const Gemm g, const Sched& S, const Epi& E) {
    const int tid = tid_fresh(), wid = __builtin_amdgcn_readfirstlane(tid >> 6), lane = tid & 63, wr = wid >> 2, wc = wid & 3, fr = lane & 15, fq = lane >> 4;
    const int K = g.K, nt = K / BK;
    unsigned voffA[2], voffB[2];
#pragma unroll
    for (int i = 0; i < 2; ++i) { int R, C; stage_rc(tid * 16 + i * 8192, R, C); const int Rb = Epi::PERM ? ((R & ~31) + perm32(R & 31)) : R;
        const int Ra = Epi::AROWPERM ? ((R & ~63) | (4 * (R & 15) + ((R >> 4) & 3))) : R;
        voffA[i] = (unsigned)(Ra * (BLKA ? BK : g.lda) + C) * 2u; voffB[i] = (unsigned)(Rb * (BLKB ? BK : g.ldb) + C) * 2u; }
    const size_t kstepA = BLKA ? (size_t)BM * BK * 2 : (size_t)(BK * 2), kstepB = BLKB ? (size_t)BM * BK * 2 : (size_t)(BK * 2);
    const size_t hstepA = BLKA ? (size_t)HALF * BK * 2 : (size_t)HALF * g.lda * 2, hstepB = BLKB ? (size_t)HALF * BK * 2 : (size_t)HALF * g.ldb * 2;
    const size_t tstepA = BLKA ? (size_t)nt * BM * BK * 2 : 2 * hstepA, tstepB = BLKB ? (size_t)nt * BM * BK * 2 : 2 * hstepB;
    const unsigned ldsw = (unsigned)wid * 1024u;
    const int aoff = lds_byte(wr * 64 + fr, fq * 8), boff = lds_byte(wc * 32 + fr, fq * 8);
#define PG8_SA(b, h) (((b) * 2 + (h)) * HTB)
#define PG8_SB(b, h) ((4 + (b) * 2 + (h)) * HTB)
#define PG8_STAGE(bufoff, gbase, voff) do { _Pragma("unroll") for (int _i = 0; _i < 2; ++_i) \
        __builtin_amdgcn_global_load_lds((const unsigned*)((const char*)(gbase) + (voff)[_i]), (PG8_LAS unsigned*)(lds + (bufoff) + ldsw + _i * 8192), 16, 0, 0); } while (0)
#define PG8_LDA(dst, b, h) do { _Pragma("unroll") for (int m = 0; m < 4; ++m) _Pragma("unroll") for (int k = 0; k < 2; ++k) dst[m][k] = *(const PG8_LAS bf16x8*)(lds + PG8_SA(b, h) + aoff + m * 2048 + k * 1024); } while (0)
#define PG8_LDB(dst, b, h) do { _Pragma("unroll") for (int n = 0; n < 2; ++n) _Pragma("unroll") for (int k = 0; k < 2; ++k) dst[n][k] = *(const PG8_LAS bf16x8*)(lds + PG8_SB(b, h) + boff + n * 2048 + k * 1024); } while (0)
#define PG8_MMA(ai, bj, At, Bt) do { __builtin_amdgcn_s_setprio(1); _Pragma("unroll") for (int m = 0; m < 4; ++m) _Pragma("unroll") for (int n = 0; n < 2; ++n) _Pragma("unroll") for (int k = 0; k < 2; ++k) \
        acc[ai][bj][m][n] = __builtin_amdgcn_mfma_f32_16x16x32_bf16(Bt[n][k], At[m][k], acc[ai][bj][m][n], 0, 0, 0); __builtin_amdgcn_s_setprio(0); } while (0)
#define PG8_WAIT_V(n) asm volatile("s_waitcnt vmcnt(" #n ")" ::: "memory")
#define PG8_WAIT_L(n) asm volatile("s_waitcnt lgkmcnt(" #n ")" ::: "memory")
#define PG8_BAR __builtin_amdgcn_s_barrier()
#define PG8_SCHED __builtin_amdgcn_sched_barrier(0)
    Unit cur, nxt; int ui = 0;
    if (!S.next(0, cur)) return;
    f32x4 acc[2][2][4][2];
#pragma unroll
    for (int a = 0; a < 2; ++a)
#pragma unroll
        for (int b = 0; b < 2; ++b)
#pragma unroll
            for (int m = 0; m < 4; ++m)
#pragma unroll
                for (int n = 0; n < 2; ++n) acc[a][b][m][n] = (f32x4){0.f, 0.f, 0.f, 0.f};
    bf16x8 At[4][2], B0[2][2], B1[2][2];
    const char* cA = (const char*)g.A + (size_t)cur.pm * tstepA; const char* cB = (const char*)g.Bt + (size_t)cur.pn * tstepB;
    S.a_ready(cur);
    if constexpr (SP2) {
        PG8_STAGE(PG8_SB(0, 0), cB, voffB); PG8_STAGE(PG8_SB(0, 1), cB + hstepB, voffB); PG8_STAGE(PG8_SA(0, 0), cA, voffA); PG8_STAGE(PG8_SA(0, 1), cA + hstepA, voffA);
        if (wr == 1) PG8_BAR;
        PG8_WAIT_V(2); PG8_BAR;
        PG8_STAGE(PG8_SB(1, 0), cB + kstepB, voffB); PG8_STAGE(PG8_SA(1, 0), cA + kstepA, voffA); PG8_STAGE(PG8_SB(1, 1), cB + hstepB + kstepB, voffB);
        PG8_WAIT_V(6); PG8_BAR;
    } else {
        PG8_STAGE(PG8_SB(0, 0), cB, voffB); PG8_STAGE(PG8_SA(0, 0), cA, voffA); PG8_STAGE(PG8_SB(0, 1), cB + hstepB, voffB); PG8_STAGE(PG8_SA(0, 1), cA + hstepA, voffA);
        if (wr == 1) PG8_BAR;
        PG8_WAIT_V(4); PG8_BAR;
        PG8_STAGE(PG8_SB(1, 0), cB + kstepB, voffB); PG8_STAGE(PG8_SA(1, 0), cA + kstepA, voffA); PG8_STAGE(PG8_SB(1, 1), cB + hstepB + kstepB, voffB);
        PG8_WAIT_V(6); PG8_BAR;
    }
    for (;;) {
        const bool has_next = S.next(ui + 1, nxt);
        const char* nA = has_next ? (const char*)g.A + (size_t)nxt.pm * tstepA : cA; const char* nB = has_next ? (const char*)g.Bt + (size_t)nxt.pn * tstepB : cB;
        for (int t = 0; t < nt; t += 2) {
            const bool last = (t == nt - 2);
            const char* a1 = cA + (size_t)(t + 1) * kstepA;
            const char* a2 = last ? nA : cA + (size_t)(t + 2) * kstepA; const char* b2 = last ? nB : cB + (size_t)(t + 2) * kstepB;
            const char* a3 = a2 + kstepA; const char* b3 = b2 + kstepB;
            if (last && has_next) S.a_ready(nxt);
            if constexpr (SP2) {
            PG8_LDB(B0, 0, 0); PG8_LDB(B1, 0, 1); PG8_SCHED; PG8_LDA(At, 0, 0); PG8_STAGE(PG8_SA(1, 1), a1 + hstepA, voffA);
            PG8_WAIT_V(8); PG8_WAIT_L(0); PG8_BAR; PG8_MMA(0, 0, At, B0); PG8_MMA(0, 1, At, B1); PG8_BAR; PG8_SCHED;
            PG8_LDA(At, 0, 1); PG8_STAGE(PG8_SB(0, 0), b2, voffB); PG8_STAGE(PG8_SB(0, 1), b2 + hstepB, voffB); PG8_STAGE(PG8_SA(0, 0), a2, voffA);
            PG8_WAIT_V(8); PG8_WAIT_L(0); PG8_BAR; PG8_MMA(1, 0, At, B0); PG8_MMA(1, 1, At, B1); PG8_BAR; PG8_SCHED;
            PG8_LDB(B0, 1, 0); PG8_LDB(B1, 1, 1); PG8_SCHED; PG8_LDA(At, 1, 0); PG8_STAGE(PG8_SA(0, 1), a2 + hstepA, voffA);
            PG8_WAIT_V(8); PG8_WAIT_L(0); PG8_BAR; PG8_MMA(0, 0, At, B0); PG8_MMA(0, 1, At, B1); PG8_BAR; PG8_SCHED;
            PG8_LDA(At, 1, 1); PG8_STAGE(PG8_SB(1, 0), b3, voffB); PG8_STAGE(PG8_SB(1, 1), b3 + hstepB, voffB); PG8_STAGE(PG8_SA(1, 0), a3, voffA);
            PG8_WAIT_V(8); PG8_WAIT_L(0); PG8_BAR; PG8_MMA(1, 0, At, B0); PG8_MMA(1, 1, At, B1); PG8_BAR; PG8_SCHED;
            } else {
            PG8_LDB(B0, 0, 0); PG8_SCHED; PG8_LDA(At, 0, 0); PG8_STAGE(PG8_SA(1, 1), a1 + hstepA, voffA);
            PG8_WAIT_L(8); PG8_BAR; PG8_WAIT_L(0); PG8_MMA(0, 0, At, B0); PG8_BAR; PG8_SCHED;
            PG8_LDB(B1, 0, 1); PG8_STAGE(PG8_SB(0, 0), b2, voffB);
            PG8_BAR; PG8_WAIT_L(0); PG8_MMA(0, 1, At, B1); PG8_BAR;
            PG8_LDA(At, 0, 1); PG8_STAGE(PG8_SA(0, 0), a2, voffA);
            PG8_BAR; PG8_WAIT_L(0); PG8_MMA(1, 0, At, B0); PG8_BAR; PG8_SCHED;
            PG8_STAGE(PG8_SB(0, 1), b2 + hstepB, voffB);
            PG8_WAIT_V(6); PG8_BAR; PG8_MMA(1, 1, At, B1); PG8_BAR;
            PG8_LDB(B0, 1, 0); PG8_SCHED; PG8_LDA(At, 1, 0); PG8_STAGE(PG8_SA(0, 1), a2 + hstepA, voffA);
            PG8_WAIT_L(8); PG8_BAR; PG8_WAIT_L(0); PG8_MMA(0, 0, At, B0); PG8_BAR; PG8_SCHED;
            PG8_LDB(B1, 1, 1); PG8_STAGE(PG8_SB(1, 0), b3, voffB);
            PG8_BAR; PG8_WAIT_L(0); PG8_MMA(0, 1, At, B1); PG8_BAR;
            PG8_LDA(At, 1, 1); PG8_STAGE(PG8_SA(1, 0), a3, voffA);
            PG8_BAR; PG8_WAIT_L(0); PG8_MMA(1, 0, At, B0); PG8_BAR; PG8_SCHED;
            PG8_STAGE(PG8_SB(1, 1), b3 + hstepB, voffB);
            PG8_WAIT_V(6); PG8_BAR; PG8_MMA(1, 1, At, B1); PG8_BAR;
            }
        }
        if constexpr (ALIGN_EPI) { if (wr == 0) PG8_BAR; }
        if constexpr (!Epi::AFTER_DRAIN) { E(acc, cur, wr, wc, fr, fq); S.done(cur); }
        if (!has_next) break;
#pragma unroll
        for (int a = 0; a < 2; ++a)
#pragma unroll
            for (int b = 0; b < 2; ++b)
#pragma unroll
                for (int m = 0; m < 4; ++m)
#pragma unroll
                    for (int n = 0; n < 2; ++n) acc[a][b][m][n] = (f32x4){0.f, 0.f, 0.f, 0.f};
        cur = nxt; cA = nA; cB = nB; ++ui;
        if constexpr (ALIGN_EPI) { if (wr == 1) PG8_BAR; }
    }
    PG8_WAIT_V(0);
    if constexpr (!ALIGN_EPI) { if (wr == 0) PG8_BAR; }
    PG8_BAR;
    if constexpr (Epi::AFTER_DRAIN) { E.fused(acc, cur, wr, wc, fr, fq, lds, wid, lane); S.done(cur); }
#undef PG8_SA
#undef PG8_SB
#undef PG8_STAGE
#undef PG8_LDA
#undef PG8_LDB
#undef PG8_MMA
#undef PG8_WAIT_V
#undef PG8_WAIT_L
#undef PG8_BAR
#undef PG8_SCHED
}
}
namespace pg8 {
struct EpiBf {
    static constexpr bool PERM = true, AFTER_DRAIN = false, AROWPERM = false;
    bf16_t* O; int ldc; int gelu_tiles;
    const PG8_LAS float* ss; const PG8_LAS float* bvec; mutable int ui;
    __device__ __forceinline__ void operator()(const f32x4 (&acc)[2][2][4][2], const Unit& u, int wr, int wc, int fr, int fq) const {
        const int row0 = u.pm * BM + wr * 64 + fr; const int col0 = u.pn * BM + wc * 32 + 8 * fq;
        const bool act = u.pn < gelu_tiles;
        f32x4 bv[2][2];
        if (ss) { const PG8_LAS float* bp = bvec + ui * BM + wc * 32 + 8 * fq;
#pragma unroll
            for (int bj = 0; bj < 2; ++bj)
#pragma unroll
                for (int n = 0; n < 2; ++n) bv[bj][n] = *(const PG8_LAS f32x4*)(bp + bj * HALF + 4 * n); }
#pragma unroll
        for (int ai = 0; ai < 2; ++ai)
#pragma unroll
            for (int m = 0; m < 4; ++m) { bf16_t* rowp = O + (size_t)(row0 + ai * HALF + m * 16) * ldc + col0;
                float rs = 1.f; if (ss) rs = ss[ui * BM + wr * 64 + fr + ai * HALF + m * 16];
#pragma unroll
                for (int bj = 0; bj < 2; ++bj) { f32x4 v0 = acc[ai][bj][m][0], v1 = acc[ai][bj][m][1];
                    if (ss) { v0 = v0 * rs + bv[bj][0]; v1 = v1 * rs + bv[bj][1]; }
                    if (act) { f32x2 a = gelu_pk((f32x2){v0[0], v0[1]}), b = gelu_pk((f32x2){v0[2], v0[3]}), c = gelu_pk((f32x2){v1[0], v1[1]}), d = gelu_pk((f32x2){v1[2], v1[3]});
                        v0 = (f32x4){a.x, a.y, b.x, b.y}; v1 = (f32x4){c.x, c.y, d.x, d.y}; }
                    u32x4 w; w.x = cvt_pk_bf16(v0[0], v0[1]); w.y = cvt_pk_bf16(v0[2], v0[3]); w.z = cvt_pk_bf16(v1[0], v1[1]); w.w = cvt_pk_bf16(v1[2], v1[3]);
                    *(u32x4*)(rowp + bj * HALF) = w; } }
        ++ui;
    }
};
struct EpiResid {
    static constexpr bool PERM = true, AFTER_DRAIN = false, AROWPERM = false;
    const float* xa; const float* xb; float* out; const float* gate;
    bf16_t* xg; const float* ga; float* ssq;
    __device__ __forceinline__ void operator()(const f32x4 (&acc)[2][2][4][2], const Unit& u, int wr, int wc, int fr, int fq) const {
        const int row0 = u.pm * BM + wr * 64 + fr; const int col0 = u.pn * BM + wc * 32 + 8 * fq;
        const int b = row_batch(u.pm * BM); const float* xin = (u.pm * BM < NPR) ? xa : xb;
        f32x4 gv[2][2], gn[2][2];
#pragma unroll
        for (int bj = 0; bj < 2; ++bj)
#pragma unroll
            for (int n = 0; n < 2; ++n) { gv[bj][n] = *(const f32x4*)(gate + (size_t)b * MODW + col0 + bj * HALF + 4 * n);
                if (xg) gn[bj][n] = *(const f32x4*)(ga + (size_t)b * DM + col0 + bj * HALF + 4 * n); }
#pragma unroll
        for (int aim = 0; aim < 4; ++aim) { const int ai = aim >> 1, mh = (aim & 1) * 2;
            f32x4 xv[2][2][2];
#pragma unroll
            for (int mm = 0; mm < 2; ++mm) { const size_t off = (size_t)(row0 + ai * HALF + (mh + mm) * 16) * DM + col0;
#pragma unroll
                for (int bj = 0; bj < 2; ++bj)
#pragma unroll
                    for (int n = 0; n < 2; ++n) xv[mm][bj][n] = *(const f32x4*)(xin + off + bj * HALF + 4 * n); }
#pragma unroll
            for (int mm = 0; mm < 2; ++mm) { const int m = mh + mm; const size_t off = (size_t)(row0 + ai * HALF + m * 16) * DM + col0; float sq = 0.f;
#pragma unroll
                for (int bj = 0; bj < 2; ++bj) { f32x4 xn[2];
#pragma unroll
                    for (int n = 0; n < 2; ++n) {
                        xn[n] = xv[mm][bj][n] + gv[bj][n] * acc[ai][bj][m][n];
                        *(f32x4*)(out + off + bj * HALF + 4 * n) = xn[n]; }
                    if (xg) { const f32x4 a = xn[0] * gn[bj][0], c = xn[1] * gn[bj][1];
                        sq += (xn[0][0] * xn[0][0] + xn[0][1] * xn[0][1]) + (xn[0][2] * xn[0][2] + xn[0][3] * xn[0][3]) + (xn[1][0] * xn[1][0] + xn[1][1] * xn[1][1]) + (xn[1][2] * xn[1][2] + xn[1][3] * xn[1][3]);
                        u32x4 w; w.x = cvt_pk_bf16(a[0], a[1]); w.y = cvt_pk_bf16(a[2], a[3]); w.z = cvt_pk_bf16(c[0], c[1]); w.w = cvt_pk_bf16(c[2], c[3]);
                        *(u32x4*)(xg + off + bj * HALF) = w; } }
                if (xg) { sq += __shfl_xor(sq, 16); sq += __shfl_xor(sq, 32);
                    if (fq == 0) __hip_atomic_fetch_add(ssq + row0 + ai * HALF + m * 16, sq, __ATOMIC_RELAXED, __HIP_MEMORY_SCOPE_AGENT); } }
        }
    }
};
}
namespace pg8 {
__device__ __forceinline__ float dpp_prev(float x) { return __int_as_float(__builtin_amdgcn_update_dpp(0, __float_as_int(x), 0x121, 0xF, 0xF, true)); }
__device__ __forceinline__ float dpp_next(float x) { return __int_as_float(__builtin_amdgcn_update_dpp(0, __float_as_int(x), 0x12F, 0xF, 0xF, true)); }
__device__ __forceinline__ float dpp_shr1_old(float oldv, float x) { return __int_as_float(__builtin_amdgcn_update_dpp(__float_as_int(oldv), __float_as_int(x), 0x111, 0xF, 0xF, false)); }
__device__ __forceinline__ float dpp_shl1_old(float oldv, float x) { return __int_as_float(__builtin_amdgcn_update_dpp(__float_as_int(oldv), __float_as_int(x), 0x101, 0xF, 0xF, false)); }
__device__ __forceinline__ f32x4 dpp_shr1_old4(f32x4 o, f32x4 v) { return (f32x4){dpp_shr1_old(o[0], v[0]), dpp_shr1_old(o[1], v[1]), dpp_shr1_old(o[2], v[2]), dpp_shr1_old(o[3], v[3])}; }
__device__ __forceinline__ f32x4 dpp_shl1_old4(f32x4 o, f32x4 v) { return (f32x4){dpp_shl1_old(o[0], v[0]), dpp_shl1_old(o[1], v[1]), dpp_shl1_old(o[2], v[2]), dpp_shl1_old(o[3], v[3])}; }
__device__ __forceinline__ f32x4 dpp_prev4(f32x4 v) { return (f32x4){dpp_prev(v[0]), dpp_prev(v[1]), dpp_prev(v[2]), dpp_prev(v[3])}; }
__device__ __forceinline__ f32x4 dpp_next4(f32x4 v) { return (f32x4){dpp_next(v[0]), dpp_next(v[1]), dpp_next(v[2]), dpp_next(v[3])}; }
struct EpiGate {
    static constexpr bool PERM = true, AFTER_DRAIN = false, AROWPERM = true;
    bf16_t* A; float* ZH; const float* cw; const float* cb; PG8_LAS float* halo;
    const PG8_LAS float* rstab; const float* bvec; mutable int ui;
    __device__ __forceinline__ void operator()(f32x4 (&acc)[2][2][4][2], const Unit& u, int wr, int wc, int fr, int fq) const {
        const int cl = wc * 32 + 8 * fq;
        f32x4 w[2][3], bs[2], bv[2];
#define EG_LOADC(n_) do { const float* bp_ = bvec + (size_t)row_batch(u.pm * BM) * DFF2 + u.pn * BM + cl + 4 * (n_); const int j0_ = u.pn * HALF + cl + 4 * (n_); \
        _Pragma("unroll") for (int bj = 0; bj < 2; ++bj) { bv[bj] = *(const f32x4*)(bp_ + bj * HALF); bs[bj] = *(const f32x4*)(cb + bj * DFF + j0_); } } while (0)
#define EG_LOADW(n_) do { const int j0_ = u.pn * HALF + cl + 4 * (n_); \
        _Pragma("unroll") for (int bj = 0; bj < 2; ++bj) _Pragma("unroll") for (int k = 0; k < 3; ++k) w[bj][k] = *(const f32x4*)(cw + (size_t)k * DFF2 + bj * DFF + j0_); } while (0)
#pragma unroll
        for (int ai = 0; ai < 2; ++ai)
#pragma unroll
            for (int m = 0; m < 4; ++m) { const float rs = rstab[ui * BM + ai * HALF + wr * 64 + 4 * fr + m];
#pragma unroll
                for (int bj = 0; bj < 2; ++bj)
#pragma unroll
                    for (int n = 0; n < 2; ++n) acc[ai][bj][m][n] = acc[ai][bj][m][n] * rs; }
#pragma unroll
        for (int ai = 0; ai < 2; ++ai)
#pragma unroll
            for (int bj = 0; bj < 2; ++bj)
#pragma unroll
                for (int n = 0; n < 2; ++n) { const int blk = ai * 2 + wr, c = bj * HALF + cl + 4 * n;
                    const f32x4 hv = (fr == 0) ? acc[ai][bj][0][n] : acc[ai][bj][3][n];
                    *(PG8_LAS f32x4*)(halo + ((fr == 0) ? (blk * 2) * 256 : (fr == 15) ? (blk * 2 + 1) * 256 : 2048) + c) = hv; }
        asm volatile("s_waitcnt lgkmcnt(0)" ::: "memory"); __builtin_amdgcn_s_barrier(); asm volatile("" ::: "memory");
        const int trow0 = u.pm * BM, pos0 = row_pos(trow0), Lb = batch_len(row_batch(trow0));
        const bool top_ok = (pos0 == 0), bot_ok = (pos0 + BM == Lb);
        const unsigned aoff = ((((unsigned)u.pm * (DFF / 64) + 2 * u.pn + (wc >> 1)) << 14) + 32 * (wc & 1) + 8 * fq) * 2u;
#pragma unroll
        for (int n = 0; n < 2; ++n) {
            EG_LOADW(n); EG_LOADC(n);
            f32x4 cfull[2];
#pragma unroll
            for (int bj = 0; bj < 2; ++bj) cfull[bj] = bs[bj] + bv[bj] * (w[bj][0] + w[bj][1] + w[bj][2]);
            { const unsigned zo = (((unsigned)u.pm * 4) * DFF2 + u.pn * BM + cl + 4 * n) * 4u;
              if (wr == 0 && fr == 0) {
#pragma unroll
                  for (int bj = 0; bj < 2; ++bj) { *(f32x4*)((char*)ZH + (zo + (unsigned)(bj * HALF) * 4u)) = acc[0][bj][0][n] + bv[bj];
                      *(f32x4*)((char*)ZH + (zo + (unsigned)(DFF2 + bj * HALF) * 4u)) = acc[0][bj][1][n] + bv[bj]; } }
              if (wr == 1 && fr == 15) {
#pragma unroll
                  for (int bj = 0; bj < 2; ++bj) { *(f32x4*)((char*)ZH + (zo + (unsigned)(2 * DFF2 + bj * HALF) * 4u)) = acc[1][bj][2][n] + bv[bj];
                      *(f32x4*)((char*)ZH + (zo + (unsigned)(3 * DFF2 + bj * HALF) * 4u)) = acc[1][bj][3][n] + bv[bj]; } } }
#pragma unroll
            for (int ai = 0; ai < 2; ++ai) {
                const int blk = ai * 2 + wr;
                f32x4 hp[2], hn[2];
#pragma unroll
                for (int bj = 0; bj < 2; ++bj) {
                    hp[bj] = (blk > 0) ? *(const PG8_LAS f32x4*)(halo + ((blk - 1) * 2 + 1) * 256 + bj * HALF + cl + 4 * n) : (f32x4){0.f, 0.f, 0.f, 0.f};
                    hn[bj] = (blk < 3) ? *(const PG8_LAS f32x4*)(halo + ((blk + 1) * 2 + 0) * 256 + bj * HALF + cl + 4 * n) : (f32x4){0.f, 0.f, 0.f, 0.f}; }
#pragma unroll
                for (int m = 0; m < 4; ++m) {
                    const int rt = ai * HALF + wr * 64 + 4 * fr + m;
                    f32x4 cv[2];
#pragma unroll
                    for (int bj = 0; bj < 2; ++bj) {
                        const f32x4 cur = acc[ai][bj][m][n];
                        const f32x4 prev = (m > 0) ? acc[ai][bj][m > 0 ? m - 1 : 0][n] : dpp_shr1_old4(hp[bj], acc[ai][bj][3][n]);
                        const f32x4 next = (m < 3) ? acc[ai][bj][m < 3 ? m + 1 : 3][n] : dpp_shl1_old4(hn[bj], acc[ai][bj][0][n]);
                        cv[bj] = w[bj][0] * prev + w[bj][1] * cur + w[bj][2] * next + cfull[bj];
                        if (ai == 0 && m == 0) { if (wr == 0 && fr == 0 && top_ok) cv[bj] = cv[bj] - bv[bj] * w[bj][0]; }
                        if (ai == 1 && m == 3) { if (wr == 1 && fr == 15 && bot_ok) cv[bj] = cv[bj] - bv[bj] * w[bj][2]; } }
                    float o[4];
#pragma unroll
                    for (int e = 0; e < 4; ++e) { const float g = cv[0][e]; o[e] = g * __builtin_amdgcn_rcpf(1.0f + __expf(-g)) * cv[1][e]; }
                    const unsigned p0 = cvt_pk_bf16(o[0], o[1]), p1 = cvt_pk_bf16(o[2], o[3]);
                    {
                      typedef unsigned u32x2e __attribute__((ext_vector_type(2)));
                      *(u32x2e*)((char*)A + (aoff + (unsigned)(rt * 128 + 8 * n))) = (u32x2e){p0, p1}; }
                }
            }
        }
        asm volatile("s_waitcnt lgkmcnt(0)" ::: "memory"); __builtin_amdgcn_s_barrier(); asm volatile("" ::: "memory");
        ++ui;
#undef EG_LOADC
#undef EG_LOADW
    }
};
template <class Sched> __device__ __forceinline__ void fill_tabs(const Sched& S, const float* ss, const float* bvec, int ldb, PG8_LAS float* rstab, PG8_LAS float* bvtab, int tid) {
    Unit u;
    for (int i = 0; S.next(i, u); ++i) {
        if (tid < 256) rstab[i * BM + tid] = rsqrtf(ss[u.pm * BM + tid] * (1.0f / DM) + EPS);
        else if (bvec) bvtab[i * BM + tid - 256] = bvec[(size_t)row_batch(u.pm * BM) * ldb + u.pn * BM + tid - 256]; }
    __syncthreads();
}
}
namespace att {
using bf16x8 = __attribute__((ext_vector_type(8))) short;
using s16x4  = __attribute__((ext_vector_type(4))) short;
using f32x16 = __attribute__((ext_vector_type(16))) float;
using u32x4  = __attribute__((ext_vector_type(4))) unsigned;
constexpr int NW = 8, QBLK = 32, KVBLK = 64, DV = 128;
constexpr float THR = 8.f;
#define ATT_SBAR() __builtin_amdgcn_sched_barrier(0)
__device__ __forceinline__ int crow(int r, int hi) { return (r & 3) + 8 * (r >> 2) + 4 * hi; }
__device__ __forceinline__ unsigned cvtpk(float lo, float hi) { unsigned r; asm volatile("v_cvt_pk_bf16_f32 %0, %1, %2" : "=v"(r) : "v"(lo), "v"(hi)); return r; }
template <int DK> __device__ __forceinline__ int kswz(int row, int colB) { return row * (2 * DK + 16) + colB; }

template <int DK> __device__ __forceinline__ void partialSM(f32x16& p0, f32x16& p1, float& m_reg, float& mn, float& alpha) {
  constexpr float SCALE = (DK == 128) ? 0.08838834764831845f : 0.07216878364870323f;
  constexpr float C = SCALE * 1.4426950408889634f;
  float pmax = p0[0];
#pragma unroll
  for (int r = 1; r < 16; ++r) pmax = fmaxf(pmax, p0[r]);
#pragma unroll
  for (int r = 0; r < 16; ++r) pmax = fmaxf(pmax, p1[r]);
  { auto rr = __builtin_amdgcn_permlane32_swap(__float_as_uint(pmax), __float_as_uint(pmax), false, false);
    pmax = fmaxf(__uint_as_float(rr[0]), __uint_as_float(rr[1])); }
  if (__builtin_expect(__all(pmax - m_reg <= THR / SCALE), 1)) { mn = m_reg; alpha = 1.f; }
  else { mn = fmaxf(m_reg, pmax); alpha = __builtin_amdgcn_exp2f((m_reg - mn) * C); m_reg = mn; }
  float mnC = -mn * C;
#pragma unroll
  for (int r = 0; r < 16; ++r) p0[r] = fmaf(p0[r], C, mnC);
#pragma unroll
  for (int r = 0; r < 16; ++r) p1[r] = fmaf(p1[r], C, mnC);
#pragma unroll
  for (int r = 0; r < 16; ++r) p0[r] = __builtin_amdgcn_exp2f(p0[r]);
}
__device__ __forceinline__ void finishSM(f32x16& p0, f32x16& p1, float alpha, float& l_reg, bf16x8& pa0, bf16x8& pa1, bf16x8& pa2, bf16x8& pa3) {
#pragma unroll
  for (int r = 0; r < 16; ++r) p1[r] = __builtin_amdgcn_exp2f(p1[r]);
  float ps = 0;
#pragma unroll
  for (int r = 0; r < 16; ++r) ps += p0[r];
#pragma unroll
  for (int r = 0; r < 16; ++r) ps += p1[r];
  { auto rr = __builtin_amdgcn_permlane32_swap(__float_as_uint(ps), __float_as_uint(ps), false, false);
    ps = __uint_as_float(rr[0]) + __uint_as_float(rr[1]); }
  l_reg = l_reg * alpha + ps;
#define ATT_PK4(P, BASE, OUT) do { unsigned a0 = cvtpk(P[BASE + 0], P[BASE + 1]), a1 = cvtpk(P[BASE + 2], P[BASE + 3]);   \
    unsigned b0 = cvtpk(P[BASE + 4], P[BASE + 5]), b1 = cvtpk(P[BASE + 6], P[BASE + 7]);                              \
    auto r0 = __builtin_amdgcn_permlane32_swap(a0, b0, false, false); auto r1 = __builtin_amdgcn_permlane32_swap(a1, b1, false, false); \
    u32x4 w = {r0[0], r1[0], r0[1], r1[1]}; OUT = *reinterpret_cast<bf16x8*>(&w); } while (0)
  ATT_PK4(p0, 0, pa0); ATT_PK4(p0, 8, pa1); ATT_PK4(p1, 0, pa2); ATT_PK4(p1, 8, pa3);
#undef ATT_PK4
}
template <int DK> __device__ __forceinline__ void qkt(f32x16& p0, f32x16& p1, const char* Ks, const bf16x8* qr, const char* ldsb, int qxo, int r32, int hi) {
  p0 = f32x16{}; p1 = f32x16{};
  if constexpr (DK > 128) asm volatile("" : "+v"(qxo));
  const char* qx = ldsb + qxo;
#pragma unroll
  for (int d0 = 0; d0 < DK / 16; ++d0) { int cb = (d0 * 16 + hi * 8) * 2;
    bf16x8 b0 = *reinterpret_cast<const bf16x8*>(Ks + kswz<DK>(r32, cb));
    bf16x8 b1 = *reinterpret_cast<const bf16x8*>(Ks + kswz<DK>(32 + r32, cb));
    bf16x8 qf; if (d0 < 8) qf = qr[d0]; else qf = *reinterpret_cast<const bf16x8*>(qx + (d0 - 8) * 1024);
    p0 = __builtin_amdgcn_mfma_f32_32x32x16_bf16(b0, qf, p0, 0, 0, 0);
    p1 = __builtin_amdgcn_mfma_f32_32x32x16_bf16(b1, qf, p1, 0, 0, 0);
    if ((d0 & 3) == 3) ATT_SBAR(); }
}
__device__ __forceinline__ int v_st(int k, int c) { const int kk = (k & ~0xC) | ((k & 4) << 1) | ((k & 8) >> 1); return ((kk >> 3) * 4 + (c >> 5)) * 512 + ((kk & 7) * 32 + (c & 31)) * 2; }
__device__ __forceinline__ int v_rd_base(int lane) { return ((lane & 3) << 3) | (((lane >> 2) & 3) << 6) | (((lane >> 4) & 1) << 5) | (((lane >> 5) & 1) << 8); }
constexpr int v_rd_off(int d0, int ks, int half) { return d0 * 512 + ks * 4096 + half * 2048; }
template <int OFF> __device__ __forceinline__ s16x4 tr_read(int vb) {
  s16x4 r; asm volatile("ds_read_b64_tr_b16 %0, %1 offset:%2" : "=&v"(r) : "v"(vb), "i"(OFF) : "memory"); return r;
}
template <int D0> __device__ __forceinline__ void pv_one(f32x16& od, int vb, bf16x8 pa0, bf16x8 pa1, bf16x8 pa2, bf16x8 pa3) {
  const s16x4 l0 = tr_read<v_rd_off(D0, 0, 0)>(vb), h0 = tr_read<v_rd_off(D0, 0, 1)>(vb), l1 = tr_read<v_rd_off(D0, 1, 0)>(vb), h1 = tr_read<v_rd_off(D0, 1, 1)>(vb);
  const s16x4 l2 = tr_read<v_rd_off(D0, 2, 0)>(vb), h2 = tr_read<v_rd_off(D0, 2, 1)>(vb), l3 = tr_read<v_rd_off(D0, 3, 0)>(vb), h3 = tr_read<v_rd_off(D0, 3, 1)>(vb);
  asm volatile("s_waitcnt lgkmcnt(0)" ::: "memory"); ATT_SBAR();
#define ATT_PK(L, H) (bf16x8){L[0], L[1], L[2], L[3], H[0], H[1], H[2], H[3]}
  od = __builtin_amdgcn_mfma_f32_32x32x16_bf16(pa0, ATT_PK(l0, h0), od, 0, 0, 0);
  od = __builtin_amdgcn_mfma_f32_32x32x16_bf16(pa1, ATT_PK(l1, h1), od, 0, 0, 0);
  od = __builtin_amdgcn_mfma_f32_32x32x16_bf16(pa2, ATT_PK(l2, h2), od, 0, 0, 0);
  od = __builtin_amdgcn_mfma_f32_32x32x16_bf16(pa3, ATT_PK(l3, h3), od, 0, 0, 0);
#undef ATT_PK
}
__device__ __forceinline__ void pv_d0(f32x16* o, int vb, bf16x8 pa0, bf16x8 pa1, bf16x8 pa2, bf16x8 pa3) {
  pv_one<0>(o[0], vb, pa0, pa1, pa2, pa3); pv_one<1>(o[1], vb, pa0, pa1, pa2, pa3); pv_one<2>(o[2], vb, pa0, pa1, pa2, pa3); pv_one<3>(o[3], vb, pa0, pa1, pa2, pa3);
}
template <int DK> struct Cfg { static constexpr int SHM_V = KVBLK * DV * 2, SHM_K = KVBLK * (DK * 2 + 16), SHM_Q = (DK > 128) ? NW * 4096 : 0, SHM = 2 * SHM_V + 2 * SHM_K + NW * 64 * 4 + SHM_Q; };

template <int DK, int SDEPTH, int ldq, int ldk, int ldv, int ldo>
__device__ __forceinline__ void attn_body(const unsigned short* __restrict__ Qb, const unsigned short* __restrict__ Kh,
                                          const unsigned short* __restrict__ Vh, unsigned short* __restrict__ Ob, int seq, char* lds) {
  constexpr int SHM_V = Cfg<DK>::SHM_V, SHM_K = Cfg<DK>::SHM_K, NQ = (DK > 128 ? 8 : DK / 16), NKI = DK / 64;
  const int tid = tid_fresh(), wid = tid >> 6, lane = tid & 63, r32 = lane & 31, hi = lane >> 5;
  char* V_lds = lds; char* K_lds = lds + 2 * SHM_V;
  float* ws = (float*)(lds + 2 * SHM_V + 2 * SHM_K) + wid * 64; float* li_l = ws; float* al_l = ws + 32;
  float m_reg = -1e30f, l_reg = 0; f32x16 o[4] = {}; bf16x8 qr[NQ];
  const unsigned short* Qw = Qb + (wid * QBLK + r32) * ldq + hi * 8;
#pragma unroll
  for (int d0 = 0; d0 < NQ; ++d0) qr[d0] = *reinterpret_cast<const bf16x8*>(Qw + d0 * 16);
  const int qxo = 2 * SHM_V + 2 * SHM_K + NW * 64 * 4 + wid * 4096 + lane * 16; char* qx = lds + qxo;
  if constexpr (DK > 128) {
#pragma unroll
    for (int d0 = 8; d0 < DK / 16; ++d0) *reinterpret_cast<bf16x8*>(qx + (d0 - 8) * 1024) = *reinterpret_cast<const bf16x8*>(Qw + d0 * 16);
  }
  const int sr = tid >> 4, sc = (tid & 15) * 8, vst0 = v_st(sr, sc);
  const int vgo = sr * ldv + sc;
  const int kr = tid >> 3, kc8 = tid & 7, kgo = kr * ldk + kc8 * 8, kdst = kswz<DK>(kr, kc8 * 16);
  const int vb0 = (int)(uintptr_t)V_lds + v_rd_base(lane);
  struct { bf16x8 vs0, vs1, ks[NKI]; } sr_[SDEPTH];
#define ATT_SLOAD(i, k0) do { const unsigned short* vt_ = Vh + (size_t)(k0) * ldv; const unsigned short* kt_ = Kh + (size_t)(k0) * ldk; \
    sr_[i].vs0 = *reinterpret_cast<const bf16x8*>(vt_ + vgo); sr_[i].vs1 = *reinterpret_cast<const bf16x8*>(vt_ + vgo + 32 * ldv); \
    _Pragma("unroll") for (int q_ = 0; q_ < NKI; ++q_) sr_[i].ks[q_] = *reinterpret_cast<const bf16x8*>(kt_ + kgo + 64 * q_); } while (0)
#define ATT_SWRITE(b, i) do { *(bf16x8*)(V_lds + (b) * SHM_V + vst0) = sr_[i].vs0; *(bf16x8*)(V_lds + (b) * SHM_V + vst0 + 8192) = sr_[i].vs1; \
    _Pragma("unroll") for (int q_ = 0; q_ < NKI; ++q_) *(bf16x8*)(K_lds + (b) * SHM_K + kdst + 128 * q_) = sr_[i].ks[q_]; } while (0)
#define ATT_SWAIT() do { if constexpr (SDEPTH == 2) { if constexpr (NKI == 2) asm volatile("s_waitcnt vmcnt(4)" ::: "memory"); else asm volatile("s_waitcnt vmcnt(5)" ::: "memory"); } else asm volatile("s_waitcnt vmcnt(0)" ::: "memory"); } while (0)
#define ATT_RESC(a) do { if (__any((a) < 1.f)) { if (hi == 0) al_l[r32] = (a); asm volatile("s_waitcnt lgkmcnt(0)" ::: "memory"); \
    _Pragma("unroll") for (int d = 0; d < 4; ++d) _Pragma("unroll") for (int r = 0; r < 16; ++r) o[d][r] *= al_l[crow(r, hi)]; } } while (0)
  f32x16 pA0, pA1, pB0, pB1; float mnA, mnB, alA, alB; bf16x8 pa0, pa1, pa2, pa3; const int NT = seq / KVBLK;
  constexpr int SE = 0, SO = SDEPTH - 1;
  ATT_SLOAD(SE, 0); asm volatile("s_waitcnt vmcnt(0)" ::: "memory"); ATT_SWRITE(0, SE); __syncthreads();
  qkt<DK>(pA0, pA1, K_lds, qr, lds, qxo, r32, hi); partialSM<DK>(pA0, pA1, m_reg, mnA, alA);
  ATT_SLOAD(SO, KVBLK); if constexpr (SDEPTH == 2) { if (2 < NT) ATT_SLOAD(SE, 2 * KVBLK); }
  ATT_SWAIT(); ATT_SWRITE(1, SO); __syncthreads();
  for (int j = 1; j + 1 < NT; j += 2) {
    ATT_SBAR(); qkt<DK>(pB0, pB1, K_lds + SHM_K, qr, lds, qxo, r32, hi);
    finishSM(pA0, pA1, alA, l_reg, pa0, pa1, pa2, pa3); ATT_SBAR();
    ATT_SLOAD(SO, (j + SDEPTH) * KVBLK); ATT_SBAR();
    pv_d0(o, vb0, pa0, pa1, pa2, pa3); partialSM<DK>(pB0, pB1, m_reg, mnB, alB);
    __syncthreads(); ATT_SWAIT(); ATT_SWRITE(0, SE);
    ATT_RESC(alB); __syncthreads();
    ATT_SBAR(); qkt<DK>(pA0, pA1, K_lds, qr, lds, qxo, r32, hi);
    finishSM(pB0, pB1, alB, l_reg, pa0, pa1, pa2, pa3); ATT_SBAR();
    if (SDEPTH == 1 || j + 3 < NT) ATT_SLOAD(SE, (j + 1 + SDEPTH) * KVBLK); ATT_SBAR();
    pv_d0(o, vb0 + SHM_V, pa0, pa1, pa2, pa3); partialSM<DK>(pA0, pA1, m_reg, mnA, alA);
    __syncthreads(); ATT_SWAIT(); ATT_SWRITE(1, SO);
    ATT_RESC(alA); __syncthreads();
  }
  ATT_SBAR(); qkt<DK>(pB0, pB1, K_lds + SHM_K, qr, lds, qxo, r32, hi);
  finishSM(pA0, pA1, alA, l_reg, pa0, pa1, pa2, pa3); ATT_SBAR();
  pv_d0(o, vb0, pa0, pa1, pa2, pa3); partialSM<DK>(pB0, pB1, m_reg, mnB, alB);
  __syncthreads(); ATT_RESC(alB);
  finishSM(pB0, pB1, alB, l_reg, pa0, pa1, pa2, pa3); ATT_SBAR();
  pv_d0(o, vb0 + SHM_V, pa0, pa1, pa2, pa3);
  if (hi == 0) li_l[r32] = l_reg; asm volatile("s_waitcnt lgkmcnt(0)" ::: "memory");
  float rli[16];
#pragma unroll
  for (int r = 0; r < 16; ++r) rli[r] = __builtin_amdgcn_rcpf(li_l[crow(r, hi)]);
  unsigned short* Ow = Ob + (wid * QBLK) * ldo;
#pragma unroll
  for (int r = 0; r < 16; ++r) { int orow = crow(r, hi);
#pragma unroll
    for (int d0 = 0; d0 < 4; ++d0) Ow[orow * ldo + d0 * 32 + r32] = (unsigned short)f2bf(o[d0][r] * rli[r]); }
  __syncthreads();
#undef ATT_SLOAD
#undef ATT_SWRITE
#undef ATT_SWAIT
#undef ATT_RESC
}

template <int DK, int ldq, int ldk, int ldv, int ldo>
__device__ __forceinline__ void attn_body_seq(const unsigned short* __restrict__ Qb, const unsigned short* __restrict__ Kh,
                                              const unsigned short* __restrict__ Vh, unsigned short* __restrict__ Ob, int seq, char* lds) {
  constexpr int SHM_V = Cfg<DK>::SHM_V, SHM_K = Cfg<DK>::SHM_K, NQ = (DK > 128 ? 8 : DK / 16), NKI = DK / 64;
  const int tid = tid_fresh(), wid = tid >> 6, lane = tid & 63, r32 = lane & 31, hi = lane >> 5;
  char* V_lds = lds; char* K_lds = lds + 2 * SHM_V;
  float* ws = (float*)(lds + 2 * SHM_V + 2 * SHM_K) + wid * 64; float* li_l = ws; float* al_l = ws + 32;
  float m_reg = -1e30f, l_reg = 0; f32x16 o[4] = {}; bf16x8 qr[NQ];
  const unsigned short* Qw = Qb + (wid * QBLK + r32) * ldq + hi * 8;
#pragma unroll
  for (int d0 = 0; d0 < NQ; ++d0) qr[d0] = *reinterpret_cast<const bf16x8*>(Qw + d0 * 16);
  const int qxo = 2 * SHM_V + 2 * SHM_K + NW * 64 * 4 + wid * 4096 + lane * 16; char* qx = lds + qxo;
  if constexpr (DK > 128) {
#pragma unroll
    for (int d0 = 8; d0 < DK / 16; ++d0) *reinterpret_cast<bf16x8*>(qx + (d0 - 8) * 1024) = *reinterpret_cast<const bf16x8*>(Qw + d0 * 16);
  }
  const int sr = tid >> 4, sc = (tid & 15) * 8, vst0 = v_st(sr, sc);
  const int vgo = sr * ldv + sc;
  const int kr = tid >> 3, kc8 = tid & 7, kgo = kr * ldk + kc8 * 8, kdst = kswz<DK>(kr, kc8 * 16);
  const int vb0 = (int)(uintptr_t)V_lds + v_rd_base(lane);
  bf16x8 vs0, vs1, ks[NKI];
#define ATT_SLOAD1(k0) do { const unsigned short* vt_ = Vh + (size_t)(k0) * ldv; const unsigned short* kt_ = Kh + (size_t)(k0) * ldk; \
    vs0 = *reinterpret_cast<const bf16x8*>(vt_ + vgo); vs1 = *reinterpret_cast<const bf16x8*>(vt_ + vgo + 32 * ldv); \
    _Pragma("unroll") for (int q_ = 0; q_ < NKI; ++q_) ks[q_] = *reinterpret_cast<const bf16x8*>(kt_ + kgo + 64 * q_); } while (0)
#define ATT_SWRITE1(b) do { *(bf16x8*)(V_lds + (b) * SHM_V + vst0) = vs0; *(bf16x8*)(V_lds + (b) * SHM_V + vst0 + 8192) = vs1; \
    _Pragma("unroll") for (int q_ = 0; q_ < NKI; ++q_) *(bf16x8*)(K_lds + (b) * SHM_K + kdst + 128 * q_) = ks[q_]; } while (0)
  const int NT = seq / KVBLK;
  ATT_SLOAD1(0); ATT_SWRITE1(0); __syncthreads();
#pragma unroll 1
  for (int j = 0; j < NT; ++j) {
    const int b = j & 1;
    f32x16 p0, p1; float mn, al; bf16x8 pa0, pa1, pa2, pa3;
    if (j + 1 < NT) ATT_SLOAD1((j + 1) * KVBLK);
    ATT_SBAR();
    qkt<DK>(p0, p1, K_lds + b * SHM_K, qr, lds, qxo, r32, hi);
    partialSM<DK>(p0, p1, m_reg, mn, al);
    if (__any(al < 1.f)) { if (hi == 0) al_l[r32] = al; asm volatile("s_waitcnt lgkmcnt(0)" ::: "memory");
#pragma unroll
      for (int d = 0; d < 4; ++d)
#pragma unroll
        for (int r = 0; r < 16; ++r) o[d][r] *= al_l[crow(r, hi)]; }
    finishSM(p0, p1, al, l_reg, pa0, pa1, pa2, pa3); ATT_SBAR();
    pv_d0(o, vb0 + b * SHM_V, pa0, pa1, pa2, pa3);
    if (j + 1 < NT) ATT_SWRITE1(b ^ 1);
    __syncthreads();
  }
  if (hi == 0) li_l[r32] = l_reg; asm volatile("s_waitcnt lgkmcnt(0)" ::: "memory");
  float rli[16];
#pragma unroll
  for (int r = 0; r < 16; ++r) rli[r] = __builtin_amdgcn_rcpf(li_l[crow(r, hi)]);
  unsigned short* Ow = Ob + (wid * QBLK) * ldo;
#pragma unroll
  for (int r = 0; r < 16; ++r) { int orow = crow(r, hi);
#pragma unroll
    for (int d0 = 0; d0 < 4; ++d0) Ow[orow * ldo + d0 * 32 + r32] = (unsigned short)f2bf(o[d0][r] * rli[r]); }
  __syncthreads();
#undef ATT_SLOAD1
#undef ATT_SWRITE1
}

template <int DK> __device__ __forceinline__ void qk_half(f32x16& p, const char* Ks, int rowoff, const bf16x8* qr, const char* ldsb, int qxo, int r32, int hi) {
  p = f32x16{};
  const char* qx = ldsb + qxo;
#pragma unroll
  for (int d0 = 0; d0 < DK / 16; ++d0) { int cb = (d0 * 16 + hi * 8) * 2;
    bf16x8 b0 = *reinterpret_cast<const bf16x8*>(Ks + kswz<DK>(rowoff + r32, cb));
    bf16x8 qf; if (d0 < 8) qf = qr[d0]; else qf = *reinterpret_cast<const bf16x8*>(qx + (d0 - 8) * 1024);
    p = __builtin_amdgcn_mfma_f32_32x32x16_bf16(b0, qf, p, 0, 0, 0); }
}
template <int KH> __device__ __forceinline__ void pv_half(f32x16* o, int vb, bf16x8 pa, bf16x8 pb) {
#define ATT_PK(L, H) (bf16x8){L[0], L[1], L[2], L[3], H[0], H[1], H[2], H[3]}
#define ATT_PVD(D0) do { const s16x4 l0 = tr_read<v_rd_off(D0, 2 * KH, 0)>(vb), h0 = tr_read<v_rd_off(D0, 2 * KH, 1)>(vb), l1 = tr_read<v_rd_off(D0, 2 * KH + 1, 0)>(vb), h1 = tr_read<v_rd_off(D0, 2 * KH + 1, 1)>(vb); \
    asm volatile("s_waitcnt lgkmcnt(0)" ::: "memory"); ATT_SBAR();   \
    o[D0] = __builtin_amdgcn_mfma_f32_32x32x16_bf16(pa, ATT_PK(l0, h0), o[D0], 0, 0, 0); o[D0] = __builtin_amdgcn_mfma_f32_32x32x16_bf16(pb, ATT_PK(l1, h1), o[D0], 0, 0, 0); } while (0)
  ATT_PVD(0); ATT_PVD(1); ATT_PVD(2); ATT_PVD(3);
#undef ATT_PVD
#undef ATT_PK
}
__device__ __forceinline__ float exp_pack(f32x16& p, bf16x8& pa, bf16x8& pb) {
#pragma unroll
  for (int r = 0; r < 16; ++r) p[r] = __builtin_amdgcn_exp2f(p[r]);
  float ps = 0.f;
#pragma unroll
  for (int r = 0; r < 16; ++r) ps += p[r];
#define ATT_PK4(P, BASE, OUT) do { unsigned a0 = cvtpk(P[BASE + 0], P[BASE + 1]), a1 = cvtpk(P[BASE + 2], P[BASE + 3]);   \
    unsigned b0 = cvtpk(P[BASE + 4], P[BASE + 5]), b1 = cvtpk(P[BASE + 6], P[BASE + 7]);                              \
    auto r0 = __builtin_amdgcn_permlane32_swap(a0, b0, false, false); auto r1 = __builtin_amdgcn_permlane32_swap(a1, b1, false, false); \
    u32x4 w = {r0[0], r1[0], r0[1], r1[1]}; OUT = *reinterpret_cast<bf16x8*>(&w); } while (0)
  ATT_PK4(p, 0, pa); ATT_PK4(p, 8, pb);
#undef ATT_PK4
  return ps;
}
template <int DK, int ldq, int ldk, int ldv, int ldo>
__device__ __forceinline__ void attn_body_nomax(const unsigned short* __restrict__ Qb, const unsigned short* __restrict__ Kh,
                                                const unsigned short* __restrict__ Vh, unsigned short* __restrict__ Ob, int seq, char* lds) {
  constexpr int SHM_V = Cfg<DK>::SHM_V, SHM_K = Cfg<DK>::SHM_K, NQ = (DK > 128 ? 8 : DK / 16), NKI = DK / 64;
  const int tid = tid_fresh(), wid = tid >> 6, lane = tid & 63, r32 = lane & 31, hi = lane >> 5;
  char* V_lds = lds; char* K_lds = lds + 2 * SHM_V;
  float* ws = (float*)(lds + 2 * SHM_V + 2 * SHM_K) + wid * 64; float* li_l = ws;
  float l_reg = 0; f32x16 o[4] = {}; bf16x8 qr[NQ];
  const unsigned short* Qw = Qb + (wid * QBLK + r32) * ldq + hi * 8;
#pragma unroll
  for (int d0 = 0; d0 < NQ; ++d0) qr[d0] = *reinterpret_cast<const bf16x8*>(Qw + d0 * 16);
  int qxo = 2 * SHM_V + 2 * SHM_K + NW * 64 * 4 + wid * 4096 + lane * 16; char* qx = lds + qxo;
  if constexpr (DK > 128) {
#pragma unroll
    for (int d0 = 8; d0 < DK / 16; ++d0) *reinterpret_cast<bf16x8*>(qx + (d0 - 8) * 1024) = *reinterpret_cast<const bf16x8*>(Qw + d0 * 16);
  }
  const int sr = tid >> 4, sc = (tid & 15) * 8, vst0 = v_st(sr, sc);
  const int vgo = sr * ldv + sc;
  const int kr = tid >> 3, kc8 = tid & 7, kgo = kr * ldk + kc8 * 8, kdst = kswz<DK>(kr, kc8 * 16);
  const int vb0 = (int)(uintptr_t)V_lds + v_rd_base(lane);
  bf16x8 vs0, vs1, ks[NKI];
#define ATT_SLOAD1(k0) do { const unsigned short* vt_ = Vh + (size_t)(k0) * ldv; const unsigned short* kt_ = Kh + (size_t)(k0) * ldk; \
    vs0 = *reinterpret_cast<const bf16x8*>(vt_ + vgo); vs1 = *reinterpret_cast<const bf16x8*>(vt_ + vgo + 32 * ldv); \
    _Pragma("unroll") for (int q_ = 0; q_ < NKI; ++q_) ks[q_] = *reinterpret_cast<const bf16x8*>(kt_ + kgo + 64 * q_); } while (0)
#define ATT_SWRITE1(b) do { *(bf16x8*)(V_lds + (b) * SHM_V + vst0) = vs0; *(bf16x8*)(V_lds + (b) * SHM_V + vst0 + 8192) = vs1; \
    _Pragma("unroll") for (int q_ = 0; q_ < NKI; ++q_) *(bf16x8*)(K_lds + (b) * SHM_K + kdst + 128 * q_) = ks[q_]; } while (0)
  const int NT = seq / KVBLK;
  ATT_SLOAD1(0); ATT_SWRITE1(0); __syncthreads();
#pragma unroll 1
  for (int j = 0; j < NT; ++j) {
    const int b = j & 1;
    f32x16 p0, p1; bf16x8 pa0, pa1, pa2, pa3;
    if (j + 1 < NT) ATT_SLOAD1((j + 1) * KVBLK);
    if constexpr (DK > 128) asm volatile("" : "+v"(qxo));
    ATT_SBAR();
    qk_half<DK>(p0, K_lds + b * SHM_K, 0, qr, lds, qxo, r32, hi);
    ATT_SBAR();
    qk_half<DK>(p1, K_lds + b * SHM_K, 32, qr, lds, qxo, r32, hi);
    float ps = exp_pack(p0, pa0, pa1);
    ATT_SBAR();
    pv_half<0>(o, vb0 + b * SHM_V, pa0, pa1);
    ps += exp_pack(p1, pa2, pa3);
    ATT_SBAR();
    pv_half<1>(o, vb0 + b * SHM_V, pa2, pa3);
    l_reg += ps;
    if (j + 1 < NT) ATT_SWRITE1(b ^ 1);
    __syncthreads();
  }
  { auto rr = __builtin_amdgcn_permlane32_swap(__float_as_uint(l_reg), __float_as_uint(l_reg), false, false); l_reg = __uint_as_float(rr[0]) + __uint_as_float(rr[1]); }
  if (hi == 0) li_l[r32] = l_reg; asm volatile("s_waitcnt lgkmcnt(0)" ::: "memory");
  float rli[16];
#pragma unroll
  for (int r = 0; r < 16; ++r) rli[r] = __builtin_amdgcn_rcpf(li_l[crow(r, hi)]);
  unsigned short* Ow = Ob + (wid * QBLK) * ldo;
#pragma unroll
  for (int r = 0; r < 16; ++r) { int orow = crow(r, hi);
#pragma unroll
    for (int d0 = 0; d0 < 4; ++d0) Ow[orow * ldo + d0 * 32 + r32] = (unsigned short)f2bf(o[d0][r] * rli[r]); }
  __syncthreads();
#undef ATT_SLOAD1
#undef ATT_SWRITE1
}

typedef float f32x4a __attribute__((ext_vector_type(4)));
__device__ __forceinline__ int v16_st(int key, int d) { return (((key >> 4) * 8 + (d >> 4)) * 4 + ((key >> 2) & 3)) * 128 + ((key & 3) * 16 + (d & 15)) * 2; }
template <int OFF> __device__ __forceinline__ s16x4 tr_read16(int vb) { s16x4 r; asm volatile("ds_read_b64_tr_b16 %0, %1 offset:%2" : "=&v"(r) : "v"(vb), "i"(OFF) : "memory"); return r; }
template <int NDS, int ST>
__device__ __forceinline__ void sgb_steps() {
  if constexpr (ST < 4 * NDS) {
    __builtin_amdgcn_sched_group_barrier(0x008, 2, 0);
    if constexpr (ST >= NDS) __builtin_amdgcn_sched_group_barrier(0x400, (((ST % NDS) + 1) * 8) / NDS - ((ST % NDS) * 8) / NDS, 0);
    if constexpr (ST + 4 < 4 * NDS) __builtin_amdgcn_sched_group_barrier(0x100, 1, 0);
    sgb_steps<NDS, ST + 1>();
  }
}
template <int DK, int ldq, int ldk, int ldv, int ldo>
__device__ __forceinline__ void attn_body16(const unsigned short* __restrict__ Qb, const unsigned short* __restrict__ Kh,
                                            const unsigned short* __restrict__ Vh, unsigned short* __restrict__ Ob, int seq, char* lds) {
  constexpr int SHM_V = KVBLK * DV * 2, KP = 2 * DK + 16, SHM_K = KVBLK * KP, NDS = DK / 32, NKI = DK / 64;
  const int tid = tid_fresh(), wid = tid >> 6, lane = tid & 63, c16 = lane & 15, g = lane >> 4;
  char* V_lds = lds; char* K_lds = lds + 2 * SHM_V;
  f32x4a ot[8][2]; float lsum[2] = {0.f, 0.f}; bf16x8 qf[2][NDS];
#pragma unroll
  for (int db = 0; db < 8; ++db) { ot[db][0] = (f32x4a){0.f, 0.f, 0.f, 0.f}; ot[db][1] = (f32x4a){0.f, 0.f, 0.f, 0.f}; }
#pragma unroll
  for (int qb = 0; qb < 2; ++qb)
#pragma unroll
    for (int ds = 0; ds < NDS; ++ds) qf[qb][ds] = *reinterpret_cast<const bf16x8*>(Qb + (wid * QBLK + 16 * qb + c16) * ldq + 32 * ds + 8 * g);
  const int sr = tid >> 4, sc = (tid & 15) * 8, vst0 = v16_st(sr, sc), vst1 = v16_st(32 + sr, sc);
  const int vgo = sr * ldv + sc;
  const int kr = tid >> 3, kc8 = tid & 7, kgo = kr * ldk + kc8 * 8, kdst = kr * KP + kc8 * 16;
  const int kfo = c16 * KP + 16 * g;
  const int vb0 = (int)(uintptr_t)V_lds + g * 128 + 8 * c16;
  bf16x8 vs0, vs1, ks[NKI];
#define A16_SLOAD(k0) do { const unsigned short* vt_ = Vh + (size_t)(k0) * ldv; const unsigned short* kt_ = Kh + (size_t)(k0) * ldk; \
    vs0 = *reinterpret_cast<const bf16x8*>(vt_ + vgo); vs1 = *reinterpret_cast<const bf16x8*>(vt_ + vgo + 32 * ldv); \
    _Pragma("unroll") for (int q_ = 0; q_ < NKI; ++q_) ks[q_] = *reinterpret_cast<const bf16x8*>(kt_ + kgo + 64 * q_); } while (0)
#define A16_SWRITE(b) do { *(bf16x8*)(V_lds + (b) * SHM_V + vst0) = vs0; *(bf16x8*)(V_lds + (b) * SHM_V + vst1) = vs1; \
    _Pragma("unroll") for (int q_ = 0; q_ < NKI; ++q_) *(bf16x8*)(K_lds + (b) * SHM_K + kdst + 128 * q_) = ks[q_]; } while (0)
  const int NT = seq / KVBLK;
  A16_SLOAD(0); A16_SWRITE(0); __syncthreads();
#pragma unroll 1
  for (int j = 0; j < NT; ++j) {
    const int b = j & 1;
    if (j + 1 < NT) A16_SLOAD((j + 1) * KVBLK);
    ATT_SBAR();
    f32x4a sct[4][2];
    const char* Kt = K_lds + b * SHM_K + kfo;
#define A16_EXP(kb_, e_) do { sct[kb_][(e_) >> 2][(e_) & 3] = __builtin_amdgcn_exp2f(sct[kb_][(e_) >> 2][(e_) & 3]); } while (0)
    bf16x8 kq[4];
#pragma unroll
    for (int s0 = 0; s0 < 3; ++s0) kq[s0] = *reinterpret_cast<const bf16x8*>(Kt + (s0 / NDS) * 16 * KP + (s0 % NDS) * 64);
#pragma unroll
    for (int kb = 0; kb < 4; ++kb) {
      sct[kb][0] = (f32x4a){0.f, 0.f, 0.f, 0.f}; sct[kb][1] = (f32x4a){0.f, 0.f, 0.f, 0.f};
#pragma unroll
      for (int ds = 0; ds < NDS; ++ds) { const int st = kb * NDS + ds, sn = st + 3;
        if (sn < 4 * NDS) kq[sn & 3] = *reinterpret_cast<const bf16x8*>(Kt + (sn / NDS) * 16 * KP + (sn % NDS) * 64);
        sct[kb][0] = __builtin_amdgcn_mfma_f32_16x16x32_bf16(kq[st & 3], qf[0][ds], sct[kb][0], 0, 0, 0);
        sct[kb][1] = __builtin_amdgcn_mfma_f32_16x16x32_bf16(kq[st & 3], qf[1][ds], sct[kb][1], 0, 0, 0);
        if (kb > 0) {
#pragma unroll
          for (int e = (ds * 8) / NDS; e < ((ds + 1) * 8) / NDS; ++e) A16_EXP(kb > 0 ? kb - 1 : 0, e); }
        ATT_SBAR(); } }
    bf16x8 pf[2][2];
#define A16_PACK(ksp_) do { _Pragma("unroll") for (int qb = 0; qb < 2; ++qb) { u32x4 w; w.x = cvtpk(sct[2 * (ksp_)][qb][0], sct[2 * (ksp_)][qb][1]); w.y = cvtpk(sct[2 * (ksp_)][qb][2], sct[2 * (ksp_)][qb][3]); \
        w.z = cvtpk(sct[2 * (ksp_) + 1][qb][0], sct[2 * (ksp_) + 1][qb][1]); w.w = cvtpk(sct[2 * (ksp_) + 1][qb][2], sct[2 * (ksp_) + 1][qb][3]); pf[qb][ksp_] = __builtin_bit_cast(bf16x8, w); \
        lsum[qb] += ((sct[2 * (ksp_)][qb][0] + sct[2 * (ksp_)][qb][1]) + (sct[2 * (ksp_)][qb][2] + sct[2 * (ksp_)][qb][3])) + ((sct[2 * (ksp_) + 1][qb][0] + sct[2 * (ksp_) + 1][qb][1]) + (sct[2 * (ksp_) + 1][qb][2] + sct[2 * (ksp_) + 1][qb][3])); } } while (0)
    A16_PACK(0);
    ATT_SBAR();
    const int vb = vb0 + b * SHM_V;
#define A16_PV(KSP, DB0, X) do { s16x4 t_[4][2]; \
      t_[0][0] = tr_read16<(2 * KSP) * 4096 + (DB0 + 0) * 512>(vb); t_[0][1] = tr_read16<(2 * KSP + 1) * 4096 + (DB0 + 0) * 512>(vb); \
      t_[1][0] = tr_read16<(2 * KSP) * 4096 + (DB0 + 1) * 512>(vb); t_[1][1] = tr_read16<(2 * KSP + 1) * 4096 + (DB0 + 1) * 512>(vb); \
      t_[2][0] = tr_read16<(2 * KSP) * 4096 + (DB0 + 2) * 512>(vb); t_[2][1] = tr_read16<(2 * KSP + 1) * 4096 + (DB0 + 2) * 512>(vb); \
      t_[3][0] = tr_read16<(2 * KSP) * 4096 + (DB0 + 3) * 512>(vb); t_[3][1] = tr_read16<(2 * KSP + 1) * 4096 + (DB0 + 3) * 512>(vb); \
      asm volatile("s_waitcnt lgkmcnt(0)" ::: "memory"); ATT_SBAR(); \
      _Pragma("unroll") for (int d_ = 0; d_ < 4; ++d_) { const bf16x8 vf = (bf16x8){t_[d_][0][0], t_[d_][0][1], t_[d_][0][2], t_[d_][0][3], t_[d_][1][0], t_[d_][1][1], t_[d_][1][2], t_[d_][1][3]}; \
        ot[DB0 + d_][0] = __builtin_amdgcn_mfma_f32_16x16x32_bf16(vf, pf[0][KSP], ot[DB0 + d_][0], 0, 0, 0); \
        ot[DB0 + d_][1] = __builtin_amdgcn_mfma_f32_16x16x32_bf16(vf, pf[1][KSP], ot[DB0 + d_][1], 0, 0, 0); } X; ATT_SBAR(); } while (0)
#define A16_PIN(qb_) asm volatile("" : "+v"(sct[3][qb_][0]), "+v"(sct[3][qb_][1]), "+v"(sct[3][qb_][2]), "+v"(sct[3][qb_][3]))
    A16_PV(0, 0, { A16_PIN(0); A16_EXP(3, 0); A16_EXP(3, 1); A16_EXP(3, 2); A16_EXP(3, 3); A16_PIN(0); });
    A16_PV(0, 4, { A16_PIN(1); A16_EXP(3, 4); A16_EXP(3, 5); A16_EXP(3, 6); A16_EXP(3, 7); A16_PIN(1); });
#undef A16_PIN
    A16_PACK(1);
    ATT_SBAR();
    A16_PV(1, 0, {}); A16_PV(1, 4, {});
#undef A16_PV
#undef A16_PACK
#undef A16_EXP
    if (j + 1 < NT) A16_SWRITE(b ^ 1);
    __syncthreads();
  }
#pragma unroll
  for (int qb = 0; qb < 2; ++qb) { float l = lsum[qb]; l += __shfl_xor(l, 16); l += __shfl_xor(l, 32); const float rl = __builtin_amdgcn_rcpf(l);
    unsigned short* Or = Ob + (wid * QBLK + 16 * qb + c16) * ldo + 4 * g;
#pragma unroll
    for (int db = 0; db < 8; ++db) { typedef unsigned u32x2a __attribute__((ext_vector_type(2)));
      u32x2a w; w.x = pk2(ot[db][qb][0] * rl, ot[db][qb][1] * rl); w.y = pk2(ot[db][qb][2] * rl, ot[db][qb][3] * rl);
      *(u32x2a*)(Or + 16 * db) = w; } }
  __syncthreads();
#undef A16_SLOAD
#undef A16_SWRITE
}
#undef ATT_SBAR
}
namespace hy {
using bf16x8 = __attribute__((ext_vector_type(8))) short;
using f32x16 = __attribute__((ext_vector_type(16))) float;
using u32x4  = __attribute__((ext_vector_type(4))) unsigned;
using u32x2  = __attribute__((ext_vector_type(2))) unsigned;
template <int L> struct HC {
    static constexpr int NMB = L / 2048, NCH = (L == 4096) ? 2 : 4, UST = L + 160, GRN = 2 * L / 64 * 72;
    static constexpr int UB = 4 * UST * 2, GB = GRN * 2, CHB = UB + GB, NK4 = L / 64 + 1;
    static_assert(NCH * CHB <= RING_BYTES, "hyena LDS");
};
__device__ __forceinline__ int crow(int r, int hi) { return (r & 3) + 8 * (r >> 2) + 4 * hi; }
__device__ __forceinline__ float bf2f(unsigned short v) { return __uint_as_float((unsigned)v << 16); }

typedef float f32x4h __attribute__((ext_vector_type(4)));
template <int L>
__device__ __forceinline__ void conv_kloop16(f32x4h (&acc)[2][8], const LAS char* gA, const LAS char* uB) {
    constexpr int NK2 = L / 64 + 1;
#pragma unroll
    for (int a = 0; a < 2; ++a)
#pragma unroll
        for (int r = 0; r < 8; ++r) acc[a][r] = (f32x4h){0.f, 0.f, 0.f, 0.f};
    for (int kk2 = 0; kk2 < NK2; ++kk2) {
#pragma unroll
        for (int h = 0; h < 2; ++h) {
            const bf16x8 A = *(const LAS bf16x8*)(gA + kk2 * 144 + h * 64);
#pragma unroll
            for (int nh = 0; nh < 2; ++nh) {
                const u32x4 w0 = *(const LAS u32x4*)(uB + kk2 * 128 + h * 64 + nh * 64);
                const u32x4 w1 = *(const LAS u32x4*)(uB + kk2 * 128 + h * 64 + nh * 64 + 16);
                const unsigned w[8] = {w0.x, w0.y, w0.z, w0.w, w1.x, w1.y, w1.z, w1.w};
#pragma unroll
                for (int r = 0; r < 8; ++r) { u32x4 bf;
                    if ((r & 1) == 0) { const int q = r >> 1; bf = (u32x4){w[q], w[q + 1], w[q + 2], w[q + 3]}; }
                    else { const int q = (r - 1) >> 1;
                        bf = (u32x4){__builtin_amdgcn_alignbit(w[q + 1], w[q], 16), __builtin_amdgcn_alignbit(w[q + 2], w[q + 1], 16),
                                     __builtin_amdgcn_alignbit(w[q + 3], w[q + 2], 16), __builtin_amdgcn_alignbit(w[q + 4], w[q + 3], 16)}; }
                    acc[nh][r] = __builtin_amdgcn_mfma_f32_16x16x32_bf16(A, __builtin_bit_cast(bf16x8, bf), acc[nh][r], 0, 0, 0); }
            }
        }
    }
}

template <int L>
__device__ __forceinline__ void hyena_unit(LAS char* lds, const unsigned short* GFl, const unsigned short* X1T, const unsigned short* X2T, const unsigned short* VT,
                                           unsigned short* Y2T, const float* skip  , int b0, int c0) {
    using C = HC<L>;
    constexpr int NCH = C::NCH, UST = C::UST, GRN = C::GRN, UB = C::UB, GB = C::GB, CHB = C::CHB, WPC = 8 / NCH;
    static_assert(L / 1024 == WPC, "one wave per (channel, 1024-output block)");
    const int tid = tid_fresh(), wid = __builtin_amdgcn_readfirstlane(tid >> 6), lane = tid & 63;
    const int ch = wid / WPC, Mb = wid % WPC;
    const int c16 = lane & 15, g = lane >> 4, np = c16 >> 2, bb = c16 & 3;
    LAS char* Uch = lds + ch * CHB; LAS char* Gch = Uch + UB;
    const LAS char* gA = Gch + 2 * ((L / 64 - 16 * Mb - c16 - 1) * 72 + 8 * g);
    const LAS char* uB = Uch + 2 * (bb * UST + 8 * g + 8 * np);
    const int c = c0 + ch;
    u32x4 y1p[2][4];
#pragma unroll 1
    for (int o = 0; o < 2; ++o) {
        { constexpr int NG = NCH * (GB / 16), NGI = (NG + NTHR - 1) / NTHR; u32x4 gv[NGI];
#pragma unroll
          for (int i = 0; i < NGI; ++i) { const int id = tid + i * NTHR, cc = id / (GB / 16), off = id % (GB / 16);
              gv[i] = (id < NG) ? *(const u32x4*)((const char*)(GFl + ((size_t)(o * 512 + c0 + cc)) * GRN) + off * 16) : (u32x4){0u, 0u, 0u, 0u}; }
          if (o == 0) {
              constexpr int NU = NCH * 4 * (L / 8), NUI = NU / NTHR; static_assert(NU % NTHR == 0, "u staging"); u32x4 uv_[NUI];
#pragma unroll
              for (int i = 0; i < NUI; ++i) { const int id = tid + i * NTHR, cb = id / (L / 8), off = id % (L / 8), cc = cb >> 2, b = cb & 3;
                  uv_[i] = *(const u32x4*)(VT + xt_off(b0 + b, c0 + cc) + off * 8); }
#pragma unroll
              for (int i = 0; i < NUI; ++i) { const int id = tid + i * NTHR, cb = id / (L / 8), off = id % (L / 8), cc = cb >> 2, b = cb & 3;
                  *(LAS u32x4*)(lds + cc * CHB + (b * UST + 64) * 2 + off * 16) = uv_[i]; }
              for (int id = tid; id < NCH * 4 * 20; id += NTHR) { const int cb = id / 20, k = id % 20, cc = cb >> 2, b = cb & 3;
                  const int el = k < 8 ? k * 8 : (L + 64) + (k - 8) * 8;
                  *(LAS u32x4*)(lds + cc * CHB + (b * UST + el) * 2) = (u32x4){0u, 0u, 0u, 0u}; }
          }
#pragma unroll
          for (int i = 0; i < NGI; ++i) { const int id = tid + i * NTHR, cc = id / (GB / 16), off = id % (GB / 16);
              if (id < NG) *(LAS u32x4*)(lds + cc * CHB + UB + off * 16) = gv[i]; } }
        if (o == 1) {
#pragma unroll
            for (int nh = 0; nh < 2; ++nh)
#pragma unroll
                for (int i = 0; i < 4; ++i) { const int t0 = 1024 * Mb + 64 * (4 * g + i) + 32 * nh + 8 * np;
                    *(LAS u32x4*)(Uch + (bb * UST + 64 + t0) * 2) = y1p[nh][i]; }
        }
        __syncthreads();
        f32x4h acc[2][8];
        conv_kloop16<L>(acc, gA, uB);
        const float sk = skip[o * 512 + c];
        const unsigned short* XT = (o == 0) ? X1T : X2T;
        const size_t gbase = xt_off(b0 + bb, c);
        u32x4 xvs[2][4];
#pragma unroll
        for (int nh = 0; nh < 2; ++nh)
#pragma unroll
            for (int i = 0; i < 4; ++i) { const int t0 = 1024 * Mb + 64 * (4 * g + i) + 32 * nh + 8 * np; xvs[nh][i] = *(const u32x4*)(XT + gbase + t0); }
#pragma unroll
        for (int nh = 0; nh < 2; ++nh)
#pragma unroll
            for (int i = 0; i < 4; ++i) { const int t0 = 1024 * Mb + 64 * (4 * g + i) + 32 * nh + 8 * np;
                const u32x4 xv = xvs[nh][i];
                const u32x4 uv = *(const LAS u32x4*)(Uch + (bb * UST + 64 + t0) * 2);
                const unsigned xw[4] = {xv.x, xv.y, xv.z, xv.w}, uw[4] = {uv.x, uv.y, uv.z, uv.w}; unsigned pw[4];
#pragma unroll
                for (int q = 0; q < 4; ++q) {
                    const float ylo = bf2f((unsigned short)(xw[q] & 0xffff)) * (acc[nh][2 * q][i] + sk * bf2f((unsigned short)(uw[q] & 0xffff)));
                    const float yhi = bf2f((unsigned short)(xw[q] >> 16)) * (acc[nh][2 * q + 1][i] + sk * bf2f((unsigned short)(uw[q] >> 16)));
                    pw[q] = pk2(ylo, yhi); }
                const u32x4 p = (u32x4){pw[0], pw[1], pw[2], pw[3]};
                if (o == 0) y1p[nh][i] = p;
                else *(u32x4*)(Y2T + gbase + t0) = p; }
        __syncthreads();
    }
}
}
typedef unsigned u32x2v __attribute__((ext_vector_type(2)));
__device__ __forceinline__ float bf2f(unsigned short v) { return __uint_as_float((unsigned)v << 16); }
__device__ __forceinline__ float bflo(unsigned w) { return __uint_as_float(w << 16); }
__device__ __forceinline__ float bfhi(unsigned w) { return __uint_as_float(w & 0xffff0000u); }
__device__ __forceinline__ float wave_sum(float v) {
#pragma unroll
    for (int o = 1; o < 64; o <<= 1) v += __shfl_xor(v, o);
    return v;
}
__device__ __forceinline__ void unpack8(const v4u& w, float (&f)[8]) {
    f[0] = bflo(w.x); f[1] = bfhi(w.x); f[2] = bflo(w.y); f[3] = bfhi(w.y); f[4] = bflo(w.z); f[5] = bfhi(w.z); f[6] = bflo(w.w); f[7] = bfhi(w.w);
}
__device__ __forceinline__ v4u pack8(const float (&f)[8]) { v4u w; w.x = pk2(f[0], f[1]); w.y = pk2(f[2], f[3]); w.z = pk2(f[4], f[5]); w.w = pk2(f[6], f[7]); return w; }

__device__ __forceinline__ void norm_rows(const float* xa, const float* xb, const float* g, const float* mod  , int sh_off, int sc_off, bf16* H, int gw, int ngw, int lane) {
    for (int ck = gw; ck < NTOK / 4; ck += ngw) {
        const int row0 = ck * 4, b = row_batch(row0);
        const float* xin = row0 < NPR ? xa : xb;
        const float* sc = mod + (size_t)b * MODW + sc_off; const float* sh = mod + (size_t)b * MODW + sh_off;
        f32x4 ga[8], sb[8];
#pragma unroll
        for (int j = 0; j < 8; ++j) { const int col = 4 * lane + 256 * j; const f32x4 gg = *(const f32x4*)(g + col), s1 = *(const f32x4*)(sc + col);
            ga[j] = gg * (s1 + 1.0f); sb[j] = *(const f32x4*)(sh + col); }
#pragma unroll 1
        for (int r = 0; r < 4; ++r) {
            const float* xr = xin + (size_t)(row0 + r) * DM;
            f32x4 v[8]; float ss = 0.f;
#pragma unroll
            for (int j = 0; j < 8; ++j) { v[j] = *(const f32x4*)(xr + 4 * lane + 256 * j); ss += (v[j].x * v[j].x + v[j].y * v[j].y) + (v[j].z * v[j].z + v[j].w * v[j].w); }
            const float rs = rsqrtf(wave_sum(ss) * (1.0f / DM) + EPS);
            bf16* hr = H + (size_t)(row0 + r) * DM;
#pragma unroll
            for (int j = 0; j < 8; ++j) { const f32x4 o = v[j] * rs * ga[j] + sb[j]; u32x2v w; w.x = pk2(o.x, o.y); w.y = pk2(o.z, o.w);
                *(u32x2v*)(hr + 4 * lane + 256 * j) = w; }
        }
    }
}

struct PostIn { v4u v, qa, ckv, h1, h2; };
__device__ __forceinline__ PostIn post_load(const bf16* P, int lane) {
    PostIn in; const int head = lane >> 3, sub = lane & 7, sec = sub >> 2, chk = sub & 3, hh = head < 6 ? head : 0;
    in.v = *(const v4u*)(P + 512 + 8 * lane); in.qa = *(const v4u*)(P + C_D + 8 * lane); in.ckv = *(const v4u*)(P + C_D + 512 + 8 * (lane & 31));
    const bf16* hp = P + C_C + hh * 128 + 64 * sec + 8 * chk; in.h1 = *(const v4u*)hp; in.h2 = *(const v4u*)(hp + 32); return in;
}
__device__ __forceinline__ void post_finish(const PostIn& in, bf16* P, int pos, const float* vng, const float* qng, const float* kng, const float* qag, const float* kvag, int lane, bool st = true) {
    { float f[8]; unpack8(in.v, f);
      float s = 0.f;
#pragma unroll
      for (int i = 0; i < 8; ++i) s += f[i];
      const float mean = wave_sum(s) * (1.0f / 512.0f); float q = 0.f;
#pragma unroll
      for (int i = 0; i < 8; ++i) { f[i] -= mean; q += f[i] * f[i]; }
      const float rs = rsqrtf(wave_sum(q) * (1.0f / 512.0f) + EPS);
      const f32x4 g0 = *(const f32x4*)(vng + 8 * lane), g1 = *(const f32x4*)(vng + 8 * lane + 4);
      f[0] *= rs * g0.x; f[1] *= rs * g0.y; f[2] *= rs * g0.z; f[3] *= rs * g0.w; f[4] *= rs * g1.x; f[5] *= rs * g1.y; f[6] *= rs * g1.z; f[7] *= rs * g1.w;
      if (st) *(v4u*)(P + 512 + 8 * lane) = pack8(f); }
    { float f[8]; unpack8(in.qa, f); float q = 0.f;
#pragma unroll
      for (int i = 0; i < 8; ++i) q += f[i] * f[i];
      const float rs = rsqrtf(wave_sum(q) * (1.0f / 512.0f) + EPS);
#pragma unroll
      for (int i = 0; i < 8; ++i) f[i] *= rs * qag[8 * lane + i];
      if (st) *(v4u*)(P + C_D + 8 * lane) = pack8(f); }
    { const int l32 = lane & 31; float f[8]; unpack8(in.ckv, f); float q = 0.f;
#pragma unroll
      for (int i = 0; i < 8; ++i) q += f[i] * f[i];
      const float rs = rsqrtf(wave_sum(q) * (0.5f / 256.0f) + EPS);
#pragma unroll
      for (int i = 0; i < 8; ++i) f[i] *= rs * kvag[8 * l32 + i];
      if (st && lane < 32) *(v4u*)(P + C_D + 512 + 8 * l32) = pack8(f); }
    { const int head = lane >> 3, sub = lane & 7, sec = sub >> 2, chk = sub & 3; const bool on = head < 6;
      const int hh = on ? head : 0;
      bf16* hp = P + C_C + hh * 128 + 64 * sec + 8 * chk;
      float a[8], c[8]; unpack8(in.h1, a); unpack8(in.h2, c);
      float q = 0.f;
#pragma unroll
      for (int i = 0; i < 8; ++i) q += a[i] * a[i] + c[i] * c[i];
      q += __shfl_xor(q, 1); q += __shfl_xor(q, 2); q += __shfl_xor(q, 4);
      const float rs = rsqrtf(q * (1.0f / 128.0f) + EPS);
      const float* gg = (hh < 4 ? qng : kng) + 64 * sec + 8 * chk;
      const float p = (float)(sec ? (pos & 63) : (pos >> 6));
#pragma unroll
      for (int i = 0; i < 8; ++i) {
          const float x1 = a[i] * rs * gg[i], x2 = c[i] * rs * gg[32 + i];
          const float inv = __expf(-(float)(2 * (8 * chk + i)) * (9.210340371976184f / 64.0f));
          float sn, cs; __sincosf(p * inv, &sn, &cs);
          const float qs = (hh < 4) ? 0.12751743082459868f : 1.0f;
          a[i] = (x1 * cs - x2 * sn) * qs; c[i] = (x2 * cs + x1 * sn) * qs; }
      if (st && on) { *(v4u*)hp = pack8(a); *(v4u*)(hp + 32) = pack8(c); } }
}
__device__ __forceinline__ void post_rows(bf16* PROJp, const float* vng, const float* qng, const float* kng, const float* qag, const float* kvag, int gw, int ngw, int lane, bool st) {
    int row = gw; if (row >= NTOK) return;
    PostIn cur = post_load(PROJp + (size_t)row * INCP, lane);
    for (; row < NTOK; row += ngw) { const int nr = row + ngw; PostIn nxt = cur;
        if (nr < NTOK) nxt = post_load(PROJp + (size_t)nr * INCP, lane);
        post_finish(cur, PROJp + (size_t)row * INCP, row_pos(row), vng, qng, kng, qag, kvag, lane, st); cur = nxt; }
}

struct MlaIn { v4u n[2], a[2], c[2]; };
__device__ __forceinline__ MlaIn mla_load(const bf16* Qr, const bf16* KVr, const bf16* krope, int lane) {
    MlaIn in; const int head = lane >> 4, sub = lane & 15; const bool rp = sub < 4; const int sec = (sub >> 1) & 1, chk = sub & 1, x1o = 128 + 32 * sec + 8 * chk;
    in.n[0] = *(const v4u*)(Qr + head * 192 + 8 * sub); in.n[1] = *(const v4u*)(KVr + head * 256 + 8 * sub);
    in.a[0] = in.c[0] = in.a[1] = in.c[1] = (v4u){0u, 0u, 0u, 0u};
    if (rp) { in.a[0] = *(const v4u*)(Qr + head * 192 + x1o); in.c[0] = *(const v4u*)(Qr + head * 192 + x1o + 16);
              in.a[1] = *(const v4u*)(krope + 32 * sec + 8 * chk); in.c[1] = *(const v4u*)(krope + 32 * sec + 8 * chk + 16); }
    return in;
}
__device__ __forceinline__ void mla_finish(const MlaIn& in, bf16* Qr, bf16* Kr, int pos, const float* qng, const float* kng, int lane, bool st = true) {
    const int head = lane >> 4, sub = lane & 15;
    const bool rp = sub < 4; const int sec = (sub >> 1) & 1, chk = sub & 1;
    const int x1o = 128 + 32 * sec + 8 * chk;
    const float p = (float)(sec ? (pos & 63) : (pos >> 6));
#pragma unroll
    for (int which = 0; which < 2; ++which) {
        const float* g = which == 0 ? qng : kng;
        bf16* dst = (which == 0 ? Qr : Kr) + head * 192;
        float n[8], a[8], c[8]; unpack8(in.n[which], n); unpack8(in.a[which], a); unpack8(in.c[which], c);
        float q = 0.f;
#pragma unroll
        for (int i = 0; i < 8; ++i) q += n[i] * n[i] + a[i] * a[i] + c[i] * c[i];
        q += __shfl_xor(q, 1); q += __shfl_xor(q, 2); q += __shfl_xor(q, 4); q += __shfl_xor(q, 8);
        const float rs = rsqrtf(q * (1.0f / 192.0f) + EPS);
        const float qs = (which == 0) ? 0.10411755155693222f : 1.0f;
#pragma unroll
        for (int i = 0; i < 8; ++i) n[i] *= rs * g[8 * sub + i] * qs;
        if (st) *(v4u*)(dst + 8 * sub) = pack8(n);
        if (rp) {
#pragma unroll
            for (int i = 0; i < 8; ++i) {
                const float x1 = a[i] * rs * g[x1o + i], x2 = c[i] * rs * g[x1o + 16 + i];
                const float inv = __expf(-(float)(2 * (8 * chk + i)) * (9.210340371976184f / 32.0f));
                float sn, cs; __sincosf(p * inv, &sn, &cs);
                a[i] = (x1 * cs - x2 * sn) * qs; c[i] = (x2 * cs + x1 * sn) * qs; }
            if (st) { *(v4u*)(dst + x1o) = pack8(a); *(v4u*)(dst + x1o + 16) = pack8(c); } }
    }
}
__device__ __forceinline__ void mla_rows(bf16* QDp, const bf16* KVDp, const bf16* PROJp, bf16* KMp, const float* qng, const float* kng, int gw, int ngw, int lane, bool st) {
    int row = gw; if (row >= NTOK) return;
    MlaIn cur = mla_load(QDp + (size_t)row * 768, KVDp + (size_t)row * 1024, PROJp + (size_t)row * INCP + C_D + 768, lane);
    for (; row < NTOK; row += ngw) { const int nr = row + ngw; MlaIn nxt = cur;
        if (nr < NTOK) nxt = mla_load(QDp + (size_t)nr * 768, KVDp + (size_t)nr * 1024, PROJp + (size_t)nr * INCP + C_D + 768, lane);
        mla_finish(cur, QDp + (size_t)row * 768, KMp + (size_t)row * 768, row_pos(row), qng, kng, lane, st); cur = nxt; }
}

__device__ __forceinline__ void hyconv_tile(LAS unsigned char* lds, const bf16* PROJ, bf16* XT, const float* cw  , const float* cb  , int tile, int tid) {
    const int which = tile % 3, tb = tile / 3, row0 = tb * 64, b = row_batch(row0), pos0 = row_pos(row0), Lb = batch_len(b);
    constexpr int PITCH = 260;
    LAS unsigned* raw = (LAS unsigned*)lds;
    { v4u w[9];
#pragma unroll
      for (int i = 0; i < 9; ++i) { const int id = tid + i * NTHR, r = id >> 6, k = id & 63, p = pos0 - 1 + r;
          w[i] = (v4u){0u, 0u, 0u, 0u};
          if (id < 66 * 64 && p >= 0 && p < Lb) w[i] = *(const v4u*)(PROJ + (size_t)(row0 - 1 + r) * INCP + C_B + which * 512 + 8 * k); }
#pragma unroll
      for (int i = 0; i < 9; ++i) { const int id = tid + i * NTHR, r = id >> 6, k = id & 63;
          if (id < 66 * 64) *(LAS v4u*)(raw + r * PITCH + 4 * k) = w[i]; } }
    __syncthreads();
    { const int c = tid, col = which * 512 + c; const float w0 = cw[col], w1 = cw[1536 + col], w2 = cw[3072 + col], bb = cb[col];
      const LAS unsigned short* rc = (const LAS unsigned short*)raw + c;
      bf16* dst = XT + (size_t)which * ((size_t)NTOK * 512) + xt_off(b, c) + pos0;
      float xm = bf2f(rc[0]), x0 = bf2f(rc[2 * PITCH]);
#pragma unroll 2
      for (int k = 0; k < 8; ++k) { float z[8];
#pragma unroll
          for (int i = 0; i < 8; ++i) { const float xp = bf2f(rc[(8 * k + i + 2) * 2 * PITCH]); z[i] = w0 * xm + w1 * x0 + w2 * xp + bb; xm = x0; x0 = xp; }
          *(v4u*)(dst + 8 * k) = pack8(z); } }
    __syncthreads();
}

__device__ __forceinline__ void gnorm_tile(LAS unsigned char* lds, const bf16* __restrict__ YCAT, const bf16* __restrict__ Y2T, const float* __restrict__ gg  , bf16* __restrict__ YN, int tile, int tid) {
    const int row0 = tile * 32, b = row_batch(row0), pos0 = row_pos(row0), lane = tid & 63, wid = tid >> 6;
    constexpr int PITCH = 17;
    LAS unsigned* yb = (LAS unsigned*)lds;
    { v4u yw[4];
#pragma unroll
      for (int i = 0; i < 4; ++i) { const int id = tid + i * NTHR, c = id >> 2, k = id & 3; yw[i] = *(const v4u*)(Y2T + xt_off(b, c) + pos0 + 8 * k); }
#pragma unroll
      for (int i = 0; i < 4; ++i) { const int id = tid + i * NTHR, c = id >> 2, k = id & 3; LAS unsigned* d = yb + c * PITCH + 4 * k; d[0] = yw[i].x; d[1] = yw[i].y; d[2] = yw[i].z; d[3] = yw[i].w; } }
    __syncthreads();
#pragma unroll 2
    for (int r = 0; r < 4; ++r) { const int t = wid * 4 + r, row = row0 + t;
        const bf16* yr = YCAT + (size_t)row * DM; bf16* on = YN + (size_t)row * DM;
#pragma unroll
        for (int grp = 0; grp < 4; ++grp) {
            if (grp == 1) {
                float f[8]; float q = 0.f;
#pragma unroll
                for (int i = 0; i < 8; ++i) { f[i] = bf2f(((const LAS unsigned short*)yb)[(lane + 64 * i) * 2 * PITCH + t]); q += f[i] * f[i]; }
                const float rs = rsqrtf(wave_sum(q) * (1.0f / 512.0f) + EPS);
#pragma unroll
                for (int i = 0; i < 8; ++i) on[512 + lane + 64 * i] = (bf16)f2bf(f[i] * rs * gg[512 + lane + 64 * i]);
            } else {
                v4u w = *(const v4u*)(yr + grp * 512 + 8 * lane); float f[8]; unpack8(w, f); float q = 0.f;
#pragma unroll
                for (int i = 0; i < 8; ++i) q += f[i] * f[i];
                const float rs = rsqrtf(wave_sum(q) * (1.0f / 512.0f) + EPS);
                const f32x4 g0 = *(const f32x4*)(gg + grp * 512 + 8 * lane), g1 = *(const f32x4*)(gg + grp * 512 + 8 * lane + 4);
                f[0] *= rs * g0.x; f[1] *= rs * g0.y; f[2] *= rs * g0.z; f[3] *= rs * g0.w; f[4] *= rs * g1.x; f[5] *= rs * g1.y; f[6] *= rs * g1.z; f[7] *= rs * g1.w;
                *(v4u*)(on + grp * 512 + 8 * lane) = pack8(f);
            }
        }
    }
    __syncthreads();
}

__device__ __forceinline__ void ffn_gate(const bf16* Z, bf16* A, const float* cw  , const float* cb  , int gt, int ngt) {
    constexpr int NCK = DFF / 8;
    for (int it = gt; it < (NTOK / 16) * NCK; it += ngt) {
        const int rb = it / NCK, ck = it % NCK, row0 = rb * 16, j0 = ck * 8;
        const int pos0 = row_pos(row0), Lb = batch_len(row_batch(row0));
        float wg[3][8], wu[3][8], bg[8], bu[8];
#pragma unroll
        for (int k = 0; k < 3; ++k)
#pragma unroll
            for (int i = 0; i < 8; ++i) { wg[k][i] = cw[k * DFF2 + j0 + i]; wu[k][i] = cw[k * DFF2 + DFF + j0 + i]; }
#pragma unroll
        for (int i = 0; i < 8; ++i) { bg[i] = cb[j0 + i]; bu[i] = cb[DFF + j0 + i]; }
        float gm[8], g0[8], um[8], u0[8];
        const bf16* zr = Z + (size_t)row0 * DFF2 + j0;
        if (pos0 > 0) { v4u a = *(const v4u*)(zr - DFF2), c = *(const v4u*)(zr - DFF2 + DFF); unpack8(a, gm); unpack8(c, um); }
        else {
#pragma unroll
            for (int i = 0; i < 8; ++i) { gm[i] = 0.f; um[i] = 0.f; } }
        { v4u a = *(const v4u*)zr, c = *(const v4u*)(zr + DFF); unpack8(a, g0); unpack8(c, u0); }
#pragma unroll 1
        for (int r = 0; r < 16; ++r) {
            float gp[8], up[8];
            if (pos0 + r + 1 < Lb) { v4u a = *(const v4u*)(zr + (size_t)(r + 1) * DFF2), c = *(const v4u*)(zr + (size_t)(r + 1) * DFF2 + DFF); unpack8(a, gp); unpack8(c, up); }
            else {
#pragma unroll
                for (int i = 0; i < 8; ++i) { gp[i] = 0.f; up[i] = 0.f; } }
            float o[8];
#pragma unroll
            for (int i = 0; i < 8; ++i) {
                const float gc = wg[0][i] * gm[i] + wg[1][i] * g0[i] + wg[2][i] * gp[i] + bg[i];
                const float uc = wu[0][i] * um[i] + wu[1][i] * u0[i] + wu[2][i] * up[i] + bu[i];
                o[i] = gc * __builtin_amdgcn_rcpf(1.0f + __expf(-gc)) * uc;
                gm[i] = g0[i]; g0[i] = gp[i]; um[i] = u0[i]; u0[i] = up[i]; }
            *(v4u*)(A + (size_t)(row0 + r) * DFF + j0) = pack8(o);
        }
    }
}

__device__ __forceinline__ void gate_fix(const float* ZH, bf16* A, const float* cw, const float* cb, int gt, int ngt) {
    constexpr int NQ4 = DFF / 4;
    for (int it = gt; it < 192 * NQ4; it += ngt) {
        const int rs = it / NQ4, q4 = it % NQ4, pm = rs >> 1, s = rs & 1, row = pm * 256 + (s ? 255 : 0), pos = row_pos(row), Lb = batch_len(row_batch(row));
        if (s == 0 ? (pos == 0) : (pos + 1 == Lb)) continue;
        const int j = q4 * 4, zc = 256 * (j >> 7) + (j & 127);
        const float* zp = s == 0 ? ZH + ((size_t)(pm - 1) * 4 + 3) * DFF2 : ZH + ((size_t)pm * 4 + 2) * DFF2;
        const float* z0 = s == 0 ? ZH + ((size_t)pm * 4 + 0) * DFF2 : ZH + ((size_t)pm * 4 + 3) * DFF2;
        const float* zn = s == 0 ? ZH + ((size_t)pm * 4 + 1) * DFF2 : ZH + ((size_t)(pm + 1) * 4 + 0) * DFF2;
        f32x4 cv[2];
#pragma unroll
        for (int h = 0; h < 2; ++h) {
            const f32x4 a = *(const f32x4*)(zp + zc + 128 * h), b = *(const f32x4*)(z0 + zc + 128 * h), c = *(const f32x4*)(zn + zc + 128 * h);
            const f32x4 w0 = *(const f32x4*)(cw + h * DFF + j), w1 = *(const f32x4*)(cw + DFF2 + h * DFF + j), w2 = *(const f32x4*)(cw + 2 * DFF2 + h * DFF + j), bb = *(const f32x4*)(cb + h * DFF + j);
            cv[h] = w0 * a + w1 * b + w2 * c + bb; }
        float o[4];
#pragma unroll
        for (int e = 0; e < 4; ++e) { const float g = cv[0][e]; o[e] = g * __builtin_amdgcn_rcpf(1.0f + __expf(-g)) * cv[1][e]; }
        u32x2v w; w.x = pk2(o[0], o[1]); w.y = pk2(o[2], o[3]);
        *(u32x2v*)(A + affn_off(row, j)) = w;
    }
}

__device__ __forceinline__ void hyconv_regs(const bf16* PROJ, bf16* XT, const float* cw  , const float* cb  , int gt, int ngt) {
    for (int it = gt; it < (NTOK / 8) * 192; it += ngt) {
        const int tb = it / 192, ck = it % 192, row0 = tb * 8, j0 = ck * 8, which = j0 >> 9, c0 = j0 & 511;
        const int b = row_batch(row0), pos0 = row_pos(row0), Lb = batch_len(b);
        float w0[8], w1[8], w2[8], bb[8];
#pragma unroll
        for (int i = 0; i < 8; i += 4) { const f32x4 a = *(const f32x4*)(cw + j0 + i), c = *(const f32x4*)(cw + 1536 + j0 + i), d = *(const f32x4*)(cw + 3072 + j0 + i), e = *(const f32x4*)(cb + j0 + i);
            w0[i] = a.x; w0[i + 1] = a.y; w0[i + 2] = a.z; w0[i + 3] = a.w; w1[i] = c.x; w1[i + 1] = c.y; w1[i + 2] = c.z; w1[i + 3] = c.w;
            w2[i] = d.x; w2[i + 1] = d.y; w2[i + 2] = d.z; w2[i + 3] = d.w; bb[i] = e.x; bb[i + 1] = e.y; bb[i + 2] = e.z; bb[i + 3] = e.w; }
        const bf16* src = PROJ + (size_t)row0 * INCP + C_B + j0;
        v4u raw[10];
        raw[0] = (pos0 > 0) ? *(const v4u*)(src - INCP) : (v4u){0u, 0u, 0u, 0u};
#pragma unroll
        for (int r = 0; r < 8; ++r) raw[r + 1] = *(const v4u*)(src + (size_t)r * INCP);
        raw[9] = (pos0 + 8 < Lb) ? *(const v4u*)(src + (size_t)8 * INCP) : (v4u){0u, 0u, 0u, 0u};
        float z[8][8]; float xm[8], x0[8], xp[8];
        unpack8(raw[0], xm); unpack8(raw[1], x0);
#pragma unroll
        for (int r = 0; r < 8; ++r) { unpack8(raw[r + 2], xp);
#pragma unroll
            for (int i = 0; i < 8; ++i) { z[r][i] = w0[i] * xm[i] + w1[i] * x0[i] + w2[i] * xp[i] + bb[i]; xm[i] = x0[i]; x0[i] = xp[i]; } }
        bf16* dst = XT + (size_t)which * ((size_t)NTOK * 512) + xt_off(b, c0) + pos0;
        const size_t cst = (size_t)Lb;
#pragma unroll
        for (int i = 0; i < 8; ++i) { v4u o; o.x = pk2(z[0][i], z[1][i]); o.y = pk2(z[2][i], z[3][i]); o.z = pk2(z[4][i], z[5][i]); o.w = pk2(z[6][i], z[7][i]);
            *(v4u*)(dst + (size_t)i * cst) = o; }
    }
}
__device__ __forceinline__ void p0_transpose_item(const float* W, int K, int N, bf16* WT, int row_off, LAS float* scr, int item, int lane) {
    const int nblk = N / 32, kb = item / nblk, nb = item % nblk, k0 = 64 * kb, n0 = 32 * nb;
#pragma unroll
    for (int i = 0; i < 32; ++i) { const int kk = 2 * i + (lane >> 5); scr[kk * 33 + (lane & 31)] = __builtin_nontemporal_load(&W[(size_t)(k0 + kk) * N + n0 + (lane & 31)]); }
    LDS_WAIT(); asm volatile("" ::: "memory");
    const int c = lane & 7;
#pragma unroll
    for (int j = 0; j < 4; ++j) { const int n = (lane >> 3) + 8 * j; const LAS float* s = scr + (8 * c) * 33 + n;
        v4u o; o.x = pk2(s[0 * 33], s[1 * 33]); o.y = pk2(s[2 * 33], s[3 * 33]); o.z = pk2(s[4 * 33], s[5 * 33]); o.w = pk2(s[6 * 33], s[7 * 33]);
        *(GAS v4u*)(WT + (size_t)(row_off + n0 + n) * K + k0 + 8 * c) = o; }
    LDS_WAIT(); asm volatile("" ::: "memory");
}
__device__ __forceinline__ void gmlp_unit(char* ldsg, const bf16* PROJ, bf16* YCAT, const float* sw  , const float* sb  , int unit, int tid) {
    using namespace att;
    const int chunk = unit >> 2, h = unit & 3, row0 = chunk * 128, lane = tid & 63, wid = __builtin_amdgcn_readfirstlane(tid >> 6), hi = lane >> 5, r32 = lane & 31;
    { bf16x8 vw[4];
#pragma unroll
      for (int i = 0; i < 4; ++i) { const int id = tid + i * NTHR, q = id >> 4, cc = (id & 15) * 8; vw[i] = *(const bf16x8*)(PROJ + (size_t)(row0 + q) * INCP + 512 + h * 128 + cc); }
#pragma unroll
      for (int i = 0; i < 4; ++i) { const int id = tid + i * NTHR, q = id >> 4, cc = (id & 15) * 8; *(bf16x8*)(ldsg + (q >> 6) * 16384 + v_st(q & 63, cc)) = vw[i]; } }
    const int pblk = wid >> 1, half = wid & 1;
    bf16x8 af[8];
    { const float* wp = sw + (size_t)h * 16384 + (32 * pblk + r32) * 128 + 8 * hi;
#pragma unroll
      for (int k = 0; k < 8; ++k) { const f32x4 a = *(const f32x4*)(wp + 16 * k), c = *(const f32x4*)(wp + 16 * k + 4);
          u32x4 w; w.x = cvtpk(a.x, a.y); w.y = cvtpk(a.z, a.w); w.z = cvtpk(c.x, c.y); w.w = cvtpk(c.z, c.w); af[k] = __builtin_bit_cast(bf16x8, w); } }
    __syncthreads();
    const int vb0 = (int)(uintptr_t)ldsg + v_rd_base(lane);
    f32x16 o0 = {}, o1 = {};
    if (half == 0) { pv_one<0>(o0, vb0, af[0], af[1], af[2], af[3]); pv_one<1>(o1, vb0, af[0], af[1], af[2], af[3]);
                     pv_one<0>(o0, vb0 + 16384, af[4], af[5], af[6], af[7]); pv_one<1>(o1, vb0 + 16384, af[4], af[5], af[6], af[7]); }
    else           { pv_one<2>(o0, vb0, af[0], af[1], af[2], af[3]); pv_one<3>(o1, vb0, af[0], af[1], af[2], af[3]);
                     pv_one<2>(o0, vb0 + 16384, af[4], af[5], af[6], af[7]); pv_one<3>(o1, vb0 + 16384, af[4], af[5], af[6], af[7]); }
    float* st = (float*)(ldsg + 32768) + wid * (32 * 68);
#pragma unroll
    for (int q = 0; q < 16; ++q) { const int pr = crow(q, hi); const float bs = sb[h * 128 + 32 * pblk + pr];
        st[pr * 68 + r32] = o0[q] + bs; st[pr * 68 + 32 + r32] = o1[q] + bs; }
    asm volatile("s_waitcnt lgkmcnt(0)" ::: "memory");
    v4u uws[4];
#pragma unroll
    for (int i = 0; i < 4; ++i) { const int pr = i * 8 + (lane >> 3), cc = (lane & 7) * 8; uws[i] = *(const v4u*)(PROJ + (size_t)(row0 + 32 * pblk + pr) * INCP + h * 128 + 64 * half + cc); }
#pragma unroll
    for (int i = 0; i < 4; ++i) { const int pr = i * 8 + (lane >> 3), cc = (lane & 7) * 8; const int row = row0 + 32 * pblk + pr, col = h * 128 + 64 * half + cc;
        const f32x4 m0 = *(const f32x4*)(st + pr * 68 + cc), m1 = *(const f32x4*)(st + pr * 68 + cc + 4);
        const v4u uw = uws[i]; float uf[8]; unpack8(uw, uf);
        float y[8] = {uf[0] * m0.x, uf[1] * m0.y, uf[2] * m0.z, uf[3] * m0.w, uf[4] * m1.x, uf[5] * m1.y, uf[6] * m1.z, uf[7] * m1.w};
        *(v4u*)(YCAT + (size_t)row * DM + col) = pack8(y); }
    __syncthreads();
}

__device__ __forceinline__ void mod_phase(LAS unsigned char* lds, const float* cp, const float* cs, const float* ada_w, const float* ada_b, float* MOD, int vcu, int G, int tid) {
    LAS float* sc = (LAS float*)lds;
    LAS float* red = (LAS float*)(lds + 65536);
    const int lane = tid & 63, wid = tid >> 6;
#pragma unroll 8
    for (int i = tid; i < NB * DM; i += NTHR) { const int b = i >> 11, k = i & 2047; const float c = b < 4 ? cp[b * DM + k] : cs[(b - 4) * DM + k]; sc[i] = c / (1.0f + __expf(-c)); }
    __syncthreads();
    for (int item = vcu; item < DEPTH * 96; item += G) {
        const int l = item / 96, cbk = item % 96, col0 = cbk * 128 + 2 * lane;
        const float* W = ada_w + (size_t)l * DM * MODW + col0;
        float acc[8][2];
#pragma unroll
        for (int b = 0; b < 8; ++b) { acc[b][0] = 0.f; acc[b][1] = 0.f; }
        const int kbeg = wid * 256;
#pragma unroll 2
        for (int k = kbeg; k < kbeg + 256; k += 4) {
            typedef float f32x2w __attribute__((ext_vector_type(2)));
            f32x2w w[4];
#pragma unroll
            for (int i = 0; i < 4; ++i) w[i] = __builtin_nontemporal_load((const f32x2w*)(W + (size_t)(k + i) * MODW));
#pragma unroll
            for (int b = 0; b < 8; ++b) { const f32x4 s = *(const LAS f32x4*)(sc + b * DM + k);
                acc[b][0] += s.x * w[0].x + s.y * w[1].x + s.z * w[2].x + s.w * w[3].x;
                acc[b][1] += s.x * w[0].y + s.y * w[1].y + s.z * w[2].y + s.w * w[3].y; }
        }
#pragma unroll
        for (int b = 0; b < 8; ++b) { red[(wid * 8 + b) * 128 + 2 * lane] = acc[b][0]; red[(wid * 8 + b) * 128 + 2 * lane + 1] = acc[b][1]; }
        __syncthreads();
        { const int b = tid >> 6, pr = tid & 63; float s0 = 0.f, s1 = 0.f;
#pragma unroll
          for (int w = 0; w < 8; ++w) { s0 += red[(w * 8 + b) * 128 + 2 * pr]; s1 += red[(w * 8 + b) * 128 + 2 * pr + 1]; }
          const int col = cbk * 128 + 2 * pr;
          float* o = MOD + ((size_t)l * NB + b) * MODW + col; o[0] = s0 + ada_b[l * MODW + col]; o[1] = s1 + ada_b[l * MODW + col + 1]; }
        __syncthreads();
    }
}

__device__ __forceinline__ unsigned rot16(unsigned x) { return __builtin_amdgcn_alignbit(x, x, 16); }
__device__ __forceinline__ void filt_item(LAS unsigned char* lds, int L, int tb, const float* w1, const float* b1, const float* f1, const float* w2, const float* b2, const float* f2,
                                          const float* w3, const float* decay, bf16* GFl, int tid) {
    using att::bf16x8; using att::f32x16; using att::u32x4; using att::cvtpk;
    LAS float* feats = (LAS float*)lds;
    LAS float* h1 = feats + 2176;
    LAS float* h2 = h1 + 65 * 64;
    LAS float* hf0 = h2 + 65 * 68;
    const int t0 = 64 * tb; const float invL1 = 1.0f / (float)(L - 1);
    const int GRN = 2 * L / 64 * 72;
    const int lane = tid & 63, wid = __builtin_amdgcn_readfirstlane(tid >> 6), hi = lane >> 5, r32 = lane & 31;
    for (int id = tid; id < 65 * 33; id += NTHR) { const int i = id / 33, f = id % 33; const float t = (float)(t0 + i); float v;
        if (f == 0) v = t * invL1;
        else { const int kb = (f - 1) & 15; const float band = 1e-4f + (float)kb * ((15.0f - 1e-4f) / 15.0f);
            float x = t * band / (float)L; x -= floorf(x); const float a = 6.283185307179586f * x;
            v = (f <= 16) ? __cosf(a) : -__sinf(a); }
        feats[i * 33 + f] = v; }
    __syncthreads();
    for (int id = tid; id < 65 * 64; id += NTHR) { const int i = id >> 6, j = id & 63; float s = b1[j];
#pragma unroll 11
        for (int f = 0; f < 33; ++f) s += feats[i * 33 + f] * w1[f * 64 + j];
        h1[i * 64 + j] = __sinf(f1[j] * s); }
    __syncthreads();
    for (int id = tid; id < 65 * 64; id += NTHR) { const int i = id >> 6, j = id & 63; float s = b2[j];
#pragma unroll 16
        for (int f = 0; f < 64; ++f) s += h1[i * 64 + f] * w2[f * 64 + j];
        h2[i * 68 + j] = __sinf(f2[j] * s); }
    __syncthreads();
    if (tb == 0) {
        for (int cc = tid; cc < 1024; cc += NTHR) { const int col = (cc >> 9) * 1024 + (cc & 511); float s = 0.f;
#pragma unroll 16
            for (int j = 0; j < 64; ++j) s += h2[j] * w3[j * 2048 + col];
            hf0[cc] = s; }
        __syncthreads();
    }
    bf16x8 af[2][2][4];
#pragma unroll
    for (int st = 0; st < 2; ++st)
#pragma unroll
        for (int mb = 0; mb < 2; ++mb)
#pragma unroll
            for (int ks = 0; ks < 4; ++ks) { const LAS float* p = h2 + (st + 32 * mb + r32) * 68 + 16 * ks + 8 * hi;
                const f32x4 x = *(const LAS f32x4*)p, y = *(const LAS f32x4*)(p + 4);
                u32x4 w; w.x = cvtpk(x.x, x.y); w.y = cvtpk(x.z, x.w); w.z = cvtpk(y.x, y.y); w.w = cvtpk(y.z, y.w); af[st][mb][ks] = __builtin_bit_cast(bf16x8, w); }
#pragma unroll 1
    for (int cbi = 0; cbi < 8; ++cbi) {
        const int cb = wid * 8 + cbi, o = cb >> 5, dir = (cb >> 4) & 1, c = (cb & 15) * 32 + r32, col = cb * 32 + r32;
        bf16x8 bfr[4];
#pragma unroll
        for (int ks = 0; ks < 4; ++ks) { float x[8];
#pragma unroll
            for (int j = 0; j < 8; ++j) x[j] = w3[(size_t)(16 * ks + 8 * hi + j) * 2048 + col];
            u32x4 w; w.x = cvtpk(x[0], x[1]); w.y = cvtpk(x[2], x[3]); w.z = cvtpk(x[4], x[5]); w.w = cvtpk(x[6], x[7]); bfr[ks] = __builtin_bit_cast(bf16x8, w); }
        const float dec = fabsf(decay[col]) * invL1;
        bf16* dst = GFl + (size_t)(o * 512 + c) * GRN;
#pragma unroll
        for (int mb = 0; mb < 2; ++mb) {
            f32x16 d = {};
#pragma unroll
            for (int ks = 0; ks < 4; ++ks) d = (dir == 0) ? __builtin_amdgcn_mfma_f32_32x32x16_bf16(af[1][mb][ks], bfr[ks], d, 0, 0, 0)
                                                          : __builtin_amdgcn_mfma_f32_32x32x16_bf16(af[0][mb][ks], bfr[ks], d, 0, 0, 0);
#pragma unroll
            for (int q = 0; q < 16; ++q) { const int mrow = 32 * mb + att::crow(q, hi), t = t0 + mrow + (dir == 0 ? 1 : 0);
                float v = d[q] * __expf(-(float)t * dec);
                if (dir == 0 && t == L) v = 0.f;
                if (dir == 1 && t == 0) v = hf0[o * 512 + c];
                d[q] = v; }
#pragma unroll
            for (int k = 0; k < 2; ++k) {
                const unsigned a0 = cvtpk(d[8 * k + 0], d[8 * k + 1]), a1 = cvtpk(d[8 * k + 2], d[8 * k + 3]), b0 = cvtpk(d[8 * k + 4], d[8 * k + 5]), b1 = cvtpk(d[8 * k + 6], d[8 * k + 7]);
                auto s0 = __builtin_amdgcn_permlane32_swap(a0, b0, false, false); auto s1 = __builtin_amdgcn_permlane32_swap(a1, b1, false, false);
                const unsigned x0 = s0[0], x1 = s1[0], x2 = s0[1], x3 = s1[1];
                const int m0 = 32 * mb + 16 * k + 8 * hi;
                if (dir == 1) { const int ib = L + t0 + m0, ph = (ib >> 6) * 72 + (ib & 63); *(v4u*)(dst + ph) = (v4u){x0, x1, x2, x3}; }
                else { const int ib = L - t0 - m0 - 8, ph = (ib >> 6) * 72 + (ib & 63); *(v4u*)(dst + ph) = (v4u){rot16(x3), rot16(x2), rot16(x1), rot16(x0)}; }
            }
        }
    }
    __syncthreads();
}

__device__ __forceinline__ void ga_tables(const float* n1g, const float* n2g, const float* MODp, float* GA1, float* GA2, int gt, int ngt) {
    for (int i = gt; i < 2 * DEPTH * NB * DM; i += ngt) { const int which = i / (DEPTH * NB * DM), r = i % (DEPTH * NB * DM), l = r / (NB * DM), b = (r / DM) % NB, c = r % DM;
        const float sc = MODp[((size_t)l * NB + b) * MODW + (which ? 4 * DM : DM) + c];
        (which ? GA2 : GA1)[r] = (which ? n2g : n1g)[l * DM + c] * (1.0f + sc); }
}
__device__ __forceinline__ void bvec_item(LAS unsigned char* lds, const float* shp, const bf16* Wt, float* BV, int ldbv, int n0, int tid) {
    LAS float* sb = (LAS float*)lds;
    const int lane = tid & 63, wid = tid >> 6;
#pragma unroll 8
    for (int i = tid; i < NB * DM / 4; i += NTHR) { const int b = i / (DM / 4), k4 = i % (DM / 4); *(LAS f32x4*)(sb + b * DM + 4 * k4) = *(const f32x4*)(shp + (size_t)b * MODW + 4 * k4); }
    __syncthreads();
#pragma unroll 1
    for (int rg = 0; rg < 2; ++rg) { const int nb = n0 + wid * 8 + rg * 4;
        float acc[32];
#pragma unroll
        for (int i = 0; i < 32; ++i) acc[i] = 0.f;
#pragma unroll 1
        for (int j = 0; j < 4; ++j) { float f[4][8];
#pragma unroll
            for (int r = 0; r < 4; ++r) { const v4u w = *(const v4u*)(Wt + (size_t)(nb + r) * DM + 8 * lane + 512 * j); unpack8(w, f[r]); }
#pragma unroll
            for (int b = 0; b < 8; ++b) { const f32x4 s0 = *(const LAS f32x4*)(sb + b * DM + 8 * lane + 512 * j), s1 = *(const LAS f32x4*)(sb + b * DM + 8 * lane + 512 * j + 4);
#pragma unroll
                for (int r = 0; r < 4; ++r)
                    acc[r * 8 + b] += (f[r][0] * s0.x + f[r][1] * s0.y) + (f[r][2] * s0.z + f[r][3] * s0.w) + (f[r][4] * s1.x + f[r][5] * s1.y) + (f[r][6] * s1.z + f[r][7] * s1.w); } }
#pragma unroll
        for (int st = 0; st < 5; ++st) { const int n = 16 >> st, x = 32 >> st; const bool up = (lane & x) != 0;
#pragma unroll
            for (int i = 0; i < n; ++i) { const float keep = up ? acc[i + n] : acc[i], send = up ? acc[i] : acc[i + n]; acc[i] = keep + __shfl_xor(send, x); } }
        const float tot = acc[0] + __shfl_xor(acc[0], 1);
        const int idx = (lane >> 1) & 31;
        const int idxr = ((idx & 16) ? 16 : 0) | ((idx & 8) ? 8 : 0) | ((idx & 4) ? 4 : 0) | ((idx & 2) ? 2 : 0) | (idx & 1);
        if ((lane & 1) == 0) BV[(size_t)(idxr & 7) * ldbv + nb + (idxr >> 3)] = tot;
    }
    __syncthreads();
}
__device__ __forceinline__ void norm0_rows(const float* xa, const float* xb, const float* g, const float* mod, bf16* H, float* SS, int gw, int ngw, int lane) {
    for (int ck = gw; ck < NTOK / 4; ck += ngw) {
        const int row0 = ck * 4, b = row_batch(row0);
        const float* xin = row0 < NPR ? xa : xb;
        const float* sc = mod + (size_t)b * MODW + DM;
        f32x4 ga[8];
#pragma unroll
        for (int j = 0; j < 8; ++j) { const int col = 4 * lane + 256 * j; ga[j] = *(const f32x4*)(g + col) * (*(const f32x4*)(sc + col) + 1.0f); }
#pragma unroll 1
        for (int r = 0; r < 4; ++r) {
            const float* xr = xin + (size_t)(row0 + r) * DM;
            f32x4 v[8]; float ss = 0.f;
#pragma unroll
            for (int j = 0; j < 8; ++j) { v[j] = *(const f32x4*)(xr + 4 * lane + 256 * j); ss += (v[j].x * v[j].x + v[j].y * v[j].y) + (v[j].z * v[j].z + v[j].w * v[j].w); }
            ss = wave_sum(ss); if (lane == 0) SS[row0 + r] = ss;
            bf16* hr = H + (size_t)(row0 + r) * DM;
#pragma unroll
            for (int j = 0; j < 8; ++j) { const f32x4 o = v[j] * ga[j]; u32x2v w; w.x = pk2(o.x, o.y); w.y = pk2(o.z, o.w);
                *(u32x2v*)(hr + 4 * lane + 256 * j) = w; }
        }
    }
}
#ifndef MK_PHMASK
#define MK_PHMASK 0xFFFFFFFFu
#endif
#define EN(p) (((MK_PHMASK) >> (p)) & 1u)
#ifndef MK_REPEAT
#define MK_REPEAT 0u
#endif
#define REP(p) for (int rep_ = 0; rep_ < 1 + (int)(((MK_REPEAT) >> (p)) & 1u); ++rep_)
constexpr int NPH_LAYER = 10, NPHASE = 2 + DEPTH * NPH_LAYER;
struct Args { const float* in[37]; float* out; unsigned char* ws; int ph_lo, ph_hi; };
static_assert(sizeof(Args) == 39 * 8 + 8, "Args has no padding");

typedef const __attribute__((address_space(4))) Args* KArgs;
__device__ __forceinline__ KArgs kargs() { KArgs p = (KArgs)__builtin_amdgcn_kernarg_segment_ptr(); asm volatile("" : "+s"(p)); return p; }
#define AIN(i) (kargs()->in[i])
__global__ void __launch_bounds__(NTHR, 2) mk_fwd(Args args_unused) {
    extern __shared__ __attribute__((aligned(16))) unsigned char lds_raw[];
    LAS unsigned char* lds = (LAS unsigned char*)lds_raw;
    volatile LAS unsigned* MISC = (volatile LAS unsigned*)(lds + MISC_OFF);
    const int tid0 = threadIdx.x;
#define tid tid_fresh()
#define lane (tid_fresh() & 63)
#define wave (__builtin_amdgcn_readfirstlane(tid_fresh() >> 6))
    const int G0 = gridDim.x; const int bx0 = blockIdx.x; const int vcu0 = (G0 % 8 == 0) ? (bx0 % 8) * (G0 / 8) + bx0 / 8 : bx0;
#define G (sfresh(G0))
#define bx (sfresh(bx0))
#define vcu (sfresh(vcu0))
#define gw (vcu * NWAVES + wave)
#define ngw (G * NWAVES)
    gu32* ctl = (gu32*)(kargs()->ws + WS_CTL);
    for (int u = tid0; u < (LDS_BYTES - LDSCTL_OFF) / 4; u += NTHR) ((LAS unsigned*)(lds + LDSCTL_OFF))[u] = 0u;
    __syncthreads();
#if MK_MULTI
    XcdBarrier bar; bar.bar = (unsigned*)(ctl + CW_BAR); bar.x = 0; bar.st = nullptr;
#define SEAM(k) do { } while (0)
#else
    XcdBarrier bar = xcd_barrier_post((unsigned*)(ctl + CW_BAR), MISC + 8);
#define SEAM(k) do { if (IN(k) && IN((k) + 1)) { xcd_barrier(bar); if ((MK_REPEAT >> 19) & 1u) xcd_barrier(bar); } } while (0)
#endif
    const int lo = kargs()->ph_lo, hi = kargs()->ph_hi;
#define IN(k) (lo <= (k) && (k) < hi)
#define ws (kargs()->ws)
#define MOD ((float*)(ws + WS_MOD))
#define HB ((bf16*)(ws + WS_HB))
#define AFFN ((bf16*)(ws + WS_AFFN))
#define Z ((bf16*)(ws + WS_Z))
#define PROJ ((bf16*)(ws + WS_PROJ))
#define XT ((bf16*)(ws + WS_XT))
#define Y2T ((bf16*)(ws + WS_Y2T))
#define QD ((bf16*)(ws + WS_QD))
#define KVD ((bf16*)(ws + WS_KVD))
#define KMLA ((bf16*)(ws + WS_KMLA))
#define YCAT ((bf16*)(ws + WS_YCAT))
#define OUT (kargs()->out)

    if (EN(0) && IN(0)) REP(0) {
        REP(21) mod_phase(lds, AIN(2), AIN(3), AIN(4), AIN(5), MOD, vcu, G, tid);
        REP(22) for (int item = (vcu + G / 2) % G; item < DEPTH * 96; item += G) {     const int l = item / 96, r = item % 96; const int L = r < 32 ? LP : LS, tb = r < 32 ? r : r - 32;
            bf16* GFl = (bf16*)(ws + WS_GF + (size_t)l * SZ_GF + (r < 32 ? 0 : SZ_GF_P));
            filt_item(lds, L, tb, AIN(13) + (size_t)l * 33 * 64, AIN(14) + l * 64, AIN(15) + l * 64, AIN(16) + (size_t)l * 4096, AIN(17) + l * 64, AIN(18) + l * 64,
                      AIN(19) + (size_t)l * 64 * 2048, AIN(20) + (size_t)l * 2048, GFl, tid); }
        { LAS float* scr = (LAS float*)(lds + wave * 16384);
          constexpr int I_IN = 32 * 138, I_QB = 8 * 24, I_KVB = 4 * 32, I_OUT = 32 * 64, I_UP = 32 * 352, I_DN = 88 * 64, I_L = I_IN + I_QB + I_KVB + I_OUT + I_UP + I_DN;
          REP(23) for (int it = gw; it < DEPTH * I_L; it += ngw) { const int l = it / I_L; int r = it % I_L;
              if (r < I_IN) { p0_transpose_item(AIN(7) + (size_t)l * DM * INC, DM, INC, (bf16*)(ws + WS_WIN + l * SZ_WIN), 0, scr, r, lane); continue; } r -= I_IN;
              if (r < I_QB) { p0_transpose_item(AIN(25) + (size_t)l * 512 * 768, 512, 768, (bf16*)(ws + WS_WQB + l * SZ_WQB), 0, scr, r, lane); continue; } r -= I_QB;
              if (r < I_KVB) { p0_transpose_item(AIN(27) + (size_t)l * 256 * 1024, 256, 1024, (bf16*)(ws + WS_WKVB + l * SZ_WKVB), 0, scr, r, lane); continue; } r -= I_KVB;
              if (r < I_OUT) { p0_transpose_item(AIN(31) + (size_t)l * DM * DM, DM, DM, (bf16*)(ws + WS_WOUT + l * SZ_WOUT), 0, scr, r, lane); continue; } r -= I_OUT;
              if (r < I_UP) { const int n0 = 32 * (r % 352), hf = n0 >= DFF ? 1 : 0, j = n0 - DFF * hf, dest = 256 * (j >> 7) + 128 * hf + (j & 127);
                  p0_transpose_item(AIN(33) + (size_t)l * DM * DFF2, DM, DFF2, (bf16*)(ws + WS_WUP + l * SZ_WUP), dest - n0, scr, r, lane); continue; } r -= I_UP;
              p0_transpose_item(AIN(36) + (size_t)l * DFF * DM, DFF, DM, (bf16*)(ws + WS_WDN + l * SZ_WDN), 0, scr, r, lane); } }
        for (int i = vcu * NTHR + tid; i < DEPTH * (INCP - INC) * (DM / 8); i += G * NTHR) { const int l = i / ((INCP - INC) * (DM / 8)), r = i % ((INCP - INC) * (DM / 8));
            *(v4u*)(ws + WS_WIN + l * SZ_WIN + ((size_t)INC * DM + (size_t)r * 8) * 2) = (v4u){0u, 0u, 0u, 0u}; }
        VM_WAIT(); __syncthreads();
    }
    SEAM(0);

    if (EN(1) && IN(1)) REP(1) {
        ga_tables(AIN(6), AIN(32), MOD, (float*)(ws + WS_GA1), (float*)(ws + WS_GA2), vcu * NTHR + tid, G * NTHR);
        for (int it = vcu; it < DEPTH * 248; it += G) { const int l = it / 248, r = it % 248;
            if (r < 72) bvec_item(lds, MOD + (size_t)l * NB * MODW, (const bf16*)(ws + WS_WIN + l * SZ_WIN), (float*)(ws + WS_BV1) + (size_t)l * NB * INCP, INCP, r * 64, tid);
            else bvec_item(lds, MOD + (size_t)l * NB * MODW + 3 * DM, (const bf16*)(ws + WS_WUP + l * SZ_WUP), (float*)(ws + WS_BV2) + (size_t)l * NB * DFF2, DFF2, (r - 72) * 64, tid); }
        norm0_rows(AIN(0), AIN(1) - (size_t)NPR * DM, AIN(6), MOD, HB, (float*)(ws + WS_SS), gw, ngw, lane);
    }
    SEAM(1);

#pragma unroll 1
    for (int l = 0; l < DEPTH; ++l) {
        const int pb = 2 + l * NPH_LAYER;
#define xa ((l == 0) ? AIN(0) : OUT)
#define xb ((l == 0) ? (AIN(1) - (size_t)NPR * DM) : OUT)
#define modl (MOD + (size_t)l * NB * MODW)
        if (EN(2) && IN(pb + 0)) REP(2) {
            pg8::Gemm g{HB, (const bf16*)(ws + WS_WIN + l * SZ_WIN), NTOK, INCP, DM, DM, DM}; pg8::StaticOrder S; S.init(NTOK, INCP, G, bx);
            LAS float* rst = (LAS float*)(lds + TAB_OFF); LAS float* bvt = rst + 8 * 256;
            pg8::fill_tabs(S, (const float*)(ws + WS_SS) + (size_t)l * NTOK, (const float*)(ws + WS_BV1) + (size_t)l * NB * INCP, INCP, rst, bvt, tid);
            pg8::EpiBf E{PROJ, INCP, 4, rst, bvt, 0};
            pg8::gemm_phase<pg8::EpiBf, pg8::StaticOrder, true, true>(lds, g, S, E);
        }
        SEAM(pb + 0);
        if (EN(3) && IN(pb + 1)) {
            REP(20) post_rows(PROJ, AIN(8) + l * 512, AIN(22) + l * 128, AIN(23) + l * 128, AIN(24) + l * 512, AIN(26) + l * 256, gw, ngw, lane, rep_ == (int)((MK_REPEAT >> 20) & 1u));
            REP(3) for (int t = vcu; t < (NTOK / 64) * 3; t += G) hyconv_tile(lds, PROJ, XT, AIN(11) + (size_t)l * 3 * 1536, AIN(12) + l * 1536, t, tid);
        }
        SEAM(pb + 1);
        if (EN(4) && IN(pb + 2)) REP(4) {
            { pg8::Gemm g{PROJ + C_D, (const bf16*)(ws + WS_WQB + l * SZ_WQB), NTOK, 768, 512, INCP, 512}; pg8::StaticOrder S; S.init(NTOK, 768, G, bx);
              pg8::EpiBf E{QD, 768, 0, nullptr, nullptr, 0};
              pg8::gemm_phase<pg8::EpiBf, pg8::StaticOrder, true, true>(lds, g, S, E); }
            { pg8::Gemm g{PROJ + C_D + 512, (const bf16*)(ws + WS_WKVB + l * SZ_WKVB), NTOK, 1024, 256, INCP, 256}; pg8::StaticOrder S; S.init(NTOK, 1024, G, (bx + G / 2) % G);
              pg8::EpiBf E{KVD, 1024, 0, nullptr, nullptr, 0};
              pg8::gemm_phase<pg8::EpiBf, pg8::StaticOrder, true, true>(lds, g, S, E); }
        }
        SEAM(pb + 2);
        if (EN(5) && IN(pb + 3)) {
            REP(5) mla_rows(QD, KVD, PROJ, KMLA, AIN(28) + l * 192, AIN(29) + l * 192, gw, ngw, lane, rep_ == (int)((MK_REPEAT >> 5) & 1u));
        }
        SEAM(pb + 3);
        if (EN(6) && IN(pb + 4)) {
            if (EN(13)) REP(13) for (int u = vcu; u < 256; u += G) { const int bh = u >> 4, qb = u & 15, b = 4 + (bh >> 2), h = bh & 3; const size_t r0 = batch_row0(b);
                att::attn_body16<192, 768, 768, 1024, DM>(QD + (r0 + qb * 256) * 768 + h * 192, KMLA + r0 * 768 + h * 192, KVD + r0 * 1024 + h * 256 + 128,
                                      YCAT + (r0 + qb * 256) * DM + 1536 + h * 128, LS, (char*)lds_raw); }
            if (EN(14)) REP(14) for (int u = vcu; u < 256; u += G) { const int bh = u >> 4, qb = u & 15, b = 4 + (bh >> 2), h = bh & 3; const size_t r0 = batch_row0(b);
                att::attn_body16<128, INCP, INCP, INCP, DM>(PROJ + (r0 + qb * 256) * INCP + C_C + h * 128, PROJ + r0 * INCP + C_C + 512 + (h >> 1) * 128, PROJ + r0 * INCP + C_C + 768 + (h >> 1) * 128,
                                      YCAT + (r0 + qb * 256) * DM + 1024 + h * 128, LS, (char*)lds_raw); }
            if (EN(15)) REP(15) for (int u = vcu; u < 256; u += G)
                hy::hyena_unit<LS>((LAS char*)lds, (const bf16*)(ws + WS_GF + (size_t)l * SZ_GF + SZ_GF_P), XT, XT + (size_t)NTOK * 512, XT + (size_t)2 * NTOK * 512, Y2T, AIN(21) + l * 1024, 4, 2 * u);
            REP(17) for (int i = vcu; i < 256; i += G) { const int u = i & 127, bh = u >> 3, qb = u & 7, b = bh >> 2, h = bh & 3; const size_t r0 = batch_row0(b);
                if (i < 128) { if (EN(13))
                    att::attn_body16<192, 768, 768, 1024, DM>(QD + (r0 + qb * 256) * 768 + h * 192, KMLA + r0 * 768 + h * 192, KVD + r0 * 1024 + h * 256 + 128,
                                          YCAT + (r0 + qb * 256) * DM + 1536 + h * 128, LP, (char*)lds_raw); }
                else if (EN(14))
                    att::attn_body16<128, INCP, INCP, INCP, DM>(PROJ + (r0 + qb * 256) * INCP + C_C + h * 128, PROJ + r0 * INCP + C_C + 512 + (h >> 1) * 128, PROJ + r0 * INCP + C_C + 768 + (h >> 1) * 128,
                                          YCAT + (r0 + qb * 256) * DM + 1024 + h * 128, LP, (char*)lds_raw); }
            if (EN(15)) REP(18) for (int i = (G == 256) ? (vcu + 128) % 256 : vcu; i < 128; i += G)
                hy::hyena_unit<LP>((LAS char*)lds, (const bf16*)(ws + WS_GF + (size_t)l * SZ_GF), XT, XT + (size_t)NTOK * 512, XT + (size_t)2 * NTOK * 512, Y2T, AIN(21) + l * 1024, 0, 4 * i);
            if (EN(16)) REP(16) {
                if (G == 256) { const int v_ = vcu;
                    if (v_ < 128) { for (int u = v_; u < 768; u += 128) gmlp_unit((char*)lds_raw, PROJ, YCAT, AIN(9) + (size_t)l * 4 * 16384, AIN(10) + l * 512, u, tid); } }
                else for (int u = vcu; u < 768; u += G) gmlp_unit((char*)lds_raw, PROJ, YCAT, AIN(9) + (size_t)l * 4 * 16384, AIN(10) + l * 512, u, tid); }
            VM_WAIT(); __syncthreads();
        }
        SEAM(pb + 4);
        if (EN(7) && IN(pb + 5)) REP(7) { for (int t = vcu; t < NTOK / 32; t += G) gnorm_tile(lds, YCAT, Y2T, AIN(30) + l * DM, HB, t, tid); }
        SEAM(pb + 5);
        if (EN(8) && IN(pb + 6)) REP(8) {
            pg8::Gemm g{HB, (const bf16*)(ws + WS_WOUT + l * SZ_WOUT), NTOK, DM, DM, DM, DM}; pg8::StaticOrder S; S.init(NTOK, DM, G, bx);
            const bool dry = (((MK_REPEAT >> 8) & 1u) && rep_ == 0);
            pg8::EpiResid E{xa, xb, dry ? (float*)(ws + WS_R1) : OUT, modl + 2 * DM, dry ? nullptr : (bf16*)(ws + WS_HB2), (const float*)(ws + WS_GA2) + (size_t)l * NB * DM, (float*)(ws + WS_SS) + (size_t)(4 + l) * NTOK};
            pg8::gemm_phase<pg8::EpiResid, pg8::StaticOrder, true, true>(lds, g, S, E);
        }
        SEAM(pb + 6);
        if (EN(10) && IN(pb + 7)) REP(10) {
            pg8::Gemm g{(const bf16*)(ws + WS_HB2), (const bf16*)(ws + WS_WUP + l * SZ_WUP), NTOK, DFF2, DM, DM, DM}; pg8::StaticOrder S; S.init(NTOK, DFF2, G, bx);
            LAS float* rst = (LAS float*)(lds + TAB_OFF);
            pg8::fill_tabs(S, (const float*)(ws + WS_SS) + (size_t)(4 + l) * NTOK, nullptr, 0, rst, rst, tid);
            pg8::EpiGate E{AFFN, (float*)(ws + WS_R1), AIN(34) + (size_t)l * 3 * DFF2, AIN(35) + l * DFF2, (LAS float*)(lds + HALO_OFF), rst, (const float*)(ws + WS_BV2) + (size_t)l * NB * DFF2, 0};
            pg8::gemm_phase<pg8::EpiGate, pg8::StaticOrder, true, true>(lds, g, S, E);
        }
        SEAM(pb + 7);
        if (EN(11) && IN(pb + 8)) REP(11) gate_fix((const float*)(ws + WS_R1), AFFN, AIN(34) + (size_t)l * 3 * DFF2, AIN(35) + l * DFF2, vcu * NTHR + tid, G * NTHR);
        SEAM(pb + 8);
        if (EN(12) && IN(pb + 9)) REP(12) {
            pg8::Gemm g{AFFN, (const bf16*)(ws + WS_WDN + l * SZ_WDN), NTOK, DM, DFF, DFF, DFF}; pg8::StaticOrder S; S.init(NTOK, DM, G, bx);
            const bool dry = (((MK_REPEAT >> 12) & 1u) && rep_ == 0);
            pg8::EpiResid E{OUT, OUT, dry ? (float*)(ws + WS_R1) : OUT, modl + 5 * DM, (dry || l + 1 == DEPTH) ? nullptr : HB, (const float*)(ws + WS_GA1) + (size_t)(l + 1) * NB * DM, (float*)(ws + WS_SS) + (size_t)(l + 1) * NTOK};
            pg8::gemm_phase<pg8::EpiResid, pg8::StaticOrder, true, true, true, false>(lds, g, S, E);
        }
        if (l + 1 < DEPTH) SEAM(pb + 9);
    }
#undef xa
#undef xb
#undef modl
#undef G
#undef bx
#undef vcu
#undef ngw
#undef IN
#undef SEAM
#undef tid
#undef lane
#undef wave
#undef gw
#undef ws
#undef MOD
#undef HB
#undef AFFN
#undef Z
#undef PROJ
#undef XT
#undef Y2T
#undef QD
#undef KVD
#undef KMLA
#undef YCAT
#undef OUT
}

extern "C" void kernel_launch(void* const* d_in, const int* in_sizes, int n_in, void* d_out, int out_size, void* d_ws, size_t ws_size, hipStream_t stream) {
    static int grid = 0;
    if (grid == 0) {
        if (n_in != 37 || out_size != NTOK * DM || ws_size < WS_END) { fprintf(stderr, "kernel_launch: shape mismatch (n_in %d out %d ws %zu need %zu)\n", n_in, out_size, ws_size, (size_t)WS_END); grid = -1; return; }
        int dev = 0, cus = 0, per_cu = 0;
        if (hipGetDevice(&dev) != hipSuccess || hipDeviceGetAttribute(&cus, hipDeviceAttributeMultiprocessorCount, dev) != hipSuccess) { grid = -1; return; }
        if (hipFuncSetAttribute((const void*)mk_fwd, hipFuncAttributeMaxDynamicSharedMemorySize, LDS_BYTES) != hipSuccess) { fprintf(stderr, "kernel_launch: hipFuncSetAttribute failed\n"); grid = -1; return; }
        if (hipOccupancyMaxActiveBlocksPerMultiprocessor(&per_cu, (const void*)mk_fwd, NTHR, LDS_BYTES) != hipSuccess || per_cu < 1)
            fprintf(stderr, "kernel_launch: occupancy query reports %d workgroups per CU\n", per_cu);
        (void)hipGetLastError();
        grid = cus;
        if (grid > 256) grid = 256;
    }
    if (grid < 0) return;
    if (hipMemsetAsync((char*)d_ws + WS_CTL, 0, CTL_ZERO_BYTES, stream) != hipSuccess) { fprintf(stderr, "kernel_launch: memset failed\n"); return; }
    Args a{};
    for (int i = 0; i < 37; ++i) a.in[i] = (const float*)d_in[i];
    a.out = (float*)d_out; a.ws = (unsigned char*)d_ws;
#if MK_MULTI
    for (int p = 0; p < NPHASE; ++p) { a.ph_lo = p; a.ph_hi = p + 1; hipLaunchKernelGGL(mk_fwd, dim3(grid), dim3(NTHR), LDS_BYTES, stream, a); }
#else
    a.ph_lo = 0; a.ph_hi = NPHASE;
    hipLaunchKernelGGL(mk_fwd, dim3(grid), dim3(NTHR), LDS_BYTES, stream, a);
#endif
    const hipError_t le = hipPeekAtLastError();
    if (le != hipSuccess) fprintf(stderr, "kernel_launch: launch failed: %s\n", hipGetErrorName(le));
}
```

```cpp
#include <hip/hip_runtime.h>
#include <hip/hip_bf16.h>
#include <cstdio>
#include <cstdint>
#include <cmath>

#ifndef MK_MULTI
#define MK_MULTI 0
#endif

constexpr int DM = 2048, NTOK = 24576, NPR = 8192  , LP = 2048, LS = 4096, DEPTH = 4, NB = 8  ;
constexpr int INC = 4416, INCP = 4608;
constexpr int C_A = 0, C_B = 1024, C_C = 2560, C_D = 3584;
constexpr int DFF = 5632, DFF2 = 11264;
constexpr int MODW = 6 * DM;
constexpr float EPS = 1e-6f;
constexpr int NWAVES = 8, NTHR = 512;

constexpr size_t MiB = 1u << 20;
constexpr size_t WS_CTL = 0, CTL_ZERO_BYTES = 512 * 1024;
constexpr size_t WS_SSQ1 = 65536, WS_SSQ2 = WS_SSQ1 + (size_t)NTOK * 8;
static_assert(WS_SSQ2 + (size_t)NTOK * 8 <= CTL_ZERO_BYTES, "ssq inside the memset");
constexpr size_t WS_MOD = 1 * MiB;
constexpr size_t WS_GA1 = 2 * MiB + 512 * 1024;
constexpr size_t WS_GA2 = WS_GA1 + 256 * 1024;
constexpr size_t WS_BV1 = 3 * MiB;
constexpr size_t WS_BV2 = 4 * MiB;
constexpr size_t WS_WIN = 6 * MiB;
constexpr size_t SZ_WIN = (size_t)INCP * DM * 2;
constexpr size_t WS_WQB = WS_WIN + DEPTH * SZ_WIN;
constexpr size_t SZ_WQB = (size_t)768 * 512 * 2;
constexpr size_t WS_WKVB = WS_WQB + DEPTH * SZ_WQB;
constexpr size_t SZ_WKVB = (size_t)1024 * 256 * 2;
constexpr size_t WS_WOUT = WS_WKVB + DEPTH * SZ_WKVB;
constexpr size_t SZ_WOUT = (size_t)DM * DM * 2;
constexpr size_t WS_WUP = WS_WOUT + DEPTH * SZ_WOUT;
constexpr size_t SZ_WUP = (size_t)DFF2 * DM * 2;
constexpr size_t WS_WDN = WS_WUP + DEPTH * SZ_WUP;
constexpr size_t SZ_WDN = (size_t)DM * DFF * 2;
constexpr size_t WS_GF = WS_WDN + DEPTH * SZ_WDN;
constexpr size_t SZ_GF_P = (size_t)2 * 512 * 4608 * 2, SZ_GF_S = (size_t)2 * 512 * 9216 * 2, SZ_GF = SZ_GF_P + SZ_GF_S;
constexpr size_t WS_HB = WS_GF + DEPTH * SZ_GF;
constexpr size_t WS_HB2 = WS_HB + (size_t)NTOK * DM * 2;
constexpr size_t WS_AFFN = WS_HB2 + (size_t)NTOK * DM * 2;
constexpr size_t WS_R1 = WS_AFFN + (size_t)NTOK * DFF * 2;
constexpr size_t WS_Z = WS_R1;
constexpr size_t WS_PROJ = WS_R1;
constexpr size_t WS_XT = WS_PROJ + (size_t)NTOK * INCP * 2;
constexpr size_t SZ_XT1 = (size_t)NTOK * 512 * 2;
constexpr size_t WS_Y2T = WS_XT + 3 * SZ_XT1;
constexpr size_t WS_QD = WS_Y2T + SZ_XT1;
constexpr size_t WS_KVD = WS_QD + (size_t)NTOK * 768 * 2;
constexpr size_t WS_KMLA = WS_KVD + (size_t)NTOK * 1024 * 2;
constexpr size_t WS_YCAT = WS_KMLA + (size_t)NTOK * 768 * 2;
constexpr size_t WS_XRES = WS_R1 + 64 * MiB;
constexpr size_t WS_END = WS_R1 + (size_t)NTOK * DFF2 * 2;
static_assert(WS_YCAT + (size_t)NTOK * DM * 2 <= WS_END, "mixer buffers fit under Z");
static_assert(WS_BV2 + (size_t)DEPTH * NB * DFF2 * 4 <= WS_WIN, "ws map");
constexpr int CW_BAR = 4096;

__host__ __device__ __forceinline__ size_t xt_off(int b, int c) { return b < 4 ? ((size_t)(b * 512 + c) * LP) : ((size_t)4 * 512 * LP + (size_t)((b - 4) * 512 + c) * LS); }
__host__ __device__ __forceinline__ int row_batch(int row) { return row < NPR ? (row >> 11) : 4 + ((row - NPR) >> 12); }
__host__ __device__ __forceinline__ int row_pos(int row) { return row < NPR ? (row & (LP - 1)) : ((row - NPR) & (LS - 1)); }
__host__ __device__ __forceinline__ int batch_row0(int b) { return b < 4 ? b * LP : NPR + (b - 4) * LS; }
__host__ __device__ __forceinline__ int batch_len(int b) { return b < 4 ? LP : LS; }

__host__ __device__ __forceinline__ size_t affn_off(int row, int j) { return ((((size_t)(row >> 8) * (DFF / 64) + (j >> 6)) * 256 + (row & 255)) << 6) + (j & 63); }

constexpr int RING_BYTES = 131072;
constexpr int LDSCTL_OFF = RING_BYTES, MISC_OFF = LDSCTL_OFF + 320, HALO_OFF = RING_BYTES + 1024;
constexpr int TAB_OFF = HALO_OFF + 8192 + 1024, TAB_BYTES = 17408;
constexpr int LDS_BYTES = 161792;
#define GAS __attribute__((address_space(1)))
#define LAS __attribute__((address_space(3)))
typedef unsigned short bf16;
typedef unsigned v4u __attribute__((ext_vector_type(4)));
typedef float f32x4 __attribute__((ext_vector_type(4)));
typedef short bf16x8 __attribute__((ext_vector_type(8)));
typedef GAS unsigned gu32;
typedef GAS unsigned long long gu64;
#define RLX_AGENT __ATOMIC_RELAXED, __HIP_MEMORY_SCOPE_AGENT
#define LDS_WAIT() asm volatile("s_waitcnt lgkmcnt(0)" ::: "memory")
#define VM_WAIT() asm volatile("s_waitcnt vmcnt(0)" ::: "memory")
__device__ __forceinline__ int tid_fresh() { int t = threadIdx.x; asm volatile("" : "+v"(t)); return t; }
__device__ __forceinline__ int sfresh(int v) { asm volatile("" : "+s"(v)); return v; }
__device__ __forceinline__ unsigned long long rt() { return __builtin_amdgcn_s_memrealtime(); }
__device__ __forceinline__ unsigned f2bf(float f) { unsigned u = __builtin_bit_cast(unsigned, f); return (u + 0x7fffu + ((u >> 16) & 1u)) >> 16; }
__device__ __forceinline__ unsigned pk2(float lo, float hi) { return f2bf(lo) | (f2bf(hi) << 16); }
#define XB_TMO      128
#define XB_XCNT(j)  (256  + 64 * (j))
#define XB_XSUB(j)  (1280 + 64 * (j))
#define XB_XGEN(j)  (2304 + 64 * (j))
#define XB_TOP      3328
#define XB_TOPGEN   3392
#define XCD_BAR_WORDS 3456
#define XB_SPIN_CAP (1u << 18)

__device__ __forceinline__ unsigned xb_ld(unsigned* p)              { return __hip_atomic_load(p, __ATOMIC_RELAXED, __HIP_MEMORY_SCOPE_AGENT); }
__device__ __forceinline__ unsigned xb_add(unsigned* p, unsigned v) { return __hip_atomic_fetch_add(p, v, __ATOMIC_RELAXED, __HIP_MEMORY_SCOPE_AGENT); }
__device__ __forceinline__ unsigned xb_xcc_id() { return (unsigned)__builtin_amdgcn_s_getreg((3 << 11) | 20) & 0xFu; }
#define XB_SPIN(cond, bar) do { unsigned _sp = 0; while (cond) { __builtin_amdgcn_s_sleep(1); \
    if ((++_sp & 255u) == 0u) { if (xb_ld(&(bar)[XB_TMO])) break; if (_sp > XB_SPIN_CAP) { atomicAdd(&(bar)[XB_TMO], 1u); break; } } } } while (0)

struct XcdBarrier {
    unsigned* bar; unsigned x;
    volatile LAS unsigned* st;
};

__device__ __forceinline__ XcdBarrier xcd_barrier_post(unsigned* bar, volatile LAS unsigned* st) {
    XcdBarrier b; b.bar = bar; b.x = xb_xcc_id(); b.st = st;
    if (threadIdx.x == 0) (void)xb_add(&bar[XB_XCNT(b.x)], 1u);
    return b;
}
__device__ __forceinline__ void xcd_barrier_complete(unsigned* bar, unsigned x, unsigned& nloc, unsigned& nx) {
    const unsigned G = gridDim.x * gridDim.y * gridDim.z;
    unsigned sum, cnt, mine, sp = 0u;
    for (;;) {
        sum = 0u; cnt = 0u; mine = 0u;
#pragma unroll
        for (unsigned j = 0; j < 16; ++j) { const unsigned c = xb_ld(&bar[XB_XCNT(j)]); sum += c; cnt += (c > 0u) ? 1u : 0u; mine = (j == x) ? c : mine; }
        if (sum == G) break;
        __builtin_amdgcn_s_sleep(1);
        if ((++sp & 255u) == 0u) { if (xb_ld(&bar[XB_TMO])) break; if (sp > XB_SPIN_CAP) { atomicAdd(&bar[XB_TMO], 1u); break; } }
    }
    nloc = mine > 0u ? mine : 1u; nx = cnt > 0u ? cnt : 1u;
}

__device__ __forceinline__ void xcd_barrier(const XcdBarrier& b) {
    asm volatile("s_waitcnt vmcnt(0)" ::: "memory");
    __syncthreads();
    if (threadIdx.x == 0) {
        unsigned* bar = b.bar;
        __builtin_amdgcn_s_waitcnt(0);
        unsigned nloc = b.st[0], nx = b.st[1];
        if (nloc == 0u) { xcd_barrier_complete(bar, b.x, nloc, nx); b.st[0] = nloc; b.st[1] = nx; }
        const unsigned old = xb_add(&bar[XB_XSUB(b.x)], 1u);
        const unsigned gen = old / nloc;
        if (old + 1u == (gen + 1u) * nloc) {
            __builtin_amdgcn_fence(__ATOMIC_RELEASE, "agent");
            asm volatile("s_waitcnt vmcnt(0)" ::: "memory");
            const unsigned og = xb_add(&bar[XB_TOP], 1u);
            const unsigned tg = og / nx;
            if (og + 1u == (tg + 1u) * nx) xb_add(&bar[XB_TOPGEN], 1u);
            else XB_SPIN(xb_ld(&bar[XB_TOPGEN]) == tg, bar);
            __builtin_amdgcn_fence(__ATOMIC_ACQUIRE, "agent");
            xb_add(&bar[XB_XGEN(b.x)], 1u);
            asm volatile("s_waitcnt vmcnt(0)" ::: "memory");
        } else {
            XB_SPIN(xb_ld(&bar[XB_XGEN(b.x)]) == gen, bar);
            __builtin_amdgcn_fence(__ATOMIC_ACQUIRE, "agent");
            asm volatile("s_waitcnt vmcnt(0)" ::: "memory");
        }
    }
    __syncthreads();
}
namespace pg8 {
#define PG8_LAS __attribute__((address_space(3)))
typedef unsigned short bf16_t;
typedef short bf16x8 __attribute__((ext_vector_type(8)));
typedef float f32x4 __attribute__((ext_vector_type(4)));
typedef unsigned u32x4 __attribute__((ext_vector_type(4)));
constexpr int BM = 256, BK = 64, HALF = 128, HTB = HALF * BK * 2  , STAGE_BYTES = 8 * HTB, NXCD = 8, WGM = 4;

__host__ __device__ __forceinline__ int lds_byte(int r, int c) { const int st = (r >> 4) * 2 + (c >> 5), rr = r & 15, cc = c & 31, ob = rr * 64 + cc * 2; return st * 1024 + (ob ^ (((ob >> 9) & 1) << 5)); }
__host__ __device__ __forceinline__ void stage_rc(int b, int& R, int& C) { const int st = b / 1024, sb = b % 1024, swz = sb ^ (((sb >> 9) & 1) << 5); R = (st >> 1) * 16 + swz / 64; C = (st & 1) * 32 + (swz % 64) / 2; }
__host__ __device__ __forceinline__ int perm32(int rho) { const int n = rho >> 4, i = rho & 15; return 8 * (i >> 2) + 4 * n + (i & 3); }

struct Unit { int pm, pn; };
struct Gemm { const bf16_t* A; const bf16_t* Bt; int M, N, K, lda, ldb; };

struct StaticOrder {
    int nM, nN, nwg, G, c;
    __host__ __device__ void init(int M, int N, int G_, int c_) { nM = M / BM; nN = N / BM; nwg = nM * nN; G = G_; c = c_; }
    __host__ __device__ bool next(int i, Unit& u) const {
        const long L = (long)i * G + c; if (L >= nwg) return false;
        int wgid = (int)L; { const int q = nwg / NXCD, r = nwg % NXCD, xcd = wgid % NXCD, off = wgid / NXCD; wgid = (xcd < r ? xcd * (q + 1) : r * (q + 1) + (xcd - r) * q) + off; }
        const int nig = WGM * nN, gid = wgid / nig, fm = gid * WGM, gsz = (nM - fm) < WGM ? (nM - fm) : WGM;
        u.pm = fm + ((wgid % nig) % gsz); u.pn = (wgid % nig) / gsz; return true;
    }
    __device__ __forceinline__ void a_ready(const Unit&) const {}
    __device__ __forceinline__ void done(const Unit&) const {}
};

__device__ __forceinline__ unsigned cvt_pk_bf16(float lo, float hi) { unsigned r; asm volatile("v_cvt_pk_bf16_f32 %0, %1, %2" : "=v"(r) : "v"(lo), "v"(hi)); return r; }
typedef float f32x2 __attribute__((ext_vector_type(2)));
__device__ __forceinline__ f32x2 gelu_pk(f32x2 v) {
    const f32x2 av = __builtin_elementwise_abs(v), d = av * 0.2316418882f + 1.0f;
    f32x2 t; t.x = __builtin_amdgcn_rcpf(d.x); t.y = __builtin_amdgcn_rcpf(d.y);
    f32x2 q = t * 0.5307027145f + (-0.7265760135f); q = q * t + 0.7107068705f; q = q * t + (-0.142248368f); q = q * t + 0.127414796f; q = q * t;
    const f32x2 s = (v * v) * (-0.72134752044f);
    f32x2 e; e.x = __builtin_amdgcn_exp2f(s.x); e.y = __builtin_amdgcn_exp2f(s.y);
    const f32x2 m = v * (q * e), r = v - m;
    f32x2 o; o.x = v.x < 0.f ? m.x : r.x; o.y = v.y < 0.f ? m.y : r.y; return o;
}

template <class Epi, class Sched, bool ALIGN_EPI = false, bool SP2 = false, bool BLKA = false, bool BLKB = false>
__device__ __forceinline__ void gemm_phase(PG8_LAS unsigned char* lds, const Gemm g, const Sched& S, const Epi& E) {
    const int tid = tid_fresh(), wid = __builtin_amdgcn_readfirstlane(tid >> 6), lane = tid & 63, wr = wid >> 2, wc = wid & 3, fr = lane & 15, fq = lane >> 4;
    const int K = g.K, nt = K / BK;
    unsigned voffA[2], voffB[2];
#pragma unroll
    for (int i = 0; i < 2; ++i) { int R, C; stage_rc(tid * 16 + i * 8192, R, C); const int Rb = Epi::PERM ? ((R & ~31) + perm32(R & 31)) : R;
        const int Ra = Epi::AROWPERM ? ((R & ~63) | (4 * (R & 15) + ((R >> 4) & 3))) : R;
        voffA[i] = (unsigned)(Ra * (BLKA ? BK : g.lda) + C) * 2u; voffB[i] = (unsigned)(Rb * (BLKB ? BK : g.ldb) + C) * 2u; }
    const size_t kstepA = BLKA ? (size_t)BM * BK * 2 : (size_t)(BK * 2), kstepB = BLKB ? (size_t)BM * BK * 2 : (size_t)(BK * 2);
    const size_t hstepA = BLKA ? (size_t)HALF * BK * 2 : (size_t)HALF * g.lda * 2, hstepB = BLKB ? (size_t)HALF * BK * 2 : (size_t)HALF * g.ldb * 2;
    const size_t tstepA = BLKA ? (size_t)nt * BM * BK * 2 : 2 * hstepA, tstepB = BLKB ? (size_t)nt * BM * BK * 2 : 2 * hstepB;
    const unsigned ldsw = (unsigned)wid * 1024u;
    const int aoff = lds_byte(wr * 64 + fr, fq * 8), boff = lds_byte(wc * 32 + fr, fq * 8);
#define PG8_SA(b, h) (((b) * 2 + (h)) * HTB)
#define PG8_SB(b, h) ((4 + (b) * 2 + (h)) * HTB)
#define PG8_STAGE(bufoff, gbase, voff) do { _Pragma("unroll") for (int _i = 0; _i < 2; ++_i) \
        __builtin_amdgcn_global_load_lds((const unsigned*)((const char*)(gbase) + (voff)[_i]), (PG8_LAS unsigned*)(lds + (bufoff) + ldsw + _i * 8192), 16, 0, 0); } while (0)
#define PG8_LDA(dst, b, h) do { _Pragma("unroll") for (int m = 0; m < 4; ++m) _Pragma("unroll") for (int k = 0; k < 2; ++k) dst[m][k] = *(const PG8_LAS bf16x8*)(lds + PG8_SA(b, h) + aoff + m * 2048 + k * 1024); } while (0)
#define PG8_LDB(dst, b, h) do { _Pragma("unroll") for (int n = 0; n < 2; ++n) _Pragma("unroll") for (int k = 0; k < 2; ++k) dst[n][k] = *(const PG8_LAS bf16x8*)(lds + PG8_SB(b, h) + boff + n * 2048 + k * 1024); } while (0)
#define PG8_MMA(ai, bj, At, Bt) do { __builtin_amdgcn_s_setprio(1); _Pragma("unroll") for (int m = 0; m < 4; ++m) _Pragma("unroll") for (int n = 0; n < 2; ++n) _Pragma("unroll") for (int k = 0; k < 2; ++k) \
        acc[ai][bj][m][n] = __builtin_amdgcn_mfma_f32_16x16x32_bf16(Bt[n][k], At[m][k], acc[ai][bj][m][n], 0, 0, 0); __builtin_amdgcn_s_setprio(0); } while (0)
#define PG8_WAIT_V(n) asm volatile("s_waitcnt vmcnt(" #n ")" ::: "memory")
#define PG8_WAIT_L(n) asm volatile("s_waitcnt lgkmcnt(" #n ")" ::: "memory")
#define PG8_BAR __builtin_amdgcn_s_barrier()
#define PG8_SCHED __builtin_amdgcn_sched_barrier(0)
    Unit cur, nxt; int ui = 0;
    if (!S.next(0, cur)) return;
    f32x4 acc[2][2][4][2];
#pragma unroll
    for (int a = 0; a < 2; ++a)
#pragma unroll
        for (int b = 0; b < 2; ++b)
#pragma unroll
            for (int m = 0; m < 4; ++m)
#pragma unroll
                for (int n = 0; n < 2; ++n) acc[a][b][m][n] = (f32x4){0.f, 0.f, 0.f, 0.f};
    bf16x8 At[4][2], B0[2][2], B1[2][2];
    const char* cA = (const char*)g.A + (size_t)cur.pm * tstepA; const char* cB = (const char*)g.Bt + (size_t)cur.pn * tstepB;
    S.a_ready(cur);
    if constexpr (SP2) {
        PG8_STAGE(PG8_SB(0, 0), cB, voffB); PG8_STAGE(PG8_SB(0, 1), cB + hstepB, voffB); PG8_STAGE(PG8_SA(0, 0), cA, voffA); PG8_STAGE(PG8_SA(0, 1), cA + hstepA, voffA);
        if (wr == 1) PG8_BAR;
        PG8_WAIT_V(2); PG8_BAR;
        PG8_STAGE(PG8_SB(1, 0), cB + kstepB, voffB); PG8_STAGE(PG8_SA(1, 0), cA + kstepA, voffA); PG8_STAGE(PG8_SB(1, 1), cB + hstepB + kstepB, voffB);
        PG8_WAIT_V(6); PG8_BAR;
    } else {
        PG8_STAGE(PG8_SB(0, 0), cB, voffB); PG8_STAGE(PG8_SA(0, 0), cA, voffA); PG8_STAGE(PG8_SB(0, 1), cB + hstepB, voffB); PG8_STAGE(PG8_SA(0, 1), cA + hstepA, voffA);
        if (wr == 1) PG8_BAR;
        PG8_WAIT_V(4); PG8_BAR;
        PG8_STAGE(PG8_SB(1, 0), cB + kstepB, voffB); PG8_STAGE(PG8_SA(1, 0), cA + kstepA, voffA); PG8_STAGE(PG8_SB(1, 1), cB + hstepB + kstepB, voffB);
        PG8_WAIT_V(6); PG8_BAR;
    }
    for (;;) {
        const bool has_next = S.next(ui + 1, nxt);
        const char* nA = has_next ? (const char*)g.A + (size_t)nxt.pm * tstepA : cA; const char* nB = has_next ? (const char*)g.Bt + (size_t)nxt.pn * tstepB : cB;
        for (int t = 0; t < nt; t += 2) {
            const bool last = (t == nt - 2);
            const char* a1 = cA + (size_t)(t + 1) * kstepA;
            const char* a2 = last ? nA : cA + (size_t)(t + 2) * kstepA; const char* b2 = last ? nB : cB + (size_t)(t + 2) * kstepB;
            const char* a3 = a2 + kstepA; const char* b3 = b2 + kstepB;
            if (last && has_next) S.a_ready(nxt);
            if constexpr (SP2) {
            PG8_LDB(B0, 0, 0); PG8_LDB(B1, 0, 1); PG8_SCHED; PG8_LDA(At, 0, 0); PG8_STAGE(PG8_SA(1, 1), a1 + hstepA, voffA);
            PG8_WAIT_V(8); PG8_WAIT_L(0); PG8_BAR; PG8_MMA(0, 0, At, B0); PG8_MMA(0, 1, At, B1); PG8_BAR; PG8_SCHED;
            PG8_LDA(At, 0, 1); PG8_STAGE(PG8_SB(0, 0), b2, voffB); PG8_STAGE(PG8_SB(0, 1), b2 + hstepB, voffB); PG8_STAGE(PG8_SA(0, 0), a2, voffA);
            PG8_WAIT_V(8); PG8_WAIT_L(0); PG8_BAR; PG8_MMA(1, 0, At, B0); PG8_MMA(1, 1, At, B1); PG8_BAR; PG8_SCHED;
            PG8_LDB(B0, 1, 0); PG8_LDB(B1, 1, 1); PG8_SCHED; PG8_LDA(At, 1, 0); PG8_STAGE(PG8_SA(0, 1), a2 + hstepA, voffA);
            PG8_WAIT_V(8); PG8_WAIT_L(0); PG8_BAR; PG8_MMA(0, 0, At, B0); PG8_MMA(0, 1, At, B1); PG8_BAR; PG8_SCHED;
            PG8_LDA(At, 1, 1); PG8_STAGE(PG8_SB(1, 0), b3, voffB); PG8_STAGE(PG8_SB(1, 1), b3 + hstepB, voffB); PG8_STAGE(PG8_SA(1, 0), a3, voffA);
            PG8_WAIT_V(8); PG8_WAIT_L(0); PG8_BAR; PG8_MMA(1, 0, At, B0); PG8_MMA(1, 1, At, B1); PG8_BAR; PG8_SCHED;
            } else {
            PG8_LDB(B0, 0, 0); PG8_SCHED; PG8_LDA(At, 0, 0); PG8_STAGE(PG8_SA(1, 1), a1 + hstepA, voffA);
            PG8_WAIT_L(8); PG8_BAR; PG8_WAIT_L(0); PG8_MMA(0, 0, At, B0); PG8_BAR; PG8_SCHED;
            PG8_LDB(B1, 0, 1); PG8_STAGE(PG8_SB(0, 0), b2, voffB);
            PG8_BAR; PG8_WAIT_L(0); PG8_MMA(0, 1, At, B1); PG8_BAR;
            PG8_LDA(At, 0, 1); PG8_STAGE(PG8_SA(0, 0), a2, voffA);
            PG8_BAR; PG8_WAIT_L(0); PG8_MMA(1, 0, At, B0); PG8_BAR; PG8_SCHED;
            PG8_STAGE(PG8_SB(0, 1), b2 + hstepB, voffB);
            PG8_WAIT_V(6); PG8_BAR; PG8_MMA(1, 1, At, B1); PG8_BAR;
            PG8_LDB(B0, 1, 0); PG8_SCHED; PG8_LDA(At, 1, 0); PG8_STAGE(PG8_SA(0, 1), a2 + hstepA, voffA);
            PG8_WAIT_L(8); PG8_BAR; PG8_WAIT_L(0); PG8_MMA(0, 0, At, B0); PG8_BAR; PG8_SCHED;
            PG8_LDB(B1, 1, 1); PG8_STAGE(PG8_SB(1, 0), b3, voffB);
            PG8_BAR; PG8_WAIT_L(0); PG8_MMA(0, 1, At, B1); PG8_BAR;
            PG8_LDA(At, 1, 1); PG8_STAGE(PG8_SA(1, 0), a3, voffA);
            PG8_BAR; PG8_WAIT_L(0); PG8_MMA(1, 0, At, B0); PG8_BAR; PG8_SCHED;
            PG8_STAGE(PG8_SB(1, 1), b3 + hstepB, voffB);
            PG8_WAIT_V(6); PG8_BAR; PG8_MMA(1, 1, At, B1); PG8_BAR;
            }
        }
        if constexpr (ALIGN_EPI) { if (wr == 0) PG8_BAR; }
        if constexpr (!Epi::AFTER_DRAIN) { E(acc, cur, wr, wc, fr, fq); S.done(cur); }
        if (!has_next) break;
#pragma unroll
        for (int a = 0; a < 2; ++a)
#pragma unroll
            for (int b = 0; b < 2; ++b)
#pragma unroll
                for (int m = 0; m < 4; ++m)
#pragma unroll
                    for (int n = 0; n < 2; ++n) acc[a][b][m][n] = (f32x4){0.f, 0.f, 0.f, 0.f};
        cur = nxt; cA = nA; cB = nB; ++ui;
        if constexpr (ALIGN_EPI) { if (wr == 1) PG8_BAR; }
    }
    PG8_WAIT_V(0);
    if constexpr (!ALIGN_EPI) { if (wr == 0) PG8_BAR; }
    PG8_BAR;
    if constexpr (Epi::AFTER_DRAIN) { E.fused(acc, cur, wr, wc, fr, fq, lds, wid, lane); S.done(cur); }
#undef PG8_SA
#undef PG8_SB
#undef PG8_STAGE
#undef PG8_LDA
#undef PG8_LDB
#undef PG8_MMA
#undef PG8_WAIT_V
#undef PG8_WAIT_L
#undef PG8_BAR
#undef PG8_SCHED
}
}
namespace pg8 {
struct EpiBf {
    static constexpr bool PERM = true, AFTER_DRAIN = false, AROWPERM = false;
    bf16_t* O; int ldc; int gelu_tiles;
    const PG8_LAS float* ss; const PG8_LAS float* bvec; mutable int ui;
    __device__ __forceinline__ void operator()(const f32x4 (&acc)[2][2][4][2], const Unit& u, int wr, int wc, int fr, int fq) const {
        const int row0 = u.pm * BM + wr * 64 + fr; const int col0 = u.pn * BM + wc * 32 + 8 * fq;
        const bool act = u.pn < gelu_tiles;
        f32x4 bv[2][2];
        if (ss) { const PG8_LAS float* bp = bvec + ui * BM + wc * 32 + 8 * fq;
#pragma unroll
            for (int bj = 0; bj < 2; ++bj)
#pragma unroll
                for (int n = 0; n < 2; ++n) bv[bj][n] = *(const PG8_LAS f32x4*)(bp + bj * HALF + 4 * n); }
#pragma unroll
        for (int ai = 0; ai < 2; ++ai)
#pragma unroll
            for (int m = 0; m < 4; ++m) { bf16_t* rowp = O + (size_t)(row0 + ai * HALF + m * 16) * ldc + col0;
                float rs = 1.f; if (ss) rs = ss[ui * BM + wr * 64 + fr + ai * HALF + m * 16];
#pragma unroll
                for (int bj = 0; bj < 2; ++bj) { f32x4 v0 = acc[ai][bj][m][0], v1 = acc[ai][bj][m][1];
                    if (ss) { v0 = v0 * rs + bv[bj][0]; v1 = v1 * rs + bv[bj][1]; }
                    if (act) { f32x2 a = gelu_pk((f32x2){v0[0], v0[1]}), b = gelu_pk((f32x2){v0[2], v0[3]}), c = gelu_pk((f32x2){v1[0], v1[1]}), d = gelu_pk((f32x2){v1[2], v1[3]});
                        v0 = (f32x4){a.x, a.y, b.x, b.y}; v1 = (f32x4){c.x, c.y, d.x, d.y}; }
                    u32x4 w; w.x = cvt_pk_bf16(v0[0], v0[1]); w.y = cvt_pk_bf16(v0[2], v0[3]); w.z = cvt_pk_bf16(v1[0], v1[1]); w.w = cvt_pk_bf16(v1[2], v1[3]);
                    *(u32x4*)(rowp + bj * HALF) = w; } }
        ++ui;
    }
};
template <bool XBF, bool OBF>
struct EpiResidT {
    static constexpr bool PERM = true, AFTER_DRAIN = false, AROWPERM = false;
    const void* xa; const void* xb; void* out; const float* gate;
    bf16_t* xg; const float* ga; unsigned long long* ssq;
    __device__ __forceinline__ void operator()(const f32x4 (&acc)[2][2][4][2], const Unit& u, int wr, int wc, int fr, int fq) const {
        const int row0 = u.pm * BM + wr * 64 + fr; const int col0 = u.pn * BM + wc * 32 + 8 * fq;
        const int b = row_batch(u.pm * BM); const void* xin = (u.pm * BM < NPR) ? xa : xb;
        f32x4 gv[2][2], gn[2][2];
#pragma unroll
        for (int bj = 0; bj < 2; ++bj)
#pragma unroll
            for (int n = 0; n < 2; ++n) { gv[bj][n] = *(const f32x4*)(gate + (size_t)b * MODW + col0 + bj * HALF + 4 * n);
                if (xg) gn[bj][n] = *(const f32x4*)(ga + (size_t)b * DM + col0 + bj * HALF + 4 * n); }
#pragma unroll
        for (int aim = 0; aim < 4; ++aim) { const int ai = aim >> 1, mh = (aim & 1) * 2;
            f32x4 xv[2][2][2];
#pragma unroll
            for (int mm = 0; mm < 2; ++mm) { const size_t off = (size_t)(row0 + ai * HALF + (mh + mm) * 16) * DM + col0;
#pragma unroll
                for (int bj = 0; bj < 2; ++bj) {
                    if constexpr (XBF) { const u32x4 w = *(const u32x4*)((const unsigned short*)xin + off + bj * HALF);
                        xv[mm][bj][0] = (f32x4){__uint_as_float(w.x << 16), __uint_as_float(w.x & 0xffff0000u), __uint_as_float(w.y << 16), __uint_as_float(w.y & 0xffff0000u)};
                        xv[mm][bj][1] = (f32x4){__uint_as_float(w.z << 16), __uint_as_float(w.z & 0xffff0000u), __uint_as_float(w.w << 16), __uint_as_float(w.w & 0xffff0000u)}; }
                    else {
#pragma unroll
                        for (int n = 0; n < 2; ++n) xv[mm][bj][n] = *(const f32x4*)((const float*)xin + off + bj * HALF + 4 * n); } } }
#pragma unroll
            for (int mm = 0; mm < 2; ++mm) { const int m = mh + mm; const size_t off = (size_t)(row0 + ai * HALF + m * 16) * DM + col0; float sq = 0.f;
#pragma unroll
                for (int bj = 0; bj < 2; ++bj) { f32x4 xn[2];
#pragma unroll
                    for (int n = 0; n < 2; ++n) {
                        xn[n] = xv[mm][bj][n] + gv[bj][n] * acc[ai][bj][m][n];
                        if constexpr (!OBF) *(f32x4*)((float*)out + off + bj * HALF + 4 * n) = xn[n]; }
                    if constexpr (OBF) { u32x4 w; w.x = cvt_pk_bf16(xn[0][0], xn[0][1]); w.y = cvt_pk_bf16(xn[0][2], xn[0][3]); w.z = cvt_pk_bf16(xn[1][0], xn[1][1]); w.w = cvt_pk_bf16(xn[1][2], xn[1][3]);
                        *(u32x4*)((unsigned short*)out + off + bj * HALF) = w; }
                    if (xg) { const f32x4 a = xn[0] * gn[bj][0], c = xn[1] * gn[bj][1];
                        sq += (xn[0][0] * xn[0][0] + xn[0][1] * xn[0][1]) + (xn[0][2] * xn[0][2] + xn[0][3] * xn[0][3]) + (xn[1][0] * xn[1][0] + xn[1][1] * xn[1][1]) + (xn[1][2] * xn[1][2] + xn[1][3] * xn[1][3]);
                        u32x4 w; w.x = cvt_pk_bf16(a[0], a[1]); w.y = cvt_pk_bf16(a[2], a[3]); w.z = cvt_pk_bf16(c[0], c[1]); w.w = cvt_pk_bf16(c[2], c[3]);
                        *(u32x4*)(xg + off + bj * HALF) = w; } }
                if (xg) { sq += __shfl_xor(sq, 16); sq += __shfl_xor(sq, 32);
                    if (fq == 0) __hip_atomic_fetch_add(ssq + row0 + ai * HALF + m * 16, (unsigned long long)(sq * 16777216.0f + 0.5f), __ATOMIC_RELAXED, __HIP_MEMORY_SCOPE_AGENT); } }
        }
    }
};
}
namespace pg8 {
__device__ __forceinline__ float dpp_prev(float x) { return __int_as_float(__builtin_amdgcn_update_dpp(0, __float_as_int(x), 0x121, 0xF, 0xF, true)); }
__device__ __forceinline__ float dpp_next(float x) { return __int_as_float(__builtin_amdgcn_update_dpp(0, __float_as_int(x), 0x12F, 0xF, 0xF, true)); }
__device__ __forceinline__ float dpp_shr1_old(float oldv, float x) { return __int_as_float(__builtin_amdgcn_update_dpp(__float_as_int(oldv), __float_as_int(x), 0x111, 0xF, 0xF, false)); }
__device__ __forceinline__ float dpp_shl1_old(float oldv, float x) { return __int_as_float(__builtin_amdgcn_update_dpp(__float_as_int(oldv), __float_as_int(x), 0x101, 0xF, 0xF, false)); }
__device__ __forceinline__ f32x4 dpp_shr1_old4(f32x4 o, f32x4 v) { return (f32x4){dpp_shr1_old(o[0], v[0]), dpp_shr1_old(o[1], v[1]), dpp_shr1_old(o[2], v[2]), dpp_shr1_old(o[3], v[3])}; }
__device__ __forceinline__ f32x4 dpp_shl1_old4(f32x4 o, f32x4 v) { return (f32x4){dpp_shl1_old(o[0], v[0]), dpp_shl1_old(o[1], v[1]), dpp_shl1_old(o[2], v[2]), dpp_shl1_old(o[3], v[3])}; }
__device__ __forceinline__ f32x4 dpp_prev4(f32x4 v) { return (f32x4){dpp_prev(v[0]), dpp_prev(v[1]), dpp_prev(v[2]), dpp_prev(v[3])}; }
__device__ __forceinline__ f32x4 dpp_next4(f32x4 v) { return (f32x4){dpp_next(v[0]), dpp_next(v[1]), dpp_next(v[2]), dpp_next(v[3])}; }
struct EpiGate {
    static constexpr bool PERM = true, AFTER_DRAIN = false, AROWPERM = true;
    bf16_t* A; float* ZH; const float* cw; const float* cb; PG8_LAS float* halo;
    const PG8_LAS float* rstab; const float* bvec; mutable int ui;
    __device__ __forceinline__ void operator()(f32x4 (&acc)[2][2][4][2], const Unit& u, int wr, int wc, int fr, int fq) const {
        const int cl = wc * 32 + 8 * fq;
        f32x4 w[2][3], bs[2], bv[2];
#define EG_LOADC(n_) do { const float* bp_ = bvec + (size_t)row_batch(u.pm * BM) * DFF2 + u.pn * BM + cl + 4 * (n_); const int j0_ = u.pn * HALF + cl + 4 * (n_); \
        _Pragma("unroll") for (int bj = 0; bj < 2; ++bj) { bv[bj] = *(const f32x4*)(bp_ + bj * HALF); bs[bj] = *(const f32x4*)(cb + bj * DFF + j0_); } } while (0)
#define EG_LOADW(n_) do { const int j0_ = u.pn * HALF + cl + 4 * (n_); \
        _Pragma("unroll") for (int bj = 0; bj < 2; ++bj) _Pragma("unroll") for (int k = 0; k < 3; ++k) w[bj][k] = *(const f32x4*)(cw + (size_t)k * DFF2 + bj * DFF + j0_); } while (0)
#pragma unroll
        for (int ai = 0; ai < 2; ++ai)
#pragma unroll
            for (int m = 0; m < 4; ++m) { const float rs = rstab[ui * BM + ai * HALF + wr * 64 + 4 * fr + m];
#pragma unroll
                for (int bj = 0; bj < 2; ++bj)
#pragma unroll
                    for (int n = 0; n < 2; ++n) acc[ai][bj][m][n] = acc[ai][bj][m][n] * rs; }
#pragma unroll
        for (int ai = 0; ai < 2; ++ai)
#pragma unroll
            for (int bj = 0; bj < 2; ++bj)
#pragma unroll
                for (int n = 0; n < 2; ++n) { const int blk = ai * 2 + wr, c = bj * HALF + cl + 4 * n;
                    const f32x4 hv = (fr == 0) ? acc[ai][bj][0][n] : acc[ai][bj][3][n];
                    *(PG8_LAS f32x4*)(halo + ((fr == 0) ? (blk * 2) * 256 : (fr == 15) ? (blk * 2 + 1) * 256 : 2048) + c) = hv; }
        asm volatile("s_waitcnt lgkmcnt(0)" ::: "memory"); __builtin_amdgcn_s_barrier(); asm volatile("" ::: "memory");
        const int trow0 = u.pm * BM, pos0 = row_pos(trow0), Lb = batch_len(row_batch(trow0));
        const bool top_ok = (pos0 == 0), bot_ok = (pos0 + BM == Lb);
        const unsigned aoff = ((((unsigned)u.pm * (DFF / 64) + 2 * u.pn + (wc >> 1)) << 14) + 32 * (wc & 1) + 8 * fq) * 2u;
#pragma unroll
        for (int n = 0; n < 2; ++n) {
            EG_LOADW(n); EG_LOADC(n);
            f32x4 cfull[2];
#pragma unroll
            for (int bj = 0; bj < 2; ++bj) cfull[bj] = bs[bj] + bv[bj] * (w[bj][0] + w[bj][1] + w[bj][2]);
            { const unsigned zo = (((unsigned)u.pm * 4) * DFF2 + u.pn * BM + cl + 4 * n) * 4u;
              if (wr == 0 && fr == 0) {
#pragma unroll
                  for (int bj = 0; bj < 2; ++bj) { *(f32x4*)((char*)ZH + (zo + (unsigned)(bj * HALF) * 4u)) = acc[0][bj][0][n] + bv[bj];
                      *(f32x4*)((char*)ZH + (zo + (unsigned)(DFF2 + bj * HALF) * 4u)) = acc[0][bj][1][n] + bv[bj]; } }
              if (wr == 1 && fr == 15) {
#pragma unroll
                  for (int bj = 0; bj < 2; ++bj) { *(f32x4*)((char*)ZH + (zo + (unsigned)(2 * DFF2 + bj * HALF) * 4u)) = acc[1][bj][2][n] + bv[bj];
                      *(f32x4*)((char*)ZH + (zo + (unsigned)(3 * DFF2 + bj * HALF) * 4u)) = acc[1][bj][3][n] + bv[bj]; } } }
#pragma unroll
            for (int ai = 0; ai < 2; ++ai) {
                const int blk = ai * 2 + wr;
                f32x4 hp[2], hn[2];
#pragma unroll
                for (int bj = 0; bj < 2; ++bj) {
                    hp[bj] = (blk > 0) ? *(const PG8_LAS f32x4*)(halo + ((blk - 1) * 2 + 1) * 256 + bj * HALF + cl + 4 * n) : (f32x4){0.f, 0.f, 0.f, 0.f};
                    hn[bj] = (blk < 3) ? *(const PG8_LAS f32x4*)(halo + ((blk + 1) * 2 + 0) * 256 + bj * HALF + cl + 4 * n) : (f32x4){0.f, 0.f, 0.f, 0.f}; }
#pragma unroll
                for (int m = 0; m < 4; ++m) {
                    const int rt = ai * HALF + wr * 64 + 4 * fr + m;
                    f32x4 cv[2];
#pragma unroll
                    for (int bj = 0; bj < 2; ++bj) {
                        const f32x4 cur = acc[ai][bj][m][n];
                        const f32x4 prev = (m > 0) ? acc[ai][bj][m > 0 ? m - 1 : 0][n] : dpp_shr1_old4(hp[bj], acc[ai][bj][3][n]);
                        const f32x4 next = (m < 3) ? acc[ai][bj][m < 3 ? m + 1 : 3][n] : dpp_shl1_old4(hn[bj], acc[ai][bj][0][n]);
                        cv[bj] = w[bj][0] * prev + w[bj][1] * cur + w[bj][2] * next + cfull[bj];
                        if (ai == 0 && m == 0) { if (wr == 0 && fr == 0 && top_ok) cv[bj] = cv[bj] - bv[bj] * w[bj][0]; }
                        if (ai == 1 && m == 3) { if (wr == 1 && fr == 15 && bot_ok) cv[bj] = cv[bj] - bv[bj] * w[bj][2]; } }
                    float o[4];
#pragma unroll
                    for (int e = 0; e < 4; ++e) { const float g = cv[0][e]; o[e] = g * __builtin_amdgcn_rcpf(1.0f + __expf(-g)) * cv[1][e]; }
                    const unsigned p0 = cvt_pk_bf16(o[0], o[1]), p1 = cvt_pk_bf16(o[2], o[3]);
                    {
                      typedef unsigned u32x2e __attribute__((ext_vector_type(2)));
                      *(u32x2e*)((char*)A + (aoff + (unsigned)(rt * 128 + 8 * n))) = (u32x2e){p0, p1}; }
                }
            }
        }
        asm volatile("s_waitcnt lgkmcnt(0)" ::: "memory"); __builtin_amdgcn_s_barrier(); asm volatile("" ::: "memory");
        ++ui;
#undef EG_LOADC
#undef EG_LOADW
    }
};
template <class Sched> __device__ __forceinline__ void fill_tabs(const Sched& S, const unsigned long long* ss, const float* bvec, int ldb, PG8_LAS float* rstab, PG8_LAS float* bvtab, int tid) {
    Unit u;
    for (int i = 0; S.next(i, u); ++i) {
        if (tid < 256) rstab[i * BM + tid] = rsqrtf((float)ss[u.pm * BM + tid] * (1.0f / 16777216.0f) * (1.0f / DM) + EPS);
        else if (bvec) bvtab[i * BM + tid - 256] = bvec[(size_t)row_batch(u.pm * BM) * ldb + u.pn * BM + tid - 256]; }
    __syncthreads();
}
}
namespace att {
using bf16x8 = __attribute__((ext_vector_type(8))) short;
using s16x4  = __attribute__((ext_vector_type(4))) short;
using f32x16 = __attribute__((ext_vector_type(16))) float;
using u32x4  = __attribute__((ext_vector_type(4))) unsigned;
constexpr int NW = 8, QBLK = 32, KVBLK = 64, DV = 128;
constexpr float THR = 8.f;
#define ATT_SBAR() __builtin_amdgcn_sched_barrier(0)
__device__ __forceinline__ int crow(int r, int hi) { return (r & 3) + 8 * (r >> 2) + 4 * hi; }
__device__ __forceinline__ unsigned cvtpk(float lo, float hi) { unsigned r; asm volatile("v_cvt_pk_bf16_f32 %0, %1, %2" : "=v"(r) : "v"(lo), "v"(hi)); return r; }
template <int DK> __device__ __forceinline__ int kswz(int row, int colB) { return row * (2 * DK + 16) + colB; }

template <int DK> __device__ __forceinline__ void partialSM(f32x16& p0, f32x16& p1, float& m_reg, float& mn, float& alpha) {
  constexpr float SCALE = (DK == 128) ? 0.08838834764831845f : 0.07216878364870323f;
  constexpr float C = SCALE * 1.4426950408889634f;
  float pmax = p0[0];
#pragma unroll
  for (int r = 1; r < 16; ++r) pmax = fmaxf(pmax, p0[r]);
#pragma unroll
  for (int r = 0; r < 16; ++r) pmax = fmaxf(pmax, p1[r]);
  { auto rr = __builtin_amdgcn_permlane32_swap(__float_as_uint(pmax), __float_as_uint(pmax), false, false);
    pmax = fmaxf(__uint_as_float(rr[0]), __uint_as_float(rr[1])); }
  if (__builtin_expect(__all(pmax - m_reg <= THR / SCALE), 1)) { mn = m_reg; alpha = 1.f; }
  else { mn = fmaxf(m_reg, pmax); alpha = __builtin_amdgcn_exp2f((m_reg - mn) * C); m_reg = mn; }
  float mnC = -mn * C;
#pragma unroll
  for (int r = 0; r < 16; ++r) p0[r] = fmaf(p0[r], C, mnC);
#pragma unroll
  for (int r = 0; r < 16; ++r) p1[r] = fmaf(p1[r], C, mnC);
#pragma unroll
  for (int r = 0; r < 16; ++r) p0[r] = __builtin_amdgcn_exp2f(p0[r]);
}
__device__ __forceinline__ void finishSM(f32x16& p0, f32x16& p1, float alpha, float& l_reg, bf16x8& pa0, bf16x8& pa1, bf16x8& pa2, bf16x8& pa3) {
#pragma unroll
  for (int r = 0; r < 16; ++r) p1[r] = __builtin_amdgcn_exp2f(p1[r]);
  float ps = 0;
#pragma unroll
  for (int r = 0; r < 16; ++r) ps += p0[r];
#pragma unroll
  for (int r = 0; r < 16; ++r) ps += p1[r];
  { auto rr = __builtin_amdgcn_permlane32_swap(__float_as_uint(ps), __float_as_uint(ps), false, false);
    ps = __uint_as_float(rr[0]) + __uint_as_float(rr[1]); }
  l_reg = l_reg * alpha + ps;
#define ATT_PK4(P, BASE, OUT) do { unsigned a0 = cvtpk(P[BASE + 0], P[BASE + 1]), a1 = cvtpk(P[BASE + 2], P[BASE + 3]);   \
    unsigned b0 = cvtpk(P[BASE + 4], P[BASE + 5]), b1 = cvtpk(P[BASE + 6], P[BASE + 7]);                              \
    auto r0 = __builtin_amdgcn_permlane32_swap(a0, b0, false, false); auto r1 = __builtin_amdgcn_permlane32_swap(a1, b1, false, false); \
    u32x4 w = {r0[0], r1[0], r0[1], r1[1]}; OUT = *reinterpret_cast<bf16x8*>(&w); } while (0)
  ATT_PK4(p0, 0, pa0); ATT_PK4(p0, 8, pa1); ATT_PK4(p1, 0, pa2); ATT_PK4(p1, 8, pa3);
#undef ATT_PK4
}
template <int DK> __device__ __forceinline__ void qkt(f32x16& p0, f32x16& p1, const char* Ks, const bf16x8* qr, const char* ldsb, int qxo, int r32, int hi) {
  p0 = f32x16{}; p1 = f32x16{};
  if constexpr (DK > 128) asm volatile("" : "+v"(qxo));
  const char* qx = ldsb + qxo;
#pragma unroll
  for (int d0 = 0; d0 < DK / 16; ++d0) { int cb = (d0 * 16 + hi * 8) * 2;
    bf16x8 b0 = *reinterpret_cast<const bf16x8*>(Ks + kswz<DK>(r32, cb));
    bf16x8 b1 = *reinterpret_cast<const bf16x8*>(Ks + kswz<DK>(32 + r32, cb));
    bf16x8 qf; if (d0 < 8) qf = qr[d0]; else qf = *reinterpret_cast<const bf16x8*>(qx + (d0 - 8) * 1024);
    p0 = __builtin_amdgcn_mfma_f32_32x32x16_bf16(b0, qf, p0, 0, 0, 0);
    p1 = __builtin_amdgcn_mfma_f32_32x32x16_bf16(b1, qf, p1, 0, 0, 0);
    if ((d0 & 3) == 3) ATT_SBAR(); }
}
__device__ __forceinline__ int v_st(int k, int c) { const int kk = (k & ~0xC) | ((k & 4) << 1) | ((k & 8) >> 1); return ((kk >> 3) * 4 + (c >> 5)) * 512 + ((kk & 7) * 32 + (c & 31)) * 2; }
__device__ __forceinline__ int v_rd_base(int lane) { return ((lane & 3) << 3) | (((lane >> 2) & 3) << 6) | (((lane >> 4) & 1) << 5) | (((lane >> 5) & 1) << 8); }
constexpr int v_rd_off(int d0, int ks, int half) { return d0 * 512 + ks * 4096 + half * 2048; }
template <int OFF> __device__ __forceinline__ s16x4 tr_read(int vb) {
  s16x4 r; asm volatile("ds_read_b64_tr_b16 %0, %1 offset:%2" : "=&v"(r) : "v"(vb), "i"(OFF) : "memory"); return r;
}
template <int D0> __device__ __forceinline__ void pv_one(f32x16& od, int vb, bf16x8 pa0, bf16x8 pa1, bf16x8 pa2, bf16x8 pa3) {
  const s16x4 l0 = tr_read<v_rd_off(D0, 0, 0)>(vb), h0 = tr_read<v_rd_off(D0, 0, 1)>(vb), l1 = tr_read<v_rd_off(D0, 1, 0)>(vb), h1 = tr_read<v_rd_off(D0, 1, 1)>(vb);
  const s16x4 l2 = tr_read<v_rd_off(D0, 2, 0)>(vb), h2 = tr_read<v_rd_off(D0, 2, 1)>(vb), l3 = tr_read<v_rd_off(D0, 3, 0)>(vb), h3 = tr_read<v_rd_off(D0, 3, 1)>(vb);
  asm volatile("s_waitcnt lgkmcnt(0)" ::: "memory"); ATT_SBAR();
#define ATT_PK(L, H) (bf16x8){L[0], L[1], L[2], L[3], H[0], H[1], H[2], H[3]}
  od = __builtin_amdgcn_mfma_f32_32x32x16_bf16(pa0, ATT_PK(l0, h0), od, 0, 0, 0);
  od = __builtin_amdgcn_mfma_f32_32x32x16_bf16(pa1, ATT_PK(l1, h1), od, 0, 0, 0);
  od = __builtin_amdgcn_mfma_f32_32x32x16_bf16(pa2, ATT_PK(l2, h2), od, 0, 0, 0);
  od = __builtin_amdgcn_mfma_f32_32x32x16_bf16(pa3, ATT_PK(l3, h3), od, 0, 0, 0);
#undef ATT_PK
}
__device__ __forceinline__ void pv_d0(f32x16* o, int vb, bf16x8 pa0, bf16x8 pa1, bf16x8 pa2, bf16x8 pa3) {
  pv_one<0>(o[0], vb, pa0, pa1, pa2, pa3); pv_one<1>(o[1], vb, pa0, pa1, pa2, pa3); pv_one<2>(o[2], vb, pa0, pa1, pa2, pa3); pv_one<3>(o[3], vb, pa0, pa1, pa2, pa3);
}
template <int DK> struct Cfg { static constexpr int SHM_V = KVBLK * DV * 2, SHM_K = KVBLK * (DK * 2 + 16), SHM_Q = (DK > 128) ? NW * 4096 : 0, SHM = 2 * SHM_V + 2 * SHM_K + NW * 64 * 4 + SHM_Q; };

template <int DK, int SDEPTH, int ldq, int ldk, int ldv, int ldo>
__device__ __forceinline__ void attn_body(const unsigned short* __restrict__ Qb, const unsigned short* __restrict__ Kh,
                                          const unsigned short* __restrict__ Vh, unsigned short* __restrict__ Ob, int seq, char* lds) {
  constexpr int SHM_V = Cfg<DK>::SHM_V, SHM_K = Cfg<DK>::SHM_K, NQ = (DK > 128 ? 8 : DK / 16), NKI = DK / 64;
  const int tid = tid_fresh(), wid = tid >> 6, lane = tid & 63, r32 = lane & 31, hi = lane >> 5;
  char* V_lds = lds; char* K_lds = lds + 2 * SHM_V;
  float* ws = (float*)(lds + 2 * SHM_V + 2 * SHM_K) + wid * 64; float* li_l = ws; float* al_l = ws + 32;
  float m_reg = -1e30f, l_reg = 0; f32x16 o[4] = {}; bf16x8 qr[NQ];
  const unsigned short* Qw = Qb + (wid * QBLK + r32) * ldq + hi * 8;
#pragma unroll
  for (int d0 = 0; d0 < NQ; ++d0) qr[d0] = *reinterpret_cast<const bf16x8*>(Qw + d0 * 16);
  const int qxo = 2 * SHM_V + 2 * SHM_K + NW * 64 * 4 + wid * 4096 + lane * 16; char* qx = lds + qxo;
  if constexpr (DK > 128) {
#pragma unroll
    for (int d0 = 8; d0 < DK / 16; ++d0) *reinterpret_cast<bf16x8*>(qx + (d0 - 8) * 1024) = *reinterpret_cast<const bf16x8*>(Qw + d0 * 16);
  }
  const int sr = tid >> 4, sc = (tid & 15) * 8, vst0 = v_st(sr, sc);
  const int vgo = sr * ldv + sc;
  const int kr = tid >> 3, kc8 = tid & 7, kgo = kr * ldk + kc8 * 8, kdst = kswz<DK>(kr, kc8 * 16);
  const int vb0 = (int)(uintptr_t)V_lds + v_rd_base(lane);
  struct { bf16x8 vs0, vs1, ks[NKI]; } sr_[SDEPTH];
#define ATT_SLOAD(i, k0) do { const unsigned short* vt_ = Vh + (size_t)(k0) * ldv; const unsigned short* kt_ = Kh + (size_t)(k0) * ldk; \
    sr_[i].vs0 = *reinterpret_cast<const bf16x8*>(vt_ + vgo); sr_[i].vs1 = *reinterpret_cast<const bf16x8*>(vt_ + vgo + 32 * ldv); \
    _Pragma("unroll") for (int q_ = 0; q_ < NKI; ++q_) sr_[i].ks[q_] = *reinterpret_cast<const bf16x8*>(kt_ + kgo + 64 * q_); } while (0)
#define ATT_SWRITE(b, i) do { *(bf16x8*)(V_lds + (b) * SHM_V + vst0) = sr_[i].vs0; *(bf16x8*)(V_lds + (b) * SHM_V + vst0 + 8192) = sr_[i].vs1; \
    _Pragma("unroll") for (int q_ = 0; q_ < NKI; ++q_) *(bf16x8*)(K_lds + (b) * SHM_K + kdst + 128 * q_) = sr_[i].ks[q_]; } while (0)
#define ATT_SWAIT() do { if constexpr (SDEPTH == 2) { if constexpr (NKI == 2) asm volatile("s_waitcnt vmcnt(4)" ::: "memory"); else asm volatile("s_waitcnt vmcnt(5)" ::: "memory"); } else asm volatile("s_waitcnt vmcnt(0)" ::: "memory"); } while (0)
#define ATT_RESC(a) do { if (__any((a) < 1.f)) { if (hi == 0) al_l[r32] = (a); asm volatile("s_waitcnt lgkmcnt(0)" ::: "memory"); \
    _Pragma("unroll") for (int d = 0; d < 4; ++d) _Pragma("unroll") for (int r = 0; r < 16; ++r) o[d][r] *= al_l[crow(r, hi)]; } } while (0)
  f32x16 pA0, pA1, pB0, pB1; float mnA, mnB, alA, alB; bf16x8 pa0, pa1, pa2, pa3; const int NT = seq / KVBLK;
  constexpr int SE = 0, SO = SDEPTH - 1;
  ATT_SLOAD(SE, 0); asm volatile("s_waitcnt vmcnt(0)" ::: "memory"); ATT_SWRITE(0, SE); __syncthreads();
  qkt<DK>(pA0, pA1, K_lds, qr, lds, qxo, r32, hi); partialSM<DK>(pA0, pA1, m_reg, mnA, alA);
  ATT_SLOAD(SO, KVBLK); if constexpr (SDEPTH == 2) { if (2 < NT) ATT_SLOAD(SE, 2 * KVBLK); }
  ATT_SWAIT(); ATT_SWRITE(1, SO); __syncthreads();
  for (int j = 1; j + 1 < NT; j += 2) {
    ATT_SBAR(); qkt<DK>(pB0, pB1, K_lds + SHM_K, qr, lds, qxo, r32, hi);
    finishSM(pA0, pA1, alA, l_reg, pa0, pa1, pa2, pa3); ATT_SBAR();
    ATT_SLOAD(SO, (j + SDEPTH) * KVBLK); ATT_SBAR();
    pv_d0(o, vb0, pa0, pa1, pa2, pa3); partialSM<DK>(pB0, pB1, m_reg, mnB, alB);
    __syncthreads(); ATT_SWAIT(); ATT_SWRITE(0, SE);
    ATT_RESC(alB); __syncthreads();
    ATT_SBAR(); qkt<DK>(pA0, pA1, K_lds, qr, lds, qxo, r32, hi);
    finishSM(pB0, pB1, alB, l_reg, pa0, pa1, pa2, pa3); ATT_SBAR();
    if (SDEPTH == 1 || j + 3 < NT) ATT_SLOAD(SE, (j + 1 + SDEPTH) * KVBLK); ATT_SBAR();
    pv_d0(o, vb0 + SHM_V, pa0, pa1, pa2, pa3); partialSM<DK>(pA0, pA1, m_reg, mnA, alA);
    __syncthreads(); ATT_SWAIT(); ATT_SWRITE(1, SO);
    ATT_RESC(alA); __syncthreads();
  }
  ATT_SBAR(); qkt<DK>(pB0, pB1, K_lds + SHM_K, qr, lds, qxo, r32, hi);
  finishSM(pA0, pA1, alA, l_reg, pa0, pa1, pa2, pa3); ATT_SBAR();
  pv_d0(o, vb0, pa0, pa1, pa2, pa3); partialSM<DK>(pB0, pB1, m_reg, mnB, alB);
  __syncthreads(); ATT_RESC(alB);
  finishSM(pB0, pB1, alB, l_reg, pa0, pa1, pa2, pa3); ATT_SBAR();
  pv_d0(o, vb0 + SHM_V, pa0, pa1, pa2, pa3);
  if (hi == 0) li_l[r32] = l_reg; asm volatile("s_waitcnt lgkmcnt(0)" ::: "memory");
  float rli[16];
#pragma unroll
  for (int r = 0; r < 16; ++r) rli[r] = __builtin_amdgcn_rcpf(li_l[crow(r, hi)]);
  unsigned short* Ow = Ob + (wid * QBLK) * ldo;
#pragma unroll
  for (int r = 0; r < 16; ++r) { int orow = crow(r, hi);
#pragma unroll
    for (int d0 = 0; d0 < 4; ++d0) Ow[orow * ldo + d0 * 32 + r32] = (unsigned short)f2bf(o[d0][r] * rli[r]); }
  __syncthreads();
#undef ATT_SLOAD
#undef ATT_SWRITE
#undef ATT_SWAIT
#undef ATT_RESC
}

template <int DK, int ldq, int ldk, int ldv, int ldo>
__device__ __forceinline__ void attn_body_seq(const unsigned short* __restrict__ Qb, const unsigned short* __restrict__ Kh,
                                              const unsigned short* __restrict__ Vh, unsigned short* __restrict__ Ob, int seq, char* lds) {
  constexpr int SHM_V = Cfg<DK>::SHM_V, SHM_K = Cfg<DK>::SHM_K, NQ = (DK > 128 ? 8 : DK / 16), NKI = DK / 64;
  const int tid = tid_fresh(), wid = tid >> 6, lane = tid & 63, r32 = lane & 31, hi = lane >> 5;
  char* V_lds = lds; char* K_lds = lds + 2 * SHM_V;
  float* ws = (float*)(lds + 2 * SHM_V + 2 * SHM_K) + wid * 64; float* li_l = ws; float* al_l = ws + 32;
  float m_reg = -1e30f, l_reg = 0; f32x16 o[4] = {}; bf16x8 qr[NQ];
  const unsigned short* Qw = Qb + (wid * QBLK + r32) * ldq + hi * 8;
#pragma unroll
  for (int d0 = 0; d0 < NQ; ++d0) qr[d0] = *reinterpret_cast<const bf16x8*>(Qw + d0 * 16);
  const int qxo = 2 * SHM_V + 2 * SHM_K + NW * 64 * 4 + wid * 4096 + lane * 16; char* qx = lds + qxo;
  if constexpr (DK > 128) {
#pragma unroll
    for (int d0 = 8; d0 < DK / 16; ++d0) *reinterpret_cast<bf16x8*>(qx + (d0 - 8) * 1024) = *reinterpret_cast<const bf16x8*>(Qw + d0 * 16);
  }
  const int sr = tid >> 4, sc = (tid & 15) * 8, vst0 = v_st(sr, sc);
  const int vgo = sr * ldv + sc;
  const int kr = tid >> 3, kc8 = tid & 7, kgo = kr * ldk + kc8 * 8, kdst = kswz<DK>(kr, kc8 * 16);
  const int vb0 = (int)(uintptr_t)V_lds + v_rd_base(lane);
  bf16x8 vs0, vs1, ks[NKI];
#define ATT_SLOAD1(k0) do { const unsigned short* vt_ = Vh + (size_t)(k0) * ldv; const unsigned short* kt_ = Kh + (size_t)(k0) * ldk; \
    vs0 = *reinterpret_cast<const bf16x8*>(vt_ + vgo); vs1 = *reinterpret_cast<const bf16x8*>(vt_ + vgo + 32 * ldv); \
    _Pragma("unroll") for (int q_ = 0; q_ < NKI; ++q_) ks[q_] = *reinterpret_cast<const bf16x8*>(kt_ + kgo + 64 * q_); } while (0)
#define ATT_SWRITE1(b) do { *(bf16x8*)(V_lds + (b) * SHM_V + vst0) = vs0; *(bf16x8*)(V_lds + (b) * SHM_V + vst0 + 8192) = vs1; \
    _Pragma("unroll") for (int q_ = 0; q_ < NKI; ++q_) *(bf16x8*)(K_lds + (b) * SHM_K + kdst + 128 * q_) = ks[q_]; } while (0)
  const int NT = seq / KVBLK;
  ATT_SLOAD1(0); ATT_SWRITE1(0); __syncthreads();
#pragma unroll 1
  for (int j = 0; j < NT; ++j) {
    const int b = j & 1;
    f32x16 p0, p1; float mn, al; bf16x8 pa0, pa1, pa2, pa3;
    if (j + 1 < NT) ATT_SLOAD1((j + 1) * KVBLK);
    ATT_SBAR();
    qkt<DK>(p0, p1, K_lds + b * SHM_K, qr, lds, qxo, r32, hi);
    partialSM<DK>(p0, p1, m_reg, mn, al);
    if (__any(al < 1.f)) { if (hi == 0) al_l[r32] = al; asm volatile("s_waitcnt lgkmcnt(0)" ::: "memory");
#pragma unroll
      for (int d = 0; d < 4; ++d)
#pragma unroll
        for (int r = 0; r < 16; ++r) o[d][r] *= al_l[crow(r, hi)]; }
    finishSM(p0, p1, al, l_reg, pa0, pa1, pa2, pa3); ATT_SBAR();
    pv_d0(o, vb0 + b * SHM_V, pa0, pa1, pa2, pa3);
    if (j + 1 < NT) ATT_SWRITE1(b ^ 1);
    __syncthreads();
  }
  if (hi == 0) li_l[r32] = l_reg; asm volatile("s_waitcnt lgkmcnt(0)" ::: "memory");
  float rli[16];
#pragma unroll
  for (int r = 0; r < 16; ++r) rli[r] = __builtin_amdgcn_rcpf(li_l[crow(r, hi)]);
  unsigned short* Ow = Ob + (wid * QBLK) * ldo;
#pragma unroll
  for (int r = 0; r < 16; ++r) { int orow = crow(r, hi);
#pragma unroll
    for (int d0 = 0; d0 < 4; ++d0) Ow[orow * ldo + d0 * 32 + r32] = (unsigned short)f2bf(o[d0][r] * rli[r]); }
  __syncthreads();
#undef ATT_SLOAD1
#undef ATT_SWRITE1
}

template <int DK> __device__ __forceinline__ void qk_half(f32x16& p, const char* Ks, int rowoff, const bf16x8* qr, const char* ldsb, int qxo, int r32, int hi) {
  p = f32x16{};
  const char* qx = ldsb + qxo;
#pragma unroll
  for (int d0 = 0; d0 < DK / 16; ++d0) { int cb = (d0 * 16 + hi * 8) * 2;
    bf16x8 b0 = *reinterpret_cast<const bf16x8*>(Ks + kswz<DK>(rowoff + r32, cb));
    bf16x8 qf; if (d0 < 8) qf = qr[d0]; else qf = *reinterpret_cast<const bf16x8*>(qx + (d0 - 8) * 1024);
    p = __builtin_amdgcn_mfma_f32_32x32x16_bf16(b0, qf, p, 0, 0, 0); }
}
template <int KH> __device__ __forceinline__ void pv_half(f32x16* o, int vb, bf16x8 pa, bf16x8 pb) {
#define ATT_PK(L, H) (bf16x8){L[0], L[1], L[2], L[3], H[0], H[1], H[2], H[3]}
#define ATT_PVD(D0) do { const s16x4 l0 = tr_read<v_rd_off(D0, 2 * KH, 0)>(vb), h0 = tr_read<v_rd_off(D0, 2 * KH, 1)>(vb), l1 = tr_read<v_rd_off(D0, 2 * KH + 1, 0)>(vb), h1 = tr_read<v_rd_off(D0, 2 * KH + 1, 1)>(vb); \
    asm volatile("s_waitcnt lgkmcnt(0)" ::: "memory"); ATT_SBAR();   \
    o[D0] = __builtin_amdgcn_mfma_f32_32x32x16_bf16(pa, ATT_PK(l0, h0), o[D0], 0, 0, 0); o[D0] = __builtin_amdgcn_mfma_f32_32x32x16_bf16(pb, ATT_PK(l1, h1), o[D0], 0, 0, 0); } while (0)
  ATT_PVD(0); ATT_PVD(1); ATT_PVD(2); ATT_PVD(3);
#undef ATT_PVD
#undef ATT_PK
}
__device__ __forceinline__ float exp_pack(f32x16& p, bf16x8& pa, bf16x8& pb) {
#pragma unroll
  for (int r = 0; r < 16; ++r) p[r] = __builtin_amdgcn_exp2f(p[r]);
  float ps = 0.f;
#pragma unroll
  for (int r = 0; r < 16; ++r) ps += p[r];
#define ATT_PK4(P, BASE, OUT) do { unsigned a0 = cvtpk(P[BASE + 0], P[BASE + 1]), a1 = cvtpk(P[BASE + 2], P[BASE + 3]);   \
    unsigned b0 = cvtpk(P[BASE + 4], P[BASE + 5]), b1 = cvtpk(P[BASE + 6], P[BASE + 7]);                              \
    auto r0 = __builtin_amdgcn_permlane32_swap(a0, b0, false, false); auto r1 = __builtin_amdgcn_permlane32_swap(a1, b1, false, false); \
    u32x4 w = {r0[0], r1[0], r0[1], r1[1]}; OUT = *reinterpret_cast<bf16x8*>(&w); } while (0)
  ATT_PK4(p, 0, pa); ATT_PK4(p, 8, pb);
#undef ATT_PK4
  return ps;
}
template <int DK, int ldq, int ldk, int ldv, int ldo>
__device__ __forceinline__ void attn_body_nomax(const unsigned short* __restrict__ Qb, const unsigned short* __restrict__ Kh,
                                                const unsigned short* __restrict__ Vh, unsigned short* __restrict__ Ob, int seq, char* lds) {
  constexpr int SHM_V = Cfg<DK>::SHM_V, SHM_K = Cfg<DK>::SHM_K, NQ = (DK > 128 ? 8 : DK / 16), NKI = DK / 64;
  const int tid = tid_fresh(), wid = tid >> 6, lane = tid & 63, r32 = lane & 31, hi = lane >> 5;
  char* V_lds = lds; char* K_lds = lds + 2 * SHM_V;
  float* ws = (float*)(lds + 2 * SHM_V + 2 * SHM_K) + wid * 64; float* li_l = ws;
  float l_reg = 0; f32x16 o[4] = {}; bf16x8 qr[NQ];
  const unsigned short* Qw = Qb + (wid * QBLK + r32) * ldq + hi * 8;
#pragma unroll
  for (int d0 = 0; d0 < NQ; ++d0) qr[d0] = *reinterpret_cast<const bf16x8*>(Qw + d0 * 16);
  int qxo = 2 * SHM_V + 2 * SHM_K + NW * 64 * 4 + wid * 4096 + lane * 16; char* qx = lds + qxo;
  if constexpr (DK > 128) {
#pragma unroll
    for (int d0 = 8; d0 < DK / 16; ++d0) *reinterpret_cast<bf16x8*>(qx + (d0 - 8) * 1024) = *reinterpret_cast<const bf16x8*>(Qw + d0 * 16);
  }
  const int sr = tid >> 4, sc = (tid & 15) * 8, vst0 = v_st(sr, sc);
  const int vgo = sr * ldv + sc;
  const int kr = tid >> 3, kc8 = tid & 7, kgo = kr * ldk + kc8 * 8, kdst = kswz<DK>(kr, kc8 * 16);
  const int vb0 = (int)(uintptr_t)V_lds + v_rd_base(lane);
  bf16x8 vs0, vs1, ks[NKI];
#define ATT_SLOAD1(k0) do { const unsigned short* vt_ = Vh + (size_t)(k0) * ldv; const unsigned short* kt_ = Kh + (size_t)(k0) * ldk; \
    vs0 = *reinterpret_cast<const bf16x8*>(vt_ + vgo); vs1 = *reinterpret_cast<const bf16x8*>(vt_ + vgo + 32 * ldv); \
    _Pragma("unroll") for (int q_ = 0; q_ < NKI; ++q_) ks[q_] = *reinterpret_cast<const bf16x8*>(kt_ + kgo + 64 * q_); } while (0)
#define ATT_SWRITE1(b) do { *(bf16x8*)(V_lds + (b) * SHM_V + vst0) = vs0; *(bf16x8*)(V_lds + (b) * SHM_V + vst0 + 8192) = vs1; \
    _Pragma("unroll") for (int q_ = 0; q_ < NKI; ++q_) *(bf16x8*)(K_lds + (b) * SHM_K + kdst + 128 * q_) = ks[q_]; } while (0)
  const int NT = seq / KVBLK;
  ATT_SLOAD1(0); ATT_SWRITE1(0); __syncthreads();
#pragma unroll 1
  for (int j = 0; j < NT; ++j) {
    const int b = j & 1;
    f32x16 p0, p1; bf16x8 pa0, pa1, pa2, pa3;
    if (j + 1 < NT) ATT_SLOAD1((j + 1) * KVBLK);
    if constexpr (DK > 128) asm volatile("" : "+v"(qxo));
    ATT_SBAR();
    qk_half<DK>(p0, K_lds + b * SHM_K, 0, qr, lds, qxo, r32, hi);
    ATT_SBAR();
    qk_half<DK>(p1, K_lds + b * SHM_K, 32, qr, lds, qxo, r32, hi);
    float ps = exp_pack(p0, pa0, pa1);
    ATT_SBAR();
    pv_half<0>(o, vb0 + b * SHM_V, pa0, pa1);
    ps += exp_pack(p1, pa2, pa3);
    ATT_SBAR();
    pv_half<1>(o, vb0 + b * SHM_V, pa2, pa3);
    l_reg += ps;
    if (j + 1 < NT) ATT_SWRITE1(b ^ 1);
    __syncthreads();
  }
  { auto rr = __builtin_amdgcn_permlane32_swap(__float_as_uint(l_reg), __float_as_uint(l_reg), false, false); l_reg = __uint_as_float(rr[0]) + __uint_as_float(rr[1]); }
  if (hi == 0) li_l[r32] = l_reg; asm volatile("s_waitcnt lgkmcnt(0)" ::: "memory");
  float rli[16];
#pragma unroll
  for (int r = 0; r < 16; ++r) rli[r] = __builtin_amdgcn_rcpf(li_l[crow(r, hi)]);
  unsigned short* Ow = Ob + (wid * QBLK) * ldo;
#pragma unroll
  for (int r = 0; r < 16; ++r) { int orow = crow(r, hi);
#pragma unroll
    for (int d0 = 0; d0 < 4; ++d0) Ow[orow * ldo + d0 * 32 + r32] = (unsigned short)f2bf(o[d0][r] * rli[r]); }
  __syncthreads();
#undef ATT_SLOAD1
#undef ATT_SWRITE1
}

typedef float f32x4a __attribute__((ext_vector_type(4)));
__device__ __forceinline__ int v16_st(int key, int d) { return (((key >> 4) * 8 + (d >> 4)) * 4 + ((key >> 2) & 3)) * 128 + ((key & 3) * 16 + (d & 15)) * 2; }
template <int OFF> __device__ __forceinline__ s16x4 tr_read16(int vb) { s16x4 r; asm volatile("ds_read_b64_tr_b16 %0, %1 offset:%2" : "=&v"(r) : "v"(vb), "i"(OFF) : "memory"); return r; }
template <int NDS, int ST>
__device__ __forceinline__ void sgb_steps() {
  if constexpr (ST < 4 * NDS) {
    __builtin_amdgcn_sched_group_barrier(0x008, 2, 0);
    if constexpr (ST >= NDS) __builtin_amdgcn_sched_group_barrier(0x400, (((ST % NDS) + 1) * 8) / NDS - ((ST % NDS) * 8) / NDS, 0);
    if constexpr (ST + 4 < 4 * NDS) __builtin_amdgcn_sched_group_barrier(0x100, 1, 0);
    sgb_steps<NDS, ST + 1>();
  }
}
template <int DK, int ldq, int ldk, int ldv, int ldo>
__device__ __forceinline__ void attn_body16(const unsigned short* __restrict__ Qb, const unsigned short* __restrict__ Kh,
                                            const unsigned short* __restrict__ Vh, unsigned short* __restrict__ Ob, int seq, char* lds) {
  constexpr int SHM_V = KVBLK * DV * 2, KP = 2 * DK + 16, SHM_K = KVBLK * KP, NDS = DK / 32, NKI = DK / 64;
  const int tid = tid_fresh(), wid = tid >> 6, lane = tid & 63, c16 = lane & 15, g = lane >> 4;
  char* V_lds = lds; char* K_lds = lds + 2 * SHM_V;
  f32x4a ot[8][2]; float lsum[2] = {0.f, 0.f}; bf16x8 qf[2][NDS];
#pragma unroll
  for (int db = 0; db < 8; ++db) { ot[db][0] = (f32x4a){0.f, 0.f, 0.f, 0.f}; ot[db][1] = (f32x4a){0.f, 0.f, 0.f, 0.f}; }
#pragma unroll
  for (int qb = 0; qb < 2; ++qb)
#pragma unroll
    for (int ds = 0; ds < NDS; ++ds) qf[qb][ds] = *reinterpret_cast<const bf16x8*>(Qb + (wid * QBLK + 16 * qb + c16) * ldq + 32 * ds + 8 * g);
  const int sr = tid >> 4, sc = (tid & 15) * 8, vst0 = v16_st(sr, sc), vst1 = v16_st(32 + sr, sc);
  const int vgo = sr * ldv + sc;
  const int kr = tid >> 3, kc8 = tid & 7, kgo = kr * ldk + kc8 * 8, kdst = kr * KP + kc8 * 16;
  const int kfo = c16 * KP + 16 * g;
  const int vb0 = (int)(uintptr_t)V_lds + g * 128 + 8 * c16;
  bf16x8 vs0, vs1, ks[NKI];
#define A16_SLOAD(k0) do { const unsigned short* vt_ = Vh + (size_t)(k0) * ldv; const unsigned short* kt_ = Kh + (size_t)(k0) * ldk; \
    vs0 = *reinterpret_cast<const bf16x8*>(vt_ + vgo); vs1 = *reinterpret_cast<const bf16x8*>(vt_ + vgo + 32 * ldv); \
    _Pragma("unroll") for (int q_ = 0; q_ < NKI; ++q_) ks[q_] = *reinterpret_cast<const bf16x8*>(kt_ + kgo + 64 * q_); } while (0)
#define A16_SWRITE(b) do { *(bf16x8*)(V_lds + (b) * SHM_V + vst0) = vs0; *(bf16x8*)(V_lds + (b) * SHM_V + vst1) = vs1; \
    _Pragma("unroll") for (int q_ = 0; q_ < NKI; ++q_) *(bf16x8*)(K_lds + (b) * SHM_K + kdst + 128 * q_) = ks[q_]; } while (0)
  const int NT = seq / KVBLK;
  A16_SLOAD(0); A16_SWRITE(0); __syncthreads();
#pragma unroll 1
  for (int j = 0; j < NT; ++j) {
    const int b = j & 1;
    if (j + 1 < NT) A16_SLOAD((j + 1) * KVBLK);
    ATT_SBAR();
    f32x4a sct[4][2];
    const char* Kt = K_lds + b * SHM_K + kfo;
#define A16_EXP(kb_, e_) do { sct[kb_][(e_) >> 2][(e_) & 3] = __builtin_amdgcn_exp2f(sct[kb_][(e_) >> 2][(e_) & 3]); } while (0)
    bf16x8 kq[4];
#pragma unroll
    for (int s0 = 0; s0 < 3; ++s0) kq[s0] = *reinterpret_cast<const bf16x8*>(Kt + (s0 / NDS) * 16 * KP + (s0 % NDS) * 64);
#pragma unroll
    for (int kb = 0; kb < 4; ++kb) {
      sct[kb][0] = (f32x4a){0.f, 0.f, 0.f, 0.f}; sct[kb][1] = (f32x4a){0.f, 0.f, 0.f, 0.f};
#pragma unroll
      for (int ds = 0; ds < NDS; ++ds) { const int st = kb * NDS + ds, sn = st + 3;
        if (sn < 4 * NDS) kq[sn & 3] = *reinterpret_cast<const bf16x8*>(Kt + (sn / NDS) * 16 * KP + (sn % NDS) * 64);
        sct[kb][0] = __builtin_amdgcn_mfma_f32_16x16x32_bf16(kq[st & 3], qf[0][ds], sct[kb][0], 0, 0, 0);
        sct[kb][1] = __builtin_amdgcn_mfma_f32_16x16x32_bf16(kq[st & 3], qf[1][ds], sct[kb][1], 0, 0, 0);
        if (kb > 0) {
#pragma unroll
          for (int e = (ds * 8) / NDS; e < ((ds + 1) * 8) / NDS; ++e) A16_EXP(kb > 0 ? kb - 1 : 0, e); }
        ATT_SBAR(); } }
    bf16x8 pf[2][2];
#define A16_PACK(ksp_) do { _Pragma("unroll") for (int qb = 0; qb < 2; ++qb) { u32x4 w; w.x = cvtpk(sct[2 * (ksp_)][qb][0], sct[2 * (ksp_)][qb][1]); w.y = cvtpk(sct[2 * (ksp_)][qb][2], sct[2 * (ksp_)][qb][3]); \
        w.z = cvtpk(sct[2 * (ksp_) + 1][qb][0], sct[2 * (ksp_) + 1][qb][1]); w.w = cvtpk(sct[2 * (ksp_) + 1][qb][2], sct[2 * (ksp_) + 1][qb][3]); pf[qb][ksp_] = __builtin_bit_cast(bf16x8, w); \
        lsum[qb] += ((sct[2 * (ksp_)][qb][0] + sct[2 * (ksp_)][qb][1]) + (sct[2 * (ksp_)][qb][2] + sct[2 * (ksp_)][qb][3])) + ((sct[2 * (ksp_) + 1][qb][0] + sct[2 * (ksp_) + 1][qb][1]) + (sct[2 * (ksp_) + 1][qb][2] + sct[2 * (ksp_) + 1][qb][3])); } } while (0)
    A16_PACK(0);
    ATT_SBAR();
    const int vb = vb0 + b * SHM_V;
#define A16_PV(KSP, DB0, X) do { s16x4 t_[4][2]; \
      t_[0][0] = tr_read16<(2 * KSP) * 4096 + (DB0 + 0) * 512>(vb); t_[0][1] = tr_read16<(2 * KSP + 1) * 4096 + (DB0 + 0) * 512>(vb); \
      t_[1][0] = tr_read16<(2 * KSP) * 4096 + (DB0 + 1) * 512>(vb); t_[1][1] = tr_read16<(2 * KSP + 1) * 4096 + (DB0 + 1) * 512>(vb); \
      t_[2][0] = tr_read16<(2 * KSP) * 4096 + (DB0 + 2) * 512>(vb); t_[2][1] = tr_read16<(2 * KSP + 1) * 4096 + (DB0 + 2) * 512>(vb); \
      t_[3][0] = tr_read16<(2 * KSP) * 4096 + (DB0 + 3) * 512>(vb); t_[3][1] = tr_read16<(2 * KSP + 1) * 4096 + (DB0 + 3) * 512>(vb); \
      asm volatile("s_waitcnt lgkmcnt(0)" ::: "memory"); ATT_SBAR(); \
      _Pragma("unroll") for (int d_ = 0; d_ < 4; ++d_) { const bf16x8 vf = (bf16x8){t_[d_][0][0], t_[d_][0][1], t_[d_][0][2], t_[d_][0][3], t_[d_][1][0], t_[d_][1][1], t_[d_][1][2], t_[d_][1][3]}; \
        ot[DB0 + d_][0] = __builtin_amdgcn_mfma_f32_16x16x32_bf16(vf, pf[0][KSP], ot[DB0 + d_][0], 0, 0, 0); \
        ot[DB0 + d_][1] = __builtin_amdgcn_mfma_f32_16x16x32_bf16(vf, pf[1][KSP], ot[DB0 + d_][1], 0, 0, 0); } X; ATT_SBAR(); } while (0)
#define A16_PIN(qb_) asm volatile("" : "+v"(sct[3][qb_][0]), "+v"(sct[3][qb_][1]), "+v"(sct[3][qb_][2]), "+v"(sct[3][qb_][3]))
    A16_PV(0, 0, { A16_PIN(0); A16_EXP(3, 0); A16_EXP(3, 1); A16_EXP(3, 2); A16_EXP(3, 3); A16_PIN(0); });
    A16_PV(0, 4, { A16_PIN(1); A16_EXP(3, 4); A16_EXP(3, 5); A16_EXP(3, 6); A16_EXP(3, 7); A16_PIN(1); });
#undef A16_PIN
    A16_PACK(1);
    ATT_SBAR();
    A16_PV(1, 0, {}); A16_PV(1, 4, {});
#undef A16_PV
#undef A16_PACK
#undef A16_EXP
    if (j + 1 < NT) A16_SWRITE(b ^ 1);
    __syncthreads();
  }
#pragma unroll
  for (int qb = 0; qb < 2; ++qb) { float l = lsum[qb]; l += __shfl_xor(l, 16); l += __shfl_xor(l, 32); const float rl = __builtin_amdgcn_rcpf(l);
    unsigned short* Or = Ob + (wid * QBLK + 16 * qb + c16) * ldo + 4 * g;
#pragma unroll
    for (int db = 0; db < 8; ++db) { typedef unsigned u32x2a __attribute__((ext_vector_type(2)));
      u32x2a w; w.x = pk2(ot[db][qb][0] * rl, ot[db][qb][1] * rl); w.y = pk2(ot[db][qb][2] * rl, ot[db][qb][3] * rl);
      *(u32x2a*)(Or + 16 * db) = w; } }
  __syncthreads();
#undef A16_SLOAD
#undef A16_SWRITE
}
#undef ATT_SBAR
}
namespace hy {
using bf16x8 = __attribute__((ext_vector_type(8))) short;
using f32x16 = __attribute__((ext_vector_type(16))) float;
using u32x4  = __attribute__((ext_vector_type(4))) unsigned;
using u32x2  = __attribute__((ext_vector_type(2))) unsigned;
template <int L> struct HC {
    static constexpr int NMB = L / 2048, NCH = (L == 4096) ? 2 : 4, UST = L + 160, GRN = 2 * L / 64 * 72;
    static constexpr int UB = 4 * UST * 2, GB = GRN * 2, CHB = UB + GB, NK4 = L / 64 + 1;
    static_assert(NCH * CHB <= RING_BYTES, "hyena LDS");
};
__device__ __forceinline__ int crow(int r, int hi) { return (r & 3) + 8 * (r >> 2) + 4 * hi; }
__device__ __forceinline__ float bf2f(unsigned short v) { return __uint_as_float((unsigned)v << 16); }

typedef float f32x4h __attribute__((ext_vector_type(4)));
template <int L>
__device__ __forceinline__ void conv_kloop16(f32x4h (&acc)[2][8], const LAS char* gA, const LAS char* uB) {
    constexpr int NK2 = L / 64 + 1;
#pragma unroll
    for (int a = 0; a < 2; ++a)
#pragma unroll
        for (int r = 0; r < 8; ++r) acc[a][r] = (f32x4h){0.f, 0.f, 0.f, 0.f};
    for (int kk2 = 0; kk2 < NK2; ++kk2) {
#pragma unroll
        for (int h = 0; h < 2; ++h) {
            const bf16x8 A = *(const LAS bf16x8*)(gA + kk2 * 144 + h * 64);
#pragma unroll
            for (int nh = 0; nh < 2; ++nh) {
                const u32x4 w0 = *(const LAS u32x4*)(uB + kk2 * 128 + h * 64 + nh * 64);
                const u32x4 w1 = *(const LAS u32x4*)(uB + kk2 * 128 + h * 64 + nh * 64 + 16);
                const unsigned w[8] = {w0.x, w0.y, w0.z, w0.w, w1.x, w1.y, w1.z, w1.w};
#pragma unroll
                for (int r = 0; r < 8; ++r) { u32x4 bf;
                    if ((r & 1) == 0) { const int q = r >> 1; bf = (u32x4){w[q], w[q + 1], w[q + 2], w[q + 3]}; }
                    else { const int q = (r - 1) >> 1;
                        bf = (u32x4){__builtin_amdgcn_alignbit(w[q + 1], w[q], 16), __builtin_amdgcn_alignbit(w[q + 2], w[q + 1], 16),
                                     __builtin_amdgcn_alignbit(w[q + 3], w[q + 2], 16), __builtin_amdgcn_alignbit(w[q + 4], w[q + 3], 16)}; }
                    acc[nh][r] = __builtin_amdgcn_mfma_f32_16x16x32_bf16(A, __builtin_bit_cast(bf16x8, bf), acc[nh][r], 0, 0, 0); }
            }
        }
    }
}

template <int L>
__device__ __forceinline__ void hyena_unit(LAS char* lds, const unsigned short* GFl, const unsigned short* X1T, const unsigned short* X2T, const unsigned short* VT,
                                           unsigned short* Y2T, const float* skip  , int b0, int c0) {
    using C = HC<L>;
    constexpr int NCH = C::NCH, UST = C::UST, GRN = C::GRN, UB = C::UB, GB = C::GB, CHB = C::CHB, WPC = 8 / NCH;
    static_assert(L / 1024 == WPC, "one wave per (channel, 1024-output block)");
    const int tid = tid_fresh(), wid = __builtin_amdgcn_readfirstlane(tid >> 6), lane = tid & 63;
    const int ch = wid / WPC, Mb = wid % WPC;
    const int c16 = lane & 15, g = lane >> 4, np = c16 >> 2, bb = c16 & 3;
    LAS char* Uch = lds + ch * CHB; LAS char* Gch = Uch + UB;
    const LAS char* gA = Gch + 2 * ((L / 64 - 16 * Mb - c16 - 1) * 72 + 8 * g);
    const LAS char* uB = Uch + 2 * (bb * UST + 8 * g + 8 * np);
    const int c = c0 + ch;
    u32x4 y1p[2][4];
#pragma unroll 1
    for (int o = 0; o < 2; ++o) {
        { constexpr int NG = NCH * (GB / 16), NGI = (NG + NTHR - 1) / NTHR; u32x4 gv[NGI];
#pragma unroll
          for (int i = 0; i < NGI; ++i) { const int id = tid + i * NTHR, cc = id / (GB / 16), off = id % (GB / 16);
              gv[i] = (id < NG) ? *(const u32x4*)((const char*)(GFl + ((size_t)(o * 512 + c0 + cc)) * GRN) + off * 16) : (u32x4){0u, 0u, 0u, 0u}; }
          if (o == 0) {
              constexpr int NU = NCH * 4 * (L / 8), NUI = NU / NTHR; static_assert(NU % NTHR == 0, "u staging"); u32x4 uv_[NUI];
#pragma unroll
              for (int i = 0; i < NUI; ++i) { const int id = tid + i * NTHR, cb = id / (L / 8), off = id % (L / 8), cc = cb >> 2, b = cb & 3;
                  uv_[i] = *(const u32x4*)(VT + xt_off(b0 + b, c0 + cc) + off * 8); }
#pragma unroll
              for (int i = 0; i < NUI; ++i) { const int id = tid + i * NTHR, cb = id / (L / 8), off = id % (L / 8), cc = cb >> 2, b = cb & 3;
                  *(LAS u32x4*)(lds + cc * CHB + (b * UST + 64) * 2 + off * 16) = uv_[i]; }
              for (int id = tid; id < NCH * 4 * 20; id += NTHR) { const int cb = id / 20, k = id % 20, cc = cb >> 2, b = cb & 3;
                  const int el = k < 8 ? k * 8 : (L + 64) + (k - 8) * 8;
                  *(LAS u32x4*)(lds + cc * CHB + (b * UST + el) * 2) = (u32x4){0u, 0u, 0u, 0u}; }
          }
#pragma unroll
          for (int i = 0; i < NGI; ++i) { const int id = tid + i * NTHR, cc = id / (GB / 16), off = id % (GB / 16);
              if (id < NG) *(LAS u32x4*)(lds + cc * CHB + UB + off * 16) = gv[i]; } }
        if (o == 1) {
#pragma unroll
            for (int nh = 0; nh < 2; ++nh)
#pragma unroll
                for (int i = 0; i < 4; ++i) { const int t0 = 1024 * Mb + 64 * (4 * g + i) + 32 * nh + 8 * np;
                    *(LAS u32x4*)(Uch + (bb * UST + 64 + t0) * 2) = y1p[nh][i]; }
        }
        __syncthreads();
        f32x4h acc[2][8];
        conv_kloop16<L>(acc, gA, uB);
        const float sk = skip[o * 512 + c];
        const unsigned short* XT = (o == 0) ? X1T : X2T;
        const size_t gbase = xt_off(b0 + bb, c);
        u32x4 xvs[2][4];
#pragma unroll
        for (int nh = 0; nh < 2; ++nh)
#pragma unroll
            for (int i = 0; i < 4; ++i) { const int t0 = 1024 * Mb + 64 * (4 * g + i) + 32 * nh + 8 * np; xvs[nh][i] = *(const u32x4*)(XT + gbase + t0); }
#pragma unroll
        for (int nh = 0; nh < 2; ++nh)
#pragma unroll
            for (int i = 0; i < 4; ++i) { const int t0 = 1024 * Mb + 64 * (4 * g + i) + 32 * nh + 8 * np;
                const u32x4 xv = xvs[nh][i];
                const u32x4 uv = *(const LAS u32x4*)(Uch + (bb * UST + 64 + t0) * 2);
                const unsigned xw[4] = {xv.x, xv.y, xv.z, xv.w}, uw[4] = {uv.x, uv.y, uv.z, uv.w}; unsigned pw[4];
#pragma unroll
                for (int q = 0; q < 4; ++q) {
                    const float ylo = bf2f((unsigned short)(xw[q] & 0xffff)) * (acc[nh][2 * q][i] + sk * bf2f((unsigned short)(uw[q] & 0xffff)));
                    const float yhi = bf2f((unsigned short)(xw[q] >> 16)) * (acc[nh][2 * q + 1][i] + sk * bf2f((unsigned short)(uw[q] >> 16)));
                    pw[q] = pk2(ylo, yhi); }
                const u32x4 p = (u32x4){pw[0], pw[1], pw[2], pw[3]};
                if (o == 0) y1p[nh][i] = p;
                else *(u32x4*)(Y2T + gbase + t0) = p; }
        __syncthreads();
    }
}
}
typedef unsigned u32x2v __attribute__((ext_vector_type(2)));
__device__ __forceinline__ float bf2f(unsigned short v) { return __uint_as_float((unsigned)v << 16); }
__device__ __forceinline__ float bflo(unsigned w) { return __uint_as_float(w << 16); }
__device__ __forceinline__ float bfhi(unsigned w) { return __uint_as_float(w & 0xffff0000u); }
__device__ __forceinline__ float wave_sum(float v) {
#pragma unroll
    for (int o = 1; o < 64; o <<= 1) v += __shfl_xor(v, o);
    return v;
}
__device__ __forceinline__ void unpack8(const v4u& w, float (&f)[8]) {
    f[0] = bflo(w.x); f[1] = bfhi(w.x); f[2] = bflo(w.y); f[3] = bfhi(w.y); f[4] = bflo(w.z); f[5] = bfhi(w.z); f[6] = bflo(w.w); f[7] = bfhi(w.w);
}
__device__ __forceinline__ v4u pack8(const float (&f)[8]) { v4u w; w.x = pk2(f[0], f[1]); w.y = pk2(f[2], f[3]); w.z = pk2(f[4], f[5]); w.w = pk2(f[6], f[7]); return w; }

__device__ __forceinline__ void norm_rows(const float* xa, const float* xb, const float* g, const float* mod  , int sh_off, int sc_off, bf16* H, int gw, int ngw, int lane) {
    for (int ck = gw; ck < NTOK / 4; ck += ngw) {
        const int row0 = ck * 4, b = row_batch(row0);
        const float* xin = row0 < NPR ? xa : xb;
        const float* sc = mod + (size_t)b * MODW + sc_off; const float* sh = mod + (size_t)b * MODW + sh_off;
        f32x4 ga[8], sb[8];
#pragma unroll
        for (int j = 0; j < 8; ++j) { const int col = 4 * lane + 256 * j; const f32x4 gg = *(const f32x4*)(g + col), s1 = *(const f32x4*)(sc + col);
            ga[j] = gg * (s1 + 1.0f); sb[j] = *(const f32x4*)(sh + col); }
#pragma unroll 1
        for (int r = 0; r < 4; ++r) {
            const float* xr = xin + (size_t)(row0 + r) * DM;
            f32x4 v[8]; float ss = 0.f;
#pragma unroll
            for (int j = 0; j < 8; ++j) { v[j] = *(const f32x4*)(xr + 4 * lane + 256 * j); ss += (v[j].x * v[j].x + v[j].y * v[j].y) + (v[j].z * v[j].z + v[j].w * v[j].w); }
            const float rs = rsqrtf(wave_sum(ss) * (1.0f / DM) + EPS);
            bf16* hr = H + (size_t)(row0 + r) * DM;
#pragma unroll
            for (int j = 0; j < 8; ++j) { const f32x4 o = v[j] * rs * ga[j] + sb[j]; u32x2v w; w.x = pk2(o.x, o.y); w.y = pk2(o.z, o.w);
                *(u32x2v*)(hr + 4 * lane + 256 * j) = w; }
        }
    }
}

struct PostIn { v4u v, qa, ckv, h1, h2; };
__device__ __forceinline__ PostIn post_load(const bf16* P, int lane) {
    PostIn in; const int head = lane >> 3, sub = lane & 7, sec = sub >> 2, chk = sub & 3, hh = head < 6 ? head : 0;
    in.v = *(const v4u*)(P + 512 + 8 * lane); in.qa = *(const v4u*)(P + C_D + 8 * lane); in.ckv = *(const v4u*)(P + C_D + 512 + 8 * (lane & 31));
    const bf16* hp = P + C_C + hh * 128 + 64 * sec + 8 * chk; in.h1 = *(const v4u*)hp; in.h2 = *(const v4u*)(hp + 32); return in;
}
__device__ __forceinline__ void post_finish(const PostIn& in, bf16* P, int pos, const float* vng, const float* qng, const float* kng, const float* qag, const float* kvag, int lane, bool st = true) {
    { float f[8]; unpack8(in.v, f);
      float s = 0.f;
#pragma unroll
      for (int i = 0; i < 8; ++i) s += f[i];
      const float mean = wave_sum(s) * (1.0f / 512.0f); float q = 0.f;
#pragma unroll
      for (int i = 0; i < 8; ++i) { f[i] -= mean; q += f[i] * f[i]; }
      const float rs = rsqrtf(wave_sum(q) * (1.0f / 512.0f) + EPS);
      const f32x4 g0 = *(const f32x4*)(vng + 8 * lane), g1 = *(const f32x4*)(vng + 8 * lane + 4);
      f[0] *= rs * g0.x; f[1] *= rs * g0.y; f[2] *= rs * g0.z; f[3] *= rs * g0.w; f[4] *= rs * g1.x; f[5] *= rs * g1.y; f[6] *= rs * g1.z; f[7] *= rs * g1.w;
      if (st) *(v4u*)(P + 512 + 8 * lane) = pack8(f); }
    { float f[8]; unpack8(in.qa, f); float q = 0.f;
#pragma unroll
      for (int i = 0; i < 8; ++i) q += f[i] * f[i];
      const float rs = rsqrtf(wave_sum(q) * (1.0f / 512.0f) + EPS);
#pragma unroll
      for (int i = 0; i < 8; ++i) f[i] *= rs * qag[8 * lane + i];
      if (st) *(v4u*)(P + C_D + 8 * lane) = pack8(f); }
    { const int l32 = lane & 31; float f[8]; unpack8(in.ckv, f); float q = 0.f;
#pragma unroll
      for (int i = 0; i < 8; ++i) q += f[i] * f[i];
      const float rs = rsqrtf(wave_sum(q) * (0.5f / 256.0f) + EPS);
#pragma unroll
      for (int i = 0; i < 8; ++i) f[i] *= rs * kvag[8 * l32 + i];
      if (st && lane < 32) *(v4u*)(P + C_D + 512 + 8 * l32) = pack8(f); }
    { const int head = lane >> 3, sub = lane & 7, sec = sub >> 2, chk = sub & 3; const bool on = head < 6;
      const int hh = on ? head : 0;
      bf16* hp = P + C_C + hh * 128 + 64 * sec + 8 * chk;
      float a[8], c[8]; unpack8(in.h1, a); unpack8(in.h2, c);
      float q = 0.f;
#pragma unroll
      for (int i = 0; i < 8; ++i) q += a[i] * a[i] + c[i] * c[i];
      q += __shfl_xor(q, 1); q += __shfl_xor(q, 2); q += __shfl_xor(q, 4);
      const float rs = rsqrtf(q * (1.0f / 128.0f) + EPS);
      const float* gg = (hh < 4 ? qng : kng) + 64 * sec + 8 * chk;
      const float p = (float)(sec ? (pos & 63) : (pos >> 6));
#pragma unroll
      for (int i = 0; i < 8; ++i) {
          const float x1 = a[i] * rs * gg[i], x2 = c[i] * rs * gg[32 + i];
          const float inv = __expf(-(float)(2 * (8 * chk + i)) * (9.210340371976184f / 64.0f));
          float sn, cs; __sincosf(p * inv, &sn, &cs);
          const float qs = (hh < 4) ? 0.12751743082459868f : 1.0f;
          a[i] = (x1 * cs - x2 * sn) * qs; c[i] = (x2 * cs + x1 * sn) * qs; }
      if (st && on) { *(v4u*)hp = pack8(a); *(v4u*)(hp + 32) = pack8(c); } }
}
__device__ __forceinline__ void post_rows(bf16* PROJp, const float* vng, const float* qng, const float* kng, const float* qag, const float* kvag, int gw, int ngw, int lane, bool st) {
    int row = gw; if (row >= NTOK) return;
    PostIn cur = post_load(PROJp + (size_t)row * INCP, lane);
    for (; row < NTOK; row += ngw) { const int nr = row + ngw; PostIn nxt = cur;
        if (nr < NTOK) nxt = post_load(PROJp + (size_t)nr * INCP, lane);
        post_finish(cur, PROJp + (size_t)row * INCP, row_pos(row), vng, qng, kng, qag, kvag, lane, st); cur = nxt; }
}

struct MlaIn { v4u n[2], a[2], c[2]; };
__device__ __forceinline__ MlaIn mla_load(const bf16* Qr, const bf16* KVr, const bf16* krope, int lane) {
    MlaIn in; const int head = lane >> 4, sub = lane & 15; const bool rp = sub < 4; const int sec = (sub >> 1) & 1, chk = sub & 1, x1o = 128 + 32 * sec + 8 * chk;
    in.n[0] = *(const v4u*)(Qr + head * 192 + 8 * sub); in.n[1] = *(const v4u*)(KVr + head * 256 + 8 * sub);
    in.a[0] = in.c[0] = in.a[1] = in.c[1] = (v4u){0u, 0u, 0u, 0u};
    if (rp) { in.a[0] = *(const v4u*)(Qr + head * 192 + x1o); in.c[0] = *(const v4u*)(Qr + head * 192 + x1o + 16);
              in.a[1] = *(const v4u*)(krope + 32 * sec + 8 * chk); in.c[1] = *(const v4u*)(krope + 32 * sec + 8 * chk + 16); }
    return in;
}
__device__ __forceinline__ void mla_finish(const MlaIn& in, bf16* Qr, bf16* Kr, int pos, const float* qng, const float* kng, int lane, bool st = true) {
    const int head = lane >> 4, sub = lane & 15;
    const bool rp = sub < 4; const int sec = (sub >> 1) & 1, chk = sub & 1;
    const int x1o = 128 + 32 * sec + 8 * chk;
    const float p = (float)(sec ? (pos & 63) : (pos >> 6));
#pragma unroll
    for (int which = 0; which < 2; ++which) {
        const float* g = which == 0 ? qng : kng;
        bf16* dst = (which == 0 ? Qr : Kr) + head * 192;
        float n[8], a[8], c[8]; unpack8(in.n[which], n); unpack8(in.a[which], a); unpack8(in.c[which], c);
        float q = 0.f;
#pragma unroll
        for (int i = 0; i < 8; ++i) q += n[i] * n[i] + a[i] * a[i] + c[i] * c[i];
        q += __shfl_xor(q, 1); q += __shfl_xor(q, 2); q += __shfl_xor(q, 4); q += __shfl_xor(q, 8);
        const float rs = rsqrtf(q * (1.0f / 192.0f) + EPS);
        const float qs = (which == 0) ? 0.10411755155693222f : 1.0f;
#pragma unroll
        for (int i = 0; i < 8; ++i) n[i] *= rs * g[8 * sub + i] * qs;
        if (st) *(v4u*)(dst + 8 * sub) = pack8(n);
        if (rp) {
#pragma unroll
            for (int i = 0; i < 8; ++i) {
                const float x1 = a[i] * rs * g[x1o + i], x2 = c[i] * rs * g[x1o + 16 + i];
                const float inv = __expf(-(float)(2 * (8 * chk + i)) * (9.210340371976184f / 32.0f));
                float sn, cs; __sincosf(p * inv, &sn, &cs);
                a[i] = (x1 * cs - x2 * sn) * qs; c[i] = (x2 * cs + x1 * sn) * qs; }
            if (st) { *(v4u*)(dst + x1o) = pack8(a); *(v4u*)(dst + x1o + 16) = pack8(c); } }
    }
}
__device__ __forceinline__ void mla_rows(bf16* QDp, const bf16* KVDp, const bf16* PROJp, bf16* KMp, const float* qng, const float* kng, int gw, int ngw, int lane, bool st) {
    int row = gw; if (row >= NTOK) return;
    MlaIn cur = mla_load(QDp + (size_t)row * 768, KVDp + (size_t)row * 1024, PROJp + (size_t)row * INCP + C_D + 768, lane);
    for (; row < NTOK; row += ngw) { const int nr = row + ngw; MlaIn nxt = cur;
        if (nr < NTOK) nxt = mla_load(QDp + (size_t)nr * 768, KVDp + (size_t)nr * 1024, PROJp + (size_t)nr * INCP + C_D + 768, lane);
        mla_finish(cur, QDp + (size_t)row * 768, KMp + (size_t)row * 768, row_pos(row), qng, kng, lane, st); cur = nxt; }
}

__device__ __forceinline__ void hyconv_tile(LAS unsigned char* lds, const bf16* PROJ, bf16* XT, const float* cw  , const float* cb  , int tile, int tid) {
    const int which = tile % 3, tb = tile / 3, row0 = tb * 64, b = row_batch(row0), pos0 = row_pos(row0), Lb = batch_len(b);
    constexpr int PITCH = 260;
    LAS unsigned* raw = (LAS unsigned*)lds;
    { v4u w[9];
#pragma unroll
      for (int i = 0; i < 9; ++i) { const int id = tid + i * NTHR, r = id >> 6, k = id & 63, p = pos0 - 1 + r;
          w[i] = (v4u){0u, 0u, 0u, 0u};
          if (id < 66 * 64 && p >= 0 && p < Lb) w[i] = *(const v4u*)(PROJ + (size_t)(row0 - 1 + r) * INCP + C_B + which * 512 + 8 * k); }
#pragma unroll
      for (int i = 0; i < 9; ++i) { const int id = tid + i * NTHR, r = id >> 6, k = id & 63;
          if (id < 66 * 64) *(LAS v4u*)(raw + r * PITCH + 4 * k) = w[i]; } }
    __syncthreads();
    { const int c = tid, col = which * 512 + c; const float w0 = cw[col], w1 = cw[1536 + col], w2 = cw[3072 + col], bb = cb[col];
      const LAS unsigned short* rc = (const LAS unsigned short*)raw + c;
      bf16* dst = XT + (size_t)which * ((size_t)NTOK * 512) + xt_off(b, c) + pos0;
      float xm = bf2f(rc[0]), x0 = bf2f(rc[2 * PITCH]);
#pragma unroll 2
      for (int k = 0; k < 8; ++k) { float z[8];
#pragma unroll
          for (int i = 0; i < 8; ++i) { const float xp = bf2f(rc[(8 * k + i + 2) * 2 * PITCH]); z[i] = w0 * xm + w1 * x0 + w2 * xp + bb; xm = x0; x0 = xp; }
          *(v4u*)(dst + 8 * k) = pack8(z); } }
    __syncthreads();
}

__device__ __forceinline__ void gnorm_tile(LAS unsigned char* lds, const bf16* __restrict__ YCAT, const bf16* __restrict__ Y2T, const float* __restrict__ gg  , bf16* __restrict__ YN, int tile, int tid) {
    const int row0 = tile * 32, b = row_batch(row0), pos0 = row_pos(row0), lane = tid & 63, wid = tid >> 6;
    constexpr int PITCH = 17;
    LAS unsigned* yb = (LAS unsigned*)lds;
    { v4u yw[4];
#pragma unroll
      for (int i = 0; i < 4; ++i) { const int id = tid + i * NTHR, c = id >> 2, k = id & 3; yw[i] = *(const v4u*)(Y2T + xt_off(b, c) + pos0 + 8 * k); }
#pragma unroll
      for (int i = 0; i < 4; ++i) { const int id = tid + i * NTHR, c = id >> 2, k = id & 3; LAS unsigned* d = yb + c * PITCH + 4 * k; d[0] = yw[i].x; d[1] = yw[i].y; d[2] = yw[i].z; d[3] = yw[i].w; } }
    __syncthreads();
#pragma unroll 2
    for (int r = 0; r < 4; ++r) { const int t = wid * 4 + r, row = row0 + t;
        const bf16* yr = YCAT + (size_t)row * DM; bf16* on = YN + (size_t)row * DM;
#pragma unroll
        for (int grp = 0; grp < 4; ++grp) {
            if (grp == 1) {
                float f[8]; float q = 0.f;
#pragma unroll
                for (int i = 0; i < 8; ++i) { f[i] = bf2f(((const LAS unsigned short*)yb)[(lane + 64 * i) * 2 * PITCH + t]); q += f[i] * f[i]; }
                const float rs = rsqrtf(wave_sum(q) * (1.0f / 512.0f) + EPS);
#pragma unroll
                for (int i = 0; i < 8; ++i) on[512 + lane + 64 * i] = (bf16)f2bf(f[i] * rs * gg[512 + lane + 64 * i]);
            } else {
                v4u w = *(const v4u*)(yr + grp * 512 + 8 * lane); float f[8]; unpack8(w, f); float q = 0.f;
#pragma unroll
                for (int i = 0; i < 8; ++i) q += f[i] * f[i];
                const float rs = rsqrtf(wave_sum(q) * (1.0f / 512.0f) + EPS);
                const f32x4 g0 = *(const f32x4*)(gg + grp * 512 + 8 * lane), g1 = *(const f32x4*)(gg + grp * 512 + 8 * lane + 4);
                f[0] *= rs * g0.x; f[1] *= rs * g0.y; f[2] *= rs * g0.z; f[3] *= rs * g0.w; f[4] *= rs * g1.x; f[5] *= rs * g1.y; f[6] *= rs * g1.z; f[7] *= rs * g1.w;
                *(v4u*)(on + grp * 512 + 8 * lane) = pack8(f);
            }
        }
    }
    __syncthreads();
}

__device__ __forceinline__ void ffn_gate(const bf16* Z, bf16* A, const float* cw  , const float* cb  , int gt, int ngt) {
    constexpr int NCK = DFF / 8;
    for (int it = gt; it < (NTOK / 16) * NCK; it += ngt) {
        const int rb = it / NCK, ck = it % NCK, row0 = rb * 16, j0 = ck * 8;
        const int pos0 = row_pos(row0), Lb = batch_len(row_batch(row0));
        float wg[3][8], wu[3][8], bg[8], bu[8];
#pragma unroll
        for (int k = 0; k < 3; ++k)
#pragma unroll
            for (int i = 0; i < 8; ++i) { wg[k][i] = cw[k * DFF2 + j0 + i]; wu[k][i] = cw[k * DFF2 + DFF + j0 + i]; }
#pragma unroll
        for (int i = 0; i < 8; ++i) { bg[i] = cb[j0 + i]; bu[i] = cb[DFF + j0 + i]; }
        float gm[8], g0[8], um[8], u0[8];
        const bf16* zr = Z + (size_t)row0 * DFF2 + j0;
        if (pos0 > 0) { v4u a = *(const v4u*)(zr - DFF2), c = *(const v4u*)(zr - DFF2 + DFF); unpack8(a, gm); unpack8(c, um); }
        else {
#pragma unroll
            for (int i = 0; i < 8; ++i) { gm[i] = 0.f; um[i] = 0.f; } }
        { v4u a = *(const v4u*)zr, c = *(const v4u*)(zr + DFF); unpack8(a, g0); unpack8(c, u0); }
#pragma unroll 1
        for (int r = 0; r < 16; ++r) {
            float gp[8], up[8];
            if (pos0 + r + 1 < Lb) { v4u a = *(const v4u*)(zr + (size_t)(r + 1) * DFF2), c = *(const v4u*)(zr + (size_t)(r + 1) * DFF2 + DFF); unpack8(a, gp); unpack8(c, up); }
            else {
#pragma unroll
                for (int i = 0; i < 8; ++i) { gp[i] = 0.f; up[i] = 0.f; } }
            float o[8];
#pragma unroll
            for (int i = 0; i < 8; ++i) {
                const float gc = wg[0][i] * gm[i] + wg[1][i] * g0[i] + wg[2][i] * gp[i] + bg[i];
                const float uc = wu[0][i] * um[i] + wu[1][i] * u0[i] + wu[2][i] * up[i] + bu[i];
                o[i] = gc * __builtin_amdgcn_rcpf(1.0f + __expf(-gc)) * uc;
                gm[i] = g0[i]; g0[i] = gp[i]; um[i] = u0[i]; u0[i] = up[i]; }
            *(v4u*)(A + (size_t)(row0 + r) * DFF + j0) = pack8(o);
        }
    }
}

__device__ __forceinline__ void gate_fix(const float* ZH, bf16* A, const float* cw, const float* cb, int gt, int ngt) {
    constexpr int NQ4 = DFF / 4;
    for (int it = gt; it < 192 * NQ4; it += ngt) {
        const int rs = it / NQ4, q4 = it % NQ4, pm = rs >> 1, s = rs & 1, row = pm * 256 + (s ? 255 : 0), pos = row_pos(row), Lb = batch_len(row_batch(row));
        if (s == 0 ? (pos == 0) : (pos + 1 == Lb)) continue;
        const int j = q4 * 4, zc = 256 * (j >> 7) + (j & 127);
        const float* zp = s == 0 ? ZH + ((size_t)(pm - 1) * 4 + 3) * DFF2 : ZH + ((size_t)pm * 4 + 2) * DFF2;
        const float* z0 = s == 0 ? ZH + ((size_t)pm * 4 + 0) * DFF2 : ZH + ((size_t)pm * 4 + 3) * DFF2;
        const float* zn = s == 0 ? ZH + ((size_t)pm * 4 + 1) * DFF2 : ZH + ((size_t)(pm + 1) * 4 + 0) * DFF2;
        f32x4 cv[2];
#pragma unroll
        for (int h = 0; h < 2; ++h) {
            const f32x4 a = *(const f32x4*)(zp + zc + 128 * h), b = *(const f32x4*)(z0 + zc + 128 * h), c = *(const f32x4*)(zn + zc + 128 * h);
            const f32x4 w0 = *(const f32x4*)(cw + h * DFF + j), w1 = *(const f32x4*)(cw + DFF2 + h * DFF + j), w2 = *(const f32x4*)(cw + 2 * DFF2 + h * DFF + j), bb = *(const f32x4*)(cb + h * DFF + j);
            cv[h] = w0 * a + w1 * b + w2 * c + bb; }
        float o[4];
#pragma unroll
        for (int e = 0; e < 4; ++e) { const float g = cv[0][e]; o[e] = g * __builtin_amdgcn_rcpf(1.0f + __expf(-g)) * cv[1][e]; }
        u32x2v w; w.x = pk2(o[0], o[1]); w.y = pk2(o[2], o[3]);
        *(u32x2v*)(A + affn_off(row, j)) = w;
    }
}

__device__ __forceinline__ void hyconv_regs(const bf16* PROJ, bf16* XT, const float* cw  , const float* cb  , int gt, int ngt) {
    for (int it = gt; it < (NTOK / 8) * 192; it += ngt) {
        const int tb = it / 192, ck = it % 192, row0 = tb * 8, j0 = ck * 8, which = j0 >> 9, c0 = j0 & 511;
        const int b = row_batch(row0), pos0 = row_pos(row0), Lb = batch_len(b);
        float w0[8], w1[8], w2[8], bb[8];
#pragma unroll
        for (int i = 0; i < 8; i += 4) { const f32x4 a = *(const f32x4*)(cw + j0 + i), c = *(const f32x4*)(cw + 1536 + j0 + i), d = *(const f32x4*)(cw + 3072 + j0 + i), e = *(const f32x4*)(cb + j0 + i);
            w0[i] = a.x; w0[i + 1] = a.y; w0[i + 2] = a.z; w0[i + 3] = a.w; w1[i] = c.x; w1[i + 1] = c.y; w1[i + 2] = c.z; w1[i + 3] = c.w;
            w2[i] = d.x; w2[i + 1] = d.y; w2[i + 2] = d.z; w2[i + 3] = d.w; bb[i] = e.x; bb[i + 1] = e.y; bb[i + 2] = e.z; bb[i + 3] = e.w; }
        const bf16* src = PROJ + (size_t)row0 * INCP + C_B + j0;
        v4u raw[10];
        raw[0] = (pos0 > 0) ? *(const v4u*)(src - INCP) : (v4u){0u, 0u, 0u, 0u};
#pragma unroll
        for (int r = 0; r < 8; ++r) raw[r + 1] = *(const v4u*)(src + (size_t)r * INCP);
        raw[9] = (pos0 + 8 < Lb) ? *(const v4u*)(src + (size_t)8 * INCP) : (v4u){0u, 0u, 0u, 0u};
        float z[8][8]; float xm[8], x0[8], xp[8];
        unpack8(raw[0], xm); unpack8(raw[1], x0);
#pragma unroll
        for (int r = 0; r < 8; ++r) { unpack8(raw[r + 2], xp);
#pragma unroll
            for (int i = 0; i < 8; ++i) { z[r][i] = w0[i] * xm[i] + w1[i] * x0[i] + w2[i] * xp[i] + bb[i]; xm[i] = x0[i]; x0[i] = xp[i]; } }
        bf16* dst = XT + (size_t)which * ((size_t)NTOK * 512) + xt_off(b, c0) + pos0;
        const size_t cst = (size_t)Lb;
#pragma unroll
        for (int i = 0; i < 8; ++i) { v4u o; o.x = pk2(z[0][i], z[1][i]); o.y = pk2(z[2][i], z[3][i]); o.z = pk2(z[4][i], z[5][i]); o.w = pk2(z[6][i], z[7][i]);
            *(v4u*)(dst + (size_t)i * cst) = o; }
    }
}
__device__ __forceinline__ void p0_transpose_item(const float* W, int K, int N, bf16* WT, int row_off, LAS float* scr, int item, int lane) {
    const int nblk = N / 32, kb = item / nblk, nb = item % nblk, k0 = 64 * kb, n0 = 32 * nb;
#pragma unroll
    for (int i = 0; i < 32; ++i) { const int kk = 2 * i + (lane >> 5); scr[kk * 33 + (lane & 31)] = __builtin_nontemporal_load(&W[(size_t)(k0 + kk) * N + n0 + (lane & 31)]); }
    LDS_WAIT(); asm volatile("" ::: "memory");
    const int c = lane & 7;
#pragma unroll
    for (int j = 0; j < 4; ++j) { const int n = (lane >> 3) + 8 * j; const LAS float* s = scr + (8 * c) * 33 + n;
        v4u o; o.x = pk2(s[0 * 33], s[1 * 33]); o.y = pk2(s[2 * 33], s[3 * 33]); o.z = pk2(s[4 * 33], s[5 * 33]); o.w = pk2(s[6 * 33], s[7 * 33]);
        *(GAS v4u*)(WT + (size_t)(row_off + n0 + n) * K + k0 + 8 * c) = o; }
    LDS_WAIT(); asm volatile("" ::: "memory");
}
__device__ __forceinline__ void gmlp_unit(char* ldsg, const bf16* PROJ, bf16* YCAT, const float* sw  , const float* sb  , int unit, int tid) {
    using namespace att;
    const int chunk = unit >> 2, h = unit & 3, row0 = chunk * 128, lane = tid & 63, wid = __builtin_amdgcn_readfirstlane(tid >> 6), hi = lane >> 5, r32 = lane & 31;
    { bf16x8 vw[4];
#pragma unroll
      for (int i = 0; i < 4; ++i) { const int id = tid + i * NTHR, q = id >> 4, cc = (id & 15) * 8; vw[i] = *(const bf16x8*)(PROJ + (size_t)(row0 + q) * INCP + 512 + h * 128 + cc); }
#pragma unroll
      for (int i = 0; i < 4; ++i) { const int id = tid + i * NTHR, q = id >> 4, cc = (id & 15) * 8; *(bf16x8*)(ldsg + (q >> 6) * 16384 + v_st(q & 63, cc)) = vw[i]; } }
    const int pblk = wid >> 1, half = wid & 1;
    bf16x8 af[8];
    { const float* wp = sw + (size_t)h * 16384 + (32 * pblk + r32) * 128 + 8 * hi;
#pragma unroll
      for (int k = 0; k < 8; ++k) { const f32x4 a = *(const f32x4*)(wp + 16 * k), c = *(const f32x4*)(wp + 16 * k + 4);
          u32x4 w; w.x = cvtpk(a.x, a.y); w.y = cvtpk(a.z, a.w); w.z = cvtpk(c.x, c.y); w.w = cvtpk(c.z, c.w); af[k] = __builtin_bit_cast(bf16x8, w); } }
    __syncthreads();
    const int vb0 = (int)(uintptr_t)ldsg + v_rd_base(lane);
    f32x16 o0 = {}, o1 = {};
    if (half == 0) { pv_one<0>(o0, vb0, af[0], af[1], af[2], af[3]); pv_one<1>(o1, vb0, af[0], af[1], af[2], af[3]);
                     pv_one<0>(o0, vb0 + 16384, af[4], af[5], af[6], af[7]); pv_one<1>(o1, vb0 + 16384, af[4], af[5], af[6], af[7]); }
    else           { pv_one<2>(o0, vb0, af[0], af[1], af[2], af[3]); pv_one<3>(o1, vb0, af[0], af[1], af[2], af[3]);
                     pv_one<2>(o0, vb0 + 16384, af[4], af[5], af[6], af[7]); pv_one<3>(o1, vb0 + 16384, af[4], af[5], af[6], af[7]); }
    float* st = (float*)(ldsg + 32768) + wid * (32 * 68);
#pragma unroll
    for (int q = 0; q < 16; ++q) { const int pr = crow(q, hi); const float bs = sb[h * 128 + 32 * pblk + pr];
        st[pr * 68 + r32] = o0[q] + bs; st[pr * 68 + 32 + r32] = o1[q] + bs; }
    asm volatile("s_waitcnt lgkmcnt(0)" ::: "memory");
    v4u uws[4];
#pragma unroll
    for (int i = 0; i < 4; ++i) { const int pr = i * 8 + (lane >> 3), cc = (lane & 7) * 8; uws[i] = *(const v4u*)(PROJ + (size_t)(row0 + 32 * pblk + pr) * INCP + h * 128 + 64 * half + cc); }
#pragma unroll
    for (int i = 0; i < 4; ++i) { const int pr = i * 8 + (lane >> 3), cc = (lane & 7) * 8; const int row = row0 + 32 * pblk + pr, col = h * 128 + 64 * half + cc;
        const f32x4 m0 = *(const f32x4*)(st + pr * 68 + cc), m1 = *(const f32x4*)(st + pr * 68 + cc + 4);
        const v4u uw = uws[i]; float uf[8]; unpack8(uw, uf);
        float y[8] = {uf[0] * m0.x, uf[1] * m0.y, uf[2] * m0.z, uf[3] * m0.w, uf[4] * m1.x, uf[5] * m1.y, uf[6] * m1.z, uf[7] * m1.w};
        *(v4u*)(YCAT + (size_t)row * DM + col) = pack8(y); }
    __syncthreads();
}

__device__ __forceinline__ void mod_phase(LAS unsigned char* lds, const float* cp, const float* cs, const float* ada_w, const float* ada_b, float* MOD, int vcu, int G, int tid) {
    LAS float* sc = (LAS float*)lds;
    LAS float* red = (LAS float*)(lds + 65536);
    const int lane = tid & 63, wid = tid >> 6;
#pragma unroll 8
    for (int i = tid; i < NB * DM; i += NTHR) { const int b = i >> 11, k = i & 2047; const float c = b < 4 ? cp[b * DM + k] : cs[(b - 4) * DM + k]; sc[i] = c / (1.0f + __expf(-c)); }
    __syncthreads();
    for (int item = vcu; item < DEPTH * 96; item += G) {
        const int l = item / 96, cbk = item % 96, col0 = cbk * 128 + 2 * lane;
        const float* W = ada_w + (size_t)l * DM * MODW + col0;
        float acc[8][2];
#pragma unroll
        for (int b = 0; b < 8; ++b) { acc[b][0] = 0.f; acc[b][1] = 0.f; }
        const int kbeg = wid * 256;
#pragma unroll 2
        for (int k = kbeg; k < kbeg + 256; k += 4) {
            typedef float f32x2w __attribute__((ext_vector_type(2)));
            f32x2w w[4];
#pragma unroll
            for (int i = 0; i < 4; ++i) w[i] = __builtin_nontemporal_load((const f32x2w*)(W + (size_t)(k + i) * MODW));
#pragma unroll
            for (int b = 0; b < 8; ++b) { const f32x4 s = *(const LAS f32x4*)(sc + b * DM + k);
                acc[b][0] += s.x * w[0].x + s.y * w[1].x + s.z * w[2].x + s.w * w[3].x;
                acc[b][1] += s.x * w[0].y + s.y * w[1].y + s.z * w[2].y + s.w * w[3].y; }
        }
#pragma unroll
        for (int b = 0; b < 8; ++b) { red[(wid * 8 + b) * 128 + 2 * lane] = acc[b][0]; red[(wid * 8 + b) * 128 + 2 * lane + 1] = acc[b][1]; }
        __syncthreads();
        { const int b = tid >> 6, pr = tid & 63; float s0 = 0.f, s1 = 0.f;
#pragma unroll
          for (int w = 0; w < 8; ++w) { s0 += red[(w * 8 + b) * 128 + 2 * pr]; s1 += red[(w * 8 + b) * 128 + 2 * pr + 1]; }
          const int col = cbk * 128 + 2 * pr;
          float* o = MOD + ((size_t)l * NB + b) * MODW + col; o[0] = s0 + ada_b[l * MODW + col]; o[1] = s1 + ada_b[l * MODW + col + 1]; }
        __syncthreads();
    }
}

__device__ __forceinline__ unsigned rot16(unsigned x) { return __builtin_amdgcn_alignbit(x, x, 16); }
__device__ __forceinline__ void filt_item(LAS unsigned char* lds, int L, int tb, const float* w1, const float* b1, const float* f1, const float* w2, const float* b2, const float* f2,
                                          const float* w3, const float* decay, bf16* GFl, int tid) {
    using att::bf16x8; using att::f32x16; using att::u32x4; using att::cvtpk;
    LAS float* feats = (LAS float*)lds;
    LAS float* h1 = feats + 2176;
    LAS float* h2 = h1 + 65 * 64;
    LAS float* hf0 = h2 + 65 * 68;
    const int t0 = 64 * tb; const float invL1 = 1.0f / (float)(L - 1);
    const int GRN = 2 * L / 64 * 72;
    const int lane = tid & 63, wid = __builtin_amdgcn_readfirstlane(tid >> 6), hi = lane >> 5, r32 = lane & 31;
    for (int id = tid; id < 65 * 33; id += NTHR) { const int i = id / 33, f = id % 33; const float t = (float)(t0 + i); float v;
        if (f == 0) v = t * invL1;
        else { const int kb = (f - 1) & 15; const float band = 1e-4f + (float)kb * ((15.0f - 1e-4f) / 15.0f);
            float x = t * band / (float)L; x -= floorf(x); const float a = 6.283185307179586f * x;
            v = (f <= 16) ? __cosf(a) : -__sinf(a); }
        feats[i * 33 + f] = v; }
    __syncthreads();
    for (int id = tid; id < 65 * 64; id += NTHR) { const int i = id >> 6, j = id & 63; float s = b1[j];
#pragma unroll 11
        for (int f = 0; f < 33; ++f) s += feats[i * 33 + f] * w1[f * 64 + j];
        h1[i * 64 + j] = __sinf(f1[j] * s); }
    __syncthreads();
    for (int id = tid; id < 65 * 64; id += NTHR) { const int i = id >> 6, j = id & 63; float s = b2[j];
#pragma unroll 16
        for (int f = 0; f < 64; ++f) s += h1[i * 64 + f] * w2[f * 64 + j];
        h2[i * 68 + j] = __sinf(f2[j] * s); }
    __syncthreads();
    if (tb == 0) {
        for (int cc = tid; cc < 1024; cc += NTHR) { const int col = (cc >> 9) * 1024 + (cc & 511); float s = 0.f;
#pragma unroll 16
            for (int j = 0; j < 64; ++j) s += h2[j] * w3[j * 2048 + col];
            hf0[cc] = s; }
        __syncthreads();
    }
    bf16x8 af[2][2][4];
#pragma unroll
    for (int st = 0; st < 2; ++st)
#pragma unroll
        for (int mb = 0; mb < 2; ++mb)
#pragma unroll
            for (int ks = 0; ks < 4; ++ks) { const LAS float* p = h2 + (st + 32 * mb + r32) * 68 + 16 * ks + 8 * hi;
                const f32x4 x = *(const LAS f32x4*)p, y = *(const LAS f32x4*)(p + 4);
                u32x4 w; w.x = cvtpk(x.x, x.y); w.y = cvtpk(x.z, x.w); w.z = cvtpk(y.x, y.y); w.w = cvtpk(y.z, y.w); af[st][mb][ks] = __builtin_bit_cast(bf16x8, w); }
#pragma unroll 1
    for (int cbi = 0; cbi < 8; ++cbi) {
        const int cb = wid * 8 + cbi, o = cb >> 5, dir = (cb >> 4) & 1, c = (cb & 15) * 32 + r32, col = cb * 32 + r32;
        bf16x8 bfr[4];
#pragma unroll
        for (int ks = 0; ks < 4; ++ks) { float x[8];
#pragma unroll
            for (int j = 0; j < 8; ++j) x[j] = w3[(size_t)(16 * ks + 8 * hi + j) * 2048 + col];
            u32x4 w; w.x = cvtpk(x[0], x[1]); w.y = cvtpk(x[2], x[3]); w.z = cvtpk(x[4], x[5]); w.w = cvtpk(x[6], x[7]); bfr[ks] = __builtin_bit_cast(bf16x8, w); }
        const float dec = fabsf(decay[col]) * invL1;
        bf16* dst = GFl + (size_t)(o * 512 + c) * GRN;
#pragma unroll
        for (int mb = 0; mb < 2; ++mb) {
            f32x16 d = {};
#pragma unroll
            for (int ks = 0; ks < 4; ++ks) d = (dir == 0) ? __builtin_amdgcn_mfma_f32_32x32x16_bf16(af[1][mb][ks], bfr[ks], d, 0, 0, 0)
                                                          : __builtin_amdgcn_mfma_f32_32x32x16_bf16(af[0][mb][ks], bfr[ks], d, 0, 0, 0);
#pragma unroll
            for (int q = 0; q < 16; ++q) { const int mrow = 32 * mb + att::crow(q, hi), t = t0 + mrow + (dir == 0 ? 1 : 0);
                float v = d[q] * __expf(-(float)t * dec);
                if (dir == 0 && t == L) v = 0.f;
                if (dir == 1 && t == 0) v = hf0[o * 512 + c];
                d[q] = v; }
#pragma unroll
            for (int k = 0; k < 2; ++k) {
                const unsigned a0 = cvtpk(d[8 * k + 0], d[8 * k + 1]), a1 = cvtpk(d[8 * k + 2], d[8 * k + 3]), b0 = cvtpk(d[8 * k + 4], d[8 * k + 5]), b1 = cvtpk(d[8 * k + 6], d[8 * k + 7]);
                auto s0 = __builtin_amdgcn_permlane32_swap(a0, b0, false, false); auto s1 = __builtin_amdgcn_permlane32_swap(a1, b1, false, false);
                const unsigned x0 = s0[0], x1 = s1[0], x2 = s0[1], x3 = s1[1];
                const int m0 = 32 * mb + 16 * k + 8 * hi;
                if (dir == 1) { const int ib = L + t0 + m0, ph = (ib >> 6) * 72 + (ib & 63); *(v4u*)(dst + ph) = (v4u){x0, x1, x2, x3}; }
                else { const int ib = L - t0 - m0 - 8, ph = (ib >> 6) * 72 + (ib & 63); *(v4u*)(dst + ph) = (v4u){rot16(x3), rot16(x2), rot16(x1), rot16(x0)}; }
            }
        }
    }
    __syncthreads();
}

__device__ __forceinline__ void ga_tables(const float* n1g, const float* n2g, const float* MODp, float* GA1, float* GA2, int gt, int ngt) {
    for (int i = gt; i < 2 * DEPTH * NB * DM; i += ngt) { const int which = i / (DEPTH * NB * DM), r = i % (DEPTH * NB * DM), l = r / (NB * DM), b = (r / DM) % NB, c = r % DM;
        const float sc = MODp[((size_t)l * NB + b) * MODW + (which ? 4 * DM : DM) + c];
        (which ? GA2 : GA1)[r] = (which ? n2g : n1g)[l * DM + c] * (1.0f + sc); }
}
__device__ __forceinline__ void bvec_item(LAS unsigned char* lds, const float* shp, const bf16* Wt, float* BV, int ldbv, int n0, int tid) {
    LAS float* sb = (LAS float*)lds;
    const int lane = tid & 63, wid = tid >> 6;
#pragma unroll 8
    for (int i = tid; i < NB * DM / 4; i += NTHR) { const int b = i / (DM / 4), k4 = i % (DM / 4); *(LAS f32x4*)(sb + b * DM + 4 * k4) = *(const f32x4*)(shp + (size_t)b * MODW + 4 * k4); }
    __syncthreads();
#pragma unroll 1
    for (int rg = 0; rg < 2; ++rg) { const int nb = n0 + wid * 8 + rg * 4;
        float acc[32];
#pragma unroll
        for (int i = 0; i < 32; ++i) acc[i] = 0.f;
#pragma unroll 1
        for (int j = 0; j < 4; ++j) { float f[4][8];
#pragma unroll
            for (int r = 0; r < 4; ++r) { const v4u w = *(const v4u*)(Wt + (size_t)(nb + r) * DM + 8 * lane + 512 * j); unpack8(w, f[r]); }
#pragma unroll
            for (int b = 0; b < 8; ++b) { const f32x4 s0 = *(const LAS f32x4*)(sb + b * DM + 8 * lane + 512 * j), s1 = *(const LAS f32x4*)(sb + b * DM + 8 * lane + 512 * j + 4);
#pragma unroll
                for (int r = 0; r < 4; ++r)
                    acc[r * 8 + b] += (f[r][0] * s0.x + f[r][1] * s0.y) + (f[r][2] * s0.z + f[r][3] * s0.w) + (f[r][4] * s1.x + f[r][5] * s1.y) + (f[r][6] * s1.z + f[r][7] * s1.w); } }
#pragma unroll
        for (int st = 0; st < 5; ++st) { const int n = 16 >> st, x = 32 >> st; const bool up = (lane & x) != 0;
#pragma unroll
            for (int i = 0; i < n; ++i) { const float keep = up ? acc[i + n] : acc[i], send = up ? acc[i] : acc[i + n]; acc[i] = keep + __shfl_xor(send, x); } }
        const float tot = acc[0] + __shfl_xor(acc[0], 1);
        const int idx = (lane >> 1) & 31;
        const int idxr = ((idx & 16) ? 16 : 0) | ((idx & 8) ? 8 : 0) | ((idx & 4) ? 4 : 0) | ((idx & 2) ? 2 : 0) | (idx & 1);
        if ((lane & 1) == 0) BV[(size_t)(idxr & 7) * ldbv + nb + (idxr >> 3)] = tot;
    }
    __syncthreads();
}
__device__ __forceinline__ void norm0_rows(const float* xa, const float* xb, const float* g, const float* mod, bf16* H, unsigned long long* SS, int gw, int ngw, int lane) {
    for (int ck = gw; ck < NTOK / 4; ck += ngw) {
        const int row0 = ck * 4, b = row_batch(row0);
        const float* xin = row0 < NPR ? xa : xb;
        const float* sc = mod + (size_t)b * MODW + DM;
        f32x4 ga[8];
#pragma unroll
        for (int j = 0; j < 8; ++j) { const int col = 4 * lane + 256 * j; ga[j] = *(const f32x4*)(g + col) * (*(const f32x4*)(sc + col) + 1.0f); }
#pragma unroll 1
        for (int r = 0; r < 4; ++r) {
            const float* xr = xin + (size_t)(row0 + r) * DM;
            f32x4 v[8]; float ss = 0.f;
#pragma unroll
            for (int j = 0; j < 8; ++j) { v[j] = *(const f32x4*)(xr + 4 * lane + 256 * j); ss += (v[j].x * v[j].x + v[j].y * v[j].y) + (v[j].z * v[j].z + v[j].w * v[j].w); }
            ss = wave_sum(ss); if (lane == 0) SS[row0 + r] = (unsigned long long)(ss * 16777216.0f + 0.5f);
            bf16* hr = H + (size_t)(row0 + r) * DM;
#pragma unroll
            for (int j = 0; j < 8; ++j) { const f32x4 o = v[j] * ga[j]; u32x2v w; w.x = pk2(o.x, o.y); w.y = pk2(o.z, o.w);
                *(u32x2v*)(hr + 4 * lane + 256 * j) = w; }
        }
    }
}
#ifndef MK_PHMASK
#define MK_PHMASK 0xFFFFFFFFu
#endif
#define EN(p) (((MK_PHMASK) >> (p)) & 1u)
#ifndef MK_REPEAT
#define MK_REPEAT 0u
#endif
#define REP(p) for (int rep_ = 0; rep_ < 1 + (int)(((MK_REPEAT) >> (p)) & 1u); ++rep_)
constexpr int NPH_LAYER = 10, NPHASE = 2 + DEPTH * NPH_LAYER;
struct Args { const float* in[37]; float* out; unsigned char* ws; int ph_lo, ph_hi; };
static_assert(sizeof(Args) == 39 * 8 + 8, "Args has no padding");

typedef const __attribute__((address_space(4))) Args* KArgs;
__device__ __forceinline__ KArgs kargs() { KArgs p = (KArgs)__builtin_amdgcn_kernarg_segment_ptr(); asm volatile("" : "+s"(p)); return p; }
#define AIN(i) (kargs()->in[i])
__global__ void __launch_bounds__(NTHR, 2) mk_fwd(Args args_unused) {
    extern __shared__ __attribute__((aligned(16))) unsigned char lds_raw[];
    LAS unsigned char* lds = (LAS unsigned char*)lds_raw;
    volatile LAS unsigned* MISC = (volatile LAS unsigned*)(lds + MISC_OFF);
    const int tid0 = threadIdx.x;
#define tid tid_fresh()
#define lane (tid_fresh() & 63)
#define wave (__builtin_amdgcn_readfirstlane(tid_fresh() >> 6))
    const int G0 = gridDim.x; const int bx0 = blockIdx.x; const int vcu0 = (G0 % 8 == 0) ? (bx0 % 8) * (G0 / 8) + bx0 / 8 : bx0;
#define G (sfresh(G0))
#define bx (sfresh(bx0))
#define vcu (sfresh(vcu0))
#define gw (vcu * NWAVES + wave)
#define ngw (G * NWAVES)
    gu32* ctl = (gu32*)(kargs()->ws + WS_CTL);
    for (int u = tid0; u < (LDS_BYTES - LDSCTL_OFF) / 4; u += NTHR) ((LAS unsigned*)(lds + LDSCTL_OFF))[u] = 0u;
    __syncthreads();
#if MK_MULTI
    XcdBarrier bar; bar.bar = (unsigned*)(ctl + CW_BAR); bar.x = 0; bar.st = nullptr;
#define SEAM(k) do { } while (0)
#else
    XcdBarrier bar = xcd_barrier_post((unsigned*)(ctl + CW_BAR), MISC + 8);
#define SEAM(k) do { if (IN(k) && IN((k) + 1)) { xcd_barrier(bar); if ((MK_REPEAT >> 19) & 1u) xcd_barrier(bar); } } while (0)
#endif
    const int lo = kargs()->ph_lo, hi = kargs()->ph_hi;
#define IN(k) (lo <= (k) && (k) < hi)
#define ws (kargs()->ws)
#define MOD ((float*)(ws + WS_MOD))
#define HB ((bf16*)(ws + WS_HB))
#define AFFN ((bf16*)(ws + WS_AFFN))
#define Z ((bf16*)(ws + WS_Z))
#define PROJ ((bf16*)(ws + WS_PROJ))
#define XT ((bf16*)(ws + WS_XT))
#define Y2T ((bf16*)(ws + WS_Y2T))
#define QD ((bf16*)(ws + WS_QD))
#define KVD ((bf16*)(ws + WS_KVD))
#define KMLA ((bf16*)(ws + WS_KMLA))
#define YCAT ((bf16*)(ws + WS_YCAT))
#define OUT (kargs()->out)

    if (EN(0) && IN(0)) REP(0) {
        REP(21) mod_phase(lds, AIN(2), AIN(3), AIN(4), AIN(5), MOD, vcu, G, tid);
        REP(22) for (int item = (vcu + G / 2) % G; item < DEPTH * 96; item += G) {     const int l = item / 96, r = item % 96; const int L = r < 32 ? LP : LS, tb = r < 32 ? r : r - 32;
            bf16* GFl = (bf16*)(ws + WS_GF + (size_t)l * SZ_GF + (r < 32 ? 0 : SZ_GF_P));
            filt_item(lds, L, tb, AIN(13) + (size_t)l * 33 * 64, AIN(14) + l * 64, AIN(15) + l * 64, AIN(16) + (size_t)l * 4096, AIN(17) + l * 64, AIN(18) + l * 64,
                      AIN(19) + (size_t)l * 64 * 2048, AIN(20) + (size_t)l * 2048, GFl, tid); }
        { LAS float* scr = (LAS float*)(lds + wave * 16384);
          constexpr int I_IN = 32 * 138, I_QB = 8 * 24, I_KVB = 4 * 32, I_OUT = 32 * 64, I_UP = 32 * 352, I_DN = 88 * 64, I_L = I_IN + I_QB + I_KVB + I_OUT + I_UP + I_DN;
          REP(23) for (int it = gw; it < DEPTH * I_L; it += ngw) { const int l = it / I_L; int r = it % I_L;
              if (r < I_IN) { p0_transpose_item(AIN(7) + (size_t)l * DM * INC, DM, INC, (bf16*)(ws + WS_WIN + l * SZ_WIN), 0, scr, r, lane); continue; } r -= I_IN;
              if (r < I_QB) { p0_transpose_item(AIN(25) + (size_t)l * 512 * 768, 512, 768, (bf16*)(ws + WS_WQB + l * SZ_WQB), 0, scr, r, lane); continue; } r -= I_QB;
              if (r < I_KVB) { p0_transpose_item(AIN(27) + (size_t)l * 256 * 1024, 256, 1024, (bf16*)(ws + WS_WKVB + l * SZ_WKVB), 0, scr, r, lane); continue; } r -= I_KVB;
              if (r < I_OUT) { p0_transpose_item(AIN(31) + (size_t)l * DM * DM, DM, DM, (bf16*)(ws + WS_WOUT + l * SZ_WOUT), 0, scr, r, lane); continue; } r -= I_OUT;
              if (r < I_UP) { const int n0 = 32 * (r % 352), hf = n0 >= DFF ? 1 : 0, j = n0 - DFF * hf, dest = 256 * (j >> 7) + 128 * hf + (j & 127);
                  p0_transpose_item(AIN(33) + (size_t)l * DM * DFF2, DM, DFF2, (bf16*)(ws + WS_WUP + l * SZ_WUP), dest - n0, scr, r, lane); continue; } r -= I_UP;
              p0_transpose_item(AIN(36) + (size_t)l * DFF * DM, DFF, DM, (bf16*)(ws + WS_WDN + l * SZ_WDN), 0, scr, r, lane); } }
        for (int i = vcu * NTHR + tid; i < DEPTH * (INCP - INC) * (DM / 8); i += G * NTHR) { const int l = i / ((INCP - INC) * (DM / 8)), r = i % ((INCP - INC) * (DM / 8));
            *(v4u*)(ws + WS_WIN + l * SZ_WIN + ((size_t)INC * DM + (size_t)r * 8) * 2) = (v4u){0u, 0u, 0u, 0u}; }
        VM_WAIT(); __syncthreads();
    }
    SEAM(0);

    if (EN(1) && IN(1)) REP(1) {
        ga_tables(AIN(6), AIN(32), MOD, (float*)(ws + WS_GA1), (float*)(ws + WS_GA2), vcu * NTHR + tid, G * NTHR);
        for (int it = vcu; it < DEPTH * 248; it += G) { const int l = it / 248, r = it % 248;
            if (r < 72) bvec_item(lds, MOD + (size_t)l * NB * MODW, (const bf16*)(ws + WS_WIN + l * SZ_WIN), (float*)(ws + WS_BV1) + (size_t)l * NB * INCP, INCP, r * 64, tid);
            else bvec_item(lds, MOD + (size_t)l * NB * MODW + 3 * DM, (const bf16*)(ws + WS_WUP + l * SZ_WUP), (float*)(ws + WS_BV2) + (size_t)l * NB * DFF2, DFF2, (r - 72) * 64, tid); }
        norm0_rows(AIN(0), AIN(1) - (size_t)NPR * DM, AIN(6), MOD, HB, (unsigned long long*)(ws + WS_SSQ1), gw, ngw, lane);
    }
    SEAM(1);

#pragma unroll 1
    for (int l = 0; l < DEPTH; ++l) {
        const int pb = 2 + l * NPH_LAYER;
#define xa ((l == 0) ? AIN(0) : OUT)
#define xb ((l == 0) ? (AIN(1) - (size_t)NPR * DM) : OUT)
#define modl (MOD + (size_t)l * NB * MODW)
        if (EN(2) && IN(pb + 0)) REP(2) {
            pg8::Gemm g{HB, (const bf16*)(ws + WS_WIN + l * SZ_WIN), NTOK, INCP, DM, DM, DM}; pg8::StaticOrder S; S.init(NTOK, INCP, G, bx);
            LAS float* rst = (LAS float*)(lds + TAB_OFF); LAS float* bvt = rst + 8 * 256;
            pg8::fill_tabs(S, (const unsigned long long*)(ws + WS_SSQ1), (const float*)(ws + WS_BV1) + (size_t)l * NB * INCP, INCP, rst, bvt, tid);
            pg8::EpiBf E{PROJ, INCP, 4, rst, bvt, 0};
            pg8::gemm_phase<pg8::EpiBf, pg8::StaticOrder, true, true>(lds, g, S, E);
        }
        SEAM(pb + 0);
        if (EN(3) && IN(pb + 1)) {
            for (int i = vcu * NTHR + tid; i < NTOK; i += G * NTHR) ((unsigned long long*)(ws + WS_SSQ1))[i] = 0ull;
            REP(20) post_rows(PROJ, AIN(8) + l * 512, AIN(22) + l * 128, AIN(23) + l * 128, AIN(24) + l * 512, AIN(26) + l * 256, gw, ngw, lane, rep_ == (int)((MK_REPEAT >> 20) & 1u));
            REP(3) for (int t = vcu; t < (NTOK / 64) * 3; t += G) hyconv_tile(lds, PROJ, XT, AIN(11) + (size_t)l * 3 * 1536, AIN(12) + l * 1536, t, tid);
        }
        SEAM(pb + 1);
        if (EN(4) && IN(pb + 2)) REP(4) {
            { pg8::Gemm g{PROJ + C_D, (const bf16*)(ws + WS_WQB + l * SZ_WQB), NTOK, 768, 512, INCP, 512}; pg8::StaticOrder S; S.init(NTOK, 768, G, bx);
              pg8::EpiBf E{QD, 768, 0, nullptr, nullptr, 0};
              pg8::gemm_phase<pg8::EpiBf, pg8::StaticOrder, true, true>(lds, g, S, E); }
            { pg8::Gemm g{PROJ + C_D + 512, (const bf16*)(ws + WS_WKVB + l * SZ_WKVB), NTOK, 1024, 256, INCP, 256}; pg8::StaticOrder S; S.init(NTOK, 1024, G, (bx + G / 2) % G);
              pg8::EpiBf E{KVD, 1024, 0, nullptr, nullptr, 0};
              pg8::gemm_phase<pg8::EpiBf, pg8::StaticOrder, true, true>(lds, g, S, E); }
        }
        SEAM(pb + 2);
        if (EN(5) && IN(pb + 3)) {
            REP(5) mla_rows(QD, KVD, PROJ, KMLA, AIN(28) + l * 192, AIN(29) + l * 192, gw, ngw, lane, rep_ == (int)((MK_REPEAT >> 5) & 1u));
        }
        SEAM(pb + 3);
        if (EN(6) && IN(pb + 4)) {
            if (EN(13)) REP(13) for (int u = vcu; u < 256; u += G) { const int bh = u >> 4, qb = u & 15, b = 4 + (bh >> 2), h = bh & 3; const size_t r0 = batch_row0(b);
                att::attn_body16<192, 768, 768, 1024, DM>(QD + (r0 + qb * 256) * 768 + h * 192, KMLA + r0 * 768 + h * 192, KVD + r0 * 1024 + h * 256 + 128,
                                      YCAT + (r0 + qb * 256) * DM + 1536 + h * 128, LS, (char*)lds_raw); }
            if (EN(14)) REP(14) for (int u = vcu; u < 256; u += G) { const int bh = u >> 4, qb = u & 15, b = 4 + (bh >> 2), h = bh & 3; const size_t r0 = batch_row0(b);
                att::attn_body16<128, INCP, INCP, INCP, DM>(PROJ + (r0 + qb * 256) * INCP + C_C + h * 128, PROJ + r0 * INCP + C_C + 512 + (h >> 1) * 128, PROJ + r0 * INCP + C_C + 768 + (h >> 1) * 128,
                                      YCAT + (r0 + qb * 256) * DM + 1024 + h * 128, LS, (char*)lds_raw); }
            if (EN(15)) REP(15) for (int u = vcu; u < 256; u += G)
                hy::hyena_unit<LS>((LAS char*)lds, (const bf16*)(ws + WS_GF + (size_t)l * SZ_GF + SZ_GF_P), XT, XT + (size_t)NTOK * 512, XT + (size_t)2 * NTOK * 512, Y2T, AIN(21) + l * 1024, 4, 2 * u);
            REP(17) for (int i = vcu; i < 256; i += G) { const int u = i & 127, bh = u >> 3, qb = u & 7, b = bh >> 2, h = bh & 3; const size_t r0 = batch_row0(b);
                if (i < 128) { if (EN(13))
                    att::attn_body16<192, 768, 768, 1024, DM>(QD + (r0 + qb * 256) * 768 + h * 192, KMLA + r0 * 768 + h * 192, KVD + r0 * 1024 + h * 256 + 128,
                                          YCAT + (r0 + qb * 256) * DM + 1536 + h * 128, LP, (char*)lds_raw); }
                else if (EN(14))
                    att::attn_body16<128, INCP, INCP, INCP, DM>(PROJ + (r0 + qb * 256) * INCP + C_C + h * 128, PROJ + r0 * INCP + C_C + 512 + (h >> 1) * 128, PROJ + r0 * INCP + C_C + 768 + (h >> 1) * 128,
                                          YCAT + (r0 + qb * 256) * DM + 1024 + h * 128, LP, (char*)lds_raw); }
            if (EN(15)) REP(18) for (int i = (G == 256) ? (vcu + 128) % 256 : vcu; i < 128; i += G)
                hy::hyena_unit<LP>((LAS char*)lds, (const bf16*)(ws + WS_GF + (size_t)l * SZ_GF), XT, XT + (size_t)NTOK * 512, XT + (size_t)2 * NTOK * 512, Y2T, AIN(21) + l * 1024, 0, 4 * i);
            if (EN(16)) REP(16) {
                if (G == 256) { const int v_ = vcu;
                    if (v_ < 128) { for (int u = v_; u < 768; u += 128) gmlp_unit((char*)lds_raw, PROJ, YCAT, AIN(9) + (size_t)l * 4 * 16384, AIN(10) + l * 512, u, tid); } }
                else for (int u = vcu; u < 768; u += G) gmlp_unit((char*)lds_raw, PROJ, YCAT, AIN(9) + (size_t)l * 4 * 16384, AIN(10) + l * 512, u, tid); }
            VM_WAIT(); __syncthreads();
        }
        SEAM(pb + 4);
        if (EN(7) && IN(pb + 5)) REP(7) { for (int t = vcu; t < NTOK / 32; t += G) gnorm_tile(lds, YCAT, Y2T, AIN(30) + l * DM, HB, t, tid); }
        SEAM(pb + 5);
        if (EN(8) && IN(pb + 6)) {
            pg8::Gemm g{HB, (const bf16*)(ws + WS_WOUT + l * SZ_WOUT), NTOK, DM, DM, DM, DM}; pg8::StaticOrder S; S.init(NTOK, DM, G, bx);
            if (l == 0) { pg8::EpiResidT<false, true> E{AIN(0), AIN(1) - (size_t)NPR * DM, OUT, modl + 2 * DM, (bf16*)(ws + WS_HB2), (const float*)(ws + WS_GA2) + (size_t)l * NB * DM, (unsigned long long*)(ws + WS_SSQ2)};
                pg8::gemm_phase<pg8::EpiResidT<false, true>, pg8::StaticOrder, true, true>(lds, g, S, E); }
            else { pg8::EpiResidT<true, true> E{OUT, OUT, (l + 1 == DEPTH) ? (void*)(ws + WS_XRES) : (void*)OUT, modl + 2 * DM, (bf16*)(ws + WS_HB2), (const float*)(ws + WS_GA2) + (size_t)l * NB * DM, (unsigned long long*)(ws + WS_SSQ2)};
                pg8::gemm_phase<pg8::EpiResidT<true, true>, pg8::StaticOrder, true, true>(lds, g, S, E); }
        }
        SEAM(pb + 6);
        if (EN(10) && IN(pb + 7)) REP(10) {
            pg8::Gemm g{(const bf16*)(ws + WS_HB2), (const bf16*)(ws + WS_WUP + l * SZ_WUP), NTOK, DFF2, DM, DM, DM}; pg8::StaticOrder S; S.init(NTOK, DFF2, G, bx);
            LAS float* rst = (LAS float*)(lds + TAB_OFF);
            pg8::fill_tabs(S, (const unsigned long long*)(ws + WS_SSQ2), nullptr, 0, rst, rst, tid);
            pg8::EpiGate E{AFFN, (float*)(ws + WS_R1), AIN(34) + (size_t)l * 3 * DFF2, AIN(35) + l * DFF2, (LAS float*)(lds + HALO_OFF), rst, (const float*)(ws + WS_BV2) + (size_t)l * NB * DFF2, 0};
            pg8::gemm_phase<pg8::EpiGate, pg8::StaticOrder, true, true>(lds, g, S, E);
        }
        SEAM(pb + 7);
        if (EN(11) && IN(pb + 8)) for (int i = vcu * NTHR + tid; i < NTOK; i += G * NTHR) ((unsigned long long*)(ws + WS_SSQ2))[i] = 0ull;
        if (EN(11) && IN(pb + 8)) REP(11) gate_fix((const float*)(ws + WS_R1), AFFN, AIN(34) + (size_t)l * 3 * DFF2, AIN(35) + l * DFF2, vcu * NTHR + tid, G * NTHR);
        SEAM(pb + 8);
        if (EN(12) && IN(pb + 9)) {
            pg8::Gemm g{AFFN, (const bf16*)(ws + WS_WDN + l * SZ_WDN), NTOK, DM, DFF, DFF, DFF}; pg8::StaticOrder S; S.init(NTOK, DM, G, bx);
            if (l + 1 < DEPTH) { pg8::EpiResidT<true, true> E{OUT, OUT, OUT, modl + 5 * DM, HB, (const float*)(ws + WS_GA1) + (size_t)(l + 1) * NB * DM, (unsigned long long*)(ws + WS_SSQ1)};
                pg8::gemm_phase<pg8::EpiResidT<true, true>, pg8::StaticOrder, true, true, true, false>(lds, g, S, E); }
            else { pg8::EpiResidT<true, false> E{(const void*)(ws + WS_XRES), (const void*)(ws + WS_XRES), OUT, modl + 5 * DM, nullptr, nullptr, nullptr};
                pg8::gemm_phase<pg8::EpiResidT<true, false>, pg8::StaticOrder, true, true, true, false>(lds, g, S, E); }
        }
        if (l + 1 < DEPTH) SEAM(pb + 9);
    }
#undef xa
#undef xb
#undef modl
#undef G
#undef bx
#undef vcu
#undef ngw
#undef IN
#undef SEAM
#undef tid
#undef lane
#undef wave
#undef gw
#undef ws
#undef MOD
#undef HB
#undef AFFN
#undef Z
#undef PROJ
#undef XT
#undef Y2T
#undef QD
#undef KVD
#undef KMLA
#undef YCAT
#undef OUT
}

extern "C" void kernel_launch(void* const* d_in, const int* in_sizes, int n_in, void* d_out, int out_size, void* d_ws, size_t ws_size, hipStream_t stream) {
    static int grid = 0;
    if (grid == 0) {
        if (n_in != 37 || out_size != NTOK * DM || ws_size < WS_END) { fprintf(stderr, "kernel_launch: shape mismatch (n_in %d out %d ws %zu need %zu)\n", n_in, out_size, ws_size, (size_t)WS_END); grid = -1; return; }
        int dev = 0, cus = 0, per_cu = 0;
        if (hipGetDevice(&dev) != hipSuccess || hipDeviceGetAttribute(&cus, hipDeviceAttributeMultiprocessorCount, dev) != hipSuccess) { grid = -1; return; }
        if (hipFuncSetAttribute((const void*)mk_fwd, hipFuncAttributeMaxDynamicSharedMemorySize, LDS_BYTES) != hipSuccess) { fprintf(stderr, "kernel_launch: hipFuncSetAttribute failed\n"); grid = -1; return; }
        if (hipOccupancyMaxActiveBlocksPerMultiprocessor(&per_cu, (const void*)mk_fwd, NTHR, LDS_BYTES) != hipSuccess || per_cu < 1)
            fprintf(stderr, "kernel_launch: occupancy query reports %d workgroups per CU\n", per_cu);
        (void)hipGetLastError();
        grid = cus;
        if (grid > 256) grid = 256;
    }
    if (grid < 0) return;
    if (hipMemsetAsync((char*)d_ws + WS_CTL, 0, CTL_ZERO_BYTES, stream) != hipSuccess) { fprintf(stderr, "kernel_launch: memset failed\n"); return; }
    Args a{};
    for (int i = 0; i < 37; ++i) a.in[i] = (const float*)d_in[i];
    a.out = (float*)d_out; a.ws = (unsigned char*)d_ws;
#if MK_MULTI
    for (int p = 0; p < NPHASE; ++p) { a.ph_lo = p; a.ph_hi = p + 1; hipLaunchKernelGGL(mk_fwd, dim3(grid), dim3(NTHR), LDS_BYTES, stream, a); }
#else
    a.ph_lo = 0; a.ph_hi = NPHASE;
    hipLaunchKernelGGL(mk_fwd, dim3(grid), dim3(NTHR), LDS_BYTES, stream, a);
#endif
    const hipError_t le = hipPeekAtLastError();
    if (le != hipSuccess) fprintf(stderr, "kernel_launch: launch failed: %s\n", hipGetErrorName(le));
}
```

```cpp
#include <hip/hip_runtime.h>
#include <hip/hip_bf16.h>
#include <cstdio>
#include <cstdint>
#include <cmath>

#ifndef MK_MULTI
#define MK_MULTI 0
#endif

constexpr int DM = 2048, NTOK = 24576, NPR = 8192  , LP = 2048, LS = 4096, DEPTH = 4, NB = 8  ;
constexpr int INC = 4416, INCP = 4608;
constexpr int C_A = 0, C_B = 1024, C_C = 2560, C_D = 3584;
constexpr int DFF = 5632, DFF2 = 11264;
constexpr int MODW = 6 * DM;
constexpr float EPS = 1e-6f;
constexpr int NWAVES = 8, NTHR = 512;

constexpr size_t MiB = 1u << 20;
constexpr size_t WS_CTL = 0, CTL_ZERO_BYTES = 512 * 1024;
constexpr size_t WS_SSQ1 = 65536, WS_SSQ2 = WS_SSQ1 + (size_t)NTOK * 8;
static_assert(WS_SSQ2 + (size_t)NTOK * 8 <= CTL_ZERO_BYTES, "ssq inside the memset");
constexpr size_t WS_MOD = 1 * MiB;
constexpr size_t WS_GA1 = 2 * MiB + 512 * 1024;
constexpr size_t WS_GA2 = WS_GA1 + 256 * 1024;
constexpr size_t WS_BV1 = 3 * MiB;
constexpr size_t WS_BV2 = 4 * MiB;
constexpr size_t WS_WIN = 6 * MiB;
constexpr size_t SZ_WIN = (size_t)INCP * DM * 2;
constexpr size_t WS_WQB = WS_WIN + DEPTH * SZ_WIN;
constexpr size_t SZ_WQB = (size_t)768 * 512 * 2;
constexpr size_t WS_WKVB = WS_WQB + DEPTH * SZ_WQB;
constexpr size_t SZ_WKVB = (size_t)1024 * 256 * 2;
constexpr size_t WS_WOUT = WS_WKVB + DEPTH * SZ_WKVB;
constexpr size_t SZ_WOUT = (size_t)DM * DM * 2;
constexpr size_t WS_WUP = WS_WOUT + DEPTH * SZ_WOUT;
constexpr size_t SZ_WUP = (size_t)DFF2 * DM * 2;
constexpr size_t WS_WDN = WS_WUP + DEPTH * SZ_WUP;
constexpr size_t SZ_WDN = (size_t)DM * DFF * 2;
constexpr size_t WS_GF = WS_WDN + DEPTH * SZ_WDN;
constexpr size_t SZ_GF_P = (size_t)2 * 512 * 4608 * 2, SZ_GF_S = (size_t)2 * 512 * 9216 * 2, SZ_GF = SZ_GF_P + SZ_GF_S;
constexpr size_t WS_HB = WS_GF + DEPTH * SZ_GF;
constexpr size_t WS_HB2 = WS_HB + (size_t)NTOK * DM * 2;
constexpr size_t WS_AFFN = WS_HB2 + (size_t)NTOK * DM * 2;
constexpr size_t WS_R1 = WS_AFFN + (size_t)NTOK * DFF * 2;
constexpr size_t WS_Z = WS_R1;
constexpr size_t WS_PROJ = WS_R1;
constexpr size_t WS_XT = WS_PROJ + (size_t)NTOK * INCP * 2;
constexpr size_t SZ_XT1 = (size_t)NTOK * 512 * 2;
constexpr size_t WS_Y2T = WS_XT + 3 * SZ_XT1;
constexpr size_t WS_QD = WS_Y2T + SZ_XT1;
constexpr size_t WS_KVD = WS_QD + (size_t)NTOK * 768 * 2;
constexpr size_t WS_KMLA = WS_KVD + (size_t)NTOK * 1024 * 2;
constexpr size_t WS_YCAT = WS_KMLA + (size_t)NTOK * 768 * 2;
constexpr size_t WS_XRES = WS_R1 + 64 * MiB;
constexpr size_t WS_END = WS_R1 + (size_t)NTOK * DFF2 * 2;
static_assert(WS_YCAT + (size_t)NTOK * DM * 2 <= WS_END, "mixer buffers fit under Z");
static_assert(WS_BV2 + (size_t)DEPTH * NB * DFF2 * 4 <= WS_WIN, "ws map");
constexpr int CW_BAR = 4096;

__host__ __device__ __forceinline__ size_t xt_off(int b, int c) { return b < 4 ? ((size_t)(b * 512 + c) * LP) : ((size_t)4 * 512 * LP + (size_t)((b - 4) * 512 + c) * LS); }
__host__ __device__ __forceinline__ int row_batch(int row) { return row < NPR ? (row >> 11) : 4 + ((row - NPR) >> 12); }
__host__ __device__ __forceinline__ int row_pos(int row) { return row < NPR ? (row & (LP - 1)) : ((row - NPR) & (LS - 1)); }
__host__ __device__ __forceinline__ int batch_row0(int b) { return b < 4 ? b * LP : NPR + (b - 4) * LS; }
__host__ __device__ __forceinline__ int batch_len(int b) { return b < 4 ? LP : LS; }

__host__ __device__ __forceinline__ size_t affn_off(int row, int j) { return ((((size_t)(row >> 8) * (DFF / 64) + (j >> 6)) * 256 + (row & 255)) << 6) + (j & 63); }

constexpr int RING_BYTES = 131072;
constexpr int LDSCTL_OFF = RING_BYTES, MISC_OFF = LDSCTL_OFF + 320, HALO_OFF = RING_BYTES + 1024;
constexpr int TAB_OFF = HALO_OFF + 8192 + 1024, TAB_BYTES = 17408;
constexpr int LDS_BYTES = 161792;
#define GAS __attribute__((address_space(1)))
#define LAS __attribute__((address_space(3)))
typedef unsigned short bf16;
typedef unsigned v4u __attribute__((ext_vector_type(4)));
typedef float f32x4 __attribute__((ext_vector_type(4)));
typedef short bf16x8 __attribute__((ext_vector_type(8)));
typedef GAS unsigned gu32;
typedef GAS unsigned long long gu64;
#define RLX_AGENT __ATOMIC_RELAXED, __HIP_MEMORY_SCOPE_AGENT
#define LDS_WAIT() asm volatile("s_waitcnt lgkmcnt(0)" ::: "memory")
#define VM_WAIT() asm volatile("s_waitcnt vmcnt(0)" ::: "memory")
__device__ __forceinline__ int tid_fresh() { int t = threadIdx.x; asm volatile("" : "+v"(t)); return t; }
__device__ __forceinline__ int sfresh(int v) { asm volatile("" : "+s"(v)); return v; }
__device__ __forceinline__ unsigned long long rt() { return __builtin_amdgcn_s_memrealtime(); }
__device__ __forceinline__ unsigned f2bf(float f) { unsigned u = __builtin_bit_cast(unsigned, f); return (u + 0x7fffu + ((u >> 16) & 1u)) >> 16; }
__device__ __forceinline__ unsigned pk2(float lo, float hi) { return f2bf(lo) | (f2bf(hi) << 16); }
#define XB_TMO      128
#define XB_XCNT(j)  (256  + 64 * (j))
#define XB_XSUB(j)  (1280 + 64 * (j))
#define XB_XGEN(j)  (2304 + 64 * (j))
#define XB_TOP      3328
#define XB_TOPGEN   3392
#define XCD_BAR_WORDS 3456
#define XB_SPIN_CAP (1u << 18)

__device__ __forceinline__ unsigned xb_ld(unsigned* p)              { return __hip_atomic_load(p, __ATOMIC_RELAXED, __HIP_MEMORY_SCOPE_AGENT); }
__device__ __forceinline__ unsigned xb_add(unsigned* p, unsigned v) { return __hip_atomic_fetch_add(p, v, __ATOMIC_RELAXED, __HIP_MEMORY_SCOPE_AGENT); }
__device__ __forceinline__ unsigned xb_xcc_id() { return (unsigned)__builtin_amdgcn_s_getreg((3 << 11) | 20) & 0xFu; }
#define XB_SPIN(cond, bar) do { unsigned _sp = 0; while (cond) { __builtin_amdgcn_s_sleep(1); \
    if ((++_sp & 255u) == 0u) { if (xb_ld(&(bar)[XB_TMO])) break; if (_sp > XB_SPIN_CAP) { atomicAdd(&(bar)[XB_TMO], 1u); break; } } } } while (0)

struct XcdBarrier {
    unsigned* bar; unsigned x;
    volatile LAS unsigned* st;
};

__device__ __forceinline__ XcdBarrier xcd_barrier_post(unsigned* bar, volatile LAS unsigned* st) {
    XcdBarrier b; b.bar = bar; b.x = xb_xcc_id(); b.st = st;
    if (threadIdx.x == 0) (void)xb_add(&bar[XB_XCNT(b.x)], 1u);
    return b;
}
__device__ __forceinline__ void xcd_barrier_complete(unsigned* bar, unsigned x, unsigned& nloc, unsigned& nx) {
    const unsigned G = gridDim.x * gridDim.y * gridDim.z;
    unsigned sum, cnt, mine, sp = 0u;
    for (;;) {
        sum = 0u; cnt = 0u; mine = 0u;
#pragma unroll
        for (unsigned j = 0; j < 16; ++j) { const unsigned c = xb_ld(&bar[XB_XCNT(j)]); sum += c; cnt += (c > 0u) ? 1u : 0u; mine = (j == x) ? c : mine; }
        if (sum == G) break;
        __builtin_amdgcn_s_sleep(1);
        if ((++sp & 255u) == 0u) { if (xb_ld(&bar[XB_TMO])) break; if (sp > XB_SPIN_CAP) { atomicAdd(&bar[XB_TMO], 1u); break; } }
    }
    nloc = mine > 0u ? mine : 1u; nx = cnt > 0u ? cnt : 1u;
}

__device__ __forceinline__ void xcd_barrier(const XcdBarrier& b) {
    asm volatile("s_waitcnt vmcnt(0)" ::: "memory");
    __syncthreads();
    if (threadIdx.x == 0) {
        unsigned* bar = b.bar;
        __builtin_amdgcn_s_waitcnt(0);
        unsigned nloc = b.st[0], nx = b.st[1];
        if (nloc == 0u) { xcd_barrier_complete(bar, b.x, nloc, nx); b.st[0] = nloc; b.st[1] = nx; }
        const unsigned old = xb_add(&bar[XB_XSUB(b.x)], 1u);
        const unsigned gen = old / nloc;
        if (old + 1u == (gen + 1u) * nloc) {
            __builtin_amdgcn_fence(__ATOMIC_RELEASE, "agent");
            asm volatile("s_waitcnt vmcnt(0)" ::: "memory");
            const unsigned og = xb_add(&bar[XB_TOP], 1u);
            const unsigned tg = og / nx;
            if (og + 1u == (tg + 1u) * nx) xb_add(&bar[XB_TOPGEN], 1u);
            else XB_SPIN(xb_ld(&bar[XB_TOPGEN]) == tg, bar);
            __builtin_amdgcn_fence(__ATOMIC_ACQUIRE, "agent");
            xb_add(&bar[XB_XGEN(b.x)], 1u);
            asm volatile("s_waitcnt vmcnt(0)" ::: "memory");
        } else {
            XB_SPIN(xb_ld(&bar[XB_XGEN(b.x)]) == gen, bar);
            __builtin_amdgcn_fence(__ATOMIC_ACQUIRE, "agent");
            asm volatile("s_waitcnt vmcnt(0)" ::: "memory");
        }
    }
    __syncthreads();
}
namespace pg8 {
#define PG8_LAS __attribute__((address_space(3)))
typedef unsigned short bf16_t;
typedef short bf16x8 __attribute__((ext_vector_type(8)));
typedef float f32x4 __attribute__((ext_vector_type(4)));
typedef unsigned u32x4 __attribute__((ext_vector_type(4)));
constexpr int BM = 256, BK = 64, HALF = 128, HTB = HALF * BK * 2  , STAGE_BYTES = 8 * HTB, NXCD = 8, WGM = 4;

__host__ __device__ __forceinline__ int lds_byte(int r, int c) { const int st = (r >> 4) * 2 + (c >> 5), rr = r & 15, cc = c & 31, ob = rr * 64 + cc * 2; return st * 1024 + (ob ^ (((ob >> 9) & 1) << 5)); }
__host__ __device__ __forceinline__ void stage_rc(int b, int& R, int& C) { const int st = b / 1024, sb = b % 1024, swz = sb ^ (((sb >> 9) & 1) << 5); R = (st >> 1) * 16 + swz / 64; C = (st & 1) * 32 + (swz % 64) / 2; }
__host__ __device__ __forceinline__ int perm32(int rho) { const int n = rho >> 4, i = rho & 15; return 8 * (i >> 2) + 4 * n + (i & 3); }

struct Unit { int pm, pn; };
struct Gemm { const bf16_t* A; const bf16_t* Bt; int M, N, K, lda, ldb; };

struct StaticOrder {
    int nM, nN, nwg, G, c;
    __host__ __device__ void init(int M, int N, int G_, int c_) { nM = M / BM; nN = N / BM; nwg = nM * nN; G = G_; c = c_; }
    __host__ __device__ bool next(int i, Unit& u) const {
        const long L = (long)i * G + c; if (L >= nwg) return false;
        int wgid = (int)L; { const int q = nwg / NXCD, r = nwg % NXCD, xcd = wgid % NXCD, off = wgid / NXCD; wgid = (xcd < r ? xcd * (q + 1) : r * (q + 1) + (xcd - r) * q) + off; }
        const int nig = WGM * nN, gid = wgid / nig, fm = gid * WGM, gsz = (nM - fm) < WGM ? (nM - fm) : WGM;
        u.pm = fm + ((wgid % nig) % gsz); u.pn = (wgid % nig) / gsz; return true;
    }
    __device__ __forceinline__ void a_ready(const Unit&) const {}
    __device__ __forceinline__ void done(const Unit&) const {}
};

__device__ __forceinline__ unsigned cvt_pk_bf16(float lo, float hi) { unsigned r; asm volatile("v_cvt_pk_bf16_f32 %0, %1, %2" : "=v"(r) : "v"(lo), "v"(hi)); return r; }
typedef float f32x2 __attribute__((ext_vector_type(2)));
__device__ __forceinline__ f32x2 gelu_pk(f32x2 v) {
    const f32x2 av = __builtin_elementwise_abs(v), d = av * 0.2316418882f + 1.0f;
    f32x2 t; t.x = __builtin_amdgcn_rcpf(d.x); t.y = __builtin_amdgcn_rcpf(d.y);
    f32x2 q = t * 0.5307027145f + (-0.7265760135f); q = q * t + 0.7107068705f; q = q * t + (-0.142248368f); q = q * t + 0.127414796f; q = q * t;
    const f32x2 s = (v * v) * (-0.72134752044f);
    f32x2 e; e.x = __builtin_amdgcn_exp2f(s.x); e.y = __builtin_amdgcn_exp2f(s.y);
    const f32x2 m = v * (q * e), r = v - m;
    f32x2 o; o.x = v.x < 0.f ? m.x : r.x; o.y = v.y < 0.f ? m.y : r.y; return o;
}

template <class Epi, class Sched, bool ALIGN_EPI = false, bool SP2 = false, bool BLKA = false, bool BLKB = false>
__device__ __forceinline__ void gemm_phase(PG8_LAS unsigned char* lds, const Gemm g, const Sched& S, const Epi& E) {
    const int tid = tid_fresh(), wid = __builtin_amdgcn_readfirstlane(tid >> 6), lane = tid & 63, wr = wid >> 2, wc = wid & 3, fr = lane & 15, fq = lane >> 4;
    const int K = g.K, nt = K / BK;
    unsigned voffA[2], voffB[2];
#pragma unroll
    for (int i = 0; i < 2; ++i) { int R, C; stage_rc(tid * 16 + i * 8192, R, C); const int Rb = Epi::PERM ? ((R & ~31) + perm32(R & 31)) : R;
        const int Ra = Epi::AROWPERM ? ((R & ~63) | (4 * (R & 15) + ((R >> 4) & 3))) : R;
        voffA[i] = (unsigned)(Ra * (BLKA ? BK : g.lda) + C) * 2u; voffB[i] = (unsigned)(Rb * (BLKB ? BK : g.ldb) + C) * 2u; }
    const size_t kstepA = BLKA ? (size_t)BM * BK * 2 : (size_t)(BK * 2), kstepB = BLKB ? (size_t)BM * BK * 2 : (size_t)(BK * 2);
    const size_t hstepA = BLKA ? (size_t)HALF * BK * 2 : (size_t)HALF * g.lda * 2, hstepB = BLKB ? (size_t)HALF * BK * 2 : (size_t)HALF * g.ldb * 2;
    const size_t tstepA = BLKA ? (size_t)nt * BM * BK * 2 : 2 * hstepA, tstepB = BLKB ? (size_t)nt * BM * BK * 2 : 2 * hstepB;
    const unsigned ldsw = (unsigned)wid * 1024u;
    const int aoff = lds_byte(wr * 64 + fr, fq * 8), boff = lds_byte(wc * 32 + fr, fq * 8);
#define PG8_SA(b, h) (((b) * 2 + (h)) * HTB)
#define PG8_SB(b, h) ((4 + (b) * 2 + (h)) * HTB)
#define PG8_STAGE(bufoff, gbase, voff) do { _Pragma("unroll") for (int _i = 0; _i < 2; ++_i) \
        __builtin_amdgcn_global_load_lds((const unsigned*)((const char*)(gbase) + (voff)[_i]), (PG8_LAS unsigned*)(lds + (bufoff) + ldsw + _i * 8192), 16, 0, 0); } while (0)
#define PG8_LDA(dst, b, h) do { _Pragma("unroll") for (int m = 0; m < 4; ++m) _Pragma("unroll") for (int k = 0; k < 2; ++k) dst[m][k] = *(const PG8_LAS bf16x8*)(lds + PG8_SA(b, h) + aoff + m * 2048 + k * 1024); } while (0)
#define PG8_LDB(dst, b, h) do { _Pragma("unroll") for (int n = 0; n < 2; ++n) _Pragma("unroll") for (int k = 0; k < 2; ++k) dst[n][k] = *(const PG8_LAS bf16x8*)(lds + PG8_SB(b, h) + boff + n * 2048 + k * 1024); } while (0)
#define PG8_MMA(ai, bj, At, Bt) do { __builtin_amdgcn_s_setprio(1); _Pragma("unroll") for (int m = 0; m < 4; ++m) _Pragma("unroll") for (int n = 0; n < 2; ++n) _Pragma("unroll") for (int k = 0; k < 2; ++k) \
        acc[ai][bj][m][n] = __builtin_amdgcn_mfma_f32_16x16x32_bf16(Bt[n][k], At[m][k], acc[ai][bj][m][n], 0, 0, 0); __builtin_amdgcn_s_setprio(0); } while (0)
#define PG8_WAIT_V(n) asm volatile("s_waitcnt vmcnt(" #n ")" ::: "memory")
#define PG8_WAIT_L(n) asm volatile("s_waitcnt lgkmcnt(" #n ")" ::: "memory")
#define PG8_BAR __builtin_amdgcn_s_barrier()
#define PG8_SCHED __builtin_amdgcn_sched_barrier(0)
    Unit cur, nxt; int ui = 0;
    if (!S.next(0, cur)) return;
    f32x4 acc[2][2][4][2];
#pragma unroll
    for (int a = 0; a < 2; ++a)
#pragma unroll
        for (int b = 0; b < 2; ++b)
#pragma unroll
            for (int m = 0; m < 4; ++m)
#pragma unroll
                for (int n = 0; n < 2; ++n) acc[a][b][m][n] = (f32x4){0.f, 0.f, 0.f, 0.f};
    bf16x8 At[4][2], B0[2][2], B1[2][2];
    const char* cA = (const char*)g.A + (size_t)cur.pm * tstepA; const char* cB = (const char*)g.Bt + (size_t)cur.pn * tstepB;
    S.a_ready(cur);
    if constexpr (SP2) {
        PG8_STAGE(PG8_SB(0, 0), cB, voffB); PG8_STAGE(PG8_SB(0, 1), cB + hstepB, voffB); PG8_STAGE(PG8_SA(0, 0), cA, voffA); PG8_STAGE(PG8_SA(0, 1), cA + hstepA, voffA);
        if (wr == 1) PG8_BAR;
        PG8_WAIT_V(2); PG8_BAR;
        PG8_STAGE(PG8_SB(1, 0), cB + kstepB, voffB); PG8_STAGE(PG8_SA(1, 0), cA + kstepA, voffA); PG8_STAGE(PG8_SB(1, 1), cB + hstepB + kstepB, voffB);
        PG8_WAIT_V(6); PG8_BAR;
    } else {
        PG8_STAGE(PG8_SB(0, 0), cB, voffB); PG8_STAGE(PG8_SA(0, 0), cA, voffA); PG8_STAGE(PG8_SB(0, 1), cB + hstepB, voffB); PG8_STAGE(PG8_SA(0, 1), cA + hstepA, voffA);
        if (wr == 1) PG8_BAR;
        PG8_WAIT_V(4); PG8_BAR;
        PG8_STAGE(PG8_SB(1, 0), cB + kstepB, voffB); PG8_STAGE(PG8_SA(1, 0), cA + kstepA, voffA); PG8_STAGE(PG8_SB(1, 1), cB + hstepB + kstepB, voffB);
        PG8_WAIT_V(6); PG8_BAR;
    }
    for (;;) {
        const bool has_next = S.next(ui + 1, nxt);
        const char* nA = has_next ? (const char*)g.A + (size_t)nxt.pm * tstepA : cA; const char* nB = has_next ? (const char*)g.Bt + (size_t)nxt.pn * tstepB : cB;
        for (int t = 0; t < nt; t += 2) {
            const bool last = (t == nt - 2);
            const char* a1 = cA + (size_t)(t + 1) * kstepA;
            const char* a2 = last ? nA : cA + (size_t)(t + 2) * kstepA; const char* b2 = last ? nB : cB + (size_t)(t + 2) * kstepB;
            const char* a3 = a2 + kstepA; const char* b3 = b2 + kstepB;
            if (last && has_next) S.a_ready(nxt);
            if constexpr (SP2) {
            PG8_LDB(B0, 0, 0); PG8_LDB(B1, 0, 1); PG8_SCHED; PG8_LDA(At, 0, 0); PG8_STAGE(PG8_SA(1, 1), a1 + hstepA, voffA);
            PG8_WAIT_V(8); PG8_WAIT_L(0); PG8_BAR; PG8_MMA(0, 0, At, B0); PG8_MMA(0, 1, At, B1); PG8_BAR; PG8_SCHED;
            PG8_LDA(At, 0, 1); PG8_STAGE(PG8_SB(0, 0), b2, voffB); PG8_STAGE(PG8_SB(0, 1), b2 + hstepB, voffB); PG8_STAGE(PG8_SA(0, 0), a2, voffA);
            PG8_WAIT_V(8); PG8_WAIT_L(0); PG8_BAR; PG8_MMA(1, 0, At, B0); PG8_MMA(1, 1, At, B1); PG8_BAR; PG8_SCHED;
            PG8_LDB(B0, 1, 0); PG8_LDB(B1, 1, 1); PG8_SCHED; PG8_LDA(At, 1, 0); PG8_STAGE(PG8_SA(0, 1), a2 + hstepA, voffA);
            PG8_WAIT_V(8); PG8_WAIT_L(0); PG8_BAR; PG8_MMA(0, 0, At, B0); PG8_MMA(0, 1, At, B1); PG8_BAR; PG8_SCHED;
            PG8_LDA(At, 1, 1); PG8_STAGE(PG8_SB(1, 0), b3, voffB); PG8_STAGE(PG8_SB(1, 1), b3 + hstepB, voffB); PG8_STAGE(PG8_SA(1, 0), a3, voffA);
            PG8_WAIT_V(8); PG8_WAIT_L(0); PG8_BAR; PG8_MMA(1, 0, At, B0); PG8_MMA(1, 1, At, B1); PG8_BAR; PG8_SCHED;
            } else {
            PG8_LDB(B0, 0, 0); PG8_SCHED; PG8_LDA(At, 0, 0); PG8_STAGE(PG8_SA(1, 1), a1 + hstepA, voffA);
            PG8_WAIT_L(8); PG8_BAR; PG8_WAIT_L(0); PG8_MMA(0, 0, At, B0); PG8_BAR; PG8_SCHED;
            PG8_LDB(B1, 0, 1); PG8_STAGE(PG8_SB(0, 0), b2, voffB);
            PG8_BAR; PG8_WAIT_L(0); PG8_MMA(0, 1, At, B1); PG8_BAR;
            PG8_LDA(At, 0, 1); PG8_STAGE(PG8_SA(0, 0), a2, voffA);
            PG8_BAR; PG8_WAIT_L(0); PG8_MMA(1, 0, At, B0); PG8_BAR; PG8_SCHED;
            PG8_STAGE(PG8_SB(0, 1), b2 + hstepB, voffB);
            PG8_WAIT_V(6); PG8_BAR; PG8_MMA(1, 1, At, B1); PG8_BAR;
            PG8_LDB(B0, 1, 0); PG8_SCHED; PG8_LDA(At, 1, 0); PG8_STAGE(PG8_SA(0, 1), a2 + hstepA, voffA);
            PG8_WAIT_L(8); PG8_BAR; PG8_WAIT_L(0); PG8_MMA(0, 0, At, B0); PG8_BAR; PG8_SCHED;
            PG8_LDB(B1, 1, 1); PG8_STAGE(PG8_SB(1, 0), b3, voffB);
            PG8_BAR; PG8_WAIT_L(0); PG8_MMA(0, 1, At, B1); PG8_BAR;
            PG8_LDA(At, 1, 1); PG8_STAGE(PG8_SA(1, 0), a3, voffA);
            PG8_BAR; PG8_WAIT_L(0); PG8_MMA(1, 0, At, B0); PG8_BAR; PG8_SCHED;
            PG8_STAGE(PG8_SB(1, 1), b3 + hstepB, voffB);
            PG8_WAIT_V(6); PG8_BAR; PG8_MMA(1, 1, At, B1); PG8_BAR;
            }
        }
        if constexpr (ALIGN_EPI) { if (wr == 0) PG8_BAR; }
        if constexpr (!Epi::AFTER_DRAIN) { E(acc, cur, wr, wc, fr, fq); S.done(cur); }
        if (!has_next) break;
#pragma unroll
        for (int a = 0; a < 2; ++a)
#pragma unroll
            for (int b = 0; b < 2; ++b)
#pragma unroll
                for (int m = 0; m < 4; ++m)
#pragma unroll
                    for (int n = 0; n < 2; ++n) acc[a][b][m][n] = (f32x4){0.f, 0.f, 0.f, 0.f};
        cur = nxt; cA = nA; cB = nB; ++ui;
        if constexpr (ALIGN_EPI) { if (wr == 1) PG8_BAR; }
    }
    PG8_WAIT_V(0);
    if constexpr (!ALIGN_EPI) { if (wr == 0) PG8_BAR; }
    PG8_BAR;
    if constexpr (Epi::AFTER_DRAIN) { E.fused(acc, cur, wr, wc, fr, fq, lds, wid, lane); S.done(cur); }
#undef PG8_SA
#undef PG8_SB
#undef PG8_STAGE
#undef PG8_LDA
#undef PG8_LDB
#undef PG8_MMA
#undef PG8_WAIT_V
#undef PG8_WAIT_L
#undef PG8_BAR
#undef PG8_SCHED
}
}
namespace pg8 {
struct EpiBf {
    static constexpr bool PERM = true, AFTER_DRAIN = false, AROWPERM = false;
    bf16_t* O; int ldc; int gelu_tiles;
    const PG8_LAS float* ss; const PG8_LAS float* bvec; mutable int ui;
    __device__ __forceinline__ void operator()(const f32x4 (&acc)[2][2][4][2], const Unit& u, int wr, int wc, int fr, int fq) const {
        const int row0 = u.pm * BM + wr * 64 + fr; const int col0 = u.pn * BM + wc * 32 + 8 * fq;
        const bool act = u.pn < gelu_tiles;
        f32x4 bv[2][2];
        if (ss) { const PG8_LAS float* bp = bvec + ui * BM + wc * 32 + 8 * fq;
#pragma unroll
            for (int bj = 0; bj < 2; ++bj)
#pragma unroll
                for (int n = 0; n < 2; ++n) bv[bj][n] = *(const PG8_LAS f32x4*)(bp + bj * HALF + 4 * n); }
#pragma unroll
        for (int ai = 0; ai < 2; ++ai)
#pragma unroll
            for (int m = 0; m < 4; ++m) { bf16_t* rowp = O + (size_t)(row0 + ai * HALF + m * 16) * ldc + col0;
                float rs = 1.f; if (ss) rs = ss[ui * BM + wr * 64 + fr + ai * HALF + m * 16];
#pragma unroll
                for (int bj = 0; bj < 2; ++bj) { f32x4 v0 = acc[ai][bj][m][0], v1 = acc[ai][bj][m][1];
                    if (ss) { v0 = v0 * rs + bv[bj][0]; v1 = v1 * rs + bv[bj][1]; }
                    if (act) { f32x2 a = gelu_pk((f32x2){v0[0], v0[1]}), b = gelu_pk((f32x2){v0[2], v0[3]}), c = gelu_pk((f32x2){v1[0], v1[1]}), d = gelu_pk((f32x2){v1[2], v1[3]});
                        v0 = (f32x4){a.x, a.y, b.x, b.y}; v1 = (f32x4){c.x, c.y, d.x, d.y}; }
                    u32x4 w; w.x = cvt_pk_bf16(v0[0], v0[1]); w.y = cvt_pk_bf16(v0[2], v0[3]); w.z = cvt_pk_bf16(v1[0], v1[1]); w.w = cvt_pk_bf16(v1[2], v1[3]);
                    *(u32x4*)(rowp + bj * HALF) = w; } }
        ++ui;
    }
};
template <bool XBF, bool OBF>
struct EpiResidT {
    static constexpr bool PERM = true, AFTER_DRAIN = false, AROWPERM = false;
    const void* xa; const void* xb; void* out; const float* gate;
    bf16_t* xg; const float* ga; unsigned long long* ssq;
    __device__ __forceinline__ void operator()(const f32x4 (&acc)[2][2][4][2], const Unit& u, int wr, int wc, int fr, int fq) const {
        const int row0 = u.pm * BM + wr * 64 + fr; const int col0 = u.pn * BM + wc * 32 + 8 * fq;
        const int b = row_batch(u.pm * BM); const void* xin = (u.pm * BM < NPR) ? xa : xb;
        f32x4 gv[2][2], gn[2][2];
#pragma unroll
        for (int bj = 0; bj < 2; ++bj)
#pragma unroll
            for (int n = 0; n < 2; ++n) { gv[bj][n] = *(const f32x4*)(gate + (size_t)b * MODW + col0 + bj * HALF + 4 * n);
                if (xg) gn[bj][n] = *(const f32x4*)(ga + (size_t)b * DM + col0 + bj * HALF + 4 * n); }
#pragma unroll
        for (int aim = 0; aim < 4; ++aim) { const int ai = aim >> 1, mh = (aim & 1) * 2;
            f32x4 xv[2][2][2];
#pragma unroll
            for (int mm = 0; mm < 2; ++mm) { const size_t off = (size_t)(row0 + ai * HALF + (mh + mm) * 16) * DM + col0;
#pragma unroll
                for (int bj = 0; bj < 2; ++bj) {
                    if constexpr (XBF) { const u32x4 w = *(const u32x4*)((const unsigned short*)xin + off + bj * HALF);
                        xv[mm][bj][0] = (f32x4){__uint_as_float(w.x << 16), __uint_as_float(w.x & 0xffff0000u), __uint_as_float(w.y << 16), __uint_as_float(w.y & 0xffff0000u)};
                        xv[mm][bj][1] = (f32x4){__uint_as_float(w.z << 16), __uint_as_float(w.z & 0xffff0000u), __uint_as_float(w.w << 16), __uint_as_float(w.w & 0xffff0000u)}; }
                    else {
#pragma unroll
                        for (int n = 0; n < 2; ++n) xv[mm][bj][n] = *(const f32x4*)((const float*)xin + off + bj * HALF + 4 * n); } } }
#pragma unroll
            for (int mm = 0; mm < 2; ++mm) { const int m = mh + mm; const size_t off = (size_t)(row0 + ai * HALF + m * 16) * DM + col0; float sq = 0.f;
#pragma unroll
                for (int bj = 0; bj < 2; ++bj) { f32x4 xn[2];
#pragma unroll
                    for (int n = 0; n < 2; ++n) {
                        xn[n] = xv[mm][bj][n] + gv[bj][n] * acc[ai][bj][m][n];
                        if constexpr (!OBF) *(f32x4*)((float*)out + off + bj * HALF + 4 * n) = xn[n]; }
                    if constexpr (OBF) { u32x4 w; w.x = cvt_pk_bf16(xn[0][0], xn[0][1]); w.y = cvt_pk_bf16(xn[0][2], xn[0][3]); w.z = cvt_pk_bf16(xn[1][0], xn[1][1]); w.w = cvt_pk_bf16(xn[1][2], xn[1][3]);
                        *(u32x4*)((unsigned short*)out + off + bj * HALF) = w; }
                    if (xg) { const f32x4 a = xn[0] * gn[bj][0], c = xn[1] * gn[bj][1];
                        sq += (xn[0][0] * xn[0][0] + xn[0][1] * xn[0][1]) + (xn[0][2] * xn[0][2] + xn[0][3] * xn[0][3]) + (xn[1][0] * xn[1][0] + xn[1][1] * xn[1][1]) + (xn[1][2] * xn[1][2] + xn[1][3] * xn[1][3]);
                        u32x4 w; w.x = cvt_pk_bf16(a[0], a[1]); w.y = cvt_pk_bf16(a[2], a[3]); w.z = cvt_pk_bf16(c[0], c[1]); w.w = cvt_pk_bf16(c[2], c[3]);
                        *(u32x4*)(xg + off + bj * HALF) = w; } }
                if (xg) { sq += __shfl_xor(sq, 16); sq += __shfl_xor(sq, 32);
                    if (fq == 0) __hip_atomic_fetch_add(ssq + row0 + ai * HALF + m * 16, (unsigned long long)(sq * 16777216.0f + 0.5f), __ATOMIC_RELAXED, __HIP_MEMORY_SCOPE_AGENT); } }
        }
    }
};
}
namespace pg8 {
__device__ __forceinline__ float dpp_prev(float x) { return __int_as_float(__builtin_amdgcn_update_dpp(0, __float_as_int(x), 0x121, 0xF, 0xF, true)); }
__device__ __forceinline__ float dpp_next(float x) { return __int_as_float(__builtin_amdgcn_update_dpp(0, __float_as_int(x), 0x12F, 0xF, 0xF, true)); }
__device__ __forceinline__ float dpp_shr1_old(float oldv, float x) { return __int_as_float(__builtin_amdgcn_update_dpp(__float_as_int(oldv), __float_as_int(x), 0x111, 0xF, 0xF, false)); }
__device__ __forceinline__ float dpp_shl1_old(float oldv, float x) { return __int_as_float(__builtin_amdgcn_update_dpp(__float_as_int(oldv), __float_as_int(x), 0x101, 0xF, 0xF, false)); }
__device__ __forceinline__ f32x4 dpp_shr1_old4(f32x4 o, f32x4 v) { return (f32x4){dpp_shr1_old(o[0], v[0]), dpp_shr1_old(o[1], v[1]), dpp_shr1_old(o[2], v[2]), dpp_shr1_old(o[3], v[3])}; }
__device__ __forceinline__ f32x4 dpp_shl1_old4(f32x4 o, f32x4 v) { return (f32x4){dpp_shl1_old(o[0], v[0]), dpp_shl1_old(o[1], v[1]), dpp_shl1_old(o[2], v[2]), dpp_shl1_old(o[3], v[3])}; }
__device__ __forceinline__ f32x4 dpp_prev4(f32x4 v) { return (f32x4){dpp_prev(v[0]), dpp_prev(v[1]), dpp_prev(v[2]), dpp_prev(v[3])}; }
__device__ __forceinline__ f32x4 dpp_next4(f32x4 v) { return (f32x4){dpp_next(v[0]), dpp_next(v[1]), dpp_next(v[2]), dpp_next(v[3])}; }
struct EpiGate {
    static constexpr bool PERM = true, AFTER_DRAIN = false, AROWPERM = true;
    bf16_t* A; float* ZH; const float* cw; const float* cb; PG8_LAS float* halo;
    const PG8_LAS float* rstab; const float* bvec; mutable int ui;
    __device__ __forceinline__ void operator()(f32x4 (&acc)[2][2][4][2], const Unit& u, int wr, int wc, int fr, int fq) const {
        const int cl = wc * 32 + 8 * fq;
        f32x4 w[2][3], bs[2], bv[2];
#define EG_LOADC(n_) do { const float* bp_ = bvec + (size_t)row_batch(u.pm * BM) * DFF2 + u.pn * BM + cl + 4 * (n_); const int j0_ = u.pn * HALF + cl + 4 * (n_); \
        _Pragma("unroll") for (int bj = 0; bj < 2; ++bj) { bv[bj] = *(const f32x4*)(bp_ + bj * HALF); bs[bj] = *(const f32x4*)(cb + bj * DFF + j0_); } } while (0)
#define EG_LOADW(n_) do { const int j0_ = u.pn * HALF + cl + 4 * (n_); \
        _Pragma("unroll") for (int bj = 0; bj < 2; ++bj) _Pragma("unroll") for (int k = 0; k < 3; ++k) w[bj][k] = *(const f32x4*)(cw + (size_t)k * DFF2 + bj * DFF + j0_); } while (0)
#pragma unroll
        for (int ai = 0; ai < 2; ++ai)
#pragma unroll
            for (int m = 0; m < 4; ++m) { const float rs = rstab[ui * BM + ai * HALF + wr * 64 + 4 * fr + m];
#pragma unroll
                for (int bj = 0; bj < 2; ++bj)
#pragma unroll
                    for (int n = 0; n < 2; ++n) acc[ai][bj][m][n] = acc[ai][bj][m][n] * rs; }
#pragma unroll
        for (int ai = 0; ai < 2; ++ai)
#pragma unroll
            for (int bj = 0; bj < 2; ++bj)
#pragma unroll
                for (int n = 0; n < 2; ++n) { const int blk = ai * 2 + wr, c = bj * HALF + cl + 4 * n;
                    const f32x4 hv = (fr == 0) ? acc[ai][bj][0][n] : acc[ai][bj][3][n];
                    *(PG8_LAS f32x4*)(halo + ((fr == 0) ? (blk * 2) * 256 : (fr == 15) ? (blk * 2 + 1) * 256 : 2048) + c) = hv; }
        asm volatile("s_waitcnt lgkmcnt(0)" ::: "memory"); __builtin_amdgcn_s_barrier(); asm volatile("" ::: "memory");
        const int trow0 = u.pm * BM, pos0 = row_pos(trow0), Lb = batch_len(row_batch(trow0));
        const bool top_ok = (pos0 == 0), bot_ok = (pos0 + BM == Lb);
        const unsigned aoff = ((((unsigned)u.pm * (DFF / 64) + 2 * u.pn + (wc >> 1)) << 14) + 32 * (wc & 1) + 8 * fq) * 2u;
#pragma unroll
        for (int n = 0; n < 2; ++n) {
            EG_LOADW(n); EG_LOADC(n);
            f32x4 cfull[2];
#pragma unroll
            for (int bj = 0; bj < 2; ++bj) cfull[bj] = bs[bj] + bv[bj] * (w[bj][0] + w[bj][1] + w[bj][2]);
            { const unsigned zo = (((unsigned)u.pm * 4) * DFF2 + u.pn * BM + cl + 4 * n) * 4u;
              if (wr == 0 && fr == 0) {
#pragma unroll
                  for (int bj = 0; bj < 2; ++bj) { *(f32x4*)((char*)ZH + (zo + (unsigned)(bj * HALF) * 4u)) = acc[0][bj][0][n] + bv[bj];
                      *(f32x4*)((char*)ZH + (zo + (unsigned)(DFF2 + bj * HALF) * 4u)) = acc[0][bj][1][n] + bv[bj]; } }
              if (wr == 1 && fr == 15) {
#pragma unroll
                  for (int bj = 0; bj < 2; ++bj) { *(f32x4*)((char*)ZH + (zo + (unsigned)(2 * DFF2 + bj * HALF) * 4u)) = acc[1][bj][2][n] + bv[bj];
                      *(f32x4*)((char*)ZH + (zo + (unsigned)(3 * DFF2 + bj * HALF) * 4u)) = acc[1][bj][3][n] + bv[bj]; } } }
#pragma unroll
            for (int ai = 0; ai < 2; ++ai) {
                const int blk = ai * 2 + wr;
                f32x4 hp[2], hn[2];
#pragma unroll
                for (int bj = 0; bj < 2; ++bj) {
                    hp[bj] = (blk > 0) ? *(const PG8_LAS f32x4*)(halo + ((blk - 1) * 2 + 1) * 256 + bj * HALF + cl + 4 * n) : (f32x4){0.f, 0.f, 0.f, 0.f};
                    hn[bj] = (blk < 3) ? *(const PG8_LAS f32x4*)(halo + ((blk + 1) * 2 + 0) * 256 + bj * HALF + cl + 4 * n) : (f32x4){0.f, 0.f, 0.f, 0.f}; }
#pragma unroll
                for (int m = 0; m < 4; ++m) {
                    const int rt = ai * HALF + wr * 64 + 4 * fr + m;
                    f32x4 cv[2];
#pragma unroll
                    for (int bj = 0; bj < 2; ++bj) {
                        const f32x4 cur = acc[ai][bj][m][n];
                        const f32x4 prev = (m > 0) ? acc[ai][bj][m > 0 ? m - 1 : 0][n] : dpp_shr1_old4(hp[bj], acc[ai][bj][3][n]);
                        const f32x4 next = (m < 3) ? acc[ai][bj][m < 3 ? m + 1 : 3][n] : dpp_shl1_old4(hn[bj], acc[ai][bj][0][n]);
                        cv[bj] = w[bj][0] * prev + w[bj][1] * cur + w[bj][2] * next + cfull[bj];
                        if (ai == 0 && m == 0) { if (wr == 0 && fr == 0 && top_ok) cv[bj] = cv[bj] - bv[bj] * w[bj][0]; }
                        if (ai == 1 && m == 3) { if (wr == 1 && fr == 15 && bot_ok) cv[bj] = cv[bj] - bv[bj] * w[bj][2]; } }
                    float o[4];
#pragma unroll
                    for (int e = 0; e < 4; ++e) { const float g = cv[0][e]; o[e] = g * __builtin_amdgcn_rcpf(1.0f + __expf(-g)) * cv[1][e]; }
                    const unsigned p0 = cvt_pk_bf16(o[0], o[1]), p1 = cvt_pk_bf16(o[2], o[3]);
                    {
                      typedef unsigned u32x2e __attribute__((ext_vector_type(2)));
                      *(u32x2e*)((char*)A + (aoff + (unsigned)(rt * 128 + 8 * n))) = (u32x2e){p0, p1}; }
                }
            }
        }
        asm volatile("s_waitcnt lgkmcnt(0)" ::: "memory"); __builtin_amdgcn_s_barrier(); asm volatile("" ::: "memory");
        ++ui;
#undef EG_LOADC
#undef EG_LOADW
    }
};
template <class Sched> __device__ __forceinline__ void fill_tabs(const Sched& S, const unsigned long long* ss, const float* bvec, int ldb, PG8_LAS float* rstab, PG8_LAS float* bvtab, int tid) {
    Unit u;
    for (int i = 0; S.next(i, u); ++i) {
        if (tid < 256) rstab[i * BM + tid] = rsqrtf((float)ss[u.pm * BM + tid] * (1.0f / 16777216.0f) * (1.0f / DM) + EPS);
        else if (bvec) bvtab[i * BM + tid - 256] = bvec[(size_t)row_batch(u.pm * BM) * ldb + u.pn * BM + tid - 256]; }
    __syncthreads();
}
}
namespace att {
using bf16x8 = __attribute__((ext_vector_type(8))) short;
using s16x4  = __attribute__((ext_vector_type(4))) short;
using f32x16 = __attribute__((ext_vector_type(16))) float;
using u32x4  = __attribute__((ext_vector_type(4))) unsigned;
constexpr int NW = 8, QBLK = 32, KVBLK = 64, DV = 128;
constexpr float THR = 8.f;
#define ATT_SBAR() __builtin_amdgcn_sched_barrier(0)
__device__ __forceinline__ int crow(int r, int hi) { return (r & 3) + 8 * (r >> 2) + 4 * hi; }
__device__ __forceinline__ unsigned cvtpk(float lo, float hi) { unsigned r; asm volatile("v_cvt_pk_bf16_f32 %0, %1, %2" : "=v"(r) : "v"(lo), "v"(hi)); return r; }
template <int DK> __device__ __forceinline__ int kswz(int row, int colB) { return row * (2 * DK + 16) + colB; }

template <int DK> __device__ __forceinline__ void partialSM(f32x16& p0, f32x16& p1, float& m_reg, float& mn, float& alpha) {
  constexpr float SCALE = (DK == 128) ? 0.08838834764831845f : 0.07216878364870323f;
  constexpr float C = SCALE * 1.4426950408889634f;
  float pmax = p0[0];
#pragma unroll
  for (int r = 1; r < 16; ++r) pmax = fmaxf(pmax, p0[r]);
#pragma unroll
  for (int r = 0; r < 16; ++r) pmax = fmaxf(pmax, p1[r]);
  { auto rr = __builtin_amdgcn_permlane32_swap(__float_as_uint(pmax), __float_as_uint(pmax), false, false);
    pmax = fmaxf(__uint_as_float(rr[0]), __uint_as_float(rr[1])); }
  if (__builtin_expect(__all(pmax - m_reg <= THR / SCALE), 1)) { mn = m_reg; alpha = 1.f; }
  else { mn = fmaxf(m_reg, pmax); alpha = __builtin_amdgcn_exp2f((m_reg - mn) * C); m_reg = mn; }
  float mnC = -mn * C;
#pragma unroll
  for (int r = 0; r < 16; ++r) p0[r] = fmaf(p0[r], C, mnC);
#pragma unroll
  for (int r = 0; r < 16; ++r) p1[r] = fmaf(p1[r], C, mnC);
#pragma unroll
  for (int r = 0; r < 16; ++r) p0[r] = __builtin_amdgcn_exp2f(p0[r]);
}
__device__ __forceinline__ void finishSM(f32x16& p0, f32x16& p1, float alpha, float& l_reg, bf16x8& pa0, bf16x8& pa1, bf16x8& pa2, bf16x8& pa3) {
#pragma unroll
  for (int r = 0; r < 16; ++r) p1[r] = __builtin_amdgcn_exp2f(p1[r]);
  float ps = 0;
#pragma unroll
  for (int r = 0; r < 16; ++r) ps += p0[r];
#pragma unroll
  for (int r = 0; r < 16; ++r) ps += p1[r];
  { auto rr = __builtin_amdgcn_permlane32_swap(__float_as_uint(ps), __float_as_uint(ps), false, false);
    ps = __uint_as_float(rr[0]) + __uint_as_float(rr[1]); }
  l_reg = l_reg * alpha + ps;
#define ATT_PK4(P, BASE, OUT) do { unsigned a0 = cvtpk(P[BASE + 0], P[BASE + 1]), a1 = cvtpk(P[BASE + 2], P[BASE + 3]);   \
    unsigned b0 = cvtpk(P[BASE + 4], P[BASE + 5]), b1 = cvtpk(P[BASE + 6], P[BASE + 7]);                              \
    auto r0 = __builtin_amdgcn_permlane32_swap(a0, b0, false, false); auto r1 = __builtin_amdgcn_permlane32_swap(a1, b1, false, false); \
    u32x4 w = {r0[0], r1[0], r0[1], r1[1]}; OUT = *reinterpret_cast<bf16x8*>(&w); } while (0)
  ATT_PK4(p0, 0, pa0); ATT_PK4(p0, 8, pa1); ATT_PK4(p1, 0, pa2); ATT_PK4(p1, 8, pa3);
#undef ATT_PK4
}
template <int DK> __device__ __forceinline__ void qkt(f32x16& p0, f32x16& p1, const char* Ks, const bf16x8* qr, const char* ldsb, int qxo, int r32, int hi) {
  p0 = f32x16{}; p1 = f32x16{};
  if constexpr (DK > 128) asm volatile("" : "+v"(qxo));
  const char* qx = ldsb + qxo;
#pragma unroll
  for (int d0 = 0; d0 < DK / 16; ++d0) { int cb = (d0 * 16 + hi * 8) * 2;
    bf16x8 b0 = *reinterpret_cast<const bf16x8*>(Ks + kswz<DK>(r32, cb));
    bf16x8 b1 = *reinterpret_cast<const bf16x8*>(Ks + kswz<DK>(32 + r32, cb));
    bf16x8 qf; if (d0 < 8) qf = qr[d0]; else qf = *reinterpret_cast<const bf16x8*>(qx + (d0 - 8) * 1024);
    p0 = __builtin_amdgcn_mfma_f32_32x32x16_bf16(b0, qf, p0, 0, 0, 0);
    p1 = __builtin_amdgcn_mfma_f32_32x32x16_bf16(b1, qf, p1, 0, 0, 0);
    if ((d0 & 3) == 3) ATT_SBAR(); }
}
__device__ __forceinline__ int v_st(int k, int c) { const int kk = (k & ~0xC) | ((k & 4) << 1) | ((k & 8) >> 1); return ((kk >> 3) * 4 + (c >> 5)) * 512 + ((kk & 7) * 32 + (c & 31)) * 2; }
__device__ __forceinline__ int v_rd_base(int lane) { return ((lane & 3) << 3) | (((lane >> 2) & 3) << 6) | (((lane >> 4) & 1) << 5) | (((lane >> 5) & 1) << 8); }
constexpr int v_rd_off(int d0, int ks, int half) { return d0 * 512 + ks * 4096 + half * 2048; }
template <int OFF> __device__ __forceinline__ s16x4 tr_read(int vb) {
  s16x4 r; asm volatile("ds_read_b64_tr_b16 %0, %1 offset:%2" : "=&v"(r) : "v"(vb), "i"(OFF) : "memory"); return r;
}
template <int D0> __device__ __forceinline__ void pv_one(f32x16& od, int vb, bf16x8 pa0, bf16x8 pa1, bf16x8 pa2, bf16x8 pa3) {
  const s16x4 l0 = tr_read<v_rd_off(D0, 0, 0)>(vb), h0 = tr_read<v_rd_off(D0, 0, 1)>(vb), l1 = tr_read<v_rd_off(D0, 1, 0)>(vb), h1 = tr_read<v_rd_off(D0, 1, 1)>(vb);
  const s16x4 l2 = tr_read<v_rd_off(D0, 2, 0)>(vb), h2 = tr_read<v_rd_off(D0, 2, 1)>(vb), l3 = tr_read<v_rd_off(D0, 3, 0)>(vb), h3 = tr_read<v_rd_off(D0, 3, 1)>(vb);
  asm volatile("s_waitcnt lgkmcnt(0)" ::: "memory"); ATT_SBAR();
#define ATT_PK(L, H) (bf16x8){L[0], L[1], L[2], L[3], H[0], H[1], H[2], H[3]}
  od = __builtin_amdgcn_mfma_f32_32x32x16_bf16(pa0, ATT_PK(l0, h0), od, 0, 0, 0);
  od = __builtin_amdgcn_mfma_f32_32x32x16_bf16(pa1, ATT_PK(l1, h1), od, 0, 0, 0);
  od = __builtin_amdgcn_mfma_f32_32x32x16_bf16(pa2, ATT_PK(l2, h2), od, 0, 0, 0);
  od = __builtin_amdgcn_mfma_f32_32x32x16_bf16(pa3, ATT_PK(l3, h3), od, 0, 0, 0);
#undef ATT_PK
}
__device__ __forceinline__ void pv_d0(f32x16* o, int vb, bf16x8 pa0, bf16x8 pa1, bf16x8 pa2, bf16x8 pa3) {
  pv_one<0>(o[0], vb, pa0, pa1, pa2, pa3); pv_one<1>(o[1], vb, pa0, pa1, pa2, pa3); pv_one<2>(o[2], vb, pa0, pa1, pa2, pa3); pv_one<3>(o[3], vb, pa0, pa1, pa2, pa3);
}
template <int DK> struct Cfg { static constexpr int SHM_V = KVBLK * DV * 2, SHM_K = KVBLK * (DK * 2 + 16), SHM_Q = (DK > 128) ? NW * 4096 : 0, SHM = 2 * SHM_V + 2 * SHM_K + NW * 64 * 4 + SHM_Q; };

template <int DK, int SDEPTH, int ldq, int ldk, int ldv, int ldo>
__device__ __forceinline__ void attn_body(const unsigned short* __restrict__ Qb, const unsigned short* __restrict__ Kh,
                                          const unsigned short* __restrict__ Vh, unsigned short* __restrict__ Ob, int seq, char* lds) {
  constexpr int SHM_V = Cfg<DK>::SHM_V, SHM_K = Cfg<DK>::SHM_K, NQ = (DK > 128 ? 8 : DK / 16), NKI = DK / 64;
  const int tid = tid_fresh(), wid = tid >> 6, lane = tid & 63, r32 = lane & 31, hi = lane >> 5;
  char* V_lds = lds; char* K_lds = lds + 2 * SHM_V;
  float* ws = (float*)(lds + 2 * SHM_V + 2 * SHM_K) + wid * 64; float* li_l = ws; float* al_l = ws + 32;
  float m_reg = -1e30f, l_reg = 0; f32x16 o[4] = {}; bf16x8 qr[NQ];
  const unsigned short* Qw = Qb + (wid * QBLK + r32) * ldq + hi * 8;
#pragma unroll
  for (int d0 = 0; d0 < NQ; ++d0) qr[d0] = *reinterpret_cast<const bf16x8*>(Qw + d0 * 16);
  const int qxo = 2 * SHM_V + 2 * SHM_K + NW * 64 * 4 + wid * 4096 + lane * 16; char* qx = lds + qxo;
  if constexpr (DK > 128) {
#pragma unroll
    for (int d0 = 8; d0 < DK / 16; ++d0) *reinterpret_cast<bf16x8*>(qx + (d0 - 8) * 1024) = *reinterpret_cast<const bf16x8*>(Qw + d0 * 16);
  }
  const int sr = tid >> 4, sc = (tid & 15) * 8, vst0 = v_st(sr, sc);
  const int vgo = sr * ldv + sc;
  const int kr = tid >> 3, kc8 = tid & 7, kgo = kr * ldk + kc8 * 8, kdst = kswz<DK>(kr, kc8 * 16);
  const int vb0 = (int)(uintptr_t)V_lds + v_rd_base(lane);
  struct { bf16x8 vs0, vs1, ks[NKI]; } sr_[SDEPTH];
#define ATT_SLOAD(i, k0) do { const unsigned short* vt_ = Vh + (size_t)(k0) * ldv; const unsigned short* kt_ = Kh + (size_t)(k0) * ldk; \
    sr_[i].vs0 = *reinterpret_cast<const bf16x8*>(vt_ + vgo); sr_[i].vs1 = *reinterpret_cast<const bf16x8*>(vt_ + vgo + 32 * ldv); \
    _Pragma("unroll") for (int q_ = 0; q_ < NKI; ++q_) sr_[i].ks[q_] = *reinterpret_cast<const bf16x8*>(kt_ + kgo + 64 * q_); } while (0)
#define ATT_SWRITE(b, i) do { *(bf16x8*)(V_lds + (b) * SHM_V + vst0) = sr_[i].vs0; *(bf16x8*)(V_lds + (b) * SHM_V + vst0 + 8192) = sr_[i].vs1; \
    _Pragma("unroll") for (int q_ = 0; q_ < NKI; ++q_) *(bf16x8*)(K_lds + (b) * SHM_K + kdst + 128 * q_) = sr_[i].ks[q_]; } while (0)
#define ATT_SWAIT() do { if constexpr (SDEPTH == 2) { if constexpr (NKI == 2) asm volatile("s_waitcnt vmcnt(4)" ::: "memory"); else asm volatile("s_waitcnt vmcnt(5)" ::: "memory"); } else asm volatile("s_waitcnt vmcnt(0)" ::: "memory"); } while (0)
#define ATT_RESC(a) do { if (__any((a) < 1.f)) { if (hi == 0) al_l[r32] = (a); asm volatile("s_waitcnt lgkmcnt(0)" ::: "memory"); \
    _Pragma("unroll") for (int d = 0; d < 4; ++d) _Pragma("unroll") for (int r = 0; r < 16; ++r) o[d][r] *= al_l[crow(r, hi)]; } } while (0)
  f32x16 pA0, pA1, pB0, pB1; float mnA, mnB, alA, alB; bf16x8 pa0, pa1, pa2, pa3; const int NT = seq / KVBLK;
  constexpr int SE = 0, SO = SDEPTH - 1;
  ATT_SLOAD(SE, 0); asm volatile("s_waitcnt vmcnt(0)" ::: "memory"); ATT_SWRITE(0, SE); __syncthreads();
  qkt<DK>(pA0, pA1, K_lds, qr, lds, qxo, r32, hi); partialSM<DK>(pA0, pA1, m_reg, mnA, alA);
  ATT_SLOAD(SO, KVBLK); if constexpr (SDEPTH == 2) { if (2 < NT) ATT_SLOAD(SE, 2 * KVBLK); }
  ATT_SWAIT(); ATT_SWRITE(1, SO); __syncthreads();
  for (int j = 1; j + 1 < NT; j += 2) {
    ATT_SBAR(); qkt<DK>(pB0, pB1, K_lds + SHM_K, qr, lds, qxo, r32, hi);
    finishSM(pA0, pA1, alA, l_reg, pa0, pa1, pa2, pa3); ATT_SBAR();
    ATT_SLOAD(SO, (j + SDEPTH) * KVBLK); ATT_SBAR();
    pv_d0(o, vb0, pa0, pa1, pa2, pa3); partialSM<DK>(pB0, pB1, m_reg, mnB, alB);
    __syncthreads(); ATT_SWAIT(); ATT_SWRITE(0, SE);
    ATT_RESC(alB); __syncthreads();
    ATT_SBAR(); qkt<DK>(pA0, pA1, K_lds, qr, lds, qxo, r32, hi);
    finishSM(pB0, pB1, alB, l_reg, pa0, pa1, pa2, pa3); ATT_SBAR();
    if (SDEPTH == 1 || j + 3 < NT) ATT_SLOAD(SE, (j + 1 + SDEPTH) * KVBLK); ATT_SBAR();
    pv_d0(o, vb0 + SHM_V, pa0, pa1, pa2, pa3); partialSM<DK>(pA0, pA1, m_reg, mnA, alA);
    __syncthreads(); ATT_SWAIT(); ATT_SWRITE(1, SO);
    ATT_RESC(alA); __syncthreads();
  }
  ATT_SBAR(); qkt<DK>(pB0, pB1, K_lds + SHM_K, qr, lds, qxo, r32, hi);
  finishSM(pA0, pA1, alA, l_reg, pa0, pa1, pa2, pa3); ATT_SBAR();
  pv_d0(o, vb0, pa0, pa1, pa2, pa3); partialSM<DK>(pB0, pB1, m_reg, mnB, alB);
  __syncthreads(); ATT_RESC(alB);
  finishSM(pB0, pB1, alB, l_reg, pa0, pa1, pa2, pa3); ATT_SBAR();
  pv_d0(o, vb0 + SHM_V, pa0, pa1, pa2, pa3);
  if (hi == 0) li_l[r32] = l_reg; asm volatile("s_waitcnt lgkmcnt(0)" ::: "memory");
  float rli[16];
#pragma unroll
  for (int r = 0; r < 16; ++r) rli[r] = __builtin_amdgcn_rcpf(li_l[crow(r, hi)]);
  unsigned short* Ow = Ob + (wid * QBLK) * ldo;
#pragma unroll
  for (int r = 0; r < 16; ++r) { int orow = crow(r, hi);
#pragma unroll
    for (int d0 = 0; d0 < 4; ++d0) Ow[orow * ldo + d0 * 32 + r32] = (unsigned short)f2bf(o[d0][r] * rli[r]); }
  __syncthreads();
#undef ATT_SLOAD
#undef ATT_SWRITE
#undef ATT_SWAIT
#undef ATT_RESC
}

template <int DK, int ldq, int ldk, int ldv, int ldo>
__device__ __forceinline__ void attn_body_seq(const unsigned short* __restrict__ Qb, const unsigned short* __restrict__ Kh,
                                              const unsigned short* __restrict__ Vh, unsigned short* __restrict__ Ob, int seq, char* lds) {
  constexpr int SHM_V = Cfg<DK>::SHM_V, SHM_K = Cfg<DK>::SHM_K, NQ = (DK > 128 ? 8 : DK / 16), NKI = DK / 64;
  const int tid = tid_fresh(), wid = tid >> 6, lane = tid & 63, r32 = lane & 31, hi = lane >> 5;
  char* V_lds = lds; char* K_lds = lds + 2 * SHM_V;
  float* ws = (float*)(lds + 2 * SHM_V + 2 * SHM_K) + wid * 64; float* li_l = ws; float* al_l = ws + 32;
  float m_reg = -1e30f, l_reg = 0; f32x16 o[4] = {}; bf16x8 qr[NQ];
  const unsigned short* Qw = Qb + (wid * QBLK + r32) * ldq + hi * 8;
#pragma unroll
  for (int d0 = 0; d0 < NQ; ++d0) qr[d0] = *reinterpret_cast<const bf16x8*>(Qw + d0 * 16);
  const int qxo = 2 * SHM_V + 2 * SHM_K + NW * 64 * 4 + wid * 4096 + lane * 16; char* qx = lds + qxo;
  if constexpr (DK > 128) {
#pragma unroll
    for (int d0 = 8; d0 < DK / 16; ++d0) *reinterpret_cast<bf16x8*>(qx + (d0 - 8) * 1024) = *reinterpret_cast<const bf16x8*>(Qw + d0 * 16);
  }
  const int sr = tid >> 4, sc = (tid & 15) * 8, vst0 = v_st(sr, sc);
  const int vgo = sr * ldv + sc;
  const int kr = tid >> 3, kc8 = tid & 7, kgo = kr * ldk + kc8 * 8, kdst = kswz<DK>(kr, kc8 * 16);
  const int vb0 = (int)(uintptr_t)V_lds + v_rd_base(lane);
  bf16x8 vs0, vs1, ks[NKI];
#define ATT_SLOAD1(k0) do { const unsigned short* vt_ = Vh + (size_t)(k0) * ldv; const unsigned short* kt_ = Kh + (size_t)(k0) * ldk; \
    vs0 = *reinterpret_cast<const bf16x8*>(vt_ + vgo); vs1 = *reinterpret_cast<const bf16x8*>(vt_ + vgo + 32 * ldv); \
    _Pragma("unroll") for (int q_ = 0; q_ < NKI; ++q_) ks[q_] = *reinterpret_cast<const bf16x8*>(kt_ + kgo + 64 * q_); } while (0)
#define ATT_SWRITE1(b) do { *(bf16x8*)(V_lds + (b) * SHM_V + vst0) = vs0; *(bf16x8*)(V_lds + (b) * SHM_V + vst0 + 8192) = vs1; \
    _Pragma("unroll") for (int q_ = 0; q_ < NKI; ++q_) *(bf16x8*)(K_lds + (b) * SHM_K + kdst + 128 * q_) = ks[q_]; } while (0)
  const int NT = seq / KVBLK;
  ATT_SLOAD1(0); ATT_SWRITE1(0); __syncthreads();
#pragma unroll 1
  for (int j = 0; j < NT; ++j) {
    const int b = j & 1;
    f32x16 p0, p1; float mn, al; bf16x8 pa0, pa1, pa2, pa3;
    if (j + 1 < NT) ATT_SLOAD1((j + 1) * KVBLK);
    ATT_SBAR();
    qkt<DK>(p0, p1, K_lds + b * SHM_K, qr, lds, qxo, r32, hi);
    partialSM<DK>(p0, p1, m_reg, mn, al);
    if (__any(al < 1.f)) { if (hi == 0) al_l[r32] = al; asm volatile("s_waitcnt lgkmcnt(0)" ::: "memory");
#pragma unroll
      for (int d = 0; d < 4; ++d)
#pragma unroll
        for (int r = 0; r < 16; ++r) o[d][r] *= al_l[crow(r, hi)]; }
    finishSM(p0, p1, al, l_reg, pa0, pa1, pa2, pa3); ATT_SBAR();
    pv_d0(o, vb0 + b * SHM_V, pa0, pa1, pa2, pa3);
    if (j + 1 < NT) ATT_SWRITE1(b ^ 1);
    __syncthreads();
  }
  if (hi == 0) li_l[r32] = l_reg; asm volatile("s_waitcnt lgkmcnt(0)" ::: "memory");
  float rli[16];
#pragma unroll
  for (int r = 0; r < 16; ++r) rli[r] = __builtin_amdgcn_rcpf(li_l[crow(r, hi)]);
  unsigned short* Ow = Ob + (wid * QBLK) * ldo;
#pragma unroll
  for (int r = 0; r < 16; ++r) { int orow = crow(r, hi);
#pragma unroll
    for (int d0 = 0; d0 < 4; ++d0) Ow[orow * ldo + d0 * 32 + r32] = (unsigned short)f2bf(o[d0][r] * rli[r]); }
  __syncthreads();
#undef ATT_SLOAD1
#undef ATT_SWRITE1
}

template <int DK> __device__ __forceinline__ void qk_half(f32x16& p, const char* Ks, int rowoff, const bf16x8* qr, const char* ldsb, int qxo, int r32, int hi) {
  p = f32x16{};
  const char* qx = ldsb + qxo;
#pragma unroll
  for (int d0 = 0; d0 < DK / 16; ++d0) { int cb = (d0 * 16 + hi * 8) * 2;
    bf16x8 b0 = *reinterpret_cast<const bf16x8*>(Ks + kswz<DK>(rowoff + r32, cb));
    bf16x8 qf; if (d0 < 8) qf = qr[d0]; else qf = *reinterpret_cast<const bf16x8*>(qx + (d0 - 8) * 1024);
    p = __builtin_amdgcn_mfma_f32_32x32x16_bf16(b0, qf, p, 0, 0, 0); }
}
template <int KH> __device__ __forceinline__ void pv_half(f32x16* o, int vb, bf16x8 pa, bf16x8 pb) {
#define ATT_PK(L, H) (bf16x8){L[0], L[1], L[2], L[3], H[0], H[1], H[2], H[3]}
#define ATT_PVD(D0) do { const s16x4 l0 = tr_read<v_rd_off(D0, 2 * KH, 0)>(vb), h0 = tr_read<v_rd_off(D0, 2 * KH, 1)>(vb), l1 = tr_read<v_rd_off(D0, 2 * KH + 1, 0)>(vb), h1 = tr_read<v_rd_off(D0, 2 * KH + 1, 1)>(vb); \
    asm volatile("s_waitcnt lgkmcnt(0)" ::: "memory"); ATT_SBAR();   \
    o[D0] = __builtin_amdgcn_mfma_f32_32x32x16_bf16(pa, ATT_PK(l0, h0), o[D0], 0, 0, 0); o[D0] = __builtin_amdgcn_mfma_f32_32x32x16_bf16(pb, ATT_PK(l1, h1), o[D0], 0, 0, 0); } while (0)
  ATT_PVD(0); ATT_PVD(1); ATT_PVD(2); ATT_PVD(3);
#undef ATT_PVD
#undef ATT_PK
}
__device__ __forceinline__ float exp_pack(f32x16& p, bf16x8& pa, bf16x8& pb) {
#pragma unroll
  for (int r = 0; r < 16; ++r) p[r] = __builtin_amdgcn_exp2f(p[r]);
  float ps = 0.f;
#pragma unroll
  for (int r = 0; r < 16; ++r) ps += p[r];
#define ATT_PK4(P, BASE, OUT) do { unsigned a0 = cvtpk(P[BASE + 0], P[BASE + 1]), a1 = cvtpk(P[BASE + 2], P[BASE + 3]);   \
    unsigned b0 = cvtpk(P[BASE + 4], P[BASE + 5]), b1 = cvtpk(P[BASE + 6], P[BASE + 7]);                              \
    auto r0 = __builtin_amdgcn_permlane32_swap(a0, b0, false, false); auto r1 = __builtin_amdgcn_permlane32_swap(a1, b1, false, false); \
    u32x4 w = {r0[0], r1[0], r0[1], r1[1]}; OUT = *reinterpret_cast<bf16x8*>(&w); } while (0)
  ATT_PK4(p, 0, pa); ATT_PK4(p, 8, pb);
#undef ATT_PK4
  return ps;
}
template <int DK, int ldq, int ldk, int ldv, int ldo>
__device__ __forceinline__ void attn_body_nomax(const unsigned short* __restrict__ Qb, const unsigned short* __restrict__ Kh,
                                                const unsigned short* __restrict__ Vh, unsigned short* __restrict__ Ob, int seq, char* lds) {
  constexpr int SHM_V = Cfg<DK>::SHM_V, SHM_K = Cfg<DK>::SHM_K, NQ = (DK > 128 ? 8 : DK / 16), NKI = DK / 64;
  const int tid = tid_fresh(), wid = tid >> 6, lane = tid & 63, r32 = lane & 31, hi = lane >> 5;
  char* V_lds = lds; char* K_lds = lds + 2 * SHM_V;
  float* ws = (float*)(lds + 2 * SHM_V + 2 * SHM_K) + wid * 64; float* li_l = ws;
  float l_reg = 0; f32x16 o[4] = {}; bf16x8 qr[NQ];
  const unsigned short* Qw = Qb + (wid * QBLK + r32) * ldq + hi * 8;
#pragma unroll
  for (int d0 = 0; d0 < NQ; ++d0) qr[d0] = *reinterpret_cast<const bf16x8*>(Qw + d0 * 16);
  int qxo = 2 * SHM_V + 2 * SHM_K + NW * 64 * 4 + wid * 4096 + lane * 16; char* qx = lds + qxo;
  if constexpr (DK > 128) {
#pragma unroll
    for (int d0 = 8; d0 < DK / 16; ++d0) *reinterpret_cast<bf16x8*>(qx + (d0 - 8) * 1024) = *reinterpret_cast<const bf16x8*>(Qw + d0 * 16);
  }
  const int sr = tid >> 4, sc = (tid & 15) * 8, vst0 = v_st(sr, sc);
  const int vgo = sr * ldv + sc;
  const int kr = tid >> 3, kc8 = tid & 7, kgo = kr * ldk + kc8 * 8, kdst = kswz<DK>(kr, kc8 * 16);
  const int vb0 = (int)(uintptr_t)V_lds + v_rd_base(lane);
  bf16x8 vs0, vs1, ks[NKI];
#define ATT_SLOAD1(k0) do { const unsigned short* vt_ = Vh + (size_t)(k0) * ldv; const unsigned short* kt_ = Kh + (size_t)(k0) * ldk; \
    vs0 = *reinterpret_cast<const bf16x8*>(vt_ + vgo); vs1 = *reinterpret_cast<const bf16x8*>(vt_ + vgo + 32 * ldv); \
    _Pragma("unroll") for (int q_ = 0; q_ < NKI; ++q_) ks[q_] = *reinterpret_cast<const bf16x8*>(kt_ + kgo + 64 * q_); } while (0)
#define ATT_SWRITE1(b) do { *(bf16x8*)(V_lds + (b) * SHM_V + vst0) = vs0; *(bf16x8*)(V_lds + (b) * SHM_V + vst0 + 8192) = vs1; \
    _Pragma("unroll") for (int q_ = 0; q_ < NKI; ++q_) *(bf16x8*)(K_lds + (b) * SHM_K + kdst + 128 * q_) = ks[q_]; } while (0)
  const int NT = seq / KVBLK;
  ATT_SLOAD1(0); ATT_SWRITE1(0); __syncthreads();
#pragma unroll 1
  for (int j = 0; j < NT; ++j) {
    const int b = j & 1;
    f32x16 p0, p1; bf16x8 pa0, pa1, pa2, pa3;
    if (j + 1 < NT) ATT_SLOAD1((j + 1) * KVBLK);
    if constexpr (DK > 128) asm volatile("" : "+v"(qxo));
    ATT_SBAR();
    qk_half<DK>(p0, K_lds + b * SHM_K, 0, qr, lds, qxo, r32, hi);
    ATT_SBAR();
    qk_half<DK>(p1, K_lds + b * SHM_K, 32, qr, lds, qxo, r32, hi);
    float ps = exp_pack(p0, pa0, pa1);
    ATT_SBAR();
    pv_half<0>(o, vb0 + b * SHM_V, pa0, pa1);
    ps += exp_pack(p1, pa2, pa3);
    ATT_SBAR();
    pv_half<1>(o, vb0 + b * SHM_V, pa2, pa3);
    l_reg += ps;
    if (j + 1 < NT) ATT_SWRITE1(b ^ 1);
    __syncthreads();
  }
  { auto rr = __builtin_amdgcn_permlane32_swap(__float_as_uint(l_reg), __float_as_uint(l_reg), false, false); l_reg = __uint_as_float(rr[0]) + __uint_as_float(rr[1]); }
  if (hi == 0) li_l[r32] = l_reg; asm volatile("s_waitcnt lgkmcnt(0)" ::: "memory");
  float rli[16];
#pragma unroll
  for (int r = 0; r < 16; ++r) rli[r] = __builtin_amdgcn_rcpf(li_l[crow(r, hi)]);
  unsigned short* Ow = Ob + (wid * QBLK) * ldo;
#pragma unroll
  for (int r = 0; r < 16; ++r) { int orow = crow(r, hi);
#pragma unroll
    for (int d0 = 0; d0 < 4; ++d0) Ow[orow * ldo + d0 * 32 + r32] = (unsigned short)f2bf(o[d0][r] * rli[r]); }
  __syncthreads();
#undef ATT_SLOAD1
#undef ATT_SWRITE1
}

typedef float f32x4a __attribute__((ext_vector_type(4)));
__device__ __forceinline__ int v16_st(int key, int d) { return (((key >> 4) * 8 + (d >> 4)) * 4 + ((key >> 2) & 3)) * 128 + ((key & 3) * 16 + (d & 15)) * 2; }
template <int OFF> __device__ __forceinline__ s16x4 tr_read16(int vb) { s16x4 r; asm volatile("ds_read_b64_tr_b16 %0, %1 offset:%2" : "=&v"(r) : "v"(vb), "i"(OFF) : "memory"); return r; }
template <int NDS, int ST>
__device__ __forceinline__ void sgb_steps() {
  if constexpr (ST < 4 * NDS) {
    __builtin_amdgcn_sched_group_barrier(0x008, 2, 0);
    if constexpr (ST >= NDS) __builtin_amdgcn_sched_group_barrier(0x400, (((ST % NDS) + 1) * 8) / NDS - ((ST % NDS) * 8) / NDS, 0);
    if constexpr (ST + 4 < 4 * NDS) __builtin_amdgcn_sched_group_barrier(0x100, 1, 0);
    sgb_steps<NDS, ST + 1>();
  }
}
template <int DK, int ldq, int ldk, int ldv, int ldo>
__device__ __forceinline__ void attn_body16(const unsigned short* __restrict__ Qb, const unsigned short* __restrict__ Kh,
                                            const unsigned short* __restrict__ Vh, unsigned short* __restrict__ Ob, int seq, char* lds) {
  constexpr int SHM_V = KVBLK * DV * 2, KP = 2 * DK + 16, SHM_K = KVBLK * KP, NDS = DK / 32, NKI = DK / 64;
  const int tid = tid_fresh(), wid = tid >> 6, lane = tid & 63, c16 = lane & 15, g = lane >> 4;
  char* V_lds = lds; char* K_lds = lds + 2 * SHM_V;
  f32x4a ot[8][2]; float lsum[2] = {0.f, 0.f}; bf16x8 qf[2][NDS];
#pragma unroll
  for (int db = 0; db < 8; ++db) { ot[db][0] = (f32x4a){0.f, 0.f, 0.f, 0.f}; ot[db][1] = (f32x4a){0.f, 0.f, 0.f, 0.f}; }
#pragma unroll
  for (int qb = 0; qb < 2; ++qb)
#pragma unroll
    for (int ds = 0; ds < NDS; ++ds) qf[qb][ds] = *reinterpret_cast<const bf16x8*>(Qb + (wid * QBLK + 16 * qb + c16) * ldq + 32 * ds + 8 * g);
  const int sr = tid >> 4, sc = (tid & 15) * 8, vst0 = v16_st(sr, sc), vst1 = v16_st(32 + sr, sc);
  const int vgo = sr * ldv + sc;
  const int kr = tid >> 3, kc8 = tid & 7, kgo = kr * ldk + kc8 * 8, kdst = kr * KP + kc8 * 16;
  const int kfo = c16 * KP + 16 * g;
  const int vb0 = (int)(uintptr_t)V_lds + g * 128 + 8 * c16;
  bf16x8 vs0, vs1, ks[NKI];
#define A16_SLOAD(k0) do { const unsigned short* vt_ = Vh + (size_t)(k0) * ldv; const unsigned short* kt_ = Kh + (size_t)(k0) * ldk; \
    vs0 = *reinterpret_cast<const bf16x8*>(vt_ + vgo); vs1 = *reinterpret_cast<const bf16x8*>(vt_ + vgo + 32 * ldv); \
    _Pragma("unroll") for (int q_ = 0; q_ < NKI; ++q_) ks[q_] = *reinterpret_cast<const bf16x8*>(kt_ + kgo + 64 * q_); } while (0)
#define A16_SWRITE(b) do { *(bf16x8*)(V_lds + (b) * SHM_V + vst0) = vs0; *(bf16x8*)(V_lds + (b) * SHM_V + vst1) = vs1; \
    _Pragma("unroll") for (int q_ = 0; q_ < NKI; ++q_) *(bf16x8*)(K_lds + (b) * SHM_K + kdst + 128 * q_) = ks[q_]; } while (0)
  const int NT = seq / KVBLK;
  A16_SLOAD(0); A16_SWRITE(0); __syncthreads();
#pragma unroll 1
  for (int j = 0; j < NT; ++j) {
    const int b = j & 1;
    if (j + 1 < NT) A16_SLOAD((j + 1) * KVBLK);
    ATT_SBAR();
    f32x4a sct[4][2];
    const char* Kt = K_lds + b * SHM_K + kfo;
#define A16_EXP(kb_, e_) do { sct[kb_][(e_) >> 2][(e_) & 3] = __builtin_amdgcn_exp2f(sct[kb_][(e_) >> 2][(e_) & 3]); } while (0)
    bf16x8 kq[4];
#pragma unroll
    for (int s0 = 0; s0 < 3; ++s0) kq[s0] = *reinterpret_cast<const bf16x8*>(Kt + (s0 / NDS) * 16 * KP + (s0 % NDS) * 64);
#pragma unroll
    for (int kb = 0; kb < 4; ++kb) {
      sct[kb][0] = (f32x4a){0.f, 0.f, 0.f, 0.f}; sct[kb][1] = (f32x4a){0.f, 0.f, 0.f, 0.f};
#pragma unroll
      for (int ds = 0; ds < NDS; ++ds) { const int st = kb * NDS + ds, sn = st + 3;
        if (sn < 4 * NDS) kq[sn & 3] = *reinterpret_cast<const bf16x8*>(Kt + (sn / NDS) * 16 * KP + (sn % NDS) * 64);
        sct[kb][0] = __builtin_amdgcn_mfma_f32_16x16x32_bf16(kq[st & 3], qf[0][ds], sct[kb][0], 0, 0, 0);
        sct[kb][1] = __builtin_amdgcn_mfma_f32_16x16x32_bf16(kq[st & 3], qf[1][ds], sct[kb][1], 0, 0, 0);
        if (kb > 0) {
#pragma unroll
          for (int e = (ds * 8) / NDS; e < ((ds + 1) * 8) / NDS; ++e) A16_EXP(kb > 0 ? kb - 1 : 0, e); }
        ATT_SBAR(); } }
    bf16x8 pf[2][2];
#define A16_PACK(ksp_) do { _Pragma("unroll") for (int qb = 0; qb < 2; ++qb) { u32x4 w; w.x = cvtpk(sct[2 * (ksp_)][qb][0], sct[2 * (ksp_)][qb][1]); w.y = cvtpk(sct[2 * (ksp_)][qb][2], sct[2 * (ksp_)][qb][3]); \
        w.z = cvtpk(sct[2 * (ksp_) + 1][qb][0], sct[2 * (ksp_) + 1][qb][1]); w.w = cvtpk(sct[2 * (ksp_) + 1][qb][2], sct[2 * (ksp_) + 1][qb][3]); pf[qb][ksp_] = __builtin_bit_cast(bf16x8, w); \
        lsum[qb] += ((sct[2 * (ksp_)][qb][0] + sct[2 * (ksp_)][qb][1]) + (sct[2 * (ksp_)][qb][2] + sct[2 * (ksp_)][qb][3])) + ((sct[2 * (ksp_) + 1][qb][0] + sct[2 * (ksp_) + 1][qb][1]) + (sct[2 * (ksp_) + 1][qb][2] + sct[2 * (ksp_) + 1][qb][3])); } } while (0)
    const int vb = vb0 + b * SHM_V;
    s16x4 ta[4][2], tb[4][2];
#define A16_RD(T, KSP, DB0) do { \
      T[0][0] = tr_read16<(2 * KSP) * 4096 + (DB0 + 0) * 512>(vb); T[0][1] = tr_read16<(2 * KSP + 1) * 4096 + (DB0 + 0) * 512>(vb); \
      T[1][0] = tr_read16<(2 * KSP) * 4096 + (DB0 + 1) * 512>(vb); T[1][1] = tr_read16<(2 * KSP + 1) * 4096 + (DB0 + 1) * 512>(vb); \
      T[2][0] = tr_read16<(2 * KSP) * 4096 + (DB0 + 2) * 512>(vb); T[2][1] = tr_read16<(2 * KSP + 1) * 4096 + (DB0 + 2) * 512>(vb); \
      T[3][0] = tr_read16<(2 * KSP) * 4096 + (DB0 + 3) * 512>(vb); T[3][1] = tr_read16<(2 * KSP + 1) * 4096 + (DB0 + 3) * 512>(vb); } while (0)
#define A16_WAIT() do { asm volatile("s_waitcnt lgkmcnt(0)" ::: "memory"); ATT_SBAR(); } while (0)
#define A16_MM(T, KSP, DB0, X) do { \
      _Pragma("unroll") for (int d_ = 0; d_ < 4; ++d_) { const bf16x8 vf = (bf16x8){T[d_][0][0], T[d_][0][1], T[d_][0][2], T[d_][0][3], T[d_][1][0], T[d_][1][1], T[d_][1][2], T[d_][1][3]}; \
        ot[DB0 + d_][0] = __builtin_amdgcn_mfma_f32_16x16x32_bf16(vf, pf[0][KSP], ot[DB0 + d_][0], 0, 0, 0); \
        ot[DB0 + d_][1] = __builtin_amdgcn_mfma_f32_16x16x32_bf16(vf, pf[1][KSP], ot[DB0 + d_][1], 0, 0, 0); } X; ATT_SBAR(); } while (0)
#define A16_PIN(qb_) asm volatile("" : "+v"(sct[3][qb_][0]), "+v"(sct[3][qb_][1]), "+v"(sct[3][qb_][2]), "+v"(sct[3][qb_][3]))
    A16_RD(ta, 0, 0);
    ATT_SBAR();
    A16_PACK(0);
    ATT_SBAR();
    A16_WAIT();
    A16_RD(tb, 0, 4); ATT_SBAR();
    A16_MM(ta, 0, 0, { A16_PIN(0); A16_EXP(3, 0); A16_EXP(3, 1); A16_EXP(3, 2); A16_EXP(3, 3); A16_PIN(0); });
    A16_WAIT();
    A16_RD(ta, 1, 0); ATT_SBAR();
    A16_MM(tb, 0, 4, { A16_PIN(1); A16_EXP(3, 4); A16_EXP(3, 5); A16_EXP(3, 6); A16_EXP(3, 7); A16_PIN(1); });
    A16_PACK(1);
    ATT_SBAR();
    A16_WAIT();
    A16_RD(tb, 1, 4); ATT_SBAR();
    A16_MM(ta, 1, 0, {});
    A16_WAIT();
    A16_MM(tb, 1, 4, {});
#undef A16_PIN
#undef A16_RD
#undef A16_WAIT
#undef A16_MM
#undef A16_PACK
#undef A16_EXP
    if (j + 1 < NT) A16_SWRITE(b ^ 1);
    __syncthreads();
  }
#pragma unroll
  for (int qb = 0; qb < 2; ++qb) { float l = lsum[qb]; l += __shfl_xor(l, 16); l += __shfl_xor(l, 32); const float rl = __builtin_amdgcn_rcpf(l);
    unsigned short* Or = Ob + (wid * QBLK + 16 * qb + c16) * ldo + 4 * g;
#pragma unroll
    for (int db = 0; db < 8; ++db) { typedef unsigned u32x2a __attribute__((ext_vector_type(2)));
      u32x2a w; w.x = pk2(ot[db][qb][0] * rl, ot[db][qb][1] * rl); w.y = pk2(ot[db][qb][2] * rl, ot[db][qb][3] * rl);
      *(u32x2a*)(Or + 16 * db) = w; } }
  __syncthreads();
#undef A16_SLOAD
#undef A16_SWRITE
}
#undef ATT_SBAR
}
namespace hy {
using bf16x8 = __attribute__((ext_vector_type(8))) short;
using f32x16 = __attribute__((ext_vector_type(16))) float;
using u32x4  = __attribute__((ext_vector_type(4))) unsigned;
using u32x2  = __attribute__((ext_vector_type(2))) unsigned;
template <int L> struct HC {
    static constexpr int NMB = L / 2048, NCH = (L == 4096) ? 2 : 4, UST = L + 160, GRN = 2 * L / 64 * 72;
    static constexpr int UB = 4 * UST * 2, GB = GRN * 2, CHB = UB + GB, NK4 = L / 64 + 1;
    static_assert(NCH * CHB <= RING_BYTES, "hyena LDS");
};
__device__ __forceinline__ int crow(int r, int hi) { return (r & 3) + 8 * (r >> 2) + 4 * hi; }
__device__ __forceinline__ float bf2f(unsigned short v) { return __uint_as_float((unsigned)v << 16); }

typedef float f32x4h __attribute__((ext_vector_type(4)));
template <int L>
__device__ __forceinline__ void conv_kloop16(f32x4h (&acc)[2][8], const LAS char* gA, const LAS char* uB) {
    constexpr int NK2 = L / 64 + 1;
#pragma unroll
    for (int a = 0; a < 2; ++a)
#pragma unroll
        for (int r = 0; r < 8; ++r) acc[a][r] = (f32x4h){0.f, 0.f, 0.f, 0.f};
    for (int kk2 = 0; kk2 < NK2; ++kk2) {
#pragma unroll
        for (int h = 0; h < 2; ++h) {
            const bf16x8 A = *(const LAS bf16x8*)(gA + kk2 * 144 + h * 64);
#pragma unroll
            for (int nh = 0; nh < 2; ++nh) {
                const u32x4 w0 = *(const LAS u32x4*)(uB + kk2 * 128 + h * 64 + nh * 64);
                const u32x4 w1 = *(const LAS u32x4*)(uB + kk2 * 128 + h * 64 + nh * 64 + 16);
                const unsigned w[8] = {w0.x, w0.y, w0.z, w0.w, w1.x, w1.y, w1.z, w1.w};
#pragma unroll
                for (int r = 0; r < 8; ++r) { u32x4 bf;
                    if ((r & 1) == 0) { const int q = r >> 1; bf = (u32x4){w[q], w[q + 1], w[q + 2], w[q + 3]}; }
                    else { const int q = (r - 1) >> 1;
                        bf = (u32x4){__builtin_amdgcn_alignbit(w[q + 1], w[q], 16), __builtin_amdgcn_alignbit(w[q + 2], w[q + 1], 16),
                                     __builtin_amdgcn_alignbit(w[q + 3], w[q + 2], 16), __builtin_amdgcn_alignbit(w[q + 4], w[q + 3], 16)}; }
                    acc[nh][r] = __builtin_amdgcn_mfma_f32_16x16x32_bf16(A, __builtin_bit_cast(bf16x8, bf), acc[nh][r], 0, 0, 0); }
            }
        }
    }
}

template <int L>
__device__ __forceinline__ void hyena_unit(LAS char* lds, const unsigned short* GFl, const unsigned short* X1T, const unsigned short* X2T, const unsigned short* VT,
                                           unsigned short* Y2T, const float* skip  , int b0, int c0) {
    using C = HC<L>;
    constexpr int NCH = C::NCH, UST = C::UST, GRN = C::GRN, UB = C::UB, GB = C::GB, CHB = C::CHB, WPC = 8 / NCH;
    static_assert(L / 1024 == WPC, "one wave per (channel, 1024-output block)");
    const int tid = tid_fresh(), wid = __builtin_amdgcn_readfirstlane(tid >> 6), lane = tid & 63;
    const int ch = wid / WPC, Mb = wid % WPC;
    const int c16 = lane & 15, g = lane >> 4, np = c16 >> 2, bb = c16 & 3;
    LAS char* Uch = lds + ch * CHB; LAS char* Gch = Uch + UB;
    const LAS char* gA = Gch + 2 * ((L / 64 - 16 * Mb - c16 - 1) * 72 + 8 * g);
    const LAS char* uB = Uch + 2 * (bb * UST + 8 * g + 8 * np);
    const int c = c0 + ch;
    u32x4 y1p[2][4];
#pragma unroll 1
    for (int o = 0; o < 2; ++o) {
        { constexpr int NG = NCH * (GB / 16), NGI = (NG + NTHR - 1) / NTHR; u32x4 gv[NGI];
#pragma unroll
          for (int i = 0; i < NGI; ++i) { const int id = tid + i * NTHR, cc = id / (GB / 16), off = id % (GB / 16);
              gv[i] = (id < NG) ? *(const u32x4*)((const char*)(GFl + ((size_t)(o * 512 + c0 + cc)) * GRN) + off * 16) : (u32x4){0u, 0u, 0u, 0u}; }
          if (o == 0) {
              constexpr int NU = NCH * 4 * (L / 8), NUI = NU / NTHR; static_assert(NU % NTHR == 0, "u staging"); u32x4 uv_[NUI];
#pragma unroll
              for (int i = 0; i < NUI; ++i) { const int id = tid + i * NTHR, cb = id / (L / 8), off = id % (L / 8), cc = cb >> 2, b = cb & 3;
                  uv_[i] = *(const u32x4*)(VT + xt_off(b0 + b, c0 + cc) + off * 8); }
#pragma unroll
              for (int i = 0; i < NUI; ++i) { const int id = tid + i * NTHR, cb = id / (L / 8), off = id % (L / 8), cc = cb >> 2, b = cb & 3;
                  *(LAS u32x4*)(lds + cc * CHB + (b * UST + 64) * 2 + off * 16) = uv_[i]; }
              for (int id = tid; id < NCH * 4 * 20; id += NTHR) { const int cb = id / 20, k = id % 20, cc = cb >> 2, b = cb & 3;
                  const int el = k < 8 ? k * 8 : (L + 64) + (k - 8) * 8;
                  *(LAS u32x4*)(lds + cc * CHB + (b * UST + el) * 2) = (u32x4){0u, 0u, 0u, 0u}; }
          }
#pragma unroll
          for (int i = 0; i < NGI; ++i) { const int id = tid + i * NTHR, cc = id / (GB / 16), off = id % (GB / 16);
              if (id < NG) *(LAS u32x4*)(lds + cc * CHB + UB + off * 16) = gv[i]; } }
        if (o == 1) {
#pragma unroll
            for (int nh = 0; nh < 2; ++nh)
#pragma unroll
                for (int i = 0; i < 4; ++i) { const int t0 = 1024 * Mb + 64 * (4 * g + i) + 32 * nh + 8 * np;
                    *(LAS u32x4*)(Uch + (bb * UST + 64 + t0) * 2) = y1p[nh][i]; }
        }
        __syncthreads();
        f32x4h acc[2][8];
        conv_kloop16<L>(acc, gA, uB);
        const float sk = skip[o * 512 + c];
        const unsigned short* XT = (o == 0) ? X1T : X2T;
        const size_t gbase = xt_off(b0 + bb, c);
        u32x4 xvs[2][4];
#pragma unroll
        for (int nh = 0; nh < 2; ++nh)
#pragma unroll
            for (int i = 0; i < 4; ++i) { const int t0 = 1024 * Mb + 64 * (4 * g + i) + 32 * nh + 8 * np; xvs[nh][i] = *(const u32x4*)(XT + gbase + t0); }
#pragma unroll
        for (int nh = 0; nh < 2; ++nh)
#pragma unroll
            for (int i = 0; i < 4; ++i) { const int t0 = 1024 * Mb + 64 * (4 * g + i) + 32 * nh + 8 * np;
                const u32x4 xv = xvs[nh][i];
                const u32x4 uv = *(const LAS u32x4*)(Uch + (bb * UST + 64 + t0) * 2);
                const unsigned xw[4] = {xv.x, xv.y, xv.z, xv.w}, uw[4] = {uv.x, uv.y, uv.z, uv.w}; unsigned pw[4];
#pragma unroll
                for (int q = 0; q < 4; ++q) {
                    const float ylo = bf2f((unsigned short)(xw[q] & 0xffff)) * (acc[nh][2 * q][i] + sk * bf2f((unsigned short)(uw[q] & 0xffff)));
                    const float yhi = bf2f((unsigned short)(xw[q] >> 16)) * (acc[nh][2 * q + 1][i] + sk * bf2f((unsigned short)(uw[q] >> 16)));
                    pw[q] = pk2(ylo, yhi); }
                const u32x4 p = (u32x4){pw[0], pw[1], pw[2], pw[3]};
                if (o == 0) y1p[nh][i] = p;
                else *(u32x4*)(Y2T + gbase + t0) = p; }
        __syncthreads();
    }
}
}
typedef unsigned u32x2v __attribute__((ext_vector_type(2)));
__device__ __forceinline__ float bf2f(unsigned short v) { return __uint_as_float((unsigned)v << 16); }
__device__ __forceinline__ float bflo(unsigned w) { return __uint_as_float(w << 16); }
__device__ __forceinline__ float bfhi(unsigned w) { return __uint_as_float(w & 0xffff0000u); }
__device__ __forceinline__ float wave_sum(float v) {
#pragma unroll
    for (int o = 1; o < 64; o <<= 1) v += __shfl_xor(v, o);
    return v;
}
__device__ __forceinline__ void unpack8(const v4u& w, float (&f)[8]) {
    f[0] = bflo(w.x); f[1] = bfhi(w.x); f[2] = bflo(w.y); f[3] = bfhi(w.y); f[4] = bflo(w.z); f[5] = bfhi(w.z); f[6] = bflo(w.w); f[7] = bfhi(w.w);
}
__device__ __forceinline__ v4u pack8(const float (&f)[8]) { v4u w; w.x = pk2(f[0], f[1]); w.y = pk2(f[2], f[3]); w.z = pk2(f[4], f[5]); w.w = pk2(f[6], f[7]); return w; }

__device__ __forceinline__ void norm_rows(const float* xa, const float* xb, const float* g, const float* mod  , int sh_off, int sc_off, bf16* H, int gw, int ngw, int lane) {
    for (int ck = gw; ck < NTOK / 4; ck += ngw) {
        const int row0 = ck * 4, b = row_batch(row0);
        const float* xin = row0 < NPR ? xa : xb;
        const float* sc = mod + (size_t)b * MODW + sc_off; const float* sh = mod + (size_t)b * MODW + sh_off;
        f32x4 ga[8], sb[8];
#pragma unroll
        for (int j = 0; j < 8; ++j) { const int col = 4 * lane + 256 * j; const f32x4 gg = *(const f32x4*)(g + col), s1 = *(const f32x4*)(sc + col);
            ga[j] = gg * (s1 + 1.0f); sb[j] = *(const f32x4*)(sh + col); }
#pragma unroll 1
        for (int r = 0; r < 4; ++r) {
            const float* xr = xin + (size_t)(row0 + r) * DM;
            f32x4 v[8]; float ss = 0.f;
#pragma unroll
            for (int j = 0; j < 8; ++j) { v[j] = *(const f32x4*)(xr + 4 * lane + 256 * j); ss += (v[j].x * v[j].x + v[j].y * v[j].y) + (v[j].z * v[j].z + v[j].w * v[j].w); }
            const float rs = rsqrtf(wave_sum(ss) * (1.0f / DM) + EPS);
            bf16* hr = H + (size_t)(row0 + r) * DM;
#pragma unroll
            for (int j = 0; j < 8; ++j) { const f32x4 o = v[j] * rs * ga[j] + sb[j]; u32x2v w; w.x = pk2(o.x, o.y); w.y = pk2(o.z, o.w);
                *(u32x2v*)(hr + 4 * lane + 256 * j) = w; }
        }
    }
}

struct PostIn { v4u v, qa, ckv, h1, h2; };
__device__ __forceinline__ PostIn post_load(const bf16* P, int lane) {
    PostIn in; const int head = lane >> 3, sub = lane & 7, sec = sub >> 2, chk = sub & 3, hh = head < 6 ? head : 0;
    in.v = *(const v4u*)(P + 512 + 8 * lane); in.qa = *(const v4u*)(P + C_D + 8 * lane); in.ckv = *(const v4u*)(P + C_D + 512 + 8 * (lane & 31));
    const bf16* hp = P + C_C + hh * 128 + 64 * sec + 8 * chk; in.h1 = *(const v4u*)hp; in.h2 = *(const v4u*)(hp + 32); return in;
}
__device__ __forceinline__ void post_finish(const PostIn& in, bf16* P, int pos, const float* vng, const float* qng, const float* kng, const float* qag, const float* kvag, int lane, bool st = true) {
    { float f[8]; unpack8(in.v, f);
      float s = 0.f;
#pragma unroll
      for (int i = 0; i < 8; ++i) s += f[i];
      const float mean = wave_sum(s) * (1.0f / 512.0f); float q = 0.f;
#pragma unroll
      for (int i = 0; i < 8; ++i) { f[i] -= mean; q += f[i] * f[i]; }
      const float rs = rsqrtf(wave_sum(q) * (1.0f / 512.0f) + EPS);
      const f32x4 g0 = *(const f32x4*)(vng + 8 * lane), g1 = *(const f32x4*)(vng + 8 * lane + 4);
      f[0] *= rs * g0.x; f[1] *= rs * g0.y; f[2] *= rs * g0.z; f[3] *= rs * g0.w; f[4] *= rs * g1.x; f[5] *= rs * g1.y; f[6] *= rs * g1.z; f[7] *= rs * g1.w;
      if (st) *(v4u*)(P + 512 + 8 * lane) = pack8(f); }
    { float f[8]; unpack8(in.qa, f); float q = 0.f;
#pragma unroll
      for (int i = 0; i < 8; ++i) q += f[i] * f[i];
      const float rs = rsqrtf(wave_sum(q) * (1.0f / 512.0f) + EPS);
#pragma unroll
      for (int i = 0; i < 8; ++i) f[i] *= rs * qag[8 * lane + i];
      if (st) *(v4u*)(P + C_D + 8 * lane) = pack8(f); }
    { const int l32 = lane & 31; float f[8]; unpack8(in.ckv, f); float q = 0.f;
#pragma unroll
      for (int i = 0; i < 8; ++i) q += f[i] * f[i];
      const float rs = rsqrtf(wave_sum(q) * (0.5f / 256.0f) + EPS);
#pragma unroll
      for (int i = 0; i < 8; ++i) f[i] *= rs * kvag[8 * l32 + i];
      if (st && lane < 32) *(v4u*)(P + C_D + 512 + 8 * l32) = pack8(f); }
    { const int head = lane >> 3, sub = lane & 7, sec = sub >> 2, chk = sub & 3; const bool on = head < 6;
      const int hh = on ? head : 0;
      bf16* hp = P + C_C + hh * 128 + 64 * sec + 8 * chk;
      float a[8], c[8]; unpack8(in.h1, a); unpack8(in.h2, c);
      float q = 0.f;
#pragma unroll
      for (int i = 0; i < 8; ++i) q += a[i] * a[i] + c[i] * c[i];
      q += __shfl_xor(q, 1); q += __shfl_xor(q, 2); q += __shfl_xor(q, 4);
      const float rs = rsqrtf(q * (1.0f / 128.0f) + EPS);
      const float* gg = (hh < 4 ? qng : kng) + 64 * sec + 8 * chk;
      const float p = (float)(sec ? (pos & 63) : (pos >> 6));
#pragma unroll
      for (int i = 0; i < 8; ++i) {
          const float x1 = a[i] * rs * gg[i], x2 = c[i] * rs * gg[32 + i];
          const float inv = __expf(-(float)(2 * (8 * chk + i)) * (9.210340371976184f / 64.0f));
          float sn, cs; __sincosf(p * inv, &sn, &cs);
          const float qs = (hh < 4) ? 0.12751743082459868f : 1.0f;
          a[i] = (x1 * cs - x2 * sn) * qs; c[i] = (x2 * cs + x1 * sn) * qs; }
      if (st && on) { *(v4u*)hp = pack8(a); *(v4u*)(hp + 32) = pack8(c); } }
}
__device__ __forceinline__ void post_rows(bf16* PROJp, const float* vng, const float* qng, const float* kng, const float* qag, const float* kvag, int gw, int ngw, int lane, bool st) {
    int row = gw; if (row >= NTOK) return;
    PostIn cur = post_load(PROJp + (size_t)row * INCP, lane);
    for (; row < NTOK; row += ngw) { const int nr = row + ngw; PostIn nxt = cur;
        if (nr < NTOK) nxt = post_load(PROJp + (size_t)nr * INCP, lane);
        post_finish(cur, PROJp + (size_t)row * INCP, row_pos(row), vng, qng, kng, qag, kvag, lane, st); cur = nxt; }
}

struct MlaIn { v4u n[2], a[2], c[2]; };
__device__ __forceinline__ MlaIn mla_load(const bf16* Qr, const bf16* KVr, const bf16* krope, int lane) {
    MlaIn in; const int head = lane >> 4, sub = lane & 15; const bool rp = sub < 4; const int sec = (sub >> 1) & 1, chk = sub & 1, x1o = 128 + 32 * sec + 8 * chk;
    in.n[0] = *(const v4u*)(Qr + head * 192 + 8 * sub); in.n[1] = *(const v4u*)(KVr + head * 256 + 8 * sub);
    in.a[0] = in.c[0] = in.a[1] = in.c[1] = (v4u){0u, 0u, 0u, 0u};
    if (rp) { in.a[0] = *(const v4u*)(Qr + head * 192 + x1o); in.c[0] = *(const v4u*)(Qr + head * 192 + x1o + 16);
              in.a[1] = *(const v4u*)(krope + 32 * sec + 8 * chk); in.c[1] = *(const v4u*)(krope + 32 * sec + 8 * chk + 16); }
    return in;
}
__device__ __forceinline__ void mla_finish(const MlaIn& in, bf16* Qr, bf16* Kr, int pos, const float* qng, const float* kng, int lane, bool st = true) {
    const int head = lane >> 4, sub = lane & 15;
    const bool rp = sub < 4; const int sec = (sub >> 1) & 1, chk = sub & 1;
    const int x1o = 128 + 32 * sec + 8 * chk;
    const float p = (float)(sec ? (pos & 63) : (pos >> 6));
#pragma unroll
    for (int which = 0; which < 2; ++which) {
        const float* g = which == 0 ? qng : kng;
        bf16* dst = (which == 0 ? Qr : Kr) + head * 192;
        float n[8], a[8], c[8]; unpack8(in.n[which], n); unpack8(in.a[which], a); unpack8(in.c[which], c);
        float q = 0.f;
#pragma unroll
        for (int i = 0; i < 8; ++i) q += n[i] * n[i] + a[i] * a[i] + c[i] * c[i];
        q += __shfl_xor(q, 1); q += __shfl_xor(q, 2); q += __shfl_xor(q, 4); q += __shfl_xor(q, 8);
        const float rs = rsqrtf(q * (1.0f / 192.0f) + EPS);
        const float qs = (which == 0) ? 0.10411755155693222f : 1.0f;
#pragma unroll
        for (int i = 0; i < 8; ++i) n[i] *= rs * g[8 * sub + i] * qs;
        if (st) *(v4u*)(dst + 8 * sub) = pack8(n);
        if (rp) {
#pragma unroll
            for (int i = 0; i < 8; ++i) {
                const float x1 = a[i] * rs * g[x1o + i], x2 = c[i] * rs * g[x1o + 16 + i];
                const float inv = __expf(-(float)(2 * (8 * chk + i)) * (9.210340371976184f / 32.0f));
                float sn, cs; __sincosf(p * inv, &sn, &cs);
                a[i] = (x1 * cs - x2 * sn) * qs; c[i] = (x2 * cs + x1 * sn) * qs; }
            if (st) { *(v4u*)(dst + x1o) = pack8(a); *(v4u*)(dst + x1o + 16) = pack8(c); } }
    }
}
__device__ __forceinline__ void mla_rows(bf16* QDp, const bf16* KVDp, const bf16* PROJp, bf16* KMp, const float* qng, const float* kng, int gw, int ngw, int lane, bool st) {
    int row = gw; if (row >= NTOK) return;
    MlaIn cur = mla_load(QDp + (size_t)row * 768, KVDp + (size_t)row * 1024, PROJp + (size_t)row * INCP + C_D + 768, lane);
    for (; row < NTOK; row += ngw) { const int nr = row + ngw; MlaIn nxt = cur;
        if (nr < NTOK) nxt = mla_load(QDp + (size_t)nr * 768, KVDp + (size_t)nr * 1024, PROJp + (size_t)nr * INCP + C_D + 768, lane);
        mla_finish(cur, QDp + (size_t)row * 768, KMp + (size_t)row * 768, row_pos(row), qng, kng, lane, st); cur = nxt; }
}

__device__ __forceinline__ void hyconv_tile(LAS unsigned char* lds, const bf16* PROJ, bf16* XT, const float* cw  , const float* cb  , int tile, int tid) {
    const int which = tile % 3, tb = tile / 3, row0 = tb * 64, b = row_batch(row0), pos0 = row_pos(row0), Lb = batch_len(b);
    constexpr int PITCH = 260;
    LAS unsigned* raw = (LAS unsigned*)lds;
    { v4u w[9];
#pragma unroll
      for (int i = 0; i < 9; ++i) { const int id = tid + i * NTHR, r = id >> 6, k = id & 63, p = pos0 - 1 + r;
          w[i] = (v4u){0u, 0u, 0u, 0u};
          if (id < 66 * 64 && p >= 0 && p < Lb) w[i] = *(const v4u*)(PROJ + (size_t)(row0 - 1 + r) * INCP + C_B + which * 512 + 8 * k); }
#pragma unroll
      for (int i = 0; i < 9; ++i) { const int id = tid + i * NTHR, r = id >> 6, k = id & 63;
          if (id < 66 * 64) *(LAS v4u*)(raw + r * PITCH + 4 * k) = w[i]; } }
    __syncthreads();
    { const int c = tid, col = which * 512 + c; const float w0 = cw[col], w1 = cw[1536 + col], w2 = cw[3072 + col], bb = cb[col];
      const LAS unsigned short* rc = (const LAS unsigned short*)raw + c;
      bf16* dst = XT + (size_t)which * ((size_t)NTOK * 512) + xt_off(b, c) + pos0;
      float xm = bf2f(rc[0]), x0 = bf2f(rc[2 * PITCH]);
#pragma unroll 2
      for (int k = 0; k < 8; ++k) { float z[8];
#pragma unroll
          for (int i = 0; i < 8; ++i) { const float xp = bf2f(rc[(8 * k + i + 2) * 2 * PITCH]); z[i] = w0 * xm + w1 * x0 + w2 * xp + bb; xm = x0; x0 = xp; }
          *(v4u*)(dst + 8 * k) = pack8(z); } }
    __syncthreads();
}

__device__ __forceinline__ void gnorm_tile(LAS unsigned char* lds, const bf16* __restrict__ YCAT, const bf16* __restrict__ Y2T, const float* __restrict__ gg  , bf16* __restrict__ YN, int tile, int tid) {
    const int row0 = tile * 32, b = row_batch(row0), pos0 = row_pos(row0), lane = tid & 63, wid = tid >> 6;
    constexpr int PITCH = 17;
    LAS unsigned* yb = (LAS unsigned*)lds;
    { v4u yw[4];
#pragma unroll
      for (int i = 0; i < 4; ++i) { const int id = tid + i * NTHR, c = id >> 2, k = id & 3; yw[i] = *(const v4u*)(Y2T + xt_off(b, c) + pos0 + 8 * k); }
#pragma unroll
      for (int i = 0; i < 4; ++i) { const int id = tid + i * NTHR, c = id >> 2, k = id & 3; LAS unsigned* d = yb + c * PITCH + 4 * k; d[0] = yw[i].x; d[1] = yw[i].y; d[2] = yw[i].z; d[3] = yw[i].w; } }
    __syncthreads();
#pragma unroll 2
    for (int r = 0; r < 4; ++r) { const int t = wid * 4 + r, row = row0 + t;
        const bf16* yr = YCAT + (size_t)row * DM; bf16* on = YN + (size_t)row * DM;
#pragma unroll
        for (int grp = 0; grp < 4; ++grp) {
            if (grp == 1) {
                float f[8]; float q = 0.f;
#pragma unroll
                for (int i = 0; i < 8; ++i) { f[i] = bf2f(((const LAS unsigned short*)yb)[(lane + 64 * i) * 2 * PITCH + t]); q += f[i] * f[i]; }
                const float rs = rsqrtf(wave_sum(q) * (1.0f / 512.0f) + EPS);
#pragma unroll
                for (int i = 0; i < 8; ++i) on[512 + lane + 64 * i] = (bf16)f2bf(f[i] * rs * gg[512 + lane + 64 * i]);
            } else {
                v4u w = *(const v4u*)(yr + grp * 512 + 8 * lane); float f[8]; unpack8(w, f); float q = 0.f;
#pragma unroll
                for (int i = 0; i < 8; ++i) q += f[i] * f[i];
                const float rs = rsqrtf(wave_sum(q) * (1.0f / 512.0f) + EPS);
                const f32x4 g0 = *(const f32x4*)(gg + grp * 512 + 8 * lane), g1 = *(const f32x4*)(gg + grp * 512 + 8 * lane + 4);
                f[0] *= rs * g0.x; f[1] *= rs * g0.y; f[2] *= rs * g0.z; f[3] *= rs * g0.w; f[4] *= rs * g1.x; f[5] *= rs * g1.y; f[6] *= rs * g1.z; f[7] *= rs * g1.w;
                *(v4u*)(on + grp * 512 + 8 * lane) = pack8(f);
            }
        }
    }
    __syncthreads();
}

__device__ __forceinline__ void ffn_gate(const bf16* Z, bf16* A, const float* cw  , const float* cb  , int gt, int ngt) {
    constexpr int NCK = DFF / 8;
    for (int it = gt; it < (NTOK / 16) * NCK; it += ngt) {
        const int rb = it / NCK, ck = it % NCK, row0 = rb * 16, j0 = ck * 8;
        const int pos0 = row_pos(row0), Lb = batch_len(row_batch(row0));
        float wg[3][8], wu[3][8], bg[8], bu[8];
#pragma unroll
        for (int k = 0; k < 3; ++k)
#pragma unroll
            for (int i = 0; i < 8; ++i) { wg[k][i] = cw[k * DFF2 + j0 + i]; wu[k][i] = cw[k * DFF2 + DFF + j0 + i]; }
#pragma unroll
        for (int i = 0; i < 8; ++i) { bg[i] = cb[j0 + i]; bu[i] = cb[DFF + j0 + i]; }
        float gm[8], g0[8], um[8], u0[8];
        const bf16* zr = Z + (size_t)row0 * DFF2 + j0;
        if (pos0 > 0) { v4u a = *(const v4u*)(zr - DFF2), c = *(const v4u*)(zr - DFF2 + DFF); unpack8(a, gm); unpack8(c, um); }
        else {
#pragma unroll
            for (int i = 0; i < 8; ++i) { gm[i] = 0.f; um[i] = 0.f; } }
        { v4u a = *(const v4u*)zr, c = *(const v4u*)(zr + DFF); unpack8(a, g0); unpack8(c, u0); }
#pragma unroll 1
        for (int r = 0; r < 16; ++r) {
            float gp[8], up[8];
            if (pos0 + r + 1 < Lb) { v4u a = *(const v4u*)(zr + (size_t)(r + 1) * DFF2), c = *(const v4u*)(zr + (size_t)(r + 1) * DFF2 + DFF); unpack8(a, gp); unpack8(c, up); }
            else {
#pragma unroll
                for (int i = 0; i < 8; ++i) { gp[i] = 0.f; up[i] = 0.f; } }
            float o[8];
#pragma unroll
            for (int i = 0; i < 8; ++i) {
                const float gc = wg[0][i] * gm[i] + wg[1][i] * g0[i] + wg[2][i] * gp[i] + bg[i];
                const float uc = wu[0][i] * um[i] + wu[1][i] * u0[i] + wu[2][i] * up[i] + bu[i];
                o[i] = gc * __builtin_amdgcn_rcpf(1.0f + __expf(-gc)) * uc;
                gm[i] = g0[i]; g0[i] = gp[i]; um[i] = u0[i]; u0[i] = up[i]; }
            *(v4u*)(A + (size_t)(row0 + r) * DFF + j0) = pack8(o);
        }
    }
}

__device__ __forceinline__ void gate_fix(const float* ZH, bf16* A, const float* cw, const float* cb, int gt, int ngt) {
    constexpr int NQ4 = DFF / 4;
    for (int it = gt; it < 192 * NQ4; it += ngt) {
        const int rs = it / NQ4, q4 = it % NQ4, pm = rs >> 1, s = rs & 1, row = pm * 256 + (s ? 255 : 0), pos = row_pos(row), Lb = batch_len(row_batch(row));
        if (s == 0 ? (pos == 0) : (pos + 1 == Lb)) continue;
        const int j = q4 * 4, zc = 256 * (j >> 7) + (j & 127);
        const float* zp = s == 0 ? ZH + ((size_t)(pm - 1) * 4 + 3) * DFF2 : ZH + ((size_t)pm * 4 + 2) * DFF2;
        const float* z0 = s == 0 ? ZH + ((size_t)pm * 4 + 0) * DFF2 : ZH + ((size_t)pm * 4 + 3) * DFF2;
        const float* zn = s == 0 ? ZH + ((size_t)pm * 4 + 1) * DFF2 : ZH + ((size_t)(pm + 1) * 4 + 0) * DFF2;
        f32x4 cv[2];
#pragma unroll
        for (int h = 0; h < 2; ++h) {
            const f32x4 a = *(const f32x4*)(zp + zc + 128 * h), b = *(const f32x4*)(z0 + zc + 128 * h), c = *(const f32x4*)(zn + zc + 128 * h);
            const f32x4 w0 = *(const f32x4*)(cw + h * DFF + j), w1 = *(const f32x4*)(cw + DFF2 + h * DFF + j), w2 = *(const f32x4*)(cw + 2 * DFF2 + h * DFF + j), bb = *(const f32x4*)(cb + h * DFF + j);
            cv[h] = w0 * a + w1 * b + w2 * c + bb; }
        float o[4];
#pragma unroll
        for (int e = 0; e < 4; ++e) { const float g = cv[0][e]; o[e] = g * __builtin_amdgcn_rcpf(1.0f + __expf(-g)) * cv[1][e]; }
        u32x2v w; w.x = pk2(o[0], o[1]); w.y = pk2(o[2], o[3]);
        *(u32x2v*)(A + affn_off(row, j)) = w;
    }
}

__device__ __forceinline__ void hyconv_regs(const bf16* PROJ, bf16* XT, const float* cw  , const float* cb  , int gt, int ngt) {
    for (int it = gt; it < (NTOK / 8) * 192; it += ngt) {
        const int tb = it / 192, ck = it % 192, row0 = tb * 8, j0 = ck * 8, which = j0 >> 9, c0 = j0 & 511;
        const int b = row_batch(row0), pos0 = row_pos(row0), Lb = batch_len(b);
        float w0[8], w1[8], w2[8], bb[8];
#pragma unroll
        for (int i = 0; i < 8; i += 4) { const f32x4 a = *(const f32x4*)(cw + j0 + i), c = *(const f32x4*)(cw + 1536 + j0 + i), d = *(const f32x4*)(cw + 3072 + j0 + i), e = *(const f32x4*)(cb + j0 + i);
            w0[i] = a.x; w0[i + 1] = a.y; w0[i + 2] = a.z; w0[i + 3] = a.w; w1[i] = c.x; w1[i + 1] = c.y; w1[i + 2] = c.z; w1[i + 3] = c.w;
            w2[i] = d.x; w2[i + 1] = d.y; w2[i + 2] = d.z; w2[i + 3] = d.w; bb[i] = e.x; bb[i + 1] = e.y; bb[i + 2] = e.z; bb[i + 3] = e.w; }
        const bf16* src = PROJ + (size_t)row0 * INCP + C_B + j0;
        v4u raw[10];
        raw[0] = (pos0 > 0) ? *(const v4u*)(src - INCP) : (v4u){0u, 0u, 0u, 0u};
#pragma unroll
        for (int r = 0; r < 8; ++r) raw[r + 1] = *(const v4u*)(src + (size_t)r * INCP);
        raw[9] = (pos0 + 8 < Lb) ? *(const v4u*)(src + (size_t)8 * INCP) : (v4u){0u, 0u, 0u, 0u};
        float z[8][8]; float xm[8], x0[8], xp[8];
        unpack8(raw[0], xm); unpack8(raw[1], x0);
#pragma unroll
        for (int r = 0; r < 8; ++r) { unpack8(raw[r + 2], xp);
#pragma unroll
            for (int i = 0; i < 8; ++i) { z[r][i] = w0[i] * xm[i] + w1[i] * x0[i] + w2[i] * xp[i] + bb[i]; xm[i] = x0[i]; x0[i] = xp[i]; } }
        bf16* dst = XT + (size_t)which * ((size_t)NTOK * 512) + xt_off(b, c0) + pos0;
        const size_t cst = (size_t)Lb;
#pragma unroll
        for (int i = 0; i < 8; ++i) { v4u o; o.x = pk2(z[0][i], z[1][i]); o.y = pk2(z[2][i], z[3][i]); o.z = pk2(z[4][i], z[5][i]); o.w = pk2(z[6][i], z[7][i]);
            *(v4u*)(dst + (size_t)i * cst) = o; }
    }
}
__device__ __forceinline__ void p0_transpose_item(const float* W, int K, int N, bf16* WT, int row_off, LAS float* scr, int item, int lane) {
    const int nblk = N / 32, kb = item / nblk, nb = item % nblk, k0 = 64 * kb, n0 = 32 * nb;
#pragma unroll
    for (int i = 0; i < 32; ++i) { const int kk = 2 * i + (lane >> 5); scr[kk * 33 + (lane & 31)] = __builtin_nontemporal_load(&W[(size_t)(k0 + kk) * N + n0 + (lane & 31)]); }
    LDS_WAIT(); asm volatile("" ::: "memory");
    const int c = lane & 7;
#pragma unroll
    for (int j = 0; j < 4; ++j) { const int n = (lane >> 3) + 8 * j; const LAS float* s = scr + (8 * c) * 33 + n;
        v4u o; o.x = pk2(s[0 * 33], s[1 * 33]); o.y = pk2(s[2 * 33], s[3 * 33]); o.z = pk2(s[4 * 33], s[5 * 33]); o.w = pk2(s[6 * 33], s[7 * 33]);
        *(GAS v4u*)(WT + (size_t)(row_off + n0 + n) * K + k0 + 8 * c) = o; }
    LDS_WAIT(); asm volatile("" ::: "memory");
}
__device__ __forceinline__ void gmlp_unit(char* ldsg, const bf16* PROJ, bf16* YCAT, const float* sw  , const float* sb  , int unit, int tid) {
    using namespace att;
    const int chunk = unit >> 2, h = unit & 3, row0 = chunk * 128, lane = tid & 63, wid = __builtin_amdgcn_readfirstlane(tid >> 6), hi = lane >> 5, r32 = lane & 31;
    { bf16x8 vw[4];
#pragma unroll
      for (int i = 0; i < 4; ++i) { const int id = tid + i * NTHR, q = id >> 4, cc = (id & 15) * 8; vw[i] = *(const bf16x8*)(PROJ + (size_t)(row0 + q) * INCP + 512 + h * 128 + cc); }
#pragma unroll
      for (int i = 0; i < 4; ++i) { const int id = tid + i * NTHR, q = id >> 4, cc = (id & 15) * 8; *(bf16x8*)(ldsg + (q >> 6) * 16384 + v_st(q & 63, cc)) = vw[i]; } }
    const int pblk = wid >> 1, half = wid & 1;
    bf16x8 af[8];
    { const float* wp = sw + (size_t)h * 16384 + (32 * pblk + r32) * 128 + 8 * hi;
#pragma unroll
      for (int k = 0; k < 8; ++k) { const f32x4 a = *(const f32x4*)(wp + 16 * k), c = *(const f32x4*)(wp + 16 * k + 4);
          u32x4 w; w.x = cvtpk(a.x, a.y); w.y = cvtpk(a.z, a.w); w.z = cvtpk(c.x, c.y); w.w = cvtpk(c.z, c.w); af[k] = __builtin_bit_cast(bf16x8, w); } }
    __syncthreads();
    const int vb0 = (int)(uintptr_t)ldsg + v_rd_base(lane);
    f32x16 o0 = {}, o1 = {};
    if (half == 0) { pv_one<0>(o0, vb0, af[0], af[1], af[2], af[3]); pv_one<1>(o1, vb0, af[0], af[1], af[2], af[3]);
                     pv_one<0>(o0, vb0 + 16384, af[4], af[5], af[6], af[7]); pv_one<1>(o1, vb0 + 16384, af[4], af[5], af[6], af[7]); }
    else           { pv_one<2>(o0, vb0, af[0], af[1], af[2], af[3]); pv_one<3>(o1, vb0, af[0], af[1], af[2], af[3]);
                     pv_one<2>(o0, vb0 + 16384, af[4], af[5], af[6], af[7]); pv_one<3>(o1, vb0 + 16384, af[4], af[5], af[6], af[7]); }
    float* st = (float*)(ldsg + 32768) + wid * (32 * 68);
#pragma unroll
    for (int q = 0; q < 16; ++q) { const int pr = crow(q, hi); const float bs = sb[h * 128 + 32 * pblk + pr];
        st[pr * 68 + r32] = o0[q] + bs; st[pr * 68 + 32 + r32] = o1[q] + bs; }
    asm volatile("s_waitcnt lgkmcnt(0)" ::: "memory");
    v4u uws[4];
#pragma unroll
    for (int i = 0; i < 4; ++i) { const int pr = i * 8 + (lane >> 3), cc = (lane & 7) * 8; uws[i] = *(const v4u*)(PROJ + (size_t)(row0 + 32 * pblk + pr) * INCP + h * 128 + 64 * half + cc); }
#pragma unroll
    for (int i = 0; i < 4; ++i) { const int pr = i * 8 + (lane >> 3), cc = (lane & 7) * 8; const int row = row0 + 32 * pblk + pr, col = h * 128 + 64 * half + cc;
        const f32x4 m0 = *(const f32x4*)(st + pr * 68 + cc), m1 = *(const f32x4*)(st + pr * 68 + cc + 4);
        const v4u uw = uws[i]; float uf[8]; unpack8(uw, uf);
        float y[8] = {uf[0] * m0.x, uf[1] * m0.y, uf[2] * m0.z, uf[3] * m0.w, uf[4] * m1.x, uf[5] * m1.y, uf[6] * m1.z, uf[7] * m1.w};
        *(v4u*)(YCAT + (size_t)row * DM + col) = pack8(y); }
    __syncthreads();
}

__device__ __forceinline__ void mod_phase(LAS unsigned char* lds, const float* cp, const float* cs, const float* ada_w, const float* ada_b, float* MOD, int vcu, int G, int tid) {
    LAS float* sc = (LAS float*)lds;
    LAS float* red = (LAS float*)(lds + 65536);
    const int lane = tid & 63, wid = tid >> 6;
#pragma unroll 8
    for (int i = tid; i < NB * DM; i += NTHR) { const int b = i >> 11, k = i & 2047; const float c = b < 4 ? cp[b * DM + k] : cs[(b - 4) * DM + k]; sc[i] = c / (1.0f + __expf(-c)); }
    __syncthreads();
    for (int item = vcu; item < DEPTH * 96; item += G) {
        const int l = item / 96, cbk = item % 96, col0 = cbk * 128 + 2 * lane;
        const float* W = ada_w + (size_t)l * DM * MODW + col0;
        float acc[8][2];
#pragma unroll
        for (int b = 0; b < 8; ++b) { acc[b][0] = 0.f; acc[b][1] = 0.f; }
        const int kbeg = wid * 256;
#pragma unroll 2
        for (int k = kbeg; k < kbeg + 256; k += 4) {
            typedef float f32x2w __attribute__((ext_vector_type(2)));
            f32x2w w[4];
#pragma unroll
            for (int i = 0; i < 4; ++i) w[i] = __builtin_nontemporal_load((const f32x2w*)(W + (size_t)(k + i) * MODW));
#pragma unroll
            for (int b = 0; b < 8; ++b) { const f32x4 s = *(const LAS f32x4*)(sc + b * DM + k);
                acc[b][0] += s.x * w[0].x + s.y * w[1].x + s.z * w[2].x + s.w * w[3].x;
                acc[b][1] += s.x * w[0].y + s.y * w[1].y + s.z * w[2].y + s.w * w[3].y; }
        }
#pragma unroll
        for (int b = 0; b < 8; ++b) { red[(wid * 8 + b) * 128 + 2 * lane] = acc[b][0]; red[(wid * 8 + b) * 128 + 2 * lane + 1] = acc[b][1]; }
        __syncthreads();
        { const int b = tid >> 6, pr = tid & 63; float s0 = 0.f, s1 = 0.f;
#pragma unroll
          for (int w = 0; w < 8; ++w) { s0 += red[(w * 8 + b) * 128 + 2 * pr]; s1 += red[(w * 8 + b) * 128 + 2 * pr + 1]; }
          const int col = cbk * 128 + 2 * pr;
          float* o = MOD + ((size_t)l * NB + b) * MODW + col; o[0] = s0 + ada_b[l * MODW + col]; o[1] = s1 + ada_b[l * MODW + col + 1]; }
        __syncthreads();
    }
}

__device__ __forceinline__ unsigned rot16(unsigned x) { return __builtin_amdgcn_alignbit(x, x, 16); }
__device__ __forceinline__ void filt_item(LAS unsigned char* lds, int L, int tb, const float* w1, const float* b1, const float* f1, const float* w2, const float* b2, const float* f2,
                                          const float* w3, const float* decay, bf16* GFl, int tid) {
    using att::bf16x8; using att::f32x16; using att::u32x4; using att::cvtpk;
    LAS float* feats = (LAS float*)lds;
    LAS float* h1 = feats + 2176;
    LAS float* h2 = h1 + 65 * 64;
    LAS float* hf0 = h2 + 65 * 68;
    const int t0 = 64 * tb; const float invL1 = 1.0f / (float)(L - 1);
    const int GRN = 2 * L / 64 * 72;
    const int lane = tid & 63, wid = __builtin_amdgcn_readfirstlane(tid >> 6), hi = lane >> 5, r32 = lane & 31;
    for (int id = tid; id < 65 * 33; id += NTHR) { const int i = id / 33, f = id % 33; const float t = (float)(t0 + i); float v;
        if (f == 0) v = t * invL1;
        else { const int kb = (f - 1) & 15; const float band = 1e-4f + (float)kb * ((15.0f - 1e-4f) / 15.0f);
            float x = t * band / (float)L; x -= floorf(x); const float a = 6.283185307179586f * x;
            v = (f <= 16) ? __cosf(a) : -__sinf(a); }
        feats[i * 33 + f] = v; }
    __syncthreads();
    for (int id = tid; id < 65 * 64; id += NTHR) { const int i = id >> 6, j = id & 63; float s = b1[j];
#pragma unroll 11
        for (int f = 0; f < 33; ++f) s += feats[i * 33 + f] * w1[f * 64 + j];
        h1[i * 64 + j] = __sinf(f1[j] * s); }
    __syncthreads();
    for (int id = tid; id < 65 * 64; id += NTHR) { const int i = id >> 6, j = id & 63; float s = b2[j];
#pragma unroll 16
        for (int f = 0; f < 64; ++f) s += h1[i * 64 + f] * w2[f * 64 + j];
        h2[i * 68 + j] = __sinf(f2[j] * s); }
    __syncthreads();
    if (tb == 0) {
        for (int cc = tid; cc < 1024; cc += NTHR) { const int col = (cc >> 9) * 1024 + (cc & 511); float s = 0.f;
#pragma unroll 16
            for (int j = 0; j < 64; ++j) s += h2[j] * w3[j * 2048 + col];
            hf0[cc] = s; }
        __syncthreads();
    }
    bf16x8 af[2][2][4];
#pragma unroll
    for (int st = 0; st < 2; ++st)
#pragma unroll
        for (int mb = 0; mb < 2; ++mb)
#pragma unroll
            for (int ks = 0; ks < 4; ++ks) { const LAS float* p = h2 + (st + 32 * mb + r32) * 68 + 16 * ks + 8 * hi;
                const f32x4 x = *(const LAS f32x4*)p, y = *(const LAS f32x4*)(p + 4);
                u32x4 w; w.x = cvtpk(x.x, x.y); w.y = cvtpk(x.z, x.w); w.z = cvtpk(y.x, y.y); w.w = cvtpk(y.z, y.w); af[st][mb][ks] = __builtin_bit_cast(bf16x8, w); }
#pragma unroll 1
    for (int cbi = 0; cbi < 8; ++cbi) {
        const int cb = wid * 8 + cbi, o = cb >> 5, dir = (cb >> 4) & 1, c = (cb & 15) * 32 + r32, col = cb * 32 + r32;
        bf16x8 bfr[4];
#pragma unroll
        for (int ks = 0; ks < 4; ++ks) { float x[8];
#pragma unroll
            for (int j = 0; j < 8; ++j) x[j] = w3[(size_t)(16 * ks + 8 * hi + j) * 2048 + col];
            u32x4 w; w.x = cvtpk(x[0], x[1]); w.y = cvtpk(x[2], x[3]); w.z = cvtpk(x[4], x[5]); w.w = cvtpk(x[6], x[7]); bfr[ks] = __builtin_bit_cast(bf16x8, w); }
        const float dec = fabsf(decay[col]) * invL1;
        bf16* dst = GFl + (size_t)(o * 512 + c) * GRN;
#pragma unroll
        for (int mb = 0; mb < 2; ++mb) {
            f32x16 d = {};
#pragma unroll
            for (int ks = 0; ks < 4; ++ks) d = (dir == 0) ? __builtin_amdgcn_mfma_f32_32x32x16_bf16(af[1][mb][ks], bfr[ks], d, 0, 0, 0)
                                                          : __builtin_amdgcn_mfma_f32_32x32x16_bf16(af[0][mb][ks], bfr[ks], d, 0, 0, 0);
#pragma unroll
            for (int q = 0; q < 16; ++q) { const int mrow = 32 * mb + att::crow(q, hi), t = t0 + mrow + (dir == 0 ? 1 : 0);
                float v = d[q] * __expf(-(float)t * dec);
                if (dir == 0 && t == L) v = 0.f;
                if (dir == 1 && t == 0) v = hf0[o * 512 + c];
                d[q] = v; }
#pragma unroll
            for (int k = 0; k < 2; ++k) {
                const unsigned a0 = cvtpk(d[8 * k + 0], d[8 * k + 1]), a1 = cvtpk(d[8 * k + 2], d[8 * k + 3]), b0 = cvtpk(d[8 * k + 4], d[8 * k + 5]), b1 = cvtpk(d[8 * k + 6], d[8 * k + 7]);
                auto s0 = __builtin_amdgcn_permlane32_swap(a0, b0, false, false); auto s1 = __builtin_amdgcn_permlane32_swap(a1, b1, false, false);
                const unsigned x0 = s0[0], x1 = s1[0], x2 = s0[1], x3 = s1[1];
                const int m0 = 32 * mb + 16 * k + 8 * hi;
                if (dir == 1) { const int ib = L + t0 + m0, ph = (ib >> 6) * 72 + (ib & 63); *(v4u*)(dst + ph) = (v4u){x0, x1, x2, x3}; }
                else { const int ib = L - t0 - m0 - 8, ph = (ib >> 6) * 72 + (ib & 63); *(v4u*)(dst + ph) = (v4u){rot16(x3), rot16(x2), rot16(x1), rot16(x0)}; }
            }
        }
    }
    __syncthreads();
}

__device__ __forceinline__ void ga_tables(const float* n1g, const float* n2g, const float* MODp, float* GA1, float* GA2, int gt, int ngt) {
    for (int i = gt; i < 2 * DEPTH * NB * DM; i += ngt) { const int which = i / (DEPTH * NB * DM), r = i % (DEPTH * NB * DM), l = r / (NB * DM), b = (r / DM) % NB, c = r % DM;
        const float sc = MODp[((size_t)l * NB + b) * MODW + (which ? 4 * DM : DM) + c];
        (which ? GA2 : GA1)[r] = (which ? n2g : n1g)[l * DM + c] * (1.0f + sc); }
}
__device__ __forceinline__ void bvec_item(LAS unsigned char* lds, const float* shp, const bf16* Wt, float* BV, int ldbv, int n0, int tid) {
    LAS float* sb = (LAS float*)lds;
    const int lane = tid & 63, wid = tid >> 6;
#pragma unroll 8
    for (int i = tid; i < NB * DM / 4; i += NTHR) { const int b = i / (DM / 4), k4 = i % (DM / 4); *(LAS f32x4*)(sb + b * DM + 4 * k4) = *(const f32x4*)(shp + (size_t)b * MODW + 4 * k4); }
    __syncthreads();
#pragma unroll 1
    for (int rg = 0; rg < 2; ++rg) { const int nb = n0 + wid * 8 + rg * 4;
        float acc[32];
#pragma unroll
        for (int i = 0; i < 32; ++i) acc[i] = 0.f;
#pragma unroll 1
        for (int j = 0; j < 4; ++j) { float f[4][8];
#pragma unroll
            for (int r = 0; r < 4; ++r) { const v4u w = *(const v4u*)(Wt + (size_t)(nb + r) * DM + 8 * lane + 512 * j); unpack8(w, f[r]); }
#pragma unroll
            for (int b = 0; b < 8; ++b) { const f32x4 s0 = *(const LAS f32x4*)(sb + b * DM + 8 * lane + 512 * j), s1 = *(const LAS f32x4*)(sb + b * DM + 8 * lane + 512 * j + 4);
#pragma unroll
                for (int r = 0; r < 4; ++r)
                    acc[r * 8 + b] += (f[r][0] * s0.x + f[r][1] * s0.y) + (f[r][2] * s0.z + f[r][3] * s0.w) + (f[r][4] * s1.x + f[r][5] * s1.y) + (f[r][6] * s1.z + f[r][7] * s1.w); } }
#pragma unroll
        for (int st = 0; st < 5; ++st) { const int n = 16 >> st, x = 32 >> st; const bool up = (lane & x) != 0;
#pragma unroll
            for (int i = 0; i < n; ++i) { const float keep = up ? acc[i + n] : acc[i], send = up ? acc[i] : acc[i + n]; acc[i] = keep + __shfl_xor(send, x); } }
        const float tot = acc[0] + __shfl_xor(acc[0], 1);
        const int idx = (lane >> 1) & 31;
        const int idxr = ((idx & 16) ? 16 : 0) | ((idx & 8) ? 8 : 0) | ((idx & 4) ? 4 : 0) | ((idx & 2) ? 2 : 0) | (idx & 1);
        if ((lane & 1) == 0) BV[(size_t)(idxr & 7) * ldbv + nb + (idxr >> 3)] = tot;
    }
    __syncthreads();
}
__device__ __forceinline__ void norm0_rows(const float* xa, const float* xb, const float* g, const float* mod, bf16* H, unsigned long long* SS, int gw, int ngw, int lane) {
    for (int ck = gw; ck < NTOK / 4; ck += ngw) {
        const int row0 = ck * 4, b = row_batch(row0);
        const float* xin = row0 < NPR ? xa : xb;
        const float* sc = mod + (size_t)b * MODW + DM;
        f32x4 ga[8];
#pragma unroll
        for (int j = 0; j < 8; ++j) { const int col = 4 * lane + 256 * j; ga[j] = *(const f32x4*)(g + col) * (*(const f32x4*)(sc + col) + 1.0f); }
#pragma unroll 1
        for (int r = 0; r < 4; ++r) {
            const float* xr = xin + (size_t)(row0 + r) * DM;
            f32x4 v[8]; float ss = 0.f;
#pragma unroll
            for (int j = 0; j < 8; ++j) { v[j] = *(const f32x4*)(xr + 4 * lane + 256 * j); ss += (v[j].x * v[j].x + v[j].y * v[j].y) + (v[j].z * v[j].z + v[j].w * v[j].w); }
            ss = wave_sum(ss); if (lane == 0) SS[row0 + r] = (unsigned long long)(ss * 16777216.0f + 0.5f);
            bf16* hr = H + (size_t)(row0 + r) * DM;
#pragma unroll
            for (int j = 0; j < 8; ++j) { const f32x4 o = v[j] * ga[j]; u32x2v w; w.x = pk2(o.x, o.y); w.y = pk2(o.z, o.w);
                *(u32x2v*)(hr + 4 * lane + 256 * j) = w; }
        }
    }
}
#ifndef MK_PHMASK
#define MK_PHMASK 0xFFFFFFFFu
#endif
#define EN(p) (((MK_PHMASK) >> (p)) & 1u)
#ifndef MK_REPEAT
#define MK_REPEAT 0u
#endif
#define REP(p) for (int rep_ = 0; rep_ < 1 + (int)(((MK_REPEAT) >> (p)) & 1u); ++rep_)
constexpr int NPH_LAYER = 10, NPHASE = 2 + DEPTH * NPH_LAYER;
struct Args { const float* in[37]; float* out; unsigned char* ws; int ph_lo, ph_hi; };
static_assert(sizeof(Args) == 39 * 8 + 8, "Args has no padding");

typedef const __attribute__((address_space(4))) Args* KArgs;
__device__ __forceinline__ KArgs kargs() { KArgs p = (KArgs)__builtin_amdgcn_kernarg_segment_ptr(); asm volatile("" : "+s"(p)); return p; }
#define AIN(i) (kargs()->in[i])
__global__ void __launch_bounds__(NTHR, 2) mk_fwd(Args args_unused) {
    extern __shared__ __attribute__((aligned(16))) unsigned char lds_raw[];
    LAS unsigned char* lds = (LAS unsigned char*)lds_raw;
    volatile LAS unsigned* MISC = (volatile LAS unsigned*)(lds + MISC_OFF);
    const int tid0 = threadIdx.x;
#define tid tid_fresh()
#define lane (tid_fresh() & 63)
#define wave (__builtin_amdgcn_readfirstlane(tid_fresh() >> 6))
    const int G0 = gridDim.x; const int bx0 = blockIdx.x; const int vcu0 = (G0 % 8 == 0) ? (bx0 % 8) * (G0 / 8) + bx0 / 8 : bx0;
#define G (sfresh(G0))
#define bx (sfresh(bx0))
#define vcu (sfresh(vcu0))
#define gw (vcu * NWAVES + wave)
#define ngw (G * NWAVES)
    gu32* ctl = (gu32*)(kargs()->ws + WS_CTL);
    for (int u = tid0; u < (LDS_BYTES - LDSCTL_OFF) / 4; u += NTHR) ((LAS unsigned*)(lds + LDSCTL_OFF))[u] = 0u;
    __syncthreads();
#if MK_MULTI
    XcdBarrier bar; bar.bar = (unsigned*)(ctl + CW_BAR); bar.x = 0; bar.st = nullptr;
#define SEAM(k) do { } while (0)
#else
    XcdBarrier bar = xcd_barrier_post((unsigned*)(ctl + CW_BAR), MISC + 8);
#define SEAM(k) do { if (IN(k) && IN((k) + 1)) { xcd_barrier(bar); if ((MK_REPEAT >> 19) & 1u) xcd_barrier(bar); } } while (0)
#endif
    const int lo = kargs()->ph_lo, hi = kargs()->ph_hi;
#define IN(k) (lo <= (k) && (k) < hi)
#define ws (kargs()->ws)
#define MOD ((float*)(ws + WS_MOD))
#define HB ((bf16*)(ws + WS_HB))
#define AFFN ((bf16*)(ws + WS_AFFN))
#define Z ((bf16*)(ws + WS_Z))
#define PROJ ((bf16*)(ws + WS_PROJ))
#define XT ((bf16*)(ws + WS_XT))
#define Y2T ((bf16*)(ws + WS_Y2T))
#define QD ((bf16*)(ws + WS_QD))
#define KVD ((bf16*)(ws + WS_KVD))
#define KMLA ((bf16*)(ws + WS_KMLA))
#define YCAT ((bf16*)(ws + WS_YCAT))
#define OUT (kargs()->out)

    if (EN(0) && IN(0)) REP(0) {
        REP(21) mod_phase(lds, AIN(2), AIN(3), AIN(4), AIN(5), MOD, vcu, G, tid);
        REP(22) for (int item = (vcu + G / 2) % G; item < DEPTH * 96; item += G) {     const int l = item / 96, r = item % 96; const int L = r < 32 ? LP : LS, tb = r < 32 ? r : r - 32;
            bf16* GFl = (bf16*)(ws + WS_GF + (size_t)l * SZ_GF + (r < 32 ? 0 : SZ_GF_P));
            filt_item(lds, L, tb, AIN(13) + (size_t)l * 33 * 64, AIN(14) + l * 64, AIN(15) + l * 64, AIN(16) + (size_t)l * 4096, AIN(17) + l * 64, AIN(18) + l * 64,
                      AIN(19) + (size_t)l * 64 * 2048, AIN(20) + (size_t)l * 2048, GFl, tid); }
        { LAS float* scr = (LAS float*)(lds + wave * 16384);
          constexpr int I_IN = 32 * 138, I_QB = 8 * 24, I_KVB = 4 * 32, I_OUT = 32 * 64, I_UP = 32 * 352, I_DN = 88 * 64, I_L = I_IN + I_QB + I_KVB + I_OUT + I_UP + I_DN;
          REP(23) for (int it = gw; it < DEPTH * I_L; it += ngw) { const int l = it / I_L; int r = it % I_L;
              if (r < I_IN) { p0_transpose_item(AIN(7) + (size_t)l * DM * INC, DM, INC, (bf16*)(ws + WS_WIN + l * SZ_WIN), 0, scr, r, lane); continue; } r -= I_IN;
              if (r < I_QB) { p0_transpose_item(AIN(25) + (size_t)l * 512 * 768, 512, 768, (bf16*)(ws + WS_WQB + l * SZ_WQB), 0, scr, r, lane); continue; } r -= I_QB;
              if (r < I_KVB) { p0_transpose_item(AIN(27) + (size_t)l * 256 * 1024, 256, 1024, (bf16*)(ws + WS_WKVB + l * SZ_WKVB), 0, scr, r, lane); continue; } r -= I_KVB;
              if (r < I_OUT) { p0_transpose_item(AIN(31) + (size_t)l * DM * DM, DM, DM, (bf16*)(ws + WS_WOUT + l * SZ_WOUT), 0, scr, r, lane); continue; } r -= I_OUT;
              if (r < I_UP) { const int n0 = 32 * (r % 352), hf = n0 >= DFF ? 1 : 0, j = n0 - DFF * hf, dest = 256 * (j >> 7) + 128 * hf + (j & 127);
                  p0_transpose_item(AIN(33) + (size_t)l * DM * DFF2, DM, DFF2, (bf16*)(ws + WS_WUP + l * SZ_WUP), dest - n0, scr, r, lane); continue; } r -= I_UP;
              p0_transpose_item(AIN(36) + (size_t)l * DFF * DM, DFF, DM, (bf16*)(ws + WS_WDN + l * SZ_WDN), 0, scr, r, lane); } }
        for (int i = vcu * NTHR + tid; i < DEPTH * (INCP - INC) * (DM / 8); i += G * NTHR) { const int l = i / ((INCP - INC) * (DM / 8)), r = i % ((INCP - INC) * (DM / 8));
            *(v4u*)(ws + WS_WIN + l * SZ_WIN + ((size_t)INC * DM + (size_t)r * 8) * 2) = (v4u){0u, 0u, 0u, 0u}; }
        VM_WAIT(); __syncthreads();
    }
    SEAM(0);

    if (EN(1) && IN(1)) REP(1) {
        ga_tables(AIN(6), AIN(32), MOD, (float*)(ws + WS_GA1), (float*)(ws + WS_GA2), vcu * NTHR + tid, G * NTHR);
        for (int it = vcu; it < DEPTH * 248; it += G) { const int l = it / 248, r = it % 248;
            if (r < 72) bvec_item(lds, MOD + (size_t)l * NB * MODW, (const bf16*)(ws + WS_WIN + l * SZ_WIN), (float*)(ws + WS_BV1) + (size_t)l * NB * INCP, INCP, r * 64, tid);
            else bvec_item(lds, MOD + (size_t)l * NB * MODW + 3 * DM, (const bf16*)(ws + WS_WUP + l * SZ_WUP), (float*)(ws + WS_BV2) + (size_t)l * NB * DFF2, DFF2, (r - 72) * 64, tid); }
        norm0_rows(AIN(0), AIN(1) - (size_t)NPR * DM, AIN(6), MOD, HB, (unsigned long long*)(ws + WS_SSQ1), gw, ngw, lane);
    }
    SEAM(1);

#pragma unroll 1
    for (int l = 0; l < DEPTH; ++l) {
        const int pb = 2 + l * NPH_LAYER;
#define xa ((l == 0) ? AIN(0) : OUT)
#define xb ((l == 0) ? (AIN(1) - (size_t)NPR * DM) : OUT)
#define modl (MOD + (size_t)l * NB * MODW)
        if (EN(2) && IN(pb + 0)) REP(2) {
            pg8::Gemm g{HB, (const bf16*)(ws + WS_WIN + l * SZ_WIN), NTOK, INCP, DM, DM, DM}; pg8::StaticOrder S; S.init(NTOK, INCP, G, bx);
            LAS float* rst = (LAS float*)(lds + TAB_OFF); LAS float* bvt = rst + 8 * 256;
            pg8::fill_tabs(S, (const unsigned long long*)(ws + WS_SSQ1), (const float*)(ws + WS_BV1) + (size_t)l * NB * INCP, INCP, rst, bvt, tid);
            pg8::EpiBf E{PROJ, INCP, 4, rst, bvt, 0};
            pg8::gemm_phase<pg8::EpiBf, pg8::StaticOrder, true, true>(lds, g, S, E);
        }
        SEAM(pb + 0);
        if (EN(3) && IN(pb + 1)) {
            for (int i = vcu * NTHR + tid; i < NTOK; i += G * NTHR) ((unsigned long long*)(ws + WS_SSQ1))[i] = 0ull;
            REP(20) post_rows(PROJ, AIN(8) + l * 512, AIN(22) + l * 128, AIN(23) + l * 128, AIN(24) + l * 512, AIN(26) + l * 256, gw, ngw, lane, rep_ == (int)((MK_REPEAT >> 20) & 1u));
            REP(3) for (int t = vcu; t < (NTOK / 64) * 3; t += G) hyconv_tile(lds, PROJ, XT, AIN(11) + (size_t)l * 3 * 1536, AIN(12) + l * 1536, t, tid);
        }
        SEAM(pb + 1);
        if (EN(4) && IN(pb + 2)) REP(4) {
            { pg8::Gemm g{PROJ + C_D, (const bf16*)(ws + WS_WQB + l * SZ_WQB), NTOK, 768, 512, INCP, 512}; pg8::StaticOrder S; S.init(NTOK, 768, G, bx);
              pg8::EpiBf E{QD, 768, 0, nullptr, nullptr, 0};
              pg8::gemm_phase<pg8::EpiBf, pg8::StaticOrder, true, true>(lds, g, S, E); }
            { pg8::Gemm g{PROJ + C_D + 512, (const bf16*)(ws + WS_WKVB + l * SZ_WKVB), NTOK, 1024, 256, INCP, 256}; pg8::StaticOrder S; S.init(NTOK, 1024, G, (bx + G / 2) % G);
              pg8::EpiBf E{KVD, 1024, 0, nullptr, nullptr, 0};
              pg8::gemm_phase<pg8::EpiBf, pg8::StaticOrder, true, true>(lds, g, S, E); }
        }
        SEAM(pb + 2);
        if (EN(5) && IN(pb + 3)) {
            REP(5) mla_rows(QD, KVD, PROJ, KMLA, AIN(28) + l * 192, AIN(29) + l * 192, gw, ngw, lane, rep_ == (int)((MK_REPEAT >> 5) & 1u));
        }
        SEAM(pb + 3);
        if (EN(6) && IN(pb + 4)) {
            if (EN(13)) REP(13) for (int u = vcu; u < 256; u += G) { const int bh = u >> 4, qb = u & 15, b = 4 + (bh >> 2), h = bh & 3; const size_t r0 = batch_row0(b);
                att::attn_body16<192, 768, 768, 1024, DM>(QD + (r0 + qb * 256) * 768 + h * 192, KMLA + r0 * 768 + h * 192, KVD + r0 * 1024 + h * 256 + 128,
                                      YCAT + (r0 + qb * 256) * DM + 1536 + h * 128, LS, (char*)lds_raw); }
            if (EN(14)) REP(14) for (int u = vcu; u < 256; u += G) { const int bh = u >> 4, qb = u & 15, b = 4 + (bh >> 2), h = bh & 3; const size_t r0 = batch_row0(b);
                att::attn_body16<128, INCP, INCP, INCP, DM>(PROJ + (r0 + qb * 256) * INCP + C_C + h * 128, PROJ + r0 * INCP + C_C + 512 + (h >> 1) * 128, PROJ + r0 * INCP + C_C + 768 + (h >> 1) * 128,
                                      YCAT + (r0 + qb * 256) * DM + 1024 + h * 128, LS, (char*)lds_raw); }
            if (EN(15)) REP(15) for (int u = vcu; u < 256; u += G)
                hy::hyena_unit<LS>((LAS char*)lds, (const bf16*)(ws + WS_GF + (size_t)l * SZ_GF + SZ_GF_P), XT, XT + (size_t)NTOK * 512, XT + (size_t)2 * NTOK * 512, Y2T, AIN(21) + l * 1024, 4, 2 * u);
            REP(17) for (int i = vcu; i < 256; i += G) { const int u = i & 127, bh = u >> 3, qb = u & 7, b = bh >> 2, h = bh & 3; const size_t r0 = batch_row0(b);
                if (i < 128) { if (EN(13))
                    att::attn_body16<192, 768, 768, 1024, DM>(QD + (r0 + qb * 256) * 768 + h * 192, KMLA + r0 * 768 + h * 192, KVD + r0 * 1024 + h * 256 + 128,
                                          YCAT + (r0 + qb * 256) * DM + 1536 + h * 128, LP, (char*)lds_raw); }
                else if (EN(14))
                    att::attn_body16<128, INCP, INCP, INCP, DM>(PROJ + (r0 + qb * 256) * INCP + C_C + h * 128, PROJ + r0 * INCP + C_C + 512 + (h >> 1) * 128, PROJ + r0 * INCP + C_C + 768 + (h >> 1) * 128,
                                          YCAT + (r0 + qb * 256) * DM + 1024 + h * 128, LP, (char*)lds_raw); }
            if (EN(15)) REP(18) for (int i = (G == 256) ? (vcu + 128) % 256 : vcu; i < 128; i += G)
                hy::hyena_unit<LP>((LAS char*)lds, (const bf16*)(ws + WS_GF + (size_t)l * SZ_GF), XT, XT + (size_t)NTOK * 512, XT + (size_t)2 * NTOK * 512, Y2T, AIN(21) + l * 1024, 0, 4 * i);
            if (EN(16)) REP(16) {
                if (G == 256) { const int v_ = vcu;
                    if (v_ < 128) { for (int u = v_; u < 768; u += 128) gmlp_unit((char*)lds_raw, PROJ, YCAT, AIN(9) + (size_t)l * 4 * 16384, AIN(10) + l * 512, u, tid); } }
                else for (int u = vcu; u < 768; u += G) gmlp_unit((char*)lds_raw, PROJ, YCAT, AIN(9) + (size_t)l * 4 * 16384, AIN(10) + l * 512, u, tid); }
            VM_WAIT(); __syncthreads();
        }
        SEAM(pb + 4);
        if (EN(7) && IN(pb + 5)) REP(7) { for (int t = vcu; t < NTOK / 32; t += G) gnorm_tile(lds, YCAT, Y2T, AIN(30) + l * DM, HB, t, tid); }
        SEAM(pb + 5);
        if (EN(8) && IN(pb + 6)) {
            pg8::Gemm g{HB, (const bf16*)(ws + WS_WOUT + l * SZ_WOUT), NTOK, DM, DM, DM, DM}; pg8::StaticOrder S; S.init(NTOK, DM, G, bx);
            if (l == 0) { pg8::EpiResidT<false, true> E{AIN(0), AIN(1) - (size_t)NPR * DM, OUT, modl + 2 * DM, (bf16*)(ws + WS_HB2), (const float*)(ws + WS_GA2) + (size_t)l * NB * DM, (unsigned long long*)(ws + WS_SSQ2)};
                pg8::gemm_phase<pg8::EpiResidT<false, true>, pg8::StaticOrder, true, true>(lds, g, S, E); }
            else { pg8::EpiResidT<true, true> E{OUT, OUT, (l + 1 == DEPTH) ? (void*)(ws + WS_XRES) : (void*)OUT, modl + 2 * DM, (bf16*)(ws + WS_HB2), (const float*)(ws + WS_GA2) + (size_t)l * NB * DM, (unsigned long long*)(ws + WS_SSQ2)};
                pg8::gemm_phase<pg8::EpiResidT<true, true>, pg8::StaticOrder, true, true>(lds, g, S, E); }
        }
        SEAM(pb + 6);
        if (EN(10) && IN(pb + 7)) REP(10) {
            pg8::Gemm g{(const bf16*)(ws + WS_HB2), (const bf16*)(ws + WS_WUP + l * SZ_WUP), NTOK, DFF2, DM, DM, DM}; pg8::StaticOrder S; S.init(NTOK, DFF2, G, bx);
            LAS float* rst = (LAS float*)(lds + TAB_OFF);
            pg8::fill_tabs(S, (const unsigned long long*)(ws + WS_SSQ2), nullptr, 0, rst, rst, tid);
            pg8::EpiGate E{AFFN, (float*)(ws + WS_R1), AIN(34) + (size_t)l * 3 * DFF2, AIN(35) + l * DFF2, (LAS float*)(lds + HALO_OFF), rst, (const float*)(ws + WS_BV2) + (size_t)l * NB * DFF2, 0};
            pg8::gemm_phase<pg8::EpiGate, pg8::StaticOrder, true, true>(lds, g, S, E);
        }
        SEAM(pb + 7);
        if (EN(11) && IN(pb + 8)) for (int i = vcu * NTHR + tid; i < NTOK; i += G * NTHR) ((unsigned long long*)(ws + WS_SSQ2))[i] = 0ull;
        if (EN(11) && IN(pb + 8)) REP(11) gate_fix((const float*)(ws + WS_R1), AFFN, AIN(34) + (size_t)l * 3 * DFF2, AIN(35) + l * DFF2, vcu * NTHR + tid, G * NTHR);
        SEAM(pb + 8);
        if (EN(12) && IN(pb + 9)) {
            pg8::Gemm g{AFFN, (const bf16*)(ws + WS_WDN + l * SZ_WDN), NTOK, DM, DFF, DFF, DFF}; pg8::StaticOrder S; S.init(NTOK, DM, G, bx);
            if (l + 1 < DEPTH) { pg8::EpiResidT<true, true> E{OUT, OUT, OUT, modl + 5 * DM, HB, (const float*)(ws + WS_GA1) + (size_t)(l + 1) * NB * DM, (unsigned long long*)(ws + WS_SSQ1)};
                pg8::gemm_phase<pg8::EpiResidT<true, true>, pg8::StaticOrder, true, true, true, false>(lds, g, S, E); }
            else { pg8::EpiResidT<true, false> E{(const void*)(ws + WS_XRES), (const void*)(ws + WS_XRES), OUT, modl + 5 * DM, nullptr, nullptr, nullptr};
                pg8::gemm_phase<pg8::EpiResidT<true, false>, pg8::StaticOrder, true, true, true, false>(lds, g, S, E); }
        }
        if (l + 1 < DEPTH) SEAM(pb + 9);
    }
#undef xa
#undef xb
#undef modl
#undef G
#undef bx
#undef vcu
#undef ngw
#undef IN
#undef SEAM
#undef tid
#undef lane
#undef wave
#undef gw
#undef ws
#undef MOD
#undef HB
#undef AFFN
#undef Z
#undef PROJ
#undef XT
#undef Y2T
#undef QD
#undef KVD
#undef KMLA
#undef YCAT
#undef OUT
}

extern "C" void kernel_launch(void* const* d_in, const int* in_sizes, int n_in, void* d_out, int out_size, void* d_ws, size_t ws_size, hipStream_t stream) {
    static int grid = 0;
    if (grid == 0) {
        if (n_in != 37 || out_size != NTOK * DM || ws_size < WS_END) { fprintf(stderr, "kernel_launch: shape mismatch (n_in %d out %d ws %zu need %zu)\n", n_in, out_size, ws_size, (size_t)WS_END); grid = -1; return; }
        int dev = 0, cus = 0, per_cu = 0;
        if (hipGetDevice(&dev) != hipSuccess || hipDeviceGetAttribute(&cus, hipDeviceAttributeMultiprocessorCount, dev) != hipSuccess) { grid = -1; return; }
        if (hipFuncSetAttribute((const void*)mk_fwd, hipFuncAttributeMaxDynamicSharedMemorySize, LDS_BYTES) != hipSuccess) { fprintf(stderr, "kernel_launch: hipFuncSetAttribute failed\n"); grid = -1; return; }
        if (hipOccupancyMaxActiveBlocksPerMultiprocessor(&per_cu, (const void*)mk_fwd, NTHR, LDS_BYTES) != hipSuccess || per_cu < 1)
            fprintf(stderr, "kernel_launch: occupancy query reports %d workgroups per CU\n", per_cu);
        (void)hipGetLastError();
        grid = cus;
        if (grid > 256) grid = 256;
    }
    if (grid < 0) return;
    if (hipMemsetAsync((char*)d_ws + WS_CTL, 0, CTL_ZERO_BYTES, stream) != hipSuccess) { fprintf(stderr, "kernel_launch: memset failed\n"); return; }
    Args a{};
    for (int i = 0; i < 37; ++i) a.in[i] = (const float*)d_in[i];
    a.out = (float*)d_out; a.ws = (unsigned char*)d_ws;
#if MK_MULTI
    for (int p = 0; p < NPHASE; ++p) { a.ph_lo = p; a.ph_hi = p + 1; hipLaunchKernelGGL(mk_fwd, dim3(grid), dim3(NTHR), LDS_BYTES, stream, a); }
#else
    a.ph_lo = 0; a.ph_hi = NPHASE;
    hipLaunchKernelGGL(mk_fwd, dim3(grid), dim3(NTHR), LDS_BYTES, stream, a);
#endif
    const hipError_t le = hipPeekAtLastError();
    if (le != hipSuccess) fprintf(stderr, "kernel_launch: launch failed: %s\n", hipGetErrorName(le));
}
```

```cpp
#include <hip/hip_runtime.h>
#include <hip/hip_bf16.h>
#include <cstdio>
#include <cstdint>
#include <cmath>

#ifndef MK_MULTI
#define MK_MULTI 0
#endif

constexpr int DM = 2048, NTOK = 24576, NPR = 8192  , LP = 2048, LS = 4096, DEPTH = 4, NB = 8  ;
constexpr int INC = 4416, INCP = 4608;
constexpr int C_A = 0, C_B = 1024, C_C = 2560, C_D = 3584;
constexpr int DFF = 5632, DFF2 = 11264;
constexpr int MODW = 6 * DM;
constexpr float EPS = 1e-6f;
constexpr int NWAVES = 8, NTHR = 512;

constexpr size_t MiB = 1u << 20;
constexpr size_t WS_CTL = 0, CTL_ZERO_BYTES = 512 * 1024;
constexpr size_t WS_SSQ1 = 65536, WS_SSQ2 = WS_SSQ1 + (size_t)NTOK * 8;
static_assert(WS_SSQ2 + (size_t)NTOK * 8 <= CTL_ZERO_BYTES, "ssq inside the memset");
constexpr size_t WS_MOD = 1 * MiB;
constexpr size_t WS_GA1 = 2 * MiB + 512 * 1024;
constexpr size_t WS_GA2 = WS_GA1 + 256 * 1024;
constexpr size_t WS_BV1 = 3 * MiB;
constexpr size_t WS_BV2 = 4 * MiB;
constexpr size_t WS_WIN = 6 * MiB;
constexpr size_t SZ_WIN = (size_t)INCP * DM * 2;
constexpr size_t WS_WQB = WS_WIN + DEPTH * SZ_WIN;
constexpr size_t SZ_WQB = (size_t)768 * 512 * 2;
constexpr size_t WS_WKVB = WS_WQB + DEPTH * SZ_WQB;
constexpr size_t SZ_WKVB = (size_t)1024 * 256 * 2;
constexpr size_t WS_WOUT = WS_WKVB + DEPTH * SZ_WKVB;
constexpr size_t SZ_WOUT = (size_t)DM * DM * 2;
constexpr size_t WS_WUP = WS_WOUT + DEPTH * SZ_WOUT;
constexpr size_t SZ_WUP = (size_t)DFF2 * DM * 2;
constexpr size_t WS_WDN = WS_WUP + DEPTH * SZ_WUP;
constexpr size_t SZ_WDN = (size_t)DM * DFF * 2;
constexpr size_t WS_GF = WS_WDN + DEPTH * SZ_WDN;
constexpr size_t SZ_GF_P = (size_t)2 * 512 * 4608 * 2, SZ_GF_S = (size_t)2 * 512 * 9216 * 2, SZ_GF = SZ_GF_P + SZ_GF_S;
constexpr size_t WS_HB = WS_GF + DEPTH * SZ_GF;
constexpr size_t WS_HB2 = WS_HB + (size_t)NTOK * DM * 2;
constexpr size_t WS_AFFN = WS_HB2 + (size_t)NTOK * DM * 2;
constexpr size_t WS_R1 = WS_AFFN + (size_t)NTOK * DFF * 2;
constexpr size_t WS_Z = WS_R1;
constexpr size_t WS_PROJ = WS_R1;
constexpr size_t WS_XT = WS_PROJ + (size_t)NTOK * INCP * 2;
constexpr size_t SZ_XT1 = (size_t)NTOK * 512 * 2;
constexpr size_t WS_Y2T = WS_XT + 3 * SZ_XT1;
constexpr size_t WS_QD = WS_Y2T + SZ_XT1;
constexpr size_t WS_KVD = WS_QD + (size_t)NTOK * 768 * 2;
constexpr size_t WS_KMLA = WS_KVD + (size_t)NTOK * 1024 * 2;
constexpr size_t WS_YCAT = WS_KMLA + (size_t)NTOK * 768 * 2;
constexpr size_t WS_XRES = WS_R1 + 64 * MiB;
constexpr size_t WS_END = WS_R1 + (size_t)NTOK * DFF2 * 2;
static_assert(WS_YCAT + (size_t)NTOK * DM * 2 <= WS_END, "mixer buffers fit under Z");
static_assert(WS_BV2 + (size_t)DEPTH * NB * DFF2 * 4 <= WS_WIN, "ws map");
constexpr int CW_BAR = 4096;

__host__ __device__ __forceinline__ size_t xt_off(int b, int c) { return b < 4 ? ((size_t)(b * 512 + c) * LP) : ((size_t)4 * 512 * LP + (size_t)((b - 4) * 512 + c) * LS); }
__host__ __device__ __forceinline__ int row_batch(int row) { return row < NPR ? (row >> 11) : 4 + ((row - NPR) >> 12); }
__host__ __device__ __forceinline__ int row_pos(int row) { return row < NPR ? (row & (LP - 1)) : ((row - NPR) & (LS - 1)); }
__host__ __device__ __forceinline__ int batch_row0(int b) { return b < 4 ? b * LP : NPR + (b - 4) * LS; }
__host__ __device__ __forceinline__ int batch_len(int b) { return b < 4 ? LP : LS; }

__host__ __device__ __forceinline__ size_t affn_off(int row, int j) { return ((((size_t)(row >> 8) * (DFF / 64) + (j >> 6)) * 256 + (row & 255)) << 6) + (j & 63); }

constexpr int RING_BYTES = 131072;
constexpr int LDSCTL_OFF = RING_BYTES, MISC_OFF = LDSCTL_OFF + 320, HALO_OFF = RING_BYTES + 1024;
constexpr int TAB_OFF = HALO_OFF + 8192 + 1024, TAB_BYTES = 17408;
constexpr int LDS_BYTES = 161792;
#define GAS __attribute__((address_space(1)))
#define LAS __attribute__((address_space(3)))
typedef unsigned short bf16;
typedef unsigned v4u __attribute__((ext_vector_type(4)));
typedef float f32x4 __attribute__((ext_vector_type(4)));
typedef short bf16x8 __attribute__((ext_vector_type(8)));
typedef GAS unsigned gu32;
typedef GAS unsigned long long gu64;
#define RLX_AGENT __ATOMIC_RELAXED, __HIP_MEMORY_SCOPE_AGENT
#define LDS_WAIT() asm volatile("s_waitcnt lgkmcnt(0)" ::: "memory")
#define VM_WAIT() asm volatile("s_waitcnt vmcnt(0)" ::: "memory")
__device__ __forceinline__ int tid_fresh() { int t = threadIdx.x; asm volatile("" : "+v"(t)); return t; }
__device__ __forceinline__ int sfresh(int v) { asm volatile("" : "+s"(v)); return v; }
__device__ __forceinline__ unsigned long long rt() { return __builtin_amdgcn_s_memrealtime(); }
__device__ __forceinline__ unsigned f2bf(float f) { unsigned u = __builtin_bit_cast(unsigned, f); return (u + 0x7fffu + ((u >> 16) & 1u)) >> 16; }
__device__ __forceinline__ unsigned pk2(float lo, float hi) { return f2bf(lo) | (f2bf(hi) << 16); }
#define XB_TMO      128
#define XB_XCNT(j)  (256  + 64 * (j))
#define XB_XSUB(j)  (1280 + 64 * (j))
#define XB_XGEN(j)  (2304 + 64 * (j))
#define XB_TOP      3328
#define XB_TOPGEN   3392
#define XCD_BAR_WORDS 3456
#define XB_SPIN_CAP (1u << 18)

__device__ __forceinline__ unsigned xb_ld(unsigned* p)              { return __hip_atomic_load(p, __ATOMIC_RELAXED, __HIP_MEMORY_SCOPE_AGENT); }
__device__ __forceinline__ unsigned xb_add(unsigned* p, unsigned v) { return __hip_atomic_fetch_add(p, v, __ATOMIC_RELAXED, __HIP_MEMORY_SCOPE_AGENT); }
__device__ __forceinline__ unsigned xb_xcc_id() { return (unsigned)__builtin_amdgcn_s_getreg((3 << 11) | 20) & 0xFu; }
#define XB_SPIN(cond, bar) do { unsigned _sp = 0; while (cond) { __builtin_amdgcn_s_sleep(1); \
    if ((++_sp & 255u) == 0u) { if (xb_ld(&(bar)[XB_TMO])) break; if (_sp > XB_SPIN_CAP) { atomicAdd(&(bar)[XB_TMO], 1u); break; } } } } while (0)

struct XcdBarrier {
    unsigned* bar; unsigned x;
    volatile LAS unsigned* st;
};

__device__ __forceinline__ XcdBarrier xcd_barrier_post(unsigned* bar, volatile LAS unsigned* st) {
    XcdBarrier b; b.bar = bar; b.x = xb_xcc_id(); b.st = st;
    if (threadIdx.x == 0) (void)xb_add(&bar[XB_XCNT(b.x)], 1u);
    return b;
}
__device__ __forceinline__ void xcd_barrier_complete(unsigned* bar, unsigned x, unsigned& nloc, unsigned& nx) {
    const unsigned G = gridDim.x * gridDim.y * gridDim.z;
    unsigned sum, cnt, mine, sp = 0u;
    for (;;) {
        sum = 0u; cnt = 0u; mine = 0u;
#pragma unroll
        for (unsigned j = 0; j < 16; ++j) { const unsigned c = xb_ld(&bar[XB_XCNT(j)]); sum += c; cnt += (c > 0u) ? 1u : 0u; mine = (j == x) ? c : mine; }
        if (sum == G) break;
        __builtin_amdgcn_s_sleep(1);
        if ((++sp & 255u) == 0u) { if (xb_ld(&bar[XB_TMO])) break; if (sp > XB_SPIN_CAP) { atomicAdd(&bar[XB_TMO], 1u); break; } }
    }
    nloc = mine > 0u ? mine : 1u; nx = cnt > 0u ? cnt : 1u;
}

__device__ __forceinline__ void xcd_barrier(const XcdBarrier& b) {
    asm volatile("s_waitcnt vmcnt(0)" ::: "memory");
    __syncthreads();
    if (threadIdx.x == 0) {
        unsigned* bar = b.bar;
        __builtin_amdgcn_s_waitcnt(0);
        unsigned nloc = b.st[0], nx = b.st[1];
        if (nloc == 0u) { xcd_barrier_complete(bar, b.x, nloc, nx); b.st[0] = nloc; b.st[1] = nx; }
        const unsigned old = xb_add(&bar[XB_XSUB(b.x)], 1u);
        const unsigned gen = old / nloc;
        if (old + 1u == (gen + 1u) * nloc) {
            __builtin_amdgcn_fence(__ATOMIC_RELEASE, "agent");
            asm volatile("s_waitcnt vmcnt(0)" ::: "memory");
            const unsigned og = xb_add(&bar[XB_TOP], 1u);
            const unsigned tg = og / nx;
            if (og + 1u == (tg + 1u) * nx) xb_add(&bar[XB_TOPGEN], 1u);
            else XB_SPIN(xb_ld(&bar[XB_TOPGEN]) == tg, bar);
            __builtin_amdgcn_fence(__ATOMIC_ACQUIRE, "agent");
            xb_add(&bar[XB_XGEN(b.x)], 1u);
            asm volatile("s_waitcnt vmcnt(0)" ::: "memory");
        } else {
            XB_SPIN(xb_ld(&bar[XB_XGEN(b.x)]) == gen, bar);
            __builtin_amdgcn_fence(__ATOMIC_ACQUIRE, "agent");
            asm volatile("s_waitcnt vmcnt(0)" ::: "memory");
        }
    }
    __syncthreads();
}
namespace pg8 {
#define PG8_LAS __attribute__((address_space(3)))
typedef unsigned short bf16_t;
typedef short bf16x8 __attribute__((ext_vector_type(8)));
typedef float f32x4 __attribute__((ext_vector_type(4)));
typedef unsigned u32x4 __attribute__((ext_vector_type(4)));
constexpr int BM = 256, BK = 64, HALF = 128, HTB = HALF * BK * 2  , STAGE_BYTES = 8 * HTB, NXCD = 8, WGM = 4;

__host__ __device__ __forceinline__ int lds_byte(int r, int c) { const int st = (r >> 4) * 2 + (c >> 5), rr = r & 15, cc = c & 31, ob = rr * 64 + cc * 2; return st * 1024 + (ob ^ (((ob >> 9) & 1) << 5)); }
__host__ __device__ __forceinline__ void stage_rc(int b, int& R, int& C) { const int st = b / 1024, sb = b % 1024, swz = sb ^ (((sb >> 9) & 1) << 5); R = (st >> 1) * 16 + swz / 64; C = (st & 1) * 32 + (swz % 64) / 2; }
__host__ __device__ __forceinline__ int perm32(int rho) { const int n = rho >> 4, i = rho & 15; return 8 * (i >> 2) + 4 * n + (i & 3); }

struct Unit { int pm, pn; };
struct Gemm { const bf16_t* A; const bf16_t* Bt; int M, N, K, lda, ldb; };

struct StaticOrder {
    int nM, nN, nwg, G, c;
    __host__ __device__ void init(int M, int N, int G_, int c_) { nM = M / BM; nN = N / BM; nwg = nM * nN; G = G_; c = c_; }
    __host__ __device__ bool next(int i, Unit& u) const {
        const long L = (long)i * G + c; if (L >= nwg) return false;
        int wgid = (int)L; { const int q = nwg / NXCD, r = nwg % NXCD, xcd = wgid % NXCD, off = wgid / NXCD; wgid = (xcd < r ? xcd * (q + 1) : r * (q + 1) + (xcd - r) * q) + off; }
        const int nig = WGM * nN, gid = wgid / nig, fm = gid * WGM, gsz = (nM - fm) < WGM ? (nM - fm) : WGM;
        u.pm = fm + ((wgid % nig) % gsz); u.pn = (wgid % nig) / gsz; return true;
    }
    __device__ __forceinline__ void a_ready(const Unit&) const {}
    __device__ __forceinline__ void done(const Unit&) const {}
};

__device__ __forceinline__ unsigned cvt_pk_bf16(float lo, float hi) { unsigned r; asm volatile("v_cvt_pk_bf16_f32 %0, %1, %2" : "=v"(r) : "v"(lo), "v"(hi)); return r; }
typedef float f32x2 __attribute__((ext_vector_type(2)));
__device__ __forceinline__ f32x2 gelu_pk(f32x2 v) {
    const f32x2 av = __builtin_elementwise_abs(v), d = av * 0.2316418882f + 1.0f;
    f32x2 t; t.x = __builtin_amdgcn_rcpf(d.x); t.y = __builtin_amdgcn_rcpf(d.y);
    f32x2 q = t * 0.5307027145f + (-0.7265760135f); q = q * t + 0.7107068705f; q = q * t + (-0.142248368f); q = q * t + 0.127414796f; q = q * t;
    const f32x2 s = (v * v) * (-0.72134752044f);
    f32x2 e; e.x = __builtin_amdgcn_exp2f(s.x); e.y = __builtin_amdgcn_exp2f(s.y);
    const f32x2 m = v * (q * e), r = v - m;
    f32x2 o; o.x = v.x < 0.f ? m.x : r.x; o.y = v.y < 0.f ? m.y : r.y; return o;
}

template <class Epi, class Sched, bool ALIGN_EPI = false, bool SP2 = false, bool BLKA = false, bool BLKB = false>
__device__ __forceinline__ void gemm_phase(PG8_LAS unsigned char* lds, const Gemm g, const Sched& S, const Epi& E) {
    const int tid = tid_fresh(), wid = __builtin_amdgcn_readfirstlane(tid >> 6), lane = tid & 63, wr = wid >> 2, wc = wid & 3, fr = lane & 15, fq = lane >> 4;
    const int K = g.K, nt = K / BK;
    unsigned voffA[2], voffB[2];
#pragma unroll
    for (int i = 0; i < 2; ++i) { int R, C; stage_rc(tid * 16 + i * 8192, R, C); const int Rb = Epi::PERM ? ((R & ~31) + perm32(R & 31)) : R;
        const int Ra = Epi::AROWPERM ? ((R & ~63) | (4 * (R & 15) + ((R >> 4) & 3))) : R;
        voffA[i] = (unsigned)(Ra * (BLKA ? BK : g.lda) + C) * 2u; voffB[i] = (unsigned)(Rb * (BLKB ? BK : g.ldb) + C) * 2u; }
    const size_t kstepA = BLKA ? (size_t)BM * BK * 2 : (size_t)(BK * 2), kstepB = BLKB ? (size_t)BM * BK * 2 : (size_t)(BK * 2);
    const size_t hstepA = BLKA ? (size_t)HALF * BK * 2 : (size_t)HALF * g.lda * 2, hstepB = BLKB ? (size_t)HALF * BK * 2 : (size_t)HALF * g.ldb * 2;
    const size_t tstepA = BLKA ? (size_t)nt * BM * BK * 2 : 2 * hstepA, tstepB = BLKB ? (size_t)nt * BM * BK * 2 : 2 * hstepB;
    const unsigned ldsw = (unsigned)wid * 1024u;
    const int aoff = lds_byte(wr * 64 + fr, fq * 8), boff = lds_byte(wc * 32 + fr, fq * 8);
#define PG8_SA(b, h) (((b) * 2 + (h)) * HTB)
#define PG8_SB(b, h) ((4 + (b) * 2 + (h)) * HTB)
#define PG8_STAGE(bufoff, gbase, voff) do { _Pragma("unroll") for (int _i = 0; _i < 2; ++_i) \
        __builtin_amdgcn_global_load_lds((const unsigned*)((const char*)(gbase) + (voff)[_i]), (PG8_LAS unsigned*)(lds + (bufoff) + ldsw + _i * 8192), 16, 0, 0); } while (0)
#define PG8_LDA(dst, b, h) do { _Pragma("unroll") for (int m = 0; m < 4; ++m) _Pragma("unroll") for (int k = 0; k < 2; ++k) dst[m][k] = *(const PG8_LAS bf16x8*)(lds + PG8_SA(b, h) + aoff + m * 2048 + k * 1024); } while (0)
#define PG8_LDB(dst, b, h) do { _Pragma("unroll") for (int n = 0; n < 2; ++n) _Pragma("unroll") for (int k = 0; k < 2; ++k) dst[n][k] = *(const PG8_LAS bf16x8*)(lds + PG8_SB(b, h) + boff + n * 2048 + k * 1024); } while (0)
#define PG8_MMA(ai, bj, At, Bt) do { __builtin_amdgcn_s_setprio(1); _Pragma("unroll") for (int m = 0; m < 4; ++m) _Pragma("unroll") for (int n = 0; n < 2; ++n) _Pragma("unroll") for (int k = 0; k < 2; ++k) \
        acc[ai][bj][m][n] = __builtin_amdgcn_mfma_f32_16x16x32_bf16(Bt[n][k], At[m][k], acc[ai][bj][m][n], 0, 0, 0); __builtin_amdgcn_s_setprio(0); } while (0)
#define PG8_WAIT_V(n) asm volatile("s_waitcnt vmcnt(" #n ")" ::: "memory")
#define PG8_WAIT_L(n) asm volatile("s_waitcnt lgkmcnt(" #n ")" ::: "memory")
#define PG8_BAR __builtin_amdgcn_s_barrier()
#define PG8_SCHED __builtin_amdgcn_sched_barrier(0)
    Unit cur, nxt; int ui = 0;
    if (!S.next(0, cur)) return;
    f32x4 acc[2][2][4][2];
#pragma unroll
    for (int a = 0; a < 2; ++a)
#pragma unroll
        for (int b = 0; b < 2; ++b)
#pragma unroll
            for (int m = 0; m < 4; ++m)
#pragma unroll
                for (int n = 0; n < 2; ++n) acc[a][b][m][n] = (f32x4){0.f, 0.f, 0.f, 0.f};
    bf16x8 At[4][2], B0[2][2], B1[2][2];
    const char* cA = (const char*)g.A + (size_t)cur.pm * tstepA; const char* cB = (const char*)g.Bt + (size_t)cur.pn * tstepB;
    S.a_ready(cur);
    if constexpr (SP2) {
        PG8_STAGE(PG8_SB(0, 0), cB, voffB); PG8_STAGE(PG8_SB(0, 1), cB + hstepB, voffB); PG8_STAGE(PG8_SA(0, 0), cA, voffA); PG8_STAGE(PG8_SA(0, 1), cA + hstepA, voffA);
        if (wr == 1) PG8_BAR;
        PG8_WAIT_V(2); PG8_BAR;
        PG8_STAGE(PG8_SB(1, 0), cB + kstepB, voffB); PG8_STAGE(PG8_SA(1, 0), cA + kstepA, voffA); PG8_STAGE(PG8_SB(1, 1), cB + hstepB + kstepB, voffB);
        PG8_WAIT_V(6); PG8_BAR;
    } else {
        PG8_STAGE(PG8_SB(0, 0), cB, voffB); PG8_STAGE(PG8_SA(0, 0), cA, voffA); PG8_STAGE(PG8_SB(0, 1), cB + hstepB, voffB); PG8_STAGE(PG8_SA(0, 1), cA + hstepA, voffA);
        if (wr == 1) PG8_BAR;
        PG8_WAIT_V(4); PG8_BAR;
        PG8_STAGE(PG8_SB(1, 0), cB + kstepB, voffB); PG8_STAGE(PG8_SA(1, 0), cA + kstepA, voffA); PG8_STAGE(PG8_SB(1, 1), cB + hstepB + kstepB, voffB);
        PG8_WAIT_V(6); PG8_BAR;
    }
    for (;;) {
        const bool has_next = S.next(ui + 1, nxt);
        const char* nA = has_next ? (const char*)g.A + (size_t)nxt.pm * tstepA : cA; const char* nB = has_next ? (const char*)g.Bt + (size_t)nxt.pn * tstepB : cB;
        for (int t = 0; t < nt; t += 2) {
            const bool last = (t == nt - 2);
            const char* a1 = cA + (size_t)(t + 1) * kstepA;
            const char* a2 = last ? nA : cA + (size_t)(t + 2) * kstepA; const char* b2 = last ? nB : cB + (size_t)(t + 2) * kstepB;
            const char* a3 = a2 + kstepA; const char* b3 = b2 + kstepB;
            if (last && has_next) S.a_ready(nxt);
            if constexpr (SP2) {
            PG8_LDB(B0, 0, 0); PG8_LDB(B1, 0, 1); PG8_SCHED; PG8_LDA(At, 0, 0); PG8_STAGE(PG8_SA(1, 1), a1 + hstepA, voffA);
            PG8_WAIT_V(8); PG8_WAIT_L(0); PG8_BAR; PG8_MMA(0, 0, At, B0); PG8_MMA(0, 1, At, B1); PG8_BAR; PG8_SCHED;
            PG8_LDA(At, 0, 1); PG8_STAGE(PG8_SB(0, 0), b2, voffB); PG8_STAGE(PG8_SB(0, 1), b2 + hstepB, voffB); PG8_STAGE(PG8_SA(0, 0), a2, voffA);
            PG8_WAIT_V(8); PG8_WAIT_L(0); PG8_BAR; PG8_MMA(1, 0, At, B0); PG8_MMA(1, 1, At, B1); PG8_BAR; PG8_SCHED;
            PG8_LDB(B0, 1, 0); PG8_LDB(B1, 1, 1); PG8_SCHED; PG8_LDA(At, 1, 0); PG8_STAGE(PG8_SA(0, 1), a2 + hstepA, voffA);
            PG8_WAIT_V(8); PG8_WAIT_L(0); PG8_BAR; PG8_MMA(0, 0, At, B0); PG8_MMA(0, 1, At, B1); PG8_BAR; PG8_SCHED;
            PG8_LDA(At, 1, 1); PG8_STAGE(PG8_SB(1, 0), b3, voffB); PG8_STAGE(PG8_SB(1, 1), b3 + hstepB, voffB); PG8_STAGE(PG8_SA(1, 0), a3, voffA);
            PG8_WAIT_V(8); PG8_WAIT_L(0); PG8_BAR; PG8_MMA(1, 0, At, B0); PG8_MMA(1, 1, At, B1); PG8_BAR; PG8_SCHED;
            } else {
            PG8_LDB(B0, 0, 0); PG8_SCHED; PG8_LDA(At, 0, 0); PG8_STAGE(PG8_SA(1, 1), a1 + hstepA, voffA);
            PG8_WAIT_L(8); PG8_BAR; PG8_WAIT_L(0); PG8_MMA(0, 0, At, B0); PG8_BAR; PG8_SCHED;
            PG8_LDB(B1, 0, 1); PG8_STAGE(PG8_SB(0, 0), b2, voffB);
            PG8_BAR; PG8_WAIT_L(0); PG8_MMA(0, 1, At, B1); PG8_BAR;
            PG8_LDA(At, 0, 1); PG8_STAGE(PG8_SA(0, 0), a2, voffA);
            PG8_BAR; PG8_WAIT_L(0); PG8_MMA(1, 0, At, B0); PG8_BAR; PG8_SCHED;
            PG8_STAGE(PG8_SB(0, 1), b2 + hstepB, voffB);
            PG8_WAIT_V(6); PG8_BAR; PG8_MMA(1, 1, At, B1); PG8_BAR;
            PG8_LDB(B0, 1, 0); PG8_SCHED; PG8_LDA(At, 1, 0); PG8_STAGE(PG8_SA(0, 1), a2 + hstepA, voffA);
            PG8_WAIT_L(8); PG8_BAR; PG8_WAIT_L(0); PG8_MMA(0, 0, At, B0); PG8_BAR; PG8_SCHED;
            PG8_LDB(B1, 1, 1); PG8_STAGE(PG8_SB(1, 0), b3, voffB);
            PG8_BAR; PG8_WAIT_L(0); PG8_MMA(0, 1, At, B1); PG8_BAR;
            PG8_LDA(At, 1, 1); PG8_STAGE(PG8_SA(1, 0), a3, voffA);
            PG8_BAR; PG8_WAIT_L(0); PG8_MMA(1, 0, At, B0); PG8_BAR; PG8_SCHED;
            PG8_STAGE(PG8_SB(1, 1), b3 + hstepB, voffB);
            PG8_WAIT_V(6); PG8_BAR; PG8_MMA(1, 1, At, B1); PG8_BAR;
            }
        }
        if constexpr (ALIGN_EPI) { if (wr == 0) PG8_BAR; }
        if constexpr (!Epi::AFTER_DRAIN) { E(acc, cur, wr, wc, fr, fq); S.done(cur); }
        if (!has_next) break;
#pragma unroll
        for (int a = 0; a < 2; ++a)
#pragma unroll
            for (int b = 0; b < 2; ++b)
#pragma unroll
                for (int m = 0; m < 4; ++m)
#pragma unroll
                    for (int n = 0; n < 2; ++n) acc[a][b][m][n] = (f32x4){0.f, 0.f, 0.f, 0.f};
        cur = nxt; cA = nA; cB = nB; ++ui;
        if constexpr (ALIGN_EPI) { if (wr == 1) PG8_BAR; }
    }
    PG8_WAIT_V(0);
    if constexpr (!ALIGN_EPI) { if (wr == 0) PG8_BAR; }
    PG8_BAR;
    if constexpr (Epi::AFTER_DRAIN) { E.fused(acc, cur, wr, wc, fr, fq, lds, wid, lane); S.done(cur); }
#undef PG8_SA
#undef PG8_SB
#undef PG8_STAGE
#undef PG8_LDA
#undef PG8_LDB
#undef PG8_MMA
#undef PG8_WAIT_V
#undef PG8_WAIT_L
#undef PG8_BAR
#undef PG8_SCHED
}
}
namespace pg8 {
struct EpiBf {
    static constexpr bool PERM = true, AFTER_DRAIN = false, AROWPERM = false;
    bf16_t* O; int ldc; int gelu_tiles;
    const PG8_LAS float* ss; const PG8_LAS float* bvec; mutable int ui;
    __device__ __forceinline__ void operator()(const f32x4 (&acc)[2][2][4][2], const Unit& u, int wr, int wc, int fr, int fq) const {
        const int row0 = u.pm * BM + wr * 64 + fr; const int col0 = u.pn * BM + wc * 32 + 8 * fq;
        const bool act = u.pn < gelu_tiles;
        f32x4 bv[2][2];
        if (ss) { const PG8_LAS float* bp = bvec + ui * BM + wc * 32 + 8 * fq;
#pragma unroll
            for (int bj = 0; bj < 2; ++bj)
#pragma unroll
                for (int n = 0; n < 2; ++n) bv[bj][n] = *(const PG8_LAS f32x4*)(bp + bj * HALF + 4 * n); }
#pragma unroll
        for (int ai = 0; ai < 2; ++ai)
#pragma unroll
            for (int m = 0; m < 4; ++m) { bf16_t* rowp = O + (size_t)(row0 + ai * HALF + m * 16) * ldc + col0;
                float rs = 1.f; if (ss) rs = ss[ui * BM + wr * 64 + fr + ai * HALF + m * 16];
#pragma unroll
                for (int bj = 0; bj < 2; ++bj) { f32x4 v0 = acc[ai][bj][m][0], v1 = acc[ai][bj][m][1];
                    if (ss) { v0 = v0 * rs + bv[bj][0]; v1 = v1 * rs + bv[bj][1]; }
                    if (act) { f32x2 a = gelu_pk((f32x2){v0[0], v0[1]}), b = gelu_pk((f32x2){v0[2], v0[3]}), c = gelu_pk((f32x2){v1[0], v1[1]}), d = gelu_pk((f32x2){v1[2], v1[3]});
                        v0 = (f32x4){a.x, a.y, b.x, b.y}; v1 = (f32x4){c.x, c.y, d.x, d.y}; }
                    u32x4 w; w.x = cvt_pk_bf16(v0[0], v0[1]); w.y = cvt_pk_bf16(v0[2], v0[3]); w.z = cvt_pk_bf16(v1[0], v1[1]); w.w = cvt_pk_bf16(v1[2], v1[3]);
                    *(u32x4*)(rowp + bj * HALF) = w; } }
        ++ui;
    }
};
template <bool XBF, bool OBF>
struct EpiResidT {
    static constexpr bool PERM = true, AFTER_DRAIN = false, AROWPERM = false;
    const void* xa; const void* xb; void* out; const float* gate;
    bf16_t* xg; const float* ga; unsigned long long* ssq;
    __device__ __forceinline__ void operator()(const f32x4 (&acc)[2][2][4][2], const Unit& u, int wr, int wc, int fr, int fq) const {
        const int row0 = u.pm * BM + wr * 64 + fr; const int col0 = u.pn * BM + wc * 32 + 8 * fq;
        const int b = row_batch(u.pm * BM); const void* xin = (u.pm * BM < NPR) ? xa : xb;
        f32x4 gv[2][2], gn[2][2];
#pragma unroll
        for (int bj = 0; bj < 2; ++bj)
#pragma unroll
            for (int n = 0; n < 2; ++n) { gv[bj][n] = *(const f32x4*)(gate + (size_t)b * MODW + col0 + bj * HALF + 4 * n);
                if (xg) gn[bj][n] = *(const f32x4*)(ga + (size_t)b * DM + col0 + bj * HALF + 4 * n); }
#pragma unroll
        for (int aim = 0; aim < 4; ++aim) { const int ai = aim >> 1, mh = (aim & 1) * 2;
            f32x4 xv[2][2][2];
#pragma unroll
            for (int mm = 0; mm < 2; ++mm) { const size_t off = (size_t)(row0 + ai * HALF + (mh + mm) * 16) * DM + col0;
#pragma unroll
                for (int bj = 0; bj < 2; ++bj) {
                    if constexpr (XBF) { const u32x4 w = *(const u32x4*)((const unsigned short*)xin + off + bj * HALF);
                        xv[mm][bj][0] = (f32x4){__uint_as_float(w.x << 16), __uint_as_float(w.x & 0xffff0000u), __uint_as_float(w.y << 16), __uint_as_float(w.y & 0xffff0000u)};
                        xv[mm][bj][1] = (f32x4){__uint_as_float(w.z << 16), __uint_as_float(w.z & 0xffff0000u), __uint_as_float(w.w << 16), __uint_as_float(w.w & 0xffff0000u)}; }
                    else {
#pragma unroll
                        for (int n = 0; n < 2; ++n) xv[mm][bj][n] = *(const f32x4*)((const float*)xin + off + bj * HALF + 4 * n); } } }
#pragma unroll
            for (int mm = 0; mm < 2; ++mm) { const int m = mh + mm; const size_t off = (size_t)(row0 + ai * HALF + m * 16) * DM + col0; float sq = 0.f;
#pragma unroll
                for (int bj = 0; bj < 2; ++bj) { f32x4 xn[2];
#pragma unroll
                    for (int n = 0; n < 2; ++n) {
                        xn[n] = xv[mm][bj][n] + gv[bj][n] * acc[ai][bj][m][n];
                        if constexpr (!OBF) *(f32x4*)((float*)out + off + bj * HALF + 4 * n) = xn[n]; }
                    if constexpr (OBF) { u32x4 w; w.x = cvt_pk_bf16(xn[0][0], xn[0][1]); w.y = cvt_pk_bf16(xn[0][2], xn[0][3]); w.z = cvt_pk_bf16(xn[1][0], xn[1][1]); w.w = cvt_pk_bf16(xn[1][2], xn[1][3]);
                        *(u32x4*)((unsigned short*)out + off + bj * HALF) = w; }
                    if (xg) { const f32x4 a = xn[0] * gn[bj][0], c = xn[1] * gn[bj][1];
                        sq += (xn[0][0] * xn[0][0] + xn[0][1] * xn[0][1]) + (xn[0][2] * xn[0][2] + xn[0][3] * xn[0][3]) + (xn[1][0] * xn[1][0] + xn[1][1] * xn[1][1]) + (xn[1][2] * xn[1][2] + xn[1][3] * xn[1][3]);
                        u32x4 w; w.x = cvt_pk_bf16(a[0], a[1]); w.y = cvt_pk_bf16(a[2], a[3]); w.z = cvt_pk_bf16(c[0], c[1]); w.w = cvt_pk_bf16(c[2], c[3]);
                        *(u32x4*)(xg + off + bj * HALF) = w; } }
                if (xg) { sq += __shfl_xor(sq, 16); sq += __shfl_xor(sq, 32);
                    if (fq == 0) __hip_atomic_fetch_add(ssq + row0 + ai * HALF + m * 16, (unsigned long long)(sq * 16777216.0f + 0.5f), __ATOMIC_RELAXED, __HIP_MEMORY_SCOPE_AGENT); } }
        }
    }
};
}
namespace pg8 {
__device__ __forceinline__ float dpp_prev(float x) { return __int_as_float(__builtin_amdgcn_update_dpp(0, __float_as_int(x), 0x121, 0xF, 0xF, true)); }
__device__ __forceinline__ float dpp_next(float x) { return __int_as_float(__builtin_amdgcn_update_dpp(0, __float_as_int(x), 0x12F, 0xF, 0xF, true)); }
__device__ __forceinline__ float dpp_shr1_old(float oldv, float x) { return __int_as_float(__builtin_amdgcn_update_dpp(__float_as_int(oldv), __float_as_int(x), 0x111, 0xF, 0xF, false)); }
__device__ __forceinline__ float dpp_shl1_old(float oldv, float x) { return __int_as_float(__builtin_amdgcn_update_dpp(__float_as_int(oldv), __float_as_int(x), 0x101, 0xF, 0xF, false)); }
__device__ __forceinline__ f32x4 dpp_shr1_old4(f32x4 o, f32x4 v) { return (f32x4){dpp_shr1_old(o[0], v[0]), dpp_shr1_old(o[1], v[1]), dpp_shr1_old(o[2], v[2]), dpp_shr1_old(o[3], v[3])}; }
__device__ __forceinline__ f32x4 dpp_shl1_old4(f32x4 o, f32x4 v) { return (f32x4){dpp_shl1_old(o[0], v[0]), dpp_shl1_old(o[1], v[1]), dpp_shl1_old(o[2], v[2]), dpp_shl1_old(o[3], v[3])}; }
__device__ __forceinline__ f32x4 dpp_prev4(f32x4 v) { return (f32x4){dpp_prev(v[0]), dpp_prev(v[1]), dpp_prev(v[2]), dpp_prev(v[3])}; }
__device__ __forceinline__ f32x4 dpp_next4(f32x4 v) { return (f32x4){dpp_next(v[0]), dpp_next(v[1]), dpp_next(v[2]), dpp_next(v[3])}; }
struct EpiGate {
    static constexpr bool PERM = true, AFTER_DRAIN = false, AROWPERM = true;
    bf16_t* A; float* ZH; const float* cw; const float* cb; PG8_LAS float* halo;
    const PG8_LAS float* rstab; const float* bvec; mutable int ui;
    __device__ __forceinline__ void operator()(f32x4 (&acc)[2][2][4][2], const Unit& u, int wr, int wc, int fr, int fq) const {
        const int cl = wc * 32 + 8 * fq;
        f32x4 w[2][3], bs[2], bv[2];
#define EG_LOADC(n_) do { const float* bp_ = bvec + (size_t)row_batch(u.pm * BM) * DFF2 + u.pn * BM + cl + 4 * (n_); const int j0_ = u.pn * HALF + cl + 4 * (n_); \
        _Pragma("unroll") for (int bj = 0; bj < 2; ++bj) { bv[bj] = *(const f32x4*)(bp_ + bj * HALF); bs[bj] = *(const f32x4*)(cb + bj * DFF + j0_); } } while (0)
#define EG_LOADW(n_) do { const int j0_ = u.pn * HALF + cl + 4 * (n_); \
        _Pragma("unroll") for (int bj = 0; bj < 2; ++bj) _Pragma("unroll") for (int k = 0; k < 3; ++k) w[bj][k] = *(const f32x4*)(cw + (size_t)k * DFF2 + bj * DFF + j0_); } while (0)
#pragma unroll
        for (int ai = 0; ai < 2; ++ai)
#pragma unroll
            for (int m = 0; m < 4; ++m) { const float rs = rstab[ui * BM + ai * HALF + wr * 64 + 4 * fr + m];
#pragma unroll
                for (int bj = 0; bj < 2; ++bj)
#pragma unroll
                    for (int n = 0; n < 2; ++n) acc[ai][bj][m][n] = acc[ai][bj][m][n] * rs; }
#pragma unroll
        for (int ai = 0; ai < 2; ++ai)
#pragma unroll
            for (int bj = 0; bj < 2; ++bj)
#pragma unroll
                for (int n = 0; n < 2; ++n) { const int blk = ai * 2 + wr, c = bj * HALF + cl + 4 * n;
                    const f32x4 hv = (fr == 0) ? acc[ai][bj][0][n] : acc[ai][bj][3][n];
                    *(PG8_LAS f32x4*)(halo + ((fr == 0) ? (blk * 2) * 256 : (fr == 15) ? (blk * 2 + 1) * 256 : 2048) + c) = hv; }
        asm volatile("s_waitcnt lgkmcnt(0)" ::: "memory"); __builtin_amdgcn_s_barrier(); asm volatile("" ::: "memory");
        const int trow0 = u.pm * BM, pos0 = row_pos(trow0), Lb = batch_len(row_batch(trow0));
        const bool top_ok = (pos0 == 0), bot_ok = (pos0 + BM == Lb);
        const unsigned aoff = ((((unsigned)u.pm * (DFF / 64) + 2 * u.pn + (wc >> 1)) << 14) + 32 * (wc & 1) + 8 * fq) * 2u;
#pragma unroll
        for (int n = 0; n < 2; ++n) {
            EG_LOADW(n); EG_LOADC(n);
            f32x4 cfull[2];
#pragma unroll
            for (int bj = 0; bj < 2; ++bj) cfull[bj] = bs[bj] + bv[bj] * (w[bj][0] + w[bj][1] + w[bj][2]);
            { const unsigned zo = (((unsigned)u.pm * 4) * DFF2 + u.pn * BM + cl + 4 * n) * 4u;
              if (wr == 0 && fr == 0) {
#pragma unroll
                  for (int bj = 0; bj < 2; ++bj) { *(f32x4*)((char*)ZH + (zo + (unsigned)(bj * HALF) * 4u)) = acc[0][bj][0][n] + bv[bj];
                      *(f32x4*)((char*)ZH + (zo + (unsigned)(DFF2 + bj * HALF) * 4u)) = acc[0][bj][1][n] + bv[bj]; } }
              if (wr == 1 && fr == 15) {
#pragma unroll
                  for (int bj = 0; bj < 2; ++bj) { *(f32x4*)((char*)ZH + (zo + (unsigned)(2 * DFF2 + bj * HALF) * 4u)) = acc[1][bj][2][n] + bv[bj];
                      *(f32x4*)((char*)ZH + (zo + (unsigned)(3 * DFF2 + bj * HALF) * 4u)) = acc[1][bj][3][n] + bv[bj]; } } }
#pragma unroll
            for (int ai = 0; ai < 2; ++ai) {
                const int blk = ai * 2 + wr;
                f32x4 hp[2], hn[2];
#pragma unroll
                for (int bj = 0; bj < 2; ++bj) {
                    hp[bj] = (blk > 0) ? *(const PG8_LAS f32x4*)(halo + ((blk - 1) * 2 + 1) * 256 + bj * HALF + cl + 4 * n) : (f32x4){0.f, 0.f, 0.f, 0.f};
                    hn[bj] = (blk < 3) ? *(const PG8_LAS f32x4*)(halo + ((blk + 1) * 2 + 0) * 256 + bj * HALF + cl + 4 * n) : (f32x4){0.f, 0.f, 0.f, 0.f}; }
#pragma unroll
                for (int m = 0; m < 4; ++m) {
                    const int rt = ai * HALF + wr * 64 + 4 * fr + m;
                    f32x4 cv[2];
#pragma unroll
                    for (int bj = 0; bj < 2; ++bj) {
                        const f32x4 cur = acc[ai][bj][m][n];
                        const f32x4 prev = (m > 0) ? acc[ai][bj][m > 0 ? m - 1 : 0][n] : dpp_shr1_old4(hp[bj], acc[ai][bj][3][n]);
                        const f32x4 next = (m < 3) ? acc[ai][bj][m < 3 ? m + 1 : 3][n] : dpp_shl1_old4(hn[bj], acc[ai][bj][0][n]);
                        cv[bj] = w[bj][0] * prev + w[bj][1] * cur + w[bj][2] * next + cfull[bj];
                        if (ai == 0 && m == 0) { if (wr == 0 && fr == 0 && top_ok) cv[bj] = cv[bj] - bv[bj] * w[bj][0]; }
                        if (ai == 1 && m == 3) { if (wr == 1 && fr == 15 && bot_ok) cv[bj] = cv[bj] - bv[bj] * w[bj][2]; } }
                    float o[4];
#pragma unroll
                    for (int e = 0; e < 4; ++e) { const float g = cv[0][e]; o[e] = g * __builtin_amdgcn_rcpf(1.0f + __expf(-g)) * cv[1][e]; }
                    const unsigned p0 = cvt_pk_bf16(o[0], o[1]), p1 = cvt_pk_bf16(o[2], o[3]);
                    {
                      typedef unsigned u32x2e __attribute__((ext_vector_type(2)));
                      *(u32x2e*)((char*)A + (aoff + (unsigned)(rt * 128 + 8 * n))) = (u32x2e){p0, p1}; }
                }
            }
        }
        asm volatile("s_waitcnt lgkmcnt(0)" ::: "memory"); __builtin_amdgcn_s_barrier(); asm volatile("" ::: "memory");
        ++ui;
#undef EG_LOADC
#undef EG_LOADW
    }
};
template <class Sched> __device__ __forceinline__ void fill_tabs(const Sched& S, const unsigned long long* ss, const float* bvec, int ldb, PG8_LAS float* rstab, PG8_LAS float* bvtab, int tid) {
    Unit u;
    for (int i = 0; S.next(i, u); ++i) {
        if (tid < 256) rstab[i * BM + tid] = rsqrtf((float)ss[u.pm * BM + tid] * (1.0f / 16777216.0f) * (1.0f / DM) + EPS);
        else if (bvec) bvtab[i * BM + tid - 256] = bvec[(size_t)row_batch(u.pm * BM) * ldb + u.pn * BM + tid - 256]; }
    __syncthreads();
}
}
namespace att {
using bf16x8 = __attribute__((ext_vector_type(8))) short;
using s16x4  = __attribute__((ext_vector_type(4))) short;
using f32x16 = __attribute__((ext_vector_type(16))) float;
using u32x4  = __attribute__((ext_vector_type(4))) unsigned;
constexpr int NW = 8, QBLK = 32, KVBLK = 64, DV = 128;
constexpr float THR = 8.f;
#define ATT_SBAR() __builtin_amdgcn_sched_barrier(0)
__device__ __forceinline__ int crow(int r, int hi) { return (r & 3) + 8 * (r >> 2) + 4 * hi; }
__device__ __forceinline__ unsigned cvtpk(float lo, float hi) { unsigned r; asm volatile("v_cvt_pk_bf16_f32 %0, %1, %2" : "=v"(r) : "v"(lo), "v"(hi)); return r; }
template <int DK> __device__ __forceinline__ int kswz(int row, int colB) { return row * (2 * DK + 16) + colB; }

template <int DK> __device__ __forceinline__ void partialSM(f32x16& p0, f32x16& p1, float& m_reg, float& mn, float& alpha) {
  constexpr float SCALE = (DK == 128) ? 0.08838834764831845f : 0.07216878364870323f;
  constexpr float C = SCALE * 1.4426950408889634f;
  float pmax = p0[0];
#pragma unroll
  for (int r = 1; r < 16; ++r) pmax = fmaxf(pmax, p0[r]);
#pragma unroll
  for (int r = 0; r < 16; ++r) pmax = fmaxf(pmax, p1[r]);
  { auto rr = __builtin_amdgcn_permlane32_swap(__float_as_uint(pmax), __float_as_uint(pmax), false, false);
    pmax = fmaxf(__uint_as_float(rr[0]), __uint_as_float(rr[1])); }
  if (__builtin_expect(__all(pmax - m_reg <= THR / SCALE), 1)) { mn = m_reg; alpha = 1.f; }
  else { mn = fmaxf(m_reg, pmax); alpha = __builtin_amdgcn_exp2f((m_reg - mn) * C); m_reg = mn; }
  float mnC = -mn * C;
#pragma unroll
  for (int r = 0; r < 16; ++r) p0[r] = fmaf(p0[r], C, mnC);
#pragma unroll
  for (int r = 0; r < 16; ++r) p1[r] = fmaf(p1[r], C, mnC);
#pragma unroll
  for (int r = 0; r < 16; ++r) p0[r] = __builtin_amdgcn_exp2f(p0[r]);
}
__device__ __forceinline__ void finishSM(f32x16& p0, f32x16& p1, float alpha, float& l_reg, bf16x8& pa0, bf16x8& pa1, bf16x8& pa2, bf16x8& pa3) {
#pragma unroll
  for (int r = 0; r < 16; ++r) p1[r] = __builtin_amdgcn_exp2f(p1[r]);
  float ps = 0;
#pragma unroll
  for (int r = 0; r < 16; ++r) ps += p0[r];
#pragma unroll
  for (int r = 0; r < 16; ++r) ps += p1[r];
  { auto rr = __builtin_amdgcn_permlane32_swap(__float_as_uint(ps), __float_as_uint(ps), false, false);
    ps = __uint_as_float(rr[0]) + __uint_as_float(rr[1]); }
  l_reg = l_reg * alpha + ps;
#define ATT_PK4(P, BASE, OUT) do { unsigned a0 = cvtpk(P[BASE + 0], P[BASE + 1]), a1 = cvtpk(P[BASE + 2], P[BASE + 3]);   \
    unsigned b0 = cvtpk(P[BASE + 4], P[BASE + 5]), b1 = cvtpk(P[BASE + 6], P[BASE + 7]);                              \
    auto r0 = __builtin_amdgcn_permlane32_swap(a0, b0, false, false); auto r1 = __builtin_amdgcn_permlane32_swap(a1, b1, false, false); \
    u32x4 w = {r0[0], r1[0], r0[1], r1[1]}; OUT = *reinterpret_cast<bf16x8*>(&w); } while (0)
  ATT_PK4(p0, 0, pa0); ATT_PK4(p0, 8, pa1); ATT_PK4(p1, 0, pa2); ATT_PK4(p1, 8, pa3);
#undef ATT_PK4
}
template <int DK> __device__ __forceinline__ void qkt(f32x16& p0, f32x16& p1, const char* Ks, const bf16x8* qr, const char* ldsb, int qxo, int r32, int hi) {
  p0 = f32x16{}; p1 = f32x16{};
  if constexpr (DK > 128) asm volatile("" : "+v"(qxo));
  const char* qx = ldsb + qxo;
#pragma unroll
  for (int d0 = 0; d0 < DK / 16; ++d0) { int cb = (d0 * 16 + hi * 8) * 2;
    bf16x8 b0 = *reinterpret_cast<const bf16x8*>(Ks + kswz<DK>(r32, cb));
    bf16x8 b1 = *reinterpret_cast<const bf16x8*>(Ks + kswz<DK>(32 + r32, cb));
    bf16x8 qf; if (d0 < 8) qf = qr[d0]; else qf = *reinterpret_cast<const bf16x8*>(qx + (d0 - 8) * 1024);
    p0 = __builtin_amdgcn_mfma_f32_32x32x16_bf16(b0, qf, p0, 0, 0, 0);
    p1 = __builtin_amdgcn_mfma_f32_32x32x16_bf16(b1, qf, p1, 0, 0, 0);
    if ((d0 & 3) == 3) ATT_SBAR(); }
}
__device__ __forceinline__ int v_st(int k, int c) { const int kk = (k & ~0xC) | ((k & 4) << 1) | ((k & 8) >> 1); return ((kk >> 3) * 4 + (c >> 5)) * 512 + ((kk & 7) * 32 + (c & 31)) * 2; }
__device__ __forceinline__ int v_rd_base(int lane) { return ((lane & 3) << 3) | (((lane >> 2) & 3) << 6) | (((lane >> 4) & 1) << 5) | (((lane >> 5) & 1) << 8); }
constexpr int v_rd_off(int d0, int ks, int half) { return d0 * 512 + ks * 4096 + half * 2048; }
template <int OFF> __device__ __forceinline__ s16x4 tr_read(int vb) {
  s16x4 r; asm volatile("ds_read_b64_tr_b16 %0, %1 offset:%2" : "=&v"(r) : "v"(vb), "i"(OFF) : "memory"); return r;
}
template <int D0> __device__ __forceinline__ void pv_one(f32x16& od, int vb, bf16x8 pa0, bf16x8 pa1, bf16x8 pa2, bf16x8 pa3) {
  const s16x4 l0 = tr_read<v_rd_off(D0, 0, 0)>(vb), h0 = tr_read<v_rd_off(D0, 0, 1)>(vb), l1 = tr_read<v_rd_off(D0, 1, 0)>(vb), h1 = tr_read<v_rd_off(D0, 1, 1)>(vb);
  const s16x4 l2 = tr_read<v_rd_off(D0, 2, 0)>(vb), h2 = tr_read<v_rd_off(D0, 2, 1)>(vb), l3 = tr_read<v_rd_off(D0, 3, 0)>(vb), h3 = tr_read<v_rd_off(D0, 3, 1)>(vb);
  asm volatile("s_waitcnt lgkmcnt(0)" ::: "memory"); ATT_SBAR();
#define ATT_PK(L, H) (bf16x8){L[0], L[1], L[2], L[3], H[0], H[1], H[2], H[3]}
  od = __builtin_amdgcn_mfma_f32_32x32x16_bf16(pa0, ATT_PK(l0, h0), od, 0, 0, 0);
  od = __builtin_amdgcn_mfma_f32_32x32x16_bf16(pa1, ATT_PK(l1, h1), od, 0, 0, 0);
  od = __builtin_amdgcn_mfma_f32_32x32x16_bf16(pa2, ATT_PK(l2, h2), od, 0, 0, 0);
  od = __builtin_amdgcn_mfma_f32_32x32x16_bf16(pa3, ATT_PK(l3, h3), od, 0, 0, 0);
#undef ATT_PK
}
__device__ __forceinline__ void pv_d0(f32x16* o, int vb, bf16x8 pa0, bf16x8 pa1, bf16x8 pa2, bf16x8 pa3) {
  pv_one<0>(o[0], vb, pa0, pa1, pa2, pa3); pv_one<1>(o[1], vb, pa0, pa1, pa2, pa3); pv_one<2>(o[2], vb, pa0, pa1, pa2, pa3); pv_one<3>(o[3], vb, pa0, pa1, pa2, pa3);
}
template <int DK> struct Cfg { static constexpr int SHM_V = KVBLK * DV * 2, SHM_K = KVBLK * (DK * 2 + 16), SHM_Q = (DK > 128) ? NW * 4096 : 0, SHM = 2 * SHM_V + 2 * SHM_K + NW * 64 * 4 + SHM_Q; };

template <int DK, int SDEPTH, int ldq, int ldk, int ldv, int ldo>
__device__ __forceinline__ void attn_body(const unsigned short* __restrict__ Qb, const unsigned short* __restrict__ Kh,
                                          const unsigned short* __restrict__ Vh, unsigned short* __restrict__ Ob, int seq, char* lds) {
  constexpr int SHM_V = Cfg<DK>::SHM_V, SHM_K = Cfg<DK>::SHM_K, NQ = (DK > 128 ? 8 : DK / 16), NKI = DK / 64;
  const int tid = tid_fresh(), wid = tid >> 6, lane = tid & 63, r32 = lane & 31, hi = lane >> 5;
  char* V_lds = lds; char* K_lds = lds + 2 * SHM_V;
  float* ws = (float*)(lds + 2 * SHM_V + 2 * SHM_K) + wid * 64; float* li_l = ws; float* al_l = ws + 32;
  float m_reg = -1e30f, l_reg = 0; f32x16 o[4] = {}; bf16x8 qr[NQ];
  const unsigned short* Qw = Qb + (wid * QBLK + r32) * ldq + hi * 8;
#pragma unroll
  for (int d0 = 0; d0 < NQ; ++d0) qr[d0] = *reinterpret_cast<const bf16x8*>(Qw + d0 * 16);
  const int qxo = 2 * SHM_V + 2 * SHM_K + NW * 64 * 4 + wid * 4096 + lane * 16; char* qx = lds + qxo;
  if constexpr (DK > 128) {
#pragma unroll
    for (int d0 = 8; d0 < DK / 16; ++d0) *reinterpret_cast<bf16x8*>(qx + (d0 - 8) * 1024) = *reinterpret_cast<const bf16x8*>(Qw + d0 * 16);
  }
  const int sr = tid >> 4, sc = (tid & 15) * 8, vst0 = v_st(sr, sc);
  const int vgo = sr * ldv + sc;
  const int kr = tid >> 3, kc8 = tid & 7, kgo = kr * ldk + kc8 * 8, kdst = kswz<DK>(kr, kc8 * 16);
  const int vb0 = (int)(uintptr_t)V_lds + v_rd_base(lane);
  struct { bf16x8 vs0, vs1, ks[NKI]; } sr_[SDEPTH];
#define ATT_SLOAD(i, k0) do { const unsigned short* vt_ = Vh + (size_t)(k0) * ldv; const unsigned short* kt_ = Kh + (size_t)(k0) * ldk; \
    sr_[i].vs0 = *reinterpret_cast<const bf16x8*>(vt_ + vgo); sr_[i].vs1 = *reinterpret_cast<const bf16x8*>(vt_ + vgo + 32 * ldv); \
    _Pragma("unroll") for (int q_ = 0; q_ < NKI; ++q_) sr_[i].ks[q_] = *reinterpret_cast<const bf16x8*>(kt_ + kgo + 64 * q_); } while (0)
#define ATT_SWRITE(b, i) do { *(bf16x8*)(V_lds + (b) * SHM_V + vst0) = sr_[i].vs0; *(bf16x8*)(V_lds + (b) * SHM_V + vst0 + 8192) = sr_[i].vs1; \
    _Pragma("unroll") for (int q_ = 0; q_ < NKI; ++q_) *(bf16x8*)(K_lds + (b) * SHM_K + kdst + 128 * q_) = sr_[i].ks[q_]; } while (0)
#define ATT_SWAIT() do { if constexpr (SDEPTH == 2) { if constexpr (NKI == 2) asm volatile("s_waitcnt vmcnt(4)" ::: "memory"); else asm volatile("s_waitcnt vmcnt(5)" ::: "memory"); } else asm volatile("s_waitcnt vmcnt(0)" ::: "memory"); } while (0)
#define ATT_RESC(a) do { if (__any((a) < 1.f)) { if (hi == 0) al_l[r32] = (a); asm volatile("s_waitcnt lgkmcnt(0)" ::: "memory"); \
    _Pragma("unroll") for (int d = 0; d < 4; ++d) _Pragma("unroll") for (int r = 0; r < 16; ++r) o[d][r] *= al_l[crow(r, hi)]; } } while (0)
  f32x16 pA0, pA1, pB0, pB1; float mnA, mnB, alA, alB; bf16x8 pa0, pa1, pa2, pa3; const int NT = seq / KVBLK;
  constexpr int SE = 0, SO = SDEPTH - 1;
  ATT_SLOAD(SE, 0); asm volatile("s_waitcnt vmcnt(0)" ::: "memory"); ATT_SWRITE(0, SE); __syncthreads();
  qkt<DK>(pA0, pA1, K_lds, qr, lds, qxo, r32, hi); partialSM<DK>(pA0, pA1, m_reg, mnA, alA);
  ATT_SLOAD(SO, KVBLK); if constexpr (SDEPTH == 2) { if (2 < NT) ATT_SLOAD(SE, 2 * KVBLK); }
  ATT_SWAIT(); ATT_SWRITE(1, SO); __syncthreads();
  for (int j = 1; j + 1 < NT; j += 2) {
    ATT_SBAR(); qkt<DK>(pB0, pB1, K_lds + SHM_K, qr, lds, qxo, r32, hi);
    finishSM(pA0, pA1, alA, l_reg, pa0, pa1, pa2, pa3); ATT_SBAR();
    ATT_SLOAD(SO, (j + SDEPTH) * KVBLK); ATT_SBAR();
    pv_d0(o, vb0, pa0, pa1, pa2, pa3); partialSM<DK>(pB0, pB1, m_reg, mnB, alB);
    __syncthreads(); ATT_SWAIT(); ATT_SWRITE(0, SE);
    ATT_RESC(alB); __syncthreads();
    ATT_SBAR(); qkt<DK>(pA0, pA1, K_lds, qr, lds, qxo, r32, hi);
    finishSM(pB0, pB1, alB, l_reg, pa0, pa1, pa2, pa3); ATT_SBAR();
    if (SDEPTH == 1 || j + 3 < NT) ATT_SLOAD(SE, (j + 1 + SDEPTH) * KVBLK); ATT_SBAR();
    pv_d0(o, vb0 + SHM_V, pa0, pa1, pa2, pa3); partialSM<DK>(pA0, pA1, m_reg, mnA, alA);
    __syncthreads(); ATT_SWAIT(); ATT_SWRITE(1, SO);
    ATT_RESC(alA); __syncthreads();
  }
  ATT_SBAR(); qkt<DK>(pB0, pB1, K_lds + SHM_K, qr, lds, qxo, r32, hi);
  finishSM(pA0, pA1, alA, l_reg, pa0, pa1, pa2, pa3); ATT_SBAR();
  pv_d0(o, vb0, pa0, pa1, pa2, pa3); partialSM<DK>(pB0, pB1, m_reg, mnB, alB);
  __syncthreads(); ATT_RESC(alB);
  finishSM(pB0, pB1, alB, l_reg, pa0, pa1, pa2, pa3); ATT_SBAR();
  pv_d0(o, vb0 + SHM_V, pa0, pa1, pa2, pa3);
  if (hi == 0) li_l[r32] = l_reg; asm volatile("s_waitcnt lgkmcnt(0)" ::: "memory");
  float rli[16];
#pragma unroll
  for (int r = 0; r < 16; ++r) rli[r] = __builtin_amdgcn_rcpf(li_l[crow(r, hi)]);
  unsigned short* Ow = Ob + (wid * QBLK) * ldo;
#pragma unroll
  for (int r = 0; r < 16; ++r) { int orow = crow(r, hi);
#pragma unroll
    for (int d0 = 0; d0 < 4; ++d0) Ow[orow * ldo + d0 * 32 + r32] = (unsigned short)f2bf(o[d0][r] * rli[r]); }
  __syncthreads();
#undef ATT_SLOAD
#undef ATT_SWRITE
#undef ATT_SWAIT
#undef ATT_RESC
}

template <int DK, int ldq, int ldk, int ldv, int ldo>
__device__ __forceinline__ void attn_body_seq(const unsigned short* __restrict__ Qb, const unsigned short* __restrict__ Kh,
                                              const unsigned short* __restrict__ Vh, unsigned short* __restrict__ Ob, int seq, char* lds) {
  constexpr int SHM_V = Cfg<DK>::SHM_V, SHM_K = Cfg<DK>::SHM_K, NQ = (DK > 128 ? 8 : DK / 16), NKI = DK / 64;
  const int tid = tid_fresh(), wid = tid >> 6, lane = tid & 63, r32 = lane & 31, hi = lane >> 5;
  char* V_lds = lds; char* K_lds = lds + 2 * SHM_V;
  float* ws = (float*)(lds + 2 * SHM_V + 2 * SHM_K) + wid * 64; float* li_l = ws; float* al_l = ws + 32;
  float m_reg = -1e30f, l_reg = 0; f32x16 o[4] = {}; bf16x8 qr[NQ];
  const unsigned short* Qw = Qb + (wid * QBLK + r32) * ldq + hi * 8;
#pragma unroll
  for (int d0 = 0; d0 < NQ; ++d0) qr[d0] = *reinterpret_cast<const bf16x8*>(Qw + d0 * 16);
  const int qxo = 2 * SHM_V + 2 * SHM_K + NW * 64 * 4 + wid * 4096 + lane * 16; char* qx = lds + qxo;
  if constexpr (DK > 128) {
#pragma unroll
    for (int d0 = 8; d0 < DK / 16; ++d0) *reinterpret_cast<bf16x8*>(qx + (d0 - 8) * 1024) = *reinterpret_cast<const bf16x8*>(Qw + d0 * 16);
  }
  const int sr = tid >> 4, sc = (tid & 15) * 8, vst0 = v_st(sr, sc);
  const int vgo = sr * ldv + sc;
  const int kr = tid >> 3, kc8 = tid & 7, kgo = kr * ldk + kc8 * 8, kdst = kswz<DK>(kr, kc8 * 16);
  const int vb0 = (int)(uintptr_t)V_lds + v_rd_base(lane);
  bf16x8 vs0, vs1, ks[NKI];
#define ATT_SLOAD1(k0) do { const unsigned short* vt_ = Vh + (size_t)(k0) * ldv; const unsigned short* kt_ = Kh + (size_t)(k0) * ldk; \
    vs0 = *reinterpret_cast<const bf16x8*>(vt_ + vgo); vs1 = *reinterpret_cast<const bf16x8*>(vt_ + vgo + 32 * ldv); \
    _Pragma("unroll") for (int q_ = 0; q_ < NKI; ++q_) ks[q_] = *reinterpret_cast<const bf16x8*>(kt_ + kgo + 64 * q_); } while (0)
#define ATT_SWRITE1(b) do { *(bf16x8*)(V_lds + (b) * SHM_V + vst0) = vs0; *(bf16x8*)(V_lds + (b) * SHM_V + vst0 + 8192) = vs1; \
    _Pragma("unroll") for (int q_ = 0; q_ < NKI; ++q_) *(bf16x8*)(K_lds + (b) * SHM_K + kdst + 128 * q_) = ks[q_]; } while (0)
  const int NT = seq / KVBLK;
  ATT_SLOAD1(0); ATT_SWRITE1(0); __syncthreads();
#pragma unroll 1
  for (int j = 0; j < NT; ++j) {
    const int b = j & 1;
    f32x16 p0, p1; float mn, al; bf16x8 pa0, pa1, pa2, pa3;
    if (j + 1 < NT) ATT_SLOAD1((j + 1) * KVBLK);
    ATT_SBAR();
    qkt<DK>(p0, p1, K_lds + b * SHM_K, qr, lds, qxo, r32, hi);
    partialSM<DK>(p0, p1, m_reg, mn, al);
    if (__any(al < 1.f)) { if (hi == 0) al_l[r32] = al; asm volatile("s_waitcnt lgkmcnt(0)" ::: "memory");
#pragma unroll
      for (int d = 0; d < 4; ++d)
#pragma unroll
        for (int r = 0; r < 16; ++r) o[d][r] *= al_l[crow(r, hi)]; }
    finishSM(p0, p1, al, l_reg, pa0, pa1, pa2, pa3); ATT_SBAR();
    pv_d0(o, vb0 + b * SHM_V, pa0, pa1, pa2, pa3);
    if (j + 1 < NT) ATT_SWRITE1(b ^ 1);
    __syncthreads();
  }
  if (hi == 0) li_l[r32] = l_reg; asm volatile("s_waitcnt lgkmcnt(0)" ::: "memory");
  float rli[16];
#pragma unroll
  for (int r = 0; r < 16; ++r) rli[r] = __builtin_amdgcn_rcpf(li_l[crow(r, hi)]);
  unsigned short* Ow = Ob + (wid * QBLK) * ldo;
#pragma unroll
  for (int r = 0; r < 16; ++r) { int orow = crow(r, hi);
#pragma unroll
    for (int d0 = 0; d0 < 4; ++d0) Ow[orow * ldo + d0 * 32 + r32] = (unsigned short)f2bf(o[d0][r] * rli[r]); }
  __syncthreads();
#undef ATT_SLOAD1
#undef ATT_SWRITE1
}

template <int DK> __device__ __forceinline__ void qk_half(f32x16& p, const char* Ks, int rowoff, const bf16x8* qr, const char* ldsb, int qxo, int r32, int hi) {
  p = f32x16{};
  const char* qx = ldsb + qxo;
#pragma unroll
  for (int d0 = 0; d0 < DK / 16; ++d0) { int cb = (d0 * 16 + hi * 8) * 2;
    bf16x8 b0 = *reinterpret_cast<const bf16x8*>(Ks + kswz<DK>(rowoff + r32, cb));
    bf16x8 qf; if (d0 < 8) qf = qr[d0]; else qf = *reinterpret_cast<const bf16x8*>(qx + (d0 - 8) * 1024);
    p = __builtin_amdgcn_mfma_f32_32x32x16_bf16(b0, qf, p, 0, 0, 0); }
}
template <int KH> __device__ __forceinline__ void pv_half(f32x16* o, int vb, bf16x8 pa, bf16x8 pb) {
#define ATT_PK(L, H) (bf16x8){L[0], L[1], L[2], L[3], H[0], H[1], H[2], H[3]}
#define ATT_PVD(D0) do { const s16x4 l0 = tr_read<v_rd_off(D0, 2 * KH, 0)>(vb), h0 = tr_read<v_rd_off(D0, 2 * KH, 1)>(vb), l1 = tr_read<v_rd_off(D0, 2 * KH + 1, 0)>(vb), h1 = tr_read<v_rd_off(D0, 2 * KH + 1, 1)>(vb); \
    asm volatile("s_waitcnt lgkmcnt(0)" ::: "memory"); ATT_SBAR();   \
    o[D0] = __builtin_amdgcn_mfma_f32_32x32x16_bf16(pa, ATT_PK(l0, h0), o[D0], 0, 0, 0); o[D0] = __builtin_amdgcn_mfma_f32_32x32x16_bf16(pb, ATT_PK(l1, h1), o[D0], 0, 0, 0); } while (0)
  ATT_PVD(0); ATT_PVD(1); ATT_PVD(2); ATT_PVD(3);
#undef ATT_PVD
#undef ATT_PK
}
__device__ __forceinline__ float exp_pack(f32x16& p, bf16x8& pa, bf16x8& pb) {
#pragma unroll
  for (int r = 0; r < 16; ++r) p[r] = __builtin_amdgcn_exp2f(p[r]);
  float ps = 0.f;
#pragma unroll
  for (int r = 0; r < 16; ++r) ps += p[r];
#define ATT_PK4(P, BASE, OUT) do { unsigned a0 = cvtpk(P[BASE + 0], P[BASE + 1]), a1 = cvtpk(P[BASE + 2], P[BASE + 3]);   \
    unsigned b0 = cvtpk(P[BASE + 4], P[BASE + 5]), b1 = cvtpk(P[BASE + 6], P[BASE + 7]);                              \
    auto r0 = __builtin_amdgcn_permlane32_swap(a0, b0, false, false); auto r1 = __builtin_amdgcn_permlane32_swap(a1, b1, false, false); \
    u32x4 w = {r0[0], r1[0], r0[1], r1[1]}; OUT = *reinterpret_cast<bf16x8*>(&w); } while (0)
  ATT_PK4(p, 0, pa); ATT_PK4(p, 8, pb);
#undef ATT_PK4
  return ps;
}
template <int DK, int ldq, int ldk, int ldv, int ldo>
__device__ __forceinline__ void attn_body_nomax(const unsigned short* __restrict__ Qb, const unsigned short* __restrict__ Kh,
                                                const unsigned short* __restrict__ Vh, unsigned short* __restrict__ Ob, int seq, char* lds) {
  constexpr int SHM_V = Cfg<DK>::SHM_V, SHM_K = Cfg<DK>::SHM_K, NQ = (DK > 128 ? 8 : DK / 16), NKI = DK / 64;
  const int tid = tid_fresh(), wid = tid >> 6, lane = tid & 63, r32 = lane & 31, hi = lane >> 5;
  char* V_lds = lds; char* K_lds = lds + 2 * SHM_V;
  float* ws = (float*)(lds + 2 * SHM_V + 2 * SHM_K) + wid * 64; float* li_l = ws;
  float l_reg = 0; f32x16 o[4] = {}; bf16x8 qr[NQ];
  const unsigned short* Qw = Qb + (wid * QBLK + r32) * ldq + hi * 8;
#pragma unroll
  for (int d0 = 0; d0 < NQ; ++d0) qr[d0] = *reinterpret_cast<const bf16x8*>(Qw + d0 * 16);
  int qxo = 2 * SHM_V + 2 * SHM_K + NW * 64 * 4 + wid * 4096 + lane * 16; char* qx = lds + qxo;
  if constexpr (DK > 128) {
#pragma unroll
    for (int d0 = 8; d0 < DK / 16; ++d0) *reinterpret_cast<bf16x8*>(qx + (d0 - 8) * 1024) = *reinterpret_cast<const bf16x8*>(Qw + d0 * 16);
  }
  const int sr = tid >> 4, sc = (tid & 15) * 8, vst0 = v_st(sr, sc);
  const int vgo = sr * ldv + sc;
  const int kr = tid >> 3, kc8 = tid & 7, kgo = kr * ldk + kc8 * 8, kdst = kswz<DK>(kr, kc8 * 16);
  const int vb0 = (int)(uintptr_t)V_lds + v_rd_base(lane);
  bf16x8 vs0, vs1, ks[NKI];
#define ATT_SLOAD1(k0) do { const unsigned short* vt_ = Vh + (size_t)(k0) * ldv; const unsigned short* kt_ = Kh + (size_t)(k0) * ldk; \
    vs0 = *reinterpret_cast<const bf16x8*>(vt_ + vgo); vs1 = *reinterpret_cast<const bf16x8*>(vt_ + vgo + 32 * ldv); \
    _Pragma("unroll") for (int q_ = 0; q_ < NKI; ++q_) ks[q_] = *reinterpret_cast<const bf16x8*>(kt_ + kgo + 64 * q_); } while (0)
#define ATT_SWRITE1(b) do { *(bf16x8*)(V_lds + (b) * SHM_V + vst0) = vs0; *(bf16x8*)(V_lds + (b) * SHM_V + vst0 + 8192) = vs1; \
    _Pragma("unroll") for (int q_ = 0; q_ < NKI; ++q_) *(bf16x8*)(K_lds + (b) * SHM_K + kdst + 128 * q_) = ks[q_]; } while (0)
  const int NT = seq / KVBLK;
  ATT_SLOAD1(0); ATT_SWRITE1(0); __syncthreads();
#pragma unroll 1
  for (int j = 0; j < NT; ++j) {
    const int b = j & 1;
    f32x16 p0, p1; bf16x8 pa0, pa1, pa2, pa3;
    if (j + 1 < NT) ATT_SLOAD1((j + 1) * KVBLK);
    if constexpr (DK > 128) asm volatile("" : "+v"(qxo));
    ATT_SBAR();
    qk_half<DK>(p0, K_lds + b * SHM_K, 0, qr, lds, qxo, r32, hi);
    ATT_SBAR();
    qk_half<DK>(p1, K_lds + b * SHM_K, 32, qr, lds, qxo, r32, hi);
    float ps = exp_pack(p0, pa0, pa1);
    ATT_SBAR();
    pv_half<0>(o, vb0 + b * SHM_V, pa0, pa1);
    ps += exp_pack(p1, pa2, pa3);
    ATT_SBAR();
    pv_half<1>(o, vb0 + b * SHM_V, pa2, pa3);
    l_reg += ps;
    if (j + 1 < NT) ATT_SWRITE1(b ^ 1);
    __syncthreads();
  }
  { auto rr = __builtin_amdgcn_permlane32_swap(__float_as_uint(l_reg), __float_as_uint(l_reg), false, false); l_reg = __uint_as_float(rr[0]) + __uint_as_float(rr[1]); }
  if (hi == 0) li_l[r32] = l_reg; asm volatile("s_waitcnt lgkmcnt(0)" ::: "memory");
  float rli[16];
#pragma unroll
  for (int r = 0; r < 16; ++r) rli[r] = __builtin_amdgcn_rcpf(li_l[crow(r, hi)]);
  unsigned short* Ow = Ob + (wid * QBLK) * ldo;
#pragma unroll
  for (int r = 0; r < 16; ++r) { int orow = crow(r, hi);
#pragma unroll
    for (int d0 = 0; d0 < 4; ++d0) Ow[orow * ldo + d0 * 32 + r32] = (unsigned short)f2bf(o[d0][r] * rli[r]); }
  __syncthreads();
#undef ATT_SLOAD1
#undef ATT_SWRITE1
}

typedef float f32x4a __attribute__((ext_vector_type(4)));
__device__ __forceinline__ int v16_st(int key, int d) { return (((key >> 4) * 8 + (d >> 4)) * 4 + ((key >> 2) & 3)) * 128 + ((key & 3) * 16 + (d & 15)) * 2; }
template <int OFF> __device__ __forceinline__ s16x4 tr_read16(int vb) { s16x4 r; asm volatile("ds_read_b64_tr_b16 %0, %1 offset:%2" : "=&v"(r) : "v"(vb), "i"(OFF) : "memory"); return r; }
template <int NDS, int ST>
__device__ __forceinline__ void sgb_steps() {
  if constexpr (ST < 4 * NDS) {
    __builtin_amdgcn_sched_group_barrier(0x008, 2, 0);
    if constexpr (ST >= NDS) __builtin_amdgcn_sched_group_barrier(0x400, (((ST % NDS) + 1) * 8) / NDS - ((ST % NDS) * 8) / NDS, 0);
    if constexpr (ST + 4 < 4 * NDS) __builtin_amdgcn_sched_group_barrier(0x100, 1, 0);
    sgb_steps<NDS, ST + 1>();
  }
}
template <int DK, int ldq, int ldk, int ldv, int ldo>
__device__ __forceinline__ void attn_body16(const unsigned short* __restrict__ Qb, const unsigned short* __restrict__ Kh,
                                            const unsigned short* __restrict__ Vh, unsigned short* __restrict__ Ob, int seq, char* lds) {
  constexpr int SHM_V = KVBLK * DV * 2, KP = 2 * DK + 16, SHM_K = KVBLK * KP, NDS = DK / 32, NKI = DK / 64;
  const int tid = tid_fresh(), wid = tid >> 6, lane = tid & 63, c16 = lane & 15, g = lane >> 4;
  char* V_lds = lds; char* K_lds = lds + 2 * SHM_V;
  f32x4a ot[8][2]; float lsum[2] = {0.f, 0.f}; bf16x8 qf[2][NDS];
#pragma unroll
  for (int db = 0; db < 8; ++db) { ot[db][0] = (f32x4a){0.f, 0.f, 0.f, 0.f}; ot[db][1] = (f32x4a){0.f, 0.f, 0.f, 0.f}; }
#pragma unroll
  for (int qb = 0; qb < 2; ++qb)
#pragma unroll
    for (int ds = 0; ds < NDS; ++ds) qf[qb][ds] = *reinterpret_cast<const bf16x8*>(Qb + (wid * QBLK + 16 * qb + c16) * ldq + 32 * ds + 8 * g);
  const int sr = tid >> 4, sc = (tid & 15) * 8, vst0 = v16_st(sr, sc), vst1 = v16_st(32 + sr, sc);
  const int vgo = sr * ldv + sc;
  const int kr = tid >> 3, kc8 = tid & 7, kgo = kr * ldk + kc8 * 8, kdst = kr * KP + kc8 * 16;
  const int kfo = c16 * KP + 16 * g;
  const int vb0 = (int)(uintptr_t)V_lds + g * 128 + 8 * c16;
  bf16x8 vs0, vs1, ks[NKI];
#define A16_SLOAD(k0) do { const unsigned short* vt_ = Vh + (size_t)(k0) * ldv; const unsigned short* kt_ = Kh + (size_t)(k0) * ldk; \
    vs0 = *reinterpret_cast<const bf16x8*>(vt_ + vgo); vs1 = *reinterpret_cast<const bf16x8*>(vt_ + vgo + 32 * ldv); \
    _Pragma("unroll") for (int q_ = 0; q_ < NKI; ++q_) ks[q_] = *reinterpret_cast<const bf16x8*>(kt_ + kgo + 64 * q_); } while (0)
#define A16_SWRITE(b) do { *(bf16x8*)(V_lds + (b) * SHM_V + vst0) = vs0; *(bf16x8*)(V_lds + (b) * SHM_V + vst1) = vs1; \
    _Pragma("unroll") for (int q_ = 0; q_ < NKI; ++q_) *(bf16x8*)(K_lds + (b) * SHM_K + kdst + 128 * q_) = ks[q_]; } while (0)
  const int NT = seq / KVBLK;
  A16_SLOAD(0); A16_SWRITE(0); __syncthreads();
#pragma unroll 1
  for (int j = 0; j < NT; ++j) {
    const int b = j & 1;
    if (j + 1 < NT) A16_SLOAD((j + 1) * KVBLK);
    ATT_SBAR();
    f32x4a sct[4][2];
    const char* Kt = K_lds + b * SHM_K + kfo;
#define A16_EXP(kb_, e_) do { sct[kb_][(e_) >> 2][(e_) & 3] = __builtin_amdgcn_exp2f(sct[kb_][(e_) >> 2][(e_) & 3]); } while (0)
    bf16x8 kq[4];
#pragma unroll
    for (int s0 = 0; s0 < 3; ++s0) kq[s0] = *reinterpret_cast<const bf16x8*>(Kt + (s0 / NDS) * 16 * KP + (s0 % NDS) * 64);
#pragma unroll
    for (int kb = 0; kb < 4; ++kb) {
      sct[kb][0] = (f32x4a){0.f, 0.f, 0.f, 0.f}; sct[kb][1] = (f32x4a){0.f, 0.f, 0.f, 0.f};
#pragma unroll
      for (int ds = 0; ds < NDS; ++ds) { const int st = kb * NDS + ds, sn = st + 3;
        if (sn < 4 * NDS) kq[sn & 3] = *reinterpret_cast<const bf16x8*>(Kt + (sn / NDS) * 16 * KP + (sn % NDS) * 64);
        sct[kb][0] = __builtin_amdgcn_mfma_f32_16x16x32_bf16(kq[st & 3], qf[0][ds], sct[kb][0], 0, 0, 0);
        sct[kb][1] = __builtin_amdgcn_mfma_f32_16x16x32_bf16(kq[st & 3], qf[1][ds], sct[kb][1], 0, 0, 0);
        if (kb > 0) {
#pragma unroll
          for (int e = (ds * 8) / NDS; e < ((ds + 1) * 8) / NDS; ++e) A16_EXP(kb > 0 ? kb - 1 : 0, e); }
        ATT_SBAR(); } }
    bf16x8 pf[2][2];
#define A16_PACK(ksp_) do { _Pragma("unroll") for (int qb = 0; qb < 2; ++qb) { u32x4 w; w.x = cvtpk(sct[2 * (ksp_)][qb][0], sct[2 * (ksp_)][qb][1]); w.y = cvtpk(sct[2 * (ksp_)][qb][2], sct[2 * (ksp_)][qb][3]); \
        w.z = cvtpk(sct[2 * (ksp_) + 1][qb][0], sct[2 * (ksp_) + 1][qb][1]); w.w = cvtpk(sct[2 * (ksp_) + 1][qb][2], sct[2 * (ksp_) + 1][qb][3]); pf[qb][ksp_] = __builtin_bit_cast(bf16x8, w); \
        lsum[qb] += ((sct[2 * (ksp_)][qb][0] + sct[2 * (ksp_)][qb][1]) + (sct[2 * (ksp_)][qb][2] + sct[2 * (ksp_)][qb][3])) + ((sct[2 * (ksp_) + 1][qb][0] + sct[2 * (ksp_) + 1][qb][1]) + (sct[2 * (ksp_) + 1][qb][2] + sct[2 * (ksp_) + 1][qb][3])); } } while (0)
    const int vb = vb0 + b * SHM_V;
    s16x4 ta[4][2], tb[4][2];
#define A16_RD(T, KSP, DB0) do { \
      T[0][0] = tr_read16<(2 * KSP) * 4096 + (DB0 + 0) * 512>(vb); T[0][1] = tr_read16<(2 * KSP + 1) * 4096 + (DB0 + 0) * 512>(vb); \
      T[1][0] = tr_read16<(2 * KSP) * 4096 + (DB0 + 1) * 512>(vb); T[1][1] = tr_read16<(2 * KSP + 1) * 4096 + (DB0 + 1) * 512>(vb); \
      T[2][0] = tr_read16<(2 * KSP) * 4096 + (DB0 + 2) * 512>(vb); T[2][1] = tr_read16<(2 * KSP + 1) * 4096 + (DB0 + 2) * 512>(vb); \
      T[3][0] = tr_read16<(2 * KSP) * 4096 + (DB0 + 3) * 512>(vb); T[3][1] = tr_read16<(2 * KSP + 1) * 4096 + (DB0 + 3) * 512>(vb); } while (0)
#define A16_WAIT() do { asm volatile("s_waitcnt lgkmcnt(0)" ::: "memory"); ATT_SBAR(); } while (0)
#define A16_MM(T, KSP, DB0, X) do { \
      _Pragma("unroll") for (int d_ = 0; d_ < 4; ++d_) { const bf16x8 vf = (bf16x8){T[d_][0][0], T[d_][0][1], T[d_][0][2], T[d_][0][3], T[d_][1][0], T[d_][1][1], T[d_][1][2], T[d_][1][3]}; \
        ot[DB0 + d_][0] = __builtin_amdgcn_mfma_f32_16x16x32_bf16(vf, pf[0][KSP], ot[DB0 + d_][0], 0, 0, 0); \
        ot[DB0 + d_][1] = __builtin_amdgcn_mfma_f32_16x16x32_bf16(vf, pf[1][KSP], ot[DB0 + d_][1], 0, 0, 0); } X; ATT_SBAR(); } while (0)
#define A16_PIN(qb_) asm volatile("" : "+v"(sct[3][qb_][0]), "+v"(sct[3][qb_][1]), "+v"(sct[3][qb_][2]), "+v"(sct[3][qb_][3]))
    A16_RD(ta, 0, 0);
    ATT_SBAR();
    A16_PACK(0);
    ATT_SBAR();
    A16_WAIT();
    A16_RD(tb, 0, 4); ATT_SBAR();
    A16_MM(ta, 0, 0, { A16_PIN(0); A16_EXP(3, 0); A16_EXP(3, 1); A16_EXP(3, 2); A16_EXP(3, 3); A16_PIN(0); });
    A16_WAIT();
    A16_RD(ta, 1, 0); ATT_SBAR();
    A16_MM(tb, 0, 4, { A16_PIN(1); A16_EXP(3, 4); A16_EXP(3, 5); A16_EXP(3, 6); A16_EXP(3, 7); A16_PIN(1); });
    A16_PACK(1);
    ATT_SBAR();
    A16_WAIT();
    A16_RD(tb, 1, 4); ATT_SBAR();
    A16_MM(ta, 1, 0, {});
    A16_WAIT();
    A16_MM(tb, 1, 4, { if (j + 1 < NT) A16_SWRITE(b ^ 1); });
#undef A16_PIN
#undef A16_RD
#undef A16_WAIT
#undef A16_MM
#undef A16_PACK
#undef A16_EXP
    __syncthreads();
  }
#pragma unroll
  for (int qb = 0; qb < 2; ++qb) { float l = lsum[qb]; l += __shfl_xor(l, 16); l += __shfl_xor(l, 32); const float rl = __builtin_amdgcn_rcpf(l);
    unsigned short* Or = Ob + (wid * QBLK + 16 * qb + c16) * ldo + 4 * g;
#pragma unroll
    for (int db = 0; db < 8; ++db) { typedef unsigned u32x2a __attribute__((ext_vector_type(2)));
      u32x2a w; w.x = pk2(ot[db][qb][0] * rl, ot[db][qb][1] * rl); w.y = pk2(ot[db][qb][2] * rl, ot[db][qb][3] * rl);
      *(u32x2a*)(Or + 16 * db) = w; } }
  __syncthreads();
#undef A16_SLOAD
#undef A16_SWRITE
}
#undef ATT_SBAR
}
namespace hy {
using bf16x8 = __attribute__((ext_vector_type(8))) short;
using f32x16 = __attribute__((ext_vector_type(16))) float;
using u32x4  = __attribute__((ext_vector_type(4))) unsigned;
using u32x2  = __attribute__((ext_vector_type(2))) unsigned;
template <int L> struct HC {
    static constexpr int NMB = L / 2048, NCH = (L == 4096) ? 2 : 4, UST = L + 160, GRN = 2 * L / 64 * 72;
    static constexpr int UB = 4 * UST * 2, GB = GRN * 2, CHB = UB + GB, NK4 = L / 64 + 1;
    static_assert(NCH * CHB <= RING_BYTES, "hyena LDS");
};
__device__ __forceinline__ int crow(int r, int hi) { return (r & 3) + 8 * (r >> 2) + 4 * hi; }
__device__ __forceinline__ float bf2f(unsigned short v) { return __uint_as_float((unsigned)v << 16); }

typedef float f32x4h __attribute__((ext_vector_type(4)));
template <int L>
__device__ __forceinline__ void conv_kloop16(f32x4h (&acc)[2][8], const LAS char* gA, const LAS char* uB) {
    constexpr int NK2 = L / 64 + 1;
#pragma unroll
    for (int a = 0; a < 2; ++a)
#pragma unroll
        for (int r = 0; r < 8; ++r) acc[a][r] = (f32x4h){0.f, 0.f, 0.f, 0.f};
    for (int kk2 = 0; kk2 < NK2; ++kk2) {
#pragma unroll
        for (int h = 0; h < 2; ++h) {
            const bf16x8 A = *(const LAS bf16x8*)(gA + kk2 * 144 + h * 64);
#pragma unroll
            for (int nh = 0; nh < 2; ++nh) {
                const u32x4 w0 = *(const LAS u32x4*)(uB + kk2 * 128 + h * 64 + nh * 64);
                const u32x4 w1 = *(const LAS u32x4*)(uB + kk2 * 128 + h * 64 + nh * 64 + 16);
                const unsigned w[8] = {w0.x, w0.y, w0.z, w0.w, w1.x, w1.y, w1.z, w1.w};
#pragma unroll
                for (int r = 0; r < 8; ++r) { u32x4 bf;
                    if ((r & 1) == 0) { const int q = r >> 1; bf = (u32x4){w[q], w[q + 1], w[q + 2], w[q + 3]}; }
                    else { const int q = (r - 1) >> 1;
                        bf = (u32x4){__builtin_amdgcn_alignbit(w[q + 1], w[q], 16), __builtin_amdgcn_alignbit(w[q + 2], w[q + 1], 16),
                                     __builtin_amdgcn_alignbit(w[q + 3], w[q + 2], 16), __builtin_amdgcn_alignbit(w[q + 4], w[q + 3], 16)}; }
                    acc[nh][r] = __builtin_amdgcn_mfma_f32_16x16x32_bf16(A, __builtin_bit_cast(bf16x8, bf), acc[nh][r], 0, 0, 0); }
            }
        }
    }
}

template <int L>
__device__ __forceinline__ void hyena_unit(LAS char* lds, const unsigned short* GFl, const unsigned short* X1T, const unsigned short* X2T, const unsigned short* VT,
                                           unsigned short* Y2T, const float* skip  , int b0, int c0) {
    using C = HC<L>;
    constexpr int NCH = C::NCH, UST = C::UST, GRN = C::GRN, UB = C::UB, GB = C::GB, CHB = C::CHB, WPC = 8 / NCH;
    static_assert(L / 1024 == WPC, "one wave per (channel, 1024-output block)");
    const int tid = tid_fresh(), wid = __builtin_amdgcn_readfirstlane(tid >> 6), lane = tid & 63;
    const int ch = wid / WPC, Mb = wid % WPC;
    const int c16 = lane & 15, g = lane >> 4, np = c16 >> 2, bb = c16 & 3;
    LAS char* Uch = lds + ch * CHB; LAS char* Gch = Uch + UB;
    const LAS char* gA = Gch + 2 * ((L / 64 - 16 * Mb - c16 - 1) * 72 + 8 * g);
    const LAS char* uB = Uch + 2 * (bb * UST + 8 * g + 8 * np);
    const int c = c0 + ch;
    u32x4 y1p[2][4];
#pragma unroll 1
    for (int o = 0; o < 2; ++o) {
        { constexpr int NG = NCH * (GB / 16), NGI = (NG + NTHR - 1) / NTHR; u32x4 gv[NGI];
#pragma unroll
          for (int i = 0; i < NGI; ++i) { const int id = tid + i * NTHR, cc = id / (GB / 16), off = id % (GB / 16);
              gv[i] = (id < NG) ? *(const u32x4*)((const char*)(GFl + ((size_t)(o * 512 + c0 + cc)) * GRN) + off * 16) : (u32x4){0u, 0u, 0u, 0u}; }
          if (o == 0) {
              constexpr int NU = NCH * 4 * (L / 8), NUI = NU / NTHR; static_assert(NU % NTHR == 0, "u staging"); u32x4 uv_[NUI];
#pragma unroll
              for (int i = 0; i < NUI; ++i) { const int id = tid + i * NTHR, cb = id / (L / 8), off = id % (L / 8), cc = cb >> 2, b = cb & 3;
                  uv_[i] = *(const u32x4*)(VT + xt_off(b0 + b, c0 + cc) + off * 8); }
#pragma unroll
              for (int i = 0; i < NUI; ++i) { const int id = tid + i * NTHR, cb = id / (L / 8), off = id % (L / 8), cc = cb >> 2, b = cb & 3;
                  *(LAS u32x4*)(lds + cc * CHB + (b * UST + 64) * 2 + off * 16) = uv_[i]; }
              for (int id = tid; id < NCH * 4 * 20; id += NTHR) { const int cb = id / 20, k = id % 20, cc = cb >> 2, b = cb & 3;
                  const int el = k < 8 ? k * 8 : (L + 64) + (k - 8) * 8;
                  *(LAS u32x4*)(lds + cc * CHB + (b * UST + el) * 2) = (u32x4){0u, 0u, 0u, 0u}; }
          }
#pragma unroll
          for (int i = 0; i < NGI; ++i) { const int id = tid + i * NTHR, cc = id / (GB / 16), off = id % (GB / 16);
              if (id < NG) *(LAS u32x4*)(lds + cc * CHB + UB + off * 16) = gv[i]; } }
        if (o == 1) {
#pragma unroll
            for (int nh = 0; nh < 2; ++nh)
#pragma unroll
                for (int i = 0; i < 4; ++i) { const int t0 = 1024 * Mb + 64 * (4 * g + i) + 32 * nh + 8 * np;
                    *(LAS u32x4*)(Uch + (bb * UST + 64 + t0) * 2) = y1p[nh][i]; }
        }
        __syncthreads();
        f32x4h acc[2][8];
        conv_kloop16<L>(acc, gA, uB);
        const float sk = skip[o * 512 + c];
        const unsigned short* XT = (o == 0) ? X1T : X2T;
        const size_t gbase = xt_off(b0 + bb, c);
        u32x4 xvs[2][4];
#pragma unroll
        for (int nh = 0; nh < 2; ++nh)
#pragma unroll
            for (int i = 0; i < 4; ++i) { const int t0 = 1024 * Mb + 64 * (4 * g + i) + 32 * nh + 8 * np; xvs[nh][i] = *(const u32x4*)(XT + gbase + t0); }
#pragma unroll
        for (int nh = 0; nh < 2; ++nh)
#pragma unroll
            for (int i = 0; i < 4; ++i) { const int t0 = 1024 * Mb + 64 * (4 * g + i) + 32 * nh + 8 * np;
                const u32x4 xv = xvs[nh][i];
                const u32x4 uv = *(const LAS u32x4*)(Uch + (bb * UST + 64 + t0) * 2);
                const unsigned xw[4] = {xv.x, xv.y, xv.z, xv.w}, uw[4] = {uv.x, uv.y, uv.z, uv.w}; unsigned pw[4];
#pragma unroll
                for (int q = 0; q < 4; ++q) {
                    const float ylo = bf2f((unsigned short)(xw[q] & 0xffff)) * (acc[nh][2 * q][i] + sk * bf2f((unsigned short)(uw[q] & 0xffff)));
                    const float yhi = bf2f((unsigned short)(xw[q] >> 16)) * (acc[nh][2 * q + 1][i] + sk * bf2f((unsigned short)(uw[q] >> 16)));
                    pw[q] = pk2(ylo, yhi); }
                const u32x4 p = (u32x4){pw[0], pw[1], pw[2], pw[3]};
                if (o == 0) y1p[nh][i] = p;
                else *(u32x4*)(Y2T + gbase + t0) = p; }
        __syncthreads();
    }
}
}
typedef unsigned u32x2v __attribute__((ext_vector_type(2)));
__device__ __forceinline__ float bf2f(unsigned short v) { return __uint_as_float((unsigned)v << 16); }
__device__ __forceinline__ float bflo(unsigned w) { return __uint_as_float(w << 16); }
__device__ __forceinline__ float bfhi(unsigned w) { return __uint_as_float(w & 0xffff0000u); }
__device__ __forceinline__ float wave_sum(float v) {
#pragma unroll
    for (int o = 1; o < 64; o <<= 1) v += __shfl_xor(v, o);
    return v;
}
__device__ __forceinline__ void unpack8(const v4u& w, float (&f)[8]) {
    f[0] = bflo(w.x); f[1] = bfhi(w.x); f[2] = bflo(w.y); f[3] = bfhi(w.y); f[4] = bflo(w.z); f[5] = bfhi(w.z); f[6] = bflo(w.w); f[7] = bfhi(w.w);
}
__device__ __forceinline__ v4u pack8(const float (&f)[8]) { v4u w; w.x = pk2(f[0], f[1]); w.y = pk2(f[2], f[3]); w.z = pk2(f[4], f[5]); w.w = pk2(f[6], f[7]); return w; }

__device__ __forceinline__ void norm_rows(const float* xa, const float* xb, const float* g, const float* mod  , int sh_off, int sc_off, bf16* H, int gw, int ngw, int lane) {
    for (int ck = gw; ck < NTOK / 4; ck += ngw) {
        const int row0 = ck * 4, b = row_batch(row0);
        const float* xin = row0 < NPR ? xa : xb;
        const float* sc = mod + (size_t)b * MODW + sc_off; const float* sh = mod + (size_t)b * MODW + sh_off;
        f32x4 ga[8], sb[8];
#pragma unroll
        for (int j = 0; j < 8; ++j) { const int col = 4 * lane + 256 * j; const f32x4 gg = *(const f32x4*)(g + col), s1 = *(const f32x4*)(sc + col);
            ga[j] = gg * (s1 + 1.0f); sb[j] = *(const f32x4*)(sh + col); }
#pragma unroll 1
        for (int r = 0; r < 4; ++r) {
            const float* xr = xin + (size_t)(row0 + r) * DM;
            f32x4 v[8]; float ss = 0.f;
#pragma unroll
            for (int j = 0; j < 8; ++j) { v[j] = *(const f32x4*)(xr + 4 * lane + 256 * j); ss += (v[j].x * v[j].x + v[j].y * v[j].y) + (v[j].z * v[j].z + v[j].w * v[j].w); }
            const float rs = rsqrtf(wave_sum(ss) * (1.0f / DM) + EPS);
            bf16* hr = H + (size_t)(row0 + r) * DM;
#pragma unroll
            for (int j = 0; j < 8; ++j) { const f32x4 o = v[j] * rs * ga[j] + sb[j]; u32x2v w; w.x = pk2(o.x, o.y); w.y = pk2(o.z, o.w);
                *(u32x2v*)(hr + 4 * lane + 256 * j) = w; }
        }
    }
}

struct PostIn { v4u v, qa, ckv, h1, h2; };
__device__ __forceinline__ PostIn post_load(const bf16* P, int lane) {
    PostIn in; const int head = lane >> 3, sub = lane & 7, sec = sub >> 2, chk = sub & 3, hh = head < 6 ? head : 0;
    in.v = *(const v4u*)(P + 512 + 8 * lane); in.qa = *(const v4u*)(P + C_D + 8 * lane); in.ckv = *(const v4u*)(P + C_D + 512 + 8 * (lane & 31));
    const bf16* hp = P + C_C + hh * 128 + 64 * sec + 8 * chk; in.h1 = *(const v4u*)hp; in.h2 = *(const v4u*)(hp + 32); return in;
}
__device__ __forceinline__ void post_finish(const PostIn& in, bf16* P, int pos, const float* vng, const float* qng, const float* kng, const float* qag, const float* kvag, int lane, bool st = true) {
    { float f[8]; unpack8(in.v, f);
      float s = 0.f;
#pragma unroll
      for (int i = 0; i < 8; ++i) s += f[i];
      const float mean = wave_sum(s) * (1.0f / 512.0f); float q = 0.f;
#pragma unroll
      for (int i = 0; i < 8; ++i) { f[i] -= mean; q += f[i] * f[i]; }
      const float rs = rsqrtf(wave_sum(q) * (1.0f / 512.0f) + EPS);
      const f32x4 g0 = *(const f32x4*)(vng + 8 * lane), g1 = *(const f32x4*)(vng + 8 * lane + 4);
      f[0] *= rs * g0.x; f[1] *= rs * g0.y; f[2] *= rs * g0.z; f[3] *= rs * g0.w; f[4] *= rs * g1.x; f[5] *= rs * g1.y; f[6] *= rs * g1.z; f[7] *= rs * g1.w;
      if (st) *(v4u*)(P + 512 + 8 * lane) = pack8(f); }
    { float f[8]; unpack8(in.qa, f); float q = 0.f;
#pragma unroll
      for (int i = 0; i < 8; ++i) q += f[i] * f[i];
      const float rs = rsqrtf(wave_sum(q) * (1.0f / 512.0f) + EPS);
#pragma unroll
      for (int i = 0; i < 8; ++i) f[i] *= rs * qag[8 * lane + i];
      if (st) *(v4u*)(P + C_D + 8 * lane) = pack8(f); }
    { const int l32 = lane & 31; float f[8]; unpack8(in.ckv, f); float q = 0.f;
#pragma unroll
      for (int i = 0; i < 8; ++i) q += f[i] * f[i];
      const float rs = rsqrtf(wave_sum(q) * (0.5f / 256.0f) + EPS);
#pragma unroll
      for (int i = 0; i < 8; ++i) f[i] *= rs * kvag[8 * l32 + i];
      if (st && lane < 32) *(v4u*)(P + C_D + 512 + 8 * l32) = pack8(f); }
    { const int head = lane >> 3, sub = lane & 7, sec = sub >> 2, chk = sub & 3; const bool on = head < 6;
      const int hh = on ? head : 0;
      bf16* hp = P + C_C + hh * 128 + 64 * sec + 8 * chk;
      float a[8], c[8]; unpack8(in.h1, a); unpack8(in.h2, c);
      float q = 0.f;
#pragma unroll
      for (int i = 0; i < 8; ++i) q += a[i] * a[i] + c[i] * c[i];
      q += __shfl_xor(q, 1); q += __shfl_xor(q, 2); q += __shfl_xor(q, 4);
      const float rs = rsqrtf(q * (1.0f / 128.0f) + EPS);
      const float* gg = (hh < 4 ? qng : kng) + 64 * sec + 8 * chk;
      const float p = (float)(sec ? (pos & 63) : (pos >> 6));
#pragma unroll
      for (int i = 0; i < 8; ++i) {
          const float x1 = a[i] * rs * gg[i], x2 = c[i] * rs * gg[32 + i];
          const float inv = __expf(-(float)(2 * (8 * chk + i)) * (9.210340371976184f / 64.0f));
          float sn, cs; __sincosf(p * inv, &sn, &cs);
          const float qs = (hh < 4) ? 0.12751743082459868f : 1.0f;
          a[i] = (x1 * cs - x2 * sn) * qs; c[i] = (x2 * cs + x1 * sn) * qs; }
      if (st && on) { *(v4u*)hp = pack8(a); *(v4u*)(hp + 32) = pack8(c); } }
}
__device__ __forceinline__ void post_rows(bf16* PROJp, const float* vng, const float* qng, const float* kng, const float* qag, const float* kvag, int gw, int ngw, int lane, bool st) {
    int row = gw; if (row >= NTOK) return;
    PostIn cur = post_load(PROJp + (size_t)row * INCP, lane);
    for (; row < NTOK; row += ngw) { const int nr = row + ngw; PostIn nxt = cur;
        if (nr < NTOK) nxt = post_load(PROJp + (size_t)nr * INCP, lane);
        post_finish(cur, PROJp + (size_t)row * INCP, row_pos(row), vng, qng, kng, qag, kvag, lane, st); cur = nxt; }
}

struct MlaIn { v4u n[2], a[2], c[2]; };
__device__ __forceinline__ MlaIn mla_load(const bf16* Qr, const bf16* KVr, const bf16* krope, int lane) {
    MlaIn in; const int head = lane >> 4, sub = lane & 15; const bool rp = sub < 4; const int sec = (sub >> 1) & 1, chk = sub & 1, x1o = 128 + 32 * sec + 8 * chk;
    in.n[0] = *(const v4u*)(Qr + head * 192 + 8 * sub); in.n[1] = *(const v4u*)(KVr + head * 256 + 8 * sub);
    in.a[0] = in.c[0] = in.a[1] = in.c[1] = (v4u){0u, 0u, 0u, 0u};
    if (rp) { in.a[0] = *(const v4u*)(Qr + head * 192 + x1o); in.c[0] = *(const v4u*)(Qr + head * 192 + x1o + 16);
              in.a[1] = *(const v4u*)(krope + 32 * sec + 8 * chk); in.c[1] = *(const v4u*)(krope + 32 * sec + 8 * chk + 16); }
    return in;
}
__device__ __forceinline__ void mla_finish(const MlaIn& in, bf16* Qr, bf16* Kr, int pos, const float* qng, const float* kng, int lane, bool st = true) {
    const int head = lane >> 4, sub = lane & 15;
    const bool rp = sub < 4; const int sec = (sub >> 1) & 1, chk = sub & 1;
    const int x1o = 128 + 32 * sec + 8 * chk;
    const float p = (float)(sec ? (pos & 63) : (pos >> 6));
#pragma unroll
    for (int which = 0; which < 2; ++which) {
        const float* g = which == 0 ? qng : kng;
        bf16* dst = (which == 0 ? Qr : Kr) + head * 192;
        float n[8], a[8], c[8]; unpack8(in.n[which], n); unpack8(in.a[which], a); unpack8(in.c[which], c);
        float q = 0.f;
#pragma unroll
        for (int i = 0; i < 8; ++i) q += n[i] * n[i] + a[i] * a[i] + c[i] * c[i];
        q += __shfl_xor(q, 1); q += __shfl_xor(q, 2); q += __shfl_xor(q, 4); q += __shfl_xor(q, 8);
        const float rs = rsqrtf(q * (1.0f / 192.0f) + EPS);
        const float qs = (which == 0) ? 0.10411755155693222f : 1.0f;
#pragma unroll
        for (int i = 0; i < 8; ++i) n[i] *= rs * g[8 * sub + i] * qs;
        if (st) *(v4u*)(dst + 8 * sub) = pack8(n);
        if (rp) {
#pragma unroll
            for (int i = 0; i < 8; ++i) {
                const float x1 = a[i] * rs * g[x1o + i], x2 = c[i] * rs * g[x1o + 16 + i];
                const float inv = __expf(-(float)(2 * (8 * chk + i)) * (9.210340371976184f / 32.0f));
                float sn, cs; __sincosf(p * inv, &sn, &cs);
                a[i] = (x1 * cs - x2 * sn) * qs; c[i] = (x2 * cs + x1 * sn) * qs; }
            if (st) { *(v4u*)(dst + x1o) = pack8(a); *(v4u*)(dst + x1o + 16) = pack8(c); } }
    }
}
__device__ __forceinline__ void mla_rows(bf16* QDp, const bf16* KVDp, const bf16* PROJp, bf16* KMp, const float* qng, const float* kng, int gw, int ngw, int lane, bool st) {
    int row = gw; if (row >= NTOK) return;
    MlaIn cur = mla_load(QDp + (size_t)row * 768, KVDp + (size_t)row * 1024, PROJp + (size_t)row * INCP + C_D + 768, lane);
    for (; row < NTOK; row += ngw) { const int nr = row + ngw; MlaIn nxt = cur;
        if (nr < NTOK) nxt = mla_load(QDp + (size_t)nr * 768, KVDp + (size_t)nr * 1024, PROJp + (size_t)nr * INCP + C_D + 768, lane);
        mla_finish(cur, QDp + (size_t)row * 768, KMp + (size_t)row * 768, row_pos(row), qng, kng, lane, st); cur = nxt; }
}

__device__ __forceinline__ void hyconv_tile(LAS unsigned char* lds, const bf16* PROJ, bf16* XT, const float* cw  , const float* cb  , int tile, int tid) {
    const int which = tile % 3, tb = tile / 3, row0 = tb * 64, b = row_batch(row0), pos0 = row_pos(row0), Lb = batch_len(b);
    constexpr int PITCH = 260;
    LAS unsigned* raw = (LAS unsigned*)lds;
    { v4u w[9];
#pragma unroll
      for (int i = 0; i < 9; ++i) { const int id = tid + i * NTHR, r = id >> 6, k = id & 63, p = pos0 - 1 + r;
          w[i] = (v4u){0u, 0u, 0u, 0u};
          if (id < 66 * 64 && p >= 0 && p < Lb) w[i] = *(const v4u*)(PROJ + (size_t)(row0 - 1 + r) * INCP + C_B + which * 512 + 8 * k); }
#pragma unroll
      for (int i = 0; i < 9; ++i) { const int id = tid + i * NTHR, r = id >> 6, k = id & 63;
          if (id < 66 * 64) *(LAS v4u*)(raw + r * PITCH + 4 * k) = w[i]; } }
    __syncthreads();
    { const int c = tid, col = which * 512 + c; const float w0 = cw[col], w1 = cw[1536 + col], w2 = cw[3072 + col], bb = cb[col];
      const LAS unsigned short* rc = (const LAS unsigned short*)raw + c;
      bf16* dst = XT + (size_t)which * ((size_t)NTOK * 512) + xt_off(b, c) + pos0;
      float xm = bf2f(rc[0]), x0 = bf2f(rc[2 * PITCH]);
#pragma unroll 2
      for (int k = 0; k < 8; ++k) { float z[8];
#pragma unroll
          for (int i = 0; i < 8; ++i) { const float xp = bf2f(rc[(8 * k + i + 2) * 2 * PITCH]); z[i] = w0 * xm + w1 * x0 + w2 * xp + bb; xm = x0; x0 = xp; }
          *(v4u*)(dst + 8 * k) = pack8(z); } }
    __syncthreads();
}

__device__ __forceinline__ void gnorm_tile(LAS unsigned char* lds, const bf16* __restrict__ YCAT, const bf16* __restrict__ Y2T, const float* __restrict__ gg  , bf16* __restrict__ YN, int tile, int tid) {
    const int row0 = tile * 32, b = row_batch(row0), pos0 = row_pos(row0), lane = tid & 63, wid = tid >> 6;
    constexpr int PITCH = 17;
    LAS unsigned* yb = (LAS unsigned*)lds;
    { v4u yw[4];
#pragma unroll
      for (int i = 0; i < 4; ++i) { const int id = tid + i * NTHR, c = id >> 2, k = id & 3; yw[i] = *(const v4u*)(Y2T + xt_off(b, c) + pos0 + 8 * k); }
#pragma unroll
      for (int i = 0; i < 4; ++i) { const int id = tid + i * NTHR, c = id >> 2, k = id & 3; LAS unsigned* d = yb + c * PITCH + 4 * k; d[0] = yw[i].x; d[1] = yw[i].y; d[2] = yw[i].z; d[3] = yw[i].w; } }
    __syncthreads();
#pragma unroll 2
    for (int r = 0; r < 4; ++r) { const int t = wid * 4 + r, row = row0 + t;
        const bf16* yr = YCAT + (size_t)row * DM; bf16* on = YN + (size_t)row * DM;
#pragma unroll
        for (int grp = 0; grp < 4; ++grp) {
            if (grp == 1) {
                float f[8]; float q = 0.f;
#pragma unroll
                for (int i = 0; i < 8; ++i) { f[i] = bf2f(((const LAS unsigned short*)yb)[(lane + 64 * i) * 2 * PITCH + t]); q += f[i] * f[i]; }
                const float rs = rsqrtf(wave_sum(q) * (1.0f / 512.0f) + EPS);
#pragma unroll
                for (int i = 0; i < 8; ++i) on[512 + lane + 64 * i] = (bf16)f2bf(f[i] * rs * gg[512 + lane + 64 * i]);
            } else {
                v4u w = *(const v4u*)(yr + grp * 512 + 8 * lane); float f[8]; unpack8(w, f); float q = 0.f;
#pragma unroll
                for (int i = 0; i < 8; ++i) q += f[i] * f[i];
                const float rs = rsqrtf(wave_sum(q) * (1.0f / 512.0f) + EPS);
                const f32x4 g0 = *(const f32x4*)(gg + grp * 512 + 8 * lane), g1 = *(const f32x4*)(gg + grp * 512 + 8 * lane + 4);
                f[0] *= rs * g0.x; f[1] *= rs * g0.y; f[2] *= rs * g0.z; f[3] *= rs * g0.w; f[4] *= rs * g1.x; f[5] *= rs * g1.y; f[6] *= rs * g1.z; f[7] *= rs * g1.w;
                *(v4u*)(on + grp * 512 + 8 * lane) = pack8(f);
            }
        }
    }
    __syncthreads();
}

__device__ __forceinline__ void ffn_gate(const bf16* Z, bf16* A, const float* cw  , const float* cb  , int gt, int ngt) {
    constexpr int NCK = DFF / 8;
    for (int it = gt; it < (NTOK / 16) * NCK; it += ngt) {
        const int rb = it / NCK, ck = it % NCK, row0 = rb * 16, j0 = ck * 8;
        const int pos0 = row_pos(row0), Lb = batch_len(row_batch(row0));
        float wg[3][8], wu[3][8], bg[8], bu[8];
#pragma unroll
        for (int k = 0; k < 3; ++k)
#pragma unroll
            for (int i = 0; i < 8; ++i) { wg[k][i] = cw[k * DFF2 + j0 + i]; wu[k][i] = cw[k * DFF2 + DFF + j0 + i]; }
#pragma unroll
        for (int i = 0; i < 8; ++i) { bg[i] = cb[j0 + i]; bu[i] = cb[DFF + j0 + i]; }
        float gm[8], g0[8], um[8], u0[8];
        const bf16* zr = Z + (size_t)row0 * DFF2 + j0;
        if (pos0 > 0) { v4u a = *(const v4u*)(zr - DFF2), c = *(const v4u*)(zr - DFF2 + DFF); unpack8(a, gm); unpack8(c, um); }
        else {
#pragma unroll
            for (int i = 0; i < 8; ++i) { gm[i] = 0.f; um[i] = 0.f; } }
        { v4u a = *(const v4u*)zr, c = *(const v4u*)(zr + DFF); unpack8(a, g0); unpack8(c, u0); }
#pragma unroll 1
        for (int r = 0; r < 16; ++r) {
            float gp[8], up[8];
            if (pos0 + r + 1 < Lb) { v4u a = *(const v4u*)(zr + (size_t)(r + 1) * DFF2), c = *(const v4u*)(zr + (size_t)(r + 1) * DFF2 + DFF); unpack8(a, gp); unpack8(c, up); }
            else {
#pragma unroll
                for (int i = 0; i < 8; ++i) { gp[i] = 0.f; up[i] = 0.f; } }
            float o[8];
#pragma unroll
            for (int i = 0; i < 8; ++i) {
                const float gc = wg[0][i] * gm[i] + wg[1][i] * g0[i] + wg[2][i] * gp[i] + bg[i];
                const float uc = wu[0][i] * um[i] + wu[1][i] * u0[i] + wu[2][i] * up[i] + bu[i];
                o[i] = gc * __builtin_amdgcn_rcpf(1.0f + __expf(-gc)) * uc;
                gm[i] = g0[i]; g0[i] = gp[i]; um[i] = u0[i]; u0[i] = up[i]; }
            *(v4u*)(A + (size_t)(row0 + r) * DFF + j0) = pack8(o);
        }
    }
}

__device__ __forceinline__ void gate_fix(const float* ZH, bf16* A, const float* cw, const float* cb, int gt, int ngt) {
    constexpr int NQ4 = DFF / 4;
    for (int it = gt; it < 192 * NQ4; it += ngt) {
        const int rs = it / NQ4, q4 = it % NQ4, pm = rs >> 1, s = rs & 1, row = pm * 256 + (s ? 255 : 0), pos = row_pos(row), Lb = batch_len(row_batch(row));
        if (s == 0 ? (pos == 0) : (pos + 1 == Lb)) continue;
        const int j = q4 * 4, zc = 256 * (j >> 7) + (j & 127);
        const float* zp = s == 0 ? ZH + ((size_t)(pm - 1) * 4 + 3) * DFF2 : ZH + ((size_t)pm * 4 + 2) * DFF2;
        const float* z0 = s == 0 ? ZH + ((size_t)pm * 4 + 0) * DFF2 : ZH + ((size_t)pm * 4 + 3) * DFF2;
        const float* zn = s == 0 ? ZH + ((size_t)pm * 4 + 1) * DFF2 : ZH + ((size_t)(pm + 1) * 4 + 0) * DFF2;
        f32x4 cv[2];
#pragma unroll
        for (int h = 0; h < 2; ++h) {
            const f32x4 a = *(const f32x4*)(zp + zc + 128 * h), b = *(const f32x4*)(z0 + zc + 128 * h), c = *(const f32x4*)(zn + zc + 128 * h);
            const f32x4 w0 = *(const f32x4*)(cw + h * DFF + j), w1 = *(const f32x4*)(cw + DFF2 + h * DFF + j), w2 = *(const f32x4*)(cw + 2 * DFF2 + h * DFF + j), bb = *(const f32x4*)(cb + h * DFF + j);
            cv[h] = w0 * a + w1 * b + w2 * c + bb; }
        float o[4];
#pragma unroll
        for (int e = 0; e < 4; ++e) { const float g = cv[0][e]; o[e] = g * __builtin_amdgcn_rcpf(1.0f + __expf(-g)) * cv[1][e]; }
        u32x2v w; w.x = pk2(o[0], o[1]); w.y = pk2(o[2], o[3]);
        *(u32x2v*)(A + affn_off(row, j)) = w;
    }
}

__device__ __forceinline__ void hyconv_regs(const bf16* PROJ, bf16* XT, const float* cw  , const float* cb  , int gt, int ngt) {
    for (int it = gt; it < (NTOK / 8) * 192; it += ngt) {
        const int tb = it / 192, ck = it % 192, row0 = tb * 8, j0 = ck * 8, which = j0 >> 9, c0 = j0 & 511;
        const int b = row_batch(row0), pos0 = row_pos(row0), Lb = batch_len(b);
        float w0[8], w1[8], w2[8], bb[8];
#pragma unroll
        for (int i = 0; i < 8; i += 4) { const f32x4 a = *(const f32x4*)(cw + j0 + i), c = *(const f32x4*)(cw + 1536 + j0 + i), d = *(const f32x4*)(cw + 3072 + j0 + i), e = *(const f32x4*)(cb + j0 + i);
            w0[i] = a.x; w0[i + 1] = a.y; w0[i + 2] = a.z; w0[i + 3] = a.w; w1[i] = c.x; w1[i + 1] = c.y; w1[i + 2] = c.z; w1[i + 3] = c.w;
            w2[i] = d.x; w2[i + 1] = d.y; w2[i + 2] = d.z; w2[i + 3] = d.w; bb[i] = e.x; bb[i + 1] = e.y; bb[i + 2] = e.z; bb[i + 3] = e.w; }
        const bf16* src = PROJ + (size_t)row0 * INCP + C_B + j0;
        v4u raw[10];
        raw[0] = (pos0 > 0) ? *(const v4u*)(src - INCP) : (v4u){0u, 0u, 0u, 0u};
#pragma unroll
        for (int r = 0; r < 8; ++r) raw[r + 1] = *(const v4u*)(src + (size_t)r * INCP);
        raw[9] = (pos0 + 8 < Lb) ? *(const v4u*)(src + (size_t)8 * INCP) : (v4u){0u, 0u, 0u, 0u};
        float z[8][8]; float xm[8], x0[8], xp[8];
        unpack8(raw[0], xm); unpack8(raw[1], x0);
#pragma unroll
        for (int r = 0; r < 8; ++r) { unpack8(raw[r + 2], xp);
#pragma unroll
            for (int i = 0; i < 8; ++i) { z[r][i] = w0[i] * xm[i] + w1[i] * x0[i] + w2[i] * xp[i] + bb[i]; xm[i] = x0[i]; x0[i] = xp[i]; } }
        bf16* dst = XT + (size_t)which * ((size_t)NTOK * 512) + xt_off(b, c0) + pos0;
        const size_t cst = (size_t)Lb;
#pragma unroll
        for (int i = 0; i < 8; ++i) { v4u o; o.x = pk2(z[0][i], z[1][i]); o.y = pk2(z[2][i], z[3][i]); o.z = pk2(z[4][i], z[5][i]); o.w = pk2(z[6][i], z[7][i]);
            *(v4u*)(dst + (size_t)i * cst) = o; }
    }
}
__device__ __forceinline__ void p0_transpose_item(const float* W, int K, int N, bf16* WT, int row_off, LAS float* scr, int item, int lane) {
    const int nblk = N / 32, kb = item / nblk, nb = item % nblk, k0 = 64 * kb, n0 = 32 * nb;
#pragma unroll
    for (int i = 0; i < 32; ++i) { const int kk = 2 * i + (lane >> 5); scr[kk * 33 + (lane & 31)] = __builtin_nontemporal_load(&W[(size_t)(k0 + kk) * N + n0 + (lane & 31)]); }
    LDS_WAIT(); asm volatile("" ::: "memory");
    const int c = lane & 7;
#pragma unroll
    for (int j = 0; j < 4; ++j) { const int n = (lane >> 3) + 8 * j; const LAS float* s = scr + (8 * c) * 33 + n;
        v4u o; o.x = pk2(s[0 * 33], s[1 * 33]); o.y = pk2(s[2 * 33], s[3 * 33]); o.z = pk2(s[4 * 33], s[5 * 33]); o.w = pk2(s[6 * 33], s[7 * 33]);
        *(GAS v4u*)(WT + (size_t)(row_off + n0 + n) * K + k0 + 8 * c) = o; }
    LDS_WAIT(); asm volatile("" ::: "memory");
}
__device__ __forceinline__ void gmlp_unit(char* ldsg, const bf16* PROJ, bf16* YCAT, const float* sw  , const float* sb  , int unit, int tid) {
    using namespace att;
    const int chunk = unit >> 2, h = unit & 3, row0 = chunk * 128, lane = tid & 63, wid = __builtin_amdgcn_readfirstlane(tid >> 6), hi = lane >> 5, r32 = lane & 31;
    { bf16x8 vw[4];
#pragma unroll
      for (int i = 0; i < 4; ++i) { const int id = tid + i * NTHR, q = id >> 4, cc = (id & 15) * 8; vw[i] = *(const bf16x8*)(PROJ + (size_t)(row0 + q) * INCP + 512 + h * 128 + cc); }
#pragma unroll
      for (int i = 0; i < 4; ++i) { const int id = tid + i * NTHR, q = id >> 4, cc = (id & 15) * 8; *(bf16x8*)(ldsg + (q >> 6) * 16384 + v_st(q & 63, cc)) = vw[i]; } }
    const int pblk = wid >> 1, half = wid & 1;
    bf16x8 af[8];
    { const float* wp = sw + (size_t)h * 16384 + (32 * pblk + r32) * 128 + 8 * hi;
#pragma unroll
      for (int k = 0; k < 8; ++k) { const f32x4 a = *(const f32x4*)(wp + 16 * k), c = *(const f32x4*)(wp + 16 * k + 4);
          u32x4 w; w.x = cvtpk(a.x, a.y); w.y = cvtpk(a.z, a.w); w.z = cvtpk(c.x, c.y); w.w = cvtpk(c.z, c.w); af[k] = __builtin_bit_cast(bf16x8, w); } }
    __syncthreads();
    const int vb0 = (int)(uintptr_t)ldsg + v_rd_base(lane);
    f32x16 o0 = {}, o1 = {};
    if (half == 0) { pv_one<0>(o0, vb0, af[0], af[1], af[2], af[3]); pv_one<1>(o1, vb0, af[0], af[1], af[2], af[3]);
                     pv_one<0>(o0, vb0 + 16384, af[4], af[5], af[6], af[7]); pv_one<1>(o1, vb0 + 16384, af[4], af[5], af[6], af[7]); }
    else           { pv_one<2>(o0, vb0, af[0], af[1], af[2], af[3]); pv_one<3>(o1, vb0, af[0], af[1], af[2], af[3]);
                     pv_one<2>(o0, vb0 + 16384, af[4], af[5], af[6], af[7]); pv_one<3>(o1, vb0 + 16384, af[4], af[5], af[6], af[7]); }
    float* st = (float*)(ldsg + 32768) + wid * (32 * 68);
#pragma unroll
    for (int q = 0; q < 16; ++q) { const int pr = crow(q, hi); const float bs = sb[h * 128 + 32 * pblk + pr];
        st[pr * 68 + r32] = o0[q] + bs; st[pr * 68 + 32 + r32] = o1[q] + bs; }
    asm volatile("s_waitcnt lgkmcnt(0)" ::: "memory");
    v4u uws[4];
#pragma unroll
    for (int i = 0; i < 4; ++i) { const int pr = i * 8 + (lane >> 3), cc = (lane & 7) * 8; uws[i] = *(const v4u*)(PROJ + (size_t)(row0 + 32 * pblk + pr) * INCP + h * 128 + 64 * half + cc); }
#pragma unroll
    for (int i = 0; i < 4; ++i) { const int pr = i * 8 + (lane >> 3), cc = (lane & 7) * 8; const int row = row0 + 32 * pblk + pr, col = h * 128 + 64 * half + cc;
        const f32x4 m0 = *(const f32x4*)(st + pr * 68 + cc), m1 = *(const f32x4*)(st + pr * 68 + cc + 4);
        const v4u uw = uws[i]; float uf[8]; unpack8(uw, uf);
        float y[8] = {uf[0] * m0.x, uf[1] * m0.y, uf[2] * m0.z, uf[3] * m0.w, uf[4] * m1.x, uf[5] * m1.y, uf[6] * m1.z, uf[7] * m1.w};
        *(v4u*)(YCAT + (size_t)row * DM + col) = pack8(y); }
    __syncthreads();
}

__device__ __forceinline__ void mod_phase(LAS unsigned char* lds, const float* cp, const float* cs, const float* ada_w, const float* ada_b, float* MOD, int vcu, int G, int tid) {
    LAS float* sc = (LAS float*)lds;
    LAS float* red = (LAS float*)(lds + 65536);
    const int lane = tid & 63, wid = tid >> 6;
#pragma unroll 8
    for (int i = tid; i < NB * DM; i += NTHR) { const int b = i >> 11, k = i & 2047; const float c = b < 4 ? cp[b * DM + k] : cs[(b - 4) * DM + k]; sc[i] = c / (1.0f + __expf(-c)); }
    __syncthreads();
    for (int item = vcu; item < DEPTH * 96; item += G) {
        const int l = item / 96, cbk = item % 96, col0 = cbk * 128 + 2 * lane;
        const float* W = ada_w + (size_t)l * DM * MODW + col0;
        float acc[8][2];
#pragma unroll
        for (int b = 0; b < 8; ++b) { acc[b][0] = 0.f; acc[b][1] = 0.f; }
        const int kbeg = wid * 256;
#pragma unroll 2
        for (int k = kbeg; k < kbeg + 256; k += 4) {
            typedef float f32x2w __attribute__((ext_vector_type(2)));
            f32x2w w[4];
#pragma unroll
            for (int i = 0; i < 4; ++i) w[i] = __builtin_nontemporal_load((const f32x2w*)(W + (size_t)(k + i) * MODW));
#pragma unroll
            for (int b = 0; b < 8; ++b) { const f32x4 s = *(const LAS f32x4*)(sc + b * DM + k);
                acc[b][0] += s.x * w[0].x + s.y * w[1].x + s.z * w[2].x + s.w * w[3].x;
                acc[b][1] += s.x * w[0].y + s.y * w[1].y + s.z * w[2].y + s.w * w[3].y; }
        }
#pragma unroll
        for (int b = 0; b < 8; ++b) { red[(wid * 8 + b) * 128 + 2 * lane] = acc[b][0]; red[(wid * 8 + b) * 128 + 2 * lane + 1] = acc[b][1]; }
        __syncthreads();
        { const int b = tid >> 6, pr = tid & 63; float s0 = 0.f, s1 = 0.f;
#pragma unroll
          for (int w = 0; w < 8; ++w) { s0 += red[(w * 8 + b) * 128 + 2 * pr]; s1 += red[(w * 8 + b) * 128 + 2 * pr + 1]; }
          const int col = cbk * 128 + 2 * pr;
          float* o = MOD + ((size_t)l * NB + b) * MODW + col; o[0] = s0 + ada_b[l * MODW + col]; o[1] = s1 + ada_b[l * MODW + col + 1]; }
        __syncthreads();
    }
}

__device__ __forceinline__ unsigned rot16(unsigned x) { return __builtin_amdgcn_alignbit(x, x, 16); }
__device__ __forceinline__ void filt_item(LAS unsigned char* lds, int L, int tb, const float* w1, const float* b1, const float* f1, const float* w2, const float* b2, const float* f2,
                                          const float* w3, const float* decay, bf16* GFl, int tid) {
    using att::bf16x8; using att::f32x16; using att::u32x4; using att::cvtpk;
    LAS float* feats = (LAS float*)lds;
    LAS float* h1 = feats + 2176;
    LAS float* h2 = h1 + 65 * 64;
    LAS float* hf0 = h2 + 65 * 68;
    const int t0 = 64 * tb; const float invL1 = 1.0f / (float)(L - 1);
    const int GRN = 2 * L / 64 * 72;
    const int lane = tid & 63, wid = __builtin_amdgcn_readfirstlane(tid >> 6), hi = lane >> 5, r32 = lane & 31;
    for (int id = tid; id < 65 * 33; id += NTHR) { const int i = id / 33, f = id % 33; const float t = (float)(t0 + i); float v;
        if (f == 0) v = t * invL1;
        else { const int kb = (f - 1) & 15; const float band = 1e-4f + (float)kb * ((15.0f - 1e-4f) / 15.0f);
            float x = t * band / (float)L; x -= floorf(x); const float a = 6.283185307179586f * x;
            v = (f <= 16) ? __cosf(a) : -__sinf(a); }
        feats[i * 33 + f] = v; }
    __syncthreads();
    for (int id = tid; id < 65 * 64; id += NTHR) { const int i = id >> 6, j = id & 63; float s = b1[j];
#pragma unroll 11
        for (int f = 0; f < 33; ++f) s += feats[i * 33 + f] * w1[f * 64 + j];
        h1[i * 64 + j] = __sinf(f1[j] * s); }
    __syncthreads();
    for (int id = tid; id < 65 * 64; id += NTHR) { const int i = id >> 6, j = id & 63; float s = b2[j];
#pragma unroll 16
        for (int f = 0; f < 64; ++f) s += h1[i * 64 + f] * w2[f * 64 + j];
        h2[i * 68 + j] = __sinf(f2[j] * s); }
    __syncthreads();
    if (tb == 0) {
        for (int cc = tid; cc < 1024; cc += NTHR) { const int col = (cc >> 9) * 1024 + (cc & 511); float s = 0.f;
#pragma unroll 16
            for (int j = 0; j < 64; ++j) s += h2[j] * w3[j * 2048 + col];
            hf0[cc] = s; }
        __syncthreads();
    }
    bf16x8 af[2][2][4];
#pragma unroll
    for (int st = 0; st < 2; ++st)
#pragma unroll
        for (int mb = 0; mb < 2; ++mb)
#pragma unroll
            for (int ks = 0; ks < 4; ++ks) { const LAS float* p = h2 + (st + 32 * mb + r32) * 68 + 16 * ks + 8 * hi;
                const f32x4 x = *(const LAS f32x4*)p, y = *(const LAS f32x4*)(p + 4);
                u32x4 w; w.x = cvtpk(x.x, x.y); w.y = cvtpk(x.z, x.w); w.z = cvtpk(y.x, y.y); w.w = cvtpk(y.z, y.w); af[st][mb][ks] = __builtin_bit_cast(bf16x8, w); }
#pragma unroll 1
    for (int cbi = 0; cbi < 8; ++cbi) {
        const int cb = wid * 8 + cbi, o = cb >> 5, dir = (cb >> 4) & 1, c = (cb & 15) * 32 + r32, col = cb * 32 + r32;
        bf16x8 bfr[4];
#pragma unroll
        for (int ks = 0; ks < 4; ++ks) { float x[8];
#pragma unroll
            for (int j = 0; j < 8; ++j) x[j] = w3[(size_t)(16 * ks + 8 * hi + j) * 2048 + col];
            u32x4 w; w.x = cvtpk(x[0], x[1]); w.y = cvtpk(x[2], x[3]); w.z = cvtpk(x[4], x[5]); w.w = cvtpk(x[6], x[7]); bfr[ks] = __builtin_bit_cast(bf16x8, w); }
        const float dec = fabsf(decay[col]) * invL1;
        bf16* dst = GFl + (size_t)(o * 512 + c) * GRN;
#pragma unroll
        for (int mb = 0; mb < 2; ++mb) {
            f32x16 d = {};
#pragma unroll
            for (int ks = 0; ks < 4; ++ks) d = (dir == 0) ? __builtin_amdgcn_mfma_f32_32x32x16_bf16(af[1][mb][ks], bfr[ks], d, 0, 0, 0)
                                                          : __builtin_amdgcn_mfma_f32_32x32x16_bf16(af[0][mb][ks], bfr[ks], d, 0, 0, 0);
#pragma unroll
            for (int q = 0; q < 16; ++q) { const int mrow = 32 * mb + att::crow(q, hi), t = t0 + mrow + (dir == 0 ? 1 : 0);
                float v = d[q] * __expf(-(float)t * dec);
                if (dir == 0 && t == L) v = 0.f;
                if (dir == 1 && t == 0) v = hf0[o * 512 + c];
                d[q] = v; }
#pragma unroll
            for (int k = 0; k < 2; ++k) {
                const unsigned a0 = cvtpk(d[8 * k + 0], d[8 * k + 1]), a1 = cvtpk(d[8 * k + 2], d[8 * k + 3]), b0 = cvtpk(d[8 * k + 4], d[8 * k + 5]), b1 = cvtpk(d[8 * k + 6], d[8 * k + 7]);
                auto s0 = __builtin_amdgcn_permlane32_swap(a0, b0, false, false); auto s1 = __builtin_amdgcn_permlane32_swap(a1, b1, false, false);
                const unsigned x0 = s0[0], x1 = s1[0], x2 = s0[1], x3 = s1[1];
                const int m0 = 32 * mb + 16 * k + 8 * hi;
                if (dir == 1) { const int ib = L + t0 + m0, ph = (ib >> 6) * 72 + (ib & 63); *(v4u*)(dst + ph) = (v4u){x0, x1, x2, x3}; }
                else { const int ib = L - t0 - m0 - 8, ph = (ib >> 6) * 72 + (ib & 63); *(v4u*)(dst + ph) = (v4u){rot16(x3), rot16(x2), rot16(x1), rot16(x0)}; }
            }
        }
    }
    __syncthreads();
}

__device__ __forceinline__ void ga_tables(const float* n1g, const float* n2g, const float* MODp, float* GA1, float* GA2, int gt, int ngt) {
    for (int i = gt; i < 2 * DEPTH * NB * DM; i += ngt) { const int which = i / (DEPTH * NB * DM), r = i % (DEPTH * NB * DM), l = r / (NB * DM), b = (r / DM) % NB, c = r % DM;
        const float sc = MODp[((size_t)l * NB + b) * MODW + (which ? 4 * DM : DM) + c];
        (which ? GA2 : GA1)[r] = (which ? n2g : n1g)[l * DM + c] * (1.0f + sc); }
}
__device__ __forceinline__ void bvec_item(LAS unsigned char* lds, const float* shp, const bf16* Wt, float* BV, int ldbv, int n0, int tid) {
    LAS float* sb = (LAS float*)lds;
    const int lane = tid & 63, wid = tid >> 6;
#pragma unroll 8
    for (int i = tid; i < NB * DM / 4; i += NTHR) { const int b = i / (DM / 4), k4 = i % (DM / 4); *(LAS f32x4*)(sb + b * DM + 4 * k4) = *(const f32x4*)(shp + (size_t)b * MODW + 4 * k4); }
    __syncthreads();
#pragma unroll 1
    for (int rg = 0; rg < 2; ++rg) { const int nb = n0 + wid * 8 + rg * 4;
        float acc[32];
#pragma unroll
        for (int i = 0; i < 32; ++i) acc[i] = 0.f;
#pragma unroll 1
        for (int j = 0; j < 4; ++j) { float f[4][8];
#pragma unroll
            for (int r = 0; r < 4; ++r) { const v4u w = *(const v4u*)(Wt + (size_t)(nb + r) * DM + 8 * lane + 512 * j); unpack8(w, f[r]); }
#pragma unroll
            for (int b = 0; b < 8; ++b) { const f32x4 s0 = *(const LAS f32x4*)(sb + b * DM + 8 * lane + 512 * j), s1 = *(const LAS f32x4*)(sb + b * DM + 8 * lane + 512 * j + 4);
#pragma unroll
                for (int r = 0; r < 4; ++r)
                    acc[r * 8 + b] += (f[r][0] * s0.x + f[r][1] * s0.y) + (f[r][2] * s0.z + f[r][3] * s0.w) + (f[r][4] * s1.x + f[r][5] * s1.y) + (f[r][6] * s1.z + f[r][7] * s1.w); } }
#pragma unroll
        for (int st = 0; st < 5; ++st) { const int n = 16 >> st, x = 32 >> st; const bool up = (lane & x) != 0;
#pragma unroll
            for (int i = 0; i < n; ++i) { const float keep = up ? acc[i + n] : acc[i], send = up ? acc[i] : acc[i + n]; acc[i] = keep + __shfl_xor(send, x); } }
        const float tot = acc[0] + __shfl_xor(acc[0], 1);
        const int idx = (lane >> 1) & 31;
        const int idxr = ((idx & 16) ? 16 : 0) | ((idx & 8) ? 8 : 0) | ((idx & 4) ? 4 : 0) | ((idx & 2) ? 2 : 0) | (idx & 1);
        if ((lane & 1) == 0) BV[(size_t)(idxr & 7) * ldbv + nb + (idxr >> 3)] = tot;
    }
    __syncthreads();
}
__device__ __forceinline__ void norm0_rows(const float* xa, const float* xb, const float* g, const float* mod, bf16* H, unsigned long long* SS, int gw, int ngw, int lane) {
    for (int ck = gw; ck < NTOK / 4; ck += ngw) {
        const int row0 = ck * 4, b = row_batch(row0);
        const float* xin = row0 < NPR ? xa : xb;
        const float* sc = mod + (size_t)b * MODW + DM;
        f32x4 ga[8];
#pragma unroll
        for (int j = 0; j < 8; ++j) { const int col = 4 * lane + 256 * j; ga[j] = *(const f32x4*)(g + col) * (*(const f32x4*)(sc + col) + 1.0f); }
#pragma unroll 1
        for (int r = 0; r < 4; ++r) {
            const float* xr = xin + (size_t)(row0 + r) * DM;
            f32x4 v[8]; float ss = 0.f;
#pragma unroll
            for (int j = 0; j < 8; ++j) { v[j] = *(const f32x4*)(xr + 4 * lane + 256 * j); ss += (v[j].x * v[j].x + v[j].y * v[j].y) + (v[j].z * v[j].z + v[j].w * v[j].w); }
            ss = wave_sum(ss); if (lane == 0) SS[row0 + r] = (unsigned long long)(ss * 16777216.0f + 0.5f);
            bf16* hr = H + (size_t)(row0 + r) * DM;
#pragma unroll
            for (int j = 0; j < 8; ++j) { const f32x4 o = v[j] * ga[j]; u32x2v w; w.x = pk2(o.x, o.y); w.y = pk2(o.z, o.w);
                *(u32x2v*)(hr + 4 * lane + 256 * j) = w; }
        }
    }
}
#ifndef MK_PHMASK
#define MK_PHMASK 0xFFFFFFFFu
#endif
#define EN(p) (((MK_PHMASK) >> (p)) & 1u)
#ifndef MK_REPEAT
#define MK_REPEAT 0u
#endif
#define REP(p) for (int rep_ = 0; rep_ < 1 + (int)(((MK_REPEAT) >> (p)) & 1u); ++rep_)
constexpr int NPH_LAYER = 10, NPHASE = 2 + DEPTH * NPH_LAYER;
struct Args { const float* in[37]; float* out; unsigned char* ws; int ph_lo, ph_hi; };
static_assert(sizeof(Args) == 39 * 8 + 8, "Args has no padding");

typedef const __attribute__((address_space(4))) Args* KArgs;
__device__ __forceinline__ KArgs kargs() { KArgs p = (KArgs)__builtin_amdgcn_kernarg_segment_ptr(); asm volatile("" : "+s"(p)); return p; }
#define AIN(i) (kargs()->in[i])
__global__ void __launch_bounds__(NTHR, 2) mk_fwd(Args args_unused) {
    extern __shared__ __attribute__((aligned(16))) unsigned char lds_raw[];
    LAS unsigned char* lds = (LAS unsigned char*)lds_raw;
    volatile LAS unsigned* MISC = (volatile LAS unsigned*)(lds + MISC_OFF);
    const int tid0 = threadIdx.x;
#define tid tid_fresh()
#define lane (tid_fresh() & 63)
#define wave (__builtin_amdgcn_readfirstlane(tid_fresh() >> 6))
    const int G0 = gridDim.x; const int bx0 = blockIdx.x; const int vcu0 = (G0 % 8 == 0) ? (bx0 % 8) * (G0 / 8) + bx0 / 8 : bx0;
#define G (sfresh(G0))
#define bx (sfresh(bx0))
#define vcu (sfresh(vcu0))
#define gw (vcu * NWAVES + wave)
#define ngw (G * NWAVES)
    gu32* ctl = (gu32*)(kargs()->ws + WS_CTL);
    for (int u = tid0; u < (LDS_BYTES - LDSCTL_OFF) / 4; u += NTHR) ((LAS unsigned*)(lds + LDSCTL_OFF))[u] = 0u;
    __syncthreads();
#if MK_MULTI
    XcdBarrier bar; bar.bar = (unsigned*)(ctl + CW_BAR); bar.x = 0; bar.st = nullptr;
#define SEAM(k) do { } while (0)
#else
    XcdBarrier bar = xcd_barrier_post((unsigned*)(ctl + CW_BAR), MISC + 8);
#define SEAM(k) do { if (IN(k) && IN((k) + 1)) { xcd_barrier(bar); if ((MK_REPEAT >> 19) & 1u) xcd_barrier(bar); } } while (0)
#endif
    const int lo = kargs()->ph_lo, hi = kargs()->ph_hi;
#define IN(k) (lo <= (k) && (k) < hi)
#define ws (kargs()->ws)
#define MOD ((float*)(ws + WS_MOD))
#define HB ((bf16*)(ws + WS_HB))
#define AFFN ((bf16*)(ws + WS_AFFN))
#define Z ((bf16*)(ws + WS_Z))
#define PROJ ((bf16*)(ws + WS_PROJ))
#define XT ((bf16*)(ws + WS_XT))
#define Y2T ((bf16*)(ws + WS_Y2T))
#define QD ((bf16*)(ws + WS_QD))
#define KVD ((bf16*)(ws + WS_KVD))
#define KMLA ((bf16*)(ws + WS_KMLA))
#define YCAT ((bf16*)(ws + WS_YCAT))
#define OUT (kargs()->out)

    if (EN(0) && IN(0)) REP(0) {
        REP(21) mod_phase(lds, AIN(2), AIN(3), AIN(4), AIN(5), MOD, vcu, G, tid);
        REP(22) for (int item = (vcu + G / 2) % G; item < DEPTH * 96; item += G) {     const int l = item / 96, r = item % 96; const int L = r < 32 ? LP : LS, tb = r < 32 ? r : r - 32;
            bf16* GFl = (bf16*)(ws + WS_GF + (size_t)l * SZ_GF + (r < 32 ? 0 : SZ_GF_P));
            filt_item(lds, L, tb, AIN(13) + (size_t)l * 33 * 64, AIN(14) + l * 64, AIN(15) + l * 64, AIN(16) + (size_t)l * 4096, AIN(17) + l * 64, AIN(18) + l * 64,
                      AIN(19) + (size_t)l * 64 * 2048, AIN(20) + (size_t)l * 2048, GFl, tid); }
        { LAS float* scr = (LAS float*)(lds + wave * 16384);
          constexpr int I_IN = 32 * 138, I_QB = 8 * 24, I_KVB = 4 * 32, I_OUT = 32 * 64, I_UP = 32 * 352, I_DN = 88 * 64, I_L = I_IN + I_QB + I_KVB + I_OUT + I_UP + I_DN;
          REP(23) for (int it = gw; it < DEPTH * I_L; it += ngw) { const int l = it / I_L; int r = it % I_L;
              if (r < I_IN) { p0_transpose_item(AIN(7) + (size_t)l * DM * INC, DM, INC, (bf16*)(ws + WS_WIN + l * SZ_WIN), 0, scr, r, lane); continue; } r -= I_IN;
              if (r < I_QB) { p0_transpose_item(AIN(25) + (size_t)l * 512 * 768, 512, 768, (bf16*)(ws + WS_WQB + l * SZ_WQB), 0, scr, r, lane); continue; } r -= I_QB;
              if (r < I_KVB) { p0_transpose_item(AIN(27) + (size_t)l * 256 * 1024, 256, 1024, (bf16*)(ws + WS_WKVB + l * SZ_WKVB), 0, scr, r, lane); continue; } r -= I_KVB;
              if (r < I_OUT) { p0_transpose_item(AIN(31) + (size_t)l * DM * DM, DM, DM, (bf16*)(ws + WS_WOUT + l * SZ_WOUT), 0, scr, r, lane); continue; } r -= I_OUT;
              if (r < I_UP) { const int n0 = 32 * (r % 352), hf = n0 >= DFF ? 1 : 0, j = n0 - DFF * hf, dest = 256 * (j >> 7) + 128 * hf + (j & 127);
                  p0_transpose_item(AIN(33) + (size_t)l * DM * DFF2, DM, DFF2, (bf16*)(ws + WS_WUP + l * SZ_WUP), dest - n0, scr, r, lane); continue; } r -= I_UP;
              p0_transpose_item(AIN(36) + (size_t)l * DFF * DM, DFF, DM, (bf16*)(ws + WS_WDN + l * SZ_WDN), 0, scr, r, lane); } }
        for (int i = vcu * NTHR + tid; i < DEPTH * (INCP - INC) * (DM / 8); i += G * NTHR) { const int l = i / ((INCP - INC) * (DM / 8)), r = i % ((INCP - INC) * (DM / 8));
            *(v4u*)(ws + WS_WIN + l * SZ_WIN + ((size_t)INC * DM + (size_t)r * 8) * 2) = (v4u){0u, 0u, 0u, 0u}; }
        VM_WAIT(); __syncthreads();
    }
    SEAM(0);

    if (EN(1) && IN(1)) REP(1) {
        ga_tables(AIN(6), AIN(32), MOD, (float*)(ws + WS_GA1), (float*)(ws + WS_GA2), vcu * NTHR + tid, G * NTHR);
        for (int it = vcu; it < DEPTH * 248; it += G) { const int l = it / 248, r = it % 248;
            if (r < 72) bvec_item(lds, MOD + (size_t)l * NB * MODW, (const bf16*)(ws + WS_WIN + l * SZ_WIN), (float*)(ws + WS_BV1) + (size_t)l * NB * INCP, INCP, r * 64, tid);
            else bvec_item(lds, MOD + (size_t)l * NB * MODW + 3 * DM, (const bf16*)(ws + WS_WUP + l * SZ_WUP), (float*)(ws + WS_BV2) + (size_t)l * NB * DFF2, DFF2, (r - 72) * 64, tid); }
        norm0_rows(AIN(0), AIN(1) - (size_t)NPR * DM, AIN(6), MOD, HB, (unsigned long long*)(ws + WS_SSQ1), gw, ngw, lane);
    }
    SEAM(1);

#pragma unroll 1
    for (int l = 0; l < DEPTH; ++l) {
        const int pb = 2 + l * NPH_LAYER;
#define xa ((l == 0) ? AIN(0) : OUT)
#define xb ((l == 0) ? (AIN(1) - (size_t)NPR * DM) : OUT)
#define modl (MOD + (size_t)l * NB * MODW)
        if (EN(2) && IN(pb + 0)) REP(2) {
            pg8::Gemm g{HB, (const bf16*)(ws + WS_WIN + l * SZ_WIN), NTOK, INCP, DM, DM, DM}; pg8::StaticOrder S; S.init(NTOK, INCP, G, bx);
            LAS float* rst = (LAS float*)(lds + TAB_OFF); LAS float* bvt = rst + 8 * 256;
            pg8::fill_tabs(S, (const unsigned long long*)(ws + WS_SSQ1), (const float*)(ws + WS_BV1) + (size_t)l * NB * INCP, INCP, rst, bvt, tid);
            pg8::EpiBf E{PROJ, INCP, 4, rst, bvt, 0};
            pg8::gemm_phase<pg8::EpiBf, pg8::StaticOrder, true, true>(lds, g, S, E);
        }
        SEAM(pb + 0);
        if (EN(3) && IN(pb + 1)) {
            for (int i = vcu * NTHR + tid; i < NTOK; i += G * NTHR) ((unsigned long long*)(ws + WS_SSQ1))[i] = 0ull;
            REP(20) post_rows(PROJ, AIN(8) + l * 512, AIN(22) + l * 128, AIN(23) + l * 128, AIN(24) + l * 512, AIN(26) + l * 256, gw, ngw, lane, rep_ == (int)((MK_REPEAT >> 20) & 1u));
            REP(3) for (int t = vcu; t < (NTOK / 64) * 3; t += G) hyconv_tile(lds, PROJ, XT, AIN(11) + (size_t)l * 3 * 1536, AIN(12) + l * 1536, t, tid);
        }
        SEAM(pb + 1);
        if (EN(4) && IN(pb + 2)) REP(4) {
            { pg8::Gemm g{PROJ + C_D, (const bf16*)(ws + WS_WQB + l * SZ_WQB), NTOK, 768, 512, INCP, 512}; pg8::StaticOrder S; S.init(NTOK, 768, G, bx);
              pg8::EpiBf E{QD, 768, 0, nullptr, nullptr, 0};
              pg8::gemm_phase<pg8::EpiBf, pg8::StaticOrder, true, true>(lds, g, S, E); }
            { pg8::Gemm g{PROJ + C_D + 512, (const bf16*)(ws + WS_WKVB + l * SZ_WKVB), NTOK, 1024, 256, INCP, 256}; pg8::StaticOrder S; S.init(NTOK, 1024, G, (bx + G / 2) % G);
              pg8::EpiBf E{KVD, 1024, 0, nullptr, nullptr, 0};
              pg8::gemm_phase<pg8::EpiBf, pg8::StaticOrder, true, true>(lds, g, S, E); }
        }
        SEAM(pb + 2);
        if (EN(5) && IN(pb + 3)) {
            REP(5) mla_rows(QD, KVD, PROJ, KMLA, AIN(28) + l * 192, AIN(29) + l * 192, gw, ngw, lane, rep_ == (int)((MK_REPEAT >> 5) & 1u));
        }
        SEAM(pb + 3);
        if (EN(6) && IN(pb + 4)) {
            if (EN(13)) REP(13) for (int u = vcu; u < 256; u += G) { const int bh = u >> 4, qb = u & 15, b = 4 + (bh >> 2), h = bh & 3; const size_t r0 = batch_row0(b);
                att::attn_body16<192, 768, 768, 1024, DM>(QD + (r0 + qb * 256) * 768 + h * 192, KMLA + r0 * 768 + h * 192, KVD + r0 * 1024 + h * 256 + 128,
                                      YCAT + (r0 + qb * 256) * DM + 1536 + h * 128, LS, (char*)lds_raw); }
            if (EN(14)) REP(14) for (int u = vcu; u < 256; u += G) { const int bh = u >> 4, qb = u & 15, b = 4 + (bh >> 2), h = bh & 3; const size_t r0 = batch_row0(b);
                att::attn_body16<128, INCP, INCP, INCP, DM>(PROJ + (r0 + qb * 256) * INCP + C_C + h * 128, PROJ + r0 * INCP + C_C + 512 + (h >> 1) * 128, PROJ + r0 * INCP + C_C + 768 + (h >> 1) * 128,
                                      YCAT + (r0 + qb * 256) * DM + 1024 + h * 128, LS, (char*)lds_raw); }
            if (EN(15)) REP(15) for (int u = vcu; u < 256; u += G)
                hy::hyena_unit<LS>((LAS char*)lds, (const bf16*)(ws + WS_GF + (size_t)l * SZ_GF + SZ_GF_P), XT, XT + (size_t)NTOK * 512, XT + (size_t)2 * NTOK * 512, Y2T, AIN(21) + l * 1024, 4, 2 * u);
            REP(17) for (int i = vcu; i < 256; i += G) { const int u = i & 127, bh = u >> 3, qb = u & 7, b = bh >> 2, h = bh & 3; const size_t r0 = batch_row0(b);
                if (i < 128) { if (EN(13))
                    att::attn_body16<192, 768, 768, 1024, DM>(QD + (r0 + qb * 256) * 768 + h * 192, KMLA + r0 * 768 + h * 192, KVD + r0 * 1024 + h * 256 + 128,
                                          YCAT + (r0 + qb * 256) * DM + 1536 + h * 128, LP, (char*)lds_raw); }
                else if (EN(14))
                    att::attn_body16<128, INCP, INCP, INCP, DM>(PROJ + (r0 + qb * 256) * INCP + C_C + h * 128, PROJ + r0 * INCP + C_C + 512 + (h >> 1) * 128, PROJ + r0 * INCP + C_C + 768 + (h >> 1) * 128,
                                          YCAT + (r0 + qb * 256) * DM + 1024 + h * 128, LP, (char*)lds_raw); }
            if (EN(15)) REP(18) for (int i = (G == 256) ? (vcu + 128) % 256 : vcu; i < 128; i += G)
                hy::hyena_unit<LP>((LAS char*)lds, (const bf16*)(ws + WS_GF + (size_t)l * SZ_GF), XT, XT + (size_t)NTOK * 512, XT + (size_t)2 * NTOK * 512, Y2T, AIN(21) + l * 1024, 0, 4 * i);
            if (EN(16)) REP(16) {
                if (G == 256) { const int v_ = vcu;
                    if (v_ < 128) { for (int u = v_; u < 768; u += 128) gmlp_unit((char*)lds_raw, PROJ, YCAT, AIN(9) + (size_t)l * 4 * 16384, AIN(10) + l * 512, u, tid); } }
                else for (int u = vcu; u < 768; u += G) gmlp_unit((char*)lds_raw, PROJ, YCAT, AIN(9) + (size_t)l * 4 * 16384, AIN(10) + l * 512, u, tid); }
            VM_WAIT(); __syncthreads();
        }
        SEAM(pb + 4);
        if (EN(7) && IN(pb + 5)) REP(7) { for (int t = vcu; t < NTOK / 32; t += G) gnorm_tile(lds, YCAT, Y2T, AIN(30) + l * DM, HB, t, tid); }
        SEAM(pb + 5);
        if (EN(8) && IN(pb + 6)) {
            pg8::Gemm g{HB, (const bf16*)(ws + WS_WOUT + l * SZ_WOUT), NTOK, DM, DM, DM, DM}; pg8::StaticOrder S; S.init(NTOK, DM, G, bx);
            if (l == 0) { pg8::EpiResidT<false, true> E{AIN(0), AIN(1) - (size_t)NPR * DM, OUT, modl + 2 * DM, (bf16*)(ws + WS_HB2), (const float*)(ws + WS_GA2) + (size_t)l * NB * DM, (unsigned long long*)(ws + WS_SSQ2)};
                pg8::gemm_phase<pg8::EpiResidT<false, true>, pg8::StaticOrder, true, true>(lds, g, S, E); }
            else { pg8::EpiResidT<true, true> E{OUT, OUT, (l + 1 == DEPTH) ? (void*)(ws + WS_XRES) : (void*)OUT, modl + 2 * DM, (bf16*)(ws + WS_HB2), (const float*)(ws + WS_GA2) + (size_t)l * NB * DM, (unsigned long long*)(ws + WS_SSQ2)};
                pg8::gemm_phase<pg8::EpiResidT<true, true>, pg8::StaticOrder, true, true>(lds, g, S, E); }
        }
        SEAM(pb + 6);
        if (EN(10) && IN(pb + 7)) REP(10) {
            pg8::Gemm g{(const bf16*)(ws + WS_HB2), (const bf16*)(ws + WS_WUP + l * SZ_WUP), NTOK, DFF2, DM, DM, DM}; pg8::StaticOrder S; S.init(NTOK, DFF2, G, bx);
            LAS float* rst = (LAS float*)(lds + TAB_OFF);
            pg8::fill_tabs(S, (const unsigned long long*)(ws + WS_SSQ2), nullptr, 0, rst, rst, tid);
            pg8::EpiGate E{AFFN, (float*)(ws + WS_R1), AIN(34) + (size_t)l * 3 * DFF2, AIN(35) + l * DFF2, (LAS float*)(lds + HALO_OFF), rst, (const float*)(ws + WS_BV2) + (size_t)l * NB * DFF2, 0};
            pg8::gemm_phase<pg8::EpiGate, pg8::StaticOrder, true, true>(lds, g, S, E);
        }
        SEAM(pb + 7);
        if (EN(11) && IN(pb + 8)) for (int i = vcu * NTHR + tid; i < NTOK; i += G * NTHR) ((unsigned long long*)(ws + WS_SSQ2))[i] = 0ull;
        if (EN(11) && IN(pb + 8)) REP(11) gate_fix((const float*)(ws + WS_R1), AFFN, AIN(34) + (size_t)l * 3 * DFF2, AIN(35) + l * DFF2, vcu * NTHR + tid, G * NTHR);
        SEAM(pb + 8);
        if (EN(12) && IN(pb + 9)) {
            pg8::Gemm g{AFFN, (const bf16*)(ws + WS_WDN + l * SZ_WDN), NTOK, DM, DFF, DFF, DFF}; pg8::StaticOrder S; S.init(NTOK, DM, G, bx);
            if (l + 1 < DEPTH) { pg8::EpiResidT<true, true> E{OUT, OUT, OUT, modl + 5 * DM, HB, (const float*)(ws + WS_GA1) + (size_t)(l + 1) * NB * DM, (unsigned long long*)(ws + WS_SSQ1)};
                pg8::gemm_phase<pg8::EpiResidT<true, true>, pg8::StaticOrder, true, true, true, false>(lds, g, S, E); }
            else { pg8::EpiResidT<true, false> E{(const void*)(ws + WS_XRES), (const void*)(ws + WS_XRES), OUT, modl + 5 * DM, nullptr, nullptr, nullptr};
                pg8::gemm_phase<pg8::EpiResidT<true, false>, pg8::StaticOrder, true, true, true, false>(lds, g, S, E); }
        }
        if (l + 1 < DEPTH) SEAM(pb + 9);
    }
#undef xa
#undef xb
#undef modl
#undef G
#undef bx
#undef vcu
#undef ngw
#undef IN
#undef SEAM
#undef tid
#undef lane
#undef wave
#undef gw
#undef ws
#undef MOD
#undef HB
#undef AFFN
#undef Z
#undef PROJ
#undef XT
#undef Y2T
#undef QD
#undef KVD
#undef KMLA
#undef YCAT
#undef OUT
}

extern "C" void kernel_launch(void* const* d_in, const int* in_sizes, int n_in, void* d_out, int out_size, void* d_ws, size_t ws_size, hipStream_t stream) {
    static int grid = 0;
    if (grid == 0) {
        if (n_in != 37 || out_size != NTOK * DM || ws_size < WS_END) { fprintf(stderr, "kernel_launch: shape mismatch (n_in %d out %d ws %zu need %zu)\n", n_in, out_size, ws_size, (size_t)WS_END); grid = -1; return; }
        int dev = 0, cus = 0, per_cu = 0;
        if (hipGetDevice(&dev) != hipSuccess || hipDeviceGetAttribute(&cus, hipDeviceAttributeMultiprocessorCount, dev) != hipSuccess) { grid = -1; return; }
        if (hipFuncSetAttribute((const void*)mk_fwd, hipFuncAttributeMaxDynamicSharedMemorySize, LDS_BYTES) != hipSuccess) { fprintf(stderr, "kernel_launch: hipFuncSetAttribute failed\n"); grid = -1; return; }
        if (hipOccupancyMaxActiveBlocksPerMultiprocessor(&per_cu, (const void*)mk_fwd, NTHR, LDS_BYTES) != hipSuccess || per_cu < 1)
            fprintf(stderr, "kernel_launch: occupancy query reports %d workgroups per CU\n", per_cu);
        (void)hipGetLastError();
        grid = cus;
        if (grid > 256) grid = 256;
    }
    if (grid < 0) return;
    if (hipMemsetAsync((char*)d_ws + WS_CTL, 0, CTL_ZERO_BYTES, stream) != hipSuccess) { fprintf(stderr, "kernel_launch: memset failed\n"); return; }
    Args a{};
    for (int i = 0; i < 37; ++i) a.in[i] = (const float*)d_in[i];
    a.out = (float*)d_out; a.ws = (unsigned char*)d_ws;
#if MK_MULTI
    for (int p = 0; p < NPHASE; ++p) { a.ph_lo = p; a.ph_hi = p + 1; hipLaunchKernelGGL(mk_fwd, dim3(grid), dim3(NTHR), LDS_BYTES, stream, a); }
#else
    a.ph_lo = 0; a.ph_hi = NPHASE;
    hipLaunchKernelGGL(mk_fwd, dim3(grid), dim3(NTHR), LDS_BYTES, stream, a);
#endif
    const hipError_t le = hipPeekAtLastError();
    if (le != hipSuccess) fprintf(stderr, "kernel_launch: launch failed: %s\n", hipGetErrorName(le));
}
```

```cpp
#include <hip/hip_runtime.h>
#include <hip/hip_bf16.h>
#include <cstdio>
#include <cstdint>
#include <cmath>

#ifndef MK_MULTI
#define MK_MULTI 0
#endif

constexpr int DM = 2048, NTOK = 24576, NPR = 8192  , LP = 2048, LS = 4096, DEPTH = 4, NB = 8  ;
constexpr int INC = 4416, INCP = 4608;
constexpr int C_A = 0, C_B = 1024, C_C = 2560, C_D = 3584;
constexpr int DFF = 5632, DFF2 = 11264;
constexpr int MODW = 6 * DM;
constexpr float EPS = 1e-6f;
constexpr int NWAVES = 8, NTHR = 512;

constexpr size_t MiB = 1u << 20;
constexpr size_t WS_CTL = 0, CTL_ZERO_BYTES = 512 * 1024;
constexpr size_t WS_SSQ1 = 65536, WS_SSQ2 = WS_SSQ1 + (size_t)NTOK * 8;
static_assert(WS_SSQ2 + (size_t)NTOK * 8 <= CTL_ZERO_BYTES, "ssq inside the memset");
constexpr size_t WS_MOD = 1 * MiB;
constexpr size_t WS_GA1 = 2 * MiB + 512 * 1024;
constexpr size_t WS_GA2 = WS_GA1 + 256 * 1024;
constexpr size_t WS_BV1 = 3 * MiB;
constexpr size_t WS_BV2 = 4 * MiB;
constexpr size_t WS_WIN = 6 * MiB;
constexpr size_t SZ_WIN = (size_t)INCP * DM * 2;
constexpr size_t WS_WQB = WS_WIN + DEPTH * SZ_WIN;
constexpr size_t SZ_WQB = (size_t)768 * 512 * 2;
constexpr size_t WS_WKVB = WS_WQB + DEPTH * SZ_WQB;
constexpr size_t SZ_WKVB = (size_t)1024 * 256 * 2;
constexpr size_t WS_WOUT = WS_WKVB + DEPTH * SZ_WKVB;
constexpr size_t SZ_WOUT = (size_t)DM * DM * 2;
constexpr size_t WS_WUP = WS_WOUT + DEPTH * SZ_WOUT;
constexpr size_t SZ_WUP = (size_t)DFF2 * DM * 2;
constexpr size_t WS_WDN = WS_WUP + DEPTH * SZ_WUP;
constexpr size_t SZ_WDN = (size_t)DM * DFF * 2;
constexpr size_t WS_GF = WS_WDN + DEPTH * SZ_WDN;
constexpr size_t SZ_GF_P = (size_t)2 * 512 * 4608 * 2, SZ_GF_S = (size_t)2 * 512 * 9216 * 2, SZ_GF = SZ_GF_P + SZ_GF_S;
constexpr size_t WS_HB = WS_GF + DEPTH * SZ_GF;
constexpr size_t WS_HB2 = WS_HB + (size_t)NTOK * DM * 2;
constexpr size_t WS_AFFN = WS_HB2 + (size_t)NTOK * DM * 2;
constexpr size_t WS_R1 = WS_AFFN + (size_t)NTOK * DFF * 2;
constexpr size_t WS_Z = WS_R1;
constexpr size_t WS_PROJ = WS_R1;
constexpr size_t WS_XT = WS_PROJ + (size_t)NTOK * INCP * 2;
constexpr size_t SZ_XT1 = (size_t)NTOK * 512 * 2;
constexpr size_t WS_Y2T = WS_XT + 3 * SZ_XT1;
constexpr size_t WS_QD = WS_Y2T + SZ_XT1;
constexpr size_t WS_KVD = WS_QD + (size_t)NTOK * 768 * 2;
constexpr size_t WS_KMLA = WS_KVD + (size_t)NTOK * 1024 * 2;
constexpr size_t WS_YCAT = WS_KMLA + (size_t)NTOK * 768 * 2;
constexpr size_t WS_XRES = WS_R1 + 64 * MiB;
constexpr size_t WS_END = WS_R1 + (size_t)NTOK * DFF2 * 2;
static_assert(WS_YCAT + (size_t)NTOK * DM * 2 <= WS_END, "mixer buffers fit under Z");
static_assert(WS_BV2 + (size_t)DEPTH * NB * DFF2 * 4 <= WS_WIN, "ws map");
constexpr int CW_BAR = 4096;

__host__ __device__ __forceinline__ size_t xt_off(int b, int c) { return b < 4 ? ((size_t)(b * 512 + c) * LP) : ((size_t)4 * 512 * LP + (size_t)((b - 4) * 512 + c) * LS); }
__host__ __device__ __forceinline__ int row_batch(int row) { return row < NPR ? (row >> 11) : 4 + ((row - NPR) >> 12); }
__host__ __device__ __forceinline__ int row_pos(int row) { return row < NPR ? (row & (LP - 1)) : ((row - NPR) & (LS - 1)); }
__host__ __device__ __forceinline__ int batch_row0(int b) { return b < 4 ? b * LP : NPR + (b - 4) * LS; }
__host__ __device__ __forceinline__ int batch_len(int b) { return b < 4 ? LP : LS; }

__host__ __device__ __forceinline__ size_t affn_off(int row, int j) { return ((((size_t)(row >> 8) * (DFF / 64) + (j >> 6)) * 256 + (row & 255)) << 6) + (j & 63); }

constexpr int RING_BYTES = 131072;
constexpr int LDSCTL_OFF = RING_BYTES, MISC_OFF = LDSCTL_OFF + 320, HALO_OFF = RING_BYTES + 1024;
constexpr int TAB_OFF = HALO_OFF + 8192 + 1024, TAB_BYTES = 17408;
constexpr int LDS_BYTES = 161792;
#define GAS __attribute__((address_space(1)))
#define LAS __attribute__((address_space(3)))
typedef unsigned short bf16;
typedef unsigned v4u __attribute__((ext_vector_type(4)));
typedef float f32x4 __attribute__((ext_vector_type(4)));
typedef short bf16x8 __attribute__((ext_vector_type(8)));
typedef GAS unsigned gu32;
typedef GAS unsigned long long gu64;
#define RLX_AGENT __ATOMIC_RELAXED, __HIP_MEMORY_SCOPE_AGENT
#define LDS_WAIT() asm volatile("s_waitcnt lgkmcnt(0)" ::: "memory")
#define VM_WAIT() asm volatile("s_waitcnt vmcnt(0)" ::: "memory")
__device__ __forceinline__ int tid_fresh() { int t = threadIdx.x; asm volatile("" : "+v"(t)); return t; }
__device__ __forceinline__ int sfresh(int v) { asm volatile("" : "+s"(v)); return v; }
__device__ __forceinline__ unsigned long long rt() { return __builtin_amdgcn_s_memrealtime(); }
__device__ __forceinline__ unsigned f2bf(float f) { unsigned u = __builtin_bit_cast(unsigned, f); return (u + 0x7fffu + ((u >> 16) & 1u)) >> 16; }
__device__ __forceinline__ unsigned pk2(float lo, float hi) { return f2bf(lo) | (f2bf(hi) << 16); }
#define XB_TMO      128
#define XB_XCNT(j)  (256  + 64 * (j))
#define XB_XSUB(j)  (1280 + 64 * (j))
#define XB_XGEN(j)  (2304 + 64 * (j))
#define XB_TOP      3328
#define XB_TOPGEN   3392
#define XCD_BAR_WORDS 3456
#define XB_SPIN_CAP (1u << 18)

__device__ __forceinline__ unsigned xb_ld(unsigned* p)              { return __hip_atomic_load(p, __ATOMIC_RELAXED, __HIP_MEMORY_SCOPE_AGENT); }
__device__ __forceinline__ unsigned xb_add(unsigned* p, unsigned v) { return __hip_atomic_fetch_add(p, v, __ATOMIC_RELAXED, __HIP_MEMORY_SCOPE_AGENT); }
__device__ __forceinline__ unsigned xb_xcc_id() { return (unsigned)__builtin_amdgcn_s_getreg((3 << 11) | 20) & 0xFu; }
#define XB_SPIN(cond, bar) do { unsigned _sp = 0; while (cond) { __builtin_amdgcn_s_sleep(1); \
    if ((++_sp & 255u) == 0u) { if (xb_ld(&(bar)[XB_TMO])) break; if (_sp > XB_SPIN_CAP) { atomicAdd(&(bar)[XB_TMO], 1u); break; } } } } while (0)

struct XcdBarrier {
    unsigned* bar; unsigned x;
    volatile LAS unsigned* st;
};

__device__ __forceinline__ XcdBarrier xcd_barrier_post(unsigned* bar, volatile LAS unsigned* st) {
    XcdBarrier b; b.bar = bar; b.x = xb_xcc_id(); b.st = st;
    if (threadIdx.x == 0) (void)xb_add(&bar[XB_XCNT(b.x)], 1u);
    return b;
}
__device__ __forceinline__ void xcd_barrier_complete(unsigned* bar, unsigned x, unsigned& nloc, unsigned& nx) {
    const unsigned G = gridDim.x * gridDim.y * gridDim.z;
    unsigned sum, cnt, mine, sp = 0u;
    for (;;) {
        sum = 0u; cnt = 0u; mine = 0u;
#pragma unroll
        for (unsigned j = 0; j < 16; ++j) { const unsigned c = xb_ld(&bar[XB_XCNT(j)]); sum += c; cnt += (c > 0u) ? 1u : 0u; mine = (j == x) ? c : mine; }
        if (sum == G) break;
        __builtin_amdgcn_s_sleep(1);
        if ((++sp & 255u) == 0u) { if (xb_ld(&bar[XB_TMO])) break; if (sp > XB_SPIN_CAP) { atomicAdd(&bar[XB_TMO], 1u); break; } }
    }
    nloc = mine > 0u ? mine : 1u; nx = cnt > 0u ? cnt : 1u;
}

__device__ __forceinline__ void xcd_barrier(const XcdBarrier& b) {
    asm volatile("s_waitcnt vmcnt(0)" ::: "memory");
    __syncthreads();
    if (threadIdx.x == 0) {
        unsigned* bar = b.bar;
        __builtin_amdgcn_s_waitcnt(0);
        unsigned nloc = b.st[0], nx = b.st[1];
        if (nloc == 0u) { xcd_barrier_complete(bar, b.x, nloc, nx); b.st[0] = nloc; b.st[1] = nx; }
        const unsigned old = xb_add(&bar[XB_XSUB(b.x)], 1u);
        const unsigned gen = old / nloc;
        if (old + 1u == (gen + 1u) * nloc) {
            __builtin_amdgcn_fence(__ATOMIC_RELEASE, "agent");
            asm volatile("s_waitcnt vmcnt(0)" ::: "memory");
            const unsigned og = xb_add(&bar[XB_TOP], 1u);
            const unsigned tg = og / nx;
            if (og + 1u == (tg + 1u) * nx) xb_add(&bar[XB_TOPGEN], 1u);
            else XB_SPIN(xb_ld(&bar[XB_TOPGEN]) == tg, bar);
            __builtin_amdgcn_fence(__ATOMIC_ACQUIRE, "agent");
            xb_add(&bar[XB_XGEN(b.x)], 1u);
            asm volatile("s_waitcnt vmcnt(0)" ::: "memory");
        } else {
            XB_SPIN(xb_ld(&bar[XB_XGEN(b.x)]) == gen, bar);
            __builtin_amdgcn_fence(__ATOMIC_ACQUIRE, "agent");
            asm volatile("s_waitcnt vmcnt(0)" ::: "memory");
        }
    }
    __syncthreads();
}
namespace pg8 {
#define PG8_LAS __attribute__((address_space(3)))
typedef unsigned short bf16_t;
typedef short bf16x8 __attribute__((ext_vector_type(8)));
typedef float f32x4 __attribute__((ext_vector_type(4)));
typedef unsigned u32x4 __attribute__((ext_vector_type(4)));
constexpr int BM = 256, BK = 64, HALF = 128, HTB = HALF * BK * 2  , STAGE_BYTES = 8 * HTB, NXCD = 8, WGM = 4;

__host__ __device__ __forceinline__ int lds_byte(int r, int c) { const int st = (r >> 4) * 2 + (c >> 5), rr = r & 15, cc = c & 31, ob = rr * 64 + cc * 2; return st * 1024 + (ob ^ (((ob >> 9) & 1) << 5)); }
__host__ __device__ __forceinline__ void stage_rc(int b, int& R, int& C) { const int st = b / 1024, sb = b % 1024, swz = sb ^ (((sb >> 9) & 1) << 5); R = (st >> 1) * 16 + swz / 64; C = (st & 1) * 32 + (swz % 64) / 2; }
__host__ __device__ __forceinline__ int perm32(int rho) { const int n = rho >> 4, i = rho & 15; return 8 * (i >> 2) + 4 * n + (i & 3); }

struct Unit { int pm, pn; };
struct Gemm { const bf16_t* A; const bf16_t* Bt; int M, N, K, lda, ldb; };

struct StaticOrder {
    int nM, nN, nwg, G, c;
    __host__ __device__ void init(int M, int N, int G_, int c_) { nM = M / BM; nN = N / BM; nwg = nM * nN; G = G_; c = c_; }
    __host__ __device__ bool next(int i, Unit& u) const {
        const long L = (long)i * G + c; if (L >= nwg) return false;
        int wgid = (int)L; { const int q = nwg / NXCD, r = nwg % NXCD, xcd = wgid % NXCD, off = wgid / NXCD; wgid = (xcd < r ? xcd * (q + 1) : r * (q + 1) + (xcd - r) * q) + off; }
        const int nig = WGM * nN, gid = wgid / nig, fm = gid * WGM, gsz = (nM - fm) < WGM ? (nM - fm) : WGM;
        u.pm = fm + ((wgid % nig) % gsz); u.pn = (wgid % nig) / gsz; return true;
    }
    __device__ __forceinline__ void a_ready(const Unit&) const {}
    __device__ __forceinline__ void done(const Unit&) const {}
};

__device__ __forceinline__ unsigned cvt_pk_bf16(float lo, float hi) { unsigned r; asm volatile("v_cvt_pk_bf16_f32 %0, %1, %2" : "=v"(r) : "v"(lo), "v"(hi)); return r; }
typedef float f32x2 __attribute__((ext_vector_type(2)));
__device__ __forceinline__ f32x2 gelu_pk(f32x2 v) {
    const f32x2 av = __builtin_elementwise_abs(v), d = av * 0.2316418882f + 1.0f;
    f32x2 t; t.x = __builtin_amdgcn_rcpf(d.x); t.y = __builtin_amdgcn_rcpf(d.y);
    f32x2 q = t * 0.5307027145f + (-0.7265760135f); q = q * t + 0.7107068705f; q = q * t + (-0.142248368f); q = q * t + 0.127414796f; q = q * t;
    const f32x2 s = (v * v) * (-0.72134752044f);
    f32x2 e; e.x = __builtin_amdgcn_exp2f(s.x); e.y = __builtin_amdgcn_exp2f(s.y);
    const f32x2 m = v * (q * e), r = v - m;
    f32x2 o; o.x = v.x < 0.f ? m.x : r.x; o.y = v.y < 0.f ? m.y : r.y; return o;
}

template <class Epi, class Sched, bool ALIGN_EPI = false, bool SP2 = false, bool BLKA = false, bool BLKB = false>
__device__ __forceinline__ void gemm_phase(PG8_LAS unsigned char* lds, const Gemm g, const Sched& S, const Epi& E) {
    const int tid = tid_fresh(), wid = __builtin_amdgcn_readfirstlane(tid >> 6), lane = tid & 63, wr = wid >> 2, wc = wid & 3, fr = lane & 15, fq = lane >> 4;
    const int K = g.K, nt = K / BK;
    unsigned voffA[2], voffB[2];
#pragma unroll
    for (int i = 0; i < 2; ++i) { int R, C; stage_rc(tid * 16 + i * 8192, R, C); const int Rb = Epi::PERM ? ((R & ~31) + perm32(R & 31)) : R;
        const int Ra = Epi::AROWPERM ? ((R & ~63) | (4 * (R & 15) + ((R >> 4) & 3))) : R;
        voffA[i] = (unsigned)(Ra * (BLKA ? BK : g.lda) + C) * 2u; voffB[i] = (unsigned)(Rb * (BLKB ? BK : g.ldb) + C) * 2u; }
    const size_t kstepA = BLKA ? (size_t)BM * BK * 2 : (size_t)(BK * 2), kstepB = BLKB ? (size_t)BM * BK * 2 : (size_t)(BK * 2);
    const size_t hstepA = BLKA ? (size_t)HALF * BK * 2 : (size_t)HALF * g.lda * 2, hstepB = BLKB ? (size_t)HALF * BK * 2 : (size_t)HALF * g.ldb * 2;
    const size_t tstepA = BLKA ? (size_t)nt * BM * BK * 2 : 2 * hstepA, tstepB = BLKB ? (size_t)nt * BM * BK * 2 : 2 * hstepB;
    const unsigned ldsw = (unsigned)wid * 1024u;
    const int aoff = lds_byte(wr * 64 + fr, fq * 8), boff = lds_byte(wc * 32 + fr, fq * 8);
#define PG8_SA(b, h) (((b) * 2 + (h)) * HTB)
#define PG8_SB(b, h) ((4 + (b) * 2 + (h)) * HTB)
#define PG8_STAGE(bufoff, gbase, voff) do { _Pragma("unroll") for (int _i = 0; _i < 2; ++_i) \
        __builtin_amdgcn_global_load_lds((const unsigned*)((const char*)(gbase) + (voff)[_i]), (PG8_LAS unsigned*)(lds + (bufoff) + ldsw + _i * 8192), 16, 0, 0); } while (0)
#define PG8_LDA(dst, b, h) do { _Pragma("unroll") for (int m = 0; m < 4; ++m) _Pragma("unroll") for (int k = 0; k < 2; ++k) dst[m][k] = *(const PG8_LAS bf16x8*)(lds + PG8_SA(b, h) + aoff + m * 2048 + k * 1024); } while (0)
#define PG8_LDB(dst, b, h) do { _Pragma("unroll") for (int n = 0; n < 2; ++n) _Pragma("unroll") for (int k = 0; k < 2; ++k) dst[n][k] = *(const PG8_LAS bf16x8*)(lds + PG8_SB(b, h) + boff + n * 2048 + k * 1024); } while (0)
#define PG8_MMA(ai, bj, At, Bt) do { __builtin_amdgcn_s_setprio(1); _Pragma("unroll") for (int m = 0; m < 4; ++m) _Pragma("unroll") for (int n = 0; n < 2; ++n) _Pragma("unroll") for (int k = 0; k < 2; ++k) \
        acc[ai][bj][m][n] = __builtin_amdgcn_mfma_f32_16x16x32_bf16(Bt[n][k], At[m][k], acc[ai][bj][m][n], 0, 0, 0); __builtin_amdgcn_s_setprio(0); } while (0)
#define PG8_WAIT_V(n) asm volatile("s_waitcnt vmcnt(" #n ")" ::: "memory")
#define PG8_WAIT_L(n) asm volatile("s_waitcnt lgkmcnt(" #n ")" ::: "memory")
#define PG8_BAR __builtin_amdgcn_s_barrier()
#define PG8_SCHED __builtin_amdgcn_sched_barrier(0)
    Unit cur, nxt; int ui = 0;
    if (!S.next(0, cur)) return;
    f32x4 acc[2][2][4][2];
#pragma unroll
    for (int a = 0; a < 2; ++a)
#pragma unroll
        for (int b = 0; b < 2; ++b)
#pragma unroll
            for (int m = 0; m < 4; ++m)
#pragma unroll
                for (int n = 0; n < 2; ++n) acc[a][b][m][n] = (f32x4){0.f, 0.f, 0.f, 0.f};
    bf16x8 At[4][2], B0[2][2], B1[2][2];
    const char* cA = (const char*)g.A + (size_t)cur.pm * tstepA; const char* cB = (const char*)g.Bt + (size_t)cur.pn * tstepB;
    S.a_ready(cur);
    if constexpr (SP2) {
        PG8_STAGE(PG8_SB(0, 0), cB, voffB); PG8_STAGE(PG8_SB(0, 1), cB + hstepB, voffB); PG8_STAGE(PG8_SA(0, 0), cA, voffA); PG8_STAGE(PG8_SA(0, 1), cA + hstepA, voffA);
        if (wr == 1) PG8_BAR;
        PG8_WAIT_V(2); PG8_BAR;
        PG8_STAGE(PG8_SB(1, 0), cB + kstepB, voffB); PG8_STAGE(PG8_SA(1, 0), cA + kstepA, voffA); PG8_STAGE(PG8_SB(1, 1), cB + hstepB + kstepB, voffB);
        PG8_WAIT_V(6); PG8_BAR;
    } else {
        PG8_STAGE(PG8_SB(0, 0), cB, voffB); PG8_STAGE(PG8_SA(0, 0), cA, voffA); PG8_STAGE(PG8_SB(0, 1), cB + hstepB, voffB); PG8_STAGE(PG8_SA(0, 1), cA + hstepA, voffA);
        if (wr == 1) PG8_BAR;
        PG8_WAIT_V(4); PG8_BAR;
        PG8_STAGE(PG8_SB(1, 0), cB + kstepB, voffB); PG8_STAGE(PG8_SA(1, 0), cA + kstepA, voffA); PG8_STAGE(PG8_SB(1, 1), cB + hstepB + kstepB, voffB);
        PG8_WAIT_V(6); PG8_BAR;
    }
    for (;;) {
        const bool has_next = S.next(ui + 1, nxt);
        const char* nA = has_next ? (const char*)g.A + (size_t)nxt.pm * tstepA : cA; const char* nB = has_next ? (const char*)g.Bt + (size_t)nxt.pn * tstepB : cB;
        for (int t = 0; t < nt; t += 2) {
            const bool last = (t == nt - 2);
            const char* a1 = cA + (size_t)(t + 1) * kstepA;
            const char* a2 = last ? nA : cA + (size_t)(t + 2) * kstepA; const char* b2 = last ? nB : cB + (size_t)(t + 2) * kstepB;
            const char* a3 = a2 + kstepA; const char* b3 = b2 + kstepB;
            if (last && has_next) S.a_ready(nxt);
            if constexpr (SP2) {
            PG8_LDB(B0, 0, 0); PG8_LDB(B1, 0, 1); PG8_SCHED; PG8_LDA(At, 0, 0); PG8_STAGE(PG8_SA(1, 1), a1 + hstepA, voffA);
            PG8_WAIT_V(8); PG8_WAIT_L(0); PG8_BAR; PG8_MMA(0, 0, At, B0); PG8_MMA(0, 1, At, B1); PG8_BAR; PG8_SCHED;
            PG8_LDA(At, 0, 1); PG8_STAGE(PG8_SB(0, 0), b2, voffB); PG8_STAGE(PG8_SB(0, 1), b2 + hstepB, voffB); PG8_STAGE(PG8_SA(0, 0), a2, voffA);
            PG8_WAIT_V(8); PG8_WAIT_L(0); PG8_BAR; PG8_MMA(1, 0, At, B0); PG8_MMA(1, 1, At, B1); PG8_BAR; PG8_SCHED;
            PG8_LDB(B0, 1, 0); PG8_LDB(B1, 1, 1); PG8_SCHED; PG8_LDA(At, 1, 0); PG8_STAGE(PG8_SA(0, 1), a2 + hstepA, voffA);
            PG8_WAIT_V(8); PG8_WAIT_L(0); PG8_BAR; PG8_MMA(0, 0, At, B0); PG8_MMA(0, 1, At, B1); PG8_BAR; PG8_SCHED;
            PG8_LDA(At, 1, 1); PG8_STAGE(PG8_SB(1, 0), b3, voffB); PG8_STAGE(PG8_SB(1, 1), b3 + hstepB, voffB); PG8_STAGE(PG8_SA(1, 0), a3, voffA);
            PG8_WAIT_V(8); PG8_WAIT_L(0); PG8_BAR; PG8_MMA(1, 0, At, B0); PG8_MMA(1, 1, At, B1); PG8_BAR; PG8_SCHED;
            } else {
            PG8_LDB(B0, 0, 0); PG8_SCHED; PG8_LDA(At, 0, 0); PG8_STAGE(PG8_SA(1, 1), a1 + hstepA, voffA);
            PG8_WAIT_L(8); PG8_BAR; PG8_WAIT_L(0); PG8_MMA(0, 0, At, B0); PG8_BAR; PG8_SCHED;
            PG8_LDB(B1, 0, 1); PG8_STAGE(PG8_SB(0, 0), b2, voffB);
            PG8_BAR; PG8_WAIT_L(0); PG8_MMA(0, 1, At, B1); PG8_BAR;
            PG8_LDA(At, 0, 1); PG8_STAGE(PG8_SA(0, 0), a2, voffA);
            PG8_BAR; PG8_WAIT_L(0); PG8_MMA(1, 0, At, B0); PG8_BAR; PG8_SCHED;
            PG8_STAGE(PG8_SB(0, 1), b2 + hstepB, voffB);
            PG8_WAIT_V(6); PG8_BAR; PG8_MMA(1, 1, At, B1); PG8_BAR;
            PG8_LDB(B0, 1, 0); PG8_SCHED; PG8_LDA(At, 1, 0); PG8_STAGE(PG8_SA(0, 1), a2 + hstepA, voffA);
            PG8_WAIT_L(8); PG8_BAR; PG8_WAIT_L(0); PG8_MMA(0, 0, At, B0); PG8_BAR; PG8_SCHED;
            PG8_LDB(B1, 1, 1); PG8_STAGE(PG8_SB(1, 0), b3, voffB);
            PG8_BAR; PG8_WAIT_L(0); PG8_MMA(0, 1, At, B1); PG8_BAR;
            PG8_LDA(At, 1, 1); PG8_STAGE(PG8_SA(1, 0), a3, voffA);
            PG8_BAR; PG8_WAIT_L(0); PG8_MMA(1, 0, At, B0); PG8_BAR; PG8_SCHED;
            PG8_STAGE(PG8_SB(1, 1), b3 + hstepB, voffB);
            PG8_WAIT_V(6); PG8_BAR; PG8_MMA(1, 1, At, B1); PG8_BAR;
            }
        }
        if constexpr (ALIGN_EPI) { if (wr == 0) PG8_BAR; }
        if constexpr (!Epi::AFTER_DRAIN) { E(acc, cur, wr, wc, fr, fq); S.done(cur); }
        if (!has_next) break;
#pragma unroll
        for (int a = 0; a < 2; ++a)
#pragma unroll
            for (int b = 0; b < 2; ++b)
#pragma unroll
                for (int m = 0; m < 4; ++m)
#pragma unroll
                    for (int n = 0; n < 2; ++n) acc[a][b][m][n] = (f32x4){0.f, 0.f, 0.f, 0.f};
        cur = nxt; cA = nA; cB = nB; ++ui;
        if constexpr (ALIGN_EPI) { if (wr == 1) PG8_BAR; }
    }
    PG8_WAIT_V(0);
    if constexpr (!ALIGN_EPI) { if (wr == 0) PG8_BAR; }
    PG8_BAR;
    if constexpr (Epi::AFTER_DRAIN) { E.fused(acc, cur, wr, wc, fr, fq, lds, wid, lane); S.done(cur); }
#undef PG8_SA
#undef PG8_SB
#undef PG8_STAGE
#undef PG8_LDA
#undef PG8_LDB
#undef PG8_MMA
#undef PG8_WAIT_V
#undef PG8_WAIT_L
#undef PG8_BAR
#undef PG8_SCHED
}
}
namespace pg8 {
struct EpiBf {
    static constexpr bool PERM = true, AFTER_DRAIN = false, AROWPERM = false;
    bf16_t* O; int ldc; int gelu_tiles;
    const PG8_LAS float* ss; const PG8_LAS float* bvec; mutable int ui;
    __device__ __forceinline__ void operator()(const f32x4 (&acc)[2][2][4][2], const Unit& u, int wr, int wc, int fr, int fq) const {
        const int row0 = u.pm * BM + wr * 64 + fr; const int col0 = u.pn * BM + wc * 32 + 8 * fq;
        const bool act = u.pn < gelu_tiles;
        f32x4 bv[2][2];
        if (ss) { const PG8_LAS float* bp = bvec + ui * BM + wc * 32 + 8 * fq;
#pragma unroll
            for (int bj = 0; bj < 2; ++bj)
#pragma unroll
                for (int n = 0; n < 2; ++n) bv[bj][n] = *(const PG8_LAS f32x4*)(bp + bj * HALF + 4 * n); }
#pragma unroll
        for (int ai = 0; ai < 2; ++ai)
#pragma unroll
            for (int m = 0; m < 4; ++m) { bf16_t* rowp = O + (size_t)(row0 + ai * HALF + m * 16) * ldc + col0;
                float rs = 1.f; if (ss) rs = ss[ui * BM + wr * 64 + fr + ai * HALF + m * 16];
#pragma unroll
                for (int bj = 0; bj < 2; ++bj) { f32x4 v0 = acc[ai][bj][m][0], v1 = acc[ai][bj][m][1];
                    if (ss) { v0 = v0 * rs + bv[bj][0]; v1 = v1 * rs + bv[bj][1]; }
                    if (act) { f32x2 a = gelu_pk((f32x2){v0[0], v0[1]}), b = gelu_pk((f32x2){v0[2], v0[3]}), c = gelu_pk((f32x2){v1[0], v1[1]}), d = gelu_pk((f32x2){v1[2], v1[3]});
                        v0 = (f32x4){a.x, a.y, b.x, b.y}; v1 = (f32x4){c.x, c.y, d.x, d.y}; }
                    u32x4 w; w.x = cvt_pk_bf16(v0[0], v0[1]); w.y = cvt_pk_bf16(v0[2], v0[3]); w.z = cvt_pk_bf16(v1[0], v1[1]); w.w = cvt_pk_bf16(v1[2], v1[3]);
                    *(u32x4*)(rowp + bj * HALF) = w; } }
        ++ui;
    }
};
template <bool XBF, bool OBF>
struct EpiResidT {
    static constexpr bool PERM = true, AFTER_DRAIN = false, AROWPERM = false;
    const void* xa; const void* xb; void* out; const float* gate;
    bf16_t* xg; const float* ga; unsigned long long* ssq;
    __device__ __forceinline__ void operator()(const f32x4 (&acc)[2][2][4][2], const Unit& u, int wr, int wc, int fr, int fq) const {
        const int row0 = u.pm * BM + wr * 64 + fr; const int col0 = u.pn * BM + wc * 32 + 8 * fq;
        const int b = row_batch(u.pm * BM); const void* xin = (u.pm * BM < NPR) ? xa : xb;
        f32x4 gv[2][2], gn[2][2];
#pragma unroll
        for (int bj = 0; bj < 2; ++bj)
#pragma unroll
            for (int n = 0; n < 2; ++n) { gv[bj][n] = *(const f32x4*)(gate + (size_t)b * MODW + col0 + bj * HALF + 4 * n);
                if (xg) gn[bj][n] = *(const f32x4*)(ga + (size_t)b * DM + col0 + bj * HALF + 4 * n); }
#pragma unroll
        for (int aim = 0; aim < 4; ++aim) { const int ai = aim >> 1, mh = (aim & 1) * 2;
            f32x4 xv[2][2][2];
#pragma unroll
            for (int mm = 0; mm < 2; ++mm) { const size_t off = (size_t)(row0 + ai * HALF + (mh + mm) * 16) * DM + col0;
#pragma unroll
                for (int bj = 0; bj < 2; ++bj) {
                    if constexpr (XBF) { const u32x4 w = *(const u32x4*)((const unsigned short*)xin + off + bj * HALF);
                        xv[mm][bj][0] = (f32x4){__uint_as_float(w.x << 16), __uint_as_float(w.x & 0xffff0000u), __uint_as_float(w.y << 16), __uint_as_float(w.y & 0xffff0000u)};
                        xv[mm][bj][1] = (f32x4){__uint_as_float(w.z << 16), __uint_as_float(w.z & 0xffff0000u), __uint_as_float(w.w << 16), __uint_as_float(w.w & 0xffff0000u)}; }
                    else {
#pragma unroll
                        for (int n = 0; n < 2; ++n) xv[mm][bj][n] = *(const f32x4*)((const float*)xin + off + bj * HALF + 4 * n); } } }
#pragma unroll
            for (int mm = 0; mm < 2; ++mm) { const int m = mh + mm; const size_t off = (size_t)(row0 + ai * HALF + m * 16) * DM + col0; float sq = 0.f;
#pragma unroll
                for (int bj = 0; bj < 2; ++bj) { f32x4 xn[2];
#pragma unroll
                    for (int n = 0; n < 2; ++n) {
                        xn[n] = xv[mm][bj][n] + gv[bj][n] * acc[ai][bj][m][n];
                        if constexpr (!OBF) *(f32x4*)((float*)out + off + bj * HALF + 4 * n) = xn[n]; }
                    if constexpr (OBF) { u32x4 w; w.x = cvt_pk_bf16(xn[0][0], xn[0][1]); w.y = cvt_pk_bf16(xn[0][2], xn[0][3]); w.z = cvt_pk_bf16(xn[1][0], xn[1][1]); w.w = cvt_pk_bf16(xn[1][2], xn[1][3]);
                        *(u32x4*)((unsigned short*)out + off + bj * HALF) = w; }
                    if (xg) { const f32x4 a = xn[0] * gn[bj][0], c = xn[1] * gn[bj][1];
                        sq += (xn[0][0] * xn[0][0] + xn[0][1] * xn[0][1]) + (xn[0][2] * xn[0][2] + xn[0][3] * xn[0][3]) + (xn[1][0] * xn[1][0] + xn[1][1] * xn[1][1]) + (xn[1][2] * xn[1][2] + xn[1][3] * xn[1][3]);
                        u32x4 w; w.x = cvt_pk_bf16(a[0], a[1]); w.y = cvt_pk_bf16(a[2], a[3]); w.z = cvt_pk_bf16(c[0], c[1]); w.w = cvt_pk_bf16(c[2], c[3]);
                        *(u32x4*)(xg + off + bj * HALF) = w; } }
                if (xg) { sq += __shfl_xor(sq, 16); sq += __shfl_xor(sq, 32);
                    if (fq == 0) __hip_atomic_fetch_add(ssq + row0 + ai * HALF + m * 16, (unsigned long long)(sq * 16777216.0f + 0.5f), __ATOMIC_RELAXED, __HIP_MEMORY_SCOPE_AGENT); } }
        }
    }
};
}
namespace pg8 {
__device__ __forceinline__ float dpp_prev(float x) { return __int_as_float(__builtin_amdgcn_update_dpp(0, __float_as_int(x), 0x121, 0xF, 0xF, true)); }
__device__ __forceinline__ float dpp_next(float x) { return __int_as_float(__builtin_amdgcn_update_dpp(0, __float_as_int(x), 0x12F, 0xF, 0xF, true)); }
__device__ __forceinline__ float dpp_shr1_old(float oldv, float x) { return __int_as_float(__builtin_amdgcn_update_dpp(__float_as_int(oldv), __float_as_int(x), 0x111, 0xF, 0xF, false)); }
__device__ __forceinline__ float dpp_shl1_old(float oldv, float x) { return __int_as_float(__builtin_amdgcn_update_dpp(__float_as_int(oldv), __float_as_int(x), 0x101, 0xF, 0xF, false)); }
__device__ __forceinline__ f32x4 dpp_shr1_old4(f32x4 o, f32x4 v) { return (f32x4){dpp_shr1_old(o[0], v[0]), dpp_shr1_old(o[1], v[1]), dpp_shr1_old(o[2], v[2]), dpp_shr1_old(o[3], v[3])}; }
__device__ __forceinline__ f32x4 dpp_shl1_old4(f32x4 o, f32x4 v) { return (f32x4){dpp_shl1_old(o[0], v[0]), dpp_shl1_old(o[1], v[1]), dpp_shl1_old(o[2], v[2]), dpp_shl1_old(o[3], v[3])}; }
__device__ __forceinline__ f32x4 dpp_prev4(f32x4 v) { return (f32x4){dpp_prev(v[0]), dpp_prev(v[1]), dpp_prev(v[2]), dpp_prev(v[3])}; }
__device__ __forceinline__ f32x4 dpp_next4(f32x4 v) { return (f32x4){dpp_next(v[0]), dpp_next(v[1]), dpp_next(v[2]), dpp_next(v[3])}; }
struct EpiGate {
    static constexpr bool PERM = true, AFTER_DRAIN = false, AROWPERM = true;
    bf16_t* A; float* ZH; const float* cw; const float* cb; PG8_LAS float* halo;
    const PG8_LAS float* rstab; const float* bvec; mutable int ui;
    __device__ __forceinline__ void operator()(f32x4 (&acc)[2][2][4][2], const Unit& u, int wr, int wc, int fr, int fq) const {
        const int cl = wc * 32 + 8 * fq;
        f32x4 w[2][3], bs[2], bv[2];
#define EG_LOADC(n_) do { const float* bp_ = bvec + (size_t)row_batch(u.pm * BM) * DFF2 + u.pn * BM + cl + 4 * (n_); const int j0_ = u.pn * HALF + cl + 4 * (n_); \
        _Pragma("unroll") for (int bj = 0; bj < 2; ++bj) { bv[bj] = *(const f32x4*)(bp_ + bj * HALF); bs[bj] = *(const f32x4*)(cb + bj * DFF + j0_); } } while (0)
#define EG_LOADW(n_) do { const int j0_ = u.pn * HALF + cl + 4 * (n_); \
        _Pragma("unroll") for (int bj = 0; bj < 2; ++bj) _Pragma("unroll") for (int k = 0; k < 3; ++k) w[bj][k] = *(const f32x4*)(cw + (size_t)k * DFF2 + bj * DFF + j0_); } while (0)
#pragma unroll
        for (int ai = 0; ai < 2; ++ai)
#pragma unroll
            for (int m = 0; m < 4; ++m) { const float rs = rstab[ui * BM + ai * HALF + wr * 64 + 4 * fr + m];
#pragma unroll
                for (int bj = 0; bj < 2; ++bj)
#pragma unroll
                    for (int n = 0; n < 2; ++n) acc[ai][bj][m][n] = acc[ai][bj][m][n] * rs; }
#pragma unroll
        for (int ai = 0; ai < 2; ++ai)
#pragma unroll
            for (int bj = 0; bj < 2; ++bj)
#pragma unroll
                for (int n = 0; n < 2; ++n) { const int blk = ai * 2 + wr, c = bj * HALF + cl + 4 * n;
                    const f32x4 hv = (fr == 0) ? acc[ai][bj][0][n] : acc[ai][bj][3][n];
                    *(PG8_LAS f32x4*)(halo + ((fr == 0) ? (blk * 2) * 256 : (fr == 15) ? (blk * 2 + 1) * 256 : 2048) + c) = hv; }
        asm volatile("s_waitcnt lgkmcnt(0)" ::: "memory"); __builtin_amdgcn_s_barrier(); asm volatile("" ::: "memory");
        const int trow0 = u.pm * BM, pos0 = row_pos(trow0), Lb = batch_len(row_batch(trow0));
        const bool top_ok = (pos0 == 0), bot_ok = (pos0 + BM == Lb);
        const unsigned aoff = ((((unsigned)u.pm * (DFF / 64) + 2 * u.pn + (wc >> 1)) << 14) + 32 * (wc & 1) + 8 * fq) * 2u;
#pragma unroll
        for (int n = 0; n < 2; ++n) {
            EG_LOADW(n); EG_LOADC(n);
            f32x4 cfull[2];
#pragma unroll
            for (int bj = 0; bj < 2; ++bj) cfull[bj] = bs[bj] + bv[bj] * (w[bj][0] + w[bj][1] + w[bj][2]);
            { const unsigned zo = (((unsigned)u.pm * 4) * DFF2 + u.pn * BM + cl + 4 * n) * 4u;
              if (wr == 0 && fr == 0) {
#pragma unroll
                  for (int bj = 0; bj < 2; ++bj) { *(f32x4*)((char*)ZH + (zo + (unsigned)(bj * HALF) * 4u)) = acc[0][bj][0][n] + bv[bj];
                      *(f32x4*)((char*)ZH + (zo + (unsigned)(DFF2 + bj * HALF) * 4u)) = acc[0][bj][1][n] + bv[bj]; } }
              if (wr == 1 && fr == 15) {
#pragma unroll
                  for (int bj = 0; bj < 2; ++bj) { *(f32x4*)((char*)ZH + (zo + (unsigned)(2 * DFF2 + bj * HALF) * 4u)) = acc[1][bj][2][n] + bv[bj];
                      *(f32x4*)((char*)ZH + (zo + (unsigned)(3 * DFF2 + bj * HALF) * 4u)) = acc[1][bj][3][n] + bv[bj]; } } }
#pragma unroll
            for (int ai = 0; ai < 2; ++ai) {
                const int blk = ai * 2 + wr;
                f32x4 hp[2], hn[2];
#pragma unroll
                for (int bj = 0; bj < 2; ++bj) {
                    hp[bj] = (blk > 0) ? *(const PG8_LAS f32x4*)(halo + ((blk - 1) * 2 + 1) * 256 + bj * HALF + cl + 4 * n) : (f32x4){0.f, 0.f, 0.f, 0.f};
                    hn[bj] = (blk < 3) ? *(const PG8_LAS f32x4*)(halo + ((blk + 1) * 2 + 0) * 256 + bj * HALF + cl + 4 * n) : (f32x4){0.f, 0.f, 0.f, 0.f}; }
#pragma unroll
                for (int m = 0; m < 4; ++m) {
                    const int rt = ai * HALF + wr * 64 + 4 * fr + m;
                    f32x4 cv[2];
#pragma unroll
                    for (int bj = 0; bj < 2; ++bj) {
                        const f32x4 cur = acc[ai][bj][m][n];
                        const f32x4 prev = (m > 0) ? acc[ai][bj][m > 0 ? m - 1 : 0][n] : dpp_shr1_old4(hp[bj], acc[ai][bj][3][n]);
                        const f32x4 next = (m < 3) ? acc[ai][bj][m < 3 ? m + 1 : 3][n] : dpp_shl1_old4(hn[bj], acc[ai][bj][0][n]);
                        cv[bj] = w[bj][0] * prev + w[bj][1] * cur + w[bj][2] * next + cfull[bj];
                        if (ai == 0 && m == 0) { if (wr == 0 && fr == 0 && top_ok) cv[bj] = cv[bj] - bv[bj] * w[bj][0]; }
                        if (ai == 1 && m == 3) { if (wr == 1 && fr == 15 && bot_ok) cv[bj] = cv[bj] - bv[bj] * w[bj][2]; } }
                    float o[4];
#pragma unroll
                    for (int e = 0; e < 4; ++e) { const float g = cv[0][e]; o[e] = g * __builtin_amdgcn_rcpf(1.0f + __expf(-g)) * cv[1][e]; }
                    const unsigned p0 = cvt_pk_bf16(o[0], o[1]), p1 = cvt_pk_bf16(o[2], o[3]);
                    {
                      typedef unsigned u32x2e __attribute__((ext_vector_type(2)));
                      *(u32x2e*)((char*)A + (aoff + (unsigned)(rt * 128 + 8 * n))) = (u32x2e){p0, p1}; }
                }
            }
        }
        asm volatile("s_waitcnt lgkmcnt(0)" ::: "memory"); __builtin_amdgcn_s_barrier(); asm volatile("" ::: "memory");
        ++ui;
#undef EG_LOADC
#undef EG_LOADW
    }
};
template <class Sched> __device__ __forceinline__ void fill_tabs(const Sched& S, const unsigned long long* ss, const float* bvec, int ldb, PG8_LAS float* rstab, PG8_LAS float* bvtab, int tid) {
    Unit u;
    for (int i = 0; S.next(i, u); ++i) {
        if (tid < 256) rstab[i * BM + tid] = rsqrtf((float)ss[u.pm * BM + tid] * (1.0f / 16777216.0f) * (1.0f / DM) + EPS);
        else if (bvec) bvtab[i * BM + tid - 256] = bvec[(size_t)row_batch(u.pm * BM) * ldb + u.pn * BM + tid - 256]; }
    __syncthreads();
}
}
namespace att {
using bf16x8 = __attribute__((ext_vector_type(8))) short;
using s16x4  = __attribute__((ext_vector_type(4))) short;
using f32x16 = __attribute__((ext_vector_type(16))) float;
using u32x4  = __attribute__((ext_vector_type(4))) unsigned;
constexpr int NW = 8, QBLK = 32, KVBLK = 64, DV = 128;
constexpr float THR = 8.f;
#define ATT_SBAR() __builtin_amdgcn_sched_barrier(0)
__device__ __forceinline__ int crow(int r, int hi) { return (r & 3) + 8 * (r >> 2) + 4 * hi; }
__device__ __forceinline__ unsigned cvtpk(float lo, float hi) { unsigned r; asm volatile("v_cvt_pk_bf16_f32 %0, %1, %2" : "=v"(r) : "v"(lo), "v"(hi)); return r; }
template <int DK> __device__ __forceinline__ int kswz(int row, int colB) { return row * (2 * DK + 16) + colB; }

template <int DK> __device__ __forceinline__ void partialSM(f32x16& p0, f32x16& p1, float& m_reg, float& mn, float& alpha) {
  constexpr float SCALE = (DK == 128) ? 0.08838834764831845f : 0.07216878364870323f;
  constexpr float C = SCALE * 1.4426950408889634f;
  float pmax = p0[0];
#pragma unroll
  for (int r = 1; r < 16; ++r) pmax = fmaxf(pmax, p0[r]);
#pragma unroll
  for (int r = 0; r < 16; ++r) pmax = fmaxf(pmax, p1[r]);
  { auto rr = __builtin_amdgcn_permlane32_swap(__float_as_uint(pmax), __float_as_uint(pmax), false, false);
    pmax = fmaxf(__uint_as_float(rr[0]), __uint_as_float(rr[1])); }
  if (__builtin_expect(__all(pmax - m_reg <= THR / SCALE), 1)) { mn = m_reg; alpha = 1.f; }
  else { mn = fmaxf(m_reg, pmax); alpha = __builtin_amdgcn_exp2f((m_reg - mn) * C); m_reg = mn; }
  float mnC = -mn * C;
#pragma unroll
  for (int r = 0; r < 16; ++r) p0[r] = fmaf(p0[r], C, mnC);
#pragma unroll
  for (int r = 0; r < 16; ++r) p1[r] = fmaf(p1[r], C, mnC);
#pragma unroll
  for (int r = 0; r < 16; ++r) p0[r] = __builtin_amdgcn_exp2f(p0[r]);
}
__device__ __forceinline__ void finishSM(f32x16& p0, f32x16& p1, float alpha, float& l_reg, bf16x8& pa0, bf16x8& pa1, bf16x8& pa2, bf16x8& pa3) {
#pragma unroll
  for (int r = 0; r < 16; ++r) p1[r] = __builtin_amdgcn_exp2f(p1[r]);
  float ps = 0;
#pragma unroll
  for (int r = 0; r < 16; ++r) ps += p0[r];
#pragma unroll
  for (int r = 0; r < 16; ++r) ps += p1[r];
  { auto rr = __builtin_amdgcn_permlane32_swap(__float_as_uint(ps), __float_as_uint(ps), false, false);
    ps = __uint_as_float(rr[0]) + __uint_as_float(rr[1]); }
  l_reg = l_reg * alpha + ps;
#define ATT_PK4(P, BASE, OUT) do { unsigned a0 = cvtpk(P[BASE + 0], P[BASE + 1]), a1 = cvtpk(P[BASE + 2], P[BASE + 3]);   \
    unsigned b0 = cvtpk(P[BASE + 4], P[BASE + 5]), b1 = cvtpk(P[BASE + 6], P[BASE + 7]);                              \
    auto r0 = __builtin_amdgcn_permlane32_swap(a0, b0, false, false); auto r1 = __builtin_amdgcn_permlane32_swap(a1, b1, false, false); \
    u32x4 w = {r0[0], r1[0], r0[1], r1[1]}; OUT = *reinterpret_cast<bf16x8*>(&w); } while (0)
  ATT_PK4(p0, 0, pa0); ATT_PK4(p0, 8, pa1); ATT_PK4(p1, 0, pa2); ATT_PK4(p1, 8, pa3);
#undef ATT_PK4
}
template <int DK> __device__ __forceinline__ void qkt(f32x16& p0, f32x16& p1, const char* Ks, const bf16x8* qr, const char* ldsb, int qxo, int r32, int hi) {
  p0 = f32x16{}; p1 = f32x16{};
  if constexpr (DK > 128) asm volatile("" : "+v"(qxo));
  const char* qx = ldsb + qxo;
#pragma unroll
  for (int d0 = 0; d0 < DK / 16; ++d0) { int cb = (d0 * 16 + hi * 8) * 2;
    bf16x8 b0 = *reinterpret_cast<const bf16x8*>(Ks + kswz<DK>(r32, cb));
    bf16x8 b1 = *reinterpret_cast<const bf16x8*>(Ks + kswz<DK>(32 + r32, cb));
    bf16x8 qf; if (d0 < 8) qf = qr[d0]; else qf = *reinterpret_cast<const bf16x8*>(qx + (d0 - 8) * 1024);
    p0 = __builtin_amdgcn_mfma_f32_32x32x16_bf16(b0, qf, p0, 0, 0, 0);
    p1 = __builtin_amdgcn_mfma_f32_32x32x16_bf16(b1, qf, p1, 0, 0, 0);
    if ((d0 & 3) == 3) ATT_SBAR(); }
}
__device__ __forceinline__ int v_st(int k, int c) { const int kk = (k & ~0xC) | ((k & 4) << 1) | ((k & 8) >> 1); return ((kk >> 3) * 4 + (c >> 5)) * 512 + ((kk & 7) * 32 + (c & 31)) * 2; }
__device__ __forceinline__ int v_rd_base(int lane) { return ((lane & 3) << 3) | (((lane >> 2) & 3) << 6) | (((lane >> 4) & 1) << 5) | (((lane >> 5) & 1) << 8); }
constexpr int v_rd_off(int d0, int ks, int half) { return d0 * 512 + ks * 4096 + half * 2048; }
template <int OFF> __device__ __forceinline__ s16x4 tr_read(int vb) {
  s16x4 r; asm volatile("ds_read_b64_tr_b16 %0, %1 offset:%2" : "=&v"(r) : "v"(vb), "i"(OFF) : "memory"); return r;
}
template <int D0> __device__ __forceinline__ void pv_one(f32x16& od, int vb, bf16x8 pa0, bf16x8 pa1, bf16x8 pa2, bf16x8 pa3) {
  const s16x4 l0 = tr_read<v_rd_off(D0, 0, 0)>(vb), h0 = tr_read<v_rd_off(D0, 0, 1)>(vb), l1 = tr_read<v_rd_off(D0, 1, 0)>(vb), h1 = tr_read<v_rd_off(D0, 1, 1)>(vb);
  const s16x4 l2 = tr_read<v_rd_off(D0, 2, 0)>(vb), h2 = tr_read<v_rd_off(D0, 2, 1)>(vb), l3 = tr_read<v_rd_off(D0, 3, 0)>(vb), h3 = tr_read<v_rd_off(D0, 3, 1)>(vb);
  asm volatile("s_waitcnt lgkmcnt(0)" ::: "memory"); ATT_SBAR();
#define ATT_PK(L, H) (bf16x8){L[0], L[1], L[2], L[3], H[0], H[1], H[2], H[3]}
  od = __builtin_amdgcn_mfma_f32_32x32x16_bf16(pa0, ATT_PK(l0, h0), od, 0, 0, 0);
  od = __builtin_amdgcn_mfma_f32_32x32x16_bf16(pa1, ATT_PK(l1, h1), od, 0, 0, 0);
  od = __builtin_amdgcn_mfma_f32_32x32x16_bf16(pa2, ATT_PK(l2, h2), od, 0, 0, 0);
  od = __builtin_amdgcn_mfma_f32_32x32x16_bf16(pa3, ATT_PK(l3, h3), od, 0, 0, 0);
#undef ATT_PK
}
__device__ __forceinline__ void pv_d0(f32x16* o, int vb, bf16x8 pa0, bf16x8 pa1, bf16x8 pa2, bf16x8 pa3) {
  pv_one<0>(o[0], vb, pa0, pa1, pa2, pa3); pv_one<1>(o[1], vb, pa0, pa1, pa2, pa3); pv_one<2>(o[2], vb, pa0, pa1, pa2, pa3); pv_one<3>(o[3], vb, pa0, pa1, pa2, pa3);
}
template <int DK> struct Cfg { static constexpr int SHM_V = KVBLK * DV * 2, SHM_K = KVBLK * (DK * 2 + 16), SHM_Q = (DK > 128) ? NW * 4096 : 0, SHM = 2 * SHM_V + 2 * SHM_K + NW * 64 * 4 + SHM_Q; };

template <int DK, int SDEPTH, int ldq, int ldk, int ldv, int ldo>
__device__ __forceinline__ void attn_body(const unsigned short* __restrict__ Qb, const unsigned short* __restrict__ Kh,
                                          const unsigned short* __restrict__ Vh, unsigned short* __restrict__ Ob, int seq, char* lds) {
  constexpr int SHM_V = Cfg<DK>::SHM_V, SHM_K = Cfg<DK>::SHM_K, NQ = (DK > 128 ? 8 : DK / 16), NKI = DK / 64;
  const int tid = tid_fresh(), wid = tid >> 6, lane = tid & 63, r32 = lane & 31, hi = lane >> 5;
  char* V_lds = lds; char* K_lds = lds + 2 * SHM_V;
  float* ws = (float*)(lds + 2 * SHM_V + 2 * SHM_K) + wid * 64; float* li_l = ws; float* al_l = ws + 32;
  float m_reg = -1e30f, l_reg = 0; f32x16 o[4] = {}; bf16x8 qr[NQ];
  const unsigned short* Qw = Qb + (wid * QBLK + r32) * ldq + hi * 8;
#pragma unroll
  for (int d0 = 0; d0 < NQ; ++d0) qr[d0] = *reinterpret_cast<const bf16x8*>(Qw + d0 * 16);
  const int qxo = 2 * SHM_V + 2 * SHM_K + NW * 64 * 4 + wid * 4096 + lane * 16; char* qx = lds + qxo;
  if constexpr (DK > 128) {
#pragma unroll
    for (int d0 = 8; d0 < DK / 16; ++d0) *reinterpret_cast<bf16x8*>(qx + (d0 - 8) * 1024) = *reinterpret_cast<const bf16x8*>(Qw + d0 * 16);
  }
  const int sr = tid >> 4, sc = (tid & 15) * 8, vst0 = v_st(sr, sc);
  const int vgo = sr * ldv + sc;
  const int kr = tid >> 3, kc8 = tid & 7, kgo = kr * ldk + kc8 * 8, kdst = kswz<DK>(kr, kc8 * 16);
  const int vb0 = (int)(uintptr_t)V_lds + v_rd_base(lane);
  struct { bf16x8 vs0, vs1, ks[NKI]; } sr_[SDEPTH];
#define ATT_SLOAD(i, k0) do { const unsigned short* vt_ = Vh + (size_t)(k0) * ldv; const unsigned short* kt_ = Kh + (size_t)(k0) * ldk; \
    sr_[i].vs0 = *reinterpret_cast<const bf16x8*>(vt_ + vgo); sr_[i].vs1 = *reinterpret_cast<const bf16x8*>(vt_ + vgo + 32 * ldv); \
    _Pragma("unroll") for (int q_ = 0; q_ < NKI; ++q_) sr_[i].ks[q_] = *reinterpret_cast<const bf16x8*>(kt_ + kgo + 64 * q_); } while (0)
#define ATT_SWRITE(b, i) do { *(bf16x8*)(V_lds + (b) * SHM_V + vst0) = sr_[i].vs0; *(bf16x8*)(V_lds + (b) * SHM_V + vst0 + 8192) = sr_[i].vs1; \
    _Pragma("unroll") for (int q_ = 0; q_ < NKI; ++q_) *(bf16x8*)(K_lds + (b) * SHM_K + kdst + 128 * q_) = sr_[i].ks[q_]; } while (0)
#define ATT_SWAIT() do { if constexpr (SDEPTH == 2) { if constexpr (NKI == 2) asm volatile("s_waitcnt vmcnt(4)" ::: "memory"); else asm volatile("s_waitcnt vmcnt(5)" ::: "memory"); } else asm volatile("s_waitcnt vmcnt(0)" ::: "memory"); } while (0)
#define ATT_RESC(a) do { if (__any((a) < 1.f)) { if (hi == 0) al_l[r32] = (a); asm volatile("s_waitcnt lgkmcnt(0)" ::: "memory"); \
    _Pragma("unroll") for (int d = 0; d < 4; ++d) _Pragma("unroll") for (int r = 0; r < 16; ++r) o[d][r] *= al_l[crow(r, hi)]; } } while (0)
  f32x16 pA0, pA1, pB0, pB1; float mnA, mnB, alA, alB; bf16x8 pa0, pa1, pa2, pa3; const int NT = seq / KVBLK;
  constexpr int SE = 0, SO = SDEPTH - 1;
  ATT_SLOAD(SE, 0); asm volatile("s_waitcnt vmcnt(0)" ::: "memory"); ATT_SWRITE(0, SE); __syncthreads();
  qkt<DK>(pA0, pA1, K_lds, qr, lds, qxo, r32, hi); partialSM<DK>(pA0, pA1, m_reg, mnA, alA);
  ATT_SLOAD(SO, KVBLK); if constexpr (SDEPTH == 2) { if (2 < NT) ATT_SLOAD(SE, 2 * KVBLK); }
  ATT_SWAIT(); ATT_SWRITE(1, SO); __syncthreads();
  for (int j = 1; j + 1 < NT; j += 2) {
    ATT_SBAR(); qkt<DK>(pB0, pB1, K_lds + SHM_K, qr, lds, qxo, r32, hi);
    finishSM(pA0, pA1, alA, l_reg, pa0, pa1, pa2, pa3); ATT_SBAR();
    ATT_SLOAD(SO, (j + SDEPTH) * KVBLK); ATT_SBAR();
    pv_d0(o, vb0, pa0, pa1, pa2, pa3); partialSM<DK>(pB0, pB1, m_reg, mnB, alB);
    __syncthreads(); ATT_SWAIT(); ATT_SWRITE(0, SE);
    ATT_RESC(alB); __syncthreads();
    ATT_SBAR(); qkt<DK>(pA0, pA1, K_lds, qr, lds, qxo, r32, hi);
    finishSM(pB0, pB1, alB, l_reg, pa0, pa1, pa2, pa3); ATT_SBAR();
    if (SDEPTH == 1 || j + 3 < NT) ATT_SLOAD(SE, (j + 1 + SDEPTH) * KVBLK); ATT_SBAR();
    pv_d0(o, vb0 + SHM_V, pa0, pa1, pa2, pa3); partialSM<DK>(pA0, pA1, m_reg, mnA, alA);
    __syncthreads(); ATT_SWAIT(); ATT_SWRITE(1, SO);
    ATT_RESC(alA); __syncthreads();
  }
  ATT_SBAR(); qkt<DK>(pB0, pB1, K_lds + SHM_K, qr, lds, qxo, r32, hi);
  finishSM(pA0, pA1, alA, l_reg, pa0, pa1, pa2, pa3); ATT_SBAR();
  pv_d0(o, vb0, pa0, pa1, pa2, pa3); partialSM<DK>(pB0, pB1, m_reg, mnB, alB);
  __syncthreads(); ATT_RESC(alB);
  finishSM(pB0, pB1, alB, l_reg, pa0, pa1, pa2, pa3); ATT_SBAR();
  pv_d0(o, vb0 + SHM_V, pa0, pa1, pa2, pa3);
  if (hi == 0) li_l[r32] = l_reg; asm volatile("s_waitcnt lgkmcnt(0)" ::: "memory");
  float rli[16];
#pragma unroll
  for (int r = 0; r < 16; ++r) rli[r] = __builtin_amdgcn_rcpf(li_l[crow(r, hi)]);
  unsigned short* Ow = Ob + (wid * QBLK) * ldo;
#pragma unroll
  for (int r = 0; r < 16; ++r) { int orow = crow(r, hi);
#pragma unroll
    for (int d0 = 0; d0 < 4; ++d0) Ow[orow * ldo + d0 * 32 + r32] = (unsigned short)f2bf(o[d0][r] * rli[r]); }
  __syncthreads();
#undef ATT_SLOAD
#undef ATT_SWRITE
#undef ATT_SWAIT
#undef ATT_RESC
}

template <int DK, int ldq, int ldk, int ldv, int ldo>
__device__ __forceinline__ void attn_body_seq(const unsigned short* __restrict__ Qb, const unsigned short* __restrict__ Kh,
                                              const unsigned short* __restrict__ Vh, unsigned short* __restrict__ Ob, int seq, char* lds) {
  constexpr int SHM_V = Cfg<DK>::SHM_V, SHM_K = Cfg<DK>::SHM_K, NQ = (DK > 128 ? 8 : DK / 16), NKI = DK / 64;
  const int tid = tid_fresh(), wid = tid >> 6, lane = tid & 63, r32 = lane & 31, hi = lane >> 5;
  char* V_lds = lds; char* K_lds = lds + 2 * SHM_V;
  float* ws = (float*)(lds + 2 * SHM_V + 2 * SHM_K) + wid * 64; float* li_l = ws; float* al_l = ws + 32;
  float m_reg = -1e30f, l_reg = 0; f32x16 o[4] = {}; bf16x8 qr[NQ];
  const unsigned short* Qw = Qb + (wid * QBLK + r32) * ldq + hi * 8;
#pragma unroll
  for (int d0 = 0; d0 < NQ; ++d0) qr[d0] = *reinterpret_cast<const bf16x8*>(Qw + d0 * 16);
  const int qxo = 2 * SHM_V + 2 * SHM_K + NW * 64 * 4 + wid * 4096 + lane * 16; char* qx = lds + qxo;
  if constexpr (DK > 128) {
#pragma unroll
    for (int d0 = 8; d0 < DK / 16; ++d0) *reinterpret_cast<bf16x8*>(qx + (d0 - 8) * 1024) = *reinterpret_cast<const bf16x8*>(Qw + d0 * 16);
  }
  const int sr = tid >> 4, sc = (tid & 15) * 8, vst0 = v_st(sr, sc);
  const int vgo = sr * ldv + sc;
  const int kr = tid >> 3, kc8 = tid & 7, kgo = kr * ldk + kc8 * 8, kdst = kswz<DK>(kr, kc8 * 16);
  const int vb0 = (int)(uintptr_t)V_lds + v_rd_base(lane);
  bf16x8 vs0, vs1, ks[NKI];
#define ATT_SLOAD1(k0) do { const unsigned short* vt_ = Vh + (size_t)(k0) * ldv; const unsigned short* kt_ = Kh + (size_t)(k0) * ldk; \
    vs0 = *reinterpret_cast<const bf16x8*>(vt_ + vgo); vs1 = *reinterpret_cast<const bf16x8*>(vt_ + vgo + 32 * ldv); \
    _Pragma("unroll") for (int q_ = 0; q_ < NKI; ++q_) ks[q_] = *reinterpret_cast<const bf16x8*>(kt_ + kgo + 64 * q_); } while (0)
#define ATT_SWRITE1(b) do { *(bf16x8*)(V_lds + (b) * SHM_V + vst0) = vs0; *(bf16x8*)(V_lds + (b) * SHM_V + vst0 + 8192) = vs1; \
    _Pragma("unroll") for (int q_ = 0; q_ < NKI; ++q_) *(bf16x8*)(K_lds + (b) * SHM_K + kdst + 128 * q_) = ks[q_]; } while (0)
  const int NT = seq / KVBLK;
  ATT_SLOAD1(0); ATT_SWRITE1(0); __syncthreads();
#pragma unroll 1
  for (int j = 0; j < NT; ++j) {
    const int b = j & 1;
    f32x16 p0, p1; float mn, al; bf16x8 pa0, pa1, pa2, pa3;
    if (j + 1 < NT) ATT_SLOAD1((j + 1) * KVBLK);
    ATT_SBAR();
    qkt<DK>(p0, p1, K_lds + b * SHM_K, qr, lds, qxo, r32, hi);
    partialSM<DK>(p0, p1, m_reg, mn, al);
    if (__any(al < 1.f)) { if (hi == 0) al_l[r32] = al; asm volatile("s_waitcnt lgkmcnt(0)" ::: "memory");
#pragma unroll
      for (int d = 0; d < 4; ++d)
#pragma unroll
        for (int r = 0; r < 16; ++r) o[d][r] *= al_l[crow(r, hi)]; }
    finishSM(p0, p1, al, l_reg, pa0, pa1, pa2, pa3); ATT_SBAR();
    pv_d0(o, vb0 + b * SHM_V, pa0, pa1, pa2, pa3);
    if (j + 1 < NT) ATT_SWRITE1(b ^ 1);
    __syncthreads();
  }
  if (hi == 0) li_l[r32] = l_reg; asm volatile("s_waitcnt lgkmcnt(0)" ::: "memory");
  float rli[16];
#pragma unroll
  for (int r = 0; r < 16; ++r) rli[r] = __builtin_amdgcn_rcpf(li_l[crow(r, hi)]);
  unsigned short* Ow = Ob + (wid * QBLK) * ldo;
#pragma unroll
  for (int r = 0; r < 16; ++r) { int orow = crow(r, hi);
#pragma unroll
    for (int d0 = 0; d0 < 4; ++d0) Ow[orow * ldo + d0 * 32 + r32] = (unsigned short)f2bf(o[d0][r] * rli[r]); }
  __syncthreads();
#undef ATT_SLOAD1
#undef ATT_SWRITE1
}

template <int DK> __device__ __forceinline__ void qk_half(f32x16& p, const char* Ks, int rowoff, const bf16x8* qr, const char* ldsb, int qxo, int r32, int hi) {
  p = f32x16{};
  const char* qx = ldsb + qxo;
#pragma unroll
  for (int d0 = 0; d0 < DK / 16; ++d0) { int cb = (d0 * 16 + hi * 8) * 2;
    bf16x8 b0 = *reinterpret_cast<const bf16x8*>(Ks + kswz<DK>(rowoff + r32, cb));
    bf16x8 qf; if (d0 < 8) qf = qr[d0]; else qf = *reinterpret_cast<const bf16x8*>(qx + (d0 - 8) * 1024);
    p = __builtin_amdgcn_mfma_f32_32x32x16_bf16(b0, qf, p, 0, 0, 0); }
}
template <int KH> __device__ __forceinline__ void pv_half(f32x16* o, int vb, bf16x8 pa, bf16x8 pb) {
#define ATT_PK(L, H) (bf16x8){L[0], L[1], L[2], L[3], H[0], H[1], H[2], H[3]}
#define ATT_PVD(D0) do { const s16x4 l0 = tr_read<v_rd_off(D0, 2 * KH, 0)>(vb), h0 = tr_read<v_rd_off(D0, 2 * KH, 1)>(vb), l1 = tr_read<v_rd_off(D0, 2 * KH + 1, 0)>(vb), h1 = tr_read<v_rd_off(D0, 2 * KH + 1, 1)>(vb); \
    asm volatile("s_waitcnt lgkmcnt(0)" ::: "memory"); ATT_SBAR();   \
    o[D0] = __builtin_amdgcn_mfma_f32_32x32x16_bf16(pa, ATT_PK(l0, h0), o[D0], 0, 0, 0); o[D0] = __builtin_amdgcn_mfma_f32_32x32x16_bf16(pb, ATT_PK(l1, h1), o[D0], 0, 0, 0); } while (0)
  ATT_PVD(0); ATT_PVD(1); ATT_PVD(2); ATT_PVD(3);
#undef ATT_PVD
#undef ATT_PK
}
__device__ __forceinline__ float exp_pack(f32x16& p, bf16x8& pa, bf16x8& pb) {
#pragma unroll
  for (int r = 0; r < 16; ++r) p[r] = __builtin_amdgcn_exp2f(p[r]);
  float ps = 0.f;
#pragma unroll
  for (int r = 0; r < 16; ++r) ps += p[r];
#define ATT_PK4(P, BASE, OUT) do { unsigned a0 = cvtpk(P[BASE + 0], P[BASE + 1]), a1 = cvtpk(P[BASE + 2], P[BASE + 3]);   \
    unsigned b0 = cvtpk(P[BASE + 4], P[BASE + 5]), b1 = cvtpk(P[BASE + 6], P[BASE + 7]);                              \
    auto r0 = __builtin_amdgcn_permlane32_swap(a0, b0, false, false); auto r1 = __builtin_amdgcn_permlane32_swap(a1, b1, false, false); \
    u32x4 w = {r0[0], r1[0], r0[1], r1[1]}; OUT = *reinterpret_cast<bf16x8*>(&w); } while (0)
  ATT_PK4(p, 0, pa); ATT_PK4(p, 8, pb);
#undef ATT_PK4
  return ps;
}
template <int DK, int ldq, int ldk, int ldv, int ldo>
__device__ __forceinline__ void attn_body_nomax(const unsigned short* __restrict__ Qb, const unsigned short* __restrict__ Kh,
                                                const unsigned short* __restrict__ Vh, unsigned short* __restrict__ Ob, int seq, char* lds) {
  constexpr int SHM_V = Cfg<DK>::SHM_V, SHM_K = Cfg<DK>::SHM_K, NQ = (DK > 128 ? 8 : DK / 16), NKI = DK / 64;
  const int tid = tid_fresh(), wid = tid >> 6, lane = tid & 63, r32 = lane & 31, hi = lane >> 5;
  char* V_lds = lds; char* K_lds = lds + 2 * SHM_V;
  float* ws = (float*)(lds + 2 * SHM_V + 2 * SHM_K) + wid * 64; float* li_l = ws;
  float l_reg = 0; f32x16 o[4] = {}; bf16x8 qr[NQ];
  const unsigned short* Qw = Qb + (wid * QBLK + r32) * ldq + hi * 8;
#pragma unroll
  for (int d0 = 0; d0 < NQ; ++d0) qr[d0] = *reinterpret_cast<const bf16x8*>(Qw + d0 * 16);
  int qxo = 2 * SHM_V + 2 * SHM_K + NW * 64 * 4 + wid * 4096 + lane * 16; char* qx = lds + qxo;
  if constexpr (DK > 128) {
#pragma unroll
    for (int d0 = 8; d0 < DK / 16; ++d0) *reinterpret_cast<bf16x8*>(qx + (d0 - 8) * 1024) = *reinterpret_cast<const bf16x8*>(Qw + d0 * 16);
  }
  const int sr = tid >> 4, sc = (tid & 15) * 8, vst0 = v_st(sr, sc);
  const int vgo = sr * ldv + sc;
  const int kr = tid >> 3, kc8 = tid & 7, kgo = kr * ldk + kc8 * 8, kdst = kswz<DK>(kr, kc8 * 16);
  const int vb0 = (int)(uintptr_t)V_lds + v_rd_base(lane);
  bf16x8 vs0, vs1, ks[NKI];
#define ATT_SLOAD1(k0) do { const unsigned short* vt_ = Vh + (size_t)(k0) * ldv; const unsigned short* kt_ = Kh + (size_t)(k0) * ldk; \
    vs0 = *reinterpret_cast<const bf16x8*>(vt_ + vgo); vs1 = *reinterpret_cast<const bf16x8*>(vt_ + vgo + 32 * ldv); \
    _Pragma("unroll") for (int q_ = 0; q_ < NKI; ++q_) ks[q_] = *reinterpret_cast<const bf16x8*>(kt_ + kgo + 64 * q_); } while (0)
#define ATT_SWRITE1(b) do { *(bf16x8*)(V_lds + (b) * SHM_V + vst0) = vs0; *(bf16x8*)(V_lds + (b) * SHM_V + vst0 + 8192) = vs1; \
    _Pragma("unroll") for (int q_ = 0; q_ < NKI; ++q_) *(bf16x8*)(K_lds + (b) * SHM_K + kdst + 128 * q_) = ks[q_]; } while (0)
  const int NT = seq / KVBLK;
  ATT_SLOAD1(0); ATT_SWRITE1(0); __syncthreads();
#pragma unroll 1
  for (int j = 0; j < NT; ++j) {
    const int b = j & 1;
    f32x16 p0, p1; bf16x8 pa0, pa1, pa2, pa3;
    if (j + 1 < NT) ATT_SLOAD1((j + 1) * KVBLK);
    if constexpr (DK > 128) asm volatile("" : "+v"(qxo));
    ATT_SBAR();
    qk_half<DK>(p0, K_lds + b * SHM_K, 0, qr, lds, qxo, r32, hi);
    ATT_SBAR();
    qk_half<DK>(p1, K_lds + b * SHM_K, 32, qr, lds, qxo, r32, hi);
    float ps = exp_pack(p0, pa0, pa1);
    ATT_SBAR();
    pv_half<0>(o, vb0 + b * SHM_V, pa0, pa1);
    ps += exp_pack(p1, pa2, pa3);
    ATT_SBAR();
    pv_half<1>(o, vb0 + b * SHM_V, pa2, pa3);
    l_reg += ps;
    if (j + 1 < NT) ATT_SWRITE1(b ^ 1);
    __syncthreads();
  }
  { auto rr = __builtin_amdgcn_permlane32_swap(__float_as_uint(l_reg), __float_as_uint(l_reg), false, false); l_reg = __uint_as_float(rr[0]) + __uint_as_float(rr[1]); }
  if (hi == 0) li_l[r32] = l_reg; asm volatile("s_waitcnt lgkmcnt(0)" ::: "memory");
  float rli[16];
#pragma unroll
  for (int r = 0; r < 16; ++r) rli[r] = __builtin_amdgcn_rcpf(li_l[crow(r, hi)]);
  unsigned short* Ow = Ob + (wid * QBLK) * ldo;
#pragma unroll
  for (int r = 0; r < 16; ++r) { int orow = crow(r, hi);
#pragma unroll
    for (int d0 = 0; d0 < 4; ++d0) Ow[orow * ldo + d0 * 32 + r32] = (unsigned short)f2bf(o[d0][r] * rli[r]); }
  __syncthreads();
#undef ATT_SLOAD1
#undef ATT_SWRITE1
}

typedef float f32x4a __attribute__((ext_vector_type(4)));
__device__ __forceinline__ int v16_st(int key, int d) { return (((key >> 4) * 8 + (d >> 4)) * 4 + ((key >> 2) & 3)) * 128 + ((key & 3) * 16 + (d & 15)) * 2; }
template <int OFF> __device__ __forceinline__ s16x4 tr_read16(int vb) { s16x4 r; asm volatile("ds_read_b64_tr_b16 %0, %1 offset:%2" : "=&v"(r) : "v"(vb), "i"(OFF) : "memory"); return r; }
template <int NDS, int ST>
__device__ __forceinline__ void sgb_steps() {
  if constexpr (ST < 4 * NDS) {
    __builtin_amdgcn_sched_group_barrier(0x008, 2, 0);
    if constexpr (ST >= NDS) __builtin_amdgcn_sched_group_barrier(0x400, (((ST % NDS) + 1) * 8) / NDS - ((ST % NDS) * 8) / NDS, 0);
    if constexpr (ST + 4 < 4 * NDS) __builtin_amdgcn_sched_group_barrier(0x100, 1, 0);
    sgb_steps<NDS, ST + 1>();
  }
}
template <int DK, int ldq, int ldk, int ldv, int ldo>
__device__ __forceinline__ void attn_body16(const unsigned short* __restrict__ Qb, const unsigned short* __restrict__ Kh,
                                            const unsigned short* __restrict__ Vh, unsigned short* __restrict__ Ob, int seq, char* lds) {
  constexpr int SHM_V = KVBLK * DV * 2, KP = 2 * DK, SHM_K = KVBLK * KP, NDS = DK / 32, NKI = DK / 64, PPR = DK / 8;
  const int tid = tid_fresh(), wid = tid >> 6, lane = tid & 63, c16 = lane & 15, g = lane >> 4;
  static_assert(3 * (SHM_V + SHM_K) <= RING_BYTES, "three K/V stage buffers");
  char* V_lds = lds; char* K_lds = lds + 3 * SHM_V;
  f32x4a ot[8][2]; float lsum[2] = {0.f, 0.f}; bf16x8 qf[2][NDS];
#pragma unroll
  for (int db = 0; db < 8; ++db) { ot[db][0] = (f32x4a){0.f, 0.f, 0.f, 0.f}; ot[db][1] = (f32x4a){0.f, 0.f, 0.f, 0.f}; }
#pragma unroll
  for (int qb = 0; qb < 2; ++qb)
#pragma unroll
    for (int ds = 0; ds < NDS; ++ds) qf[qb][ds] = *reinterpret_cast<const bf16x8*>(Qb + (wid * QBLK + 16 * qb + c16) * ldq + 32 * ds + 8 * g);
  int kgo[NKI], vgo[2];
#pragma unroll
  for (int i = 0; i < NKI; ++i) { const int P = i * NTHR + tid, r = P / PPR, ph = P % PPR, lg = ph ^ (r & 7) ^ (DK == 128 ? ((r & 1) << 3) : 0); kgo[i] = r * ldk + lg * 8; }
#pragma unroll
  for (int i = 0; i < 2; ++i) { const int P = i * NTHR + tid, key = ((P >> 8) & 3) * 16 + ((P >> 3) & 3) * 4 + ((P >> 1) & 3), d = ((P >> 5) & 7) * 16 + (P & 1) * 8; vgo[i] = key * ldv + d; }
  const int swl = (c16 & 7) ^ (DK == 128 ? ((c16 & 1) << 3) : 0);
  int kfo[NDS];
#pragma unroll
  for (int ds = 0; ds < NDS; ++ds) kfo[ds] = c16 * KP + 16 * (g ^ (swl & 3)) + 64 * (ds ^ (swl >> 2));
  const int vb0 = (int)(uintptr_t)V_lds + g * 128 + 8 * c16;
  const int wv = __builtin_amdgcn_readfirstlane(wid) * 1024;
  LAS char* ldsl = (LAS char*)lds;
#define A16_SDMA(k0, b) do { const unsigned short* vt_ = Vh + (size_t)(k0) * ldv; const unsigned short* kt_ = Kh + (size_t)(k0) * ldk; \
    _Pragma("unroll") for (int i_ = 0; i_ < 2; ++i_) __builtin_amdgcn_global_load_lds((const unsigned*)(vt_ + vgo[i_]), (LAS unsigned*)(ldsl + (b) * SHM_V + i_ * 8192 + wv), 16, 0, 0); \
    _Pragma("unroll") for (int i_ = 0; i_ < NKI; ++i_) __builtin_amdgcn_global_load_lds((const unsigned*)(kt_ + kgo[i_]), (LAS unsigned*)(ldsl + 3 * SHM_V + (b) * SHM_K + i_ * 8192 + wv), 16, 0, 0); } while (0)
  const int NT = seq / KVBLK;
  A16_SDMA(0, 0); A16_SDMA(KVBLK, 1);
  if constexpr (NKI == 2) asm volatile("s_waitcnt vmcnt(4) lgkmcnt(0)\n\ts_barrier" ::: "memory"); else asm volatile("s_waitcnt vmcnt(5) lgkmcnt(0)\n\ts_barrier" ::: "memory");
  int b = 0, b1 = 1, b2 = 2;
#pragma unroll 1
  for (int j = 0; j < NT; ++j) {
    if (j + 2 < NT) A16_SDMA((j + 2) * KVBLK, b2);
    ATT_SBAR();
    f32x4a sct[4][2];
    const char* Kt = K_lds + b * SHM_K;
#define A16_EXP(kb_, e_) do { sct[kb_][(e_) >> 2][(e_) & 3] = __builtin_amdgcn_exp2f(sct[kb_][(e_) >> 2][(e_) & 3]); } while (0)
    bf16x8 kq[4];
#pragma unroll
    for (int s0 = 0; s0 < 3; ++s0) kq[s0] = *reinterpret_cast<const bf16x8*>(Kt + kfo[s0 % NDS] + (s0 / NDS) * 16 * KP);
#pragma unroll
    for (int kb = 0; kb < 4; ++kb) {
      sct[kb][0] = (f32x4a){0.f, 0.f, 0.f, 0.f}; sct[kb][1] = (f32x4a){0.f, 0.f, 0.f, 0.f};
#pragma unroll
      for (int ds = 0; ds < NDS; ++ds) { const int st = kb * NDS + ds, sn = st + 3;
        if (sn < 4 * NDS) kq[sn & 3] = *reinterpret_cast<const bf16x8*>(Kt + kfo[sn % NDS] + (sn / NDS) * 16 * KP);
        sct[kb][0] = __builtin_amdgcn_mfma_f32_16x16x32_bf16(kq[st & 3], qf[0][ds], sct[kb][0], 0, 0, 0);
        sct[kb][1] = __builtin_amdgcn_mfma_f32_16x16x32_bf16(kq[st & 3], qf[1][ds], sct[kb][1], 0, 0, 0);
        if (kb > 0) {
#pragma unroll
          for (int e = (ds * 8) / NDS; e < ((ds + 1) * 8) / NDS; ++e) A16_EXP(kb > 0 ? kb - 1 : 0, e); }
        ATT_SBAR(); } }
    bf16x8 pf[2][2];
#define A16_PACK(ksp_) do { _Pragma("unroll") for (int qb = 0; qb < 2; ++qb) { u32x4 w; w.x = cvtpk(sct[2 * (ksp_)][qb][0], sct[2 * (ksp_)][qb][1]); w.y = cvtpk(sct[2 * (ksp_)][qb][2], sct[2 * (ksp_)][qb][3]); \
        w.z = cvtpk(sct[2 * (ksp_) + 1][qb][0], sct[2 * (ksp_) + 1][qb][1]); w.w = cvtpk(sct[2 * (ksp_) + 1][qb][2], sct[2 * (ksp_) + 1][qb][3]); pf[qb][ksp_] = __builtin_bit_cast(bf16x8, w); \
        lsum[qb] += ((sct[2 * (ksp_)][qb][0] + sct[2 * (ksp_)][qb][1]) + (sct[2 * (ksp_)][qb][2] + sct[2 * (ksp_)][qb][3])) + ((sct[2 * (ksp_) + 1][qb][0] + sct[2 * (ksp_) + 1][qb][1]) + (sct[2 * (ksp_) + 1][qb][2] + sct[2 * (ksp_) + 1][qb][3])); } } while (0)
    const int vb = vb0 + b * SHM_V;
    s16x4 ta[4][2], tb[4][2];
#define A16_RD(T, KSP, DB0) do { \
      T[0][0] = tr_read16<(2 * KSP) * 4096 + (DB0 + 0) * 512>(vb); T[0][1] = tr_read16<(2 * KSP + 1) * 4096 + (DB0 + 0) * 512>(vb); \
      T[1][0] = tr_read16<(2 * KSP) * 4096 + (DB0 + 1) * 512>(vb); T[1][1] = tr_read16<(2 * KSP + 1) * 4096 + (DB0 + 1) * 512>(vb); \
      T[2][0] = tr_read16<(2 * KSP) * 4096 + (DB0 + 2) * 512>(vb); T[2][1] = tr_read16<(2 * KSP + 1) * 4096 + (DB0 + 2) * 512>(vb); \
      T[3][0] = tr_read16<(2 * KSP) * 4096 + (DB0 + 3) * 512>(vb); T[3][1] = tr_read16<(2 * KSP + 1) * 4096 + (DB0 + 3) * 512>(vb); } while (0)
#define A16_WAIT() do { asm volatile("s_waitcnt lgkmcnt(0)" ::: "memory"); ATT_SBAR(); } while (0)
#define A16_MM(T, KSP, DB0, X) do { \
      _Pragma("unroll") for (int d_ = 0; d_ < 4; ++d_) { const bf16x8 vf = (bf16x8){T[d_][0][0], T[d_][0][1], T[d_][0][2], T[d_][0][3], T[d_][1][0], T[d_][1][1], T[d_][1][2], T[d_][1][3]}; \
        ot[DB0 + d_][0] = __builtin_amdgcn_mfma_f32_16x16x32_bf16(vf, pf[0][KSP], ot[DB0 + d_][0], 0, 0, 0); \
        ot[DB0 + d_][1] = __builtin_amdgcn_mfma_f32_16x16x32_bf16(vf, pf[1][KSP], ot[DB0 + d_][1], 0, 0, 0); } X; ATT_SBAR(); } while (0)
#define A16_PIN(qb_) asm volatile("" : "+v"(sct[3][qb_][0]), "+v"(sct[3][qb_][1]), "+v"(sct[3][qb_][2]), "+v"(sct[3][qb_][3]))
    A16_RD(ta, 0, 0);
    ATT_SBAR();
    A16_PACK(0);
    ATT_SBAR();
    A16_WAIT();
    A16_RD(tb, 0, 4); ATT_SBAR();
    A16_MM(ta, 0, 0, { A16_PIN(0); A16_EXP(3, 0); A16_EXP(3, 1); A16_EXP(3, 2); A16_EXP(3, 3); A16_PIN(0); });
    A16_WAIT();
    A16_RD(ta, 1, 0); ATT_SBAR();
    A16_MM(tb, 0, 4, { A16_PIN(1); A16_EXP(3, 4); A16_EXP(3, 5); A16_EXP(3, 6); A16_EXP(3, 7); A16_PIN(1); });
    A16_PACK(1);
    ATT_SBAR();
    A16_WAIT();
    A16_RD(tb, 1, 4); ATT_SBAR();
    A16_MM(ta, 1, 0, {});
    A16_WAIT();
    A16_MM(tb, 1, 4, {});
#undef A16_PIN
#undef A16_RD
#undef A16_WAIT
#undef A16_MM
#undef A16_PACK
#undef A16_EXP
    if (j + 2 < NT) { if constexpr (NKI == 2) asm volatile("s_waitcnt vmcnt(4) lgkmcnt(0)\n\ts_barrier" ::: "memory"); else asm volatile("s_waitcnt vmcnt(5) lgkmcnt(0)\n\ts_barrier" ::: "memory"); }
    else asm volatile("s_waitcnt vmcnt(0) lgkmcnt(0)\n\ts_barrier" ::: "memory");
    { const int t_ = b; b = b1; b1 = b2; b2 = t_; }
  }
#pragma unroll
  for (int qb = 0; qb < 2; ++qb) { float l = lsum[qb]; l += __shfl_xor(l, 16); l += __shfl_xor(l, 32); const float rl = __builtin_amdgcn_rcpf(l);
    unsigned short* Or = Ob + (wid * QBLK + 16 * qb + c16) * ldo + 4 * g;
#pragma unroll
    for (int db = 0; db < 8; ++db) { typedef unsigned u32x2a __attribute__((ext_vector_type(2)));
      u32x2a w; w.x = pk2(ot[db][qb][0] * rl, ot[db][qb][1] * rl); w.y = pk2(ot[db][qb][2] * rl, ot[db][qb][3] * rl);
      *(u32x2a*)(Or + 16 * db) = w; } }
  __syncthreads();
#undef A16_SDMA
}
#undef ATT_SBAR
}
namespace hy {
using bf16x8 = __attribute__((ext_vector_type(8))) short;
using f32x16 = __attribute__((ext_vector_type(16))) float;
using u32x4  = __attribute__((ext_vector_type(4))) unsigned;
using u32x2  = __attribute__((ext_vector_type(2))) unsigned;
template <int L> struct HC {
    static constexpr int NMB = L / 2048, NCH = (L == 4096) ? 2 : 4, UST = L + 160, GRN = 2 * L / 64 * 72;
    static constexpr int UB = 4 * UST * 2, GB = GRN * 2, CHB = UB + GB, NK4 = L / 64 + 1;
    static_assert(NCH * CHB <= RING_BYTES, "hyena LDS");
};
__device__ __forceinline__ int crow(int r, int hi) { return (r & 3) + 8 * (r >> 2) + 4 * hi; }
__device__ __forceinline__ float bf2f(unsigned short v) { return __uint_as_float((unsigned)v << 16); }

typedef float f32x4h __attribute__((ext_vector_type(4)));
template <int L>
__device__ __forceinline__ void conv_kloop16(f32x4h (&acc)[2][8], const LAS char* gA, const LAS char* uB) {
    constexpr int NK2 = L / 64 + 1;
#pragma unroll
    for (int a = 0; a < 2; ++a)
#pragma unroll
        for (int r = 0; r < 8; ++r) acc[a][r] = (f32x4h){0.f, 0.f, 0.f, 0.f};
    for (int kk2 = 0; kk2 < NK2; ++kk2) {
#pragma unroll
        for (int h = 0; h < 2; ++h) {
            const bf16x8 A = *(const LAS bf16x8*)(gA + kk2 * 144 + h * 64);
#pragma unroll
            for (int nh = 0; nh < 2; ++nh) {
                const u32x4 w0 = *(const LAS u32x4*)(uB + kk2 * 128 + h * 64 + nh * 64);
                const u32x4 w1 = *(const LAS u32x4*)(uB + kk2 * 128 + h * 64 + nh * 64 + 16);
                const unsigned w[8] = {w0.x, w0.y, w0.z, w0.w, w1.x, w1.y, w1.z, w1.w};
#pragma unroll
                for (int r = 0; r < 8; ++r) { u32x4 bf;
                    if ((r & 1) == 0) { const int q = r >> 1; bf = (u32x4){w[q], w[q + 1], w[q + 2], w[q + 3]}; }
                    else { const int q = (r - 1) >> 1;
                        bf = (u32x4){__builtin_amdgcn_alignbit(w[q + 1], w[q], 16), __builtin_amdgcn_alignbit(w[q + 2], w[q + 1], 16),
                                     __builtin_amdgcn_alignbit(w[q + 3], w[q + 2], 16), __builtin_amdgcn_alignbit(w[q + 4], w[q + 3], 16)}; }
                    acc[nh][r] = __builtin_amdgcn_mfma_f32_16x16x32_bf16(A, __builtin_bit_cast(bf16x8, bf), acc[nh][r], 0, 0, 0); }
            }
        }
    }
}

template <int L>
__device__ __forceinline__ void hyena_unit(LAS char* lds, const unsigned short* GFl, const unsigned short* X1T, const unsigned short* X2T, const unsigned short* VT,
                                           unsigned short* Y2T, const float* skip  , int b0, int c0) {
    using C = HC<L>;
    constexpr int NCH = C::NCH, UST = C::UST, GRN = C::GRN, UB = C::UB, GB = C::GB, CHB = C::CHB, WPC = 8 / NCH;
    static_assert(L / 1024 == WPC, "one wave per (channel, 1024-output block)");
    const int tid = tid_fresh(), wid = __builtin_amdgcn_readfirstlane(tid >> 6), lane = tid & 63;
    const int ch = wid / WPC, Mb = wid % WPC;
    const int c16 = lane & 15, g = lane >> 4, np = c16 >> 2, bb = c16 & 3;
    LAS char* Uch = lds + ch * CHB; LAS char* Gch = Uch + UB;
    const LAS char* gA = Gch + 2 * ((L / 64 - 16 * Mb - c16 - 1) * 72 + 8 * g);
    const LAS char* uB = Uch + 2 * (bb * UST + 8 * g + 8 * np);
    const int c = c0 + ch;
    u32x4 y1p[2][4];
#pragma unroll 1
    for (int o = 0; o < 2; ++o) {
        { constexpr int NG = NCH * (GB / 16), NGI = (NG + NTHR - 1) / NTHR; u32x4 gv[NGI];
#pragma unroll
          for (int i = 0; i < NGI; ++i) { const int id = tid + i * NTHR, cc = id / (GB / 16), off = id % (GB / 16);
              gv[i] = (id < NG) ? *(const u32x4*)((const char*)(GFl + ((size_t)(o * 512 + c0 + cc)) * GRN) + off * 16) : (u32x4){0u, 0u, 0u, 0u}; }
          if (o == 0) {
              constexpr int NU = NCH * 4 * (L / 8), NUI = NU / NTHR; static_assert(NU % NTHR == 0, "u staging"); u32x4 uv_[NUI];
#pragma unroll
              for (int i = 0; i < NUI; ++i) { const int id = tid + i * NTHR, cb = id / (L / 8), off = id % (L / 8), cc = cb >> 2, b = cb & 3;
                  uv_[i] = *(const u32x4*)(VT + xt_off(b0 + b, c0 + cc) + off * 8); }
#pragma unroll
              for (int i = 0; i < NUI; ++i) { const int id = tid + i * NTHR, cb = id / (L / 8), off = id % (L / 8), cc = cb >> 2, b = cb & 3;
                  *(LAS u32x4*)(lds + cc * CHB + (b * UST + 64) * 2 + off * 16) = uv_[i]; }
              for (int id = tid; id < NCH * 4 * 20; id += NTHR) { const int cb = id / 20, k = id % 20, cc = cb >> 2, b = cb & 3;
                  const int el = k < 8 ? k * 8 : (L + 64) + (k - 8) * 8;
                  *(LAS u32x4*)(lds + cc * CHB + (b * UST + el) * 2) = (u32x4){0u, 0u, 0u, 0u}; }
          }
#pragma unroll
          for (int i = 0; i < NGI; ++i) { const int id = tid + i * NTHR, cc = id / (GB / 16), off = id % (GB / 16);
              if (id < NG) *(LAS u32x4*)(lds + cc * CHB + UB + off * 16) = gv[i]; } }
        if (o == 1) {
#pragma unroll
            for (int nh = 0; nh < 2; ++nh)
#pragma unroll
                for (int i = 0; i < 4; ++i) { const int t0 = 1024 * Mb + 64 * (4 * g + i) + 32 * nh + 8 * np;
                    *(LAS u32x4*)(Uch + (bb * UST + 64 + t0) * 2) = y1p[nh][i]; }
        }
        __syncthreads();
        f32x4h acc[2][8];
        conv_kloop16<L>(acc, gA, uB);
        const float sk = skip[o * 512 + c];
        const unsigned short* XT = (o == 0) ? X1T : X2T;
        const size_t gbase = xt_off(b0 + bb, c);
        u32x4 xvs[2][4];
#pragma unroll
        for (int nh = 0; nh < 2; ++nh)
#pragma unroll
            for (int i = 0; i < 4; ++i) { const int t0 = 1024 * Mb + 64 * (4 * g + i) + 32 * nh + 8 * np; xvs[nh][i] = *(const u32x4*)(XT + gbase + t0); }
#pragma unroll
        for (int nh = 0; nh < 2; ++nh)
#pragma unroll
            for (int i = 0; i < 4; ++i) { const int t0 = 1024 * Mb + 64 * (4 * g + i) + 32 * nh + 8 * np;
                const u32x4 xv = xvs[nh][i];
                const u32x4 uv = *(const LAS u32x4*)(Uch + (bb * UST + 64 + t0) * 2);
                const unsigned xw[4] = {xv.x, xv.y, xv.z, xv.w}, uw[4] = {uv.x, uv.y, uv.z, uv.w}; unsigned pw[4];
#pragma unroll
                for (int q = 0; q < 4; ++q) {
                    const float ylo = bf2f((unsigned short)(xw[q] & 0xffff)) * (acc[nh][2 * q][i] + sk * bf2f((unsigned short)(uw[q] & 0xffff)));
                    const float yhi = bf2f((unsigned short)(xw[q] >> 16)) * (acc[nh][2 * q + 1][i] + sk * bf2f((unsigned short)(uw[q] >> 16)));
                    pw[q] = pk2(ylo, yhi); }
                const u32x4 p = (u32x4){pw[0], pw[1], pw[2], pw[3]};
                if (o == 0) y1p[nh][i] = p;
                else *(u32x4*)(Y2T + gbase + t0) = p; }
        __syncthreads();
    }
}
}
typedef unsigned u32x2v __attribute__((ext_vector_type(2)));
__device__ __forceinline__ float bf2f(unsigned short v) { return __uint_as_float((unsigned)v << 16); }
__device__ __forceinline__ float bflo(unsigned w) { return __uint_as_float(w << 16); }
__device__ __forceinline__ float bfhi(unsigned w) { return __uint_as_float(w & 0xffff0000u); }
__device__ __forceinline__ float wave_sum(float v) {
#pragma unroll
    for (int o = 1; o < 64; o <<= 1) v += __shfl_xor(v, o);
    return v;
}
__device__ __forceinline__ void unpack8(const v4u& w, float (&f)[8]) {
    f[0] = bflo(w.x); f[1] = bfhi(w.x); f[2] = bflo(w.y); f[3] = bfhi(w.y); f[4] = bflo(w.z); f[5] = bfhi(w.z); f[6] = bflo(w.w); f[7] = bfhi(w.w);
}
__device__ __forceinline__ v4u pack8(const float (&f)[8]) { v4u w; w.x = pk2(f[0], f[1]); w.y = pk2(f[2], f[3]); w.z = pk2(f[4], f[5]); w.w = pk2(f[6], f[7]); return w; }

__device__ __forceinline__ void norm_rows(const float* xa, const float* xb, const float* g, const float* mod  , int sh_off, int sc_off, bf16* H, int gw, int ngw, int lane) {
    for (int ck = gw; ck < NTOK / 4; ck += ngw) {
        const int row0 = ck * 4, b = row_batch(row0);
        const float* xin = row0 < NPR ? xa : xb;
        const float* sc = mod + (size_t)b * MODW + sc_off; const float* sh = mod + (size_t)b * MODW + sh_off;
        f32x4 ga[8], sb[8];
#pragma unroll
        for (int j = 0; j < 8; ++j) { const int col = 4 * lane + 256 * j; const f32x4 gg = *(const f32x4*)(g + col), s1 = *(const f32x4*)(sc + col);
            ga[j] = gg * (s1 + 1.0f); sb[j] = *(const f32x4*)(sh + col); }
#pragma unroll 1
        for (int r = 0; r < 4; ++r) {
            const float* xr = xin + (size_t)(row0 + r) * DM;
            f32x4 v[8]; float ss = 0.f;
#pragma unroll
            for (int j = 0; j < 8; ++j) { v[j] = *(const f32x4*)(xr + 4 * lane + 256 * j); ss += (v[j].x * v[j].x + v[j].y * v[j].y) + (v[j].z * v[j].z + v[j].w * v[j].w); }
            const float rs = rsqrtf(wave_sum(ss) * (1.0f / DM) + EPS);
            bf16* hr = H + (size_t)(row0 + r) * DM;
#pragma unroll
            for (int j = 0; j < 8; ++j) { const f32x4 o = v[j] * rs * ga[j] + sb[j]; u32x2v w; w.x = pk2(o.x, o.y); w.y = pk2(o.z, o.w);
                *(u32x2v*)(hr + 4 * lane + 256 * j) = w; }
        }
    }
}

struct PostIn { v4u v, qa, ckv, h1, h2; };
__device__ __forceinline__ PostIn post_load(const bf16* P, int lane) {
    PostIn in; const int head = lane >> 3, sub = lane & 7, sec = sub >> 2, chk = sub & 3, hh = head < 6 ? head : 0;
    in.v = *(const v4u*)(P + 512 + 8 * lane); in.qa = *(const v4u*)(P + C_D + 8 * lane); in.ckv = *(const v4u*)(P + C_D + 512 + 8 * (lane & 31));
    const bf16* hp = P + C_C + hh * 128 + 64 * sec + 8 * chk; in.h1 = *(const v4u*)hp; in.h2 = *(const v4u*)(hp + 32); return in;
}
__device__ __forceinline__ void post_finish(const PostIn& in, bf16* P, int pos, const float* vng, const float* qng, const float* kng, const float* qag, const float* kvag, int lane, bool st = true) {
    { float f[8]; unpack8(in.v, f);
      float s = 0.f;
#pragma unroll
      for (int i = 0; i < 8; ++i) s += f[i];
      const float mean = wave_sum(s) * (1.0f / 512.0f); float q = 0.f;
#pragma unroll
      for (int i = 0; i < 8; ++i) { f[i] -= mean; q += f[i] * f[i]; }
      const float rs = rsqrtf(wave_sum(q) * (1.0f / 512.0f) + EPS);
      const f32x4 g0 = *(const f32x4*)(vng + 8 * lane), g1 = *(const f32x4*)(vng + 8 * lane + 4);
      f[0] *= rs * g0.x; f[1] *= rs * g0.y; f[2] *= rs * g0.z; f[3] *= rs * g0.w; f[4] *= rs * g1.x; f[5] *= rs * g1.y; f[6] *= rs * g1.z; f[7] *= rs * g1.w;
      if (st) *(v4u*)(P + 512 + 8 * lane) = pack8(f); }
    { float f[8]; unpack8(in.qa, f); float q = 0.f;
#pragma unroll
      for (int i = 0; i < 8; ++i) q += f[i] * f[i];
      const float rs = rsqrtf(wave_sum(q) * (1.0f / 512.0f) + EPS);
#pragma unroll
      for (int i = 0; i < 8; ++i) f[i] *= rs * qag[8 * lane + i];
      if (st) *(v4u*)(P + C_D + 8 * lane) = pack8(f); }
    { const int l32 = lane & 31; float f[8]; unpack8(in.ckv, f); float q = 0.f;
#pragma unroll
      for (int i = 0; i < 8; ++i) q += f[i] * f[i];
      const float rs = rsqrtf(wave_sum(q) * (0.5f / 256.0f) + EPS);
#pragma unroll
      for (int i = 0; i < 8; ++i) f[i] *= rs * kvag[8 * l32 + i];
      if (st && lane < 32) *(v4u*)(P + C_D + 512 + 8 * l32) = pack8(f); }
    { const int head = lane >> 3, sub = lane & 7, sec = sub >> 2, chk = sub & 3; const bool on = head < 6;
      const int hh = on ? head : 0;
      bf16* hp = P + C_C + hh * 128 + 64 * sec + 8 * chk;
      float a[8], c[8]; unpack8(in.h1, a); unpack8(in.h2, c);
      float q = 0.f;
#pragma unroll
      for (int i = 0; i < 8; ++i) q += a[i] * a[i] + c[i] * c[i];
      q += __shfl_xor(q, 1); q += __shfl_xor(q, 2); q += __shfl_xor(q, 4);
      const float rs = rsqrtf(q * (1.0f / 128.0f) + EPS);
      const float* gg = (hh < 4 ? qng : kng) + 64 * sec + 8 * chk;
      const float p = (float)(sec ? (pos & 63) : (pos >> 6));
#pragma unroll
      for (int i = 0; i < 8; ++i) {
          const float x1 = a[i] * rs * gg[i], x2 = c[i] * rs * gg[32 + i];
          const float inv = __expf(-(float)(2 * (8 * chk + i)) * (9.210340371976184f / 64.0f));
          float sn, cs; __sincosf(p * inv, &sn, &cs);
          const float qs = (hh < 4) ? 0.12751743082459868f : 1.0f;
          a[i] = (x1 * cs - x2 * sn) * qs; c[i] = (x2 * cs + x1 * sn) * qs; }
      if (st && on) { *(v4u*)hp = pack8(a); *(v4u*)(hp + 32) = pack8(c); } }
}
__device__ __forceinline__ void post_rows(bf16* PROJp, const float* vng, const float* qng, const float* kng, const float* qag, const float* kvag, int gw, int ngw, int lane, bool st) {
    int row = gw; if (row >= NTOK) return;
    PostIn cur = post_load(PROJp + (size_t)row * INCP, lane);
    for (; row < NTOK; row += ngw) { const int nr = row + ngw; PostIn nxt = cur;
        if (nr < NTOK) nxt = post_load(PROJp + (size_t)nr * INCP, lane);
        post_finish(cur, PROJp + (size_t)row * INCP, row_pos(row), vng, qng, kng, qag, kvag, lane, st); cur = nxt; }
}

struct MlaIn { v4u n[2], a[2], c[2]; };
__device__ __forceinline__ MlaIn mla_load(const bf16* Qr, const bf16* KVr, const bf16* krope, int lane) {
    MlaIn in; const int head = lane >> 4, sub = lane & 15; const bool rp = sub < 4; const int sec = (sub >> 1) & 1, chk = sub & 1, x1o = 128 + 32 * sec + 8 * chk;
    in.n[0] = *(const v4u*)(Qr + head * 192 + 8 * sub); in.n[1] = *(const v4u*)(KVr + head * 256 + 8 * sub);
    in.a[0] = in.c[0] = in.a[1] = in.c[1] = (v4u){0u, 0u, 0u, 0u};
    if (rp) { in.a[0] = *(const v4u*)(Qr + head * 192 + x1o); in.c[0] = *(const v4u*)(Qr + head * 192 + x1o + 16);
              in.a[1] = *(const v4u*)(krope + 32 * sec + 8 * chk); in.c[1] = *(const v4u*)(krope + 32 * sec + 8 * chk + 16); }
    return in;
}
__device__ __forceinline__ void mla_finish(const MlaIn& in, bf16* Qr, bf16* Kr, int pos, const float* qng, const float* kng, int lane, bool st = true) {
    const int head = lane >> 4, sub = lane & 15;
    const bool rp = sub < 4; const int sec = (sub >> 1) & 1, chk = sub & 1;
    const int x1o = 128 + 32 * sec + 8 * chk;
    const float p = (float)(sec ? (pos & 63) : (pos >> 6));
#pragma unroll
    for (int which = 0; which < 2; ++which) {
        const float* g = which == 0 ? qng : kng;
        bf16* dst = (which == 0 ? Qr : Kr) + head * 192;
        float n[8], a[8], c[8]; unpack8(in.n[which], n); unpack8(in.a[which], a); unpack8(in.c[which], c);
        float q = 0.f;
#pragma unroll
        for (int i = 0; i < 8; ++i) q += n[i] * n[i] + a[i] * a[i] + c[i] * c[i];
        q += __shfl_xor(q, 1); q += __shfl_xor(q, 2); q += __shfl_xor(q, 4); q += __shfl_xor(q, 8);
        const float rs = rsqrtf(q * (1.0f / 192.0f) + EPS);
        const float qs = (which == 0) ? 0.10411755155693222f : 1.0f;
#pragma unroll
        for (int i = 0; i < 8; ++i) n[i] *= rs * g[8 * sub + i] * qs;
        if (st) *(v4u*)(dst + 8 * sub) = pack8(n);
        if (rp) {
#pragma unroll
            for (int i = 0; i < 8; ++i) {
                const float x1 = a[i] * rs * g[x1o + i], x2 = c[i] * rs * g[x1o + 16 + i];
                const float inv = __expf(-(float)(2 * (8 * chk + i)) * (9.210340371976184f / 32.0f));
                float sn, cs; __sincosf(p * inv, &sn, &cs);
                a[i] = (x1 * cs - x2 * sn) * qs; c[i] = (x2 * cs + x1 * sn) * qs; }
            if (st) { *(v4u*)(dst + x1o) = pack8(a); *(v4u*)(dst + x1o + 16) = pack8(c); } }
    }
}
__device__ __forceinline__ void mla_rows(bf16* QDp, const bf16* KVDp, const bf16* PROJp, bf16* KMp, const float* qng, const float* kng, int gw, int ngw, int lane, bool st) {
    int row = gw; if (row >= NTOK) return;
    MlaIn cur = mla_load(QDp + (size_t)row * 768, KVDp + (size_t)row * 1024, PROJp + (size_t)row * INCP + C_D + 768, lane);
    for (; row < NTOK; row += ngw) { const int nr = row + ngw; MlaIn nxt = cur;
        if (nr < NTOK) nxt = mla_load(QDp + (size_t)nr * 768, KVDp + (size_t)nr * 1024, PROJp + (size_t)nr * INCP + C_D + 768, lane);
        mla_finish(cur, QDp + (size_t)row * 768, KMp + (size_t)row * 768, row_pos(row), qng, kng, lane, st); cur = nxt; }
}

__device__ __forceinline__ void hyconv_tile(LAS unsigned char* lds, const bf16* PROJ, bf16* XT, const float* cw  , const float* cb  , int tile, int tid) {
    const int which = tile % 3, tb = tile / 3, row0 = tb * 64, b = row_batch(row0), pos0 = row_pos(row0), Lb = batch_len(b);
    constexpr int PITCH = 260;
    LAS unsigned* raw = (LAS unsigned*)lds;
    { v4u w[9];
#pragma unroll
      for (int i = 0; i < 9; ++i) { const int id = tid + i * NTHR, r = id >> 6, k = id & 63, p = pos0 - 1 + r;
          w[i] = (v4u){0u, 0u, 0u, 0u};
          if (id < 66 * 64 && p >= 0 && p < Lb) w[i] = *(const v4u*)(PROJ + (size_t)(row0 - 1 + r) * INCP + C_B + which * 512 + 8 * k); }
#pragma unroll
      for (int i = 0; i < 9; ++i) { const int id = tid + i * NTHR, r = id >> 6, k = id & 63;
          if (id < 66 * 64) *(LAS v4u*)(raw + r * PITCH + 4 * k) = w[i]; } }
    __syncthreads();
    { const int c = tid, col = which * 512 + c; const float w0 = cw[col], w1 = cw[1536 + col], w2 = cw[3072 + col], bb = cb[col];
      const LAS unsigned short* rc = (const LAS unsigned short*)raw + c;
      bf16* dst = XT + (size_t)which * ((size_t)NTOK * 512) + xt_off(b, c) + pos0;
      float xm = bf2f(rc[0]), x0 = bf2f(rc[2 * PITCH]);
#pragma unroll 2
      for (int k = 0; k < 8; ++k) { float z[8];
#pragma unroll
          for (int i = 0; i < 8; ++i) { const float xp = bf2f(rc[(8 * k + i + 2) * 2 * PITCH]); z[i] = w0 * xm + w1 * x0 + w2 * xp + bb; xm = x0; x0 = xp; }
          *(v4u*)(dst + 8 * k) = pack8(z); } }
    __syncthreads();
}

__device__ __forceinline__ void gnorm_tile(LAS unsigned char* lds, const bf16* __restrict__ YCAT, const bf16* __restrict__ Y2T, const float* __restrict__ gg  , bf16* __restrict__ YN, int tile, int tid) {
    const int row0 = tile * 32, b = row_batch(row0), pos0 = row_pos(row0), lane = tid & 63, wid = tid >> 6;
    constexpr int PITCH = 17;
    LAS unsigned* yb = (LAS unsigned*)lds;
    { v4u yw[4];
#pragma unroll
      for (int i = 0; i < 4; ++i) { const int id = tid + i * NTHR, c = id >> 2, k = id & 3; yw[i] = *(const v4u*)(Y2T + xt_off(b, c) + pos0 + 8 * k); }
#pragma unroll
      for (int i = 0; i < 4; ++i) { const int id = tid + i * NTHR, c = id >> 2, k = id & 3; LAS unsigned* d = yb + c * PITCH + 4 * k; d[0] = yw[i].x; d[1] = yw[i].y; d[2] = yw[i].z; d[3] = yw[i].w; } }
    __syncthreads();
#pragma unroll 2
    for (int r = 0; r < 4; ++r) { const int t = wid * 4 + r, row = row0 + t;
        const bf16* yr = YCAT + (size_t)row * DM; bf16* on = YN + (size_t)row * DM;
#pragma unroll
        for (int grp = 0; grp < 4; ++grp) {
            if (grp == 1) {
                float f[8]; float q = 0.f;
#pragma unroll
                for (int i = 0; i < 8; ++i) { f[i] = bf2f(((const LAS unsigned short*)yb)[(lane + 64 * i) * 2 * PITCH + t]); q += f[i] * f[i]; }
                const float rs = rsqrtf(wave_sum(q) * (1.0f / 512.0f) + EPS);
#pragma unroll
                for (int i = 0; i < 8; ++i) on[512 + lane + 64 * i] = (bf16)f2bf(f[i] * rs * gg[512 + lane + 64 * i]);
            } else {
                v4u w = *(const v4u*)(yr + grp * 512 + 8 * lane); float f[8]; unpack8(w, f); float q = 0.f;
#pragma unroll
                for (int i = 0; i < 8; ++i) q += f[i] * f[i];
                const float rs = rsqrtf(wave_sum(q) * (1.0f / 512.0f) + EPS);
                const f32x4 g0 = *(const f32x4*)(gg + grp * 512 + 8 * lane), g1 = *(const f32x4*)(gg + grp * 512 + 8 * lane + 4);
                f[0] *= rs * g0.x; f[1] *= rs * g0.y; f[2] *= rs * g0.z; f[3] *= rs * g0.w; f[4] *= rs * g1.x; f[5] *= rs * g1.y; f[6] *= rs * g1.z; f[7] *= rs * g1.w;
                *(v4u*)(on + grp * 512 + 8 * lane) = pack8(f);
            }
        }
    }
    __syncthreads();
}

__device__ __forceinline__ void ffn_gate(const bf16* Z, bf16* A, const float* cw  , const float* cb  , int gt, int ngt) {
    constexpr int NCK = DFF / 8;
    for (int it = gt; it < (NTOK / 16) * NCK; it += ngt) {
        const int rb = it / NCK, ck = it % NCK, row0 = rb * 16, j0 = ck * 8;
        const int pos0 = row_pos(row0), Lb = batch_len(row_batch(row0));
        float wg[3][8], wu[3][8], bg[8], bu[8];
#pragma unroll
        for (int k = 0; k < 3; ++k)
#pragma unroll
            for (int i = 0; i < 8; ++i) { wg[k][i] = cw[k * DFF2 + j0 + i]; wu[k][i] = cw[k * DFF2 + DFF + j0 + i]; }
#pragma unroll
        for (int i = 0; i < 8; ++i) { bg[i] = cb[j0 + i]; bu[i] = cb[DFF + j0 + i]; }
        float gm[8], g0[8], um[8], u0[8];
        const bf16* zr = Z + (size_t)row0 * DFF2 + j0;
        if (pos0 > 0) { v4u a = *(const v4u*)(zr - DFF2), c = *(const v4u*)(zr - DFF2 + DFF); unpack8(a, gm); unpack8(c, um); }
        else {
#pragma unroll
            for (int i = 0; i < 8; ++i) { gm[i] = 0.f; um[i] = 0.f; } }
        { v4u a = *(const v4u*)zr, c = *(const v4u*)(zr + DFF); unpack8(a, g0); unpack8(c, u0); }
#pragma unroll 1
        for (int r = 0; r < 16; ++r) {
            float gp[8], up[8];
            if (pos0 + r + 1 < Lb) { v4u a = *(const v4u*)(zr + (size_t)(r + 1) * DFF2), c = *(const v4u*)(zr + (size_t)(r + 1) * DFF2 + DFF); unpack8(a, gp); unpack8(c, up); }
            else {
#pragma unroll
                for (int i = 0; i < 8; ++i) { gp[i] = 0.f; up[i] = 0.f; } }
            float o[8];
#pragma unroll
            for (int i = 0; i < 8; ++i) {
                const float gc = wg[0][i] * gm[i] + wg[1][i] * g0[i] + wg[2][i] * gp[i] + bg[i];
                const float uc = wu[0][i] * um[i] + wu[1][i] * u0[i] + wu[2][i] * up[i] + bu[i];
                o[i] = gc * __builtin_amdgcn_rcpf(1.0f + __expf(-gc)) * uc;
                gm[i] = g0[i]; g0[i] = gp[i]; um[i] = u0[i]; u0[i] = up[i]; }
            *(v4u*)(A + (size_t)(row0 + r) * DFF + j0) = pack8(o);
        }
    }
}

__device__ __forceinline__ void gate_fix(const float* ZH, bf16* A, const float* cw, const float* cb, int gt, int ngt) {
    constexpr int NQ4 = DFF / 4;
    for (int it = gt; it < 192 * NQ4; it += ngt) {
        const int rs = it / NQ4, q4 = it % NQ4, pm = rs >> 1, s = rs & 1, row = pm * 256 + (s ? 255 : 0), pos = row_pos(row), Lb = batch_len(row_batch(row));
        if (s == 0 ? (pos == 0) : (pos + 1 == Lb)) continue;
        const int j = q4 * 4, zc = 256 * (j >> 7) + (j & 127);
        const float* zp = s == 0 ? ZH + ((size_t)(pm - 1) * 4 + 3) * DFF2 : ZH + ((size_t)pm * 4 + 2) * DFF2;
        const float* z0 = s == 0 ? ZH + ((size_t)pm * 4 + 0) * DFF2 : ZH + ((size_t)pm * 4 + 3) * DFF2;
        const float* zn = s == 0 ? ZH + ((size_t)pm * 4 + 1) * DFF2 : ZH + ((size_t)(pm + 1) * 4 + 0) * DFF2;
        f32x4 cv[2];
#pragma unroll
        for (int h = 0; h < 2; ++h) {
            const f32x4 a = *(const f32x4*)(zp + zc + 128 * h), b = *(const f32x4*)(z0 + zc + 128 * h), c = *(const f32x4*)(zn + zc + 128 * h);
            const f32x4 w0 = *(const f32x4*)(cw + h * DFF + j), w1 = *(const f32x4*)(cw + DFF2 + h * DFF + j), w2 = *(const f32x4*)(cw + 2 * DFF2 + h * DFF + j), bb = *(const f32x4*)(cb + h * DFF + j);
            cv[h] = w0 * a + w1 * b + w2 * c + bb; }
        float o[4];
#pragma unroll
        for (int e = 0; e < 4; ++e) { const float g = cv[0][e]; o[e] = g * __builtin_amdgcn_rcpf(1.0f + __expf(-g)) * cv[1][e]; }
        u32x2v w; w.x = pk2(o[0], o[1]); w.y = pk2(o[2], o[3]);
        *(u32x2v*)(A + affn_off(row, j)) = w;
    }
}

__device__ __forceinline__ void hyconv_regs(const bf16* PROJ, bf16* XT, const float* cw  , const float* cb  , int gt, int ngt) {
    for (int it = gt; it < (NTOK / 8) * 192; it += ngt) {
        const int tb = it / 192, ck = it % 192, row0 = tb * 8, j0 = ck * 8, which = j0 >> 9, c0 = j0 & 511;
        const int b = row_batch(row0), pos0 = row_pos(row0), Lb = batch_len(b);
        float w0[8], w1[8], w2[8], bb[8];
#pragma unroll
        for (int i = 0; i < 8; i += 4) { const f32x4 a = *(const f32x4*)(cw + j0 + i), c = *(const f32x4*)(cw + 1536 + j0 + i), d = *(const f32x4*)(cw + 3072 + j0 + i), e = *(const f32x4*)(cb + j0 + i);
            w0[i] = a.x; w0[i + 1] = a.y; w0[i + 2] = a.z; w0[i + 3] = a.w; w1[i] = c.x; w1[i + 1] = c.y; w1[i + 2] = c.z; w1[i + 3] = c.w;
            w2[i] = d.x; w2[i + 1] = d.y; w2[i + 2] = d.z; w2[i + 3] = d.w; bb[i] = e.x; bb[i + 1] = e.y; bb[i + 2] = e.z; bb[i + 3] = e.w; }
        const bf16* src = PROJ + (size_t)row0 * INCP + C_B + j0;
        v4u raw[10];
        raw[0] = (pos0 > 0) ? *(const v4u*)(src - INCP) : (v4u){0u, 0u, 0u, 0u};
#pragma unroll
        for (int r = 0; r < 8; ++r) raw[r + 1] = *(const v4u*)(src + (size_t)r * INCP);
        raw[9] = (pos0 + 8 < Lb) ? *(const v4u*)(src + (size_t)8 * INCP) : (v4u){0u, 0u, 0u, 0u};
        float z[8][8]; float xm[8], x0[8], xp[8];
        unpack8(raw[0], xm); unpack8(raw[1], x0);
#pragma unroll
        for (int r = 0; r < 8; ++r) { unpack8(raw[r + 2], xp);
#pragma unroll
            for (int i = 0; i < 8; ++i) { z[r][i] = w0[i] * xm[i] + w1[i] * x0[i] + w2[i] * xp[i] + bb[i]; xm[i] = x0[i]; x0[i] = xp[i]; } }
        bf16* dst = XT + (size_t)which * ((size_t)NTOK * 512) + xt_off(b, c0) + pos0;
        const size_t cst = (size_t)Lb;
#pragma unroll
        for (int i = 0; i < 8; ++i) { v4u o; o.x = pk2(z[0][i], z[1][i]); o.y = pk2(z[2][i], z[3][i]); o.z = pk2(z[4][i], z[5][i]); o.w = pk2(z[6][i], z[7][i]);
            *(v4u*)(dst + (size_t)i * cst) = o; }
    }
}
constexpr int I_IN = 32 * 138, I_QB = 8 * 24, I_KVB = 4 * 32, I_OUT = 32 * 64, I_UP = 32 * 352, I_DN = 88 * 64, I_A = I_IN + I_QB + I_KVB + I_OUT, I_L = I_A + I_UP + I_DN;
__device__ __forceinline__ void p0_transpose_item(const float* W, int K, int N, bf16* WT, int row_off, LAS float* scr, int item, int lane) {
    const int nblk = N / 32, kb = item / nblk, nb = item % nblk, k0 = 64 * kb, n0 = 32 * nb;
#pragma unroll
    for (int i = 0; i < 32; ++i) { const int kk = 2 * i + (lane >> 5); scr[kk * 33 + (lane & 31)] = __builtin_nontemporal_load(&W[(size_t)(k0 + kk) * N + n0 + (lane & 31)]); }
    LDS_WAIT(); asm volatile("" ::: "memory");
    const int c = lane & 7;
#pragma unroll
    for (int j = 0; j < 4; ++j) { const int n = (lane >> 3) + 8 * j; const LAS float* s = scr + (8 * c) * 33 + n;
        v4u o; o.x = pk2(s[0 * 33], s[1 * 33]); o.y = pk2(s[2 * 33], s[3 * 33]); o.z = pk2(s[4 * 33], s[5 * 33]); o.w = pk2(s[6 * 33], s[7 * 33]);
        *(GAS v4u*)(WT + (size_t)(row_off + n0 + n) * K + k0 + 8 * c) = o; }
    LDS_WAIT(); asm volatile("" ::: "memory");
}

struct TrItem { const float* W; bf16* WT; int K, N, row_off, r; };
__device__ __forceinline__ void tr_dma(const TrItem& a, int lane, LAS char* buf  ) {
    const int nblk = a.N / 32, kb = a.r / nblk, nb = a.r % nblk, k0 = 64 * kb, n0 = 32 * nb;
    const float* src = a.W + (size_t)(k0 + (lane >> 3)) * a.N + n0;
#pragma unroll
    for (int i = 0; i < 8; ++i)
        __builtin_amdgcn_global_load_lds((const unsigned*)(src + (size_t)(8 * i) * a.N + 4 * ((lane & 7) ^ i)), (LAS unsigned*)(buf + i * 1024), 16, 0, 2);
}
__device__ __forceinline__ void tr_out(const TrItem& a, int lane, const LAS float* s) {
    const int nblk = a.N / 32, kb = a.r / nblk, nb = a.r % nblk, k0 = 64 * kb, n0 = 32 * nb;
    const int c = lane & 7;
#pragma unroll
    for (int j = 0; j < 4; ++j) { const int n = (lane >> 3) + 8 * j; const LAS float* q = s + (64 * c + ((n >> 2) ^ c)) * 4 + (n & 3);
        v4u o; o.x = pk2(q[0 * 32], q[1 * 32]); o.y = pk2(q[2 * 32], q[3 * 32]); o.z = pk2(q[4 * 32], q[5 * 32]); o.w = pk2(q[6 * 32], q[7 * 32]);
        *(GAS v4u*)(a.WT + (size_t)(a.row_off + n0 + n) * a.K + k0 + 8 * c) = o; }
    LDS_WAIT(); asm volatile("" ::: "memory");
}
__device__ __forceinline__ void gmlp_unit(char* ldsg, const bf16* PROJ, bf16* YCAT, const float* sw  , const float* sb  , int unit, int tid) {
    using namespace att;
    const int chunk = unit >> 2, h = unit & 3, row0 = chunk * 128, lane = tid & 63, wid = __builtin_amdgcn_readfirstlane(tid >> 6), hi = lane >> 5, r32 = lane & 31;
    { bf16x8 vw[4];
#pragma unroll
      for (int i = 0; i < 4; ++i) { const int id = tid + i * NTHR, q = id >> 4, cc = (id & 15) * 8; vw[i] = *(const bf16x8*)(PROJ + (size_t)(row0 + q) * INCP + 512 + h * 128 + cc); }
#pragma unroll
      for (int i = 0; i < 4; ++i) { const int id = tid + i * NTHR, q = id >> 4, cc = (id & 15) * 8; *(bf16x8*)(ldsg + (q >> 6) * 16384 + v_st(q & 63, cc)) = vw[i]; } }
    const int pblk = wid >> 1, half = wid & 1;
    bf16x8 af[8];
    { const float* wp = sw + (size_t)h * 16384 + (32 * pblk + r32) * 128 + 8 * hi;
#pragma unroll
      for (int k = 0; k < 8; ++k) { const f32x4 a = *(const f32x4*)(wp + 16 * k), c = *(const f32x4*)(wp + 16 * k + 4);
          u32x4 w; w.x = cvtpk(a.x, a.y); w.y = cvtpk(a.z, a.w); w.z = cvtpk(c.x, c.y); w.w = cvtpk(c.z, c.w); af[k] = __builtin_bit_cast(bf16x8, w); } }
    __syncthreads();
    const int vb0 = (int)(uintptr_t)ldsg + v_rd_base(lane);
    f32x16 o0 = {}, o1 = {};
    if (half == 0) { pv_one<0>(o0, vb0, af[0], af[1], af[2], af[3]); pv_one<1>(o1, vb0, af[0], af[1], af[2], af[3]);
                     pv_one<0>(o0, vb0 + 16384, af[4], af[5], af[6], af[7]); pv_one<1>(o1, vb0 + 16384, af[4], af[5], af[6], af[7]); }
    else           { pv_one<2>(o0, vb0, af[0], af[1], af[2], af[3]); pv_one<3>(o1, vb0, af[0], af[1], af[2], af[3]);
                     pv_one<2>(o0, vb0 + 16384, af[4], af[5], af[6], af[7]); pv_one<3>(o1, vb0 + 16384, af[4], af[5], af[6], af[7]); }
    float* st = (float*)(ldsg + 32768) + wid * (32 * 68);
#pragma unroll
    for (int q = 0; q < 16; ++q) { const int pr = crow(q, hi); const float bs = sb[h * 128 + 32 * pblk + pr];
        st[pr * 68 + r32] = o0[q] + bs; st[pr * 68 + 32 + r32] = o1[q] + bs; }
    asm volatile("s_waitcnt lgkmcnt(0)" ::: "memory");
    v4u uws[4];
#pragma unroll
    for (int i = 0; i < 4; ++i) { const int pr = i * 8 + (lane >> 3), cc = (lane & 7) * 8; uws[i] = *(const v4u*)(PROJ + (size_t)(row0 + 32 * pblk + pr) * INCP + h * 128 + 64 * half + cc); }
#pragma unroll
    for (int i = 0; i < 4; ++i) { const int pr = i * 8 + (lane >> 3), cc = (lane & 7) * 8; const int row = row0 + 32 * pblk + pr, col = h * 128 + 64 * half + cc;
        const f32x4 m0 = *(const f32x4*)(st + pr * 68 + cc), m1 = *(const f32x4*)(st + pr * 68 + cc + 4);
        const v4u uw = uws[i]; float uf[8]; unpack8(uw, uf);
        float y[8] = {uf[0] * m0.x, uf[1] * m0.y, uf[2] * m0.z, uf[3] * m0.w, uf[4] * m1.x, uf[5] * m1.y, uf[6] * m1.z, uf[7] * m1.w};
        *(v4u*)(YCAT + (size_t)row * DM + col) = pack8(y); }
    __syncthreads();
}

__device__ __forceinline__ void mod_phase(LAS unsigned char* lds, const float* cp, const float* cs, const float* ada_w, const float* ada_b, float* MOD, int vcu, int G, int tid) {
    LAS float* sc = (LAS float*)lds;
    LAS float* red = (LAS float*)(lds + 65536);
    const int lane = tid & 63, wid = tid >> 6;
#pragma unroll 8
    for (int i = tid; i < NB * DM; i += NTHR) { const int b = i >> 11, k = i & 2047; const float c = b < 4 ? cp[b * DM + k] : cs[(b - 4) * DM + k]; sc[i] = c / (1.0f + __expf(-c)); }
    __syncthreads();
    for (int item = vcu; item < DEPTH * 96; item += G) {
        const int l = item / 96, cbk = item % 96, col0 = cbk * 128 + 2 * lane;
        const float* W = ada_w + (size_t)l * DM * MODW + col0;
        float acc[8][2];
#pragma unroll
        for (int b = 0; b < 8; ++b) { acc[b][0] = 0.f; acc[b][1] = 0.f; }
        const int kbeg = wid * 256;
#pragma unroll 2
        for (int k = kbeg; k < kbeg + 256; k += 4) {
            typedef float f32x2w __attribute__((ext_vector_type(2)));
            f32x2w w[4];
#pragma unroll
            for (int i = 0; i < 4; ++i) w[i] = __builtin_nontemporal_load((const f32x2w*)(W + (size_t)(k + i) * MODW));
#pragma unroll
            for (int b = 0; b < 8; ++b) { const f32x4 s = *(const LAS f32x4*)(sc + b * DM + k);
                acc[b][0] += s.x * w[0].x + s.y * w[1].x + s.z * w[2].x + s.w * w[3].x;
                acc[b][1] += s.x * w[0].y + s.y * w[1].y + s.z * w[2].y + s.w * w[3].y; }
        }
#pragma unroll
        for (int b = 0; b < 8; ++b) { red[(wid * 8 + b) * 128 + 2 * lane] = acc[b][0]; red[(wid * 8 + b) * 128 + 2 * lane + 1] = acc[b][1]; }
        __syncthreads();
        { const int b = tid >> 6, pr = tid & 63; float s0 = 0.f, s1 = 0.f;
#pragma unroll
          for (int w = 0; w < 8; ++w) { s0 += red[(w * 8 + b) * 128 + 2 * pr]; s1 += red[(w * 8 + b) * 128 + 2 * pr + 1]; }
          const int col = cbk * 128 + 2 * pr;
          float* o = MOD + ((size_t)l * NB + b) * MODW + col; o[0] = s0 + ada_b[l * MODW + col]; o[1] = s1 + ada_b[l * MODW + col + 1]; }
        __syncthreads();
    }
}

__device__ __forceinline__ unsigned rot16(unsigned x) { return __builtin_amdgcn_alignbit(x, x, 16); }
__device__ __forceinline__ void filt_item(LAS unsigned char* lds, int L, int tb, const float* w1, const float* b1, const float* f1, const float* w2, const float* b2, const float* f2,
                                          const float* w3, const float* decay, bf16* GFl, int tid) {
    using att::bf16x8; using att::f32x16; using att::u32x4; using att::cvtpk;
    LAS float* feats = (LAS float*)lds;
    LAS float* h1 = feats + 2176;
    LAS float* h2 = h1 + 65 * 64;
    LAS float* hf0 = h2 + 65 * 68;
    const int t0 = 64 * tb; const float invL1 = 1.0f / (float)(L - 1);
    const int GRN = 2 * L / 64 * 72;
    const int lane = tid & 63, wid = __builtin_amdgcn_readfirstlane(tid >> 6), hi = lane >> 5, r32 = lane & 31;
    for (int id = tid; id < 65 * 33; id += NTHR) { const int i = id / 33, f = id % 33; const float t = (float)(t0 + i); float v;
        if (f == 0) v = t * invL1;
        else { const int kb = (f - 1) & 15; const float band = 1e-4f + (float)kb * ((15.0f - 1e-4f) / 15.0f);
            float x = t * band / (float)L; x -= floorf(x); const float a = 6.283185307179586f * x;
            v = (f <= 16) ? __cosf(a) : -__sinf(a); }
        feats[i * 33 + f] = v; }
    __syncthreads();
    for (int id = tid; id < 65 * 64; id += NTHR) { const int i = id >> 6, j = id & 63; float s = b1[j];
#pragma unroll 11
        for (int f = 0; f < 33; ++f) s += feats[i * 33 + f] * w1[f * 64 + j];
        h1[i * 64 + j] = __sinf(f1[j] * s); }
    __syncthreads();
    for (int id = tid; id < 65 * 64; id += NTHR) { const int i = id >> 6, j = id & 63; float s = b2[j];
#pragma unroll 16
        for (int f = 0; f < 64; ++f) s += h1[i * 64 + f] * w2[f * 64 + j];
        h2[i * 68 + j] = __sinf(f2[j] * s); }
    __syncthreads();
    if (tb == 0) {
        for (int cc = tid; cc < 1024; cc += NTHR) { const int col = (cc >> 9) * 1024 + (cc & 511); float s = 0.f;
#pragma unroll 16
            for (int j = 0; j < 64; ++j) s += h2[j] * w3[j * 2048 + col];
            hf0[cc] = s; }
        __syncthreads();
    }
    bf16x8 af[2][2][4];
#pragma unroll
    for (int st = 0; st < 2; ++st)
#pragma unroll
        for (int mb = 0; mb < 2; ++mb)
#pragma unroll
            for (int ks = 0; ks < 4; ++ks) { const LAS float* p = h2 + (st + 32 * mb + r32) * 68 + 16 * ks + 8 * hi;
                const f32x4 x = *(const LAS f32x4*)p, y = *(const LAS f32x4*)(p + 4);
                u32x4 w; w.x = cvtpk(x.x, x.y); w.y = cvtpk(x.z, x.w); w.z = cvtpk(y.x, y.y); w.w = cvtpk(y.z, y.w); af[st][mb][ks] = __builtin_bit_cast(bf16x8, w); }
#pragma unroll 1
    for (int cbi = 0; cbi < 8; ++cbi) {
        const int cb = wid * 8 + cbi, o = cb >> 5, dir = (cb >> 4) & 1, c = (cb & 15) * 32 + r32, col = cb * 32 + r32;
        bf16x8 bfr[4];
#pragma unroll
        for (int ks = 0; ks < 4; ++ks) { float x[8];
#pragma unroll
            for (int j = 0; j < 8; ++j) x[j] = w3[(size_t)(16 * ks + 8 * hi + j) * 2048 + col];
            u32x4 w; w.x = cvtpk(x[0], x[1]); w.y = cvtpk(x[2], x[3]); w.z = cvtpk(x[4], x[5]); w.w = cvtpk(x[6], x[7]); bfr[ks] = __builtin_bit_cast(bf16x8, w); }
        const float dec = fabsf(decay[col]) * invL1;
        bf16* dst = GFl + (size_t)(o * 512 + c) * GRN;
#pragma unroll
        for (int mb = 0; mb < 2; ++mb) {
            f32x16 d = {};
#pragma unroll
            for (int ks = 0; ks < 4; ++ks) d = (dir == 0) ? __builtin_amdgcn_mfma_f32_32x32x16_bf16(af[1][mb][ks], bfr[ks], d, 0, 0, 0)
                                                          : __builtin_amdgcn_mfma_f32_32x32x16_bf16(af[0][mb][ks], bfr[ks], d, 0, 0, 0);
#pragma unroll
            for (int q = 0; q < 16; ++q) { const int mrow = 32 * mb + att::crow(q, hi), t = t0 + mrow + (dir == 0 ? 1 : 0);
                float v = d[q] * __expf(-(float)t * dec);
                if (dir == 0 && t == L) v = 0.f;
                if (dir == 1 && t == 0) v = hf0[o * 512 + c];
                d[q] = v; }
#pragma unroll
            for (int k = 0; k < 2; ++k) {
                const unsigned a0 = cvtpk(d[8 * k + 0], d[8 * k + 1]), a1 = cvtpk(d[8 * k + 2], d[8 * k + 3]), b0 = cvtpk(d[8 * k + 4], d[8 * k + 5]), b1 = cvtpk(d[8 * k + 6], d[8 * k + 7]);
                auto s0 = __builtin_amdgcn_permlane32_swap(a0, b0, false, false); auto s1 = __builtin_amdgcn_permlane32_swap(a1, b1, false, false);
                const unsigned x0 = s0[0], x1 = s1[0], x2 = s0[1], x3 = s1[1];
                const int m0 = 32 * mb + 16 * k + 8 * hi;
                if (dir == 1) { const int ib = L + t0 + m0, ph = (ib >> 6) * 72 + (ib & 63); *(v4u*)(dst + ph) = (v4u){x0, x1, x2, x3}; }
                else { const int ib = L - t0 - m0 - 8, ph = (ib >> 6) * 72 + (ib & 63); *(v4u*)(dst + ph) = (v4u){rot16(x3), rot16(x2), rot16(x1), rot16(x0)}; }
            }
        }
    }
    __syncthreads();
}

__device__ __forceinline__ void ga_tables(const float* n1g, const float* n2g, const float* MODp, float* GA1, float* GA2, int gt, int ngt) {
    for (int i = gt; i < 2 * DEPTH * NB * DM; i += ngt) { const int which = i / (DEPTH * NB * DM), r = i % (DEPTH * NB * DM), l = r / (NB * DM), b = (r / DM) % NB, c = r % DM;
        const float sc = MODp[((size_t)l * NB + b) * MODW + (which ? 4 * DM : DM) + c];
        (which ? GA2 : GA1)[r] = (which ? n2g : n1g)[l * DM + c] * (1.0f + sc); }
}
__device__ __forceinline__ void bvec_item(LAS unsigned char* lds, const float* shp, const bf16* Wt, float* BV, int ldbv, int n0, int tid) {
    LAS float* sb = (LAS float*)lds;
    const int lane = tid & 63, wid = tid >> 6;
#pragma unroll 8
    for (int i = tid; i < NB * DM / 4; i += NTHR) { const int b = i / (DM / 4), k4 = i % (DM / 4); *(LAS f32x4*)(sb + b * DM + 4 * k4) = *(const f32x4*)(shp + (size_t)b * MODW + 4 * k4); }
    __syncthreads();
#pragma unroll 1
    for (int rg = 0; rg < 2; ++rg) { const int nb = n0 + wid * 8 + rg * 4;
        float acc[32];
#pragma unroll
        for (int i = 0; i < 32; ++i) acc[i] = 0.f;
#pragma unroll 1
        for (int j = 0; j < 4; ++j) { float f[4][8];
#pragma unroll
            for (int r = 0; r < 4; ++r) { const v4u w = *(const v4u*)(Wt + (size_t)(nb + r) * DM + 8 * lane + 512 * j); unpack8(w, f[r]); }
#pragma unroll
            for (int b = 0; b < 8; ++b) { const f32x4 s0 = *(const LAS f32x4*)(sb + b * DM + 8 * lane + 512 * j), s1 = *(const LAS f32x4*)(sb + b * DM + 8 * lane + 512 * j + 4);
#pragma unroll
                for (int r = 0; r < 4; ++r)
                    acc[r * 8 + b] += (f[r][0] * s0.x + f[r][1] * s0.y) + (f[r][2] * s0.z + f[r][3] * s0.w) + (f[r][4] * s1.x + f[r][5] * s1.y) + (f[r][6] * s1.z + f[r][7] * s1.w); } }
#pragma unroll
        for (int st = 0; st < 5; ++st) { const int n = 16 >> st, x = 32 >> st; const bool up = (lane & x) != 0;
#pragma unroll
            for (int i = 0; i < n; ++i) { const float keep = up ? acc[i + n] : acc[i], send = up ? acc[i] : acc[i + n]; acc[i] = keep + __shfl_xor(send, x); } }
        const float tot = acc[0] + __shfl_xor(acc[0], 1);
        const int idx = (lane >> 1) & 31;
        const int idxr = ((idx & 16) ? 16 : 0) | ((idx & 8) ? 8 : 0) | ((idx & 4) ? 4 : 0) | ((idx & 2) ? 2 : 0) | (idx & 1);
        if ((lane & 1) == 0) BV[(size_t)(idxr & 7) * ldbv + nb + (idxr >> 3)] = tot;
    }
    __syncthreads();
}
__device__ __forceinline__ void norm0_rows(const float* xa, const float* xb, const float* g, const float* mod, bf16* H, unsigned long long* SS, int gw, int ngw, int lane) {
    for (int ck = gw; ck < NTOK / 4; ck += ngw) {
        const int row0 = ck * 4, b = row_batch(row0);
        const float* xin = row0 < NPR ? xa : xb;
        const float* sc = mod + (size_t)b * MODW + DM;
        f32x4 ga[8];
#pragma unroll
        for (int j = 0; j < 8; ++j) { const int col = 4 * lane + 256 * j; ga[j] = *(const f32x4*)(g + col) * (*(const f32x4*)(sc + col) + 1.0f); }
#pragma unroll 1
        for (int r = 0; r < 4; ++r) {
            const float* xr = xin + (size_t)(row0 + r) * DM;
            f32x4 v[8]; float ss = 0.f;
#pragma unroll
            for (int j = 0; j < 8; ++j) { v[j] = *(const f32x4*)(xr + 4 * lane + 256 * j); ss += (v[j].x * v[j].x + v[j].y * v[j].y) + (v[j].z * v[j].z + v[j].w * v[j].w); }
            ss = wave_sum(ss); if (lane == 0) SS[row0 + r] = (unsigned long long)(ss * 16777216.0f + 0.5f);
            bf16* hr = H + (size_t)(row0 + r) * DM;
#pragma unroll
            for (int j = 0; j < 8; ++j) { const f32x4 o = v[j] * ga[j]; u32x2v w; w.x = pk2(o.x, o.y); w.y = pk2(o.z, o.w);
                *(u32x2v*)(hr + 4 * lane + 256 * j) = w; }
        }
    }
}
#ifndef MK_PHMASK
#define MK_PHMASK 0xFFFFFFFFu
#endif
#define EN(p) (((MK_PHMASK) >> (p)) & 1u)
#ifndef MK_REPEAT
#define MK_REPEAT 0u
#endif
#define REP(p) for (int rep_ = 0; rep_ < 1 + (int)(((MK_REPEAT) >> (p)) & 1u); ++rep_)
constexpr int NPH_LAYER = 10, NPHASE = 2 + DEPTH * NPH_LAYER;
struct Args { const float* in[37]; float* out; unsigned char* ws; int ph_lo, ph_hi; };
static_assert(sizeof(Args) == 39 * 8 + 8, "Args has no padding");

typedef const __attribute__((address_space(4))) Args* KArgs;
__device__ __forceinline__ KArgs kargs() { KArgs p = (KArgs)__builtin_amdgcn_kernarg_segment_ptr(); asm volatile("" : "+s"(p)); return p; }
#define AIN(i) (kargs()->in[i])
__global__ void __launch_bounds__(NTHR, 2) mk_fwd(Args args_unused) {
    extern __shared__ __attribute__((aligned(16))) unsigned char lds_raw[];
    LAS unsigned char* lds = (LAS unsigned char*)lds_raw;
    volatile LAS unsigned* MISC = (volatile LAS unsigned*)(lds + MISC_OFF);
    const int tid0 = threadIdx.x;
#define tid tid_fresh()
#define lane (tid_fresh() & 63)
#define wave (__builtin_amdgcn_readfirstlane(tid_fresh() >> 6))
    const int G0 = gridDim.x; const int bx0 = blockIdx.x; const int vcu0 = (G0 % 8 == 0) ? (bx0 % 8) * (G0 / 8) + bx0 / 8 : bx0;
#define G (sfresh(G0))
#define bx (sfresh(bx0))
#define vcu (sfresh(vcu0))
#define gw (vcu * NWAVES + wave)
#define ngw (G * NWAVES)
    gu32* ctl = (gu32*)(kargs()->ws + WS_CTL);
    for (int u = tid0; u < (LDS_BYTES - LDSCTL_OFF) / 4; u += NTHR) ((LAS unsigned*)(lds + LDSCTL_OFF))[u] = 0u;
    __syncthreads();
#if MK_MULTI
    XcdBarrier bar; bar.bar = (unsigned*)(ctl + CW_BAR); bar.x = 0; bar.st = nullptr;
#define SEAM(k) do { } while (0)
#else
    XcdBarrier bar = xcd_barrier_post((unsigned*)(ctl + CW_BAR), MISC + 8);
#define SEAM(k) do { if (IN(k) && IN((k) + 1)) { xcd_barrier(bar); if ((MK_REPEAT >> 19) & 1u) xcd_barrier(bar); } } while (0)
#endif
    const int lo = kargs()->ph_lo, hi = kargs()->ph_hi;
#define IN(k) (lo <= (k) && (k) < hi)
#define ws (kargs()->ws)
#define MOD ((float*)(ws + WS_MOD))
#define HB ((bf16*)(ws + WS_HB))
#define AFFN ((bf16*)(ws + WS_AFFN))
#define Z ((bf16*)(ws + WS_Z))
#define PROJ ((bf16*)(ws + WS_PROJ))
#define XT ((bf16*)(ws + WS_XT))
#define Y2T ((bf16*)(ws + WS_Y2T))
#define QD ((bf16*)(ws + WS_QD))
#define KVD ((bf16*)(ws + WS_KVD))
#define KMLA ((bf16*)(ws + WS_KMLA))
#define YCAT ((bf16*)(ws + WS_YCAT))
#define OUT (kargs()->out)

#define CONV_DECODE(l_, r_, T) do { const int cl_ = (l_); int r = (r_); \
        if (r < I_IN) T = TrItem{AIN(7) + (size_t)cl_ * DM * INC, (bf16*)(ws + WS_WIN + cl_ * SZ_WIN), DM, INC, 0, r}; \
        else if ((r -= I_IN) < I_QB) T = TrItem{AIN(25) + (size_t)cl_ * 512 * 768, (bf16*)(ws + WS_WQB + cl_ * SZ_WQB), 512, 768, 0, r}; \
        else if ((r -= I_QB) < I_KVB) T = TrItem{AIN(27) + (size_t)cl_ * 256 * 1024, (bf16*)(ws + WS_WKVB + cl_ * SZ_WKVB), 256, 1024, 0, r}; \
        else if ((r -= I_KVB) < I_OUT) T = TrItem{AIN(31) + (size_t)cl_ * DM * DM, (bf16*)(ws + WS_WOUT + cl_ * SZ_WOUT), DM, DM, 0, r}; \
        else if ((r -= I_OUT) < I_UP) { const int n0 = 32 * (r % 352), hf = n0 >= DFF ? 1 : 0, j = n0 - DFF * hf, dest = 256 * (j >> 7) + 128 * hf + (j & 127); \
            T = TrItem{AIN(33) + (size_t)cl_ * DM * DFF2, (bf16*)(ws + WS_WUP + cl_ * SZ_WUP), DM, DFF2, dest - n0, r}; } \
        else { r -= I_UP; T = TrItem{AIN(36) + (size_t)cl_ * DFF * DM, (bf16*)(ws + WS_WDN + cl_ * SZ_WDN), DFF, DM, 0, r}; } } while (0)
#define CONV_STREAM(l_, i0_, i1_, w0_, nw_) do { LAS char* sb_ = (LAS char*)lds + wave * 16384; const int ln_ = lane; \
        int it = (i0_) + (w0_), pb_ = 0; TrItem ta_; \
        if (it < (i1_)) { CONV_DECODE(l_, it, ta_); tr_dma(ta_, ln_, sb_); } \
        while (it < (i1_)) { const int nx_ = it + (nw_); TrItem tb_ = ta_; \
            if (nx_ < (i1_)) { CONV_DECODE(l_, nx_, tb_); tr_dma(tb_, ln_, sb_ + (pb_ ^ 1) * 8192); asm volatile("s_waitcnt vmcnt(8)" ::: "memory"); }     \
            else asm volatile("s_waitcnt vmcnt(0)" ::: "memory"); \
            tr_out(ta_, ln_, (const LAS float*)(sb_ + pb_ * 8192)); \
            ta_ = tb_; pb_ ^= 1; it = nx_; } \
        VM_WAIT(); } while (0)
#define CONV_TAIL(S_, l_, i0_, i1_) do { if ((l_) < DEPTH) { const int rem_ = (S_).nwg % G; if (rem_ == 0 || bx >= rem_) { \
        VM_WAIT(); __syncthreads(); \
        CONV_STREAM(l_, i0_, i1_, (rem_ == 0 ? bx : bx - rem_) * NWAVES + wave, (rem_ == 0 ? G : G - rem_) * NWAVES); } } } while (0)

    if (EN(0) && IN(0)) REP(0) {
        REP(21) mod_phase(lds, AIN(2), AIN(3), AIN(4), AIN(5), MOD, vcu, G, tid);
        REP(22) for (int item = (vcu + G / 2) % G; item < DEPTH * 96; item += G) {     const int l = item / 96, r = item % 96; const int L = r < 32 ? LP : LS, tb = r < 32 ? r : r - 32;
            bf16* GFl = (bf16*)(ws + WS_GF + (size_t)l * SZ_GF + (r < 32 ? 0 : SZ_GF_P));
            filt_item(lds, L, tb, AIN(13) + (size_t)l * 33 * 64, AIN(14) + l * 64, AIN(15) + l * 64, AIN(16) + (size_t)l * 4096, AIN(17) + l * 64, AIN(18) + l * 64,
                      AIN(19) + (size_t)l * 64 * 2048, AIN(20) + (size_t)l * 2048, GFl, tid); }
        __syncthreads();
        REP(23) CONV_STREAM(0, 0, I_L, gw, ngw);
        for (int i = vcu * NTHR + tid; i < DEPTH * (INCP - INC) * (DM / 8); i += G * NTHR) { const int l = i / ((INCP - INC) * (DM / 8)), r = i % ((INCP - INC) * (DM / 8));
            *(v4u*)(ws + WS_WIN + l * SZ_WIN + ((size_t)INC * DM + (size_t)r * 8) * 2) = (v4u){0u, 0u, 0u, 0u}; }
        VM_WAIT(); __syncthreads();
    }
    SEAM(0);

    if (EN(1) && IN(1)) REP(1) {
        ga_tables(AIN(6), AIN(32), MOD, (float*)(ws + WS_GA1), (float*)(ws + WS_GA2), vcu * NTHR + tid, G * NTHR);
        for (int it = vcu; it < 248; it += G) { const int l = 0, r = it;
            if (r < 72) bvec_item(lds, MOD + (size_t)l * NB * MODW, (const bf16*)(ws + WS_WIN + l * SZ_WIN), (float*)(ws + WS_BV1) + (size_t)l * NB * INCP, INCP, r * 64, tid);
            else bvec_item(lds, MOD + (size_t)l * NB * MODW + 3 * DM, (const bf16*)(ws + WS_WUP + l * SZ_WUP), (float*)(ws + WS_BV2) + (size_t)l * NB * DFF2, DFF2, (r - 72) * 64, tid); }
        norm0_rows(AIN(0), AIN(1) - (size_t)NPR * DM, AIN(6), MOD, HB, (unsigned long long*)(ws + WS_SSQ1), gw, ngw, lane);
    }
    SEAM(1);

#pragma unroll 1
    for (int l = 0; l < DEPTH; ++l) {
        const int pb = 2 + l * NPH_LAYER;
#define xa ((l == 0) ? AIN(0) : OUT)
#define xb ((l == 0) ? (AIN(1) - (size_t)NPR * DM) : OUT)
#define modl (MOD + (size_t)l * NB * MODW)
        if (EN(2) && IN(pb + 0)) REP(2) {
            pg8::Gemm g{HB, (const bf16*)(ws + WS_WIN + l * SZ_WIN), NTOK, INCP, DM, DM, DM}; pg8::StaticOrder S; S.init(NTOK, INCP, G, bx);
            LAS float* rst = (LAS float*)(lds + TAB_OFF); LAS float* bvt = rst + 8 * 256;
            pg8::fill_tabs(S, (const unsigned long long*)(ws + WS_SSQ1), (const float*)(ws + WS_BV1) + (size_t)l * NB * INCP, INCP, rst, bvt, tid);
            pg8::EpiBf E{PROJ, INCP, 4, rst, bvt, 0};
            pg8::gemm_phase<pg8::EpiBf, pg8::StaticOrder, true, true>(lds, g, S, E);
            CONV_TAIL(S, l + 1, 0, I_A);
        }
        SEAM(pb + 0);
        if (EN(3) && IN(pb + 1)) {
            for (int i = vcu * NTHR + tid; i < NTOK; i += G * NTHR) ((unsigned long long*)(ws + WS_SSQ1))[i] = 0ull;
            REP(20) post_rows(PROJ, AIN(8) + l * 512, AIN(22) + l * 128, AIN(23) + l * 128, AIN(24) + l * 512, AIN(26) + l * 256, gw, ngw, lane, rep_ == (int)((MK_REPEAT >> 20) & 1u));
            REP(3) for (int t = vcu; t < (NTOK / 64) * 3; t += G) hyconv_tile(lds, PROJ, XT, AIN(11) + (size_t)l * 3 * 1536, AIN(12) + l * 1536, t, tid);
        }
        SEAM(pb + 1);
        if (EN(4) && IN(pb + 2)) REP(4) {
            { pg8::Gemm g{PROJ + C_D, (const bf16*)(ws + WS_WQB + l * SZ_WQB), NTOK, 768, 512, INCP, 512}; pg8::StaticOrder S; S.init(NTOK, 768, G, bx);
              pg8::EpiBf E{QD, 768, 0, nullptr, nullptr, 0};
              pg8::gemm_phase<pg8::EpiBf, pg8::StaticOrder, true, true>(lds, g, S, E); }
            { pg8::Gemm g{PROJ + C_D + 512, (const bf16*)(ws + WS_WKVB + l * SZ_WKVB), NTOK, 1024, 256, INCP, 256}; pg8::StaticOrder S; S.init(NTOK, 1024, G, (bx + G / 2) % G);
              pg8::EpiBf E{KVD, 1024, 0, nullptr, nullptr, 0};
              pg8::gemm_phase<pg8::EpiBf, pg8::StaticOrder, true, true>(lds, g, S, E); }
        }
        SEAM(pb + 2);
        if (EN(5) && IN(pb + 3)) {
            REP(5) mla_rows(QD, KVD, PROJ, KMLA, AIN(28) + l * 192, AIN(29) + l * 192, gw, ngw, lane, rep_ == (int)((MK_REPEAT >> 5) & 1u));
        }
        SEAM(pb + 3);
        if (EN(6) && IN(pb + 4)) {
            if (EN(13)) REP(13) for (int u = vcu; u < 256; u += G) { const int bh = u >> 4, qb = u & 15, b = 4 + (bh >> 2), h = bh & 3; const size_t r0 = batch_row0(b);
                att::attn_body16<192, 768, 768, 1024, DM>(QD + (r0 + qb * 256) * 768 + h * 192, KMLA + r0 * 768 + h * 192, KVD + r0 * 1024 + h * 256 + 128,
                                      YCAT + (r0 + qb * 256) * DM + 1536 + h * 128, LS, (char*)lds_raw); }
            if (EN(14)) REP(14) for (int u = vcu; u < 256; u += G) { const int bh = u >> 4, qb = u & 15, b = 4 + (bh >> 2), h = bh & 3; const size_t r0 = batch_row0(b);
                att::attn_body16<128, INCP, INCP, INCP, DM>(PROJ + (r0 + qb * 256) * INCP + C_C + h * 128, PROJ + r0 * INCP + C_C + 512 + (h >> 1) * 128, PROJ + r0 * INCP + C_C + 768 + (h >> 1) * 128,
                                      YCAT + (r0 + qb * 256) * DM + 1024 + h * 128, LS, (char*)lds_raw); }
            if (EN(15)) REP(15) for (int u = vcu; u < 256; u += G)
                hy::hyena_unit<LS>((LAS char*)lds, (const bf16*)(ws + WS_GF + (size_t)l * SZ_GF + SZ_GF_P), XT, XT + (size_t)NTOK * 512, XT + (size_t)2 * NTOK * 512, Y2T, AIN(21) + l * 1024, 4, 2 * u);
            REP(17) for (int i = vcu; i < 256; i += G) { const int u = i & 127, bh = u >> 3, qb = u & 7, b = bh >> 2, h = bh & 3; const size_t r0 = batch_row0(b);
                if (i < 128) { if (EN(13))
                    att::attn_body16<192, 768, 768, 1024, DM>(QD + (r0 + qb * 256) * 768 + h * 192, KMLA + r0 * 768 + h * 192, KVD + r0 * 1024 + h * 256 + 128,
                                          YCAT + (r0 + qb * 256) * DM + 1536 + h * 128, LP, (char*)lds_raw); }
                else if (EN(14))
                    att::attn_body16<128, INCP, INCP, INCP, DM>(PROJ + (r0 + qb * 256) * INCP + C_C + h * 128, PROJ + r0 * INCP + C_C + 512 + (h >> 1) * 128, PROJ + r0 * INCP + C_C + 768 + (h >> 1) * 128,
                                          YCAT + (r0 + qb * 256) * DM + 1024 + h * 128, LP, (char*)lds_raw); }
            if (EN(15)) REP(18) for (int i = (G == 256) ? (vcu + 128) % 256 : vcu; i < 128; i += G)
                hy::hyena_unit<LP>((LAS char*)lds, (const bf16*)(ws + WS_GF + (size_t)l * SZ_GF), XT, XT + (size_t)NTOK * 512, XT + (size_t)2 * NTOK * 512, Y2T, AIN(21) + l * 1024, 0, 4 * i);
            if (EN(16)) REP(16) {
                if (G == 256) { const int v_ = vcu;
                    if (v_ < 128) { for (int u = v_; u < 768; u += 128) gmlp_unit((char*)lds_raw, PROJ, YCAT, AIN(9) + (size_t)l * 4 * 16384, AIN(10) + l * 512, u, tid); } }
                else for (int u = vcu; u < 768; u += G) gmlp_unit((char*)lds_raw, PROJ, YCAT, AIN(9) + (size_t)l * 4 * 16384, AIN(10) + l * 512, u, tid); }
            VM_WAIT(); __syncthreads();
        }
        SEAM(pb + 4);
        if (EN(7) && IN(pb + 5)) REP(7) { for (int t = vcu; t < NTOK / 32; t += G) gnorm_tile(lds, YCAT, Y2T, AIN(30) + l * DM, HB, t, tid); }
        SEAM(pb + 5);
        if (EN(8) && IN(pb + 6)) {
            pg8::Gemm g{HB, (const bf16*)(ws + WS_WOUT + l * SZ_WOUT), NTOK, DM, DM, DM, DM}; pg8::StaticOrder S; S.init(NTOK, DM, G, bx);
            if (l == 0) { pg8::EpiResidT<false, true> E{AIN(0), AIN(1) - (size_t)NPR * DM, OUT, modl + 2 * DM, (bf16*)(ws + WS_HB2), (const float*)(ws + WS_GA2) + (size_t)l * NB * DM, (unsigned long long*)(ws + WS_SSQ2)};
                pg8::gemm_phase<pg8::EpiResidT<false, true>, pg8::StaticOrder, true, true>(lds, g, S, E); }
            else { pg8::EpiResidT<true, true> E{OUT, OUT, (l + 1 == DEPTH) ? (void*)(ws + WS_XRES) : (void*)OUT, modl + 2 * DM, (bf16*)(ws + WS_HB2), (const float*)(ws + WS_GA2) + (size_t)l * NB * DM, (unsigned long long*)(ws + WS_SSQ2)};
                pg8::gemm_phase<pg8::EpiResidT<true, true>, pg8::StaticOrder, true, true>(lds, g, S, E); }
        }
        SEAM(pb + 6);
        if (EN(10) && IN(pb + 7)) REP(10) {
            pg8::Gemm g{(const bf16*)(ws + WS_HB2), (const bf16*)(ws + WS_WUP + l * SZ_WUP), NTOK, DFF2, DM, DM, DM}; pg8::StaticOrder S; S.init(NTOK, DFF2, G, bx);
            LAS float* rst = (LAS float*)(lds + TAB_OFF);
            pg8::fill_tabs(S, (const unsigned long long*)(ws + WS_SSQ2), nullptr, 0, rst, rst, tid);
            pg8::EpiGate E{AFFN, (float*)(ws + WS_R1), AIN(34) + (size_t)l * 3 * DFF2, AIN(35) + l * DFF2, (LAS float*)(lds + HALO_OFF), rst, (const float*)(ws + WS_BV2) + (size_t)l * NB * DFF2, 0};
            pg8::gemm_phase<pg8::EpiGate, pg8::StaticOrder, true, true>(lds, g, S, E);
            CONV_TAIL(S, l + 1, I_A, I_L);
        }
        SEAM(pb + 7);
        if (EN(11) && IN(pb + 8)) for (int i = vcu * NTHR + tid; i < NTOK; i += G * NTHR) ((unsigned long long*)(ws + WS_SSQ2))[i] = 0ull;
        if (EN(11) && IN(pb + 8)) REP(11) gate_fix((const float*)(ws + WS_R1), AFFN, AIN(34) + (size_t)l * 3 * DFF2, AIN(35) + l * DFF2, vcu * NTHR + tid, G * NTHR);
        if (EN(11) && IN(pb + 8) && l + 1 < DEPTH) for (int it = vcu; it < 248; it += G) { const int l1 = l + 1, r = it;
            if (r < 72) bvec_item(lds, MOD + (size_t)l1 * NB * MODW, (const bf16*)(ws + WS_WIN + l1 * SZ_WIN), (float*)(ws + WS_BV1) + (size_t)l1 * NB * INCP, INCP, r * 64, tid);
            else bvec_item(lds, MOD + (size_t)l1 * NB * MODW + 3 * DM, (const bf16*)(ws + WS_WUP + l1 * SZ_WUP), (float*)(ws + WS_BV2) + (size_t)l1 * NB * DFF2, DFF2, (r - 72) * 64, tid); }
        SEAM(pb + 8);
        if (EN(12) && IN(pb + 9)) {
            pg8::Gemm g{AFFN, (const bf16*)(ws + WS_WDN + l * SZ_WDN), NTOK, DM, DFF, DFF, DFF}; pg8::StaticOrder S; S.init(NTOK, DM, G, bx);
            if (l + 1 < DEPTH) { pg8::EpiResidT<true, true> E{OUT, OUT, OUT, modl + 5 * DM, HB, (const float*)(ws + WS_GA1) + (size_t)(l + 1) * NB * DM, (unsigned long long*)(ws + WS_SSQ1)};
                pg8::gemm_phase<pg8::EpiResidT<true, true>, pg8::StaticOrder, true, true, true, false>(lds, g, S, E); }
            else { pg8::EpiResidT<true, false> E{(const void*)(ws + WS_XRES), (const void*)(ws + WS_XRES), OUT, modl + 5 * DM, nullptr, nullptr, nullptr};
                pg8::gemm_phase<pg8::EpiResidT<true, false>, pg8::StaticOrder, true, true, true, false>(lds, g, S, E); }
        }
        if (l + 1 < DEPTH) SEAM(pb + 9);
    }
#undef xa
#undef xb
#undef modl
#undef G
#undef bx
#undef vcu
#undef ngw
#undef IN
#undef SEAM
#undef tid
#undef lane
#undef wave
#undef gw
#undef ws
#undef MOD
#undef HB
#undef AFFN
#undef Z
#undef PROJ
#undef XT
#undef Y2T
#undef QD
#undef KVD
#undef KMLA
#undef YCAT
#undef OUT
}

extern "C" void kernel_launch(void* const* d_in, const int* in_sizes, int n_in, void* d_out, int out_size, void* d_ws, size_t ws_size, hipStream_t stream) {
    static int grid = 0;
    if (grid == 0) {
        if (n_in != 37 || out_size != NTOK * DM || ws_size < WS_END) { fprintf(stderr, "kernel_launch: shape mismatch (n_in %d out %d ws %zu need %zu)\n", n_in, out_size, ws_size, (size_t)WS_END); grid = -1; return; }
        int dev = 0, cus = 0, per_cu = 0;
        if (hipGetDevice(&dev) != hipSuccess || hipDeviceGetAttribute(&cus, hipDeviceAttributeMultiprocessorCount, dev) != hipSuccess) { grid = -1; return; }
        if (hipFuncSetAttribute((const void*)mk_fwd, hipFuncAttributeMaxDynamicSharedMemorySize, LDS_BYTES) != hipSuccess) { fprintf(stderr, "kernel_launch: hipFuncSetAttribute failed\n"); grid = -1; return; }
        if (hipOccupancyMaxActiveBlocksPerMultiprocessor(&per_cu, (const void*)mk_fwd, NTHR, LDS_BYTES) != hipSuccess || per_cu < 1)
            fprintf(stderr, "kernel_launch: occupancy query reports %d workgroups per CU\n", per_cu);
        (void)hipGetLastError();
        grid = cus;
        if (grid > 256) grid = 256;
    }
    if (grid < 0) return;
    if (hipMemsetAsync((char*)d_ws + WS_CTL, 0, CTL_ZERO_BYTES, stream) != hipSuccess) { fprintf(stderr, "kernel_launch: memset failed\n"); return; }
    Args a{};
    for (int i = 0; i < 37; ++i) a.in[i] = (const float*)d_in[i];
    a.out = (float*)d_out; a.ws = (unsigned char*)d_ws;
#if MK_MULTI
    for (int p = 0; p < NPHASE; ++p) { a.ph_lo = p; a.ph_hi = p + 1; hipLaunchKernelGGL(mk_fwd, dim3(grid), dim3(NTHR), LDS_BYTES, stream, a); }
#else
    a.ph_lo = 0; a.ph_hi = NPHASE;
    hipLaunchKernelGGL(mk_fwd, dim3(grid), dim3(NTHR), LDS_BYTES, stream, a);
#endif
    const hipError_t le = hipPeekAtLastError();
    if (le != hipSuccess) fprintf(stderr, "kernel_launch: launch failed: %s\n", hipGetErrorName(le));
}
```

```cpp
#include <hip/hip_runtime.h>
#include <hip/hip_bf16.h>
#include <cstdio>
#include <cstdint>
#include <cmath>

#ifndef MK_MULTI
#define MK_MULTI 0
#endif

constexpr int DM = 2048, NTOK = 24576, NPR = 8192  , LP = 2048, LS = 4096, DEPTH = 4, NB = 8  ;
constexpr int INC = 4416, INCP = 4608;
constexpr int C_A = 0, C_B = 1024, C_C = 2560, C_D = 3584;
constexpr int DFF = 5632, DFF2 = 11264;
constexpr int MODW = 6 * DM;
constexpr float EPS = 1e-6f;
constexpr int NWAVES = 8, NTHR = 512;

constexpr size_t MiB = 1u << 20;
constexpr size_t WS_CTL = 0, CTL_ZERO_BYTES = 512 * 1024;
constexpr size_t WS_SSQ1 = 65536, WS_SSQ2 = WS_SSQ1 + (size_t)NTOK * 8;
static_assert(WS_SSQ2 + (size_t)NTOK * 8 <= CTL_ZERO_BYTES, "ssq inside the memset");
constexpr size_t WS_MOD = 1 * MiB;
constexpr size_t WS_GA1 = 2 * MiB + 512 * 1024;
constexpr size_t WS_GA2 = WS_GA1 + 256 * 1024;
constexpr size_t WS_BV1 = 3 * MiB;
constexpr size_t WS_BV2 = 4 * MiB;
constexpr size_t WS_WIN = 6 * MiB;
constexpr size_t SZ_WIN = (size_t)INCP * DM * 2;
constexpr size_t WS_WQB = WS_WIN + DEPTH * SZ_WIN;
constexpr size_t SZ_WQB = (size_t)768 * 512 * 2;
constexpr size_t WS_WKVB = WS_WQB + DEPTH * SZ_WQB;
constexpr size_t SZ_WKVB = (size_t)1024 * 256 * 2;
constexpr size_t WS_WOUT = WS_WKVB + DEPTH * SZ_WKVB;
constexpr size_t SZ_WOUT = (size_t)DM * DM * 2;
constexpr size_t WS_WUP = WS_WOUT + DEPTH * SZ_WOUT;
constexpr size_t SZ_WUP = (size_t)DFF2 * DM * 2;
constexpr size_t WS_WDN = WS_WUP + DEPTH * SZ_WUP;
constexpr size_t SZ_WDN = (size_t)DM * DFF * 2;
constexpr size_t WS_GF = WS_WDN + DEPTH * SZ_WDN;
constexpr size_t SZ_GF_P = (size_t)2 * 512 * 4608 * 2, SZ_GF_S = (size_t)2 * 512 * 9216 * 2, SZ_GF = SZ_GF_P + SZ_GF_S;
constexpr size_t WS_HB = WS_GF + DEPTH * SZ_GF;
constexpr size_t WS_HB2 = WS_HB + (size_t)NTOK * DM * 2;
constexpr size_t WS_AFFN = WS_HB2 + (size_t)NTOK * DM * 2;
constexpr size_t WS_R1 = WS_AFFN + (size_t)NTOK * DFF * 2;
constexpr size_t WS_Z = WS_R1;
constexpr size_t WS_PROJ = WS_R1;
constexpr size_t WS_XT = WS_PROJ + (size_t)NTOK * INCP * 2;
constexpr size_t SZ_XT1 = (size_t)NTOK * 512 * 2;
constexpr size_t WS_Y2T = WS_XT + 3 * SZ_XT1;
constexpr size_t WS_QD = WS_Y2T + SZ_XT1;
constexpr size_t WS_KVD = WS_QD + (size_t)NTOK * 768 * 2;
constexpr size_t WS_KMLA = WS_KVD + (size_t)NTOK * 1024 * 2;
constexpr size_t WS_YCAT = WS_KMLA + (size_t)NTOK * 768 * 2;
constexpr size_t WS_XRES = WS_R1 + 64 * MiB;
constexpr size_t WS_END = WS_R1 + (size_t)NTOK * DFF2 * 2;
static_assert(WS_YCAT + (size_t)NTOK * DM * 2 <= WS_END, "mixer buffers fit under Z");
static_assert(WS_BV2 + (size_t)DEPTH * NB * DFF2 * 4 <= WS_WIN, "ws map");
constexpr int CW_BAR = 4096;

__host__ __device__ __forceinline__ size_t xt_off(int b, int c) { return b < 4 ? ((size_t)(b * 512 + c) * LP) : ((size_t)4 * 512 * LP + (size_t)((b - 4) * 512 + c) * LS); }
__host__ __device__ __forceinline__ int row_batch(int row) { return row < NPR ? (row >> 11) : 4 + ((row - NPR) >> 12); }
__host__ __device__ __forceinline__ int row_pos(int row) { return row < NPR ? (row & (LP - 1)) : ((row - NPR) & (LS - 1)); }
__host__ __device__ __forceinline__ int batch_row0(int b) { return b < 4 ? b * LP : NPR + (b - 4) * LS; }
__host__ __device__ __forceinline__ int batch_len(int b) { return b < 4 ? LP : LS; }

__host__ __device__ __forceinline__ size_t affn_off(int row, int j) { return ((((size_t)(row >> 8) * (DFF / 64) + (j >> 6)) * 256 + (row & 255)) << 6) + (j & 63); }

constexpr int RING_BYTES = 131072;
constexpr int LDSCTL_OFF = RING_BYTES, MISC_OFF = LDSCTL_OFF + 320, HALO_OFF = RING_BYTES + 1024;
constexpr int TAB_OFF = HALO_OFF + 8192 + 1024, TAB_BYTES = 17408;
constexpr int LDS_BYTES = 161792;
#define GAS __attribute__((address_space(1)))
#define LAS __attribute__((address_space(3)))
typedef unsigned short bf16;
typedef unsigned v4u __attribute__((ext_vector_type(4)));
typedef float f32x4 __attribute__((ext_vector_type(4)));
typedef short bf16x8 __attribute__((ext_vector_type(8)));
typedef GAS unsigned gu32;
typedef GAS unsigned long long gu64;
#define RLX_AGENT __ATOMIC_RELAXED, __HIP_MEMORY_SCOPE_AGENT
#define LDS_WAIT() asm volatile("s_waitcnt lgkmcnt(0)" ::: "memory")
#define VM_WAIT() asm volatile("s_waitcnt vmcnt(0)" ::: "memory")
__device__ __forceinline__ int tid_fresh() { int t = threadIdx.x; asm volatile("" : "+v"(t)); return t; }
__device__ __forceinline__ int sfresh(int v) { asm volatile("" : "+s"(v)); return v; }
__device__ __forceinline__ unsigned long long rt() { return __builtin_amdgcn_s_memrealtime(); }
__device__ __forceinline__ unsigned f2bf(float f) { unsigned u = __builtin_bit_cast(unsigned, f); return (u + 0x7fffu + ((u >> 16) & 1u)) >> 16; }
__device__ __forceinline__ unsigned pk2(float lo, float hi) { return f2bf(lo) | (f2bf(hi) << 16); }
#define XB_TMO      128
#define XB_XCNT(j)  (256  + 64 * (j))
#define XB_XSUB(j)  (1280 + 64 * (j))
#define XB_XGEN(j)  (2304 + 64 * (j))
#define XB_TOP      3328
#define XB_TOPGEN   3392
#define XCD_BAR_WORDS 3456
#define XB_SPIN_CAP (1u << 18)

__device__ __forceinline__ unsigned xb_ld(unsigned* p)              { return __hip_atomic_load(p, __ATOMIC_RELAXED, __HIP_MEMORY_SCOPE_AGENT); }
__device__ __forceinline__ unsigned xb_add(unsigned* p, unsigned v) { return __hip_atomic_fetch_add(p, v, __ATOMIC_RELAXED, __HIP_MEMORY_SCOPE_AGENT); }
__device__ __forceinline__ unsigned xb_xcc_id() { return (unsigned)__builtin_amdgcn_s_getreg((3 << 11) | 20) & 0xFu; }
#define XB_SPIN(cond, bar) do { unsigned _sp = 0; while (cond) { __builtin_amdgcn_s_sleep(1); \
    if ((++_sp & 255u) == 0u) { if (xb_ld(&(bar)[XB_TMO])) break; if (_sp > XB_SPIN_CAP) { atomicAdd(&(bar)[XB_TMO], 1u); break; } } } } while (0)

struct XcdBarrier {
    unsigned* bar; unsigned x;
    volatile LAS unsigned* st;
};

__device__ __forceinline__ XcdBarrier xcd_barrier_post(unsigned* bar, volatile LAS unsigned* st) {
    XcdBarrier b; b.bar = bar; b.x = xb_xcc_id(); b.st = st;
    if (threadIdx.x == 0) (void)xb_add(&bar[XB_XCNT(b.x)], 1u);
    return b;
}
__device__ __forceinline__ void xcd_barrier_complete(unsigned* bar, unsigned x, unsigned& nloc, unsigned& nx) {
    const unsigned G = gridDim.x * gridDim.y * gridDim.z;
    unsigned sum, cnt, mine, sp = 0u;
    for (;;) {
        sum = 0u; cnt = 0u; mine = 0u;
#pragma unroll
        for (unsigned j = 0; j < 16; ++j) { const unsigned c = xb_ld(&bar[XB_XCNT(j)]); sum += c; cnt += (c > 0u) ? 1u : 0u; mine = (j == x) ? c : mine; }
        if (sum == G) break;
        __builtin_amdgcn_s_sleep(1);
        if ((++sp & 255u) == 0u) { if (xb_ld(&bar[XB_TMO])) break; if (sp > XB_SPIN_CAP) { atomicAdd(&bar[XB_TMO], 1u); break; } }
    }
    nloc = mine > 0u ? mine : 1u; nx = cnt > 0u ? cnt : 1u;
}

__device__ __forceinline__ void xcd_barrier(const XcdBarrier& b) {
    asm volatile("s_waitcnt vmcnt(0)" ::: "memory");
    __syncthreads();
    if (threadIdx.x == 0) {
        unsigned* bar = b.bar;
        __builtin_amdgcn_s_waitcnt(0);
        unsigned nloc = b.st[0], nx = b.st[1];
        if (nloc == 0u) { xcd_barrier_complete(bar, b.x, nloc, nx); b.st[0] = nloc; b.st[1] = nx; }
        const unsigned old = xb_add(&bar[XB_XSUB(b.x)], 1u);
        const unsigned gen = old / nloc;
        if (old + 1u == (gen + 1u) * nloc) {
            __builtin_amdgcn_fence(__ATOMIC_RELEASE, "agent");
            asm volatile("s_waitcnt vmcnt(0)" ::: "memory");
            const unsigned og = xb_add(&bar[XB_TOP], 1u);
            const unsigned tg = og / nx;
            if (og + 1u == (tg + 1u) * nx) xb_add(&bar[XB_TOPGEN], 1u);
            else XB_SPIN(xb_ld(&bar[XB_TOPGEN]) == tg, bar);
            __builtin_amdgcn_fence(__ATOMIC_ACQUIRE, "agent");
            xb_add(&bar[XB_XGEN(b.x)], 1u);
            asm volatile("s_waitcnt vmcnt(0)" ::: "memory");
        } else {
            XB_SPIN(xb_ld(&bar[XB_XGEN(b.x)]) == gen, bar);
            __builtin_amdgcn_fence(__ATOMIC_ACQUIRE, "agent");
            asm volatile("s_waitcnt vmcnt(0)" ::: "memory");
        }
    }
    __syncthreads();
}
namespace pg8 {
#define PG8_LAS __attribute__((address_space(3)))
typedef unsigned short bf16_t;
typedef short bf16x8 __attribute__((ext_vector_type(8)));
typedef float f32x4 __attribute__((ext_vector_type(4)));
typedef unsigned u32x4 __attribute__((ext_vector_type(4)));
constexpr int BM = 256, BK = 64, HALF = 128, HTB = HALF * BK * 2  , STAGE_BYTES = 8 * HTB, NXCD = 8, WGM = 4;

__host__ __device__ __forceinline__ int lds_byte(int r, int c) { const int st = (r >> 4) * 2 + (c >> 5), rr = r & 15, cc = c & 31, ob = rr * 64 + cc * 2; return st * 1024 + (ob ^ (((ob >> 9) & 1) << 5)); }
__host__ __device__ __forceinline__ void stage_rc(int b, int& R, int& C) { const int st = b / 1024, sb = b % 1024, swz = sb ^ (((sb >> 9) & 1) << 5); R = (st >> 1) * 16 + swz / 64; C = (st & 1) * 32 + (swz % 64) / 2; }
__host__ __device__ __forceinline__ int perm32(int rho) { const int n = rho >> 4, i = rho & 15; return 8 * (i >> 2) + 4 * n + (i & 3); }

struct Unit { int pm, pn; };
struct Gemm { const bf16_t* A; const bf16_t* Bt; int M, N, K, lda, ldb; };

struct StaticOrder {
    int nM, nN, nwg, G, c;
    __host__ __device__ void init(int M, int N, int G_, int c_) { nM = M / BM; nN = N / BM; nwg = nM * nN; G = G_; c = c_; }
    __host__ __device__ bool next(int i, Unit& u) const {
        const long L = (long)i * G + c; if (L >= nwg) return false;
        int wgid = (int)L; { const int q = nwg / NXCD, r = nwg % NXCD, xcd = wgid % NXCD, off = wgid / NXCD; wgid = (xcd < r ? xcd * (q + 1) : r * (q + 1) + (xcd - r) * q) + off; }
        const int nig = WGM * nN, gid = wgid / nig, fm = gid * WGM, gsz = (nM - fm) < WGM ? (nM - fm) : WGM;
        u.pm = fm + ((wgid % nig) % gsz); u.pn = (wgid % nig) / gsz; return true;
    }
    __device__ __forceinline__ void a_ready(const Unit&) const {}
    __device__ __forceinline__ void done(const Unit&) const {}
};

__device__ __forceinline__ unsigned cvt_pk_bf16(float lo, float hi) { unsigned r; asm volatile("v_cvt_pk_bf16_f32 %0, %1, %2" : "=v"(r) : "v"(lo), "v"(hi)); return r; }
typedef float f32x2 __attribute__((ext_vector_type(2)));
__device__ __forceinline__ f32x2 gelu_pk(f32x2 v) {
    const f32x2 av = __builtin_elementwise_abs(v), d = av * 0.2316418882f + 1.0f;
    f32x2 t; t.x = __builtin_amdgcn_rcpf(d.x); t.y = __builtin_amdgcn_rcpf(d.y);
    f32x2 q = t * 0.5307027145f + (-0.7265760135f); q = q * t + 0.7107068705f; q = q * t + (-0.142248368f); q = q * t + 0.127414796f; q = q * t;
    const f32x2 s = (v * v) * (-0.72134752044f);
    f32x2 e; e.x = __builtin_amdgcn_exp2f(s.x); e.y = __builtin_amdgcn_exp2f(s.y);
    const f32x2 m = v * (q * e), r = v - m;
    f32x2 o; o.x = v.x < 0.f ? m.x : r.x; o.y = v.y < 0.f ? m.y : r.y; return o;
}

template <class Epi, class Sched, bool ALIGN_EPI = false, bool SP2 = false, bool BLKA = false, bool BLKB = false>
__device__ __forceinline__ void gemm_phase(PG8_LAS unsigned char* lds, const Gemm g, const Sched& S, const Epi& E) {
    const int tid = tid_fresh(), wid = __builtin_amdgcn_readfirstlane(tid >> 6), lane = tid & 63, wr = wid >> 2, wc = wid & 3, fr = lane & 15, fq = lane >> 4;
    const int K = g.K, nt = K / BK;
    unsigned voffA[2], voffB[2];
#pragma unroll
    for (int i = 0; i < 2; ++i) { int R, C; stage_rc(tid * 16 + i * 8192, R, C); const int Rb = Epi::PERM ? ((R & ~31) + perm32(R & 31)) : R;
        const int Ra = Epi::AROWPERM ? ((R & ~63) | (4 * (R & 15) + ((R >> 4) & 3))) : R;
        voffA[i] = (unsigned)(Ra * (BLKA ? BK : g.lda) + C) * 2u; voffB[i] = (unsigned)(Rb * (BLKB ? BK : g.ldb) + C) * 2u; }
    const size_t kstepA = BLKA ? (size_t)BM * BK * 2 : (size_t)(BK * 2), kstepB = BLKB ? (size_t)BM * BK * 2 : (size_t)(BK * 2);
    const size_t hstepA = BLKA ? (size_t)HALF * BK * 2 : (size_t)HALF * g.lda * 2, hstepB = BLKB ? (size_t)HALF * BK * 2 : (size_t)HALF * g.ldb * 2;
    const size_t tstepA = BLKA ? (size_t)nt * BM * BK * 2 : 2 * hstepA, tstepB = BLKB ? (size_t)nt * BM * BK * 2 : 2 * hstepB;
    const unsigned ldsw = (unsigned)wid * 1024u;
    const int aoff = lds_byte(wr * 64 + fr, fq * 8), boff = lds_byte(wc * 32 + fr, fq * 8);
#define PG8_SA(b, h) (((b) * 2 + (h)) * HTB)
#define PG8_SB(b, h) ((4 + (b) * 2 + (h)) * HTB)
#define PG8_STAGE(bufoff, gbase, voff) do { _Pragma("unroll") for (int _i = 0; _i < 2; ++_i) \
        __builtin_amdgcn_global_load_lds((const unsigned*)((const char*)(gbase) + (voff)[_i]), (PG8_LAS unsigned*)(lds + (bufoff) + ldsw + _i * 8192), 16, 0, 0); } while (0)
#define PG8_LDA(dst, b, h) do { _Pragma("unroll") for (int m = 0; m < 4; ++m) _Pragma("unroll") for (int k = 0; k < 2; ++k) dst[m][k] = *(const PG8_LAS bf16x8*)(lds + PG8_SA(b, h) + aoff + m * 2048 + k * 1024); } while (0)
#define PG8_LDB(dst, b, h) do { _Pragma("unroll") for (int n = 0; n < 2; ++n) _Pragma("unroll") for (int k = 0; k < 2; ++k) dst[n][k] = *(const PG8_LAS bf16x8*)(lds + PG8_SB(b, h) + boff + n * 2048 + k * 1024); } while (0)
#define PG8_MMA(ai, bj, At, Bt) do { __builtin_amdgcn_s_setprio(1); _Pragma("unroll") for (int m = 0; m < 4; ++m) _Pragma("unroll") for (int n = 0; n < 2; ++n) _Pragma("unroll") for (int k = 0; k < 2; ++k) \
        acc[ai][bj][m][n] = __builtin_amdgcn_mfma_f32_16x16x32_bf16(Bt[n][k], At[m][k], acc[ai][bj][m][n], 0, 0, 0); __builtin_amdgcn_s_setprio(0); } while (0)
#define PG8_WAIT_V(n) asm volatile("s_waitcnt vmcnt(" #n ")" ::: "memory")
#define PG8_WAIT_L(n) asm volatile("s_waitcnt lgkmcnt(" #n ")" ::: "memory")
#define PG8_BAR __builtin_amdgcn_s_barrier()
#define PG8_SCHED __builtin_amdgcn_sched_barrier(0)
    Unit cur, nxt; int ui = 0;
    if (!S.next(0, cur)) return;
    f32x4 acc[2][2][4][2];
#pragma unroll
    for (int a = 0; a < 2; ++a)
#pragma unroll
        for (int b = 0; b < 2; ++b)
#pragma unroll
            for (int m = 0; m < 4; ++m)
#pragma unroll
                for (int n = 0; n < 2; ++n) acc[a][b][m][n] = (f32x4){0.f, 0.f, 0.f, 0.f};
    bf16x8 At[4][2], B0[2][2], B1[2][2];
    const char* cA = (const char*)g.A + (size_t)cur.pm * tstepA; const char* cB = (const char*)g.Bt + (size_t)cur.pn * tstepB;
    S.a_ready(cur);
    if constexpr (SP2) {
        PG8_STAGE(PG8_SB(0, 0), cB, voffB); PG8_STAGE(PG8_SB(0, 1), cB + hstepB, voffB); PG8_STAGE(PG8_SA(0, 0), cA, voffA); PG8_STAGE(PG8_SA(0, 1), cA + hstepA, voffA);
        if (wr == 1) PG8_BAR;
        PG8_WAIT_V(2); PG8_BAR;
        PG8_STAGE(PG8_SB(1, 0), cB + kstepB, voffB); PG8_STAGE(PG8_SA(1, 0), cA + kstepA, voffA); PG8_STAGE(PG8_SB(1, 1), cB + hstepB + kstepB, voffB);
        PG8_WAIT_V(6); PG8_BAR;
    } else {
        PG8_STAGE(PG8_SB(0, 0), cB, voffB); PG8_STAGE(PG8_SA(0, 0), cA, voffA); PG8_STAGE(PG8_SB(0, 1), cB + hstepB, voffB); PG8_STAGE(PG8_SA(0, 1), cA + hstepA, voffA);
        if (wr == 1) PG8_BAR;
        PG8_WAIT_V(4); PG8_BAR;
        PG8_STAGE(PG8_SB(1, 0), cB + kstepB, voffB); PG8_STAGE(PG8_SA(1, 0), cA + kstepA, voffA); PG8_STAGE(PG8_SB(1, 1), cB + hstepB + kstepB, voffB);
        PG8_WAIT_V(6); PG8_BAR;
    }
    for (;;) {
        const bool has_next = S.next(ui + 1, nxt);
        const char* nA = has_next ? (const char*)g.A + (size_t)nxt.pm * tstepA : cA; const char* nB = has_next ? (const char*)g.Bt + (size_t)nxt.pn * tstepB : cB;
        for (int t = 0; t < nt; t += 2) {
            const bool last = (t == nt - 2);
            const char* a1 = cA + (size_t)(t + 1) * kstepA;
            const char* a2 = last ? nA : cA + (size_t)(t + 2) * kstepA; const char* b2 = last ? nB : cB + (size_t)(t + 2) * kstepB;
            const char* a3 = a2 + kstepA; const char* b3 = b2 + kstepB;
            if (last && has_next) S.a_ready(nxt);
            if constexpr (SP2) {
            PG8_LDB(B0, 0, 0); PG8_LDB(B1, 0, 1); PG8_SCHED; PG8_LDA(At, 0, 0); PG8_STAGE(PG8_SA(1, 1), a1 + hstepA, voffA);
            PG8_WAIT_V(8); PG8_WAIT_L(0); PG8_BAR; PG8_MMA(0, 0, At, B0); PG8_MMA(0, 1, At, B1); PG8_BAR; PG8_SCHED;
            PG8_LDA(At, 0, 1); PG8_STAGE(PG8_SB(0, 0), b2, voffB); PG8_STAGE(PG8_SB(0, 1), b2 + hstepB, voffB); PG8_STAGE(PG8_SA(0, 0), a2, voffA);
            PG8_WAIT_V(8); PG8_WAIT_L(0); PG8_BAR; PG8_MMA(1, 0, At, B0); PG8_MMA(1, 1, At, B1); PG8_BAR; PG8_SCHED;
            PG8_LDB(B0, 1, 0); PG8_LDB(B1, 1, 1); PG8_SCHED; PG8_LDA(At, 1, 0); PG8_STAGE(PG8_SA(0, 1), a2 + hstepA, voffA);
            PG8_WAIT_V(8); PG8_WAIT_L(0); PG8_BAR; PG8_MMA(0, 0, At, B0); PG8_MMA(0, 1, At, B1); PG8_BAR; PG8_SCHED;
            PG8_LDA(At, 1, 1); PG8_STAGE(PG8_SB(1, 0), b3, voffB); PG8_STAGE(PG8_SB(1, 1), b3 + hstepB, voffB); PG8_STAGE(PG8_SA(1, 0), a3, voffA);
            PG8_WAIT_V(8); PG8_WAIT_L(0); PG8_BAR; PG8_MMA(1, 0, At, B0); PG8_MMA(1, 1, At, B1); PG8_BAR; PG8_SCHED;
            } else {
            PG8_LDB(B0, 0, 0); PG8_SCHED; PG8_LDA(At, 0, 0); PG8_STAGE(PG8_SA(1, 1), a1 + hstepA, voffA);
            PG8_WAIT_L(8); PG8_BAR; PG8_WAIT_L(0); PG8_MMA(0, 0, At, B0); PG8_BAR; PG8_SCHED;
            PG8_LDB(B1, 0, 1); PG8_STAGE(PG8_SB(0, 0), b2, voffB);
            PG8_BAR; PG8_WAIT_L(0); PG8_MMA(0, 1, At, B1); PG8_BAR;
            PG8_LDA(At, 0, 1); PG8_STAGE(PG8_SA(0, 0), a2, voffA);
            PG8_BAR; PG8_WAIT_L(0); PG8_MMA(1, 0, At, B0); PG8_BAR; PG8_SCHED;
            PG8_STAGE(PG8_SB(0, 1), b2 + hstepB, voffB);
            PG8_WAIT_V(6); PG8_BAR; PG8_MMA(1, 1, At, B1); PG8_BAR;
            PG8_LDB(B0, 1, 0); PG8_SCHED; PG8_LDA(At, 1, 0); PG8_STAGE(PG8_SA(0, 1), a2 + hstepA, voffA);
            PG8_WAIT_L(8); PG8_BAR; PG8_WAIT_L(0); PG8_MMA(0, 0, At, B0); PG8_BAR; PG8_SCHED;
            PG8_LDB(B1, 1, 1); PG8_STAGE(PG8_SB(1, 0), b3, voffB);
            PG8_BAR; PG8_WAIT_L(0); PG8_MMA(0, 1, At, B1); PG8_BAR;
            PG8_LDA(At, 1, 1); PG8_STAGE(PG8_SA(1, 0), a3, voffA);
            PG8_BAR; PG8_WAIT_L(0); PG8_MMA(1, 0, At, B0); PG8_BAR; PG8_SCHED;
            PG8_STAGE(PG8_SB(1, 1), b3 + hstepB, voffB);
            PG8_WAIT_V(6); PG8_BAR; PG8_MMA(1, 1, At, B1); PG8_BAR;
            }
        }
        if constexpr (ALIGN_EPI) { if (wr == 0) PG8_BAR; }
        if constexpr (!Epi::AFTER_DRAIN) { E(acc, cur, wr, wc, fr, fq); S.done(cur); }
        if (!has_next) break;
#pragma unroll
        for (int a = 0; a < 2; ++a)
#pragma unroll
            for (int b = 0; b < 2; ++b)
#pragma unroll
                for (int m = 0; m < 4; ++m)
#pragma unroll
                    for (int n = 0; n < 2; ++n) acc[a][b][m][n] = (f32x4){0.f, 0.f, 0.f, 0.f};
        cur = nxt; cA = nA; cB = nB; ++ui;
        if constexpr (ALIGN_EPI) { if (wr == 1) PG8_BAR; }
    }
    PG8_WAIT_V(0);
    if constexpr (!ALIGN_EPI) { if (wr == 0) PG8_BAR; }
    PG8_BAR;
    if constexpr (Epi::AFTER_DRAIN) { E.fused(acc, cur, wr, wc, fr, fq, lds, wid, lane); S.done(cur); }
#undef PG8_SA
#undef PG8_SB
#undef PG8_STAGE
#undef PG8_LDA
#undef PG8_LDB
#undef PG8_MMA
#undef PG8_WAIT_V
#undef PG8_WAIT_L
#undef PG8_BAR
#undef PG8_SCHED
}
}
namespace pg8 {
struct EpiBf {
    static constexpr bool PERM = true, AFTER_DRAIN = false, AROWPERM = false;
    bf16_t* O; int ldc; int gelu_tiles;
    const PG8_LAS float* ss; const PG8_LAS float* bvec; mutable int ui;
    __device__ __forceinline__ void operator()(const f32x4 (&acc)[2][2][4][2], const Unit& u, int wr, int wc, int fr, int fq) const {
        const int row0 = u.pm * BM + wr * 64 + fr; const int col0 = u.pn * BM + wc * 32 + 8 * fq;
        const bool act = u.pn < gelu_tiles;
        f32x4 bv[2][2];
        if (ss) { const PG8_LAS float* bp = bvec + ui * BM + wc * 32 + 8 * fq;
#pragma unroll
            for (int bj = 0; bj < 2; ++bj)
#pragma unroll
                for (int n = 0; n < 2; ++n) bv[bj][n] = *(const PG8_LAS f32x4*)(bp + bj * HALF + 4 * n); }
#pragma unroll
        for (int ai = 0; ai < 2; ++ai)
#pragma unroll
            for (int m = 0; m < 4; ++m) { bf16_t* rowp = O + (size_t)(row0 + ai * HALF + m * 16) * ldc + col0;
                float rs = 1.f; if (ss) rs = ss[ui * BM + wr * 64 + fr + ai * HALF + m * 16];
#pragma unroll
                for (int bj = 0; bj < 2; ++bj) { f32x4 v0 = acc[ai][bj][m][0], v1 = acc[ai][bj][m][1];
                    if (ss) { v0 = v0 * rs + bv[bj][0]; v1 = v1 * rs + bv[bj][1]; }
                    if (act) { f32x2 a = gelu_pk((f32x2){v0[0], v0[1]}), b = gelu_pk((f32x2){v0[2], v0[3]}), c = gelu_pk((f32x2){v1[0], v1[1]}), d = gelu_pk((f32x2){v1[2], v1[3]});
                        v0 = (f32x4){a.x, a.y, b.x, b.y}; v1 = (f32x4){c.x, c.y, d.x, d.y}; }
                    u32x4 w; w.x = cvt_pk_bf16(v0[0], v0[1]); w.y = cvt_pk_bf16(v0[2], v0[3]); w.z = cvt_pk_bf16(v1[0], v1[1]); w.w = cvt_pk_bf16(v1[2], v1[3]);
                    *(u32x4*)(rowp + bj * HALF) = w; } }
        ++ui;
    }
};
template <bool XBF, bool OBF>
struct EpiResidT {
    static constexpr bool PERM = true, AFTER_DRAIN = false, AROWPERM = false;
    const void* xa; const void* xb; void* out; const float* gate;
    bf16_t* xg; const float* ga; unsigned long long* ssq;
    __device__ __forceinline__ void operator()(const f32x4 (&acc)[2][2][4][2], const Unit& u, int wr, int wc, int fr, int fq) const {
        const int row0 = u.pm * BM + wr * 64 + fr; const int col0 = u.pn * BM + wc * 32 + 8 * fq;
        const int b = row_batch(u.pm * BM); const void* xin = (u.pm * BM < NPR) ? xa : xb;
        f32x4 gv[2][2], gn[2][2];
#pragma unroll
        for (int bj = 0; bj < 2; ++bj)
#pragma unroll
            for (int n = 0; n < 2; ++n) { gv[bj][n] = *(const f32x4*)(gate + (size_t)b * MODW + col0 + bj * HALF + 4 * n);
                if (xg) gn[bj][n] = *(const f32x4*)(ga + (size_t)b * DM + col0 + bj * HALF + 4 * n); }
#pragma unroll
        for (int aim = 0; aim < 4; ++aim) { const int ai = aim >> 1, mh = (aim & 1) * 2;
            f32x4 xv[2][2][2];
#pragma unroll
            for (int mm = 0; mm < 2; ++mm) { const size_t off = (size_t)(row0 + ai * HALF + (mh + mm) * 16) * DM + col0;
#pragma unroll
                for (int bj = 0; bj < 2; ++bj) {
                    if constexpr (XBF) { const u32x4 w = *(const u32x4*)((const unsigned short*)xin + off + bj * HALF);
                        xv[mm][bj][0] = (f32x4){__uint_as_float(w.x << 16), __uint_as_float(w.x & 0xffff0000u), __uint_as_float(w.y << 16), __uint_as_float(w.y & 0xffff0000u)};
                        xv[mm][bj][1] = (f32x4){__uint_as_float(w.z << 16), __uint_as_float(w.z & 0xffff0000u), __uint_as_float(w.w << 16), __uint_as_float(w.w & 0xffff0000u)}; }
                    else {
#pragma unroll
                        for (int n = 0; n < 2; ++n) xv[mm][bj][n] = *(const f32x4*)((const float*)xin + off + bj * HALF + 4 * n); } } }
#pragma unroll
            for (int mm = 0; mm < 2; ++mm) { const int m = mh + mm; const size_t off = (size_t)(row0 + ai * HALF + m * 16) * DM + col0; float sq = 0.f;
#pragma unroll
                for (int bj = 0; bj < 2; ++bj) { f32x4 xn[2];
#pragma unroll
                    for (int n = 0; n < 2; ++n) {
                        xn[n] = xv[mm][bj][n] + gv[bj][n] * acc[ai][bj][m][n];
                        if constexpr (!OBF) *(f32x4*)((float*)out + off + bj * HALF + 4 * n) = xn[n]; }
                    if constexpr (OBF) { u32x4 w; w.x = cvt_pk_bf16(xn[0][0], xn[0][1]); w.y = cvt_pk_bf16(xn[0][2], xn[0][3]); w.z = cvt_pk_bf16(xn[1][0], xn[1][1]); w.w = cvt_pk_bf16(xn[1][2], xn[1][3]);
                        *(u32x4*)((unsigned short*)out + off + bj * HALF) = w; }
                    if (xg) { const f32x4 a = xn[0] * gn[bj][0], c = xn[1] * gn[bj][1];
                        sq += (xn[0][0] * xn[0][0] + xn[0][1] * xn[0][1]) + (xn[0][2] * xn[0][2] + xn[0][3] * xn[0][3]) + (xn[1][0] * xn[1][0] + xn[1][1] * xn[1][1]) + (xn[1][2] * xn[1][2] + xn[1][3] * xn[1][3]);
                        u32x4 w; w.x = cvt_pk_bf16(a[0], a[1]); w.y = cvt_pk_bf16(a[2], a[3]); w.z = cvt_pk_bf16(c[0], c[1]); w.w = cvt_pk_bf16(c[2], c[3]);
                        *(u32x4*)(xg + off + bj * HALF) = w; } }
                if (xg) { sq += __shfl_xor(sq, 16); sq += __shfl_xor(sq, 32);
                    if (fq == 0) __hip_atomic_fetch_add(ssq + row0 + ai * HALF + m * 16, (unsigned long long)(sq * 16777216.0f + 0.5f), __ATOMIC_RELAXED, __HIP_MEMORY_SCOPE_AGENT); } }
        }
    }
};
}
namespace pg8 {
__device__ __forceinline__ float dpp_prev(float x) { return __int_as_float(__builtin_amdgcn_update_dpp(0, __float_as_int(x), 0x121, 0xF, 0xF, true)); }
__device__ __forceinline__ float dpp_next(float x) { return __int_as_float(__builtin_amdgcn_update_dpp(0, __float_as_int(x), 0x12F, 0xF, 0xF, true)); }
__device__ __forceinline__ float dpp_shr1_old(float oldv, float x) { return __int_as_float(__builtin_amdgcn_update_dpp(__float_as_int(oldv), __float_as_int(x), 0x111, 0xF, 0xF, false)); }
__device__ __forceinline__ float dpp_shl1_old(float oldv, float x) { return __int_as_float(__builtin_amdgcn_update_dpp(__float_as_int(oldv), __float_as_int(x), 0x101, 0xF, 0xF, false)); }
__device__ __forceinline__ f32x4 dpp_shr1_old4(f32x4 o, f32x4 v) { return (f32x4){dpp_shr1_old(o[0], v[0]), dpp_shr1_old(o[1], v[1]), dpp_shr1_old(o[2], v[2]), dpp_shr1_old(o[3], v[3])}; }
__device__ __forceinline__ f32x4 dpp_shl1_old4(f32x4 o, f32x4 v) { return (f32x4){dpp_shl1_old(o[0], v[0]), dpp_shl1_old(o[1], v[1]), dpp_shl1_old(o[2], v[2]), dpp_shl1_old(o[3], v[3])}; }
__device__ __forceinline__ f32x4 dpp_prev4(f32x4 v) { return (f32x4){dpp_prev(v[0]), dpp_prev(v[1]), dpp_prev(v[2]), dpp_prev(v[3])}; }
__device__ __forceinline__ f32x4 dpp_next4(f32x4 v) { return (f32x4){dpp_next(v[0]), dpp_next(v[1]), dpp_next(v[2]), dpp_next(v[3])}; }
struct EpiGate {
    static constexpr bool PERM = true, AFTER_DRAIN = false, AROWPERM = true;
    bf16_t* A; float* ZH; const float* cw; const float* cb; PG8_LAS float* halo;
    const PG8_LAS float* rstab; const float* bvec; mutable int ui;
    __device__ __forceinline__ void operator()(f32x4 (&acc)[2][2][4][2], const Unit& u, int wr, int wc, int fr, int fq) const {
        const int cl = wc * 32 + 8 * fq;
        f32x4 w[2][3], bs[2], bv[2];
#define EG_LOADC(n_) do { const float* bp_ = bvec + (size_t)row_batch(u.pm * BM) * DFF2 + u.pn * BM + cl + 4 * (n_); const int j0_ = u.pn * HALF + cl + 4 * (n_); \
        _Pragma("unroll") for (int bj = 0; bj < 2; ++bj) { bv[bj] = *(const f32x4*)(bp_ + bj * HALF); bs[bj] = *(const f32x4*)(cb + bj * DFF + j0_); } } while (0)
#define EG_LOADW(n_) do { const int j0_ = u.pn * HALF + cl + 4 * (n_); \
        _Pragma("unroll") for (int bj = 0; bj < 2; ++bj) _Pragma("unroll") for (int k = 0; k < 3; ++k) w[bj][k] = *(const f32x4*)(cw + (size_t)k * DFF2 + bj * DFF + j0_); } while (0)
#pragma unroll
        for (int ai = 0; ai < 2; ++ai)
#pragma unroll
            for (int m = 0; m < 4; ++m) { const float rs = rstab[ui * BM + ai * HALF + wr * 64 + 4 * fr + m];
#pragma unroll
                for (int bj = 0; bj < 2; ++bj)
#pragma unroll
                    for (int n = 0; n < 2; ++n) acc[ai][bj][m][n] = acc[ai][bj][m][n] * rs; }
#pragma unroll
        for (int ai = 0; ai < 2; ++ai)
#pragma unroll
            for (int bj = 0; bj < 2; ++bj)
#pragma unroll
                for (int n = 0; n < 2; ++n) { const int blk = ai * 2 + wr, c = bj * HALF + cl + 4 * n;
                    const f32x4 hv = (fr == 0) ? acc[ai][bj][0][n] : acc[ai][bj][3][n];
                    *(PG8_LAS f32x4*)(halo + ((fr == 0) ? (blk * 2) * 256 : (fr == 15) ? (blk * 2 + 1) * 256 : 2048) + c) = hv; }
        asm volatile("s_waitcnt lgkmcnt(0)" ::: "memory"); __builtin_amdgcn_s_barrier(); asm volatile("" ::: "memory");
        const int trow0 = u.pm * BM, pos0 = row_pos(trow0), Lb = batch_len(row_batch(trow0));
        const bool top_ok = (pos0 == 0), bot_ok = (pos0 + BM == Lb);
        const unsigned aoff = ((((unsigned)u.pm * (DFF / 64) + 2 * u.pn + (wc >> 1)) << 14) + 32 * (wc & 1) + 8 * fq) * 2u;
#pragma unroll
        for (int n = 0; n < 2; ++n) {
            EG_LOADW(n); EG_LOADC(n);
            f32x4 cfull[2];
#pragma unroll
            for (int bj = 0; bj < 2; ++bj) cfull[bj] = bs[bj] + bv[bj] * (w[bj][0] + w[bj][1] + w[bj][2]);
            { const unsigned zo = (((unsigned)u.pm * 4) * DFF2 + u.pn * BM + cl + 4 * n) * 4u;
              if (wr == 0 && fr == 0) {
#pragma unroll
                  for (int bj = 0; bj < 2; ++bj) { *(f32x4*)((char*)ZH + (zo + (unsigned)(bj * HALF) * 4u)) = acc[0][bj][0][n] + bv[bj];
                      *(f32x4*)((char*)ZH + (zo + (unsigned)(DFF2 + bj * HALF) * 4u)) = acc[0][bj][1][n] + bv[bj]; } }
              if (wr == 1 && fr == 15) {
#pragma unroll
                  for (int bj = 0; bj < 2; ++bj) { *(f32x4*)((char*)ZH + (zo + (unsigned)(2 * DFF2 + bj * HALF) * 4u)) = acc[1][bj][2][n] + bv[bj];
                      *(f32x4*)((char*)ZH + (zo + (unsigned)(3 * DFF2 + bj * HALF) * 4u)) = acc[1][bj][3][n] + bv[bj]; } } }
#pragma unroll
            for (int ai = 0; ai < 2; ++ai) {
                const int blk = ai * 2 + wr;
                f32x4 hp[2], hn[2];
#pragma unroll
                for (int bj = 0; bj < 2; ++bj) {
                    hp[bj] = (blk > 0) ? *(const PG8_LAS f32x4*)(halo + ((blk - 1) * 2 + 1) * 256 + bj * HALF + cl + 4 * n) : (f32x4){0.f, 0.f, 0.f, 0.f};
                    hn[bj] = (blk < 3) ? *(const PG8_LAS f32x4*)(halo + ((blk + 1) * 2 + 0) * 256 + bj * HALF + cl + 4 * n) : (f32x4){0.f, 0.f, 0.f, 0.f}; }
#pragma unroll
                for (int m = 0; m < 4; ++m) {
                    const int rt = ai * HALF + wr * 64 + 4 * fr + m;
                    f32x4 cv[2];
#pragma unroll
                    for (int bj = 0; bj < 2; ++bj) {
                        const f32x4 cur = acc[ai][bj][m][n];
                        const f32x4 prev = (m > 0) ? acc[ai][bj][m > 0 ? m - 1 : 0][n] : dpp_shr1_old4(hp[bj], acc[ai][bj][3][n]);
                        const f32x4 next = (m < 3) ? acc[ai][bj][m < 3 ? m + 1 : 3][n] : dpp_shl1_old4(hn[bj], acc[ai][bj][0][n]);
                        cv[bj] = w[bj][0] * prev + w[bj][1] * cur + w[bj][2] * next + cfull[bj];
                        if (ai == 0 && m == 0) { if (wr == 0 && fr == 0 && top_ok) cv[bj] = cv[bj] - bv[bj] * w[bj][0]; }
                        if (ai == 1 && m == 3) { if (wr == 1 && fr == 15 && bot_ok) cv[bj] = cv[bj] - bv[bj] * w[bj][2]; } }
                    float o[4];
#pragma unroll
                    for (int e = 0; e < 4; ++e) { const float g = cv[0][e]; o[e] = g * __builtin_amdgcn_rcpf(1.0f + __expf(-g)) * cv[1][e]; }
                    const unsigned p0 = cvt_pk_bf16(o[0], o[1]), p1 = cvt_pk_bf16(o[2], o[3]);
                    {
                      typedef unsigned u32x2e __attribute__((ext_vector_type(2)));
                      *(u32x2e*)((char*)A + (aoff + (unsigned)(rt * 128 + 8 * n))) = (u32x2e){p0, p1}; }
                }
            }
        }
        asm volatile("s_waitcnt lgkmcnt(0)" ::: "memory"); __builtin_amdgcn_s_barrier(); asm volatile("" ::: "memory");
        ++ui;
#undef EG_LOADC
#undef EG_LOADW
    }
};
template <class Sched> __device__ __forceinline__ void fill_tabs(const Sched& S, const unsigned long long* ss, const float* bvec, int ldb, PG8_LAS float* rstab, PG8_LAS float* bvtab, int tid) {
    Unit u;
    for (int i = 0; S.next(i, u); ++i) {
        if (tid < 256) rstab[i * BM + tid] = rsqrtf((float)ss[u.pm * BM + tid] * (1.0f / 16777216.0f) * (1.0f / DM) + EPS);
        else if (bvec) bvtab[i * BM + tid - 256] = bvec[(size_t)row_batch(u.pm * BM) * ldb + u.pn * BM + tid - 256]; }
    __syncthreads();
}
}
namespace att {
using bf16x8 = __attribute__((ext_vector_type(8))) short;
using s16x4  = __attribute__((ext_vector_type(4))) short;
using f32x16 = __attribute__((ext_vector_type(16))) float;
using u32x4  = __attribute__((ext_vector_type(4))) unsigned;
constexpr int NW = 8, QBLK = 32, KVBLK = 64, DV = 128;
constexpr float THR = 8.f;
#define ATT_SBAR() __builtin_amdgcn_sched_barrier(0)
__device__ __forceinline__ int crow(int r, int hi) { return (r & 3) + 8 * (r >> 2) + 4 * hi; }
__device__ __forceinline__ unsigned cvtpk(float lo, float hi) { unsigned r; asm volatile("v_cvt_pk_bf16_f32 %0, %1, %2" : "=v"(r) : "v"(lo), "v"(hi)); return r; }
template <int DK> __device__ __forceinline__ int kswz(int row, int colB) { return row * (2 * DK + 16) + colB; }

template <int DK> __device__ __forceinline__ void partialSM(f32x16& p0, f32x16& p1, float& m_reg, float& mn, float& alpha) {
  constexpr float SCALE = (DK == 128) ? 0.08838834764831845f : 0.07216878364870323f;
  constexpr float C = SCALE * 1.4426950408889634f;
  float pmax = p0[0];
#pragma unroll
  for (int r = 1; r < 16; ++r) pmax = fmaxf(pmax, p0[r]);
#pragma unroll
  for (int r = 0; r < 16; ++r) pmax = fmaxf(pmax, p1[r]);
  { auto rr = __builtin_amdgcn_permlane32_swap(__float_as_uint(pmax), __float_as_uint(pmax), false, false);
    pmax = fmaxf(__uint_as_float(rr[0]), __uint_as_float(rr[1])); }
  if (__builtin_expect(__all(pmax - m_reg <= THR / SCALE), 1)) { mn = m_reg; alpha = 1.f; }
  else { mn = fmaxf(m_reg, pmax); alpha = __builtin_amdgcn_exp2f((m_reg - mn) * C); m_reg = mn; }
  float mnC = -mn * C;
#pragma unroll
  for (int r = 0; r < 16; ++r) p0[r] = fmaf(p0[r], C, mnC);
#pragma unroll
  for (int r = 0; r < 16; ++r) p1[r] = fmaf(p1[r], C, mnC);
#pragma unroll
  for (int r = 0; r < 16; ++r) p0[r] = __builtin_amdgcn_exp2f(p0[r]);
}
__device__ __forceinline__ void finishSM(f32x16& p0, f32x16& p1, float alpha, float& l_reg, bf16x8& pa0, bf16x8& pa1, bf16x8& pa2, bf16x8& pa3) {
#pragma unroll
  for (int r = 0; r < 16; ++r) p1[r] = __builtin_amdgcn_exp2f(p1[r]);
  float ps = 0;
#pragma unroll
  for (int r = 0; r < 16; ++r) ps += p0[r];
#pragma unroll
  for (int r = 0; r < 16; ++r) ps += p1[r];
  { auto rr = __builtin_amdgcn_permlane32_swap(__float_as_uint(ps), __float_as_uint(ps), false, false);
    ps = __uint_as_float(rr[0]) + __uint_as_float(rr[1]); }
  l_reg = l_reg * alpha + ps;
#define ATT_PK4(P, BASE, OUT) do { unsigned a0 = cvtpk(P[BASE + 0], P[BASE + 1]), a1 = cvtpk(P[BASE + 2], P[BASE + 3]);   \
    unsigned b0 = cvtpk(P[BASE + 4], P[BASE + 5]), b1 = cvtpk(P[BASE + 6], P[BASE + 7]);                              \
    auto r0 = __builtin_amdgcn_permlane32_swap(a0, b0, false, false); auto r1 = __builtin_amdgcn_permlane32_swap(a1, b1, false, false); \
    u32x4 w = {r0[0], r1[0], r0[1], r1[1]}; OUT = *reinterpret_cast<bf16x8*>(&w); } while (0)
  ATT_PK4(p0, 0, pa0); ATT_PK4(p0, 8, pa1); ATT_PK4(p1, 0, pa2); ATT_PK4(p1, 8, pa3);
#undef ATT_PK4
}
template <int DK> __device__ __forceinline__ void qkt(f32x16& p0, f32x16& p1, const char* Ks, const bf16x8* qr, const char* ldsb, int qxo, int r32, int hi) {
  p0 = f32x16{}; p1 = f32x16{};
  if constexpr (DK > 128) asm volatile("" : "+v"(qxo));
  const char* qx = ldsb + qxo;
#pragma unroll
  for (int d0 = 0; d0 < DK / 16; ++d0) { int cb = (d0 * 16 + hi * 8) * 2;
    bf16x8 b0 = *reinterpret_cast<const bf16x8*>(Ks + kswz<DK>(r32, cb));
    bf16x8 b1 = *reinterpret_cast<const bf16x8*>(Ks + kswz<DK>(32 + r32, cb));
    bf16x8 qf; if (d0 < 8) qf = qr[d0]; else qf = *reinterpret_cast<const bf16x8*>(qx + (d0 - 8) * 1024);
    p0 = __builtin_amdgcn_mfma_f32_32x32x16_bf16(b0, qf, p0, 0, 0, 0);
    p1 = __builtin_amdgcn_mfma_f32_32x32x16_bf16(b1, qf, p1, 0, 0, 0);
    if ((d0 & 3) == 3) ATT_SBAR(); }
}
__device__ __forceinline__ int v_st(int k, int c) { const int kk = (k & ~0xC) | ((k & 4) << 1) | ((k & 8) >> 1); return ((kk >> 3) * 4 + (c >> 5)) * 512 + ((kk & 7) * 32 + (c & 31)) * 2; }
__device__ __forceinline__ int v_rd_base(int lane) { return ((lane & 3) << 3) | (((lane >> 2) & 3) << 6) | (((lane >> 4) & 1) << 5) | (((lane >> 5) & 1) << 8); }
constexpr int v_rd_off(int d0, int ks, int half) { return d0 * 512 + ks * 4096 + half * 2048; }
template <int OFF> __device__ __forceinline__ s16x4 tr_read(int vb) {
  s16x4 r; asm volatile("ds_read_b64_tr_b16 %0, %1 offset:%2" : "=&v"(r) : "v"(vb), "i"(OFF) : "memory"); return r;
}
template <int D0> __device__ __forceinline__ void pv_one(f32x16& od, int vb, bf16x8 pa0, bf16x8 pa1, bf16x8 pa2, bf16x8 pa3) {
  const s16x4 l0 = tr_read<v_rd_off(D0, 0, 0)>(vb), h0 = tr_read<v_rd_off(D0, 0, 1)>(vb), l1 = tr_read<v_rd_off(D0, 1, 0)>(vb), h1 = tr_read<v_rd_off(D0, 1, 1)>(vb);
  const s16x4 l2 = tr_read<v_rd_off(D0, 2, 0)>(vb), h2 = tr_read<v_rd_off(D0, 2, 1)>(vb), l3 = tr_read<v_rd_off(D0, 3, 0)>(vb), h3 = tr_read<v_rd_off(D0, 3, 1)>(vb);
  asm volatile("s_waitcnt lgkmcnt(0)" ::: "memory"); ATT_SBAR();
#define ATT_PK(L, H) (bf16x8){L[0], L[1], L[2], L[3], H[0], H[1], H[2], H[3]}
  od = __builtin_amdgcn_mfma_f32_32x32x16_bf16(pa0, ATT_PK(l0, h0), od, 0, 0, 0);
  od = __builtin_amdgcn_mfma_f32_32x32x16_bf16(pa1, ATT_PK(l1, h1), od, 0, 0, 0);
  od = __builtin_amdgcn_mfma_f32_32x32x16_bf16(pa2, ATT_PK(l2, h2), od, 0, 0, 0);
  od = __builtin_amdgcn_mfma_f32_32x32x16_bf16(pa3, ATT_PK(l3, h3), od, 0, 0, 0);
#undef ATT_PK
}
__device__ __forceinline__ void pv_d0(f32x16* o, int vb, bf16x8 pa0, bf16x8 pa1, bf16x8 pa2, bf16x8 pa3) {
  pv_one<0>(o[0], vb, pa0, pa1, pa2, pa3); pv_one<1>(o[1], vb, pa0, pa1, pa2, pa3); pv_one<2>(o[2], vb, pa0, pa1, pa2, pa3); pv_one<3>(o[3], vb, pa0, pa1, pa2, pa3);
}
template <int DK> struct Cfg { static constexpr int SHM_V = KVBLK * DV * 2, SHM_K = KVBLK * (DK * 2 + 16), SHM_Q = (DK > 128) ? NW * 4096 : 0, SHM = 2 * SHM_V + 2 * SHM_K + NW * 64 * 4 + SHM_Q; };

template <int DK, int SDEPTH, int ldq, int ldk, int ldv, int ldo>
__device__ __forceinline__ void attn_body(const unsigned short* __restrict__ Qb, const unsigned short* __restrict__ Kh,
                                          const unsigned short* __restrict__ Vh, unsigned short* __restrict__ Ob, int seq, char* lds) {
  constexpr int SHM_V = Cfg<DK>::SHM_V, SHM_K = Cfg<DK>::SHM_K, NQ = (DK > 128 ? 8 : DK / 16), NKI = DK / 64;
  const int tid = tid_fresh(), wid = tid >> 6, lane = tid & 63, r32 = lane & 31, hi = lane >> 5;
  char* V_lds = lds; char* K_lds = lds + 2 * SHM_V;
  float* ws = (float*)(lds + 2 * SHM_V + 2 * SHM_K) + wid * 64; float* li_l = ws; float* al_l = ws + 32;
  float m_reg = -1e30f, l_reg = 0; f32x16 o[4] = {}; bf16x8 qr[NQ];
  const unsigned short* Qw = Qb + (wid * QBLK + r32) * ldq + hi * 8;
#pragma unroll
  for (int d0 = 0; d0 < NQ; ++d0) qr[d0] = *reinterpret_cast<const bf16x8*>(Qw + d0 * 16);
  const int qxo = 2 * SHM_V + 2 * SHM_K + NW * 64 * 4 + wid * 4096 + lane * 16; char* qx = lds + qxo;
  if constexpr (DK > 128) {
#pragma unroll
    for (int d0 = 8; d0 < DK / 16; ++d0) *reinterpret_cast<bf16x8*>(qx + (d0 - 8) * 1024) = *reinterpret_cast<const bf16x8*>(Qw + d0 * 16);
  }
  const int sr = tid >> 4, sc = (tid & 15) * 8, vst0 = v_st(sr, sc);
  const int vgo = sr * ldv + sc;
  const int kr = tid >> 3, kc8 = tid & 7, kgo = kr * ldk + kc8 * 8, kdst = kswz<DK>(kr, kc8 * 16);
  const int vb0 = (int)(uintptr_t)V_lds + v_rd_base(lane);
  struct { bf16x8 vs0, vs1, ks[NKI]; } sr_[SDEPTH];
#define ATT_SLOAD(i, k0) do { const unsigned short* vt_ = Vh + (size_t)(k0) * ldv; const unsigned short* kt_ = Kh + (size_t)(k0) * ldk; \
    sr_[i].vs0 = *reinterpret_cast<const bf16x8*>(vt_ + vgo); sr_[i].vs1 = *reinterpret_cast<const bf16x8*>(vt_ + vgo + 32 * ldv); \
    _Pragma("unroll") for (int q_ = 0; q_ < NKI; ++q_) sr_[i].ks[q_] = *reinterpret_cast<const bf16x8*>(kt_ + kgo + 64 * q_); } while (0)
#define ATT_SWRITE(b, i) do { *(bf16x8*)(V_lds + (b) * SHM_V + vst0) = sr_[i].vs0; *(bf16x8*)(V_lds + (b) * SHM_V + vst0 + 8192) = sr_[i].vs1; \
    _Pragma("unroll") for (int q_ = 0; q_ < NKI; ++q_) *(bf16x8*)(K_lds + (b) * SHM_K + kdst + 128 * q_) = sr_[i].ks[q_]; } while (0)
#define ATT_SWAIT() do { if constexpr (SDEPTH == 2) { if constexpr (NKI == 2) asm volatile("s_waitcnt vmcnt(4)" ::: "memory"); else asm volatile("s_waitcnt vmcnt(5)" ::: "memory"); } else asm volatile("s_waitcnt vmcnt(0)" ::: "memory"); } while (0)
#define ATT_RESC(a) do { if (__any((a) < 1.f)) { if (hi == 0) al_l[r32] = (a); asm volatile("s_waitcnt lgkmcnt(0)" ::: "memory"); \
    _Pragma("unroll") for (int d = 0; d < 4; ++d) _Pragma("unroll") for (int r = 0; r < 16; ++r) o[d][r] *= al_l[crow(r, hi)]; } } while (0)
  f32x16 pA0, pA1, pB0, pB1; float mnA, mnB, alA, alB; bf16x8 pa0, pa1, pa2, pa3; const int NT = seq / KVBLK;
  constexpr int SE = 0, SO = SDEPTH - 1;
  ATT_SLOAD(SE, 0); asm volatile("s_waitcnt vmcnt(0)" ::: "memory"); ATT_SWRITE(0, SE); __syncthreads();
  qkt<DK>(pA0, pA1, K_lds, qr, lds, qxo, r32, hi); partialSM<DK>(pA0, pA1, m_reg, mnA, alA);
  ATT_SLOAD(SO, KVBLK); if constexpr (SDEPTH == 2) { if (2 < NT) ATT_SLOAD(SE, 2 * KVBLK); }
  ATT_SWAIT(); ATT_SWRITE(1, SO); __syncthreads();
  for (int j = 1; j + 1 < NT; j += 2) {
    ATT_SBAR(); qkt<DK>(pB0, pB1, K_lds + SHM_K, qr, lds, qxo, r32, hi);
    finishSM(pA0, pA1, alA, l_reg, pa0, pa1, pa2, pa3); ATT_SBAR();
    ATT_SLOAD(SO, (j + SDEPTH) * KVBLK); ATT_SBAR();
    pv_d0(o, vb0, pa0, pa1, pa2, pa3); partialSM<DK>(pB0, pB1, m_reg, mnB, alB);
    __syncthreads(); ATT_SWAIT(); ATT_SWRITE(0, SE);
    ATT_RESC(alB); __syncthreads();
    ATT_SBAR(); qkt<DK>(pA0, pA1, K_lds, qr, lds, qxo, r32, hi);
    finishSM(pB0, pB1, alB, l_reg, pa0, pa1, pa2, pa3); ATT_SBAR();
    if (SDEPTH == 1 || j + 3 < NT) ATT_SLOAD(SE, (j + 1 + SDEPTH) * KVBLK); ATT_SBAR();
    pv_d0(o, vb0 + SHM_V, pa0, pa1, pa2, pa3); partialSM<DK>(pA0, pA1, m_reg, mnA, alA);
    __syncthreads(); ATT_SWAIT(); ATT_SWRITE(1, SO);
    ATT_RESC(alA); __syncthreads();
  }
  ATT_SBAR(); qkt<DK>(pB0, pB1, K_lds + SHM_K, qr, lds, qxo, r32, hi);
  finishSM(pA0, pA1, alA, l_reg, pa0, pa1, pa2, pa3); ATT_SBAR();
  pv_d0(o, vb0, pa0, pa1, pa2, pa3); partialSM<DK>(pB0, pB1, m_reg, mnB, alB);
  __syncthreads(); ATT_RESC(alB);
  finishSM(pB0, pB1, alB, l_reg, pa0, pa1, pa2, pa3); ATT_SBAR();
  pv_d0(o, vb0 + SHM_V, pa0, pa1, pa2, pa3);
  if (hi == 0) li_l[r32] = l_reg; asm volatile("s_waitcnt lgkmcnt(0)" ::: "memory");
  float rli[16];
#pragma unroll
  for (int r = 0; r < 16; ++r) rli[r] = __builtin_amdgcn_rcpf(li_l[crow(r, hi)]);
  unsigned short* Ow = Ob + (wid * QBLK) * ldo;
#pragma unroll
  for (int r = 0; r < 16; ++r) { int orow = crow(r, hi);
#pragma unroll
    for (int d0 = 0; d0 < 4; ++d0) Ow[orow * ldo + d0 * 32 + r32] = (unsigned short)f2bf(o[d0][r] * rli[r]); }
  __syncthreads();
#undef ATT_SLOAD
#undef ATT_SWRITE
#undef ATT_SWAIT
#undef ATT_RESC
}

template <int DK, int ldq, int ldk, int ldv, int ldo>
__device__ __forceinline__ void attn_body_seq(const unsigned short* __restrict__ Qb, const unsigned short* __restrict__ Kh,
                                              const unsigned short* __restrict__ Vh, unsigned short* __restrict__ Ob, int seq, char* lds) {
  constexpr int SHM_V = Cfg<DK>::SHM_V, SHM_K = Cfg<DK>::SHM_K, NQ = (DK > 128 ? 8 : DK / 16), NKI = DK / 64;
  const int tid = tid_fresh(), wid = tid >> 6, lane = tid & 63, r32 = lane & 31, hi = lane >> 5;
  char* V_lds = lds; char* K_lds = lds + 2 * SHM_V;
  float* ws = (float*)(lds + 2 * SHM_V + 2 * SHM_K) + wid * 64; float* li_l = ws; float* al_l = ws + 32;
  float m_reg = -1e30f, l_reg = 0; f32x16 o[4] = {}; bf16x8 qr[NQ];
  const unsigned short* Qw = Qb + (wid * QBLK + r32) * ldq + hi * 8;
#pragma unroll
  for (int d0 = 0; d0 < NQ; ++d0) qr[d0] = *reinterpret_cast<const bf16x8*>(Qw + d0 * 16);
  const int qxo = 2 * SHM_V + 2 * SHM_K + NW * 64 * 4 + wid * 4096 + lane * 16; char* qx = lds + qxo;
  if constexpr (DK > 128) {
#pragma unroll
    for (int d0 = 8; d0 < DK / 16; ++d0) *reinterpret_cast<bf16x8*>(qx + (d0 - 8) * 1024) = *reinterpret_cast<const bf16x8*>(Qw + d0 * 16);
  }
  const int sr = tid >> 4, sc = (tid & 15) * 8, vst0 = v_st(sr, sc);
  const int vgo = sr * ldv + sc;
  const int kr = tid >> 3, kc8 = tid & 7, kgo = kr * ldk + kc8 * 8, kdst = kswz<DK>(kr, kc8 * 16);
  const int vb0 = (int)(uintptr_t)V_lds + v_rd_base(lane);
  bf16x8 vs0, vs1, ks[NKI];
#define ATT_SLOAD1(k0) do { const unsigned short* vt_ = Vh + (size_t)(k0) * ldv; const unsigned short* kt_ = Kh + (size_t)(k0) * ldk; \
    vs0 = *reinterpret_cast<const bf16x8*>(vt_ + vgo); vs1 = *reinterpret_cast<const bf16x8*>(vt_ + vgo + 32 * ldv); \
    _Pragma("unroll") for (int q_ = 0; q_ < NKI; ++q_) ks[q_] = *reinterpret_cast<const bf16x8*>(kt_ + kgo + 64 * q_); } while (0)
#define ATT_SWRITE1(b) do { *(bf16x8*)(V_lds + (b) * SHM_V + vst0) = vs0; *(bf16x8*)(V_lds + (b) * SHM_V + vst0 + 8192) = vs1; \
    _Pragma("unroll") for (int q_ = 0; q_ < NKI; ++q_) *(bf16x8*)(K_lds + (b) * SHM_K + kdst + 128 * q_) = ks[q_]; } while (0)
  const int NT = seq / KVBLK;
  ATT_SLOAD1(0); ATT_SWRITE1(0); __syncthreads();
#pragma unroll 1
  for (int j = 0; j < NT; ++j) {
    const int b = j & 1;
    f32x16 p0, p1; float mn, al; bf16x8 pa0, pa1, pa2, pa3;
    if (j + 1 < NT) ATT_SLOAD1((j + 1) * KVBLK);
    ATT_SBAR();
    qkt<DK>(p0, p1, K_lds + b * SHM_K, qr, lds, qxo, r32, hi);
    partialSM<DK>(p0, p1, m_reg, mn, al);
    if (__any(al < 1.f)) { if (hi == 0) al_l[r32] = al; asm volatile("s_waitcnt lgkmcnt(0)" ::: "memory");
#pragma unroll
      for (int d = 0; d < 4; ++d)
#pragma unroll
        for (int r = 0; r < 16; ++r) o[d][r] *= al_l[crow(r, hi)]; }
    finishSM(p0, p1, al, l_reg, pa0, pa1, pa2, pa3); ATT_SBAR();
    pv_d0(o, vb0 + b * SHM_V, pa0, pa1, pa2, pa3);
    if (j + 1 < NT) ATT_SWRITE1(b ^ 1);
    __syncthreads();
  }
  if (hi == 0) li_l[r32] = l_reg; asm volatile("s_waitcnt lgkmcnt(0)" ::: "memory");
  float rli[16];
#pragma unroll
  for (int r = 0; r < 16; ++r) rli[r] = __builtin_amdgcn_rcpf(li_l[crow(r, hi)]);
  unsigned short* Ow = Ob + (wid * QBLK) * ldo;
#pragma unroll
  for (int r = 0; r < 16; ++r) { int orow = crow(r, hi);
#pragma unroll
    for (int d0 = 0; d0 < 4; ++d0) Ow[orow * ldo + d0 * 32 + r32] = (unsigned short)f2bf(o[d0][r] * rli[r]); }
  __syncthreads();
#undef ATT_SLOAD1
#undef ATT_SWRITE1
}

template <int DK> __device__ __forceinline__ void qk_half(f32x16& p, const char* Ks, int rowoff, const bf16x8* qr, const char* ldsb, int qxo, int r32, int hi) {
  p = f32x16{};
  const char* qx = ldsb + qxo;
#pragma unroll
  for (int d0 = 0; d0 < DK / 16; ++d0) { int cb = (d0 * 16 + hi * 8) * 2;
    bf16x8 b0 = *reinterpret_cast<const bf16x8*>(Ks + kswz<DK>(rowoff + r32, cb));
    bf16x8 qf; if (d0 < 8) qf = qr[d0]; else qf = *reinterpret_cast<const bf16x8*>(qx + (d0 - 8) * 1024);
    p = __builtin_amdgcn_mfma_f32_32x32x16_bf16(b0, qf, p, 0, 0, 0); }
}
template <int KH> __device__ __forceinline__ void pv_half(f32x16* o, int vb, bf16x8 pa, bf16x8 pb) {
#define ATT_PK(L, H) (bf16x8){L[0], L[1], L[2], L[3], H[0], H[1], H[2], H[3]}
#define ATT_PVD(D0) do { const s16x4 l0 = tr_read<v_rd_off(D0, 2 * KH, 0)>(vb), h0 = tr_read<v_rd_off(D0, 2 * KH, 1)>(vb), l1 = tr_read<v_rd_off(D0, 2 * KH + 1, 0)>(vb), h1 = tr_read<v_rd_off(D0, 2 * KH + 1, 1)>(vb); \
    asm volatile("s_waitcnt lgkmcnt(0)" ::: "memory"); ATT_SBAR();   \
    o[D0] = __builtin_amdgcn_mfma_f32_32x32x16_bf16(pa, ATT_PK(l0, h0), o[D0], 0, 0, 0); o[D0] = __builtin_amdgcn_mfma_f32_32x32x16_bf16(pb, ATT_PK(l1, h1), o[D0], 0, 0, 0); } while (0)
  ATT_PVD(0); ATT_PVD(1); ATT_PVD(2); ATT_PVD(3);
#undef ATT_PVD
#undef ATT_PK
}
__device__ __forceinline__ float exp_pack(f32x16& p, bf16x8& pa, bf16x8& pb) {
#pragma unroll
  for (int r = 0; r < 16; ++r) p[r] = __builtin_amdgcn_exp2f(p[r]);
  float ps = 0.f;
#pragma unroll
  for (int r = 0; r < 16; ++r) ps += p[r];
#define ATT_PK4(P, BASE, OUT) do { unsigned a0 = cvtpk(P[BASE + 0], P[BASE + 1]), a1 = cvtpk(P[BASE + 2], P[BASE + 3]);   \
    unsigned b0 = cvtpk(P[BASE + 4], P[BASE + 5]), b1 = cvtpk(P[BASE + 6], P[BASE + 7]);                              \
    auto r0 = __builtin_amdgcn_permlane32_swap(a0, b0, false, false); auto r1 = __builtin_amdgcn_permlane32_swap(a1, b1, false, false); \
    u32x4 w = {r0[0], r1[0], r0[1], r1[1]}; OUT = *reinterpret_cast<bf16x8*>(&w); } while (0)
  ATT_PK4(p, 0, pa); ATT_PK4(p, 8, pb);
#undef ATT_PK4
  return ps;
}
template <int DK, int ldq, int ldk, int ldv, int ldo>
__device__ __forceinline__ void attn_body_nomax(const unsigned short* __restrict__ Qb, const unsigned short* __restrict__ Kh,
                                                const unsigned short* __restrict__ Vh, unsigned short* __restrict__ Ob, int seq, char* lds) {
  constexpr int SHM_V = Cfg<DK>::SHM_V, SHM_K = Cfg<DK>::SHM_K, NQ = (DK > 128 ? 8 : DK / 16), NKI = DK / 64;
  const int tid = tid_fresh(), wid = tid >> 6, lane = tid & 63, r32 = lane & 31, hi = lane >> 5;
  char* V_lds = lds; char* K_lds = lds + 2 * SHM_V;
  float* ws = (float*)(lds + 2 * SHM_V + 2 * SHM_K) + wid * 64; float* li_l = ws;
  float l_reg = 0; f32x16 o[4] = {}; bf16x8 qr[NQ];
  const unsigned short* Qw = Qb + (wid * QBLK + r32) * ldq + hi * 8;
#pragma unroll
  for (int d0 = 0; d0 < NQ; ++d0) qr[d0] = *reinterpret_cast<const bf16x8*>(Qw + d0 * 16);
  int qxo = 2 * SHM_V + 2 * SHM_K + NW * 64 * 4 + wid * 4096 + lane * 16; char* qx = lds + qxo;
  if constexpr (DK > 128) {
#pragma unroll
    for (int d0 = 8; d0 < DK / 16; ++d0) *reinterpret_cast<bf16x8*>(qx + (d0 - 8) * 1024) = *reinterpret_cast<const bf16x8*>(Qw + d0 * 16);
  }
  const int sr = tid >> 4, sc = (tid & 15) * 8, vst0 = v_st(sr, sc);
  const int vgo = sr * ldv + sc;
  const int kr = tid >> 3, kc8 = tid & 7, kgo = kr * ldk + kc8 * 8, kdst = kswz<DK>(kr, kc8 * 16);
  const int vb0 = (int)(uintptr_t)V_lds + v_rd_base(lane);
  bf16x8 vs0, vs1, ks[NKI];
#define ATT_SLOAD1(k0) do { const unsigned short* vt_ = Vh + (size_t)(k0) * ldv; const unsigned short* kt_ = Kh + (size_t)(k0) * ldk; \
    vs0 = *reinterpret_cast<const bf16x8*>(vt_ + vgo); vs1 = *reinterpret_cast<const bf16x8*>(vt_ + vgo + 32 * ldv); \
    _Pragma("unroll") for (int q_ = 0; q_ < NKI; ++q_) ks[q_] = *reinterpret_cast<const bf16x8*>(kt_ + kgo + 64 * q_); } while (0)
#define ATT_SWRITE1(b) do { *(bf16x8*)(V_lds + (b) * SHM_V + vst0) = vs0; *(bf16x8*)(V_lds + (b) * SHM_V + vst0 + 8192) = vs1; \
    _Pragma("unroll") for (int q_ = 0; q_ < NKI; ++q_) *(bf16x8*)(K_lds + (b) * SHM_K + kdst + 128 * q_) = ks[q_]; } while (0)
  const int NT = seq / KVBLK;
  ATT_SLOAD1(0); ATT_SWRITE1(0); __syncthreads();
#pragma unroll 1
  for (int j = 0; j < NT; ++j) {
    const int b = j & 1;
    f32x16 p0, p1; bf16x8 pa0, pa1, pa2, pa3;
    if (j + 1 < NT) ATT_SLOAD1((j + 1) * KVBLK);
    if constexpr (DK > 128) asm volatile("" : "+v"(qxo));
    ATT_SBAR();
    qk_half<DK>(p0, K_lds + b * SHM_K, 0, qr, lds, qxo, r32, hi);
    ATT_SBAR();
    qk_half<DK>(p1, K_lds + b * SHM_K, 32, qr, lds, qxo, r32, hi);
    float ps = exp_pack(p0, pa0, pa1);
    ATT_SBAR();
    pv_half<0>(o, vb0 + b * SHM_V, pa0, pa1);
    ps += exp_pack(p1, pa2, pa3);
    ATT_SBAR();
    pv_half<1>(o, vb0 + b * SHM_V, pa2, pa3);
    l_reg += ps;
    if (j + 1 < NT) ATT_SWRITE1(b ^ 1);
    __syncthreads();
  }
  { auto rr = __builtin_amdgcn_permlane32_swap(__float_as_uint(l_reg), __float_as_uint(l_reg), false, false); l_reg = __uint_as_float(rr[0]) + __uint_as_float(rr[1]); }
  if (hi == 0) li_l[r32] = l_reg; asm volatile("s_waitcnt lgkmcnt(0)" ::: "memory");
  float rli[16];
#pragma unroll
  for (int r = 0; r < 16; ++r) rli[r] = __builtin_amdgcn_rcpf(li_l[crow(r, hi)]);
  unsigned short* Ow = Ob + (wid * QBLK) * ldo;
#pragma unroll
  for (int r = 0; r < 16; ++r) { int orow = crow(r, hi);
#pragma unroll
    for (int d0 = 0; d0 < 4; ++d0) Ow[orow * ldo + d0 * 32 + r32] = (unsigned short)f2bf(o[d0][r] * rli[r]); }
  __syncthreads();
#undef ATT_SLOAD1
#undef ATT_SWRITE1
}

typedef float f32x4a __attribute__((ext_vector_type(4)));
__device__ __forceinline__ int v16_st(int key, int d) { return (((key >> 4) * 8 + (d >> 4)) * 4 + ((key >> 2) & 3)) * 128 + ((key & 3) * 16 + (d & 15)) * 2; }
template <int OFF> __device__ __forceinline__ s16x4 tr_read16(int vb) { s16x4 r; asm volatile("ds_read_b64_tr_b16 %0, %1 offset:%2" : "=&v"(r) : "v"(vb), "i"(OFF) : "memory"); return r; }
template <int NDS, int ST>
__device__ __forceinline__ void sgb_steps() {
  if constexpr (ST < 4 * NDS) {
    __builtin_amdgcn_sched_group_barrier(0x008, 2, 0);
    if constexpr (ST >= NDS) __builtin_amdgcn_sched_group_barrier(0x400, (((ST % NDS) + 1) * 8) / NDS - ((ST % NDS) * 8) / NDS, 0);
    if constexpr (ST + 4 < 4 * NDS) __builtin_amdgcn_sched_group_barrier(0x100, 1, 0);
    sgb_steps<NDS, ST + 1>();
  }
}
template <int DK, int ldq, int ldk, int ldv, int ldo>
__device__ __forceinline__ void attn_body16(const unsigned short* __restrict__ Qb, const unsigned short* __restrict__ Kh,
                                            const unsigned short* __restrict__ Vh, unsigned short* __restrict__ Ob, int seq, char* lds) {
  constexpr int SHM_V = KVBLK * DV * 2, KP = 2 * DK, SHM_K = KVBLK * KP, NDS = DK / 32, NKI = DK / 64, PPR = DK / 8;
  const int tid = tid_fresh(), wid = tid >> 6, lane = tid & 63, c16 = lane & 15, g = lane >> 4;
  static_assert(3 * (SHM_V + SHM_K) <= RING_BYTES, "three K/V stage buffers");
  char* V_lds = lds; char* K_lds = lds + 3 * SHM_V;
  f32x4a ot[8][2]; float lsum[2] = {0.f, 0.f}; bf16x8 qf[2][NDS];
#pragma unroll
  for (int db = 0; db < 8; ++db) { ot[db][0] = (f32x4a){0.f, 0.f, 0.f, 0.f}; ot[db][1] = (f32x4a){0.f, 0.f, 0.f, 0.f}; }
#pragma unroll
  for (int qb = 0; qb < 2; ++qb)
#pragma unroll
    for (int ds = 0; ds < NDS; ++ds) qf[qb][ds] = *reinterpret_cast<const bf16x8*>(Qb + (wid * QBLK + 16 * qb + c16) * ldq + 32 * ds + 8 * g);
  int kgo[NKI], vgo[2];
#pragma unroll
  for (int i = 0; i < NKI; ++i) { const int P = i * NTHR + tid, r = P / PPR, ph = P % PPR, lg = ph ^ (r & 7) ^ (DK == 128 ? ((r & 1) << 3) : 0); kgo[i] = r * ldk + lg * 8; }
#pragma unroll
  for (int i = 0; i < 2; ++i) { const int P = i * NTHR + tid, key = ((P >> 8) & 3) * 16 + ((P >> 3) & 3) * 4 + ((P >> 1) & 3), d = ((P >> 5) & 7) * 16 + (P & 1) * 8; vgo[i] = key * ldv + d; }
  const int swl = (c16 & 7) ^ (DK == 128 ? ((c16 & 1) << 3) : 0);
  int kfo[NDS];
#pragma unroll
  for (int ds = 0; ds < NDS; ++ds) kfo[ds] = c16 * KP + 16 * (g ^ (swl & 3)) + 64 * (ds ^ (swl >> 2));
  const int vb0 = (int)(uintptr_t)V_lds + g * 128 + 8 * c16;
  const int wv = __builtin_amdgcn_readfirstlane(wid) * 1024;
  LAS char* ldsl = (LAS char*)lds;
#define A16_SDMA(k0, b) do { const unsigned short* vt_ = Vh + (size_t)(k0) * ldv; const unsigned short* kt_ = Kh + (size_t)(k0) * ldk; \
    _Pragma("unroll") for (int i_ = 0; i_ < 2; ++i_) __builtin_amdgcn_global_load_lds((const unsigned*)(vt_ + vgo[i_]), (LAS unsigned*)(ldsl + (b) * SHM_V + i_ * 8192 + wv), 16, 0, 0); \
    _Pragma("unroll") for (int i_ = 0; i_ < NKI; ++i_) __builtin_amdgcn_global_load_lds((const unsigned*)(kt_ + kgo[i_]), (LAS unsigned*)(ldsl + 3 * SHM_V + (b) * SHM_K + i_ * 8192 + wv), 16, 0, 0); } while (0)
  const int NT = seq / KVBLK;
  A16_SDMA(0, 0); A16_SDMA(KVBLK, 1);
  if constexpr (NKI == 2) asm volatile("s_waitcnt vmcnt(4) lgkmcnt(0)\n\ts_barrier" ::: "memory"); else asm volatile("s_waitcnt vmcnt(5) lgkmcnt(0)\n\ts_barrier" ::: "memory");
  int b = 0, b1 = 1, b2 = 2;
#pragma unroll 1
  for (int j = 0; j < NT; ++j) {
    if (j + 2 < NT) A16_SDMA((j + 2) * KVBLK, b2);
    ATT_SBAR();
    f32x4a sct[4][2];
    const char* Kt = K_lds + b * SHM_K;
#define A16_EXP(kb_, e_) do { sct[kb_][(e_) >> 2][(e_) & 3] = __builtin_amdgcn_exp2f(sct[kb_][(e_) >> 2][(e_) & 3]); } while (0)
    bf16x8 kq[4];
#pragma unroll
    for (int s0 = 0; s0 < 3; ++s0) kq[s0] = *reinterpret_cast<const bf16x8*>(Kt + kfo[s0 % NDS] + (s0 / NDS) * 16 * KP);
#pragma unroll
    for (int kb = 0; kb < 4; ++kb) {
      sct[kb][0] = (f32x4a){0.f, 0.f, 0.f, 0.f}; sct[kb][1] = (f32x4a){0.f, 0.f, 0.f, 0.f};
#pragma unroll
      for (int ds = 0; ds < NDS; ++ds) { const int st = kb * NDS + ds, sn = st + 3;
        if (sn < 4 * NDS) kq[sn & 3] = *reinterpret_cast<const bf16x8*>(Kt + kfo[sn % NDS] + (sn / NDS) * 16 * KP);
        sct[kb][0] = __builtin_amdgcn_mfma_f32_16x16x32_bf16(kq[st & 3], qf[0][ds], sct[kb][0], 0, 0, 0);
        sct[kb][1] = __builtin_amdgcn_mfma_f32_16x16x32_bf16(kq[st & 3], qf[1][ds], sct[kb][1], 0, 0, 0);
        if (kb > 0) {
#pragma unroll
          for (int e = (ds * 8) / NDS; e < ((ds + 1) * 8) / NDS; ++e) A16_EXP(kb > 0 ? kb - 1 : 0, e); }
        ATT_SBAR(); } }
    bf16x8 pf[2][2];
#define A16_PACK(ksp_) do { _Pragma("unroll") for (int qb = 0; qb < 2; ++qb) { u32x4 w; w.x = cvtpk(sct[2 * (ksp_)][qb][0], sct[2 * (ksp_)][qb][1]); w.y = cvtpk(sct[2 * (ksp_)][qb][2], sct[2 * (ksp_)][qb][3]); \
        w.z = cvtpk(sct[2 * (ksp_) + 1][qb][0], sct[2 * (ksp_) + 1][qb][1]); w.w = cvtpk(sct[2 * (ksp_) + 1][qb][2], sct[2 * (ksp_) + 1][qb][3]); pf[qb][ksp_] = __builtin_bit_cast(bf16x8, w); \
        lsum[qb] += ((sct[2 * (ksp_)][qb][0] + sct[2 * (ksp_)][qb][1]) + (sct[2 * (ksp_)][qb][2] + sct[2 * (ksp_)][qb][3])) + ((sct[2 * (ksp_) + 1][qb][0] + sct[2 * (ksp_) + 1][qb][1]) + (sct[2 * (ksp_) + 1][qb][2] + sct[2 * (ksp_) + 1][qb][3])); } } while (0)
    const int vb = vb0 + b * SHM_V;
    s16x4 ta[4][2], tb[4][2];
#define A16_RD(T, KSP, DB0) do { \
      T[0][0] = tr_read16<(2 * KSP) * 4096 + (DB0 + 0) * 512>(vb); T[0][1] = tr_read16<(2 * KSP + 1) * 4096 + (DB0 + 0) * 512>(vb); \
      T[1][0] = tr_read16<(2 * KSP) * 4096 + (DB0 + 1) * 512>(vb); T[1][1] = tr_read16<(2 * KSP + 1) * 4096 + (DB0 + 1) * 512>(vb); \
      T[2][0] = tr_read16<(2 * KSP) * 4096 + (DB0 + 2) * 512>(vb); T[2][1] = tr_read16<(2 * KSP + 1) * 4096 + (DB0 + 2) * 512>(vb); \
      T[3][0] = tr_read16<(2 * KSP) * 4096 + (DB0 + 3) * 512>(vb); T[3][1] = tr_read16<(2 * KSP + 1) * 4096 + (DB0 + 3) * 512>(vb); } while (0)
#define A16_WAIT() do { asm volatile("s_waitcnt lgkmcnt(0)" ::: "memory"); ATT_SBAR(); } while (0)
#define A16_MM(T, KSP, DB0, X) do { \
      _Pragma("unroll") for (int d_ = 0; d_ < 4; ++d_) { const bf16x8 vf = (bf16x8){T[d_][0][0], T[d_][0][1], T[d_][0][2], T[d_][0][3], T[d_][1][0], T[d_][1][1], T[d_][1][2], T[d_][1][3]}; \
        ot[DB0 + d_][0] = __builtin_amdgcn_mfma_f32_16x16x32_bf16(vf, pf[0][KSP], ot[DB0 + d_][0], 0, 0, 0); \
        ot[DB0 + d_][1] = __builtin_amdgcn_mfma_f32_16x16x32_bf16(vf, pf[1][KSP], ot[DB0 + d_][1], 0, 0, 0); } X; ATT_SBAR(); } while (0)
#define A16_PIN(qb_) asm volatile("" : "+v"(sct[3][qb_][0]), "+v"(sct[3][qb_][1]), "+v"(sct[3][qb_][2]), "+v"(sct[3][qb_][3]))
    A16_RD(ta, 0, 0);
    ATT_SBAR();
    A16_PACK(0);
    ATT_SBAR();
    A16_WAIT();
    A16_RD(tb, 0, 4); ATT_SBAR();
    A16_MM(ta, 0, 0, { A16_PIN(0); A16_EXP(3, 0); A16_EXP(3, 1); A16_EXP(3, 2); A16_EXP(3, 3); A16_PIN(0); });
    A16_WAIT();
    A16_RD(ta, 1, 0); ATT_SBAR();
    A16_MM(tb, 0, 4, { A16_PIN(1); A16_EXP(3, 4); A16_EXP(3, 5); A16_EXP(3, 6); A16_EXP(3, 7); A16_PIN(1); });
    A16_PACK(1);
    ATT_SBAR();
    A16_WAIT();
    A16_RD(tb, 1, 4); ATT_SBAR();
    A16_MM(ta, 1, 0, {});
    A16_WAIT();
    A16_MM(tb, 1, 4, {});
#undef A16_PIN
#undef A16_RD
#undef A16_WAIT
#undef A16_MM
#undef A16_PACK
#undef A16_EXP
    if (j + 2 < NT) { if constexpr (NKI == 2) asm volatile("s_waitcnt vmcnt(4) lgkmcnt(0)\n\ts_barrier" ::: "memory"); else asm volatile("s_waitcnt vmcnt(5) lgkmcnt(0)\n\ts_barrier" ::: "memory"); }
    else asm volatile("s_waitcnt vmcnt(0) lgkmcnt(0)\n\ts_barrier" ::: "memory");
    { const int t_ = b; b = b1; b1 = b2; b2 = t_; }
  }
#pragma unroll
  for (int qb = 0; qb < 2; ++qb) { float l = lsum[qb]; l += __shfl_xor(l, 16); l += __shfl_xor(l, 32); const float rl = __builtin_amdgcn_rcpf(l);
    unsigned short* Or = Ob + (wid * QBLK + 16 * qb + c16) * ldo + 4 * g;
#pragma unroll
    for (int db = 0; db < 8; ++db) { typedef unsigned u32x2a __attribute__((ext_vector_type(2)));
      u32x2a w; w.x = pk2(ot[db][qb][0] * rl, ot[db][qb][1] * rl); w.y = pk2(ot[db][qb][2] * rl, ot[db][qb][3] * rl);
      *(u32x2a*)(Or + 16 * db) = w; } }
  __syncthreads();
#undef A16_SDMA
}
#undef ATT_SBAR
}
namespace hy {
using bf16x8 = __attribute__((ext_vector_type(8))) short;
using f32x16 = __attribute__((ext_vector_type(16))) float;
using u32x4  = __attribute__((ext_vector_type(4))) unsigned;
using u32x2  = __attribute__((ext_vector_type(2))) unsigned;
template <int L> struct HC {
    static constexpr int NMB = L / 2048, NCH = (L == 4096) ? 2 : 4, UST = L + 160, GRN = 2 * L / 64 * 72;
    static constexpr int UB = 4 * UST * 2, GB = GRN * 2, CHB = UB + GB, NK4 = L / 64 + 1;
    static_assert(NCH * CHB <= RING_BYTES, "hyena LDS");
};
__device__ __forceinline__ int crow(int r, int hi) { return (r & 3) + 8 * (r >> 2) + 4 * hi; }
__device__ __forceinline__ float bf2f(unsigned short v) { return __uint_as_float((unsigned)v << 16); }

typedef float f32x4h __attribute__((ext_vector_type(4)));
template <int L>
__device__ __forceinline__ void conv_kloop16(f32x4h (&acc)[2][8], const LAS char* gA, const LAS char* uB) {
    constexpr int NK2 = L / 64 + 1;
#pragma unroll
    for (int a = 0; a < 2; ++a)
#pragma unroll
        for (int r = 0; r < 8; ++r) acc[a][r] = (f32x4h){0.f, 0.f, 0.f, 0.f};
    for (int kk2 = 0; kk2 < NK2; ++kk2) {
#pragma unroll
        for (int h = 0; h < 2; ++h) {
            const bf16x8 A = *(const LAS bf16x8*)(gA + kk2 * 144 + h * 64);
#pragma unroll
            for (int nh = 0; nh < 2; ++nh) {
                const u32x4 w0 = *(const LAS u32x4*)(uB + kk2 * 128 + h * 64 + nh * 64);
                const u32x4 w1 = *(const LAS u32x4*)(uB + kk2 * 128 + h * 64 + nh * 64 + 16);
                const unsigned w[8] = {w0.x, w0.y, w0.z, w0.w, w1.x, w1.y, w1.z, w1.w};
#pragma unroll
                for (int r = 0; r < 8; ++r) { u32x4 bf;
                    if ((r & 1) == 0) { const int q = r >> 1; bf = (u32x4){w[q], w[q + 1], w[q + 2], w[q + 3]}; }
                    else { const int q = (r - 1) >> 1;
                        bf = (u32x4){__builtin_amdgcn_alignbit(w[q + 1], w[q], 16), __builtin_amdgcn_alignbit(w[q + 2], w[q + 1], 16),
                                     __builtin_amdgcn_alignbit(w[q + 3], w[q + 2], 16), __builtin_amdgcn_alignbit(w[q + 4], w[q + 3], 16)}; }
                    acc[nh][r] = __builtin_amdgcn_mfma_f32_16x16x32_bf16(A, __builtin_bit_cast(bf16x8, bf), acc[nh][r], 0, 0, 0); }
            }
        }
    }
}

template <int L>
__device__ __forceinline__ void hyena_unit(LAS char* lds, const unsigned short* GFl, const unsigned short* X1T, const unsigned short* X2T, const unsigned short* VT,
                                           unsigned short* Y2T, const float* skip  , int b0, int c0) {
    using C = HC<L>;
    constexpr int NCH = C::NCH, UST = C::UST, GRN = C::GRN, UB = C::UB, GB = C::GB, CHB = C::CHB, WPC = 8 / NCH;
    static_assert(L / 1024 == WPC, "one wave per (channel, 1024-output block)");
    const int tid = tid_fresh(), wid = __builtin_amdgcn_readfirstlane(tid >> 6), lane = tid & 63;
    const int ch = wid / WPC, Mb = wid % WPC;
    const int c16 = lane & 15, g = lane >> 4, np = c16 >> 2, bb = c16 & 3;
    LAS char* Uch = lds + ch * CHB; LAS char* Gch = Uch + UB;
    const LAS char* gA = Gch + 2 * ((L / 64 - 16 * Mb - c16 - 1) * 72 + 8 * g);
    const LAS char* uB = Uch + 2 * (bb * UST + 8 * g + 8 * np);
    const int c = c0 + ch;
    u32x4 y1p[2][4];
#pragma unroll 1
    for (int o = 0; o < 2; ++o) {
        { constexpr int NG = NCH * (GB / 16), NGI = (NG + NTHR - 1) / NTHR; u32x4 gv[NGI];
#pragma unroll
          for (int i = 0; i < NGI; ++i) { const int id = tid + i * NTHR, cc = id / (GB / 16), off = id % (GB / 16);
              gv[i] = (id < NG) ? *(const u32x4*)((const char*)(GFl + ((size_t)(o * 512 + c0 + cc)) * GRN) + off * 16) : (u32x4){0u, 0u, 0u, 0u}; }
          if (o == 0) {
              constexpr int NU = NCH * 4 * (L / 8), NUI = NU / NTHR; static_assert(NU % NTHR == 0, "u staging"); u32x4 uv_[NUI];
#pragma unroll
              for (int i = 0; i < NUI; ++i) { const int id = tid + i * NTHR, cb = id / (L / 8), off = id % (L / 8), cc = cb >> 2, b = cb & 3;
                  uv_[i] = *(const u32x4*)(VT + xt_off(b0 + b, c0 + cc) + off * 8); }
#pragma unroll
              for (int i = 0; i < NUI; ++i) { const int id = tid + i * NTHR, cb = id / (L / 8), off = id % (L / 8), cc = cb >> 2, b = cb & 3;
                  *(LAS u32x4*)(lds + cc * CHB + (b * UST + 64) * 2 + off * 16) = uv_[i]; }
              for (int id = tid; id < NCH * 4 * 20; id += NTHR) { const int cb = id / 20, k = id % 20, cc = cb >> 2, b = cb & 3;
                  const int el = k < 8 ? k * 8 : (L + 64) + (k - 8) * 8;
                  *(LAS u32x4*)(lds + cc * CHB + (b * UST + el) * 2) = (u32x4){0u, 0u, 0u, 0u}; }
          }
#pragma unroll
          for (int i = 0; i < NGI; ++i) { const int id = tid + i * NTHR, cc = id / (GB / 16), off = id % (GB / 16);
              if (id < NG) *(LAS u32x4*)(lds + cc * CHB + UB + off * 16) = gv[i]; } }
        if (o == 1) {
#pragma unroll
            for (int nh = 0; nh < 2; ++nh)
#pragma unroll
                for (int i = 0; i < 4; ++i) { const int t0 = 1024 * Mb + 64 * (4 * g + i) + 32 * nh + 8 * np;
                    *(LAS u32x4*)(Uch + (bb * UST + 64 + t0) * 2) = y1p[nh][i]; }
        }
        __syncthreads();
        f32x4h acc[2][8];
        conv_kloop16<L>(acc, gA, uB);
        const float sk = skip[o * 512 + c];
        const unsigned short* XT = (o == 0) ? X1T : X2T;
        const size_t gbase = xt_off(b0 + bb, c);
        u32x4 xvs[2][4];
#pragma unroll
        for (int nh = 0; nh < 2; ++nh)
#pragma unroll
            for (int i = 0; i < 4; ++i) { const int t0 = 1024 * Mb + 64 * (4 * g + i) + 32 * nh + 8 * np; xvs[nh][i] = *(const u32x4*)(XT + gbase + t0); }
#pragma unroll
        for (int nh = 0; nh < 2; ++nh)
#pragma unroll
            for (int i = 0; i < 4; ++i) { const int t0 = 1024 * Mb + 64 * (4 * g + i) + 32 * nh + 8 * np;
                const u32x4 xv = xvs[nh][i];
                const u32x4 uv = *(const LAS u32x4*)(Uch + (bb * UST + 64 + t0) * 2);
                const unsigned xw[4] = {xv.x, xv.y, xv.z, xv.w}, uw[4] = {uv.x, uv.y, uv.z, uv.w}; unsigned pw[4];
#pragma unroll
                for (int q = 0; q < 4; ++q) {
                    const float ylo = bf2f((unsigned short)(xw[q] & 0xffff)) * (acc[nh][2 * q][i] + sk * bf2f((unsigned short)(uw[q] & 0xffff)));
                    const float yhi = bf2f((unsigned short)(xw[q] >> 16)) * (acc[nh][2 * q + 1][i] + sk * bf2f((unsigned short)(uw[q] >> 16)));
                    pw[q] = pk2(ylo, yhi); }
                const u32x4 p = (u32x4){pw[0], pw[1], pw[2], pw[3]};
                if (o == 0) y1p[nh][i] = p;
                else *(u32x4*)(Y2T + gbase + t0) = p; }
        __syncthreads();
    }
}
}
typedef unsigned u32x2v __attribute__((ext_vector_type(2)));
__device__ __forceinline__ float bf2f(unsigned short v) { return __uint_as_float((unsigned)v << 16); }
__device__ __forceinline__ float bflo(unsigned w) { return __uint_as_float(w << 16); }
__device__ __forceinline__ float bfhi(unsigned w) { return __uint_as_float(w & 0xffff0000u); }
__device__ __forceinline__ float wave_sum(float v) {
#pragma unroll
    for (int o = 1; o < 64; o <<= 1) v += __shfl_xor(v, o);
    return v;
}
__device__ __forceinline__ void unpack8(const v4u& w, float (&f)[8]) {
    f[0] = bflo(w.x); f[1] = bfhi(w.x); f[2] = bflo(w.y); f[3] = bfhi(w.y); f[4] = bflo(w.z); f[5] = bfhi(w.z); f[6] = bflo(w.w); f[7] = bfhi(w.w);
}
__device__ __forceinline__ v4u pack8(const float (&f)[8]) { v4u w; w.x = pk2(f[0], f[1]); w.y = pk2(f[2], f[3]); w.z = pk2(f[4], f[5]); w.w = pk2(f[6], f[7]); return w; }

__device__ __forceinline__ void norm_rows(const float* xa, const float* xb, const float* g, const float* mod  , int sh_off, int sc_off, bf16* H, int gw, int ngw, int lane) {
    for (int ck = gw; ck < NTOK / 4; ck += ngw) {
        const int row0 = ck * 4, b = row_batch(row0);
        const float* xin = row0 < NPR ? xa : xb;
        const float* sc = mod + (size_t)b * MODW + sc_off; const float* sh = mod + (size_t)b * MODW + sh_off;
        f32x4 ga[8], sb[8];
#pragma unroll
        for (int j = 0; j < 8; ++j) { const int col = 4 * lane + 256 * j; const f32x4 gg = *(const f32x4*)(g + col), s1 = *(const f32x4*)(sc + col);
            ga[j] = gg * (s1 + 1.0f); sb[j] = *(const f32x4*)(sh + col); }
#pragma unroll 1
        for (int r = 0; r < 4; ++r) {
            const float* xr = xin + (size_t)(row0 + r) * DM;
            f32x4 v[8]; float ss = 0.f;
#pragma unroll
            for (int j = 0; j < 8; ++j) { v[j] = *(const f32x4*)(xr + 4 * lane + 256 * j); ss += (v[j].x * v[j].x + v[j].y * v[j].y) + (v[j].z * v[j].z + v[j].w * v[j].w); }
            const float rs = rsqrtf(wave_sum(ss) * (1.0f / DM) + EPS);
            bf16* hr = H + (size_t)(row0 + r) * DM;
#pragma unroll
            for (int j = 0; j < 8; ++j) { const f32x4 o = v[j] * rs * ga[j] + sb[j]; u32x2v w; w.x = pk2(o.x, o.y); w.y = pk2(o.z, o.w);
                *(u32x2v*)(hr + 4 * lane + 256 * j) = w; }
        }
    }
}

struct PostIn { v4u v, qa, ckv, h1, h2; };
__device__ __forceinline__ PostIn post_load(const bf16* P, int lane) {
    PostIn in; const int head = lane >> 3, sub = lane & 7, sec = sub >> 2, chk = sub & 3, hh = head < 6 ? head : 0;
    in.v = *(const v4u*)(P + 512 + 8 * lane); in.qa = *(const v4u*)(P + C_D + 8 * lane); in.ckv = *(const v4u*)(P + C_D + 512 + 8 * (lane & 31));
    const bf16* hp = P + C_C + hh * 128 + 64 * sec + 8 * chk; in.h1 = *(const v4u*)hp; in.h2 = *(const v4u*)(hp + 32); return in;
}
__device__ __forceinline__ void post_finish(const PostIn& in, bf16* P, int pos, const float* vng, const float* qng, const float* kng, const float* qag, const float* kvag, int lane, bool st = true) {
    { float f[8]; unpack8(in.v, f);
      float s = 0.f;
#pragma unroll
      for (int i = 0; i < 8; ++i) s += f[i];
      const float mean = wave_sum(s) * (1.0f / 512.0f); float q = 0.f;
#pragma unroll
      for (int i = 0; i < 8; ++i) { f[i] -= mean; q += f[i] * f[i]; }
      const float rs = rsqrtf(wave_sum(q) * (1.0f / 512.0f) + EPS);
      const f32x4 g0 = *(const f32x4*)(vng + 8 * lane), g1 = *(const f32x4*)(vng + 8 * lane + 4);
      f[0] *= rs * g0.x; f[1] *= rs * g0.y; f[2] *= rs * g0.z; f[3] *= rs * g0.w; f[4] *= rs * g1.x; f[5] *= rs * g1.y; f[6] *= rs * g1.z; f[7] *= rs * g1.w;
      if (st) *(v4u*)(P + 512 + 8 * lane) = pack8(f); }
    { float f[8]; unpack8(in.qa, f); float q = 0.f;
#pragma unroll
      for (int i = 0; i < 8; ++i) q += f[i] * f[i];
      const float rs = rsqrtf(wave_sum(q) * (1.0f / 512.0f) + EPS);
#pragma unroll
      for (int i = 0; i < 8; ++i) f[i] *= rs * qag[8 * lane + i];
      if (st) *(v4u*)(P + C_D + 8 * lane) = pack8(f); }
    { const int l32 = lane & 31; float f[8]; unpack8(in.ckv, f); float q = 0.f;
#pragma unroll
      for (int i = 0; i < 8; ++i) q += f[i] * f[i];
      const float rs = rsqrtf(wave_sum(q) * (0.5f / 256.0f) + EPS);
#pragma unroll
      for (int i = 0; i < 8; ++i) f[i] *= rs * kvag[8 * l32 + i];
      if (st && lane < 32) *(v4u*)(P + C_D + 512 + 8 * l32) = pack8(f); }
    { const int head = lane >> 3, sub = lane & 7, sec = sub >> 2, chk = sub & 3; const bool on = head < 6;
      const int hh = on ? head : 0;
      bf16* hp = P + C_C + hh * 128 + 64 * sec + 8 * chk;
      float a[8], c[8]; unpack8(in.h1, a); unpack8(in.h2, c);
      float q = 0.f;
#pragma unroll
      for (int i = 0; i < 8; ++i) q += a[i] * a[i] + c[i] * c[i];
      q += __shfl_xor(q, 1); q += __shfl_xor(q, 2); q += __shfl_xor(q, 4);
      const float rs = rsqrtf(q * (1.0f / 128.0f) + EPS);
      const float* gg = (hh < 4 ? qng : kng) + 64 * sec + 8 * chk;
      const float p = (float)(sec ? (pos & 63) : (pos >> 6));
#pragma unroll
      for (int i = 0; i < 8; ++i) {
          const float x1 = a[i] * rs * gg[i], x2 = c[i] * rs * gg[32 + i];
          const float inv = __expf(-(float)(2 * (8 * chk + i)) * (9.210340371976184f / 64.0f));
          float sn, cs; __sincosf(p * inv, &sn, &cs);
          const float qs = (hh < 4) ? 0.12751743082459868f : 1.0f;
          a[i] = (x1 * cs - x2 * sn) * qs; c[i] = (x2 * cs + x1 * sn) * qs; }
      if (st && on) { *(v4u*)hp = pack8(a); *(v4u*)(hp + 32) = pack8(c); } }
}
__device__ __forceinline__ void post_rows(bf16* PROJp, const float* vng, const float* qng, const float* kng, const float* qag, const float* kvag, int gw, int ngw, int lane, bool st) {
    int row = gw; if (row >= NTOK) return;
    PostIn cur = post_load(PROJp + (size_t)row * INCP, lane);
    for (; row < NTOK; row += ngw) { const int nr = row + ngw; PostIn nxt = cur;
        if (nr < NTOK) nxt = post_load(PROJp + (size_t)nr * INCP, lane);
        post_finish(cur, PROJp + (size_t)row * INCP, row_pos(row), vng, qng, kng, qag, kvag, lane, st); cur = nxt; }
}

struct MlaIn { v4u n[2], a[2], c[2]; };
__device__ __forceinline__ MlaIn mla_load(const bf16* Qr, const bf16* KVr, const bf16* krope, int lane) {
    MlaIn in; const int head = lane >> 4, sub = lane & 15; const bool rp = sub < 4; const int sec = (sub >> 1) & 1, chk = sub & 1, x1o = 128 + 32 * sec + 8 * chk;
    in.n[0] = *(const v4u*)(Qr + head * 192 + 8 * sub); in.n[1] = *(const v4u*)(KVr + head * 256 + 8 * sub);
    in.a[0] = in.c[0] = in.a[1] = in.c[1] = (v4u){0u, 0u, 0u, 0u};
    if (rp) { in.a[0] = *(const v4u*)(Qr + head * 192 + x1o); in.c[0] = *(const v4u*)(Qr + head * 192 + x1o + 16);
              in.a[1] = *(const v4u*)(krope + 32 * sec + 8 * chk); in.c[1] = *(const v4u*)(krope + 32 * sec + 8 * chk + 16); }
    return in;
}
__device__ __forceinline__ void mla_finish(const MlaIn& in, bf16* Qr, bf16* Kr, int pos, const float* qng, const float* kng, int lane, bool st = true) {
    const int head = lane >> 4, sub = lane & 15;
    const bool rp = sub < 4; const int sec = (sub >> 1) & 1, chk = sub & 1;
    const int x1o = 128 + 32 * sec + 8 * chk;
    const float p = (float)(sec ? (pos & 63) : (pos >> 6));
#pragma unroll
    for (int which = 0; which < 2; ++which) {
        const float* g = which == 0 ? qng : kng;
        bf16* dst = (which == 0 ? Qr : Kr) + head * 192;
        float n[8], a[8], c[8]; unpack8(in.n[which], n); unpack8(in.a[which], a); unpack8(in.c[which], c);
        float q = 0.f;
#pragma unroll
        for (int i = 0; i < 8; ++i) q += n[i] * n[i] + a[i] * a[i] + c[i] * c[i];
        q += __shfl_xor(q, 1); q += __shfl_xor(q, 2); q += __shfl_xor(q, 4); q += __shfl_xor(q, 8);
        const float rs = rsqrtf(q * (1.0f / 192.0f) + EPS);
        const float qs = (which == 0) ? 0.10411755155693222f : 1.0f;
#pragma unroll
        for (int i = 0; i < 8; ++i) n[i] *= rs * g[8 * sub + i] * qs;
        if (st) *(v4u*)(dst + 8 * sub) = pack8(n);
        if (rp) {
#pragma unroll
            for (int i = 0; i < 8; ++i) {
                const float x1 = a[i] * rs * g[x1o + i], x2 = c[i] * rs * g[x1o + 16 + i];
                const float inv = __expf(-(float)(2 * (8 * chk + i)) * (9.210340371976184f / 32.0f));
                float sn, cs; __sincosf(p * inv, &sn, &cs);
                a[i] = (x1 * cs - x2 * sn) * qs; c[i] = (x2 * cs + x1 * sn) * qs; }
            if (st) { *(v4u*)(dst + x1o) = pack8(a); *(v4u*)(dst + x1o + 16) = pack8(c); } }
    }
}
__device__ __forceinline__ void mla_rows(bf16* QDp, const bf16* KVDp, const bf16* PROJp, bf16* KMp, const float* qng, const float* kng, int gw, int ngw, int lane, bool st) {
    int row = gw; if (row >= NTOK) return;
    MlaIn cur = mla_load(QDp + (size_t)row * 768, KVDp + (size_t)row * 1024, PROJp + (size_t)row * INCP + C_D + 768, lane);
    for (; row < NTOK; row += ngw) { const int nr = row + ngw; MlaIn nxt = cur;
        if (nr < NTOK) nxt = mla_load(QDp + (size_t)nr * 768, KVDp + (size_t)nr * 1024, PROJp + (size_t)nr * INCP + C_D + 768, lane);
        mla_finish(cur, QDp + (size_t)row * 768, KMp + (size_t)row * 768, row_pos(row), qng, kng, lane, st); cur = nxt; }
}

__device__ __forceinline__ void hyconv_tile(LAS unsigned char* lds, const bf16* PROJ, bf16* XT, const float* cw  , const float* cb  , int tile, int tid) {
    const int which = tile % 3, tb = tile / 3, row0 = tb * 64, b = row_batch(row0), pos0 = row_pos(row0), Lb = batch_len(b);
    constexpr int PITCH = 260;
    LAS unsigned* raw = (LAS unsigned*)lds;
    { v4u w[9];
#pragma unroll
      for (int i = 0; i < 9; ++i) { const int id = tid + i * NTHR, r = id >> 6, k = id & 63, p = pos0 - 1 + r;
          w[i] = (v4u){0u, 0u, 0u, 0u};
          if (id < 66 * 64 && p >= 0 && p < Lb) w[i] = *(const v4u*)(PROJ + (size_t)(row0 - 1 + r) * INCP + C_B + which * 512 + 8 * k); }
#pragma unroll
      for (int i = 0; i < 9; ++i) { const int id = tid + i * NTHR, r = id >> 6, k = id & 63;
          if (id < 66 * 64) *(LAS v4u*)(raw + r * PITCH + 4 * k) = w[i]; } }
    __syncthreads();
    { const int c = tid, col = which * 512 + c; const float w0 = cw[col], w1 = cw[1536 + col], w2 = cw[3072 + col], bb = cb[col];
      const LAS unsigned short* rc = (const LAS unsigned short*)raw + c;
      bf16* dst = XT + (size_t)which * ((size_t)NTOK * 512) + xt_off(b, c) + pos0;
      float xm = bf2f(rc[0]), x0 = bf2f(rc[2 * PITCH]);
#pragma unroll 2
      for (int k = 0; k < 8; ++k) { float z[8];
#pragma unroll
          for (int i = 0; i < 8; ++i) { const float xp = bf2f(rc[(8 * k + i + 2) * 2 * PITCH]); z[i] = w0 * xm + w1 * x0 + w2 * xp + bb; xm = x0; x0 = xp; }
          *(v4u*)(dst + 8 * k) = pack8(z); } }
    __syncthreads();
}

__device__ __forceinline__ void gnorm_tile(LAS unsigned char* lds, const bf16* __restrict__ YCAT, const bf16* __restrict__ Y2T, const float* __restrict__ gg  , bf16* __restrict__ YN, int tile, int tid) {
    const int row0 = tile * 32, b = row_batch(row0), pos0 = row_pos(row0), lane = tid & 63, wid = tid >> 6;
    constexpr int PITCH = 17;
    LAS unsigned* yb = (LAS unsigned*)lds;
    { v4u yw[4];
#pragma unroll
      for (int i = 0; i < 4; ++i) { const int id = tid + i * NTHR, c = id >> 2, k = id & 3; yw[i] = *(const v4u*)(Y2T + xt_off(b, c) + pos0 + 8 * k); }
#pragma unroll
      for (int i = 0; i < 4; ++i) { const int id = tid + i * NTHR, c = id >> 2, k = id & 3; LAS unsigned* d = yb + c * PITCH + 4 * k; d[0] = yw[i].x; d[1] = yw[i].y; d[2] = yw[i].z; d[3] = yw[i].w; } }
    __syncthreads();
#pragma unroll 2
    for (int r = 0; r < 4; ++r) { const int t = wid * 4 + r, row = row0 + t;
        const bf16* yr = YCAT + (size_t)row * DM; bf16* on = YN + (size_t)row * DM;
#pragma unroll
        for (int grp = 0; grp < 4; ++grp) {
            if (grp == 1) {
                float f[8]; float q = 0.f;
#pragma unroll
                for (int i = 0; i < 8; ++i) { f[i] = bf2f(((const LAS unsigned short*)yb)[(lane + 64 * i) * 2 * PITCH + t]); q += f[i] * f[i]; }
                const float rs = rsqrtf(wave_sum(q) * (1.0f / 512.0f) + EPS);
#pragma unroll
                for (int i = 0; i < 8; ++i) on[512 + lane + 64 * i] = (bf16)f2bf(f[i] * rs * gg[512 + lane + 64 * i]);
            } else {
                v4u w = *(const v4u*)(yr + grp * 512 + 8 * lane); float f[8]; unpack8(w, f); float q = 0.f;
#pragma unroll
                for (int i = 0; i < 8; ++i) q += f[i] * f[i];
                const float rs = rsqrtf(wave_sum(q) * (1.0f / 512.0f) + EPS);
                const f32x4 g0 = *(const f32x4*)(gg + grp * 512 + 8 * lane), g1 = *(const f32x4*)(gg + grp * 512 + 8 * lane + 4);
                f[0] *= rs * g0.x; f[1] *= rs * g0.y; f[2] *= rs * g0.z; f[3] *= rs * g0.w; f[4] *= rs * g1.x; f[5] *= rs * g1.y; f[6] *= rs * g1.z; f[7] *= rs * g1.w;
                *(v4u*)(on + grp * 512 + 8 * lane) = pack8(f);
            }
        }
    }
    __syncthreads();
}

__device__ __forceinline__ void ffn_gate(const bf16* Z, bf16* A, const float* cw  , const float* cb  , int gt, int ngt) {
    constexpr int NCK = DFF / 8;
    for (int it = gt; it < (NTOK / 16) * NCK; it += ngt) {
        const int rb = it / NCK, ck = it % NCK, row0 = rb * 16, j0 = ck * 8;
        const int pos0 = row_pos(row0), Lb = batch_len(row_batch(row0));
        float wg[3][8], wu[3][8], bg[8], bu[8];
#pragma unroll
        for (int k = 0; k < 3; ++k)
#pragma unroll
            for (int i = 0; i < 8; ++i) { wg[k][i] = cw[k * DFF2 + j0 + i]; wu[k][i] = cw[k * DFF2 + DFF + j0 + i]; }
#pragma unroll
        for (int i = 0; i < 8; ++i) { bg[i] = cb[j0 + i]; bu[i] = cb[DFF + j0 + i]; }
        float gm[8], g0[8], um[8], u0[8];
        const bf16* zr = Z + (size_t)row0 * DFF2 + j0;
        if (pos0 > 0) { v4u a = *(const v4u*)(zr - DFF2), c = *(const v4u*)(zr - DFF2 + DFF); unpack8(a, gm); unpack8(c, um); }
        else {
#pragma unroll
            for (int i = 0; i < 8; ++i) { gm[i] = 0.f; um[i] = 0.f; } }
        { v4u a = *(const v4u*)zr, c = *(const v4u*)(zr + DFF); unpack8(a, g0); unpack8(c, u0); }
#pragma unroll 1
        for (int r = 0; r < 16; ++r) {
            float gp[8], up[8];
            if (pos0 + r + 1 < Lb) { v4u a = *(const v4u*)(zr + (size_t)(r + 1) * DFF2), c = *(const v4u*)(zr + (size_t)(r + 1) * DFF2 + DFF); unpack8(a, gp); unpack8(c, up); }
            else {
#pragma unroll
                for (int i = 0; i < 8; ++i) { gp[i] = 0.f; up[i] = 0.f; } }
            float o[8];
#pragma unroll
            for (int i = 0; i < 8; ++i) {
                const float gc = wg[0][i] * gm[i] + wg[1][i] * g0[i] + wg[2][i] * gp[i] + bg[i];
                const float uc = wu[0][i] * um[i] + wu[1][i] * u0[i] + wu[2][i] * up[i] + bu[i];
                o[i] = gc * __builtin_amdgcn_rcpf(1.0f + __expf(-gc)) * uc;
                gm[i] = g0[i]; g0[i] = gp[i]; um[i] = u0[i]; u0[i] = up[i]; }
            *(v4u*)(A + (size_t)(row0 + r) * DFF + j0) = pack8(o);
        }
    }
}

__device__ __forceinline__ void gate_fix(const float* ZH, bf16* A, const float* cw, const float* cb, int gt, int ngt) {
    constexpr int NQ4 = DFF / 4;
    for (int it = gt; it < 192 * NQ4; it += ngt) {
        const int rs = it / NQ4, q4 = it % NQ4, pm = rs >> 1, s = rs & 1, row = pm * 256 + (s ? 255 : 0), pos = row_pos(row), Lb = batch_len(row_batch(row));
        if (s == 0 ? (pos == 0) : (pos + 1 == Lb)) continue;
        const int j = q4 * 4, zc = 256 * (j >> 7) + (j & 127);
        const float* zp = s == 0 ? ZH + ((size_t)(pm - 1) * 4 + 3) * DFF2 : ZH + ((size_t)pm * 4 + 2) * DFF2;
        const float* z0 = s == 0 ? ZH + ((size_t)pm * 4 + 0) * DFF2 : ZH + ((size_t)pm * 4 + 3) * DFF2;
        const float* zn = s == 0 ? ZH + ((size_t)pm * 4 + 1) * DFF2 : ZH + ((size_t)(pm + 1) * 4 + 0) * DFF2;
        f32x4 cv[2];
#pragma unroll
        for (int h = 0; h < 2; ++h) {
            const f32x4 a = *(const f32x4*)(zp + zc + 128 * h), b = *(const f32x4*)(z0 + zc + 128 * h), c = *(const f32x4*)(zn + zc + 128 * h);
            const f32x4 w0 = *(const f32x4*)(cw + h * DFF + j), w1 = *(const f32x4*)(cw + DFF2 + h * DFF + j), w2 = *(const f32x4*)(cw + 2 * DFF2 + h * DFF + j), bb = *(const f32x4*)(cb + h * DFF + j);
            cv[h] = w0 * a + w1 * b + w2 * c + bb; }
        float o[4];
#pragma unroll
        for (int e = 0; e < 4; ++e) { const float g = cv[0][e]; o[e] = g * __builtin_amdgcn_rcpf(1.0f + __expf(-g)) * cv[1][e]; }
        u32x2v w; w.x = pk2(o[0], o[1]); w.y = pk2(o[2], o[3]);
        *(u32x2v*)(A + affn_off(row, j)) = w;
    }
}

__device__ __forceinline__ void hyconv_regs(const bf16* PROJ, bf16* XT, const float* cw  , const float* cb  , int gt, int ngt) {
    for (int it = gt; it < (NTOK / 8) * 192; it += ngt) {
        const int tb = it / 192, ck = it % 192, row0 = tb * 8, j0 = ck * 8, which = j0 >> 9, c0 = j0 & 511;
        const int b = row_batch(row0), pos0 = row_pos(row0), Lb = batch_len(b);
        float w0[8], w1[8], w2[8], bb[8];
#pragma unroll
        for (int i = 0; i < 8; i += 4) { const f32x4 a = *(const f32x4*)(cw + j0 + i), c = *(const f32x4*)(cw + 1536 + j0 + i), d = *(const f32x4*)(cw + 3072 + j0 + i), e = *(const f32x4*)(cb + j0 + i);
            w0[i] = a.x; w0[i + 1] = a.y; w0[i + 2] = a.z; w0[i + 3] = a.w; w1[i] = c.x; w1[i + 1] = c.y; w1[i + 2] = c.z; w1[i + 3] = c.w;
            w2[i] = d.x; w2[i + 1] = d.y; w2[i + 2] = d.z; w2[i + 3] = d.w; bb[i] = e.x; bb[i + 1] = e.y; bb[i + 2] = e.z; bb[i + 3] = e.w; }
        const bf16* src = PROJ + (size_t)row0 * INCP + C_B + j0;
        v4u raw[10];
        raw[0] = (pos0 > 0) ? *(const v4u*)(src - INCP) : (v4u){0u, 0u, 0u, 0u};
#pragma unroll
        for (int r = 0; r < 8; ++r) raw[r + 1] = *(const v4u*)(src + (size_t)r * INCP);
        raw[9] = (pos0 + 8 < Lb) ? *(const v4u*)(src + (size_t)8 * INCP) : (v4u){0u, 0u, 0u, 0u};
        float z[8][8]; float xm[8], x0[8], xp[8];
        unpack8(raw[0], xm); unpack8(raw[1], x0);
#pragma unroll
        for (int r = 0; r < 8; ++r) { unpack8(raw[r + 2], xp);
#pragma unroll
            for (int i = 0; i < 8; ++i) { z[r][i] = w0[i] * xm[i] + w1[i] * x0[i] + w2[i] * xp[i] + bb[i]; xm[i] = x0[i]; x0[i] = xp[i]; } }
        bf16* dst = XT + (size_t)which * ((size_t)NTOK * 512) + xt_off(b, c0) + pos0;
        const size_t cst = (size_t)Lb;
#pragma unroll
        for (int i = 0; i < 8; ++i) { v4u o; o.x = pk2(z[0][i], z[1][i]); o.y = pk2(z[2][i], z[3][i]); o.z = pk2(z[4][i], z[5][i]); o.w = pk2(z[6][i], z[7][i]);
            *(v4u*)(dst + (size_t)i * cst) = o; }
    }
}
constexpr int I_IN = 32 * 138, I_QB = 8 * 24, I_KVB = 4 * 32, I_OUT = 32 * 64, I_UP = 32 * 352, I_DN = 88 * 64, I_P = I_IN + I_QB + I_KVB, I_A = I_P + I_OUT, I_L = I_A + I_UP + I_DN;
__device__ __forceinline__ void p0_transpose_item(const float* W, int K, int N, bf16* WT, int row_off, LAS float* scr, int item, int lane) {
    const int nblk = N / 32, kb = item / nblk, nb = item % nblk, k0 = 64 * kb, n0 = 32 * nb;
#pragma unroll
    for (int i = 0; i < 32; ++i) { const int kk = 2 * i + (lane >> 5); scr[kk * 33 + (lane & 31)] = __builtin_nontemporal_load(&W[(size_t)(k0 + kk) * N + n0 + (lane & 31)]); }
    LDS_WAIT(); asm volatile("" ::: "memory");
    const int c = lane & 7;
#pragma unroll
    for (int j = 0; j < 4; ++j) { const int n = (lane >> 3) + 8 * j; const LAS float* s = scr + (8 * c) * 33 + n;
        v4u o; o.x = pk2(s[0 * 33], s[1 * 33]); o.y = pk2(s[2 * 33], s[3 * 33]); o.z = pk2(s[4 * 33], s[5 * 33]); o.w = pk2(s[6 * 33], s[7 * 33]);
        *(GAS v4u*)(WT + (size_t)(row_off + n0 + n) * K + k0 + 8 * c) = o; }
    LDS_WAIT(); asm volatile("" ::: "memory");
}

struct TrItem { const float* W; bf16* WT; int K, N, row_off, r; };
__device__ __forceinline__ void tr_dma(const TrItem& a, int lane, LAS char* buf  ) {
    const int nblk = a.N / 32, kb = a.r / nblk, nb = a.r % nblk, k0 = 64 * kb, n0 = 32 * nb;
    const float* src = a.W + (size_t)(k0 + (lane >> 3)) * a.N + n0;
#pragma unroll
    for (int i = 0; i < 8; ++i)
        __builtin_amdgcn_global_load_lds((const unsigned*)(src + (size_t)(8 * i) * a.N + 4 * ((lane & 7) ^ i)), (LAS unsigned*)(buf + i * 1024), 16, 0, 2);
}
__device__ __forceinline__ void tr_out(const TrItem& a, int lane, const LAS float* s) {
    const int nblk = a.N / 32, kb = a.r / nblk, nb = a.r % nblk, k0 = 64 * kb, n0 = 32 * nb;
    const int c = lane & 7;
#pragma unroll
    for (int j = 0; j < 4; ++j) { const int n = (lane >> 3) + 8 * j; const LAS float* q = s + (64 * c + ((n >> 2) ^ c)) * 4 + (n & 3);
        v4u o; o.x = pk2(q[0 * 32], q[1 * 32]); o.y = pk2(q[2 * 32], q[3 * 32]); o.z = pk2(q[4 * 32], q[5 * 32]); o.w = pk2(q[6 * 32], q[7 * 32]);
        *(GAS v4u*)(a.WT + (size_t)(a.row_off + n0 + n) * a.K + k0 + 8 * c) = o; }
    LDS_WAIT(); asm volatile("" ::: "memory");
}
__device__ __forceinline__ void gmlp_unit(char* ldsg, const bf16* PROJ, bf16* YCAT, const float* sw  , const float* sb  , int unit, int tid) {
    using namespace att;
    const int chunk = unit >> 2, h = unit & 3, row0 = chunk * 128, lane = tid & 63, wid = __builtin_amdgcn_readfirstlane(tid >> 6), hi = lane >> 5, r32 = lane & 31;
    { bf16x8 vw[4];
#pragma unroll
      for (int i = 0; i < 4; ++i) { const int id = tid + i * NTHR, q = id >> 4, cc = (id & 15) * 8; vw[i] = *(const bf16x8*)(PROJ + (size_t)(row0 + q) * INCP + 512 + h * 128 + cc); }
#pragma unroll
      for (int i = 0; i < 4; ++i) { const int id = tid + i * NTHR, q = id >> 4, cc = (id & 15) * 8; *(bf16x8*)(ldsg + (q >> 6) * 16384 + v_st(q & 63, cc)) = vw[i]; } }
    const int pblk = wid >> 1, half = wid & 1;
    bf16x8 af[8];
    { const float* wp = sw + (size_t)h * 16384 + (32 * pblk + r32) * 128 + 8 * hi;
#pragma unroll
      for (int k = 0; k < 8; ++k) { const f32x4 a = *(const f32x4*)(wp + 16 * k), c = *(const f32x4*)(wp + 16 * k + 4);
          u32x4 w; w.x = cvtpk(a.x, a.y); w.y = cvtpk(a.z, a.w); w.z = cvtpk(c.x, c.y); w.w = cvtpk(c.z, c.w); af[k] = __builtin_bit_cast(bf16x8, w); } }
    __syncthreads();
    const int vb0 = (int)(uintptr_t)ldsg + v_rd_base(lane);
    f32x16 o0 = {}, o1 = {};
    if (half == 0) { pv_one<0>(o0, vb0, af[0], af[1], af[2], af[3]); pv_one<1>(o1, vb0, af[0], af[1], af[2], af[3]);
                     pv_one<0>(o0, vb0 + 16384, af[4], af[5], af[6], af[7]); pv_one<1>(o1, vb0 + 16384, af[4], af[5], af[6], af[7]); }
    else           { pv_one<2>(o0, vb0, af[0], af[1], af[2], af[3]); pv_one<3>(o1, vb0, af[0], af[1], af[2], af[3]);
                     pv_one<2>(o0, vb0 + 16384, af[4], af[5], af[6], af[7]); pv_one<3>(o1, vb0 + 16384, af[4], af[5], af[6], af[7]); }
    float* st = (float*)(ldsg + 32768) + wid * (32 * 68);
#pragma unroll
    for (int q = 0; q < 16; ++q) { const int pr = crow(q, hi); const float bs = sb[h * 128 + 32 * pblk + pr];
        st[pr * 68 + r32] = o0[q] + bs; st[pr * 68 + 32 + r32] = o1[q] + bs; }
    asm volatile("s_waitcnt lgkmcnt(0)" ::: "memory");
    v4u uws[4];
#pragma unroll
    for (int i = 0; i < 4; ++i) { const int pr = i * 8 + (lane >> 3), cc = (lane & 7) * 8; uws[i] = *(const v4u*)(PROJ + (size_t)(row0 + 32 * pblk + pr) * INCP + h * 128 + 64 * half + cc); }
#pragma unroll
    for (int i = 0; i < 4; ++i) { const int pr = i * 8 + (lane >> 3), cc = (lane & 7) * 8; const int row = row0 + 32 * pblk + pr, col = h * 128 + 64 * half + cc;
        const f32x4 m0 = *(const f32x4*)(st + pr * 68 + cc), m1 = *(const f32x4*)(st + pr * 68 + cc + 4);
        const v4u uw = uws[i]; float uf[8]; unpack8(uw, uf);
        float y[8] = {uf[0] * m0.x, uf[1] * m0.y, uf[2] * m0.z, uf[3] * m0.w, uf[4] * m1.x, uf[5] * m1.y, uf[6] * m1.z, uf[7] * m1.w};
        *(v4u*)(YCAT + (size_t)row * DM + col) = pack8(y); }
    __syncthreads();
}

__device__ __forceinline__ void mod_phase(LAS unsigned char* lds, const float* cp, const float* cs, const float* ada_w, const float* ada_b, float* MOD, int item0, int item1, int idx, int nidx, int tid) {
    LAS float* sc = (LAS float*)lds;
    LAS float* red = (LAS float*)(lds + 65536);
    const int lane = tid & 63, wid = tid >> 6;
#pragma unroll 8
    for (int i = tid; i < NB * DM; i += NTHR) { const int b = i >> 11, k = i & 2047; const float c = b < 4 ? cp[b * DM + k] : cs[(b - 4) * DM + k]; sc[i] = c / (1.0f + __expf(-c)); }
    __syncthreads();
    for (int item = item0 + idx; item < item1; item += nidx) {
        const int l = item / 96, cbk = item % 96, col0 = cbk * 128 + 2 * lane;
        const float* W = ada_w + (size_t)l * DM * MODW + col0;
        float acc[8][2];
#pragma unroll
        for (int b = 0; b < 8; ++b) { acc[b][0] = 0.f; acc[b][1] = 0.f; }
        const int kbeg = wid * 256;
#pragma unroll 2
        for (int k = kbeg; k < kbeg + 256; k += 4) {
            typedef float f32x2w __attribute__((ext_vector_type(2)));
            f32x2w w[4];
#pragma unroll
            for (int i = 0; i < 4; ++i) w[i] = __builtin_nontemporal_load((const f32x2w*)(W + (size_t)(k + i) * MODW));
#pragma unroll
            for (int b = 0; b < 8; ++b) { const f32x4 s = *(const LAS f32x4*)(sc + b * DM + k);
                acc[b][0] += s.x * w[0].x + s.y * w[1].x + s.z * w[2].x + s.w * w[3].x;
                acc[b][1] += s.x * w[0].y + s.y * w[1].y + s.z * w[2].y + s.w * w[3].y; }
        }
#pragma unroll
        for (int b = 0; b < 8; ++b) { red[(wid * 8 + b) * 128 + 2 * lane] = acc[b][0]; red[(wid * 8 + b) * 128 + 2 * lane + 1] = acc[b][1]; }
        __syncthreads();
        { const int b = tid >> 6, pr = tid & 63; float s0 = 0.f, s1 = 0.f;
#pragma unroll
          for (int w = 0; w < 8; ++w) { s0 += red[(w * 8 + b) * 128 + 2 * pr]; s1 += red[(w * 8 + b) * 128 + 2 * pr + 1]; }
          const int col = cbk * 128 + 2 * pr;
          float* o = MOD + ((size_t)l * NB + b) * MODW + col; o[0] = s0 + ada_b[l * MODW + col]; o[1] = s1 + ada_b[l * MODW + col + 1]; }
        __syncthreads();
    }
}

__device__ __forceinline__ unsigned rot16(unsigned x) { return __builtin_amdgcn_alignbit(x, x, 16); }
__device__ __forceinline__ void filt_item(LAS unsigned char* lds, int L, int tb, const float* w1, const float* b1, const float* f1, const float* w2, const float* b2, const float* f2,
                                          const float* w3, const float* decay, bf16* GFl, int tid) {
    using att::bf16x8; using att::f32x16; using att::u32x4; using att::cvtpk;
    LAS float* feats = (LAS float*)lds;
    LAS float* h1 = feats + 2176;
    LAS float* h2 = h1 + 65 * 64;
    LAS float* hf0 = h2 + 65 * 68;
    const int t0 = 64 * tb; const float invL1 = 1.0f / (float)(L - 1);
    const int GRN = 2 * L / 64 * 72;
    const int lane = tid & 63, wid = __builtin_amdgcn_readfirstlane(tid >> 6), hi = lane >> 5, r32 = lane & 31;
    for (int id = tid; id < 65 * 33; id += NTHR) { const int i = id / 33, f = id % 33; const float t = (float)(t0 + i); float v;
        if (f == 0) v = t * invL1;
        else { const int kb = (f - 1) & 15; const float band = 1e-4f + (float)kb * ((15.0f - 1e-4f) / 15.0f);
            float x = t * band / (float)L; x -= floorf(x); const float a = 6.283185307179586f * x;
            v = (f <= 16) ? __cosf(a) : -__sinf(a); }
        feats[i * 33 + f] = v; }
    __syncthreads();
    for (int id = tid; id < 65 * 64; id += NTHR) { const int i = id >> 6, j = id & 63; float s = b1[j];
#pragma unroll 11
        for (int f = 0; f < 33; ++f) s += feats[i * 33 + f] * w1[f * 64 + j];
        h1[i * 64 + j] = __sinf(f1[j] * s); }
    __syncthreads();
    for (int id = tid; id < 65 * 64; id += NTHR) { const int i = id >> 6, j = id & 63; float s = b2[j];
#pragma unroll 16
        for (int f = 0; f < 64; ++f) s += h1[i * 64 + f] * w2[f * 64 + j];
        h2[i * 68 + j] = __sinf(f2[j] * s); }
    __syncthreads();
    if (tb == 0) {
        for (int cc = tid; cc < 1024; cc += NTHR) { const int col = (cc >> 9) * 1024 + (cc & 511); float s = 0.f;
#pragma unroll 16
            for (int j = 0; j < 64; ++j) s += h2[j] * w3[j * 2048 + col];
            hf0[cc] = s; }
        __syncthreads();
    }
    bf16x8 af[2][2][4];
#pragma unroll
    for (int st = 0; st < 2; ++st)
#pragma unroll
        for (int mb = 0; mb < 2; ++mb)
#pragma unroll
            for (int ks = 0; ks < 4; ++ks) { const LAS float* p = h2 + (st + 32 * mb + r32) * 68 + 16 * ks + 8 * hi;
                const f32x4 x = *(const LAS f32x4*)p, y = *(const LAS f32x4*)(p + 4);
                u32x4 w; w.x = cvtpk(x.x, x.y); w.y = cvtpk(x.z, x.w); w.z = cvtpk(y.x, y.y); w.w = cvtpk(y.z, y.w); af[st][mb][ks] = __builtin_bit_cast(bf16x8, w); }
#pragma unroll 1
    for (int cbi = 0; cbi < 8; ++cbi) {
        const int cb = wid * 8 + cbi, o = cb >> 5, dir = (cb >> 4) & 1, c = (cb & 15) * 32 + r32, col = cb * 32 + r32;
        bf16x8 bfr[4];
#pragma unroll
        for (int ks = 0; ks < 4; ++ks) { float x[8];
#pragma unroll
            for (int j = 0; j < 8; ++j) x[j] = w3[(size_t)(16 * ks + 8 * hi + j) * 2048 + col];
            u32x4 w; w.x = cvtpk(x[0], x[1]); w.y = cvtpk(x[2], x[3]); w.z = cvtpk(x[4], x[5]); w.w = cvtpk(x[6], x[7]); bfr[ks] = __builtin_bit_cast(bf16x8, w); }
        const float dec = fabsf(decay[col]) * invL1;
        bf16* dst = GFl + (size_t)(o * 512 + c) * GRN;
#pragma unroll
        for (int mb = 0; mb < 2; ++mb) {
            f32x16 d = {};
#pragma unroll
            for (int ks = 0; ks < 4; ++ks) d = (dir == 0) ? __builtin_amdgcn_mfma_f32_32x32x16_bf16(af[1][mb][ks], bfr[ks], d, 0, 0, 0)
                                                          : __builtin_amdgcn_mfma_f32_32x32x16_bf16(af[0][mb][ks], bfr[ks], d, 0, 0, 0);
#pragma unroll
            for (int q = 0; q < 16; ++q) { const int mrow = 32 * mb + att::crow(q, hi), t = t0 + mrow + (dir == 0 ? 1 : 0);
                float v = d[q] * __expf(-(float)t * dec);
                if (dir == 0 && t == L) v = 0.f;
                if (dir == 1 && t == 0) v = hf0[o * 512 + c];
                d[q] = v; }
#pragma unroll
            for (int k = 0; k < 2; ++k) {
                const unsigned a0 = cvtpk(d[8 * k + 0], d[8 * k + 1]), a1 = cvtpk(d[8 * k + 2], d[8 * k + 3]), b0 = cvtpk(d[8 * k + 4], d[8 * k + 5]), b1 = cvtpk(d[8 * k + 6], d[8 * k + 7]);
                auto s0 = __builtin_amdgcn_permlane32_swap(a0, b0, false, false); auto s1 = __builtin_amdgcn_permlane32_swap(a1, b1, false, false);
                const unsigned x0 = s0[0], x1 = s1[0], x2 = s0[1], x3 = s1[1];
                const int m0 = 32 * mb + 16 * k + 8 * hi;
                if (dir == 1) { const int ib = L + t0 + m0, ph = (ib >> 6) * 72 + (ib & 63); *(v4u*)(dst + ph) = (v4u){x0, x1, x2, x3}; }
                else { const int ib = L - t0 - m0 - 8, ph = (ib >> 6) * 72 + (ib & 63); *(v4u*)(dst + ph) = (v4u){rot16(x3), rot16(x2), rot16(x1), rot16(x0)}; }
            }
        }
    }
    __syncthreads();
}

__device__ __forceinline__ void ga_tables(const float* n1g, const float* n2g, const float* MODp, float* GA1, float* GA2, int l, int gt, int ngt) {
    for (int i = gt; i < 2 * NB * DM; i += ngt) { const int which = i / (NB * DM), r = l * (NB * DM) + i % (NB * DM), b = (r / DM) % NB, c = r % DM;
        const float sc = MODp[((size_t)l * NB + b) * MODW + (which ? 4 * DM : DM) + c];
        (which ? GA2 : GA1)[r] = (which ? n2g : n1g)[l * DM + c] * (1.0f + sc); }
}
__device__ __forceinline__ void bvec_item(LAS unsigned char* lds, const float* shp, const bf16* Wt, float* BV, int ldbv, int n0, int tid) {
    LAS float* sb = (LAS float*)lds;
    const int lane = tid & 63, wid = tid >> 6;
#pragma unroll 8
    for (int i = tid; i < NB * DM / 4; i += NTHR) { const int b = i / (DM / 4), k4 = i % (DM / 4); *(LAS f32x4*)(sb + b * DM + 4 * k4) = *(const f32x4*)(shp + (size_t)b * MODW + 4 * k4); }
    __syncthreads();
#pragma unroll 1
    for (int rg = 0; rg < 2; ++rg) { const int nb = n0 + wid * 8 + rg * 4;
        float acc[32];
#pragma unroll
        for (int i = 0; i < 32; ++i) acc[i] = 0.f;
#pragma unroll 1
        for (int j = 0; j < 4; ++j) { float f[4][8];
#pragma unroll
            for (int r = 0; r < 4; ++r) { const v4u w = *(const v4u*)(Wt + (size_t)(nb + r) * DM + 8 * lane + 512 * j); unpack8(w, f[r]); }
#pragma unroll
            for (int b = 0; b < 8; ++b) { const f32x4 s0 = *(const LAS f32x4*)(sb + b * DM + 8 * lane + 512 * j), s1 = *(const LAS f32x4*)(sb + b * DM + 8 * lane + 512 * j + 4);
#pragma unroll
                for (int r = 0; r < 4; ++r)
                    acc[r * 8 + b] += (f[r][0] * s0.x + f[r][1] * s0.y) + (f[r][2] * s0.z + f[r][3] * s0.w) + (f[r][4] * s1.x + f[r][5] * s1.y) + (f[r][6] * s1.z + f[r][7] * s1.w); } }
#pragma unroll
        for (int st = 0; st < 5; ++st) { const int n = 16 >> st, x = 32 >> st; const bool up = (lane & x) != 0;
#pragma unroll
            for (int i = 0; i < n; ++i) { const float keep = up ? acc[i + n] : acc[i], send = up ? acc[i] : acc[i + n]; acc[i] = keep + __shfl_xor(send, x); } }
        const float tot = acc[0] + __shfl_xor(acc[0], 1);
        const int idx = (lane >> 1) & 31;
        const int idxr = ((idx & 16) ? 16 : 0) | ((idx & 8) ? 8 : 0) | ((idx & 4) ? 4 : 0) | ((idx & 2) ? 2 : 0) | (idx & 1);
        if ((lane & 1) == 0) BV[(size_t)(idxr & 7) * ldbv + nb + (idxr >> 3)] = tot;
    }
    __syncthreads();
}
__device__ __forceinline__ void norm0_rows(const float* xa, const float* xb, const float* g, const float* mod, bf16* H, unsigned long long* SS, int gw, int ngw, int lane) {
    for (int ck = gw; ck < NTOK / 4; ck += ngw) {
        const int row0 = ck * 4, b = row_batch(row0);
        const float* xin = row0 < NPR ? xa : xb;
        const float* sc = mod + (size_t)b * MODW + DM;
        f32x4 ga[8];
#pragma unroll
        for (int j = 0; j < 8; ++j) { const int col = 4 * lane + 256 * j; ga[j] = *(const f32x4*)(g + col) * (*(const f32x4*)(sc + col) + 1.0f); }
#pragma unroll 1
        for (int r = 0; r < 4; ++r) {
            const float* xr = xin + (size_t)(row0 + r) * DM;
            f32x4 v[8]; float ss = 0.f;
#pragma unroll
            for (int j = 0; j < 8; ++j) { v[j] = *(const f32x4*)(xr + 4 * lane + 256 * j); ss += (v[j].x * v[j].x + v[j].y * v[j].y) + (v[j].z * v[j].z + v[j].w * v[j].w); }
            ss = wave_sum(ss); if (lane == 0) SS[row0 + r] = (unsigned long long)(ss * 16777216.0f + 0.5f);
            bf16* hr = H + (size_t)(row0 + r) * DM;
#pragma unroll
            for (int j = 0; j < 8; ++j) { const f32x4 o = v[j] * ga[j]; u32x2v w; w.x = pk2(o.x, o.y); w.y = pk2(o.z, o.w);
                *(u32x2v*)(hr + 4 * lane + 256 * j) = w; }
        }
    }
}
#ifndef MK_PHMASK
#define MK_PHMASK 0xFFFFFFFFu
#endif
#define EN(p) (((MK_PHMASK) >> (p)) & 1u)
#ifndef MK_REPEAT
#define MK_REPEAT 0u
#endif
#define REP(p) for (int rep_ = 0; rep_ < 1 + (int)(((MK_REPEAT) >> (p)) & 1u); ++rep_)
constexpr int NPH_LAYER = 10, NPHASE = 2 + DEPTH * NPH_LAYER;
struct Args { const float* in[37]; float* out; unsigned char* ws; int ph_lo, ph_hi; };
static_assert(sizeof(Args) == 39 * 8 + 8, "Args has no padding");

typedef const __attribute__((address_space(4))) Args* KArgs;
__device__ __forceinline__ KArgs kargs() { KArgs p = (KArgs)__builtin_amdgcn_kernarg_segment_ptr(); asm volatile("" : "+s"(p)); return p; }
#define AIN(i) (kargs()->in[i])
__global__ void __launch_bounds__(NTHR, 2) mk_fwd(Args args_unused) {
    extern __shared__ __attribute__((aligned(16))) unsigned char lds_raw[];
    LAS unsigned char* lds = (LAS unsigned char*)lds_raw;
    volatile LAS unsigned* MISC = (volatile LAS unsigned*)(lds + MISC_OFF);
    const int tid0 = threadIdx.x;
#define tid tid_fresh()
#define lane (tid_fresh() & 63)
#define wave (__builtin_amdgcn_readfirstlane(tid_fresh() >> 6))
    const int G0 = gridDim.x; const int bx0 = blockIdx.x; const int vcu0 = (G0 % 8 == 0) ? (bx0 % 8) * (G0 / 8) + bx0 / 8 : bx0;
#define G (sfresh(G0))
#define bx (sfresh(bx0))
#define vcu (sfresh(vcu0))
#define gw (vcu * NWAVES + wave)
#define ngw (G * NWAVES)
    gu32* ctl = (gu32*)(kargs()->ws + WS_CTL);
    for (int u = tid0; u < (LDS_BYTES - LDSCTL_OFF) / 4; u += NTHR) ((LAS unsigned*)(lds + LDSCTL_OFF))[u] = 0u;
    __syncthreads();
#if MK_MULTI
    XcdBarrier bar; bar.bar = (unsigned*)(ctl + CW_BAR); bar.x = 0; bar.st = nullptr;
#define SEAM(k) do { } while (0)
#else
    XcdBarrier bar = xcd_barrier_post((unsigned*)(ctl + CW_BAR), MISC + 8);
#define SEAM(k) do { if (IN(k) && IN((k) + 1)) { xcd_barrier(bar); if ((MK_REPEAT >> 19) & 1u) xcd_barrier(bar); } } while (0)
#endif
    const int lo = kargs()->ph_lo, hi = kargs()->ph_hi;
#define IN(k) (lo <= (k) && (k) < hi)
#define ws (kargs()->ws)
#define MOD ((float*)(ws + WS_MOD))
#define HB ((bf16*)(ws + WS_HB))
#define AFFN ((bf16*)(ws + WS_AFFN))
#define Z ((bf16*)(ws + WS_Z))
#define PROJ ((bf16*)(ws + WS_PROJ))
#define XT ((bf16*)(ws + WS_XT))
#define Y2T ((bf16*)(ws + WS_Y2T))
#define QD ((bf16*)(ws + WS_QD))
#define KVD ((bf16*)(ws + WS_KVD))
#define KMLA ((bf16*)(ws + WS_KMLA))
#define YCAT ((bf16*)(ws + WS_YCAT))
#define OUT (kargs()->out)

#define CONV_DECODE(l_, r_, T) do { const int cl_ = (l_); int r = (r_); \
        if (r < I_IN) T = TrItem{AIN(7) + (size_t)cl_ * DM * INC, (bf16*)(ws + WS_WIN + cl_ * SZ_WIN), DM, INC, 0, r}; \
        else if ((r -= I_IN) < I_QB) T = TrItem{AIN(25) + (size_t)cl_ * 512 * 768, (bf16*)(ws + WS_WQB + cl_ * SZ_WQB), 512, 768, 0, r}; \
        else if ((r -= I_QB) < I_KVB) T = TrItem{AIN(27) + (size_t)cl_ * 256 * 1024, (bf16*)(ws + WS_WKVB + cl_ * SZ_WKVB), 256, 1024, 0, r}; \
        else if ((r -= I_KVB) < I_OUT) T = TrItem{AIN(31) + (size_t)cl_ * DM * DM, (bf16*)(ws + WS_WOUT + cl_ * SZ_WOUT), DM, DM, 0, r}; \
        else if ((r -= I_OUT) < I_DN) T = TrItem{AIN(36) + (size_t)cl_ * DFF * DM, (bf16*)(ws + WS_WDN + cl_ * SZ_WDN), DFF, DM, 0, r}; \
        else { r -= I_DN; const int n0 = 32 * (r % 352), hf = n0 >= DFF ? 1 : 0, j = n0 - DFF * hf, dest = 256 * (j >> 7) + 128 * hf + (j & 127);     \
            T = TrItem{AIN(33) + (size_t)cl_ * DM * DFF2, (bf16*)(ws + WS_WUP + cl_ * SZ_WUP), DM, DFF2, dest - n0, r}; } } while (0)
#define CONV_STREAM(l_, i0_, i1_, w0_, nw_, sk0_, skn_) do { LAS char* sb_ = (LAS char*)lds + wave * 16384; const int ln_ = lane; \
        int it = (i0_) + (w0_), pb_ = 0; TrItem ta_; \
        if (it < (i1_)) { CONV_DECODE(l_, it < (sk0_) ? it : it + (skn_), ta_); tr_dma(ta_, ln_, sb_); } \
        while (it < (i1_)) { const int nx_ = it + (nw_); TrItem tb_ = ta_; \
            if (nx_ < (i1_)) { CONV_DECODE(l_, nx_ < (sk0_) ? nx_ : nx_ + (skn_), tb_); tr_dma(tb_, ln_, sb_ + (pb_ ^ 1) * 8192); asm volatile("s_waitcnt vmcnt(8)" ::: "memory"); }     \
            else asm volatile("s_waitcnt vmcnt(0)" ::: "memory"); \
            tr_out(ta_, ln_, (const LAS float*)(sb_ + pb_ * 8192)); \
            ta_ = tb_; pb_ ^= 1; it = nx_; } \
        VM_WAIT(); } while (0)
#define CONV_TAIL(S_, l_, i0_, i1_, sk0_, skn_) do { if ((l_) < DEPTH) { const int rem_ = (S_).nwg % G; if (rem_ == 0 || bx >= rem_) { \
        VM_WAIT(); __syncthreads(); \
        CONV_STREAM(l_, i0_, i1_, (rem_ == 0 ? bx : bx - rem_) * NWAVES + wave, (rem_ == 0 ? G : G - rem_) * NWAVES, sk0_, skn_); } } } while (0)

    if (EN(0) && IN(0)) REP(0) {
        REP(21) mod_phase(lds, AIN(2), AIN(3), AIN(4), AIN(5), MOD, 0, DEPTH * 96, vcu, G, tid);
        REP(22) for (int item = (vcu + G / 2) % G; item < DEPTH * 96; item += G) {     const int l = item / 96, r = item % 96; const int L = r < 32 ? LP : LS, tb = r < 32 ? r : r - 32;
            bf16* GFl = (bf16*)(ws + WS_GF + (size_t)l * SZ_GF + (r < 32 ? 0 : SZ_GF_P));
            filt_item(lds, L, tb, AIN(13) + (size_t)l * 33 * 64, AIN(14) + l * 64, AIN(15) + l * 64, AIN(16) + (size_t)l * 4096, AIN(17) + l * 64, AIN(18) + l * 64,
                      AIN(19) + (size_t)l * 64 * 2048, AIN(20) + (size_t)l * 2048, GFl, tid); }
        __syncthreads();
        REP(23) CONV_STREAM(0, 0, I_L - (I_OUT + I_DN), gw, ngw, I_P, I_OUT + I_DN);
        for (int i = vcu * NTHR + tid; i < DEPTH * (INCP - INC) * (DM / 8); i += G * NTHR) { const int l = i / ((INCP - INC) * (DM / 8)), r = i % ((INCP - INC) * (DM / 8));
            *(v4u*)(ws + WS_WIN + l * SZ_WIN + ((size_t)INC * DM + (size_t)r * 8) * 2) = (v4u){0u, 0u, 0u, 0u}; }
        VM_WAIT(); __syncthreads();
    }
    SEAM(0);

    if (EN(1) && IN(1)) REP(1) {
        for (int l = 0; l < DEPTH; ++l) ga_tables(AIN(6), AIN(32), MOD, (float*)(ws + WS_GA1), (float*)(ws + WS_GA2), l, vcu * NTHR + tid, G * NTHR);
        for (int it = vcu; it < 248; it += G) { const int l = 0, r = it;
            if (r < 72) bvec_item(lds, MOD + (size_t)l * NB * MODW, (const bf16*)(ws + WS_WIN + l * SZ_WIN), (float*)(ws + WS_BV1) + (size_t)l * NB * INCP, INCP, r * 64, tid);
            else bvec_item(lds, MOD + (size_t)l * NB * MODW + 3 * DM, (const bf16*)(ws + WS_WUP + l * SZ_WUP), (float*)(ws + WS_BV2) + (size_t)l * NB * DFF2, DFF2, (r - 72) * 64, tid); }
        norm0_rows(AIN(0), AIN(1) - (size_t)NPR * DM, AIN(6), MOD, HB, (unsigned long long*)(ws + WS_SSQ1), gw, ngw, lane);
    }
    SEAM(1);

#pragma unroll 1
    for (int l = 0; l < DEPTH; ++l) {
        const int pb = 2 + l * NPH_LAYER;
#define xa ((l == 0) ? AIN(0) : OUT)
#define xb ((l == 0) ? (AIN(1) - (size_t)NPR * DM) : OUT)
#define modl (MOD + (size_t)l * NB * MODW)
        if (EN(2) && IN(pb + 0)) REP(2) {
            pg8::Gemm g{HB, (const bf16*)(ws + WS_WIN + l * SZ_WIN), NTOK, INCP, DM, DM, DM}; pg8::StaticOrder S; S.init(NTOK, INCP, G, bx);
            LAS float* rst = (LAS float*)(lds + TAB_OFF); LAS float* bvt = rst + 8 * 256;
            pg8::fill_tabs(S, (const unsigned long long*)(ws + WS_SSQ1), (const float*)(ws + WS_BV1) + (size_t)l * NB * INCP, INCP, rst, bvt, tid);
            pg8::EpiBf E{PROJ, INCP, 4, rst, bvt, 0};
            pg8::gemm_phase<pg8::EpiBf, pg8::StaticOrder, true, true>(lds, g, S, E);
            if (l == 0) CONV_TAIL(S, 0, I_P, I_P + I_OUT + I_DN, I_L, 0);
        }
        SEAM(pb + 0);
        if (EN(3) && IN(pb + 1)) {
            for (int i = vcu * NTHR + tid; i < NTOK; i += G * NTHR) ((unsigned long long*)(ws + WS_SSQ1))[i] = 0ull;
            REP(20) post_rows(PROJ, AIN(8) + l * 512, AIN(22) + l * 128, AIN(23) + l * 128, AIN(24) + l * 512, AIN(26) + l * 256, gw, ngw, lane, rep_ == (int)((MK_REPEAT >> 20) & 1u));
            REP(3) for (int t = vcu; t < (NTOK / 64) * 3; t += G) hyconv_tile(lds, PROJ, XT, AIN(11) + (size_t)l * 3 * 1536, AIN(12) + l * 1536, t, tid);
        }
        SEAM(pb + 1);
        if (EN(4) && IN(pb + 2)) REP(4) {
            { pg8::Gemm g{PROJ + C_D, (const bf16*)(ws + WS_WQB + l * SZ_WQB), NTOK, 768, 512, INCP, 512}; pg8::StaticOrder S; S.init(NTOK, 768, G, bx);
              pg8::EpiBf E{QD, 768, 0, nullptr, nullptr, 0};
              pg8::gemm_phase<pg8::EpiBf, pg8::StaticOrder, true, true>(lds, g, S, E); }
            { pg8::Gemm g{PROJ + C_D + 512, (const bf16*)(ws + WS_WKVB + l * SZ_WKVB), NTOK, 1024, 256, INCP, 256}; pg8::StaticOrder S; S.init(NTOK, 1024, G, (bx + G / 2) % G);
              pg8::EpiBf E{KVD, 1024, 0, nullptr, nullptr, 0};
              pg8::gemm_phase<pg8::EpiBf, pg8::StaticOrder, true, true>(lds, g, S, E); }
        }
        SEAM(pb + 2);
        if (EN(5) && IN(pb + 3)) {
            REP(5) mla_rows(QD, KVD, PROJ, KMLA, AIN(28) + l * 192, AIN(29) + l * 192, gw, ngw, lane, rep_ == (int)((MK_REPEAT >> 5) & 1u));
        }
        SEAM(pb + 3);
        if (EN(6) && IN(pb + 4)) {
            if (EN(13)) REP(13) for (int u = vcu; u < 256; u += G) { const int bh = u >> 4, qb = u & 15, b = 4 + (bh >> 2), h = bh & 3; const size_t r0 = batch_row0(b);
                att::attn_body16<192, 768, 768, 1024, DM>(QD + (r0 + qb * 256) * 768 + h * 192, KMLA + r0 * 768 + h * 192, KVD + r0 * 1024 + h * 256 + 128,
                                      YCAT + (r0 + qb * 256) * DM + 1536 + h * 128, LS, (char*)lds_raw); }
            if (EN(14)) REP(14) for (int u = vcu; u < 256; u += G) { const int bh = u >> 4, qb = u & 15, b = 4 + (bh >> 2), h = bh & 3; const size_t r0 = batch_row0(b);
                att::attn_body16<128, INCP, INCP, INCP, DM>(PROJ + (r0 + qb * 256) * INCP + C_C + h * 128, PROJ + r0 * INCP + C_C + 512 + (h >> 1) * 128, PROJ + r0 * INCP + C_C + 768 + (h >> 1) * 128,
                                      YCAT + (r0 + qb * 256) * DM + 1024 + h * 128, LS, (char*)lds_raw); }
            if (EN(15)) REP(15) for (int u = vcu; u < 256; u += G)
                hy::hyena_unit<LS>((LAS char*)lds, (const bf16*)(ws + WS_GF + (size_t)l * SZ_GF + SZ_GF_P), XT, XT + (size_t)NTOK * 512, XT + (size_t)2 * NTOK * 512, Y2T, AIN(21) + l * 1024, 4, 2 * u);
            REP(17) for (int i = vcu; i < 256; i += G) { const int u = i & 127, bh = u >> 3, qb = u & 7, b = bh >> 2, h = bh & 3; const size_t r0 = batch_row0(b);
                if (i < 128) { if (EN(13))
                    att::attn_body16<192, 768, 768, 1024, DM>(QD + (r0 + qb * 256) * 768 + h * 192, KMLA + r0 * 768 + h * 192, KVD + r0 * 1024 + h * 256 + 128,
                                          YCAT + (r0 + qb * 256) * DM + 1536 + h * 128, LP, (char*)lds_raw); }
                else if (EN(14))
                    att::attn_body16<128, INCP, INCP, INCP, DM>(PROJ + (r0 + qb * 256) * INCP + C_C + h * 128, PROJ + r0 * INCP + C_C + 512 + (h >> 1) * 128, PROJ + r0 * INCP + C_C + 768 + (h >> 1) * 128,
                                          YCAT + (r0 + qb * 256) * DM + 1024 + h * 128, LP, (char*)lds_raw); }
            if (EN(15)) REP(18) for (int i = (G == 256) ? (vcu + 128) % 256 : vcu; i < 128; i += G)
                hy::hyena_unit<LP>((LAS char*)lds, (const bf16*)(ws + WS_GF + (size_t)l * SZ_GF), XT, XT + (size_t)NTOK * 512, XT + (size_t)2 * NTOK * 512, Y2T, AIN(21) + l * 1024, 0, 4 * i);
            if (EN(16)) REP(16) {
                if (G == 256) { const int v_ = vcu;
                    if (v_ < 128) { for (int u = v_; u < 768; u += 128) gmlp_unit((char*)lds_raw, PROJ, YCAT, AIN(9) + (size_t)l * 4 * 16384, AIN(10) + l * 512, u, tid); } }
                else for (int u = vcu; u < 768; u += G) gmlp_unit((char*)lds_raw, PROJ, YCAT, AIN(9) + (size_t)l * 4 * 16384, AIN(10) + l * 512, u, tid); }
            VM_WAIT(); __syncthreads();
        }
        SEAM(pb + 4);
        if (EN(7) && IN(pb + 5)) REP(7) { for (int t = vcu; t < NTOK / 32; t += G) gnorm_tile(lds, YCAT, Y2T, AIN(30) + l * DM, HB, t, tid); }
        SEAM(pb + 5);
        if (EN(8) && IN(pb + 6)) {
            pg8::Gemm g{HB, (const bf16*)(ws + WS_WOUT + l * SZ_WOUT), NTOK, DM, DM, DM, DM}; pg8::StaticOrder S; S.init(NTOK, DM, G, bx);
            if (l == 0) { pg8::EpiResidT<false, true> E{AIN(0), AIN(1) - (size_t)NPR * DM, OUT, modl + 2 * DM, (bf16*)(ws + WS_HB2), (const float*)(ws + WS_GA2) + (size_t)l * NB * DM, (unsigned long long*)(ws + WS_SSQ2)};
                pg8::gemm_phase<pg8::EpiResidT<false, true>, pg8::StaticOrder, true, true>(lds, g, S, E); }
            else { pg8::EpiResidT<true, true> E{OUT, OUT, (l + 1 == DEPTH) ? (void*)(ws + WS_XRES) : (void*)OUT, modl + 2 * DM, (bf16*)(ws + WS_HB2), (const float*)(ws + WS_GA2) + (size_t)l * NB * DM, (unsigned long long*)(ws + WS_SSQ2)};
                pg8::gemm_phase<pg8::EpiResidT<true, true>, pg8::StaticOrder, true, true>(lds, g, S, E); }
        }
        SEAM(pb + 6);
        if (EN(10) && IN(pb + 7)) REP(10) {
            pg8::Gemm g{(const bf16*)(ws + WS_HB2), (const bf16*)(ws + WS_WUP + l * SZ_WUP), NTOK, DFF2, DM, DM, DM}; pg8::StaticOrder S; S.init(NTOK, DFF2, G, bx);
            LAS float* rst = (LAS float*)(lds + TAB_OFF);
            pg8::fill_tabs(S, (const unsigned long long*)(ws + WS_SSQ2), nullptr, 0, rst, rst, tid);
            pg8::EpiGate E{AFFN, (float*)(ws + WS_R1), AIN(34) + (size_t)l * 3 * DFF2, AIN(35) + l * DFF2, (LAS float*)(lds + HALO_OFF), rst, (const float*)(ws + WS_BV2) + (size_t)l * NB * DFF2, 0};
            pg8::gemm_phase<pg8::EpiGate, pg8::StaticOrder, true, true>(lds, g, S, E);
            CONV_TAIL(S, l + 1, 0, I_L, I_L, 0);
        }
        SEAM(pb + 7);
        if (EN(11) && IN(pb + 8)) for (int i = vcu * NTHR + tid; i < NTOK; i += G * NTHR) ((unsigned long long*)(ws + WS_SSQ2))[i] = 0ull;
        if (EN(11) && IN(pb + 8)) REP(11) gate_fix((const float*)(ws + WS_R1), AFFN, AIN(34) + (size_t)l * 3 * DFF2, AIN(35) + l * DFF2, vcu * NTHR + tid, G * NTHR);
        if (EN(11) && IN(pb + 8) && l + 1 < DEPTH) for (int it = vcu; it < 248; it += G) { const int l1 = l + 1, r = it;
            if (r < 72) bvec_item(lds, MOD + (size_t)l1 * NB * MODW, (const bf16*)(ws + WS_WIN + l1 * SZ_WIN), (float*)(ws + WS_BV1) + (size_t)l1 * NB * INCP, INCP, r * 64, tid);
            else bvec_item(lds, MOD + (size_t)l1 * NB * MODW + 3 * DM, (const bf16*)(ws + WS_WUP + l1 * SZ_WUP), (float*)(ws + WS_BV2) + (size_t)l1 * NB * DFF2, DFF2, (r - 72) * 64, tid); }
        SEAM(pb + 8);
        if (EN(12) && IN(pb + 9)) {
            pg8::Gemm g{AFFN, (const bf16*)(ws + WS_WDN + l * SZ_WDN), NTOK, DM, DFF, DFF, DFF}; pg8::StaticOrder S; S.init(NTOK, DM, G, bx);
            if (l + 1 < DEPTH) { pg8::EpiResidT<true, true> E{OUT, OUT, OUT, modl + 5 * DM, HB, (const float*)(ws + WS_GA1) + (size_t)(l + 1) * NB * DM, (unsigned long long*)(ws + WS_SSQ1)};
                pg8::gemm_phase<pg8::EpiResidT<true, true>, pg8::StaticOrder, true, true, true, false>(lds, g, S, E); }
            else { pg8::EpiResidT<true, false> E{(const void*)(ws + WS_XRES), (const void*)(ws + WS_XRES), OUT, modl + 5 * DM, nullptr, nullptr, nullptr};
                pg8::gemm_phase<pg8::EpiResidT<true, false>, pg8::StaticOrder, true, true, true, false>(lds, g, S, E); }
        }
        if (l + 1 < DEPTH) SEAM(pb + 9);
    }
#undef xa
#undef xb
#undef modl
#undef G
#undef bx
#undef vcu
#undef ngw
#undef IN
#undef SEAM
#undef tid
#undef lane
#undef wave
#undef gw
#undef ws
#undef MOD
#undef HB
#undef AFFN
#undef Z
#undef PROJ
#undef XT
#undef Y2T
#undef QD
#undef KVD
#undef KMLA
#undef YCAT
#undef OUT
}

extern "C" void kernel_launch(void* const* d_in, const int* in_sizes, int n_in, void* d_out, int out_size, void* d_ws, size_t ws_size, hipStream_t stream) {
    static int grid = 0;
    if (grid == 0) {
        if (n_in != 37 || out_size != NTOK * DM || ws_size < WS_END) { fprintf(stderr, "kernel_launch: shape mismatch (n_in %d out %d ws %zu need %zu)\n", n_in, out_size, ws_size, (size_t)WS_END); grid = -1; return; }
        int dev = 0, cus = 0, per_cu = 0;
        if (hipGetDevice(&dev) != hipSuccess || hipDeviceGetAttribute(&cus, hipDeviceAttributeMultiprocessorCount, dev) != hipSuccess) { grid = -1; return; }
        if (hipFuncSetAttribute((const void*)mk_fwd, hipFuncAttributeMaxDynamicSharedMemorySize, LDS_BYTES) != hipSuccess) { fprintf(stderr, "kernel_launch: hipFuncSetAttribute failed\n"); grid = -1; return; }
        if (hipOccupancyMaxActiveBlocksPerMultiprocessor(&per_cu, (const void*)mk_fwd, NTHR, LDS_BYTES) != hipSuccess || per_cu < 1)
            fprintf(stderr, "kernel_launch: occupancy query reports %d workgroups per CU\n", per_cu);
        (void)hipGetLastError();
        grid = cus;
        if (grid > 256) grid = 256;
    }
    if (grid < 0) return;
    if (hipMemsetAsync((char*)d_ws + WS_CTL, 0, CTL_ZERO_BYTES, stream) != hipSuccess) { fprintf(stderr, "kernel_launch: memset failed\n"); return; }
    Args a{};
    for (int i = 0; i < 37; ++i) a.in[i] = (const float*)d_in[i];
    a.out = (float*)d_out; a.ws = (unsigned char*)d_ws;
#if MK_MULTI
    for (int p = 0; p < NPHASE; ++p) { a.ph_lo = p; a.ph_hi = p + 1; hipLaunchKernelGGL(mk_fwd, dim3(grid), dim3(NTHR), LDS_BYTES, stream, a); }
#else
    a.ph_lo = 0; a.ph_hi = NPHASE;
    hipLaunchKernelGGL(mk_fwd, dim3(grid), dim3(NTHR), LDS_BYTES, stream, a);
#endif
    const hipError_t le = hipPeekAtLastError();
    if (le != hipSuccess) fprintf(stderr, "kernel_launch: launch failed: %s\n", hipGetErrorName(le));
}
```
